# Optimizing an MI355X kernel written in HIP

```python
import jax, jax.numpy as jnp
from jax import lax
import numpy as np

D_MODEL = 2048
BATCH = 4
SEQ = 2048
DEPTH = 1

CHUNK = 64
NORM_EPS = 1e-5
N_BRANCHES = 2
RWKV_WIDTH = 1024
RWKV_HEAD = 64
RWKV_HEADS = RWKV_WIDTH // RWKV_HEAD
DECAY_LORA = 96
ICL_LORA = 96
GATE_LORA = 256
RWKV_GN_EPS = 64e-5
GLA_HEADS = 4
GLA_DK = 128
GLA_DV = 256
GLA_KEY_WIDTH = GLA_HEADS * GLA_DK
GLA_VAL_WIDTH = GLA_HEADS * GLA_DV
GLA_GATE_LORA = 16
GLA_TAU = 16.0
N_EXPERTS = 32
TOP_K = 4
D_FF = 2048
SWIGLU_LIMIT = 7.0
SWIGLU_ALPHA = 1.702
EXPERT_BLOCK = 128
RWKV_COLS = 3 * RWKV_WIDTH + DECAY_LORA + ICL_LORA + GATE_LORA
GLA_COLS = 2 * GLA_KEY_WIDTH + 2 * GLA_VAL_WIDTH + GLA_GATE_LORA
IN_COLS = RWKV_COLS + GLA_COLS + N_BRANCHES * D_MODEL

kernel_name = "hybrid_rwkv7_gla_moe_block"


def _f32(t):
    return t.astype(jnp.float32)


def _split(p, sizes):
    idx, acc = [], 0
    for s in sizes[:-1]:
        acc += s
        idx.append(acc)
    return jnp.split(p, idx, axis=-1)


def _rms_norm(x, g):
    xf = _f32(x)
    y = xf * lax.rsqrt(jnp.mean(xf * xf, axis=-1, keepdims=True) + NORM_EPS)
    return (y * _f32(g)).astype(x.dtype)


def _token_shift(p):
    return jnp.concatenate([jnp.zeros_like(p[:, :1]), p[:, :-1]], axis=1)


def _rwkv7_step(state, inp):
    r_t, w_t, k_t, v_t, kk_t, a_t = inp
    sa = jnp.einsum('bhvk,bhk->bhv', state, -kk_t)
    state = (state * w_t[:, :, None, :]
             + sa[..., None] * (kk_t * a_t)[:, :, None, :]
             + v_t[..., None] * k_t[:, :, None, :])
    y = jnp.einsum('bhvk,bhk->bhv', state, r_t)
    return state, y


def _rwkv7_branch(p, mu, w0, w2, a0, a2, g2, k_k, k_a, r_k, lnx_g, lnx_b):
    B, L, _ = p.shape
    dt = p.dtype
    p = _f32(p + (_token_shift(p) - p) * mu)
    r, k, v, wl, al, gl = _split(p, (RWKV_WIDTH, RWKV_WIDTH, RWKV_WIDTH, DECAY_LORA, ICL_LORA, GATE_LORA))
    w_log = -jax.nn.softplus(-(_f32(w0) + jnp.tanh(wl) @ _f32(w2))) - 0.5
    decay = jnp.exp(-jnp.exp(w_log))
    a = jax.nn.sigmoid(_f32(a0) + al @ _f32(a2))
    g = jax.nn.sigmoid(gl) @ _f32(g2)
    heads = lambda t: t.reshape(B, L, RWKV_HEADS, RWKV_HEAD)
    kk = heads(k * _f32(k_k))
    kk = kk / jnp.maximum(jnp.linalg.norm(kk, axis=-1, keepdims=True), 1e-12)
    k = k * (1.0 + (a - 1.0) * _f32(k_a))
    r, k, v, decay, a = heads(r), heads(k), heads(v), heads(decay), heads(a)
    xs = tuple(jnp.swapaxes(t, 0, 1) for t in (r, decay, k, v, kk, a))
    state0 = jnp.zeros((B, RWKV_HEADS, RWKV_HEAD, RWKV_HEAD), jnp.float32)
    _, y = lax.scan(_rwkv7_step, state0, xs)
    y = jnp.swapaxes(y, 0, 1)
    mean = jnp.mean(y, axis=-1, keepdims=True)
    var = jnp.mean(jnp.square(y - mean), axis=-1, keepdims=True)
    y = ((y - mean) * lax.rsqrt(var + RWKV_GN_EPS)).reshape(B, L, RWKV_WIDTH) * _f32(lnx_g) + _f32(lnx_b)
    bonus = (jnp.sum(r * k * _f32(r_k), axis=-1, keepdims=True) * v).reshape(B, L, RWKV_WIDTH)
    return ((y + bonus) * g).astype(dt)


def _gla_chunk_step(state, inp):
    q, k, v, g = inp
    b = jnp.cumsum(g, axis=2)
    diff = b[:, :, :, None, :] - b[:, :, None, :, :]
    causal = jnp.tril(jnp.ones((CHUNK, CHUNK), bool))[None, None, :, :, None]
    decay = jnp.exp(jnp.where(causal, diff, -jnp.inf))
    attn = jnp.einsum('bhtd,bhsd,bhtsd->bhts', q, k, decay)
    o = attn @ v + jnp.einsum('bhtd,bhdv->bhtv', q * jnp.exp(b), state)
    b_last = b[:, :, -1, :]
    state = (state * jnp.exp(b_last)[..., None]
             + jnp.einsum('bhsd,bhsv->bhdv', k * jnp.exp(b_last[:, :, None, :] - b), v))
    return state, o


def _gla_branch(p, w_alpha2, b_alpha, norm_g):
    B, L, _ = p.shape
    dt = p.dtype
    p = _f32(p)
    q, k, v, og, al = _split(p, (GLA_KEY_WIDTH, GLA_KEY_WIDTH, GLA_VAL_WIDTH, GLA_VAL_WIDTH, GLA_GATE_LORA))
    log_alpha = jax.nn.log_sigmoid(al @ _f32(w_alpha2) + _f32(b_alpha)) / GLA_TAU
    q = q * (GLA_DK ** -0.5)
    nc = L // CHUNK
    to_chunks = lambda t, d: t.reshape(B, nc, CHUNK, GLA_HEADS, d).transpose(1, 0, 3, 2, 4)
    xs = (to_chunks(q, GLA_DK), to_chunks(k, GLA_DK), to_chunks(v, GLA_DV), to_chunks(log_alpha, GLA_DK))
    state0 = jnp.zeros((B, GLA_HEADS, GLA_DK, GLA_DV), jnp.float32)
    _, o = lax.scan(_gla_chunk_step, state0, xs)
    o = o.transpose(1, 0, 3, 2, 4).reshape(B, L, GLA_HEADS, GLA_DV)
    o = o * lax.rsqrt(jnp.mean(o * o, axis=-1, keepdims=True) + NORM_EPS) * _f32(norm_g)
    return (o.reshape(B, L, GLA_VAL_WIDTH) * jax.nn.silu(og)).astype(dt)


def _moe(h, w_router, b_router, w_gate, b_gate, w_up, b_up, w_down, b_down):
    B, L, D = h.shape
    T = B * L
    M = T * TOP_K
    P = -(-M // EXPERT_BLOCK) * EXPERT_BLOCK + N_EXPERTS * EXPERT_BLOCK
    NB = P // EXPERT_BLOCK
    xt = h.reshape(T, D)
    logits = _f32(xt @ w_router + b_router)
    top_vals, top_idx = lax.top_k(logits, TOP_K)
    top_w = jax.nn.softmax(top_vals, axis=-1)
    expert_flat = top_idx.reshape(-1).astype(jnp.int32)
    token_flat = jnp.repeat(jnp.arange(T, dtype=jnp.int32), TOP_K)
    w_flat = top_w.reshape(-1)
    order = jnp.argsort(expert_flat, stable=True)
    sorted_e = expert_flat[order]
    counts = jnp.bincount(expert_flat, length=N_EXPERTS).astype(jnp.int32)
    padded = ((counts + EXPERT_BLOCK - 1) // EXPERT_BLOCK) * EXPERT_BLOCK
    offsets = jnp.cumsum(counts) - counts
    padded_end = jnp.cumsum(padded)
    padded_start = padded_end - padded
    rank = jnp.arange(M, dtype=jnp.int32) - offsets[sorted_e]
    dest = padded_start[sorted_e] + rank
    row_token = jnp.full((P,), T, jnp.int32).at[dest].set(token_flat[order])
    row_w = jnp.zeros((P,), jnp.float32).at[dest].set(w_flat[order])
    block_expert = jnp.minimum(
        jnp.searchsorted(padded_end, jnp.arange(NB, dtype=jnp.int32) * EXPERT_BLOCK, side='right'),
        N_EXPERTS - 1).astype(jnp.int32)
    x_pad = jnp.concatenate([xt, jnp.zeros((1, D), xt.dtype)], axis=0)
    xs = x_pad[row_token].reshape(NB, EXPERT_BLOCK, D)

    def expert_rows(args):
        xb, e = args
        gate = xb @ w_gate[e] + b_gate[e]
        up = xb @ w_up[e] + b_up[e]
        gate = jnp.minimum(gate, SWIGLU_LIMIT)
        up = jnp.clip(up, -SWIGLU_LIMIT, SWIGLU_LIMIT)
        glu = gate * jax.nn.sigmoid(gate * SWIGLU_ALPHA)
        return ((up + 1.0) * glu) @ w_down[e] + b_down[e]

    out = lax.map(expert_rows, (xs, block_expert)).reshape(P, D)
    y = jnp.zeros((T + 1, D), h.dtype).at[row_token].add(out * row_w[:, None].astype(h.dtype))[:T]
    return y.reshape(B, L, D)


def setup_inputs(seed: int = 0) -> dict:
    key = jax.random.key(seed)
    ks = iter(jax.random.split(key, 40))
    nrm = lambda shape, scale: jax.random.normal(next(ks), shape, jnp.float32) * scale
    Ly = DEPTH
    return {
        "x": nrm((BATCH, SEQ, D_MODEL), 1.0),
        "norm_mix_g": 1.0 + nrm((Ly, D_MODEL), 0.02),
        "w_in": nrm((Ly, D_MODEL, IN_COLS), D_MODEL ** -0.5),
        "token_shift_mu": jax.random.uniform(next(ks), (Ly, RWKV_COLS), jnp.float32),
        "rwkv_w0": -1.0 + nrm((Ly, RWKV_WIDTH), 0.5),
        "rwkv_w2": nrm((Ly, DECAY_LORA, RWKV_WIDTH), 0.1 * DECAY_LORA ** -0.5),
        "rwkv_a0": nrm((Ly, RWKV_WIDTH), 0.1),
        "rwkv_a2": nrm((Ly, ICL_LORA, RWKV_WIDTH), 0.1 * ICL_LORA ** -0.5),
        "rwkv_g2": nrm((Ly, GATE_LORA, RWKV_WIDTH), GATE_LORA ** -0.5),
        "rwkv_k_k": 0.85 + nrm((Ly, RWKV_WIDTH), 0.05),
        "rwkv_k_a": 1.0 + nrm((Ly, RWKV_WIDTH), 0.05),
        "rwkv_r_k": nrm((Ly, RWKV_HEADS, RWKV_HEAD), 0.1),
        "rwkv_lnx_g": 1.0 + nrm((Ly, RWKV_WIDTH), 0.02),
        "rwkv_lnx_b": nrm((Ly, RWKV_WIDTH), 0.01),
        "gla_w_alpha2": nrm((Ly, GLA_GATE_LORA, GLA_KEY_WIDTH), GLA_GATE_LORA ** -0.5),
        "gla_b_alpha": nrm((Ly, GLA_KEY_WIDTH), 0.1),
        "gla_norm_g": 1.0 + nrm((Ly, GLA_DV), 0.02),
        "b_merge": nrm((Ly, N_BRANCHES * D_MODEL), 0.01),
        "w_branch_rwkv": nrm((Ly, RWKV_WIDTH, D_MODEL), RWKV_WIDTH ** -0.5),
        "w_branch_gla": nrm((Ly, GLA_VAL_WIDTH, D_MODEL), GLA_VAL_WIDTH ** -0.5),
        "w_out": nrm((Ly, D_MODEL, D_MODEL), D_MODEL ** -0.5),
        "norm_ffn_g": 1.0 + nrm((Ly, D_MODEL), 0.02),
        "w_router": nrm((Ly, D_MODEL, N_EXPERTS), D_MODEL ** -0.5),
        "b_router": nrm((Ly, N_EXPERTS), 0.01),
        "w_gate": nrm((Ly, N_EXPERTS, D_MODEL, D_FF), D_MODEL ** -0.5),
        "b_gate": nrm((Ly, N_EXPERTS, D_FF), 0.01),
        "w_up": nrm((Ly, N_EXPERTS, D_MODEL, D_FF), D_MODEL ** -0.5),
        "b_up": nrm((Ly, N_EXPERTS, D_FF), 0.01),
        "w_down": nrm((Ly, N_EXPERTS, D_FF, D_MODEL), D_FF ** -0.5),
        "b_down": nrm((Ly, N_EXPERTS, D_MODEL), 0.01),
        "norm_final_g": 1.0 + nrm((D_MODEL,), 0.02),
    }


def reference(x, norm_mix_g, w_in, token_shift_mu, rwkv_w0, rwkv_w2, rwkv_a0, rwkv_a2, rwkv_g2,
              rwkv_k_k, rwkv_k_a, rwkv_r_k, rwkv_lnx_g, rwkv_lnx_b, gla_w_alpha2, gla_b_alpha,
              gla_norm_g, b_merge, w_branch_rwkv, w_branch_gla, w_out, norm_ffn_g, w_router,
              b_router, w_gate, b_gate, w_up, b_up, w_down, b_down, norm_final_g):
    for l in range(DEPTH):
        h = _rms_norm(x, norm_mix_g[l])
        p = h @ w_in[l]
        p_rwkv, p_gla, p_gate = _split(p, (RWKV_COLS, GLA_COLS, N_BRANCHES * D_MODEL))
        y_a = _rwkv7_branch(p_rwkv, token_shift_mu[l], rwkv_w0[l], rwkv_w2[l], rwkv_a0[l],
                            rwkv_a2[l], rwkv_g2[l], rwkv_k_k[l], rwkv_k_a[l], rwkv_r_k[l],
                            rwkv_lnx_g[l], rwkv_lnx_b[l])
        y_b = _gla_branch(p_gla, gla_w_alpha2[l], gla_b_alpha[l], gla_norm_g[l])
        gates = jax.nn.sigmoid(p_gate + b_merge[l])
        g_a, g_b = gates[..., :D_MODEL], gates[..., D_MODEL:]
        merged = g_a * (y_a @ w_branch_rwkv[l]) + g_b * (y_b @ w_branch_gla[l])
        x = x + merged @ w_out[l]
        x = x + _moe(_rms_norm(x, norm_ffn_g[l]), w_router[l], b_router[l], w_gate[l], b_gate[l],
                     w_up[l], b_up[l], w_down[l], b_down[l])
    return _rms_norm(x, norm_final_g)
```

```cpp
#include <hip/hip_runtime.h>
#include <cstdio>
#include <cstdint>

#ifndef MK_PER_PHASE
#define MK_PER_PHASE 0
#endif

#ifndef PROBE_GEMM
#define PROBE_GEMM -1
#endif
#ifndef PROBE_DUP
#define PROBE_DUP 0
#endif
#define GAS __attribute__((address_space(1)))
#define LAS __attribute__((address_space(3)))
typedef unsigned short bf16;
typedef unsigned v4u __attribute__((ext_vector_type(4)));
typedef unsigned v2u __attribute__((ext_vector_type(2)));
typedef float f32x4 __attribute__((ext_vector_type(4)));
typedef float f32x2 __attribute__((ext_vector_type(2)));
typedef short bf16x8 __attribute__((ext_vector_type(8)));
typedef long i64x2 __attribute__((ext_vector_type(2)));
typedef int v4i __attribute__((ext_vector_type(4)));
typedef int v8i __attribute__((ext_vector_type(8)));
#define RLX_AGENT __ATOMIC_RELAXED, __HIP_MEMORY_SCOPE_AGENT
#define LDS_WAIT() asm volatile("s_waitcnt lgkmcnt(0)" ::: "memory")
#define VM_WAIT() asm volatile("s_waitcnt vmcnt(0)" ::: "memory")

constexpr int D = 2048, BATCH = 4, SEQ = 2048, T = BATCH * SEQ;
constexpr int RW = 1024, RH = 16, RN = 64;
constexpr int DLORA = 96, GLORA = 256;
constexpr int RWKV_COLS = 3 * RW + 2 * DLORA + GLORA;
constexpr int GH = 4, GDK = 128, GDV = 256, GKW = GH * GDK, GVW = GH * GDV, GAL = 16;
constexpr int GLA_COLS = 2 * GKW + 2 * GVW + GAL;
constexpr int IN_COLS = RWKV_COLS + GLA_COLS + 2 * D;
constexpr int PLD = 10752;
constexpr int DP = D + 64;
constexpr int C_R = 0, C_K = 1024, C_V = 2048, C_WL = 3072, C_AL = 3168, C_GL = 3264;
constexpr int C_GQ = 3520, C_GK = 4032, C_GV = 4544, C_OG = 5568, C_GAL = 6592, C_GATE = 6608;
constexpr int NE = 32, TOPK = 4, FF = 2048;
constexpr int XS_ROWS = T * TOPK + NE * 256;
constexpr int CHUNK = 64, NCH = SEQ / CHUNK;
constexpr float NORM_EPS = 1e-5f, GN_EPS = 64e-5f;
constexpr float WQ_SCALE = 64.f, WQ_INV = 1.f / 64.f;

constexpr size_t MiB = 1u << 20;
constexpr size_t WS_CTL = 0, CTL_ZERO_BYTES = 1 * MiB;
constexpr size_t WS_WR = 1 * MiB;
constexpr size_t WS_WLWA = 2 * MiB;
constexpr size_t WS_WLG = 3 * MiB;
constexpr size_t WS_WBA = 4 * MiB, WS_WBB = 8 * MiB;
constexpr size_t WS_WOUT = 12 * MiB;
constexpr size_t WS_WIN = 64 * MiB;
constexpr size_t WS_WGU = 192 * MiB;
constexpr size_t WS_WD = 448 * MiB;
constexpr size_t WS_H = 128 * MiB;
constexpr size_t WS_P = 864 * MiB;
constexpr size_t WS_Y = WS_P;
constexpr size_t WS_A2 = 1032 * MiB;
constexpr size_t WS_WAO = 1040 * MiB;
constexpr size_t WS_GO = 1072 * MiB;
constexpr size_t WS_SCAN = 1088 * MiB;
constexpr size_t WS_BON = 1200 * MiB;
constexpr size_t WS_YRAW = 1280 * MiB;
constexpr size_t WS_GHT = 1312 * MiB;
constexpr size_t WS_GST = 1376 * MiB;
constexpr size_t WS_GDEC = 1408 * MiB;
constexpr size_t WS_GBC = 576 * MiB;
constexpr size_t WS_YA = 1410 * MiB, WS_YB = 1426 * MiB;
constexpr size_t WS_MRG = 1442 * MiB;
constexpr size_t WS_X1 = 1474 * MiB;
constexpr size_t WS_H2 = 832 * MiB;
constexpr size_t WS_ROUTE = 1570 * MiB;
constexpr size_t WS_XS = 1572 * MiB;
constexpr size_t WS_HH = 1732 * MiB;
constexpr size_t WS_END = 1892 * MiB;
constexpr int CW_BAR = 4096;
constexpr int CW_CNT = 16384;
constexpr int CW_CVQ = 20480, CW_CVSTOP = 20544;

constexpr int RING_BYTES = 131072;
constexpr int LDSCTL_OFF = 159744, MISC_OFF = LDSCTL_OFF + 320;
constexpr int MOE_OFF = LDSCTL_OFF + 1024;
constexpr int LDS_BYTES = 163840;

__device__ __forceinline__ unsigned f2bf(float f) { unsigned u = __builtin_bit_cast(unsigned, f); return (u + 0x7fffu + ((u >> 16) & 1u)) >> 16; }
__device__ __forceinline__ unsigned pk2(float lo, float hi) { return f2bf(lo) | (f2bf(hi) << 16); }
__device__ __forceinline__ unsigned pk4_fp8(float a, float b, float c, float d) { int w = 0; w = __builtin_amdgcn_cvt_pk_fp8_f32(a, b, w, false); w = __builtin_amdgcn_cvt_pk_fp8_f32(c, d, w, true); return (unsigned)w; }
__device__ __forceinline__ float bflo(unsigned u) { return __builtin_bit_cast(float, u << 16); }
__device__ __forceinline__ float bfhi(unsigned u) { return __builtin_bit_cast(float, u & 0xffff0000u); }
__device__ __forceinline__ float bf2f(bf16 b) { return __builtin_bit_cast(float, ((unsigned)b) << 16); }
__device__ __forceinline__ float wave_sum(float v) {
#pragma unroll
    for (int o = 1; o < 64; o <<= 1) v += __shfl_xor(v, o);
    return v;
}
__device__ __forceinline__ float sigmoidf_(float x) { return 1.f / (1.f + __expf(-x)); }
__device__ __forceinline__ float softplusf_(float x) { return fmaxf(x, 0.f) + log1pf(__expf(-fabsf(x))); }

namespace pg8 {
constexpr int BM = 256, BK = 64, HALF = 128, HTB = HALF * BK * 2, STAGE_BYTES = 8 * HTB, NXCD = 8, WGM = 8;
__host__ __device__ __forceinline__ int lds_byte(int r, int c) { return r * 128 + (((c >> 3) ^ ((r >> 1) & 7)) << 4) + (c & 7) * 2; }
__host__ __device__ __forceinline__ void stage_rc(int b, int& R, int& C) { R = b >> 7; C = ((((b & 127) >> 4) ^ ((R >> 1) & 7)) << 3); }
__host__ __device__ __forceinline__ int perm32(int rho) { const int n = rho >> 4, i = rho & 15; return 8 * (i >> 2) + 4 * n + (i & 3); }

struct Unit { int rowA, rowB, pn, e, rk0, cnt; };
struct Gemm { const bf16* A; const bf16* Bt; int lda, ldb, K; const int* list; };

struct StaticOrder {
    int nM, nN, nwg, G, c;
    __device__ void init(int M, int N, int G_, int c_) { nM = M / BM; nN = N / BM; nwg = nM * nN; G = G_; c = c_; }
    __device__ bool next(int i, Unit& u) const {
        const long L = (long)i * G + c; if (L >= nwg) return false;
        int wgid = (int)L; { const int q = nwg / NXCD, r = nwg % NXCD, xcd = wgid % NXCD, off = wgid / NXCD; wgid = (xcd < r ? xcd * (q + 1) : r * (q + 1) + (xcd - r) * q) + off; }
        const int nig = WGM * nN, gid = wgid / nig, fm = gid * WGM, gsz = (nM - fm) < WGM ? (nM - fm) : WGM;
        const int pm = fm + ((wgid % nig) % gsz); u.pn = (wgid % nig) / gsz; u.rowA = pm * BM; u.rowB = u.pn * BM; u.e = 0; u.rk0 = 0; u.cnt = 0; return true;
    }
};
struct ProbeOrder {
    StaticOrder so; int mode;
    __device__ bool next(int i, Unit& u) const { if (!so.next(i, u)) return false; u.e = (u.rowA >> 8) * 64 + u.pn; if (mode & 1) u.rowA = 0; if (mode & 2) u.rowB = 0; return true; }
};
struct MoeOrder {
    const volatile LAS int* tab; int nct, rowsB, G, c;
    __device__ bool next(int i, Unit& u) const {
        const int L = i * G + c; const int total = __builtin_amdgcn_readfirstlane(tab[32]); if (L >= total) return false;
        int e = 0;
        for (; e < 31; ++e) { if (L < __builtin_amdgcn_readfirstlane(tab[e + 1])) break; }
        const int local = L - __builtin_amdgcn_readfirstlane(tab[e]); const int nt = __builtin_amdgcn_readfirstlane(tab[72 + e]);
        const int ct = local / nt, rt = local - ct * nt;
        u.rowA = __builtin_amdgcn_readfirstlane(tab[36 + e]) + rt * BM; u.rowB = e * rowsB + ct * BM; u.pn = ct; u.e = e; u.rk0 = rt * BM; u.cnt = __builtin_amdgcn_readfirstlane(tab[108 + e]); return true;
    }
};

__device__ __forceinline__ unsigned cvt_pk_bf16(float lo, float hi) { unsigned r; asm volatile("v_cvt_pk_bf16_f32 %0, %1, %2" : "=v"(r) : "v"(lo), "v"(hi)); return r; }

struct EpiBf16 {
    static constexpr bool PERM = true;
    bf16* O; int ldc; const float* bias; int bias_estride; float scale;
    __device__ __forceinline__ void operator()(const f32x4 (&acc)[2][2][4][2], const Unit& u, int wr, int wc, int fr, int fq) const {
        const int row0 = u.rowA + wr * 64 + fr, col0 = u.pn * BM + wc * 32 + 8 * fq;
        f32x4 bv[2][2];
#pragma unroll
        for (int bj = 0; bj < 2; ++bj)
#pragma unroll
            for (int n = 0; n < 2; ++n) bv[bj][n] = bias ? *(const f32x4*)(bias + (size_t)u.e * bias_estride + col0 + bj * HALF + 4 * n) : (f32x4){0.f, 0.f, 0.f, 0.f};
#pragma unroll
        for (int ai = 0; ai < 2; ++ai)
#pragma unroll
            for (int m = 0; m < 4; ++m) { bf16* rowp = O + (size_t)(row0 + ai * HALF + m * 16) * ldc + col0;
#pragma unroll
                for (int bj = 0; bj < 2; ++bj) { const f32x4 v0 = acc[ai][bj][m][0] * scale + bv[bj][0], v1 = acc[ai][bj][m][1] * scale + bv[bj][1];
                    v4u w; w.x = cvt_pk_bf16(v0[0], v0[1]); w.y = cvt_pk_bf16(v0[2], v0[3]); w.z = cvt_pk_bf16(v1[0], v1[1]); w.w = cvt_pk_bf16(v1[2], v1[3]);
                    *(v4u*)(rowp + bj * HALF) = w; } }
    }
};
struct EpiProbe {
    static constexpr bool PERM = true;
    bf16* O;
    __device__ __forceinline__ void operator()(const f32x4 (&acc)[2][2][4][2], const Unit& u, int wr, int wc, int fr, int fq) const {
        const int pm = u.e >> 6, pn = u.e & 63; const int row0 = pm * BM + wr * 64 + fr, col0 = pn * BM + wc * 32 + 8 * fq;
#pragma unroll
        for (int ai = 0; ai < 2; ++ai)
#pragma unroll
            for (int m = 0; m < 4; ++m) { bf16* rowp = O + (size_t)(row0 + ai * HALF + m * 16) * PLD + col0;
#pragma unroll
                for (int bj = 0; bj < 2; ++bj) { const f32x4 v0 = acc[ai][bj][m][0], v1 = acc[ai][bj][m][1];
                    v4u w; w.x = cvt_pk_bf16(v0[0], v0[1]); w.y = cvt_pk_bf16(v0[2], v0[3]); w.z = cvt_pk_bf16(v1[0], v1[1]); w.w = cvt_pk_bf16(v1[2], v1[3]);
                    *(v4u*)(rowp + bj * HALF) = w; } }
    }
};
template <bool ADD> struct EpiGate {
    static constexpr bool PERM = true;
    bf16* O; const bf16* P; const float* bm; int gcol;
    __device__ __forceinline__ void operator()(const f32x4 (&acc)[2][2][4][2], const Unit& u, int wr, int wc, int fr, int fq) const {
        const int row0 = u.rowA + wr * 64 + fr, col0 = u.pn * BM + wc * 32 + 8 * fq;
        f32x4 bv[2][2];
#pragma unroll
        for (int bj = 0; bj < 2; ++bj)
#pragma unroll
            for (int n = 0; n < 2; ++n) bv[bj][n] = *(const f32x4*)(bm + col0 + bj * HALF + 4 * n);
#pragma unroll
        for (int ai = 0; ai < 2; ++ai)
#pragma unroll
            for (int m = 0; m < 4; ++m) { const size_t row = (size_t)(row0 + ai * HALF + m * 16);
#pragma unroll
                for (int bj = 0; bj < 2; ++bj) {
                    const v4u pg = *(const v4u*)(P + row * PLD + gcol + col0 + bj * HALF);
                    bf16* op = O + row * D + col0 + bj * HALF;
                    float g[8] = {bflo(pg.x), bfhi(pg.x), bflo(pg.y), bfhi(pg.y), bflo(pg.z), bfhi(pg.z), bflo(pg.w), bfhi(pg.w)};
                    float r[8];
#pragma unroll
                    for (int j = 0; j < 4; ++j) { r[j] = sigmoidf_(g[j] + bv[bj][0][j]) * acc[ai][bj][m][0][j]; r[4 + j] = sigmoidf_(g[4 + j] + bv[bj][1][j]) * acc[ai][bj][m][1][j]; }
                    if (ADD) { const v4u pv = *(const v4u*)op;
                        r[0] += bflo(pv.x); r[1] += bfhi(pv.x); r[2] += bflo(pv.y); r[3] += bfhi(pv.y); r[4] += bflo(pv.z); r[5] += bfhi(pv.z); r[6] += bflo(pv.w); r[7] += bfhi(pv.w); }
                    v4u w; w.x = cvt_pk_bf16(r[0], r[1]); w.y = cvt_pk_bf16(r[2], r[3]); w.z = cvt_pk_bf16(r[4], r[5]); w.w = cvt_pk_bf16(r[6], r[7]);
                    *(v4u*)op = w; } }
    }
};
struct EpiResF32 {
    static constexpr bool PERM = false;
    float* O; const float* X;
    __device__ __forceinline__ void operator()(const f32x4 (&acc)[2][2][4][2], const Unit& u, int wr, int wc, int fr, int fq) const {
        const int row0 = u.rowA + wr * 64 + fr, col0 = u.pn * BM + wc * 32 + 4 * fq;
#pragma unroll
        for (int ai = 0; ai < 2; ++ai)
#pragma unroll
            for (int m = 0; m < 4; ++m) { const size_t ro = (size_t)(row0 + ai * HALF + m * 16) * D + col0;
#pragma unroll
                for (int bj = 0; bj < 2; ++bj)
#pragma unroll
                    for (int n = 0; n < 2; ++n) *(f32x4*)(O + ro + bj * HALF + n * 16) = acc[ai][bj][m][n] + __builtin_nontemporal_load((const f32x4*)(X + ro + bj * HALF + n * 16)); }
    }
};
struct EpiGlu {
    static constexpr bool PERM = true;
    bf16* O; const float* bg; const float* bu;
    __device__ __forceinline__ void operator()(const f32x4 (&acc)[2][2][4][2], const Unit& u, int wr, int wc, int fr, int fq) const {
        const int row0 = u.rowA + wr * 64 + fr, col0 = u.pn * HALF + wc * 32 + 8 * fq;
        f32x4 gb[2], ub[2];
#pragma unroll
        for (int n = 0; n < 2; ++n) { gb[n] = *(const f32x4*)(bg + (size_t)u.e * FF + col0 + 4 * n); ub[n] = *(const f32x4*)(bu + (size_t)u.e * FF + col0 + 4 * n); }
#pragma unroll
        for (int ai = 0; ai < 2; ++ai)
#pragma unroll
            for (int m = 0; m < 4; ++m) { bf16* op = O + (size_t)(row0 + ai * HALF + m * 16) * FF + col0;
                float r[8];
#pragma unroll
                for (int n = 0; n < 2; ++n)
#pragma unroll
                    for (int j = 0; j < 4; ++j) { float g = fminf(acc[ai][0][m][n][j] + gb[n][j], 7.f); float up = fminf(fmaxf(acc[ai][1][m][n][j] + ub[n][j], -7.f), 7.f);
                        r[4 * n + j] = (up + 1.f) * g * sigmoidf_(1.702f * g); }
                v4u w; w.x = cvt_pk_bf16(r[0], r[1]); w.y = cvt_pk_bf16(r[2], r[3]); w.z = cvt_pk_bf16(r[4], r[5]); w.w = cvt_pk_bf16(r[6], r[7]);
                *(v4u*)op = w; }
    }
};

struct EpiGluQ {
    static constexpr bool PERM = true;
    unsigned char* O; const float* bg; const float* bu;
    __device__ __forceinline__ void operator()(const f32x4 (&acc)[2][2][4][2], const Unit& u, int wr, int wc, int fr, int fq) const {
        const int row0 = u.rowA + wr * 64 + fr, col0 = u.pn * HALF + wc * 32 + 8 * fq;
        f32x4 gb[2], ub[2];
#pragma unroll
        for (int n = 0; n < 2; ++n) { gb[n] = *(const f32x4*)(bg + (size_t)u.e * FF + col0 + 4 * n); ub[n] = *(const f32x4*)(bu + (size_t)u.e * FF + col0 + 4 * n); }
#pragma unroll
        for (int ai = 0; ai < 2; ++ai)
#pragma unroll
            for (int m = 0; m < 4; ++m) { unsigned char* op = O + (size_t)(row0 + ai * HALF + m * 16) * FF + col0;
                float r[8];
#pragma unroll
                for (int n = 0; n < 2; ++n)
#pragma unroll
                    for (int j = 0; j < 4; ++j) { float g = fminf(acc[ai][0][m][n][j] * WQ_INV + gb[n][j], 7.f); float up = fminf(fmaxf(acc[ai][1][m][n][j] * WQ_INV + ub[n][j], -7.f), 7.f);
                        r[4 * n + j] = (up + 1.f) * g * sigmoidf_(1.702f * g); }
                v2u w; w.x = pk4_fp8(r[0], r[1], r[2], r[3]); w.y = pk4_fp8(r[4], r[5], r[6], r[7]);
                *(v2u*)op = w; }
    }
};

template <class Epi, class Sched, int ESZ = 2, bool GATHER = false, bool ALIGN_EPI = true>
__device__ __forceinline__ void gemm_phase(LAS unsigned char* lds, const Gemm g, const Sched& S, const Epi& E) {
    const int tid = threadIdx.x, wid = __builtin_amdgcn_readfirstlane(tid >> 6), lane = tid & 63, wr = wid >> 2, wc = wid & 3, fr = lane & 15, fq = lane >> 4;
    const int K = g.K, nt = K * ESZ / (BK * 2);
    unsigned voffA[2], voffB[2]; int Rst[2], Cst[2];
#pragma unroll
    for (int i = 0; i < 2; ++i) { int R, C; stage_rc(tid * 16 + i * 8192, R, C); const int Rb = Epi::PERM ? ((R & ~31) + perm32(R & 31)) : R; Rst[i] = R; Cst[i] = C * 2;
        voffA[i] = (unsigned)(R * g.lda * ESZ + C * 2); voffB[i] = (unsigned)(Rb * g.ldb * ESZ + C * 2); }
    const size_t kstep = (size_t)(BK * 2);
    const size_t hstepA = (size_t)HALF * g.lda * ESZ, hstepB = (size_t)HALF * g.ldb * ESZ;
    const unsigned ldsw = (unsigned)wid * 1024u;
    const int aoff = lds_byte(wr * 64 + fr, fq * 8), boff = lds_byte(wc * 32 + fr, fq * 8);
#define PG8_SA(b, h) (((b) * 2 + (h)) * HTB)
#define PG8_SB(b, h) ((4 + (b) * 2 + (h)) * HTB)
#define PG8_STAGE(bufoff, gbase, voff) do { _Pragma("unroll") for (int _i = 0; _i < 2; ++_i) \
        __builtin_amdgcn_global_load_lds((const unsigned*)((const char*)(gbase) + (voff)[_i]), (LAS unsigned*)(lds + (bufoff) + ldsw + _i * 8192), 16, 0, 0); } while (0)
#define PG8_GOFF(u_, v_) do { _Pragma("unroll") for (int h_ = 0; h_ < 2; ++h_) _Pragma("unroll") for (int i_ = 0; i_ < 2; ++i_) { const int rk_ = (u_).rk0 + 128 * h_ + Rst[i_]; \
        const int tok_ = rk_ < (u_).cnt ? g.list[(u_).e * 8192 + rk_] : 0; (v_)[h_][i_] = (unsigned)tok_ * (unsigned)(g.lda * ESZ) + (unsigned)Cst[i_]; } } while (0)
#define PG8_STAGE_A(bufoff, isnext, tt, h) do { if constexpr (GATHER) { unsigned vo_[2] = {(isnext) ? vN[h][0] : vA[h][0], (isnext) ? vN[h][1] : vA[h][1]}; PG8_STAGE(bufoff, (const char*)g.A + (size_t)(tt) * kstep, vo_); } \
        else PG8_STAGE(bufoff, ((isnext) ? nA : cA) + (size_t)(tt) * kstep + (size_t)(h) * hstepA, voffA); } while (0)
#define PG8_LD16(off_) (*(const LAS v4i*)(lds + (off_)))
#define PG8_LDA(dst, b, h) do { if constexpr (ESZ == 2) { _Pragma("unroll") for (int m = 0; m < 4; ++m) _Pragma("unroll") for (int k = 0; k < 2; ++k) dst[m][k] = *(const LAS bf16x8*)(lds + PG8_SA(b, h) + (k ? (aoff ^ 64) : aoff) + m * 2048); } \
        else { _Pragma("unroll") for (int m = 0; m < 4; ++m) dst##8[m] = __builtin_shufflevector(PG8_LD16(PG8_SA(b, h) + aoff + m * 2048), PG8_LD16(PG8_SA(b, h) + (aoff ^ 64) + m * 2048), 0, 1, 2, 3, 4, 5, 6, 7); } } while (0)
#define PG8_LDB(dst, b, h) do { if constexpr (ESZ == 2) { _Pragma("unroll") for (int n = 0; n < 2; ++n) _Pragma("unroll") for (int k = 0; k < 2; ++k) dst[n][k] = *(const LAS bf16x8*)(lds + PG8_SB(b, h) + (k ? (boff ^ 64) : boff) + n * 2048); } \
        else { _Pragma("unroll") for (int n = 0; n < 2; ++n) dst##8[n] = __builtin_shufflevector(PG8_LD16(PG8_SB(b, h) + boff + n * 2048), PG8_LD16(PG8_SB(b, h) + (boff ^ 64) + n * 2048), 0, 1, 2, 3, 4, 5, 6, 7); } } while (0)
#define PG8_MMA(ai, bj, At, Bt) do { __builtin_amdgcn_s_setprio(1); _Pragma("unroll") for (int m = 0; m < 4; ++m) _Pragma("unroll") for (int n = 0; n < 2; ++n) { \
        if constexpr (ESZ == 2) { _Pragma("unroll") for (int k = 0; k < 2; ++k) acc[ai][bj][m][n] = __builtin_amdgcn_mfma_f32_16x16x32_bf16(Bt[n][k], At[m][k], acc[ai][bj][m][n], 0, 0, 0); } \
        else asm volatile("s_nop 1\n\tv_mfma_scale_f32_16x16x128_f8f6f4 %0, %1, %2, %0, %3, %3 op_sel_hi:[0,0,0]" : "+v"(acc[ai][bj][m][n]) : "v"(Bt##8[n]), "v"(At##8[m]), "v"(one_scale)); } \
        __builtin_amdgcn_s_setprio(0); } while (0)
#define PG8_WAIT_V(n) asm volatile("s_waitcnt vmcnt(" #n ")" ::: "memory")
#define PG8_WAIT_L(n) asm volatile("s_waitcnt lgkmcnt(" #n ")" ::: "memory")
#define PG8_BAR __builtin_amdgcn_s_barrier()
#define PG8_SCHED __builtin_amdgcn_sched_barrier(0)
    Unit cur, nxt; int ui = 0;
    if (!S.next(0, cur)) return;
    f32x4 acc[2][2][4][2];
#pragma unroll
    for (int a = 0; a < 2; ++a)
#pragma unroll
        for (int b = 0; b < 2; ++b)
#pragma unroll
            for (int m = 0; m < 4; ++m)
#pragma unroll
                for (int n = 0; n < 2; ++n) acc[a][b][m][n] = (f32x4){0.f, 0.f, 0.f, 0.f};
    const int one_scale = 0x7F7F7F7F;
    bf16x8 At[4][2], B0[2][2], B1[2][2]; v8i At8[4], B08[2], B18[2];
    const char* cA = (const char*)g.A + (size_t)cur.rowA * g.lda * ESZ; const char* cB = (const char*)g.Bt + (size_t)cur.rowB * g.ldb * ESZ;
    unsigned vA[2][2] = {{0u, 0u}, {0u, 0u}}, vN[2][2] = {{0u, 0u}, {0u, 0u}}; const char* nA = cA;
    if constexpr (GATHER) PG8_GOFF(cur, vA);
    PG8_STAGE(PG8_SB(0, 0), cB, voffB); PG8_STAGE(PG8_SB(0, 1), cB + hstepB, voffB); PG8_STAGE_A(PG8_SA(0, 0), false, 0, 0); PG8_STAGE_A(PG8_SA(0, 1), false, 0, 1);
    if (wr == 1) PG8_BAR;
    PG8_WAIT_V(2); PG8_BAR;
    PG8_STAGE(PG8_SB(1, 0), cB + kstep, voffB); PG8_STAGE_A(PG8_SA(1, 0), false, 1, 0); PG8_STAGE(PG8_SB(1, 1), cB + hstepB + kstep, voffB);
    PG8_WAIT_V(6); PG8_BAR;
    for (;;) {
        const bool has_next = S.next(ui + 1, nxt);
        nA = has_next ? (const char*)g.A + (size_t)nxt.rowA * g.lda * ESZ : cA; const char* nB = has_next ? (const char*)g.Bt + (size_t)nxt.rowB * g.ldb * ESZ : cB;
        if constexpr (GATHER) { if (has_next) PG8_GOFF(nxt, vN); else { vN[0][0] = vA[0][0]; vN[0][1] = vA[0][1]; vN[1][0] = vA[1][0]; vN[1][1] = vA[1][1]; } }
        for (int t = 0; t < nt; t += 2) {
            const bool last = (t == nt - 2);
            const char* b2 = last ? nB : cB + (size_t)(t + 2) * kstep; const char* b3 = b2 + kstep;
            const int t2 = last ? 0 : t + 2, t3 = last ? 1 : t + 3;
            PG8_LDB(B0, 0, 0); PG8_LDB(B1, 0, 1); PG8_SCHED; PG8_LDA(At, 0, 0); PG8_STAGE_A(PG8_SA(1, 1), false, t + 1, 1);
            PG8_WAIT_V(8); PG8_WAIT_L(0); PG8_BAR; PG8_MMA(0, 0, At, B0); PG8_MMA(0, 1, At, B1); PG8_BAR; PG8_SCHED;
            PG8_LDA(At, 0, 1); PG8_STAGE(PG8_SB(0, 0), b2, voffB); PG8_STAGE(PG8_SB(0, 1), b2 + hstepB, voffB); PG8_STAGE_A(PG8_SA(0, 0), last, t2, 0);
            PG8_WAIT_V(8); PG8_WAIT_L(0); PG8_BAR; PG8_MMA(1, 0, At, B0); PG8_MMA(1, 1, At, B1); PG8_BAR; PG8_SCHED;
            PG8_LDB(B0, 1, 0); PG8_LDB(B1, 1, 1); PG8_SCHED; PG8_LDA(At, 1, 0); PG8_STAGE_A(PG8_SA(0, 1), last, t2, 1);
            PG8_WAIT_V(8); PG8_WAIT_L(0); PG8_BAR; PG8_MMA(0, 0, At, B0); PG8_MMA(0, 1, At, B1); PG8_BAR; PG8_SCHED;
            PG8_LDA(At, 1, 1); PG8_STAGE(PG8_SB(1, 0), b3, voffB); PG8_STAGE(PG8_SB(1, 1), b3 + hstepB, voffB); PG8_STAGE_A(PG8_SA(1, 0), last, t3, 0);
            PG8_WAIT_V(8); PG8_WAIT_L(0); PG8_BAR; PG8_MMA(1, 0, At, B0); PG8_MMA(1, 1, At, B1); PG8_BAR; PG8_SCHED;
        }
        if constexpr (ESZ == 1) asm volatile("s_nop 15\n\ts_nop 15" ::: "memory");
        if constexpr (ALIGN_EPI) { if (wr == 0) PG8_BAR; }
        E(acc, cur, wr, wc, fr, fq);
        if (!has_next) break;
#pragma unroll
        for (int a = 0; a < 2; ++a)
#pragma unroll
            for (int b = 0; b < 2; ++b)
#pragma unroll
                for (int m = 0; m < 4; ++m)
#pragma unroll
                    for (int n = 0; n < 2; ++n) acc[a][b][m][n] = (f32x4){0.f, 0.f, 0.f, 0.f};
        cur = nxt; cA = nA; cB = nB; ++ui;
        if constexpr (GATHER) { vA[0][0] = vN[0][0]; vA[0][1] = vN[0][1]; vA[1][0] = vN[1][0]; vA[1][1] = vN[1][1]; }
        if constexpr (ALIGN_EPI) { if (wr == 1) PG8_BAR; }
    }
    PG8_WAIT_V(0);
    if constexpr (!ALIGN_EPI) { if (wr == 0) PG8_BAR; }
    PG8_BAR;
#undef PG8_SA
#undef PG8_SB
#undef PG8_STAGE
#undef PG8_LDA
#undef PG8_LD16
#undef PG8_GOFF
#undef PG8_STAGE_A
#undef PG8_LDB
#undef PG8_MMA
#undef PG8_WAIT_V
#undef PG8_WAIT_L
#undef PG8_BAR
#undef PG8_SCHED
}

typedef short s16x4 __attribute__((ext_vector_type(4)));
struct UnitF { int rowA, pn, e; const float* b0; const float* b1; };
struct GemmF { const bf16* A; int lda, K, ldbn; };
struct MoeOrderF {
    const volatile LAS int* tab; int nct, G, c; const float* w0; const float* w1; size_t estride; int cstep;
    __device__ bool next(int i, UnitF& u) const {
        const int L = i * G + c; const int total = __builtin_amdgcn_readfirstlane(tab[32]); if (L >= total) return false;
        int e = 0;
        for (; e < 31; ++e) { if (L < __builtin_amdgcn_readfirstlane(tab[e + 1])) break; }
        const int local = L - __builtin_amdgcn_readfirstlane(tab[e]); const int nt = __builtin_amdgcn_readfirstlane(tab[72 + e]);
        const int ct = local / nt, rt = local - ct * nt;
        u.rowA = __builtin_amdgcn_readfirstlane(tab[36 + e]) + rt * BM; u.pn = ct; u.e = e;
        u.b0 = w0 + (size_t)e * estride + (size_t)ct * cstep; u.b1 = w1 + (size_t)e * estride + (size_t)ct * cstep; return true;
    }
};
struct EpiGluNP {
    bf16* O; const float* bg; const float* bu;
    __device__ __forceinline__ void operator()(const f32x4 (&acc)[2][2][4][2], const UnitF& u, int wr, int wc, int fr, int fq) const {
        const int row0 = u.rowA + wr * 64 + fr, col0 = u.pn * HALF + wc * 32 + 4 * fq;
        f32x4 gb[2], ub[2];
#pragma unroll
        for (int n = 0; n < 2; ++n) { gb[n] = *(const f32x4*)(bg + (size_t)u.e * FF + col0 + 16 * n); ub[n] = *(const f32x4*)(bu + (size_t)u.e * FF + col0 + 16 * n); }
#pragma unroll
        for (int ai = 0; ai < 2; ++ai)
#pragma unroll
            for (int m = 0; m < 4; ++m) { bf16* op = O + (size_t)(row0 + ai * HALF + m * 16) * FF + col0;
#pragma unroll
                for (int n = 0; n < 2; ++n) { float r[4];
#pragma unroll
                    for (int j = 0; j < 4; ++j) { const float gg = fminf(acc[ai][0][m][n][j] + gb[n][j], 7.f); const float up = fminf(fmaxf(acc[ai][1][m][n][j] + ub[n][j], -7.f), 7.f);
                        r[j] = (up + 1.f) * gg * sigmoidf_(1.702f * gg); }
                    v2u w; w.x = cvt_pk_bf16(r[0], r[1]); w.y = cvt_pk_bf16(r[2], r[3]); *(v2u*)(op + 16 * n) = w; } }
    }
};
struct EpiBf16NP {
    bf16* O; int ldc; const float* bias; int bias_estride;
    __device__ __forceinline__ void operator()(const f32x4 (&acc)[2][2][4][2], const UnitF& u, int wr, int wc, int fr, int fq) const {
        const int row0 = u.rowA + wr * 64 + fr, col0 = u.pn * BM + wc * 32 + 4 * fq;
        f32x4 bv[2][2];
#pragma unroll
        for (int bj = 0; bj < 2; ++bj)
#pragma unroll
            for (int n = 0; n < 2; ++n) bv[bj][n] = *(const f32x4*)(bias + (size_t)u.e * bias_estride + col0 + bj * HALF + 16 * n);
#pragma unroll
        for (int ai = 0; ai < 2; ++ai)
#pragma unroll
            for (int m = 0; m < 4; ++m) { bf16* rowp = O + (size_t)(row0 + ai * HALF + m * 16) * ldc + col0;
#pragma unroll
                for (int bj = 0; bj < 2; ++bj)
#pragma unroll
                    for (int n = 0; n < 2; ++n) { const f32x4 v = acc[ai][bj][m][n] + bv[bj][n]; v2u w; w.x = cvt_pk_bf16(v[0], v[1]); w.y = cvt_pk_bf16(v[2], v[3]); *(v2u*)(rowp + bj * HALF + 16 * n) = w; } }
    }
};
template <class Epi, class Sched>
__device__ __forceinline__ void gemm_phase_f32b(LAS unsigned char* lds, const GemmF g, const Sched& S, const Epi& E) {
    const int tid = threadIdx.x, wid = __builtin_amdgcn_readfirstlane(tid >> 6), lane = tid & 63, wr = wid >> 2, wc = wid & 3, fr = lane & 15, fq = lane >> 4;
    const int K = g.K, nt = K / BK;
    unsigned voffA[2];
#pragma unroll
    for (int i = 0; i < 2; ++i) { int R, C; stage_rc(tid * 16 + i * 8192, R, C); voffA[i] = (unsigned)(R * g.lda + C) * 2u; }
    const size_t kstep = (size_t)(BK * 2);
    const size_t hstepA = (size_t)HALF * g.lda * 2;
    const unsigned ldsw = (unsigned)wid * 1024u;
    const int aoff = lds_byte(wr * 64 + fr, fq * 8);
    const int ldsb = (int)(uintptr_t)lds;
    const int q4 = (lane & 15) >> 2, p4 = lane & 3;
    const int fsw = q4 | ((fq & 1) << 2);
    int rbase[2];
#pragma unroll
    for (int n = 0; n < 2; ++n) rbase[n] = (8 * fq + q4) * 256 + ((((wc * 2) ^ fsw) ^ n) * 32) + 8 * p4;
    const int hB = wid >> 2, r0 = 2 * (wid & 3) + (lane >> 5), l31 = lane & 31;
    const int wslot = (l31 >> 2) ^ (r0 & 3);
    const int wb0 = hB * HTB + r0 * 256 + wslot * 32 + (lane & 3) * 8, wb1 = hB * HTB + r0 * 256 + (wslot ^ 4) * 32 + (lane & 3) * 8;
    const unsigned laneoffB = (unsigned)(r0 * g.ldbn + 4 * l31) * 4u;
    const size_t rstep8 = (size_t)8 * g.ldbn * 4, tstepB = (size_t)64 * g.ldbn * 4;
#define PG8_SA(b, h) (((b) * 2 + (h)) * HTB)
#define PG8_SB(b, h) ((4 + (b) * 2 + (h)) * HTB)
#define PG8_STAGE(bufoff, gbase, voff) do { _Pragma("unroll") for (int _i = 0; _i < 2; ++_i) { unsigned keep_; \
        asm volatile("s_mov_b32 %0, m0\n\ts_mov_b32 m0, %2\n\ts_nop 0\n\tglobal_load_lds_dwordx4 %1, off\n\ts_mov_b32 m0, %0" : "=&s"(keep_) \
            : "v"((const char*)(gbase) + (voff)[_i]), "s"(__builtin_amdgcn_readfirstlane(ldsb + (bufoff) + (int)ldsw + _i * 8192)) : "memory"); } } while (0)
#define PG8_LDA(dst, b, h) do { _Pragma("unroll") for (int m = 0; m < 4; ++m) _Pragma("unroll") for (int k = 0; k < 2; ++k) dst[m][k] = *(const LAS bf16x8*)(lds + PG8_SA(b, h) + (k ? (aoff ^ 64) : aoff) + m * 2048); } while (0)
#define PG8_LDBT(dst, b, h) do { _Pragma("unroll") for (int n = 0; n < 2; ++n) _Pragma("unroll") for (int k = 0; k < 2; ++k) { \
        const s16x4 lo_ = __builtin_amdgcn_ds_read_tr16_b64_v4i16((LAS s16x4*)(lds + PG8_SB(b, h) + rbase[n] + k * 8192)); \
        const s16x4 hi_ = __builtin_amdgcn_ds_read_tr16_b64_v4i16((LAS s16x4*)(lds + PG8_SB(b, h) + rbase[n] + k * 8192 + 1024)); \
        dst[n][k] = __builtin_shufflevector(lo_, hi_, 0, 1, 2, 3, 4, 5, 6, 7); } } while (0)
#define PG8_BPTR(p0, p1, tt) ((const char*)(hB ? (p1) : (p0)) + (size_t)(tt) * tstepB)
#define PG8_LOADB1(pb, i) dreg[i] = *(const f32x4*)((pb) + (size_t)(i) * rstep8 + laneoffB)
#define PG8_LOADB(p0, p1, tt) do { const char* pb_ = PG8_BPTR(p0, p1, tt); _Pragma("unroll") for (int _i = 0; _i < 8; ++_i) PG8_LOADB1(pb_, _i); } while (0)
#define PG8_WRITEB1(b, i) do { v2u pk_; pk_.x = cvt_pk_bf16(dreg[i].x, dreg[i].y); pk_.y = cvt_pk_bf16(dreg[i].z, dreg[i].w); \
        *(LAS v2u*)(lds + PG8_SB(b, 0) + (((i) & 1) ? wb1 : wb0) + (i) * 2048) = pk_; } while (0)
#define PG8_WRITEB(b) do { _Pragma("unroll") for (int _i = 0; _i < 8; ++_i) PG8_WRITEB1(b, _i); } while (0)
#define PG8_MF(ai, bj, m, At, Bt) do { _Pragma("unroll") for (int n = 0; n < 2; ++n) _Pragma("unroll") for (int k = 0; k < 2; ++k) \
        acc[ai][bj][m][n] = __builtin_amdgcn_mfma_f32_16x16x32_bf16(Bt[n][k], At[m][k], acc[ai][bj][m][n], 0, 0, 0); } while (0)
#define PG8_MMA(ai, bj, At, Bt) do { __builtin_amdgcn_s_setprio(1); _Pragma("unroll") for (int m = 0; m < 4; ++m) PG8_MF(ai, bj, m, At, Bt); __builtin_amdgcn_s_setprio(0); } while (0)
#define PG8_MMA_CVT(ai, bj, At, Bt, b) do { __builtin_amdgcn_s_setprio(1); _Pragma("unroll") for (int m = 0; m < 4; ++m) { PG8_MF(ai, bj, m, At, Bt); PG8_WRITEB1(b, 2 * m); PG8_WRITEB1(b, 2 * m + 1); PG8_SCHED; } __builtin_amdgcn_s_setprio(0); } while (0)
#define PG8_MMA_LD(ai, bj, At, Bt, pb) do { __builtin_amdgcn_s_setprio(1); _Pragma("unroll") for (int m = 0; m < 4; ++m) { PG8_MF(ai, bj, m, At, Bt); PG8_LOADB1(pb, 2 * m); PG8_LOADB1(pb, 2 * m + 1); PG8_SCHED; } __builtin_amdgcn_s_setprio(0); } while (0)
#define PG8_WAIT_V(n) asm volatile("s_waitcnt vmcnt(" #n ")" ::: "memory")
#define PG8_WAIT_L(n) asm volatile("s_waitcnt lgkmcnt(" #n ")" ::: "memory")
#define PG8_BAR __builtin_amdgcn_s_barrier()
#define PG8_SCHED __builtin_amdgcn_sched_barrier(0)
#define PG8_BS0(T) ((T) >= nt ? nb0 : cur.b0)
#define PG8_BS1(T) ((T) >= nt ? nb1 : cur.b1)
#define PG8_BT(T) ((T) >= nt ? (T) - nt : (T))
    UnitF cur, nxt; int ui = 0;
    if (!S.next(0, cur)) return;
    f32x4 acc[2][2][4][2];
#pragma unroll
    for (int a = 0; a < 2; ++a)
#pragma unroll
        for (int b = 0; b < 2; ++b)
#pragma unroll
            for (int m = 0; m < 4; ++m)
#pragma unroll
                for (int n = 0; n < 2; ++n) acc[a][b][m][n] = (f32x4){0.f, 0.f, 0.f, 0.f};
    bf16x8 At[4][2], B0[2][2], B1[2][2];
    f32x4 dreg[8];
    const char* cA = (const char*)g.A + (size_t)cur.rowA * g.lda * 2;
    PG8_STAGE(PG8_SA(0, 0), cA, voffA); PG8_STAGE(PG8_SA(0, 1), cA + hstepA, voffA); PG8_STAGE(PG8_SA(1, 0), cA + kstep, voffA);
    PG8_LOADB(cur.b0, cur.b1, 0); PG8_WRITEB(0); PG8_LOADB(cur.b0, cur.b1, 1); PG8_WRITEB(1); PG8_LOADB(cur.b0, cur.b1, 2);
    PG8_WAIT_V(8); PG8_WAIT_L(0);
    if (wr == 1) PG8_BAR;
    PG8_BAR;
    for (;;) {
        const bool has_next = S.next(ui + 1, nxt);
        const char* nA = has_next ? (const char*)g.A + (size_t)nxt.rowA * g.lda * 2 : cA;
        const float* nb0 = has_next ? nxt.b0 : cur.b0; const float* nb1 = has_next ? nxt.b1 : cur.b1;
        for (int t = 0; t < nt; t += 2) {
            const bool last = (t == nt - 2);
            const char* a1 = cA + (size_t)(t + 1) * kstep;
            const char* a2 = last ? nA : cA + (size_t)(t + 2) * kstep;
            const char* a3 = a2 + kstep;
            const char* pb3 = PG8_BPTR(PG8_BS0(t + 3), PG8_BS1(t + 3), PG8_BT(t + 3));
            const char* pb4 = PG8_BPTR(PG8_BS0(t + 4), PG8_BS1(t + 4), PG8_BT(t + 4));
            PG8_LDBT(B0, 0, 0); PG8_LDBT(B1, 0, 1); PG8_SCHED; PG8_LDA(At, 0, 0); PG8_STAGE(PG8_SA(1, 1), a1 + hstepA, voffA);
            PG8_WAIT_V(12); PG8_WAIT_L(0); PG8_SCHED; PG8_BAR; PG8_MMA(0, 0, At, B0); PG8_MMA(0, 1, At, B1); PG8_BAR; PG8_SCHED;
            PG8_LDA(At, 0, 1);
            PG8_WAIT_V(10); PG8_WAIT_L(0); PG8_SCHED; PG8_BAR; PG8_MMA_CVT(1, 0, At, B0, 0); PG8_STAGE(PG8_SA(0, 0), a2, voffA); PG8_MMA_LD(1, 1, At, B1, pb3); PG8_BAR; PG8_SCHED;
            PG8_LDBT(B0, 1, 0); PG8_LDBT(B1, 1, 1); PG8_SCHED; PG8_LDA(At, 1, 0); PG8_STAGE(PG8_SA(0, 1), a2 + hstepA, voffA);
            PG8_WAIT_V(12); PG8_WAIT_L(0); PG8_SCHED; PG8_BAR; PG8_MMA(0, 0, At, B0); PG8_MMA(0, 1, At, B1); PG8_BAR; PG8_SCHED;
            PG8_LDA(At, 1, 1);
            PG8_WAIT_V(10); PG8_WAIT_L(0); PG8_SCHED; PG8_BAR; PG8_MMA_CVT(1, 0, At, B0, 1); PG8_STAGE(PG8_SA(1, 0), a3, voffA); PG8_MMA_LD(1, 1, At, B1, pb4); PG8_BAR; PG8_SCHED;
        }
        if (wr == 0) PG8_BAR;
        E(acc, cur, wr, wc, fr, fq);
        if (!has_next) break;
#pragma unroll
        for (int a = 0; a < 2; ++a)
#pragma unroll
            for (int b = 0; b < 2; ++b)
#pragma unroll
                for (int m = 0; m < 4; ++m)
#pragma unroll
                    for (int n = 0; n < 2; ++n) acc[a][b][m][n] = (f32x4){0.f, 0.f, 0.f, 0.f};
        cur = nxt; cA = nA; ++ui;
        if (wr == 1) PG8_BAR;
    }
    PG8_WAIT_V(0);
    asm volatile("" :: "v"(dreg[0]), "v"(dreg[7]));
    PG8_BAR;
#undef PG8_SA
#undef PG8_SB
#undef PG8_STAGE
#undef PG8_LDA
#undef PG8_LDBT
#undef PG8_BPTR
#undef PG8_LOADB1
#undef PG8_LOADB
#undef PG8_WRITEB1
#undef PG8_WRITEB
#undef PG8_MF
#undef PG8_MMA
#undef PG8_MMA_CVT
#undef PG8_MMA_LD
#undef PG8_WAIT_V
#undef PG8_WAIT_L
#undef PG8_BAR
#undef PG8_SCHED
#undef PG8_BS0
#undef PG8_BS1
#undef PG8_BT
}
}

#define XB_TMO      128
#define XB_XCNT(j)  (256  + 64 * (j))
#define XB_XSUB(j)  (1280 + 64 * (j))
#define XB_XGEN(j)  (2304 + 64 * (j))
#define XB_TOP      3328
#define XB_TOPGEN   3392
#define XCD_BAR_WORDS 3456
#define XB_SPIN_CAP (1u << 18)
__device__ __forceinline__ unsigned xb_ld(unsigned* p)              { return __hip_atomic_load(p, __ATOMIC_RELAXED, __HIP_MEMORY_SCOPE_AGENT); }
__device__ __forceinline__ unsigned xb_add(unsigned* p, unsigned v) { return __hip_atomic_fetch_add(p, v, __ATOMIC_RELAXED, __HIP_MEMORY_SCOPE_AGENT); }
__device__ __forceinline__ unsigned xb_xcc_id() { return (unsigned)__builtin_amdgcn_s_getreg((3 << 11) | 20) & 0xFu; }
#define XB_SPIN(cond, bar) do { unsigned _sp = 0; while (cond) { __builtin_amdgcn_s_sleep(1); \
    if ((++_sp & 255u) == 0u) { if (xb_ld(&(bar)[XB_TMO])) break; if (_sp > XB_SPIN_CAP) { atomicAdd(&(bar)[XB_TMO], 1u); break; } } } } while (0)
struct XcdBarrier { unsigned* bar; unsigned x; volatile LAS unsigned* st; };
__device__ __forceinline__ XcdBarrier xcd_barrier_post(unsigned* bar, volatile LAS unsigned* st) {
    XcdBarrier b; b.bar = bar; b.x = xb_xcc_id(); b.st = st;
    if (threadIdx.x == 0) (void)xb_add(&bar[XB_XCNT(b.x)], 1u);
    return b;
}
__device__ __forceinline__ void xcd_barrier_complete(unsigned* bar, unsigned x, unsigned& nloc, unsigned& nx) {
    const unsigned G = gridDim.x * gridDim.y * gridDim.z;
    unsigned sum, cnt, mine, sp = 0u;
    for (;;) {
        sum = 0u; cnt = 0u; mine = 0u;
#pragma unroll
        for (unsigned j = 0; j < 16; ++j) { const unsigned c = xb_ld(&bar[XB_XCNT(j)]); sum += c; cnt += (c > 0u) ? 1u : 0u; mine = (j == x) ? c : mine; }
        if (sum == G) break;
        __builtin_amdgcn_s_sleep(1);
        if ((++sp & 255u) == 0u) { if (xb_ld(&bar[XB_TMO])) break; if (sp > XB_SPIN_CAP) { atomicAdd(&bar[XB_TMO], 1u); break; } }
    }
    nloc = mine > 0u ? mine : 1u; nx = cnt > 0u ? cnt : 1u;
}
__device__ __forceinline__ void xcd_barrier(const XcdBarrier& b) {
    asm volatile("s_waitcnt vmcnt(0)" ::: "memory");
    __syncthreads();
    if (threadIdx.x == 0) {
        unsigned* bar = b.bar;
        __builtin_amdgcn_s_waitcnt(0);
        unsigned nloc = b.st[0], nx = b.st[1];
        if (nloc == 0u) { xcd_barrier_complete(bar, b.x, nloc, nx); b.st[0] = nloc; b.st[1] = nx; }
        const unsigned old = xb_add(&bar[XB_XSUB(b.x)], 1u);
        const unsigned gen = old / nloc;
        if (old + 1u == (gen + 1u) * nloc) {
            __builtin_amdgcn_fence(__ATOMIC_RELEASE, "agent");
            asm volatile("s_waitcnt vmcnt(0)" ::: "memory");
            const unsigned og = xb_add(&bar[XB_TOP], 1u);
            const unsigned tg = og / nx;
            if (og + 1u == (tg + 1u) * nx) xb_add(&bar[XB_TOPGEN], 1u);
            else XB_SPIN(xb_ld(&bar[XB_TOPGEN]) == tg, bar);
            __builtin_amdgcn_fence(__ATOMIC_ACQUIRE, "agent");
            xb_add(&bar[XB_XGEN(b.x)], 1u);
            asm volatile("s_waitcnt vmcnt(0)" ::: "memory");
        } else {
            XB_SPIN(xb_ld(&bar[XB_XGEN(b.x)]) == gen, bar);
            __builtin_amdgcn_fence(__ATOMIC_ACQUIRE, "agent");
            asm volatile("s_waitcnt vmcnt(0)" ::: "memory");
        }
    }
    __syncthreads();
}

struct Args { const float* in[31]; float* out; unsigned char* ws; int ph_lo, ph_hi; };
enum { I_X = 0, I_NMG, I_WIN, I_MU, I_W0, I_W2, I_A0, I_A2, I_G2, I_KK, I_KA, I_RK, I_LNG, I_LNB, I_GWA2, I_GBA, I_GNG, I_BM, I_WBR, I_WBG, I_WOUT, I_NFG,
       I_WROUTER, I_BROUTER, I_WGATE, I_BGATE, I_WUP, I_BUP, I_WDOWN, I_BDOWN, I_NFINAL };
struct Frame {
    LAS unsigned char* lds; unsigned char* ws; unsigned* ctl;
    int tid, lane, wave, vcu, G;
};

__device__ __forceinline__ void tr_item(const float* W, int ldw, int nvalid, int k0, int n0, bf16* dst, int ldk, LAS float* scr, int lane) {
    const int c = lane & 31;
    const bool ok = (n0 + c) < nvalid;
#pragma unroll 8
    for (int i = 0; i < 32; ++i) { const int kk = 2 * i + (lane >> 5); scr[kk * 33 + c] = ok ? W[(size_t)(k0 + kk) * ldw + n0 + c] : 0.f; }
    LDS_WAIT(); asm volatile("" ::: "memory");
    const int c8 = lane & 7;
#pragma unroll
    for (int j = 0; j < 4; ++j) { const int n = (lane >> 3) + 8 * j; const LAS float* s = scr + (8 * c8) * 33 + n;
        v4u o; o.x = pk2(s[0 * 33], s[1 * 33]); o.y = pk2(s[2 * 33], s[3 * 33]); o.z = pk2(s[4 * 33], s[5 * 33]); o.w = pk2(s[6 * 33], s[7 * 33]);
        *(v4u*)(dst + (size_t)n * ldk + k0 + 8 * c8) = o; }
    LDS_WAIT(); asm volatile("" ::: "memory");
}
__device__ __forceinline__ void cv_load(const float* W, int ldw, int k0, int n0, int lane, f32x4 (&cr)[16]) {
    const unsigned laneoff = (unsigned)((lane >> 3) * ldw + n0 + 4 * (lane & 7)) * 4u;
#pragma unroll
    for (int i = 0; i < 16; ++i) { const char* rowp = (const char*)W + (size_t)(k0 + 8 * i) * ldw * 4; cr[i] = *(const f32x4*)(rowp + laneoff); }
}
__device__ __forceinline__ void cv_finish(const f32x4 (&cr)[16], int k0, unsigned char* dst, int ldk, LAS float* scr, int lane, float scale) {
    const int rr = lane >> 3, ch = lane & 7;
#pragma unroll
    for (int i = 0; i < 16; ++i) { LAS float* d = scr + (8 * i + rr) * 33 + 4 * ch; d[0] = cr[i].x * scale; d[1] = cr[i].y * scale; d[2] = cr[i].z * scale; d[3] = cr[i].w * scale; }
    LDS_WAIT(); asm volatile("" ::: "memory");
#pragma unroll
    for (int j = 0; j < 4; ++j) { const int n = rr + 8 * j; const LAS float* sp = scr + (16 * ch) * 33 + n;
        v4u o; o.x = pk4_fp8(sp[0 * 33], sp[1 * 33], sp[2 * 33], sp[3 * 33]); o.y = pk4_fp8(sp[4 * 33], sp[5 * 33], sp[6 * 33], sp[7 * 33]);
        o.z = pk4_fp8(sp[8 * 33], sp[9 * 33], sp[10 * 33], sp[11 * 33]); o.w = pk4_fp8(sp[12 * 33], sp[13 * 33], sp[14 * 33], sp[15 * 33]);
        *(v4u*)(dst + (size_t)n * ldk + k0 + 16 * ch) = o; }
    LDS_WAIT(); asm volatile("" ::: "memory");
}
__device__ __forceinline__ void cv_issue_dma(const float* W, int ldw, int k0, int n0, int lane, LAS float* scr) {
#pragma unroll
    for (int i = 0; i < 16; ++i) { const char* rowp = (const char*)W + (size_t)(k0 + 8 * i) * ldw * 4;
        const unsigned off = (unsigned)((lane >> 3) * ldw + n0 + 4 * ((lane & 7) ^ (i >> 1))) * 4u;
        __builtin_amdgcn_global_load_lds((const unsigned*)(rowp + off), (LAS unsigned*)(scr + i * 256), 16, 0, 2); }
}
__device__ __forceinline__ void cv_finish_dma(int k0, unsigned char* dst, int ldk, const LAS float* scr, int lane, float scale) {
    const int rr = lane >> 3, ch = lane & 7;
#pragma unroll
    for (int j = 0; j < 4; ++j) { const int n = rr + 8 * j; const LAS float* sp = scr + (16 * ch) * 32 + ((((n >> 2) ^ ch) << 2) | (n & 3));
        float f[16];
#pragma unroll
        for (int i = 0; i < 16; ++i) f[i] = sp[i * 32] * scale;
        v4u o; o.x = pk4_fp8(f[0], f[1], f[2], f[3]); o.y = pk4_fp8(f[4], f[5], f[6], f[7]); o.z = pk4_fp8(f[8], f[9], f[10], f[11]); o.w = pk4_fp8(f[12], f[13], f[14], f[15]);
        *(v4u*)(dst + (size_t)n * ldk + k0 + 16 * ch) = o; }
}
__device__ __forceinline__ void cvb_finish_dma(int k0, bf16* dst, int ldk, const LAS float* scr, int lane) {
    const int rr = lane >> 3, ch = lane & 7;
#pragma unroll
    for (int j = 0; j < 4; ++j) { const int n = rr + 8 * j; const LAS float* sp = scr + (16 * ch) * 32 + ((((n >> 2) ^ ch) << 2) | (n & 3));
        float f[16];
#pragma unroll
        for (int i = 0; i < 16; ++i) f[i] = sp[i * 32];
        v4u o0, o1; o0.x = pk2(f[0], f[1]); o0.y = pk2(f[2], f[3]); o0.z = pk2(f[4], f[5]); o0.w = pk2(f[6], f[7]); o1.x = pk2(f[8], f[9]); o1.y = pk2(f[10], f[11]); o1.z = pk2(f[12], f[13]); o1.w = pk2(f[14], f[15]);
        bf16* d = dst + (size_t)n * ldk + k0 + 16 * ch; *(v4u*)d = o0; *(v4u*)(d + 8) = o1; }
}
__device__ __forceinline__ void cvr_load(const float* W, int ldw, int k0, int n0, int lane, f32x4 (&cr)[16]) {
    const unsigned laneoff = (unsigned)((16 * (lane >> 3)) * ldw + n0 + 4 * (lane & 7)) * 4u;
#pragma unroll
    for (int i = 0; i < 16; ++i) { const char* rowp = (const char*)W + (size_t)(k0 + i) * ldw * 4; cr[i] = __builtin_nontemporal_load((const f32x4*)(rowp + laneoff)); }
}
__device__ __forceinline__ void cvr_store(const f32x4 (&cr)[16], int k0, unsigned char* dst, int ldk, int lane, float scale) {
    unsigned char* d = dst + (size_t)(4 * (lane & 7)) * ldk + k0 + 16 * (lane >> 3);
#pragma unroll
    for (int j = 0; j < 4; ++j) { v4u o;
        o.x = pk4_fp8(cr[0][j] * scale, cr[1][j] * scale, cr[2][j] * scale, cr[3][j] * scale); o.y = pk4_fp8(cr[4][j] * scale, cr[5][j] * scale, cr[6][j] * scale, cr[7][j] * scale);
        o.z = pk4_fp8(cr[8][j] * scale, cr[9][j] * scale, cr[10][j] * scale, cr[11][j] * scale); o.w = pk4_fp8(cr[12][j] * scale, cr[13][j] * scale, cr[14][j] * scale, cr[15][j] * scale);
        __builtin_nontemporal_store(o, (v4u*)(d + (size_t)j * ldk)); }
}
struct CvItem { const float* W; unsigned char* dst; int ldw, ldk, k0, n0; };
__device__ __forceinline__ CvItem cv_item(const Args& a, unsigned char* ws, int idx) {
    constexpr int I_EXP = (D / 128) * (FF / 32);
    int r = idx; const int mat = r / (NE * I_EXP); r -= mat * (NE * I_EXP); const int e = r / I_EXP; r -= e * I_EXP;
    const int kb = r / (FF / 32), nb = r % (FF / 32), n0 = 32 * nb;
    CvItem it; it.k0 = 128 * kb; it.n0 = n0;
    if (mat == 0) { it.W = a.in[I_WGATE] + (size_t)e * D * FF; it.ldw = FF; it.dst = ws + WS_WGU + ((size_t)e * 4096 + (n0 >> 7) * 256 + (n0 & 127)) * D; it.ldk = D; }
    else if (mat == 1) { it.W = a.in[I_WUP] + (size_t)e * D * FF; it.ldw = FF; it.dst = ws + WS_WGU + ((size_t)e * 4096 + (n0 >> 7) * 256 + 128 + (n0 & 127)) * D; it.ldk = D; }
    else { it.W = a.in[I_WDOWN] + (size_t)e * FF * D; it.ldw = D; it.dst = ws + WS_WD + ((size_t)e * 2048 + n0) * FF; it.ldk = FF; }
    return it;
}
constexpr int CV_ITEMS = 3 * NE * (D / 128) * (FF / 32);
constexpr int CVQ_CH = 4, CVQ_NCH = CV_ITEMS / CVQ_CH;
__device__ __forceinline__ unsigned cvq_issue(unsigned* q, int lane) { unsigned c = 0; if (lane == 0) c = __hip_atomic_fetch_add(q, 1u, RLX_AGENT); return c; }
__device__ __forceinline__ void rms_row_to_bf16(const float* xrow, const float* g, bf16* orow, int lane) {
    const f32x4* xr = (const f32x4*)xrow + lane; const f32x4* gr = (const f32x4*)g + lane;
    f32x4 v[8]; float s = 0.f;
#pragma unroll
    for (int j = 0; j < 8; ++j) { v[j] = __builtin_nontemporal_load(xr + 64 * j); s += (v[j].x * v[j].x + v[j].y * v[j].y) + (v[j].z * v[j].z + v[j].w * v[j].w); }
    const float rstd = rsqrtf(wave_sum(s) * (1.f / D) + NORM_EPS);
    v2u* o8 = (v2u*)orow + lane;
#pragma unroll
    for (int j = 0; j < 8; ++j) { const f32x4 gg = gr[64 * j]; v2u o; o.x = pk2(v[j].x * rstd * gg.x, v[j].y * rstd * gg.y); o.y = pk2(v[j].z * rstd * gg.z, v[j].w * rstd * gg.w); o8[64 * j] = o; }
}
__device__ __forceinline__ void p0_prologue(const Frame& F, const Args& a) {
    LAS float* scr = (LAS float*)(F.lds + F.wave * 16896);
    const int gw = F.vcu * 8 + F.wave, NGW = F.G * 8;
    bf16* Wt_in = (bf16*)(F.ws + WS_WIN); bf16* Wt_ba = (bf16*)(F.ws + WS_WBA); bf16* Wt_bb = (bf16*)(F.ws + WS_WBB); bf16* Wt_out = (bf16*)(F.ws + WS_WOUT);
    constexpr int NB_IN = PLD / 32;
    constexpr int I_IN = (D / 64) * NB_IN, I_BA = (RW / 64) * (D / 32), I_BB = I_BA, I_OUT = (D / 64) * (D / 32);
    constexpr int NITEMS = I_IN + I_BA + I_BB + I_OUT;
    {
        constexpr int NBF = IN_COLS / 32;
        constexpr int J_IN = (D / 128) * NBF, J_BA = (RW / 128) * (D / 32), J_BB = J_BA, J_OUT = (D / 128) * (D / 32), NJ = J_IN + J_BA + J_BB + J_OUT;
        LAS float* t2 = (LAS float*)(F.lds + F.wave * 16384);
        for (int it = gw; it < NJ; it += NGW) {
            const float* W = nullptr; int ldw = 0, k0 = 0, n0 = 0, ldk = 0; bf16* dst = nullptr; int r = it;
            if (r < J_IN) { const int kb = r / NBF, nb = r % NBF; W = a.in[I_WIN]; ldw = IN_COLS; k0 = 128 * kb; n0 = 32 * nb; dst = Wt_in + (size_t)n0 * DP; ldk = DP; }
            else if ((r -= J_IN) < J_BA) { const int kb = r / (D / 32), nb = r % (D / 32); W = a.in[I_WBR]; ldw = D; k0 = 128 * kb; n0 = 32 * nb; dst = Wt_ba + (size_t)n0 * RW; ldk = RW; }
            else if ((r -= J_BA) < J_BB) { const int kb = r / (D / 32), nb = r % (D / 32); W = a.in[I_WBG]; ldw = D; k0 = 128 * kb; n0 = 32 * nb; dst = Wt_bb + (size_t)n0 * GVW; ldk = GVW; }
            else { r -= J_BB; const int kb = r / (D / 32), nb = r % (D / 32); W = a.in[I_WOUT]; ldw = D; k0 = 128 * kb; n0 = 32 * nb; dst = Wt_out + (size_t)n0 * D; ldk = D; }
            cv_issue_dma(W, ldw, k0, n0, F.lane, t2);
            asm volatile("s_waitcnt vmcnt(0)" ::: "memory");
            cvb_finish_dma(k0, dst, ldk, t2, F.lane); asm volatile("s_waitcnt lgkmcnt(0)" ::: "memory");
        }
        __syncthreads();
        for (int it = gw; it < (D / 64) * 2; it += NGW) { const int kb = it >> 1, nb = NBF + (it & 1); tr_item(a.in[I_WIN], IN_COLS, IN_COLS, 64 * kb, 32 * nb, Wt_in + (size_t)(32 * nb) * DP, DP, scr, F.lane); }
    }
    bf16* Hh = (bf16*)(F.ws + WS_H);
    for (int m = gw; m < T; m += NGW) rms_row_to_bf16(a.in[I_X] + (size_t)m * D, a.in[I_NMG], Hh + (size_t)m * DP, F.lane);
    const int gt = F.vcu * 512 + F.tid, NGT = F.G * 512;
    bf16* Wl_wa = (bf16*)(F.ws + WS_WLWA); bf16* Wl_g = (bf16*)(F.ws + WS_WLG);
    for (int i = gt; i < 2048 * 256; i += NGT) { const int n = i >> 8, k = i & 255; float v = 0.f;
        if (n < 1024) { if (k < DLORA) v = a.in[I_W2][(size_t)k * RW + n]; } else { if (k >= DLORA && k < 2 * DLORA) v = a.in[I_A2][(size_t)(k - DLORA) * RW + (n - 1024)]; }
        Wl_wa[i] = (bf16)f2bf(v); }
    for (int i = gt; i < 1024 * 256; i += NGT) { const int n = i >> 8, k = i & 255; Wl_g[i] = (bf16)f2bf(a.in[I_G2][(size_t)k * RW + n]); }
    float* Wr = (float*)(F.ws + WS_WR);
    for (int i = gt; i < 8 * 32 * 64 * 4; i += NGT) { const int ii = i & 3, l = (i >> 2) & 63, e = (i >> 8) & 31, j = i >> 13; const int k = 256 * j + 4 * l + ii;
        Wr[i] = a.in[I_NFG][k] * a.in[I_WROUTER][(size_t)k * NE + e]; }
}

__device__ __forceinline__ void cv_queue_run(const Frame& F, const Args& a, unsigned* stop) {
    unsigned* q = F.ctl + CW_CVQ; const int lane = F.lane;
    f32x4 ca[16], cb[16];
    int cur = __builtin_amdgcn_readfirstlane((int)cvq_issue(q, lane)); unsigned nraw = cvq_issue(q, lane); int pos = 0; bool stopped = false;
#define CVQ_NEXT(idx) do { if (pos == CVQ_CH) { cur = __builtin_amdgcn_readfirstlane((int)nraw); pos = 0; \
        if (stop && !stopped && __hip_atomic_load(stop, RLX_AGENT) != 0u) stopped = true; \
        nraw = stopped ? 0x7fffffffu : cvq_issue(q, lane); } \
        idx = cur < CVQ_NCH ? cur * CVQ_CH + pos++ : -1; } while (0)
    int xa, xb; CvItem ia, ib;
    CVQ_NEXT(xa); if (xa < 0) return;
    ia = cv_item(a, F.ws, xa); cvr_load(ia.W, ia.ldw, ia.k0, ia.n0, lane, ca);
    CVQ_NEXT(xb); ib = ia; if (xb >= 0) { ib = cv_item(a, F.ws, xb); cvr_load(ib.W, ib.ldw, ib.k0, ib.n0, lane, cb); }
    while (xa >= 0) {
        cvr_store(ca, ia.k0, ia.dst, ia.ldk, lane, WQ_SCALE);
        xa = -1; if (xb >= 0) { CVQ_NEXT(xa); if (xa >= 0) { ia = cv_item(a, F.ws, xa); cvr_load(ia.W, ia.ldw, ia.k0, ia.n0, lane, ca); } }
        if (xb >= 0) { cvr_store(cb, ib.k0, ib.dst, ib.ldk, lane, WQ_SCALE);
            xb = -1; if (xa >= 0) { CVQ_NEXT(xb); if (xb >= 0) { ib = cv_item(a, F.ws, xb); cvr_load(ib.W, ib.ldw, ib.k0, ib.n0, lane, cb); } } }
    }
#undef CVQ_NEXT
}
constexpr int CVW_SH = 3;
__device__ __forceinline__ void p1_gemm_in(const Frame& F, const Args& a) {
    const bool split = (F.G == 256);
    const int bx = (int)blockIdx.x, grp = bx >> 3;
    if (split && (grp & ((1 << CVW_SH) - 1)) == (1 << CVW_SH) - 1) { cv_queue_run(F, a, F.ctl + CW_CVSTOP); return; }
    pg8::Gemm g{(const bf16*)(F.ws + WS_H), (const bf16*)(F.ws + WS_WIN), DP, DP, D, nullptr}; pg8::StaticOrder S;
    if (split) S.init(T, PLD, 256 - (256 >> CVW_SH), (grp - (grp >> CVW_SH)) * 8 + (bx & 7)); else S.init(T, PLD, F.G, bx);
    pg8::EpiBf16 E{(bf16*)(F.ws + WS_P), PLD, nullptr, 0, 1.f};
    pg8::gemm_phase(F.lds, g, S, E);
    if (F.tid == 0) __hip_atomic_fetch_add(F.ctl + CW_CVSTOP, 1u, RLX_AGENT);
}
__device__ __forceinline__ void p2_lora_in(const Frame& F, const Args& a) {
    const int gw = F.vcu * 8 + F.wave, NGW = F.G * 8, lane = F.lane;
    const bf16* P = (const bf16*)(F.ws + WS_P); bf16* A2 = (bf16*)(F.ws + WS_A2);
    const int kind = lane < 12 ? 0 : (lane < 24 ? 1 : (lane < 32 ? 2 : 3));
    const int src = lane < 24 ? (C_WL + 8 * lane) : (C_GL + 8 * (lane - 32));
    float mu[8];
    if (kind != 2) {
#pragma unroll
        for (int j = 0; j < 8; ++j) mu[j] = a.in[I_MU][src + j];
    }
    for (int t = gw; t < T; t += NGW) {
        v4u o = {0u, 0u, 0u, 0u};
        if (kind != 2) {
            const v4u c = *(const v4u*)(P + (size_t)t * PLD + src);
            v4u pv = {0u, 0u, 0u, 0u};
            if ((t & (SEQ - 1)) != 0) pv = *(const v4u*)(P + (size_t)(t - 1) * PLD + src);
            float x[8] = {bflo(c.x), bfhi(c.x), bflo(c.y), bfhi(c.y), bflo(c.z), bfhi(c.z), bflo(c.w), bfhi(c.w)};
            float q[8] = {bflo(pv.x), bfhi(pv.x), bflo(pv.y), bfhi(pv.y), bflo(pv.z), bfhi(pv.z), bflo(pv.w), bfhi(pv.w)};
#pragma unroll
            for (int j = 0; j < 8; ++j) { float m = x[j] + (q[j] - x[j]) * mu[j]; x[j] = kind == 0 ? tanhf(m) : (kind == 1 ? m : sigmoidf_(m)); }
            o.x = pk2(x[0], x[1]); o.y = pk2(x[2], x[3]); o.z = pk2(x[4], x[5]); o.w = pk2(x[6], x[7]);
        }
        *(v4u*)(A2 + (size_t)t * 512 + 8 * lane) = o;
    }
}

#define DPPF(x, ctrl) __builtin_bit_cast(float, __builtin_amdgcn_update_dpp(0, __builtin_bit_cast(int, (x)), (ctrl), 0xF, 0xF, false))
__device__ __forceinline__ float dpp_sum16(float x) { x += DPPF(x, 0xB1); x += DPPF(x, 0x4E); x += DPPF(x, 0x141); x += DPPF(x, 0x140); return x; }
__device__ __forceinline__ float wave_sum_dpp(float x) {
    x = dpp_sum16(x); const int xi = __builtin_bit_cast(int, x);
    return (__builtin_bit_cast(float, __builtin_amdgcn_readlane(xi, 0)) + __builtin_bit_cast(float, __builtin_amdgcn_readlane(xi, 16))) +
           (__builtin_bit_cast(float, __builtin_amdgcn_readlane(xi, 32)) + __builtin_bit_cast(float, __builtin_amdgcn_readlane(xi, 48)));
}
__device__ __forceinline__ float quad_sum(float x) { x += DPPF(x, 0xB1); x += DPPF(x, 0x4E); return x; }
__device__ __forceinline__ void unpack8(const v4u u, float (&f)[8]) { f[0] = bflo(u.x); f[1] = bfhi(u.x); f[2] = bflo(u.y); f[3] = bfhi(u.y); f[4] = bflo(u.z); f[5] = bfhi(u.z); f[6] = bflo(u.w); f[7] = bfhi(u.w); }
__device__ __forceinline__ v4u pack8(const float (&f)[8]) { v4u u; u.x = pk2(f[0], f[1]); u.y = pk2(f[2], f[3]); u.z = pk2(f[4], f[5]); u.w = pk2(f[6], f[7]); return u; }
__device__ __forceinline__ void p4_rwkv_prep(const Frame& F, const Args& a) {
    const int gw = F.vcu * 8 + F.wave, NGW = F.G * 8, lane = F.lane;
    const bf16* P = (const bf16*)(F.ws + WS_P); const bf16* WA = (const bf16*)(F.ws + WS_WAO); bf16* SC = (bf16*)(F.ws + WS_SCAN); float* BON = (float*)(F.ws + WS_BON);
    const int h = lane >> 2, q = lane & 3, c0 = h * RN + 16 * q;
    for (int t = gw; t < T; t += NGW) {
        const bool first = (t & (SEQ - 1)) == 0;
        const bf16* pr = P + (size_t)t * PLD + c0; const bf16* pp = first ? pr : pr - PLD;
        v4u ur[2], uk[2], uv[2], ur1[2], uk1[2], uv1[2], uw[2], ua[2];
#pragma unroll
        for (int j = 0; j < 2; ++j) { ur[j] = *(const v4u*)(pr + C_R + 8 * j); uk[j] = *(const v4u*)(pr + C_K + 8 * j); uv[j] = *(const v4u*)(pr + C_V + 8 * j);
            ur1[j] = *(const v4u*)(pp + C_R + 8 * j); uk1[j] = *(const v4u*)(pp + C_K + 8 * j); uv1[j] = *(const v4u*)(pp + C_V + 8 * j);
            uw[j] = *(const v4u*)(WA + (size_t)t * 2048 + c0 + 8 * j); ua[j] = *(const v4u*)(WA + (size_t)t * 2048 + 1024 + c0 + 8 * j); }
        float r[2][8], k[2][8], v[2][8], kk[2][8], dec[2][8], aa[2][8];
        float n2 = 0.f;
#pragma unroll
        for (int j = 0; j < 2; ++j) { float x[8], x1[8], wv[8], av[8];
            unpack8(ur[j], x); unpack8(ur1[j], x1);
#pragma unroll
            for (int i = 0; i < 8; ++i) { const float m = a.in[I_MU][C_R + c0 + 8 * j + i]; r[j][i] = x[i] + ((first ? 0.f : x1[i]) - x[i]) * m; }
            unpack8(uk[j], x); unpack8(uk1[j], x1);
#pragma unroll
            for (int i = 0; i < 8; ++i) { const float m = a.in[I_MU][C_K + c0 + 8 * j + i]; k[j][i] = x[i] + ((first ? 0.f : x1[i]) - x[i]) * m; }
            unpack8(uv[j], x); unpack8(uv1[j], x1);
#pragma unroll
            for (int i = 0; i < 8; ++i) { const float m = a.in[I_MU][C_V + c0 + 8 * j + i]; v[j][i] = x[i] + ((first ? 0.f : x1[i]) - x[i]) * m; }
            unpack8(uw[j], wv); unpack8(ua[j], av);
#pragma unroll
            for (int i = 0; i < 8; ++i) { const int c = c0 + 8 * j + i;
                dec[j][i] = __expf(-0.60653066f * sigmoidf_(a.in[I_W0][c] + wv[i]));
                aa[j][i] = sigmoidf_(a.in[I_A0][c] + av[i]);
                const float kq = k[j][i] * a.in[I_KK][c]; kk[j][i] = kq; n2 += kq * kq; } }
        n2 = quad_sum(n2);
        const float inv = rsqrtf(fmaxf(n2, 1e-24f));
        float bon = 0.f; float o0[2][8], o2[2][8], o3[2][8];
#pragma unroll
        for (int j = 0; j < 2; ++j)
#pragma unroll
            for (int i = 0; i < 8; ++i) { const int c = c0 + 8 * j + i; const float kn = kk[j][i] * inv; const float kf = k[j][i] * (1.f + (aa[j][i] - 1.f) * a.in[I_KA][c]);
                o0[j][i] = -kn; o2[j][i] = kn * aa[j][i]; o3[j][i] = kf; bon += r[j][i] * kf * a.in[I_RK][c]; }
        bon = quad_sum(bon);
        const int bh = (t >> 11) * RH + h, ts = t & (SEQ - 1);
        bf16* o = SC + ((size_t)(bh * SEQ + ts) * 6) * 64 + 16 * q;
#pragma unroll
        for (int j = 0; j < 2; ++j) { *(v4u*)(o + 8 * j) = pack8(o0[j]); *(v4u*)(o + 64 + 8 * j) = pack8(dec[j]); *(v4u*)(o + 128 + 8 * j) = pack8(o2[j]);
            *(v4u*)(o + 192 + 8 * j) = pack8(o3[j]); *(v4u*)(o + 256 + 8 * j) = pack8(r[j]); *(v4u*)(o + 320 + 8 * j) = pack8(v[j]); }
        if (q == 0) BON[(size_t)t * RH + h] = bon;
    }
}
__device__ __forceinline__ void p5_rwkv_scan(const Frame& F, const Args& a) {
    constexpr int TB = 16, NBLK = SEQ / TB, STF = 384, BLKF = TB * STF;
    const bf16* SC = (const bf16*)(F.ws + WS_SCAN); float* YR = (float*)(F.ws + WS_YRAW);
    LAS float* buf = (LAS float*)F.lds;
    volatile LAS int* hs = (volatile LAS int*)(F.lds + MOE_OFF + 2048);
    const int lane = F.lane;
    for (int u = F.vcu; u < 256; u += F.G) {
        const int bh = u >> 2, vg = u & 3, b = bh >> 4, h = bh & 15;
        const int role = F.wave < 4 ? 0 : (F.wave == 4 ? 1 : 2);
        const int cw = F.wave - 5;
        const bf16* src = SC + (size_t)bh * SEQ * STF;
        const int rl = lane >> 4, kq = lane & 15, row = 16 * vg + 4 * F.wave + rl;
        __syncthreads();
        if (F.tid < 8) hs[F.tid] = 0;
        __syncthreads();
#define HS_WAIT(cond) do { unsigned sp_ = 0; while (!(cond)) { __builtin_amdgcn_s_sleep(1); if (++sp_ > (1u << 24)) break; } asm volatile("" ::: "memory"); } while (0)
        if (role == 1) {
            v4u xb[12];
            { const v4u* s4 = (const v4u*)src;
#pragma unroll
              for (int i = 0; i < 12; ++i) xb[i] = s4[lane + 64 * i]; }
            for (int m = 0; m < NBLK; ++m) {
                if (m >= 4) HS_WAIT(hs[1] >= m - 3 && hs[2] >= m - 3 && hs[3] >= m - 3 && hs[4] >= m - 3);
                LAS f32x4* d4 = (LAS f32x4*)(buf + (m & 3) * BLKF);
#pragma unroll
                for (int i = 0; i < 12; ++i) { const int c = lane + 64 * i;
                    d4[2 * c] = (f32x4){bflo(xb[i].x), bfhi(xb[i].x), bflo(xb[i].y), bfhi(xb[i].y)}; d4[2 * c + 1] = (f32x4){bflo(xb[i].z), bfhi(xb[i].z), bflo(xb[i].w), bfhi(xb[i].w)}; }
                asm volatile("s_waitcnt lgkmcnt(0)" ::: "memory");
                if (lane == 0) hs[0] = m + 1;
                if (m + 1 < NBLK) { const v4u* s4 = (const v4u*)(src + (size_t)(m + 1) * BLKF);
#pragma unroll
                    for (int i = 0; i < 12; ++i) xb[i] = s4[lane + 64 * i]; }
            }
        } else if (role == 2) {
            cv_queue_run(F, a, nullptr);
        } else {
            float S0 = 0.f, S1 = 0.f, S2 = 0.f, S3 = 0.f;
            for (int n = 0; n < NBLK; ++n) {
                HS_WAIT(hs[0] >= n + 1);
                const LAS float* bb = buf + (n & 3) * BLKF;
                float* yo = YR + ((size_t)(b * SEQ + n * TB)) * RW + h * RN + row;
                f32x4 al = *(const LAS f32x4*)(bb + 4 * kq), w = *(const LAS f32x4*)(bb + 64 + 4 * kq), be = *(const LAS f32x4*)(bb + 128 + 4 * kq);
                f32x4 kf = *(const LAS f32x4*)(bb + 192 + 4 * kq), r = *(const LAS f32x4*)(bb + 256 + 4 * kq); float vv = bb[320 + row];
                float ykeep = 0.f, yp = 0.f;
#pragma unroll
                for (int j = 0; j < TB; ++j) {
                    f32x4 al_n = al, w_n = w, be_n = be, kf_n = kf, r_n = r; float vv_n = vv;
                    if (j + 1 < TB) { const LAS float* st = bb + (j + 1) * STF;
                        al_n = *(const LAS f32x4*)(st + 4 * kq); w_n = *(const LAS f32x4*)(st + 64 + 4 * kq); be_n = *(const LAS f32x4*)(st + 128 + 4 * kq);
                        kf_n = *(const LAS f32x4*)(st + 192 + 4 * kq); r_n = *(const LAS f32x4*)(st + 256 + 4 * kq); vv_n = st[320 + row]; }
                    float sa = (S0 * al.x + S1 * al.y) + (S2 * al.z + S3 * al.w);
                    float yq = yp;
                    sa += DPPF(sa, 0xB1); if (j > 0) yq += DPPF(yq, 0xB1);
                    sa += DPPF(sa, 0x4E); if (j > 0) yq += DPPF(yq, 0x4E);
                    sa += DPPF(sa, 0x141); if (j > 0) yq += DPPF(yq, 0x141);
                    sa += DPPF(sa, 0x140); if (j > 0) yq += DPPF(yq, 0x140);
                    if (j > 0) ykeep = __builtin_bit_cast(float, __builtin_amdgcn_update_dpp(__builtin_bit_cast(int, yq), __builtin_bit_cast(int, ykeep), 0x111, 0xF, 0xF, false));
                    S0 = S0 * w.x + (sa * be.x + vv * kf.x); S1 = S1 * w.y + (sa * be.y + vv * kf.y);
                    S2 = S2 * w.z + (sa * be.z + vv * kf.z); S3 = S3 * w.w + (sa * be.w + vv * kf.w);
                    yp = (S0 * r.x + S1 * r.y) + (S2 * r.z + S3 * r.w);
                    al = al_n; w = w_n; be = be_n; kf = kf_n; r = r_n; vv = vv_n;
                }
                const float yl = dpp_sum16(yp);
                ykeep = __builtin_bit_cast(float, __builtin_amdgcn_update_dpp(__builtin_bit_cast(int, yl), __builtin_bit_cast(int, ykeep), 0x111, 0xF, 0xF, false));
                yo[(size_t)(TB - 1 - kq) * RW] = ykeep;
                asm volatile("s_waitcnt lgkmcnt(0)" ::: "memory");
                if (lane == 0) hs[1 + F.wave] = n + 1;
            }
            __builtin_amdgcn_s_setprio(0);
        }
#undef HS_WAIT
        __syncthreads();
    }
    if (F.G != 256) { LAS float* scr = (LAS float*)(F.lds + F.wave * 16896); __syncthreads();
        for (int it = F.vcu * 8 + F.wave; it < CV_ITEMS; it += F.G * 8) { const CvItem c2 = cv_item(a, F.ws, it); f32x4 c3[16]; cv_load(c2.W, c2.ldw, c2.k0, c2.n0, lane, c3); cv_finish(c3, c2.k0, c2.dst, c2.ldk, scr, lane, WQ_SCALE); } }
}

__device__ __forceinline__ void p6_rwkv_post(const Frame& F, const Args& a) {
    const int gw = F.vcu * 8 + F.wave, NGW = F.G * 8, lane = F.lane;
    const bf16* SC = (const bf16*)(F.ws + WS_SCAN); const float* YR = (const float*)(F.ws + WS_YRAW); const float* BON = (const float*)(F.ws + WS_BON);
    const bf16* GO = (const bf16*)(F.ws + WS_GO); bf16* YA = (bf16*)(F.ws + WS_YA);
    const int h = lane >> 2, q = lane & 3, c0 = h * RN + 16 * q;
    f32x4 lg[4], lb[4];
#pragma unroll
    for (int j = 0; j < 4; ++j) { lg[j] = *(const f32x4*)(a.in[I_LNG] + c0 + 4 * j); lb[j] = *(const f32x4*)(a.in[I_LNB] + c0 + 4 * j); }
    for (int t = gw; t < T; t += NGW) {
        const int bh = (t >> 11) * RH + h, ts = t & (SEQ - 1);
        f32x4 y[4]; v4u uv[2], ug[2];
#pragma unroll
        for (int j = 0; j < 4; ++j) y[j] = *(const f32x4*)(YR + (size_t)t * RW + c0 + 4 * j);
#pragma unroll
        for (int j = 0; j < 2; ++j) { uv[j] = *(const v4u*)(SC + ((size_t)(bh * SEQ + ts) * 6 + 5) * 64 + 16 * q + 8 * j); ug[j] = *(const v4u*)(GO + (size_t)t * RW + c0 + 8 * j); }
        const float bo = BON[(size_t)t * RH + h];
        float s = 0.f;
#pragma unroll
        for (int j = 0; j < 4; ++j) s += (y[j].x + y[j].y) + (y[j].z + y[j].w);
        const float mean = quad_sum(s) * (1.f / RN);
        float s2 = 0.f;
#pragma unroll
        for (int j = 0; j < 4; ++j) { y[j] = y[j] - mean; s2 += (y[j].x * y[j].x + y[j].y * y[j].y) + (y[j].z * y[j].z + y[j].w * y[j].w); }
        const float rstd = rsqrtf(quad_sum(s2) * (1.f / RN) + GN_EPS);
        float vv[2][8], gg[2][8], o[2][8];
        unpack8(uv[0], vv[0]); unpack8(uv[1], vv[1]); unpack8(ug[0], gg[0]); unpack8(ug[1], gg[1]);
#pragma unroll
        for (int j = 0; j < 4; ++j)
#pragma unroll
            for (int i = 0; i < 4; ++i) o[j >> 1][4 * (j & 1) + i] = (y[j][i] * rstd * lg[j][i] + lb[j][i] + bo * vv[j >> 1][4 * (j & 1) + i]) * gg[j >> 1][4 * (j & 1) + i];
        *(v4u*)(YA + (size_t)t * RW + c0) = pack8(o[0]); *(v4u*)(YA + (size_t)t * RW + c0 + 8) = pack8(o[1]);
    }
}

constexpr int G_BC = 0;
constexpr int G_ALF = 32768;
constexpr int G_RED = 36864;
constexpr int G_TOT = 38912;
constexpr int G_QT = 40960;
constexpr int G_KT = 58368;
constexpr int G_VT = 76800;
constexpr int G_AT = 113664;
__device__ __forceinline__ void gla_bcum(const Frame& F, const Args& a, const bf16* P, int t0, int h) {
    LAS float* bc = (LAS float*)(F.lds + G_BC); LAS float* alf = (LAS float*)(F.lds + G_ALF); LAS float* tot = (LAS float*)(F.lds + G_TOT);
    const int tid = F.tid;
    __syncthreads();
    { const int j = tid >> 3, i2 = (tid & 7) * 2; const unsigned u = *(const unsigned*)(P + (size_t)(t0 + j) * PLD + C_GAL + i2); alf[j * 16 + i2] = bflo(u); alf[j * 16 + i2 + 1] = bfhi(u); }
    const int d = tid & 127, jq = tid >> 7, hd = h * GDK + d;
    float wv[16];
#pragma unroll
    for (int i = 0; i < 16; ++i) wv[i] = a.in[I_GWA2][(size_t)i * GKW + hd];
    const float bb = a.in[I_GBA][hd];
    __syncthreads();
    float run = 0.f;
    for (int jj = 0; jj < 16; ++jj) { const int j = jq * 16 + jj; float x = bb;
#pragma unroll
        for (int i = 0; i < 16; ++i) x += alf[j * 16 + i] * wv[i];
        run += -softplusf_(-x) * (1.f / 16.f); bc[j * 128 + d] = run; }
    tot[jq * 128 + d] = run;
    __syncthreads();
    float pre = 0.f;
    for (int q = 0; q < jq; ++q) pre += tot[q * 128 + d];
    if (jq > 0) { for (int jj = 0; jj < 16; ++jj) bc[(jq * 16 + jj) * 128 + d] += pre; }
    __syncthreads();
}
constexpr int G_VP = 264, G_KP = 136;
__device__ __forceinline__ void gla_stage_v(const Frame& F, const bf16* P, int t0, int h) {
    LAS bf16* VR = (LAS bf16*)(F.lds + G_VT);
    const int j = F.tid >> 3, e0 = (F.tid & 7) * 32;
    const bf16* src = P + (size_t)(t0 + j) * PLD + C_GV + h * GDV + e0;
#pragma unroll
    for (int q = 0; q < 4; ++q) *(LAS v4u*)(VR + j * G_VP + e0 + 8 * q) = *(const v4u*)(src + 8 * q);
}
typedef short s16x4g __attribute__((ext_vector_type(4)));
__device__ __forceinline__ bf16x8 tr_frag(const LAS bf16* img, int pitch, int row0, int col0, int lane) {
    const LAS bf16* p = img + (row0 + 8 * (lane >> 4) + ((lane & 15) >> 2)) * pitch + col0 + 4 * (lane & 3);
    const s16x4g lo = __builtin_amdgcn_ds_read_tr16_b64_v4i16((LAS s16x4g*)p);
    const s16x4g hi = __builtin_amdgcn_ds_read_tr16_b64_v4i16((LAS s16x4g*)(p + 4 * pitch));
    return __builtin_shufflevector(lo, hi, 0, 1, 2, 3, 4, 5, 6, 7);
}
#define MMA16(a_, b_, c_) __builtin_amdgcn_mfma_f32_16x16x32_bf16(a_, b_, c_, 0, 0, 0)
__device__ __forceinline__ void gla_pass_a(const Frame& F, const Args& a) {
    const bf16* P = (const bf16*)(F.ws + WS_P); float* HT = (float*)(F.ws + WS_GHT); float* DEC = (float*)(F.ws + WS_GDEC);
    LAS float* bc = (LAS float*)(F.lds + G_BC); LAS bf16* KH = (LAS bf16*)(F.lds + G_KT); LAS bf16* VR = (LAS bf16*)(F.lds + G_VT);
    const int fr = F.lane & 15, fq = F.lane >> 4;
    for (int it = F.vcu; it < BATCH * GH * NCH; it += F.G) {
        const int c = it & 31, h = (it >> 5) & 3, b = it >> 7, t0 = b * SEQ + c * CHUNK;
        gla_bcum(F, a, P, t0, h);
        if (F.tid < 128) DEC[(size_t)it * 128 + F.tid] = __expf(bc[63 * 128 + F.tid]);
        { f32x4* gbc = (f32x4*)(F.ws + WS_GBC) + (size_t)it * 2048;
#pragma unroll
          for (int i = 0; i < 4; ++i) gbc[F.tid + 512 * i] = ((const LAS f32x4*)bc)[F.tid + 512 * i]; }
        { const int j = F.tid >> 3, d0 = (F.tid & 7) * 16; const bf16* src = P + (size_t)(t0 + j) * PLD + C_GK + h * GDK + d0;
#pragma unroll
          for (int q = 0; q < 2; ++q) { const v4u u = *(const v4u*)(src + 8 * q); float kv[8]; unpack8(u, kv);
#pragma unroll
            for (int i = 0; i < 8; ++i) { const int d = d0 + 8 * q + i; kv[i] *= __expf(bc[63 * 128 + d] - bc[j * 128 + d]); }
            *(LAS v4u*)(KH + j * G_KP + d0 + 8 * q) = pack8(kv); } }
        gla_stage_v(F, P, t0, h);
        __syncthreads();
        f32x4 acc[8][2];
#pragma unroll
        for (int m = 0; m < 8; ++m)
#pragma unroll
            for (int n = 0; n < 2; ++n) acc[m][n] = (f32x4){0.f, 0.f, 0.f, 0.f};
#pragma unroll
        for (int ks = 0; ks < 2; ++ks) {
            bf16x8 vf[2];
#pragma unroll
            for (int n = 0; n < 2; ++n) vf[n] = tr_frag(VR, G_VP, ks * 32, F.wave * 32 + n * 16, F.lane);
#pragma unroll
            for (int m = 0; m < 8; ++m) { const bf16x8 kf = tr_frag(KH, G_KP, ks * 32, m * 16, F.lane);
#pragma unroll
                for (int n = 0; n < 2; ++n) acc[m][n] = MMA16(kf, vf[n], acc[m][n]); }
        }
        float* o = HT + (size_t)it * (GDV * GDK);
#pragma unroll
        for (int m = 0; m < 8; ++m)
#pragma unroll
            for (int n = 0; n < 2; ++n) *(f32x4*)(o + (size_t)(F.wave * 32 + n * 16 + fr) * GDK + m * 16 + 4 * fq) = acc[m][n];
    }
}
__device__ __forceinline__ void gla_pass_b(const Frame& F) {
    const float* HT = (const float*)(F.ws + WS_GHT); const float* DEC = (const float*)(F.ws + WS_GDEC); bf16* ST = (bf16*)(F.ws + WS_GST);
    const int gt = F.vcu * 512 + F.tid, NGT = F.G * 512;
    for (int i = gt; i < BATCH * GH * GDV * GDK; i += NGT) {
        const int bh = i >> 15, ed = i & 32767, d = ed & 127;
        float s = 0.f;
        for (int c = 0; c < NCH; ++c) { const size_t it = (size_t)bh * NCH + c;
            ST[it * (GDV * GDK) + ed] = (bf16)f2bf(s);
            s = s * DEC[it * 128 + d] + HT[it * (GDV * GDK) + ed]; }
    }
}
__device__ __forceinline__ void gla_pass_c(const Frame& F, const Args& a) {
    const bf16* P = (const bf16*)(F.ws + WS_P); const bf16* ST = (const bf16*)(F.ws + WS_GST); bf16* YB = (bf16*)(F.ws + WS_YB);
    LAS float* bc = (LAS float*)(F.lds + G_BC); LAS float* red = (LAS float*)(F.lds + G_RED);
    LAS bf16* QT = (LAS bf16*)(F.lds + G_QT); LAS bf16* KT = (LAS bf16*)(F.lds + G_KT); LAS bf16* VR = (LAS bf16*)(F.lds + G_VT); LAS bf16* AT = (LAS bf16*)(F.lds + G_AT);
    const int fr = F.lane & 15, fq = F.lane >> 4, w = F.wave;
    const float scale = 0.08838834764831845f;
    for (int it = F.vcu; it < BATCH * GH * NCH; it += F.G) {
        const int c = it & 31, h = (it >> 5) & 3, b = it >> 7, t0 = b * SEQ + c * CHUNK;
        __syncthreads();
        { const f32x4* gbc = (const f32x4*)(F.ws + WS_GBC) + (size_t)it * 2048;
#pragma unroll
          for (int i = 0; i < 4; ++i) ((LAS f32x4*)bc)[F.tid + 512 * i] = gbc[F.tid + 512 * i]; }
        const bf16* Sg = ST + (size_t)it * (GDV * GDK);
        bf16x8 sfr[4][2];
#pragma unroll
        for (int ks = 0; ks < 4; ++ks)
#pragma unroll
            for (int n = 0; n < 2; ++n) sfr[ks][n] = *(const bf16x8*)(Sg + (size_t)(w * 32 + n * 16 + fr) * GDK + ks * 32 + fq * 8);
        f32x4 gng[2];
#pragma unroll
        for (int n = 0; n < 2; ++n) gng[n] = *(const f32x4*)(a.in[I_GNG] + w * 32 + n * 16 + 4 * fq);
        __syncthreads();
        { const int j = F.tid >> 3, d0 = (F.tid & 7) * 16;
          const bf16* sq = P + (size_t)(t0 + j) * PLD + C_GQ + h * GDK + d0; const bf16* sk = P + (size_t)(t0 + j) * PLD + C_GK + h * GDK + d0;
#pragma unroll
          for (int q = 0; q < 2; ++q) { const v4u uq = *(const v4u*)(sq + 8 * q), uk = *(const v4u*)(sk + 8 * q); float fq8[8], fk8[8]; unpack8(uq, fq8); unpack8(uk, fk8);
#pragma unroll
            for (int i = 0; i < 8; ++i) { const float bv = bc[j * 128 + d0 + 8 * q + i]; fq8[i] *= scale * __expf(bv); fk8[i] *= __expf(-bv); }
            *(LAS v4u*)(QT + j * 136 + d0 + 8 * q) = pack8(fq8); *(LAS v4u*)(KT + j * 136 + d0 + 8 * q) = pack8(fk8); } }
        gla_stage_v(F, P, t0, h);
        __syncthreads();
        { const int mt = w >> 1;
#pragma unroll
          for (int q = 0; q < 2; ++q) { const int nt = (w & 1) * 2 + q; f32x4 sacc = {0.f, 0.f, 0.f, 0.f};
            if (nt <= mt) {
#pragma unroll
                for (int ks = 0; ks < 4; ++ks) { const bf16x8 kfr = *(const LAS bf16x8*)(KT + (nt * 16 + fr) * 136 + ks * 32 + fq * 8); const bf16x8 qfr = *(const LAS bf16x8*)(QT + (mt * 16 + fr) * 136 + ks * 32 + fq * 8);
                    sacc = MMA16(kfr, qfr, sacc); } }
            const int i = mt * 16 + fr, j0 = nt * 16 + 4 * fq; float v4[4];
#pragma unroll
            for (int jj = 0; jj < 4; ++jj) v4[jj] = (j0 + jj <= i) ? sacc[jj] : 0.f;
            v2u pk; pk.x = pk2(v4[0], v4[1]); pk.y = pk2(v4[2], v4[3]); *(LAS v2u*)(AT + i * 72 + j0) = pk; } }
        __syncthreads();
        f32x4 acc[2][4];
#pragma unroll
        for (int n = 0; n < 2; ++n)
#pragma unroll
            for (int m = 0; m < 4; ++m) acc[n][m] = (f32x4){0.f, 0.f, 0.f, 0.f};
#pragma unroll
        for (int ks = 0; ks < 2; ++ks) {
            bf16x8 vf[2];
#pragma unroll
            for (int n = 0; n < 2; ++n) vf[n] = tr_frag(VR, G_VP, ks * 32, w * 32 + n * 16, F.lane);
#pragma unroll
            for (int m = 0; m < 4; ++m) { const bf16x8 af = *(const LAS bf16x8*)(AT + (m * 16 + fr) * 72 + ks * 32 + fq * 8);
#pragma unroll
                for (int n = 0; n < 2; ++n) acc[n][m] = MMA16(vf[n], af, acc[n][m]); }
        }
#pragma unroll
        for (int ks = 0; ks < 4; ++ks) {
#pragma unroll
            for (int m = 0; m < 4; ++m) { const bf16x8 qf = *(const LAS bf16x8*)(QT + (m * 16 + fr) * 136 + ks * 32 + fq * 8);
#pragma unroll
                for (int n = 0; n < 2; ++n) acc[n][m] = MMA16(sfr[ks][n], qf, acc[n][m]); }
        }
        float ssq[4];
#pragma unroll
        for (int m = 0; m < 4; ++m) { float ss = 0.f;
#pragma unroll
            for (int n = 0; n < 2; ++n) ss += (acc[n][m][0] * acc[n][m][0] + acc[n][m][1] * acc[n][m][1]) + (acc[n][m][2] * acc[n][m][2] + acc[n][m][3] * acc[n][m][3]);
            ss += __shfl_xor(ss, 16); ss += __shfl_xor(ss, 32); ssq[m] = ss;
            if (fq == 0) red[(m * 16 + fr) * 8 + w] = ss; }
        __syncthreads();
#pragma unroll
        for (int m = 0; m < 4; ++m) { const int i = m * 16 + fr; float tot = 0.f;
#pragma unroll
            for (int q = 0; q < 8; ++q) tot += red[i * 8 + q];
            const float rstd = rsqrtf(tot * (1.f / GDV) + NORM_EPS);
#pragma unroll
            for (int n = 0; n < 2; ++n) { const int e = w * 32 + n * 16 + 4 * fq; const v2u ogu = *(const v2u*)(P + (size_t)(t0 + i) * PLD + C_OG + h * GDV + e);
                const float og[4] = {bflo(ogu.x), bfhi(ogu.x), bflo(ogu.y), bfhi(ogu.y)}; float r4[4];
#pragma unroll
                for (int jj = 0; jj < 4; ++jj) r4[jj] = acc[n][m][jj] * rstd * gng[n][jj] * (og[jj] * sigmoidf_(og[jj]));
                v2u pk; pk.x = pk2(r4[0], r4[1]); pk.y = pk2(r4[2], r4[3]); *(v2u*)(YB + (size_t)(t0 + i) * GVW + h * GDV + e) = pk; } }
    }
}

__device__ __forceinline__ void p11_router(const Frame& F, const Args& a) {
    const int lane = F.lane, w = F.wave;
    const float* X1 = (const float*)(F.ws + WS_X1); unsigned char* H2 = (unsigned char*)(F.ws + WS_H2); const float* Wr = (const float*)(F.ws + WS_WR);
    int* SEL_E = (int*)(F.ws + WS_ROUTE); float* SEL_W = (float*)(F.ws + WS_ROUTE + 256 * 1024); int* SEL_R = (int*)(F.ws + WS_ROUTE + 512 * 1024);
    volatile LAS int* hist = (volatile LAS int*)(F.lds + MOE_OFF + 1024); volatile LAS int* base = (volatile LAS int*)(F.lds + MOE_OFF + 1280);
    int* LIST = (int*)(F.ws + WS_ROUTE + 1024 * 1024);
    LAS float* part = (LAS float*)F.lds;
    LAS float* ssq = (LAS float*)(F.lds + 16384);
    __syncthreads();
    if (F.tid < 32) hist[F.tid] = 0;
    __syncthreads();
    const int mt = w & 1, ks = w >> 1, r = lane & 15, kq = lane >> 4;
    const int grp = lane >> 4, el = lane & 15;
    const float br0 = a.in[I_BROUTER][el], br1 = a.in[I_BROUTER][16 + el];
    for (int tile = F.vcu; tile < T / 32; tile += F.G) {
        const int tb = tile * 32;
        {
            const float* xp = X1 + (size_t)(tb + 16 * mt + r) * D + 512 * ks + 8 * kq;
            const float* bp = Wr + (size_t)(2 * ks) * 8192 + r * 256 + 8 * kq;
            f32x4 acc0 = {0.f, 0.f, 0.f, 0.f}, acc1 = {0.f, 0.f, 0.f, 0.f}; float ss = 0.f;
#pragma unroll 4
            for (int s = 0; s < 16; ++s) {
                const f32x4 xa = *(const f32x4*)(xp + 32 * s), xb = *(const f32x4*)(xp + 32 * s + 4);
                const float* bs = bp + (s >> 3) * 8192 + 32 * (s & 7);
                const f32x4 b00 = *(const f32x4*)bs, b01 = *(const f32x4*)(bs + 4), b10 = *(const f32x4*)(bs + 4096), b11 = *(const f32x4*)(bs + 4096 + 4);
                ss += ((xa.x * xa.x + xa.y * xa.y) + (xa.z * xa.z + xa.w * xa.w)) + ((xb.x * xb.x + xb.y * xb.y) + (xb.z * xb.z + xb.w * xb.w));
#pragma unroll
                for (int i = 0; i < 4; ++i) { acc0 = __builtin_amdgcn_mfma_f32_16x16x4f32(xa[i], b00[i], acc0, 0, 0, 0); acc1 = __builtin_amdgcn_mfma_f32_16x16x4f32(xa[i], b10[i], acc1, 0, 0, 0); }
#pragma unroll
                for (int i = 0; i < 4; ++i) { acc0 = __builtin_amdgcn_mfma_f32_16x16x4f32(xb[i], b01[i], acc0, 0, 0, 0); acc1 = __builtin_amdgcn_mfma_f32_16x16x4f32(xb[i], b11[i], acc1, 0, 0, 0); }
            }
#pragma unroll
            for (int j = 0; j < 4; ++j) { LAS float* pr = part + ((ks * 32 + 16 * mt + 4 * kq + j) * 32); pr[r] = acc0[j]; pr[16 + r] = acc1[j]; }
            ss += __shfl_xor(ss, 16); ss += __shfl_xor(ss, 32);
            if (kq == 0) ssq[ks * 32 + 16 * mt + r] = ss;
        }
        __syncthreads();
        {
            const int tk = 4 * w + grp;
            const float rstd = rsqrtf(((ssq[tk] + ssq[32 + tk]) + (ssq[64 + tk] + ssq[96 + tk])) * (1.f / D) + NORM_EPS);
            const LAS float* pr = part + tk * 32;
            float c0 = ((pr[el] + pr[1024 + el]) + (pr[2048 + el] + pr[3072 + el])) * rstd + br0;
            float c1 = ((pr[16 + el] + pr[1024 + 16 + el]) + (pr[2048 + 16 + el] + pr[3072 + 16 + el])) * rstd + br1;
            float tv[4]; int ti[4];
#pragma unroll
            for (int k = 0; k < 4; ++k) { float bv = c0; int bi = el; if (c1 > c0) { bv = c1; bi = 16 + el; }
#pragma unroll
                for (int o = 1; o < 16; o <<= 1) { const float ov = __shfl_xor(bv, o); const int oi = __shfl_xor(bi, o); if (ov > bv || (ov == bv && oi < bi)) { bv = ov; bi = oi; } }
                tv[k] = bv; ti[k] = bi; if (bi == el) c0 = -3.0e38f; if (bi == 16 + el) c1 = -3.0e38f; }
            const float e1 = __expf(tv[1] - tv[0]), e2 = __expf(tv[2] - tv[0]), e3 = __expf(tv[3] - tv[0]); const float inv = 1.f / (1.f + e1 + e2 + e3);
            if (el < 4) { const int k = el; const float wk = (k == 0 ? 1.f : (k == 1 ? e1 : (k == 2 ? e2 : e3))) * inv; const int ek = (k == 0 ? ti[0] : (k == 1 ? ti[1] : (k == 2 ? ti[2] : ti[3])));
                const int lr = __hip_atomic_fetch_add((LAS int*)&hist[ek], 1, __ATOMIC_RELAXED, __HIP_MEMORY_SCOPE_WORKGROUP);
                SEL_E[(tb + tk) * 4 + k] = ek; SEL_W[(tb + tk) * 4 + k] = wk; SEL_R[(tb + tk) * 4 + k] = lr; }
        }
#pragma unroll
        for (int rr = 0; rr < 4; ++rr) { const int tk = 4 * w + rr;
            const float rstd = rsqrtf(((ssq[tk] + ssq[32 + tk]) + (ssq[64 + tk] + ssq[96 + tk])) * (1.f / D) + NORM_EPS);
            const f32x4* xr = (const f32x4*)(X1 + (size_t)(tb + tk) * D) + lane; unsigned* hr = (unsigned*)(H2 + (size_t)(tb + tk) * D) + lane;
#pragma unroll
            for (int j = 0; j < 8; ++j) { const f32x4 xv = xr[64 * j]; const f32x4 gg = ((const f32x4*)a.in[I_NFG])[64 * j + lane];
                hr[64 * j] = pk4_fp8(xv.x * rstd * gg.x, xv.y * rstd * gg.y, xv.z * rstd * gg.z, xv.w * rstd * gg.w); } }
        __syncthreads();
    }
    if (F.tid < 32) base[F.tid] = (int)__hip_atomic_fetch_add(F.ctl + CW_CNT + F.tid, (unsigned)hist[F.tid], RLX_AGENT);
    __syncthreads();
    for (int tile = F.vcu; tile < T / 32; tile += F.G) {
        if (F.tid < 128) { const int tk = tile * 32 + (F.tid >> 2); const int idx = tk * 4 + (F.tid & 3);
            const int e_ = __hip_atomic_load(SEL_E + idx, RLX_AGENT); const int rk_ = __hip_atomic_load(SEL_R + idx, RLX_AGENT) + base[e_]; SEL_R[idx] = rk_; LIST[e_ * 8192 + rk_] = tk; }
    }
}
__device__ __forceinline__ void moe_tables(const Frame& F, int nct) {
    volatile LAS int* tab = (volatile LAS int*)(F.lds + MOE_OFF);
    __syncthreads();
    if (F.tid == 0) { int run = 0, units = 0;
        for (int e = 0; e < NE; ++e) { const int cnt = (int)__hip_atomic_load(F.ctl + CW_CNT + e, RLX_AGENT); const int nt = (cnt + 255) >> 8;
            tab[e] = units; tab[36 + e] = run * 256; tab[72 + e] = nt > 0 ? nt : 1; tab[108 + e] = cnt; run += nt; units += nt * nct; }
        tab[32] = units; }
    __syncthreads();
}
__device__ __forceinline__ void p12_scatter(const Frame& F) {
    const int gw = F.vcu * 8 + F.wave, NGW = F.G * 8, lane = F.lane;
    const unsigned char* H2 = (const unsigned char*)(F.ws + WS_H2); unsigned char* XS = (unsigned char*)(F.ws + WS_XS);
    const int* SEL_E = (const int*)(F.ws + WS_ROUTE); const int* SEL_R = (const int*)(F.ws + WS_ROUTE + 512 * 1024); int* DEST = (int*)(F.ws + WS_ROUTE + 768 * 1024);
    moe_tables(F, 1);
    volatile LAS int* tab = (volatile LAS int*)(F.lds + MOE_OFF);
    for (int it = gw; it < T * TOPK; it += NGW) {
        const int t = it >> 2; const int e = SEL_E[it], dest = tab[36 + e] + SEL_R[it];
        const v4u* s = (const v4u*)(H2 + (size_t)t * D) + lane; v4u* d = (v4u*)(XS + (size_t)dest * D) + lane;
        d[0] = s[0]; d[64] = s[64];
        if (lane == 0) DEST[it] = dest;
    }
}
__device__ __forceinline__ void p15_combine(const Frame& F, const Args& a) {
    const int gw = F.vcu * 8 + F.wave, NGW = F.G * 8, lane = F.lane;
    const float* X1 = (const float*)(F.ws + WS_X1); const bf16* Y = (const bf16*)(F.ws + WS_Y);
    const float* SEL_W = (const float*)(F.ws + WS_ROUTE + 256 * 1024); const int* SEL_E = (const int*)(F.ws + WS_ROUTE); const int* SEL_R = (const int*)(F.ws + WS_ROUTE + 512 * 1024);
    moe_tables(F, 1);
    volatile LAS int* tab = (volatile LAS int*)(F.lds + MOE_OFF);
    for (int t = gw; t < T; t += NGW) {
        f32x4 v[8];
        const f32x4* xr = (const f32x4*)(X1 + (size_t)t * D) + lane;
#pragma unroll
        for (int j = 0; j < 8; ++j) v[j] = __builtin_nontemporal_load(xr + 64 * j);
#pragma unroll
        for (int k = 0; k < 4; ++k) { const float wk = SEL_W[t * 4 + k]; const v2u* yr = (const v2u*)(Y + (size_t)(tab[36 + SEL_E[t * 4 + k]] + SEL_R[t * 4 + k]) * D) + lane;
#pragma unroll
            for (int j = 0; j < 8; ++j) { const v2u u = __builtin_nontemporal_load(yr + 64 * j); v[j].x += wk * bflo(u.x); v[j].y += wk * bfhi(u.x); v[j].z += wk * bflo(u.y); v[j].w += wk * bfhi(u.y); } }
        float s = 0.f;
#pragma unroll
        for (int j = 0; j < 8; ++j) s += (v[j].x * v[j].x + v[j].y * v[j].y) + (v[j].z * v[j].z + v[j].w * v[j].w);
        const float rstd = rsqrtf(wave_sum(s) * (1.f / D) + NORM_EPS);
        f32x4* o = (f32x4*)(a.out + (size_t)t * D) + lane;
#pragma unroll
        for (int j = 0; j < 8; ++j) { const f32x4 gg = ((const f32x4*)a.in[I_NFINAL])[64 * j + lane]; __builtin_nontemporal_store(v[j] * rstd * gg, o + 64 * j); }
    }
}

__global__ void __launch_bounds__(512, 2) __attribute__((amdgpu_num_sgpr(96))) fwd(Args args) {
    extern __shared__ __attribute__((aligned(16))) unsigned char lds[];
    Frame F;
    F.lds = (LAS unsigned char*)lds; F.ws = args.ws; F.ctl = (unsigned*)(args.ws + WS_CTL);
    F.tid = threadIdx.x; F.lane = F.tid & 63; F.wave = __builtin_amdgcn_readfirstlane(F.tid >> 6);
    F.G = gridDim.x; { const int bx = blockIdx.x; F.vcu = (F.G % 8 == 0) ? (bx % 8) * (F.G / 8) + bx / 8 : bx; }
    for (int u = F.tid; u < (LDS_BYTES - LDSCTL_OFF) / 4; u += 512) ((LAS unsigned*)(F.lds + LDSCTL_OFF))[u] = 0u;
    __syncthreads();
    volatile LAS unsigned* MISC = (volatile LAS unsigned*)(F.lds + MISC_OFF);
#if MK_PER_PHASE
#define GRID_BAR() do { } while (0)
#else
    XcdBarrier bar = xcd_barrier_post(F.ctl + CW_BAR, MISC + 8);
#define GRID_BAR() xcd_barrier(bar)
#endif
    const int lo = args.ph_lo, hi = args.ph_hi;
#define IN(k) (lo <= (k) && (k) < hi)
#define SEAM(k) do { if (IN(k) && IN((k) + 1)) GRID_BAR(); } while (0)
#define DUP(k) (((PROBE_DUP) >> (k)) & 1)
#define PH_BEGIN {
#define PH_END }
    const bf16* P = (const bf16*)(F.ws + WS_P);

    if (IN(0)) { PH_BEGIN  p0_prologue(F, args);  PH_END if (DUP(0)) { GRID_BAR(); PH_BEGIN  p0_prologue(F, args);  PH_END } } SEAM(0);
    if (IN(1)) { PH_BEGIN  p1_gemm_in(F, args);  PH_END if (DUP(1)) { GRID_BAR(); PH_BEGIN  p1_gemm_in(F, args);  PH_END } } SEAM(1);
    if (PROBE_GEMM >= 0 && IN(1)) {
        pg8::Gemm g{(const bf16*)(F.ws + WS_H), (const bf16*)(F.ws + WS_WIN), DP, DP, D, nullptr}; pg8::ProbeOrder S; S.so.init(T, PLD, F.G, (int)blockIdx.x); S.mode = PROBE_GEMM;
        pg8::EpiProbe E{(bf16*)(F.ws + WS_XS)}; pg8::gemm_phase(F.lds, g, S, E); GRID_BAR();
    }
    if (IN(2)) { PH_BEGIN  p2_lora_in(F, args); gla_pass_a(F, args);  PH_END if (DUP(2)) { GRID_BAR(); PH_BEGIN  p2_lora_in(F, args); gla_pass_a(F, args);  PH_END } } SEAM(2);
    if (IN(3)) { PH_BEGIN
        { pg8::Gemm g{(const bf16*)(F.ws + WS_A2), (const bf16*)(F.ws + WS_WLWA), 512, 256, 256, nullptr}; pg8::StaticOrder S; S.init(T, 2048, F.G, (int)blockIdx.x);
          pg8::EpiBf16 E{(bf16*)(F.ws + WS_WAO), 2048, nullptr, 0, 1.f}; pg8::gemm_phase(F.lds, g, S, E); }
        { pg8::Gemm g{(const bf16*)(F.ws + WS_A2) + 256, (const bf16*)(F.ws + WS_WLG), 512, 256, 256, nullptr}; pg8::StaticOrder S; S.init(T, 1024, F.G, (int)blockIdx.x);
          pg8::EpiBf16 E{(bf16*)(F.ws + WS_GO), 1024, nullptr, 0, 1.f}; pg8::gemm_phase(F.lds, g, S, E); }
        gla_pass_b(F);
     PH_END if (DUP(3)) { GRID_BAR(); PH_BEGIN
        { pg8::Gemm g{(const bf16*)(F.ws + WS_A2), (const bf16*)(F.ws + WS_WLWA), 512, 256, 256, nullptr}; pg8::StaticOrder S; S.init(T, 2048, F.G, (int)blockIdx.x);
          pg8::EpiBf16 E{(bf16*)(F.ws + WS_WAO), 2048, nullptr, 0, 1.f}; pg8::gemm_phase(F.lds, g, S, E); }
        { pg8::Gemm g{(const bf16*)(F.ws + WS_A2) + 256, (const bf16*)(F.ws + WS_WLG), 512, 256, 256, nullptr}; pg8::StaticOrder S; S.init(T, 1024, F.G, (int)blockIdx.x);
          pg8::EpiBf16 E{(bf16*)(F.ws + WS_GO), 1024, nullptr, 0, 1.f}; pg8::gemm_phase(F.lds, g, S, E); }
        gla_pass_b(F);
     PH_END } } SEAM(3);
    if (IN(4)) { PH_BEGIN  p4_rwkv_prep(F, args); gla_pass_c(F, args);  PH_END if (DUP(4)) { GRID_BAR(); PH_BEGIN  p4_rwkv_prep(F, args); gla_pass_c(F, args);  PH_END } } SEAM(4);
    if (IN(5)) { PH_BEGIN  p5_rwkv_scan(F, args);  PH_END if (DUP(5)) { GRID_BAR(); PH_BEGIN  p5_rwkv_scan(F, args);  PH_END } } SEAM(5);
    if (IN(6)) { PH_BEGIN  p6_rwkv_post(F, args);  PH_END if (DUP(6)) { GRID_BAR(); PH_BEGIN  p6_rwkv_post(F, args);  PH_END } } SEAM(6);
    if (IN(7)) { PH_BEGIN
        { pg8::Gemm g{(const bf16*)(F.ws + WS_YA), (const bf16*)(F.ws + WS_WBA), RW, RW, RW, nullptr}; pg8::StaticOrder S; S.init(T, D, F.G, (int)blockIdx.x);
          pg8::EpiGate<false> E{(bf16*)(F.ws + WS_MRG), P, args.in[I_BM], C_GATE}; pg8::gemm_phase(F.lds, g, S, E); }
        { pg8::Gemm g{(const bf16*)(F.ws + WS_YB), (const bf16*)(F.ws + WS_WBB), GVW, GVW, GVW, nullptr}; pg8::StaticOrder S; S.init(T, D, F.G, (int)blockIdx.x);
          pg8::EpiGate<true> E{(bf16*)(F.ws + WS_MRG), P, args.in[I_BM] + D, C_GATE + D}; pg8::gemm_phase(F.lds, g, S, E); }
     PH_END if (DUP(7)) { GRID_BAR(); PH_BEGIN
        { pg8::Gemm g{(const bf16*)(F.ws + WS_YA), (const bf16*)(F.ws + WS_WBA), RW, RW, RW, nullptr}; pg8::StaticOrder S; S.init(T, D, F.G, (int)blockIdx.x);
          pg8::EpiGate<false> E{(bf16*)(F.ws + WS_MRG), P, args.in[I_BM], C_GATE}; pg8::gemm_phase(F.lds, g, S, E); }
        { pg8::Gemm g{(const bf16*)(F.ws + WS_YB), (const bf16*)(F.ws + WS_WBB), GVW, GVW, GVW, nullptr}; pg8::StaticOrder S; S.init(T, D, F.G, (int)blockIdx.x);
          pg8::EpiGate<true> E{(bf16*)(F.ws + WS_MRG), P, args.in[I_BM] + D, C_GATE + D}; pg8::gemm_phase(F.lds, g, S, E); }
     PH_END } } SEAM(7);
    if (IN(8)) { PH_BEGIN
        pg8::Gemm g{(const bf16*)(F.ws + WS_MRG), (const bf16*)(F.ws + WS_WOUT), D, D, D, nullptr}; pg8::StaticOrder S; S.init(T, D, F.G, (int)blockIdx.x);
        pg8::EpiResF32 E{(float*)(F.ws + WS_X1), args.in[I_X]}; pg8::gemm_phase(F.lds, g, S, E);
     PH_END if (DUP(8)) { GRID_BAR(); PH_BEGIN
        pg8::Gemm g{(const bf16*)(F.ws + WS_MRG), (const bf16*)(F.ws + WS_WOUT), D, D, D, nullptr}; pg8::StaticOrder S; S.init(T, D, F.G, (int)blockIdx.x);
        pg8::EpiResF32 E{(float*)(F.ws + WS_X1), args.in[I_X]}; pg8::gemm_phase(F.lds, g, S, E);
     PH_END } } SEAM(8);
    if (IN(9)) { PH_BEGIN  p11_router(F, args);  PH_END if (DUP(9)) { GRID_BAR(); PH_BEGIN  p11_router(F, args);  PH_END } } SEAM(9);
    if (IN(10)) { PH_BEGIN
        moe_tables(F, 16);
        pg8::Gemm g{(const bf16*)(F.ws + WS_H2), (const bf16*)(F.ws + WS_WGU), D, D, D, (const int*)(F.ws + WS_ROUTE + 1024 * 1024)};
        pg8::MoeOrder S{(const volatile LAS int*)(F.lds + MOE_OFF), 16, 4096, F.G, F.vcu};
        pg8::EpiGluQ E{(unsigned char*)(F.ws + WS_HH), args.in[I_BGATE], args.in[I_BUP]}; pg8::gemm_phase<pg8::EpiGluQ, pg8::MoeOrder, 1, true>(F.lds, g, S, E);
     PH_END if (DUP(10)) { GRID_BAR(); PH_BEGIN
        moe_tables(F, 16);
        pg8::Gemm g{(const bf16*)(F.ws + WS_H2), (const bf16*)(F.ws + WS_WGU), D, D, D, (const int*)(F.ws + WS_ROUTE + 1024 * 1024)};
        pg8::MoeOrder S{(const volatile LAS int*)(F.lds + MOE_OFF), 16, 4096, F.G, F.vcu};
        pg8::EpiGluQ E{(unsigned char*)(F.ws + WS_HH), args.in[I_BGATE], args.in[I_BUP]}; pg8::gemm_phase<pg8::EpiGluQ, pg8::MoeOrder, 1, true>(F.lds, g, S, E);
     PH_END } } SEAM(10);
    if (IN(11)) { PH_BEGIN
        moe_tables(F, 8);
        pg8::Gemm g{(const bf16*)(F.ws + WS_HH), (const bf16*)(F.ws + WS_WD), FF, FF, FF, nullptr};
        pg8::MoeOrder S{(const volatile LAS int*)(F.lds + MOE_OFF), 8, 2048, F.G, F.vcu};
        pg8::EpiBf16 E{(bf16*)(F.ws + WS_Y), D, args.in[I_BDOWN], D, WQ_INV}; pg8::gemm_phase<pg8::EpiBf16, pg8::MoeOrder, 1>(F.lds, g, S, E);
     PH_END if (DUP(11)) { GRID_BAR(); PH_BEGIN
        moe_tables(F, 8);
        pg8::Gemm g{(const bf16*)(F.ws + WS_HH), (const bf16*)(F.ws + WS_WD), FF, FF, FF, nullptr};
        pg8::MoeOrder S{(const volatile LAS int*)(F.lds + MOE_OFF), 8, 2048, F.G, F.vcu};
        pg8::EpiBf16 E{(bf16*)(F.ws + WS_Y), D, args.in[I_BDOWN], D, WQ_INV}; pg8::gemm_phase<pg8::EpiBf16, pg8::MoeOrder, 1>(F.lds, g, S, E);
     PH_END } } SEAM(11);
    if (IN(12)) { PH_BEGIN  p15_combine(F, args);  PH_END if (DUP(12)) { GRID_BAR(); PH_BEGIN  p15_combine(F, args);  PH_END } }
#undef IN
#undef SEAM
}
constexpr int N_PHASES = 13;

extern "C" void kernel_launch(void* const* d_in, const int* in_sizes, int n_in, void* d_out, int out_size, void* d_ws, size_t ws_size, hipStream_t stream) {
    static int grid = 0;
    if (grid == 0) {
        if (n_in != 31 || in_sizes[0] != T * D || out_size != T * D || ws_size < WS_END) { fprintf(stderr, "kernel_launch: unexpected shapes (n_in %d, ws %zu)\n", n_in, ws_size); grid = -1; return; }
        int dev = 0, cus = 0, per_cu = 0;
        if (hipGetDevice(&dev) != hipSuccess || hipDeviceGetAttribute(&cus, hipDeviceAttributeMultiprocessorCount, dev) != hipSuccess) { grid = -1; return; }
        if (hipFuncSetAttribute((const void*)fwd, hipFuncAttributeMaxDynamicSharedMemorySize, LDS_BYTES) != hipSuccess) { fprintf(stderr, "kernel_launch: hipFuncSetAttribute failed\n"); grid = -1; return; }
        if (hipOccupancyMaxActiveBlocksPerMultiprocessor(&per_cu, (const void*)fwd, 512, LDS_BYTES) != hipSuccess || per_cu < 1) { fprintf(stderr, "kernel_launch: occupancy query says %d\n", per_cu); }
        (void)hipGetLastError();
        grid = cus;
    }
    if (grid < 0) return;
    (void)hipMemsetAsync((char*)d_ws + WS_CTL, 0, CTL_ZERO_BYTES, stream);
    Args a{};
    for (int i = 0; i < 31; ++i) a.in[i] = (const float*)d_in[i];
    a.out = (float*)d_out; a.ws = (unsigned char*)d_ws;
#if MK_PER_PHASE
    for (int p = 0; p < N_PHASES; ++p) { a.ph_lo = p; a.ph_hi = p + 1; hipLaunchKernelGGL(fwd, dim3(grid), dim3(512), LDS_BYTES, stream, a); }
#else
    a.ph_lo = 0; a.ph_hi = N_PHASES;
    hipLaunchKernelGGL(fwd, dim3(grid), dim3(512), LDS_BYTES, stream, a);
#endif
}
```

```cpp
#include <hip/hip_runtime.h>
#include <cstdio>
#include <cstdint>

#ifndef MK_PER_PHASE
#define MK_PER_PHASE 0
#endif

#ifndef PROBE_GEMM
#define PROBE_GEMM -1
#endif
#ifndef PROBE_DUP
#define PROBE_DUP 0
#endif
#define GAS __attribute__((address_space(1)))
#define LAS __attribute__((address_space(3)))
typedef unsigned short bf16;
typedef unsigned v4u __attribute__((ext_vector_type(4)));
typedef unsigned v2u __attribute__((ext_vector_type(2)));
typedef float f32x4 __attribute__((ext_vector_type(4)));
typedef float f32x2 __attribute__((ext_vector_type(2)));
typedef short bf16x8 __attribute__((ext_vector_type(8)));
typedef long i64x2 __attribute__((ext_vector_type(2)));
typedef int v4i __attribute__((ext_vector_type(4)));
typedef int v8i __attribute__((ext_vector_type(8)));
#define RLX_AGENT __ATOMIC_RELAXED, __HIP_MEMORY_SCOPE_AGENT
#define LDS_WAIT() asm volatile("s_waitcnt lgkmcnt(0)" ::: "memory")
#define VM_WAIT() asm volatile("s_waitcnt vmcnt(0)" ::: "memory")

constexpr int D = 2048, BATCH = 4, SEQ = 2048, T = BATCH * SEQ;
constexpr int RW = 1024, RH = 16, RN = 64;
constexpr int DLORA = 96, GLORA = 256;
constexpr int RWKV_COLS = 3 * RW + 2 * DLORA + GLORA;
constexpr int GH = 4, GDK = 128, GDV = 256, GKW = GH * GDK, GVW = GH * GDV, GAL = 16;
constexpr int GLA_COLS = 2 * GKW + 2 * GVW + GAL;
constexpr int IN_COLS = RWKV_COLS + GLA_COLS + 2 * D;
constexpr int PLD = 10752;
constexpr int DP = D + 64;
constexpr int C_R = 0, C_K = 1024, C_V = 2048, C_WL = 3072, C_AL = 3168, C_GL = 3264;
constexpr int C_GQ = 3520, C_GK = 4032, C_GV = 4544, C_OG = 5568, C_GAL = 6592, C_GATE = 6608;
constexpr int NE = 32, TOPK = 4, FF = 2048;
constexpr int XS_ROWS = T * TOPK + NE * 256;
constexpr int CHUNK = 64, NCH = SEQ / CHUNK;
constexpr float NORM_EPS = 1e-5f, GN_EPS = 64e-5f;
constexpr float WQ_SCALE = 64.f, WQ_INV = 1.f / 64.f;

constexpr size_t MiB = 1u << 20;
constexpr size_t WS_CTL = 0, CTL_ZERO_BYTES = 1 * MiB;
constexpr size_t WS_WR = 1 * MiB;
constexpr size_t WS_WLWA = 2 * MiB;
constexpr size_t WS_WLG = 3 * MiB;
constexpr size_t WS_WBA = 4 * MiB, WS_WBB = 8 * MiB;
constexpr size_t WS_WOUT = 12 * MiB;
constexpr size_t WS_WIN = 64 * MiB;
constexpr size_t WS_WGU = 192 * MiB;
constexpr size_t WS_WD = 448 * MiB;
constexpr size_t WS_H = 128 * MiB;
constexpr size_t WS_P = 864 * MiB;
constexpr size_t WS_Y = WS_P;
constexpr size_t WS_A2 = 1032 * MiB;
constexpr size_t WS_WAO = 1040 * MiB;
constexpr size_t WS_GO = 1072 * MiB;
constexpr size_t WS_SCAN = 1088 * MiB;
constexpr size_t WS_BON = 1200 * MiB;
constexpr size_t WS_YRAW = 1280 * MiB;
constexpr size_t WS_GHT = 1312 * MiB;
constexpr size_t WS_GST = 1376 * MiB;
constexpr size_t WS_GDEC = 1408 * MiB;
constexpr size_t WS_GBC = 576 * MiB;
constexpr size_t WS_YA = 1410 * MiB, WS_YB = 1426 * MiB;
constexpr size_t WS_MRG = 1442 * MiB;
constexpr size_t WS_X1 = 1474 * MiB;
constexpr size_t WS_H2 = 832 * MiB;
constexpr size_t WS_ROUTE = 1570 * MiB;
constexpr size_t WS_XS = 1572 * MiB;
constexpr size_t WS_HH = 1732 * MiB;
constexpr size_t WS_END = 1892 * MiB;
constexpr int CW_BAR = 4096;
constexpr int CW_CNT = 16384;
constexpr int CW_CVQ = 20480, CW_CVSTOP = 20544;

constexpr int RING_BYTES = 131072;
constexpr int LDSCTL_OFF = 159744, MISC_OFF = LDSCTL_OFF + 320;
constexpr int MOE_OFF = LDSCTL_OFF + 1024;
constexpr int LDS_BYTES = 163840;

__device__ __forceinline__ unsigned f2bf(float f) { unsigned u = __builtin_bit_cast(unsigned, f); return (u + 0x7fffu + ((u >> 16) & 1u)) >> 16; }
__device__ __forceinline__ unsigned pk2(float lo, float hi) { return f2bf(lo) | (f2bf(hi) << 16); }
__device__ __forceinline__ unsigned pk4_fp8(float a, float b, float c, float d) { int w = 0; w = __builtin_amdgcn_cvt_pk_fp8_f32(a, b, w, false); w = __builtin_amdgcn_cvt_pk_fp8_f32(c, d, w, true); return (unsigned)w; }
__device__ __forceinline__ float bflo(unsigned u) { return __builtin_bit_cast(float, u << 16); }
__device__ __forceinline__ float bfhi(unsigned u) { return __builtin_bit_cast(float, u & 0xffff0000u); }
__device__ __forceinline__ float bf2f(bf16 b) { return __builtin_bit_cast(float, ((unsigned)b) << 16); }
__device__ __forceinline__ float wave_sum(float v) {
#pragma unroll
    for (int o = 1; o < 64; o <<= 1) v += __shfl_xor(v, o);
    return v;
}
__device__ __forceinline__ float sigmoidf_(float x) { return 1.f / (1.f + __expf(-x)); }
__device__ __forceinline__ float softplusf_(float x) { return fmaxf(x, 0.f) + log1pf(__expf(-fabsf(x))); }

namespace pg8 {
constexpr int BM = 256, BK = 64, HALF = 128, HTB = HALF * BK * 2, STAGE_BYTES = 8 * HTB, NXCD = 8, WGM = 8;
__host__ __device__ __forceinline__ int lds_byte(int r, int c) { return r * 128 + (((c >> 3) ^ ((r >> 1) & 7)) << 4) + (c & 7) * 2; }
__host__ __device__ __forceinline__ void stage_rc(int b, int& R, int& C) { R = b >> 7; C = ((((b & 127) >> 4) ^ ((R >> 1) & 7)) << 3); }
__host__ __device__ __forceinline__ int perm32(int rho) { const int n = rho >> 4, i = rho & 15; return 8 * (i >> 2) + 4 * n + (i & 3); }

struct Unit { int rowA, rowB, pn, e, rk0, cnt; };
struct Gemm { const bf16* A; const bf16* Bt; int lda, ldb, K; const int* list; };

struct StaticOrder {
    int nM, nN, nwg, G, c;
    __device__ void init(int M, int N, int G_, int c_) { nM = M / BM; nN = N / BM; nwg = nM * nN; G = G_; c = c_; }
    __device__ bool next(int i, Unit& u) const {
        const long L = (long)i * G + c; if (L >= nwg) return false;
        int wgid = (int)L; { const int q = nwg / NXCD, r = nwg % NXCD, xcd = wgid % NXCD, off = wgid / NXCD; wgid = (xcd < r ? xcd * (q + 1) : r * (q + 1) + (xcd - r) * q) + off; }
        const int nig = WGM * nN, gid = wgid / nig, fm = gid * WGM, gsz = (nM - fm) < WGM ? (nM - fm) : WGM;
        const int pm = fm + ((wgid % nig) % gsz); u.pn = (wgid % nig) / gsz; u.rowA = pm * BM; u.rowB = u.pn * BM; u.e = 0; u.rk0 = 0; u.cnt = 0; return true;
    }
};
struct ProbeOrder {
    StaticOrder so; int mode;
    __device__ bool next(int i, Unit& u) const { if (!so.next(i, u)) return false; u.e = (u.rowA >> 8) * 64 + u.pn; if (mode & 1) u.rowA = 0; if (mode & 2) u.rowB = 0; return true; }
};
struct MoeOrder {
    const volatile LAS int* tab; int nct, rowsB, G, c;
    __device__ bool next(int i, Unit& u) const {
        const int L = i * G + c; const int total = __builtin_amdgcn_readfirstlane(tab[32]); if (L >= total) return false;
        int e = 0;
        for (; e < 31; ++e) { if (L < __builtin_amdgcn_readfirstlane(tab[e + 1])) break; }
        const int local = L - __builtin_amdgcn_readfirstlane(tab[e]); const int nt = __builtin_amdgcn_readfirstlane(tab[72 + e]);
        const int ct = local / nt, rt = local - ct * nt;
        u.rowA = __builtin_amdgcn_readfirstlane(tab[36 + e]) + rt * BM; u.rowB = e * rowsB + ct * BM; u.pn = ct; u.e = e; u.rk0 = rt * BM; u.cnt = __builtin_amdgcn_readfirstlane(tab[108 + e]); return true;
    }
};

__device__ __forceinline__ unsigned cvt_pk_bf16(float lo, float hi) { unsigned r; asm volatile("v_cvt_pk_bf16_f32 %0, %1, %2" : "=v"(r) : "v"(lo), "v"(hi)); return r; }

struct EpiBf16 {
    static constexpr bool PERM = true;
    bf16* O; int ldc; const float* bias; int bias_estride; float scale;
    __device__ __forceinline__ void operator()(const f32x4 (&acc)[2][2][4][2], const Unit& u, int wr, int wc, int fr, int fq) const {
        const int row0 = u.rowA + wr * 64 + fr, col0 = u.pn * BM + wc * 32 + 8 * fq;
        f32x4 bv[2][2];
#pragma unroll
        for (int bj = 0; bj < 2; ++bj)
#pragma unroll
            for (int n = 0; n < 2; ++n) bv[bj][n] = bias ? *(const f32x4*)(bias + (size_t)u.e * bias_estride + col0 + bj * HALF + 4 * n) : (f32x4){0.f, 0.f, 0.f, 0.f};
#pragma unroll
        for (int ai = 0; ai < 2; ++ai)
#pragma unroll
            for (int m = 0; m < 4; ++m) { bf16* rowp = O + (size_t)(row0 + ai * HALF + m * 16) * ldc + col0;
#pragma unroll
                for (int bj = 0; bj < 2; ++bj) { const f32x4 v0 = acc[ai][bj][m][0] * scale + bv[bj][0], v1 = acc[ai][bj][m][1] * scale + bv[bj][1];
                    v4u w; w.x = cvt_pk_bf16(v0[0], v0[1]); w.y = cvt_pk_bf16(v0[2], v0[3]); w.z = cvt_pk_bf16(v1[0], v1[1]); w.w = cvt_pk_bf16(v1[2], v1[3]);
                    *(v4u*)(rowp + bj * HALF) = w; } }
    }
};
struct EpiProbe {
    static constexpr bool PERM = true;
    bf16* O;
    __device__ __forceinline__ void operator()(const f32x4 (&acc)[2][2][4][2], const Unit& u, int wr, int wc, int fr, int fq) const {
        const int pm = u.e >> 6, pn = u.e & 63; const int row0 = pm * BM + wr * 64 + fr, col0 = pn * BM + wc * 32 + 8 * fq;
#pragma unroll
        for (int ai = 0; ai < 2; ++ai)
#pragma unroll
            for (int m = 0; m < 4; ++m) { bf16* rowp = O + (size_t)(row0 + ai * HALF + m * 16) * PLD + col0;
#pragma unroll
                for (int bj = 0; bj < 2; ++bj) { const f32x4 v0 = acc[ai][bj][m][0], v1 = acc[ai][bj][m][1];
                    v4u w; w.x = cvt_pk_bf16(v0[0], v0[1]); w.y = cvt_pk_bf16(v0[2], v0[3]); w.z = cvt_pk_bf16(v1[0], v1[1]); w.w = cvt_pk_bf16(v1[2], v1[3]);
                    *(v4u*)(rowp + bj * HALF) = w; } }
    }
};
template <bool ADD> struct EpiGate {
    static constexpr bool PERM = true;
    bf16* O; const bf16* P; const float* bm; int gcol;
    __device__ __forceinline__ void operator()(const f32x4 (&acc)[2][2][4][2], const Unit& u, int wr, int wc, int fr, int fq) const {
        const int row0 = u.rowA + wr * 64 + fr, col0 = u.pn * BM + wc * 32 + 8 * fq;
        f32x4 bv[2][2];
#pragma unroll
        for (int bj = 0; bj < 2; ++bj)
#pragma unroll
            for (int n = 0; n < 2; ++n) bv[bj][n] = *(const f32x4*)(bm + col0 + bj * HALF + 4 * n);
#pragma unroll
        for (int ai = 0; ai < 2; ++ai)
#pragma unroll
            for (int m = 0; m < 4; ++m) { const size_t row = (size_t)(row0 + ai * HALF + m * 16);
#pragma unroll
                for (int bj = 0; bj < 2; ++bj) {
                    const v4u pg = *(const v4u*)(P + row * PLD + gcol + col0 + bj * HALF);
                    bf16* op = O + row * D + col0 + bj * HALF;
                    float g[8] = {bflo(pg.x), bfhi(pg.x), bflo(pg.y), bfhi(pg.y), bflo(pg.z), bfhi(pg.z), bflo(pg.w), bfhi(pg.w)};
                    float r[8];
#pragma unroll
                    for (int j = 0; j < 4; ++j) { r[j] = sigmoidf_(g[j] + bv[bj][0][j]) * acc[ai][bj][m][0][j]; r[4 + j] = sigmoidf_(g[4 + j] + bv[bj][1][j]) * acc[ai][bj][m][1][j]; }
                    if (ADD) { const v4u pv = *(const v4u*)op;
                        r[0] += bflo(pv.x); r[1] += bfhi(pv.x); r[2] += bflo(pv.y); r[3] += bfhi(pv.y); r[4] += bflo(pv.z); r[5] += bfhi(pv.z); r[6] += bflo(pv.w); r[7] += bfhi(pv.w); }
                    v4u w; w.x = cvt_pk_bf16(r[0], r[1]); w.y = cvt_pk_bf16(r[2], r[3]); w.z = cvt_pk_bf16(r[4], r[5]); w.w = cvt_pk_bf16(r[6], r[7]);
                    *(v4u*)op = w; } }
    }
};
struct EpiResF32 {
    static constexpr bool PERM = false;
    float* O; const float* X;
    __device__ __forceinline__ void operator()(const f32x4 (&acc)[2][2][4][2], const Unit& u, int wr, int wc, int fr, int fq) const {
        const int row0 = u.rowA + wr * 64 + fr, col0 = u.pn * BM + wc * 32 + 4 * fq;
#pragma unroll
        for (int ai = 0; ai < 2; ++ai)
#pragma unroll
            for (int m = 0; m < 4; ++m) { const size_t ro = (size_t)(row0 + ai * HALF + m * 16) * D + col0;
#pragma unroll
                for (int bj = 0; bj < 2; ++bj)
#pragma unroll
                    for (int n = 0; n < 2; ++n) *(f32x4*)(O + ro + bj * HALF + n * 16) = acc[ai][bj][m][n] + __builtin_nontemporal_load((const f32x4*)(X + ro + bj * HALF + n * 16)); }
    }
};
struct EpiGlu {
    static constexpr bool PERM = true;
    bf16* O; const float* bg; const float* bu;
    __device__ __forceinline__ void operator()(const f32x4 (&acc)[2][2][4][2], const Unit& u, int wr, int wc, int fr, int fq) const {
        const int row0 = u.rowA + wr * 64 + fr, col0 = u.pn * HALF + wc * 32 + 8 * fq;
        f32x4 gb[2], ub[2];
#pragma unroll
        for (int n = 0; n < 2; ++n) { gb[n] = *(const f32x4*)(bg + (size_t)u.e * FF + col0 + 4 * n); ub[n] = *(const f32x4*)(bu + (size_t)u.e * FF + col0 + 4 * n); }
#pragma unroll
        for (int ai = 0; ai < 2; ++ai)
#pragma unroll
            for (int m = 0; m < 4; ++m) { bf16* op = O + (size_t)(row0 + ai * HALF + m * 16) * FF + col0;
                float r[8];
#pragma unroll
                for (int n = 0; n < 2; ++n)
#pragma unroll
                    for (int j = 0; j < 4; ++j) { float g = fminf(acc[ai][0][m][n][j] + gb[n][j], 7.f); float up = fminf(fmaxf(acc[ai][1][m][n][j] + ub[n][j], -7.f), 7.f);
                        r[4 * n + j] = (up + 1.f) * g * sigmoidf_(1.702f * g); }
                v4u w; w.x = cvt_pk_bf16(r[0], r[1]); w.y = cvt_pk_bf16(r[2], r[3]); w.z = cvt_pk_bf16(r[4], r[5]); w.w = cvt_pk_bf16(r[6], r[7]);
                *(v4u*)op = w; }
    }
};

struct EpiGluQ {
    static constexpr bool PERM = true;
    unsigned char* O; const float* bg; const float* bu;
    __device__ __forceinline__ void operator()(const f32x4 (&acc)[2][2][4][2], const Unit& u, int wr, int wc, int fr, int fq) const {
        const int row0 = u.rowA + wr * 64 + fr, col0 = u.pn * HALF + wc * 32 + 8 * fq;
        f32x4 gb[2], ub[2];
#pragma unroll
        for (int n = 0; n < 2; ++n) { gb[n] = *(const f32x4*)(bg + (size_t)u.e * FF + col0 + 4 * n); ub[n] = *(const f32x4*)(bu + (size_t)u.e * FF + col0 + 4 * n); }
#pragma unroll
        for (int ai = 0; ai < 2; ++ai)
#pragma unroll
            for (int m = 0; m < 4; ++m) { unsigned char* op = O + (size_t)(row0 + ai * HALF + m * 16) * FF + col0;
                float r[8];
#pragma unroll
                for (int n = 0; n < 2; ++n)
#pragma unroll
                    for (int j = 0; j < 4; ++j) { float g = fminf(acc[ai][0][m][n][j] * WQ_INV + gb[n][j], 7.f); float up = fminf(fmaxf(acc[ai][1][m][n][j] * WQ_INV + ub[n][j], -7.f), 7.f);
                        r[4 * n + j] = (up + 1.f) * g * sigmoidf_(1.702f * g); }
                v2u w; w.x = pk4_fp8(r[0], r[1], r[2], r[3]); w.y = pk4_fp8(r[4], r[5], r[6], r[7]);
                *(v2u*)op = w; }
    }
};

template <class Epi, class Sched, int ESZ = 2, bool GATHER = false, bool ALIGN_EPI = true>
__device__ __forceinline__ void gemm_phase(LAS unsigned char* lds, const Gemm g, const Sched& S, const Epi& E) {
    const int tid = threadIdx.x, wid = __builtin_amdgcn_readfirstlane(tid >> 6), lane = tid & 63, wr = wid >> 2, wc = wid & 3, fr = lane & 15, fq = lane >> 4;
    const int K = g.K, nt = K * ESZ / (BK * 2);
    unsigned voffA[2], voffB[2]; int Rst[2], Cst[2];
#pragma unroll
    for (int i = 0; i < 2; ++i) { int R, C; stage_rc(tid * 16 + i * 8192, R, C); const int Rb = Epi::PERM ? ((R & ~31) + perm32(R & 31)) : R; Rst[i] = R; Cst[i] = C * 2;
        voffA[i] = (unsigned)(R * g.lda * ESZ + C * 2); voffB[i] = (unsigned)(Rb * g.ldb * ESZ + C * 2); }
    const size_t kstep = (size_t)(BK * 2);
    const size_t hstepA = (size_t)HALF * g.lda * ESZ, hstepB = (size_t)HALF * g.ldb * ESZ;
    const unsigned ldsw = (unsigned)wid * 1024u;
    const int aoff = lds_byte(wr * 64 + fr, fq * 8), boff = lds_byte(wc * 32 + fr, fq * 8);
#define PG8_SA(b, h) (((b) * 2 + (h)) * HTB)
#define PG8_SB(b, h) ((4 + (b) * 2 + (h)) * HTB)
#define PG8_STAGE(bufoff, gbase, voff) do { _Pragma("unroll") for (int _i = 0; _i < 2; ++_i) \
        __builtin_amdgcn_global_load_lds((const unsigned*)((const char*)(gbase) + (voff)[_i]), (LAS unsigned*)(lds + (bufoff) + ldsw + _i * 8192), 16, 0, 0); } while (0)
#define PG8_GOFF(u_, v_) do { _Pragma("unroll") for (int h_ = 0; h_ < 2; ++h_) _Pragma("unroll") for (int i_ = 0; i_ < 2; ++i_) { const int rk_ = (u_).rk0 + 128 * h_ + Rst[i_]; \
        const int tok_ = rk_ < (u_).cnt ? g.list[(u_).e * 8192 + rk_] : 0; (v_)[h_][i_] = (unsigned)tok_ * (unsigned)(g.lda * ESZ) + (unsigned)Cst[i_]; } } while (0)
#define PG8_STAGE_A(bufoff, isnext, tt, h) do { if constexpr (GATHER) { unsigned vo_[2] = {(isnext) ? vN[h][0] : vA[h][0], (isnext) ? vN[h][1] : vA[h][1]}; PG8_STAGE(bufoff, (const char*)g.A + (size_t)(tt) * kstep, vo_); } \
        else PG8_STAGE(bufoff, ((isnext) ? nA : cA) + (size_t)(tt) * kstep + (size_t)(h) * hstepA, voffA); } while (0)
#define PG8_LD16(off_) (*(const LAS v4i*)(lds + (off_)))
#define PG8_LDA(dst, b, h) do { if constexpr (ESZ == 2) { _Pragma("unroll") for (int m = 0; m < 4; ++m) _Pragma("unroll") for (int k = 0; k < 2; ++k) dst[m][k] = *(const LAS bf16x8*)(lds + PG8_SA(b, h) + (k ? (aoff ^ 64) : aoff) + m * 2048); } \
        else { _Pragma("unroll") for (int m = 0; m < 4; ++m) dst##8[m] = __builtin_shufflevector(PG8_LD16(PG8_SA(b, h) + aoff + m * 2048), PG8_LD16(PG8_SA(b, h) + (aoff ^ 64) + m * 2048), 0, 1, 2, 3, 4, 5, 6, 7); } } while (0)
#define PG8_LDB(dst, b, h) do { if constexpr (ESZ == 2) { _Pragma("unroll") for (int n = 0; n < 2; ++n) _Pragma("unroll") for (int k = 0; k < 2; ++k) dst[n][k] = *(const LAS bf16x8*)(lds + PG8_SB(b, h) + (k ? (boff ^ 64) : boff) + n * 2048); } \
        else { _Pragma("unroll") for (int n = 0; n < 2; ++n) dst##8[n] = __builtin_shufflevector(PG8_LD16(PG8_SB(b, h) + boff + n * 2048), PG8_LD16(PG8_SB(b, h) + (boff ^ 64) + n * 2048), 0, 1, 2, 3, 4, 5, 6, 7); } } while (0)
#define PG8_MMA(ai, bj, At, Bt) do { __builtin_amdgcn_s_setprio(1); _Pragma("unroll") for (int m = 0; m < 4; ++m) _Pragma("unroll") for (int n = 0; n < 2; ++n) { \
        if constexpr (ESZ == 2) { _Pragma("unroll") for (int k = 0; k < 2; ++k) acc[ai][bj][m][n] = __builtin_amdgcn_mfma_f32_16x16x32_bf16(Bt[n][k], At[m][k], acc[ai][bj][m][n], 0, 0, 0); } \
        else asm volatile("s_nop 1\n\tv_mfma_scale_f32_16x16x128_f8f6f4 %0, %1, %2, %0, %3, %3 op_sel_hi:[0,0,0]" : "+v"(acc[ai][bj][m][n]) : "v"(Bt##8[n]), "v"(At##8[m]), "v"(one_scale)); } \
        __builtin_amdgcn_s_setprio(0); } while (0)
#define PG8_WAIT_V(n) asm volatile("s_waitcnt vmcnt(" #n ")" ::: "memory")
#define PG8_WAIT_L(n) asm volatile("s_waitcnt lgkmcnt(" #n ")" ::: "memory")
#define PG8_BAR __builtin_amdgcn_s_barrier()
#define PG8_SCHED __builtin_amdgcn_sched_barrier(0)
    Unit cur, nxt; int ui = 0;
    if (!S.next(0, cur)) return;
    f32x4 acc[2][2][4][2];
#pragma unroll
    for (int a = 0; a < 2; ++a)
#pragma unroll
        for (int b = 0; b < 2; ++b)
#pragma unroll
            for (int m = 0; m < 4; ++m)
#pragma unroll
                for (int n = 0; n < 2; ++n) acc[a][b][m][n] = (f32x4){0.f, 0.f, 0.f, 0.f};
    const int one_scale = 0x7F7F7F7F;
    bf16x8 At[4][2], B0[2][2], B1[2][2]; v8i At8[4], B08[2], B18[2];
    const char* cA = (const char*)g.A + (size_t)cur.rowA * g.lda * ESZ; const char* cB = (const char*)g.Bt + (size_t)cur.rowB * g.ldb * ESZ;
    unsigned vA[2][2] = {{0u, 0u}, {0u, 0u}}, vN[2][2] = {{0u, 0u}, {0u, 0u}}; const char* nA = cA;
    if constexpr (GATHER) PG8_GOFF(cur, vA);
    PG8_STAGE(PG8_SB(0, 0), cB, voffB); PG8_STAGE(PG8_SB(0, 1), cB + hstepB, voffB); PG8_STAGE_A(PG8_SA(0, 0), false, 0, 0); PG8_STAGE_A(PG8_SA(0, 1), false, 0, 1);
    if (wr == 1) PG8_BAR;
    PG8_WAIT_V(2); PG8_BAR;
    PG8_STAGE(PG8_SB(1, 0), cB + kstep, voffB); PG8_STAGE_A(PG8_SA(1, 0), false, 1, 0); PG8_STAGE(PG8_SB(1, 1), cB + hstepB + kstep, voffB);
    PG8_WAIT_V(6); PG8_BAR;
    for (;;) {
        const bool has_next = S.next(ui + 1, nxt);
        nA = has_next ? (const char*)g.A + (size_t)nxt.rowA * g.lda * ESZ : cA; const char* nB = has_next ? (const char*)g.Bt + (size_t)nxt.rowB * g.ldb * ESZ : cB;
        if constexpr (GATHER) { if (has_next) PG8_GOFF(nxt, vN); else { vN[0][0] = vA[0][0]; vN[0][1] = vA[0][1]; vN[1][0] = vA[1][0]; vN[1][1] = vA[1][1]; } }
        for (int t = 0; t < nt; t += 2) {
            const bool last = (t == nt - 2);
            const char* b2 = last ? nB : cB + (size_t)(t + 2) * kstep; const char* b3 = b2 + kstep;
            const int t2 = last ? 0 : t + 2, t3 = last ? 1 : t + 3;
            PG8_LDB(B0, 0, 0); PG8_LDB(B1, 0, 1); PG8_SCHED; PG8_LDA(At, 0, 0); PG8_STAGE_A(PG8_SA(1, 1), false, t + 1, 1);
            PG8_WAIT_V(8); PG8_WAIT_L(0); PG8_BAR; PG8_MMA(0, 0, At, B0); PG8_MMA(0, 1, At, B1); PG8_BAR; PG8_SCHED;
            PG8_LDA(At, 0, 1); PG8_STAGE(PG8_SB(0, 0), b2, voffB); PG8_STAGE(PG8_SB(0, 1), b2 + hstepB, voffB); PG8_STAGE_A(PG8_SA(0, 0), last, t2, 0);
            PG8_WAIT_V(8); PG8_WAIT_L(0); PG8_BAR; PG8_MMA(1, 0, At, B0); PG8_MMA(1, 1, At, B1); PG8_BAR; PG8_SCHED;
            PG8_LDB(B0, 1, 0); PG8_LDB(B1, 1, 1); PG8_SCHED; PG8_LDA(At, 1, 0); PG8_STAGE_A(PG8_SA(0, 1), last, t2, 1);
            PG8_WAIT_V(8); PG8_WAIT_L(0); PG8_BAR; PG8_MMA(0, 0, At, B0); PG8_MMA(0, 1, At, B1); PG8_BAR; PG8_SCHED;
            PG8_LDA(At, 1, 1); PG8_STAGE(PG8_SB(1, 0), b3, voffB); PG8_STAGE(PG8_SB(1, 1), b3 + hstepB, voffB); PG8_STAGE_A(PG8_SA(1, 0), last, t3, 0);
            PG8_WAIT_V(8); PG8_WAIT_L(0); PG8_BAR; PG8_MMA(1, 0, At, B0); PG8_MMA(1, 1, At, B1); PG8_BAR; PG8_SCHED;
        }
        if constexpr (ESZ == 1) asm volatile("s_nop 15\n\ts_nop 15" ::: "memory");
        if constexpr (ALIGN_EPI) { if (wr == 0) PG8_BAR; }
        E(acc, cur, wr, wc, fr, fq);
        if (!has_next) break;
#pragma unroll
        for (int a = 0; a < 2; ++a)
#pragma unroll
            for (int b = 0; b < 2; ++b)
#pragma unroll
                for (int m = 0; m < 4; ++m)
#pragma unroll
                    for (int n = 0; n < 2; ++n) acc[a][b][m][n] = (f32x4){0.f, 0.f, 0.f, 0.f};
        cur = nxt; cA = nA; cB = nB; ++ui;
        if constexpr (GATHER) { vA[0][0] = vN[0][0]; vA[0][1] = vN[0][1]; vA[1][0] = vN[1][0]; vA[1][1] = vN[1][1]; }
        if constexpr (ALIGN_EPI) { if (wr == 1) PG8_BAR; }
    }
    PG8_WAIT_V(0);
    if constexpr (!ALIGN_EPI) { if (wr == 0) PG8_BAR; }
    PG8_BAR;
#undef PG8_SA
#undef PG8_SB
#undef PG8_STAGE
#undef PG8_LDA
#undef PG8_LD16
#undef PG8_GOFF
#undef PG8_STAGE_A
#undef PG8_LDB
#undef PG8_MMA
#undef PG8_WAIT_V
#undef PG8_WAIT_L
#undef PG8_BAR
#undef PG8_SCHED
}

typedef short s16x4 __attribute__((ext_vector_type(4)));
struct UnitF { int rowA, pn, e; const float* b0; const float* b1; };
struct GemmF { const bf16* A; int lda, K, ldbn; };
struct MoeOrderF {
    const volatile LAS int* tab; int nct, G, c; const float* w0; const float* w1; size_t estride; int cstep;
    __device__ bool next(int i, UnitF& u) const {
        const int L = i * G + c; const int total = __builtin_amdgcn_readfirstlane(tab[32]); if (L >= total) return false;
        int e = 0;
        for (; e < 31; ++e) { if (L < __builtin_amdgcn_readfirstlane(tab[e + 1])) break; }
        const int local = L - __builtin_amdgcn_readfirstlane(tab[e]); const int nt = __builtin_amdgcn_readfirstlane(tab[72 + e]);
        const int ct = local / nt, rt = local - ct * nt;
        u.rowA = __builtin_amdgcn_readfirstlane(tab[36 + e]) + rt * BM; u.pn = ct; u.e = e;
        u.b0 = w0 + (size_t)e * estride + (size_t)ct * cstep; u.b1 = w1 + (size_t)e * estride + (size_t)ct * cstep; return true;
    }
};
struct EpiGluNP {
    bf16* O; const float* bg; const float* bu;
    __device__ __forceinline__ void operator()(const f32x4 (&acc)[2][2][4][2], const UnitF& u, int wr, int wc, int fr, int fq) const {
        const int row0 = u.rowA + wr * 64 + fr, col0 = u.pn * HALF + wc * 32 + 4 * fq;
        f32x4 gb[2], ub[2];
#pragma unroll
        for (int n = 0; n < 2; ++n) { gb[n] = *(const f32x4*)(bg + (size_t)u.e * FF + col0 + 16 * n); ub[n] = *(const f32x4*)(bu + (size_t)u.e * FF + col0 + 16 * n); }
#pragma unroll
        for (int ai = 0; ai < 2; ++ai)
#pragma unroll
            for (int m = 0; m < 4; ++m) { bf16* op = O + (size_t)(row0 + ai * HALF + m * 16) * FF + col0;
#pragma unroll
                for (int n = 0; n < 2; ++n) { float r[4];
#pragma unroll
                    for (int j = 0; j < 4; ++j) { const float gg = fminf(acc[ai][0][m][n][j] + gb[n][j], 7.f); const float up = fminf(fmaxf(acc[ai][1][m][n][j] + ub[n][j], -7.f), 7.f);
                        r[j] = (up + 1.f) * gg * sigmoidf_(1.702f * gg); }
                    v2u w; w.x = cvt_pk_bf16(r[0], r[1]); w.y = cvt_pk_bf16(r[2], r[3]); *(v2u*)(op + 16 * n) = w; } }
    }
};
struct EpiBf16NP {
    bf16* O; int ldc; const float* bias; int bias_estride;
    __device__ __forceinline__ void operator()(const f32x4 (&acc)[2][2][4][2], const UnitF& u, int wr, int wc, int fr, int fq) const {
        const int row0 = u.rowA + wr * 64 + fr, col0 = u.pn * BM + wc * 32 + 4 * fq;
        f32x4 bv[2][2];
#pragma unroll
        for (int bj = 0; bj < 2; ++bj)
#pragma unroll
            for (int n = 0; n < 2; ++n) bv[bj][n] = *(const f32x4*)(bias + (size_t)u.e * bias_estride + col0 + bj * HALF + 16 * n);
#pragma unroll
        for (int ai = 0; ai < 2; ++ai)
#pragma unroll
            for (int m = 0; m < 4; ++m) { bf16* rowp = O + (size_t)(row0 + ai * HALF + m * 16) * ldc + col0;
#pragma unroll
                for (int bj = 0; bj < 2; ++bj)
#pragma unroll
                    for (int n = 0; n < 2; ++n) { const f32x4 v = acc[ai][bj][m][n] + bv[bj][n]; v2u w; w.x = cvt_pk_bf16(v[0], v[1]); w.y = cvt_pk_bf16(v[2], v[3]); *(v2u*)(rowp + bj * HALF + 16 * n) = w; } }
    }
};
template <class Epi, class Sched>
__device__ __forceinline__ void gemm_phase_f32b(LAS unsigned char* lds, const GemmF g, const Sched& S, const Epi& E) {
    const int tid = threadIdx.x, wid = __builtin_amdgcn_readfirstlane(tid >> 6), lane = tid & 63, wr = wid >> 2, wc = wid & 3, fr = lane & 15, fq = lane >> 4;
    const int K = g.K, nt = K / BK;
    unsigned voffA[2];
#pragma unroll
    for (int i = 0; i < 2; ++i) { int R, C; stage_rc(tid * 16 + i * 8192, R, C); voffA[i] = (unsigned)(R * g.lda + C) * 2u; }
    const size_t kstep = (size_t)(BK * 2);
    const size_t hstepA = (size_t)HALF * g.lda * 2;
    const unsigned ldsw = (unsigned)wid * 1024u;
    const int aoff = lds_byte(wr * 64 + fr, fq * 8);
    const int ldsb = (int)(uintptr_t)lds;
    const int q4 = (lane & 15) >> 2, p4 = lane & 3;
    const int fsw = q4 | ((fq & 1) << 2);
    int rbase[2];
#pragma unroll
    for (int n = 0; n < 2; ++n) rbase[n] = (8 * fq + q4) * 256 + ((((wc * 2) ^ fsw) ^ n) * 32) + 8 * p4;
    const int hB = wid >> 2, r0 = 2 * (wid & 3) + (lane >> 5), l31 = lane & 31;
    const int wslot = (l31 >> 2) ^ (r0 & 3);
    const int wb0 = hB * HTB + r0 * 256 + wslot * 32 + (lane & 3) * 8, wb1 = hB * HTB + r0 * 256 + (wslot ^ 4) * 32 + (lane & 3) * 8;
    const unsigned laneoffB = (unsigned)(r0 * g.ldbn + 4 * l31) * 4u;
    const size_t rstep8 = (size_t)8 * g.ldbn * 4, tstepB = (size_t)64 * g.ldbn * 4;
#define PG8_SA(b, h) (((b) * 2 + (h)) * HTB)
#define PG8_SB(b, h) ((4 + (b) * 2 + (h)) * HTB)
#define PG8_STAGE(bufoff, gbase, voff) do { _Pragma("unroll") for (int _i = 0; _i < 2; ++_i) { unsigned keep_; \
        asm volatile("s_mov_b32 %0, m0\n\ts_mov_b32 m0, %2\n\ts_nop 0\n\tglobal_load_lds_dwordx4 %1, off\n\ts_mov_b32 m0, %0" : "=&s"(keep_) \
            : "v"((const char*)(gbase) + (voff)[_i]), "s"(__builtin_amdgcn_readfirstlane(ldsb + (bufoff) + (int)ldsw + _i * 8192)) : "memory"); } } while (0)
#define PG8_LDA(dst, b, h) do { _Pragma("unroll") for (int m = 0; m < 4; ++m) _Pragma("unroll") for (int k = 0; k < 2; ++k) dst[m][k] = *(const LAS bf16x8*)(lds + PG8_SA(b, h) + (k ? (aoff ^ 64) : aoff) + m * 2048); } while (0)
#define PG8_LDBT(dst, b, h) do { _Pragma("unroll") for (int n = 0; n < 2; ++n) _Pragma("unroll") for (int k = 0; k < 2; ++k) { \
        const s16x4 lo_ = __builtin_amdgcn_ds_read_tr16_b64_v4i16((LAS s16x4*)(lds + PG8_SB(b, h) + rbase[n] + k * 8192)); \
        const s16x4 hi_ = __builtin_amdgcn_ds_read_tr16_b64_v4i16((LAS s16x4*)(lds + PG8_SB(b, h) + rbase[n] + k * 8192 + 1024)); \
        dst[n][k] = __builtin_shufflevector(lo_, hi_, 0, 1, 2, 3, 4, 5, 6, 7); } } while (0)
#define PG8_BPTR(p0, p1, tt) ((const char*)(hB ? (p1) : (p0)) + (size_t)(tt) * tstepB)
#define PG8_LOADB1(pb, i) dreg[i] = *(const f32x4*)((pb) + (size_t)(i) * rstep8 + laneoffB)
#define PG8_LOADB(p0, p1, tt) do { const char* pb_ = PG8_BPTR(p0, p1, tt); _Pragma("unroll") for (int _i = 0; _i < 8; ++_i) PG8_LOADB1(pb_, _i); } while (0)
#define PG8_WRITEB1(b, i) do { v2u pk_; pk_.x = cvt_pk_bf16(dreg[i].x, dreg[i].y); pk_.y = cvt_pk_bf16(dreg[i].z, dreg[i].w); \
        *(LAS v2u*)(lds + PG8_SB(b, 0) + (((i) & 1) ? wb1 : wb0) + (i) * 2048) = pk_; } while (0)
#define PG8_WRITEB(b) do { _Pragma("unroll") for (int _i = 0; _i < 8; ++_i) PG8_WRITEB1(b, _i); } while (0)
#define PG8_MF(ai, bj, m, At, Bt) do { _Pragma("unroll") for (int n = 0; n < 2; ++n) _Pragma("unroll") for (int k = 0; k < 2; ++k) \
        acc[ai][bj][m][n] = __builtin_amdgcn_mfma_f32_16x16x32_bf16(Bt[n][k], At[m][k], acc[ai][bj][m][n], 0, 0, 0); } while (0)
#define PG8_MMA(ai, bj, At, Bt) do { __builtin_amdgcn_s_setprio(1); _Pragma("unroll") for (int m = 0; m < 4; ++m) PG8_MF(ai, bj, m, At, Bt); __builtin_amdgcn_s_setprio(0); } while (0)
#define PG8_MMA_CVT(ai, bj, At, Bt, b) do { __builtin_amdgcn_s_setprio(1); _Pragma("unroll") for (int m = 0; m < 4; ++m) { PG8_MF(ai, bj, m, At, Bt); PG8_WRITEB1(b, 2 * m); PG8_WRITEB1(b, 2 * m + 1); PG8_SCHED; } __builtin_amdgcn_s_setprio(0); } while (0)
#define PG8_MMA_LD(ai, bj, At, Bt, pb) do { __builtin_amdgcn_s_setprio(1); _Pragma("unroll") for (int m = 0; m < 4; ++m) { PG8_MF(ai, bj, m, At, Bt); PG8_LOADB1(pb, 2 * m); PG8_LOADB1(pb, 2 * m + 1); PG8_SCHED; } __builtin_amdgcn_s_setprio(0); } while (0)
#define PG8_WAIT_V(n) asm volatile("s_waitcnt vmcnt(" #n ")" ::: "memory")
#define PG8_WAIT_L(n) asm volatile("s_waitcnt lgkmcnt(" #n ")" ::: "memory")
#define PG8_BAR __builtin_amdgcn_s_barrier()
#define PG8_SCHED __builtin_amdgcn_sched_barrier(0)
#define PG8_BS0(T) ((T) >= nt ? nb0 : cur.b0)
#define PG8_BS1(T) ((T) >= nt ? nb1 : cur.b1)
#define PG8_BT(T) ((T) >= nt ? (T) - nt : (T))
    UnitF cur, nxt; int ui = 0;
    if (!S.next(0, cur)) return;
    f32x4 acc[2][2][4][2];
#pragma unroll
    for (int a = 0; a < 2; ++a)
#pragma unroll
        for (int b = 0; b < 2; ++b)
#pragma unroll
            for (int m = 0; m < 4; ++m)
#pragma unroll
                for (int n = 0; n < 2; ++n) acc[a][b][m][n] = (f32x4){0.f, 0.f, 0.f, 0.f};
    bf16x8 At[4][2], B0[2][2], B1[2][2];
    f32x4 dreg[8];
    const char* cA = (const char*)g.A + (size_t)cur.rowA * g.lda * 2;
    PG8_STAGE(PG8_SA(0, 0), cA, voffA); PG8_STAGE(PG8_SA(0, 1), cA + hstepA, voffA); PG8_STAGE(PG8_SA(1, 0), cA + kstep, voffA);
    PG8_LOADB(cur.b0, cur.b1, 0); PG8_WRITEB(0); PG8_LOADB(cur.b0, cur.b1, 1); PG8_WRITEB(1); PG8_LOADB(cur.b0, cur.b1, 2);
    PG8_WAIT_V(8); PG8_WAIT_L(0);
    if (wr == 1) PG8_BAR;
    PG8_BAR;
    for (;;) {
        const bool has_next = S.next(ui + 1, nxt);
        const char* nA = has_next ? (const char*)g.A + (size_t)nxt.rowA * g.lda * 2 : cA;
        const float* nb0 = has_next ? nxt.b0 : cur.b0; const float* nb1 = has_next ? nxt.b1 : cur.b1;
        for (int t = 0; t < nt; t += 2) {
            const bool last = (t == nt - 2);
            const char* a1 = cA + (size_t)(t + 1) * kstep;
            const char* a2 = last ? nA : cA + (size_t)(t + 2) * kstep;
            const char* a3 = a2 + kstep;
            const char* pb3 = PG8_BPTR(PG8_BS0(t + 3), PG8_BS1(t + 3), PG8_BT(t + 3));
            const char* pb4 = PG8_BPTR(PG8_BS0(t + 4), PG8_BS1(t + 4), PG8_BT(t + 4));
            PG8_LDBT(B0, 0, 0); PG8_LDBT(B1, 0, 1); PG8_SCHED; PG8_LDA(At, 0, 0); PG8_STAGE(PG8_SA(1, 1), a1 + hstepA, voffA);
            PG8_WAIT_V(12); PG8_WAIT_L(0); PG8_SCHED; PG8_BAR; PG8_MMA(0, 0, At, B0); PG8_MMA(0, 1, At, B1); PG8_BAR; PG8_SCHED;
            PG8_LDA(At, 0, 1);
            PG8_WAIT_V(10); PG8_WAIT_L(0); PG8_SCHED; PG8_BAR; PG8_MMA_CVT(1, 0, At, B0, 0); PG8_STAGE(PG8_SA(0, 0), a2, voffA); PG8_MMA_LD(1, 1, At, B1, pb3); PG8_BAR; PG8_SCHED;
            PG8_LDBT(B0, 1, 0); PG8_LDBT(B1, 1, 1); PG8_SCHED; PG8_LDA(At, 1, 0); PG8_STAGE(PG8_SA(0, 1), a2 + hstepA, voffA);
            PG8_WAIT_V(12); PG8_WAIT_L(0); PG8_SCHED; PG8_BAR; PG8_MMA(0, 0, At, B0); PG8_MMA(0, 1, At, B1); PG8_BAR; PG8_SCHED;
            PG8_LDA(At, 1, 1);
            PG8_WAIT_V(10); PG8_WAIT_L(0); PG8_SCHED; PG8_BAR; PG8_MMA_CVT(1, 0, At, B0, 1); PG8_STAGE(PG8_SA(1, 0), a3, voffA); PG8_MMA_LD(1, 1, At, B1, pb4); PG8_BAR; PG8_SCHED;
        }
        if (wr == 0) PG8_BAR;
        E(acc, cur, wr, wc, fr, fq);
        if (!has_next) break;
#pragma unroll
        for (int a = 0; a < 2; ++a)
#pragma unroll
            for (int b = 0; b < 2; ++b)
#pragma unroll
                for (int m = 0; m < 4; ++m)
#pragma unroll
                    for (int n = 0; n < 2; ++n) acc[a][b][m][n] = (f32x4){0.f, 0.f, 0.f, 0.f};
        cur = nxt; cA = nA; ++ui;
        if (wr == 1) PG8_BAR;
    }
    PG8_WAIT_V(0);
    asm volatile("" :: "v"(dreg[0]), "v"(dreg[7]));
    PG8_BAR;
#undef PG8_SA
#undef PG8_SB
#undef PG8_STAGE
#undef PG8_LDA
#undef PG8_LDBT
#undef PG8_BPTR
#undef PG8_LOADB1
#undef PG8_LOADB
#undef PG8_WRITEB1
#undef PG8_WRITEB
#undef PG8_MF
#undef PG8_MMA
#undef PG8_MMA_CVT
#undef PG8_MMA_LD
#undef PG8_WAIT_V
#undef PG8_WAIT_L
#undef PG8_BAR
#undef PG8_SCHED
#undef PG8_BS0
#undef PG8_BS1
#undef PG8_BT
}
}

#define XB_TMO      128
#define XB_XCNT(j)  (256  + 64 * (j))
#define XB_XSUB(j)  (1280 + 64 * (j))
#define XB_XGEN(j)  (2304 + 64 * (j))
#define XB_TOP      3328
#define XB_TOPGEN   3392
#define XCD_BAR_WORDS 3456
#define XB_SPIN_CAP (1u << 18)
__device__ __forceinline__ unsigned xb_ld(unsigned* p)              { return __hip_atomic_load(p, __ATOMIC_RELAXED, __HIP_MEMORY_SCOPE_AGENT); }
__device__ __forceinline__ unsigned xb_add(unsigned* p, unsigned v) { return __hip_atomic_fetch_add(p, v, __ATOMIC_RELAXED, __HIP_MEMORY_SCOPE_AGENT); }
__device__ __forceinline__ unsigned xb_xcc_id() { return (unsigned)__builtin_amdgcn_s_getreg((3 << 11) | 20) & 0xFu; }
#define XB_SPIN(cond, bar) do { unsigned _sp = 0; while (cond) { __builtin_amdgcn_s_sleep(1); \
    if ((++_sp & 255u) == 0u) { if (xb_ld(&(bar)[XB_TMO])) break; if (_sp > XB_SPIN_CAP) { atomicAdd(&(bar)[XB_TMO], 1u); break; } } } } while (0)
struct XcdBarrier { unsigned* bar; unsigned x; volatile LAS unsigned* st; };
__device__ __forceinline__ XcdBarrier xcd_barrier_post(unsigned* bar, volatile LAS unsigned* st) {
    XcdBarrier b; b.bar = bar; b.x = xb_xcc_id(); b.st = st;
    if (threadIdx.x == 0) (void)xb_add(&bar[XB_XCNT(b.x)], 1u);
    return b;
}
__device__ __forceinline__ void xcd_barrier_complete(unsigned* bar, unsigned x, unsigned& nloc, unsigned& nx) {
    const unsigned G = gridDim.x * gridDim.y * gridDim.z;
    unsigned sum, cnt, mine, sp = 0u;
    for (;;) {
        sum = 0u; cnt = 0u; mine = 0u;
#pragma unroll
        for (unsigned j = 0; j < 16; ++j) { const unsigned c = xb_ld(&bar[XB_XCNT(j)]); sum += c; cnt += (c > 0u) ? 1u : 0u; mine = (j == x) ? c : mine; }
        if (sum == G) break;
        __builtin_amdgcn_s_sleep(1);
        if ((++sp & 255u) == 0u) { if (xb_ld(&bar[XB_TMO])) break; if (sp > XB_SPIN_CAP) { atomicAdd(&bar[XB_TMO], 1u); break; } }
    }
    nloc = mine > 0u ? mine : 1u; nx = cnt > 0u ? cnt : 1u;
}
__device__ __forceinline__ void xcd_barrier(const XcdBarrier& b) {
    asm volatile("s_waitcnt vmcnt(0)" ::: "memory");
    __syncthreads();
    if (threadIdx.x == 0) {
        unsigned* bar = b.bar;
        __builtin_amdgcn_s_waitcnt(0);
        unsigned nloc = b.st[0], nx = b.st[1];
        if (nloc == 0u) { xcd_barrier_complete(bar, b.x, nloc, nx); b.st[0] = nloc; b.st[1] = nx; }
        const unsigned old = xb_add(&bar[XB_XSUB(b.x)], 1u);
        const unsigned gen = old / nloc;
        if (old + 1u == (gen + 1u) * nloc) {
            __builtin_amdgcn_fence(__ATOMIC_RELEASE, "agent");
            asm volatile("s_waitcnt vmcnt(0)" ::: "memory");
            const unsigned og = xb_add(&bar[XB_TOP], 1u);
            const unsigned tg = og / nx;
            if (og + 1u == (tg + 1u) * nx) xb_add(&bar[XB_TOPGEN], 1u);
            else XB_SPIN(xb_ld(&bar[XB_TOPGEN]) == tg, bar);
            __builtin_amdgcn_fence(__ATOMIC_ACQUIRE, "agent");
            xb_add(&bar[XB_XGEN(b.x)], 1u);
            asm volatile("s_waitcnt vmcnt(0)" ::: "memory");
        } else {
            XB_SPIN(xb_ld(&bar[XB_XGEN(b.x)]) == gen, bar);
            __builtin_amdgcn_fence(__ATOMIC_ACQUIRE, "agent");
            asm volatile("s_waitcnt vmcnt(0)" ::: "memory");
        }
    }
    __syncthreads();
}

struct Args { const float* in[31]; float* out; unsigned char* ws; int ph_lo, ph_hi; };
enum { I_X = 0, I_NMG, I_WIN, I_MU, I_W0, I_W2, I_A0, I_A2, I_G2, I_KK, I_KA, I_RK, I_LNG, I_LNB, I_GWA2, I_GBA, I_GNG, I_BM, I_WBR, I_WBG, I_WOUT, I_NFG,
       I_WROUTER, I_BROUTER, I_WGATE, I_BGATE, I_WUP, I_BUP, I_WDOWN, I_BDOWN, I_NFINAL };
struct Frame {
    LAS unsigned char* lds; unsigned char* ws; unsigned* ctl;
    int tid, lane, wave, vcu, G;
};

__device__ __forceinline__ void tr_item(const float* W, int ldw, int nvalid, int k0, int n0, bf16* dst, int ldk, LAS float* scr, int lane) {
    const int c = lane & 31;
    const bool ok = (n0 + c) < nvalid;
#pragma unroll 8
    for (int i = 0; i < 32; ++i) { const int kk = 2 * i + (lane >> 5); scr[kk * 33 + c] = ok ? W[(size_t)(k0 + kk) * ldw + n0 + c] : 0.f; }
    LDS_WAIT(); asm volatile("" ::: "memory");
    const int c8 = lane & 7;
#pragma unroll
    for (int j = 0; j < 4; ++j) { const int n = (lane >> 3) + 8 * j; const LAS float* s = scr + (8 * c8) * 33 + n;
        v4u o; o.x = pk2(s[0 * 33], s[1 * 33]); o.y = pk2(s[2 * 33], s[3 * 33]); o.z = pk2(s[4 * 33], s[5 * 33]); o.w = pk2(s[6 * 33], s[7 * 33]);
        *(v4u*)(dst + (size_t)n * ldk + k0 + 8 * c8) = o; }
    LDS_WAIT(); asm volatile("" ::: "memory");
}
__device__ __forceinline__ void cv_load(const float* W, int ldw, int k0, int n0, int lane, f32x4 (&cr)[16]) {
    const unsigned laneoff = (unsigned)((lane >> 3) * ldw + n0 + 4 * (lane & 7)) * 4u;
#pragma unroll
    for (int i = 0; i < 16; ++i) { const char* rowp = (const char*)W + (size_t)(k0 + 8 * i) * ldw * 4; cr[i] = *(const f32x4*)(rowp + laneoff); }
}
__device__ __forceinline__ void cv_finish(const f32x4 (&cr)[16], int k0, unsigned char* dst, int ldk, LAS float* scr, int lane, float scale) {
    const int rr = lane >> 3, ch = lane & 7;
#pragma unroll
    for (int i = 0; i < 16; ++i) { LAS float* d = scr + (8 * i + rr) * 33 + 4 * ch; d[0] = cr[i].x * scale; d[1] = cr[i].y * scale; d[2] = cr[i].z * scale; d[3] = cr[i].w * scale; }
    LDS_WAIT(); asm volatile("" ::: "memory");
#pragma unroll
    for (int j = 0; j < 4; ++j) { const int n = rr + 8 * j; const LAS float* sp = scr + (16 * ch) * 33 + n;
        v4u o; o.x = pk4_fp8(sp[0 * 33], sp[1 * 33], sp[2 * 33], sp[3 * 33]); o.y = pk4_fp8(sp[4 * 33], sp[5 * 33], sp[6 * 33], sp[7 * 33]);
        o.z = pk4_fp8(sp[8 * 33], sp[9 * 33], sp[10 * 33], sp[11 * 33]); o.w = pk4_fp8(sp[12 * 33], sp[13 * 33], sp[14 * 33], sp[15 * 33]);
        *(v4u*)(dst + (size_t)n * ldk + k0 + 16 * ch) = o; }
    LDS_WAIT(); asm volatile("" ::: "memory");
}
__device__ __forceinline__ void cv_issue_dma(const float* W, int ldw, int k0, int n0, int lane, LAS float* scr) {
#pragma unroll
    for (int i = 0; i < 16; ++i) { const char* rowp = (const char*)W + (size_t)(k0 + 8 * i) * ldw * 4;
        const unsigned off = (unsigned)((lane >> 3) * ldw + n0 + 4 * ((lane & 7) ^ (i >> 1))) * 4u;
        __builtin_amdgcn_global_load_lds((const unsigned*)(rowp + off), (LAS unsigned*)(scr + i * 256), 16, 0, 2); }
}
__device__ __forceinline__ void cv_finish_dma(int k0, unsigned char* dst, int ldk, const LAS float* scr, int lane, float scale) {
    const int rr = lane >> 3, ch = lane & 7;
#pragma unroll
    for (int j = 0; j < 4; ++j) { const int n = rr + 8 * j; const LAS float* sp = scr + (16 * ch) * 32 + ((((n >> 2) ^ ch) << 2) | (n & 3));
        float f[16];
#pragma unroll
        for (int i = 0; i < 16; ++i) f[i] = sp[i * 32] * scale;
        v4u o; o.x = pk4_fp8(f[0], f[1], f[2], f[3]); o.y = pk4_fp8(f[4], f[5], f[6], f[7]); o.z = pk4_fp8(f[8], f[9], f[10], f[11]); o.w = pk4_fp8(f[12], f[13], f[14], f[15]);
        *(v4u*)(dst + (size_t)n * ldk + k0 + 16 * ch) = o; }
}
__device__ __forceinline__ void cvb_finish_dma(int k0, bf16* dst, int ldk, const LAS float* scr, int lane) {
    const int rr = lane >> 3, ch = lane & 7;
#pragma unroll
    for (int j = 0; j < 4; ++j) { const int n = rr + 8 * j; const LAS float* sp = scr + (16 * ch) * 32 + ((((n >> 2) ^ ch) << 2) | (n & 3));
        float f[16];
#pragma unroll
        for (int i = 0; i < 16; ++i) f[i] = sp[i * 32];
        v4u o0, o1; o0.x = pk2(f[0], f[1]); o0.y = pk2(f[2], f[3]); o0.z = pk2(f[4], f[5]); o0.w = pk2(f[6], f[7]); o1.x = pk2(f[8], f[9]); o1.y = pk2(f[10], f[11]); o1.z = pk2(f[12], f[13]); o1.w = pk2(f[14], f[15]);
        bf16* d = dst + (size_t)n * ldk + k0 + 16 * ch; *(v4u*)d = o0; *(v4u*)(d + 8) = o1; }
}
__device__ __forceinline__ void cvr_load(const float* W, int ldw, int k0, int n0, int lane, f32x4 (&cr)[16]) {
    const unsigned laneoff = (unsigned)((16 * (lane >> 3)) * ldw + n0 + 4 * (lane & 7)) * 4u;
#pragma unroll
    for (int i = 0; i < 16; ++i) { const char* rowp = (const char*)W + (size_t)(k0 + i) * ldw * 4; cr[i] = __builtin_nontemporal_load((const f32x4*)(rowp + laneoff)); }
}
__device__ __forceinline__ void cvr_store(const f32x4 (&cr)[16], int k0, unsigned char* dst, int ldk, int lane, float scale) {
    unsigned char* d = dst + (size_t)(4 * (lane & 7)) * ldk + k0 + 16 * (lane >> 3);
#pragma unroll
    for (int j = 0; j < 4; ++j) { v4u o;
        o.x = pk4_fp8(cr[0][j] * scale, cr[1][j] * scale, cr[2][j] * scale, cr[3][j] * scale); o.y = pk4_fp8(cr[4][j] * scale, cr[5][j] * scale, cr[6][j] * scale, cr[7][j] * scale);
        o.z = pk4_fp8(cr[8][j] * scale, cr[9][j] * scale, cr[10][j] * scale, cr[11][j] * scale); o.w = pk4_fp8(cr[12][j] * scale, cr[13][j] * scale, cr[14][j] * scale, cr[15][j] * scale);
        __builtin_nontemporal_store(o, (v4u*)(d + (size_t)j * ldk)); }
}
struct CvItem { const float* W; unsigned char* dst; int ldw, ldk, k0, n0; };
__device__ __forceinline__ CvItem cv_item(const Args& a, unsigned char* ws, int idx) {
    constexpr int I_EXP = (D / 128) * (FF / 32);
    int r = idx; const int mat = r / (NE * I_EXP); r -= mat * (NE * I_EXP); const int e = r / I_EXP; r -= e * I_EXP;
    const int kb = r / (FF / 32), nb = r % (FF / 32), n0 = 32 * nb;
    CvItem it; it.k0 = 128 * kb; it.n0 = n0;
    if (mat == 0) { it.W = a.in[I_WGATE] + (size_t)e * D * FF; it.ldw = FF; it.dst = ws + WS_WGU + ((size_t)e * 4096 + (n0 >> 7) * 256 + (n0 & 127)) * D; it.ldk = D; }
    else if (mat == 1) { it.W = a.in[I_WUP] + (size_t)e * D * FF; it.ldw = FF; it.dst = ws + WS_WGU + ((size_t)e * 4096 + (n0 >> 7) * 256 + 128 + (n0 & 127)) * D; it.ldk = D; }
    else { it.W = a.in[I_WDOWN] + (size_t)e * FF * D; it.ldw = D; it.dst = ws + WS_WD + ((size_t)e * 2048 + n0) * FF; it.ldk = FF; }
    return it;
}
constexpr int CV_ITEMS = 3 * NE * (D / 128) * (FF / 32);
constexpr int CVQ_CH = 4, CVQ_NCH = CV_ITEMS / CVQ_CH;
__device__ __forceinline__ unsigned cvq_issue(unsigned* q, int lane) { unsigned c = 0; if (lane == 0) c = __hip_atomic_fetch_add(q, 1u, RLX_AGENT); return c; }
__device__ __forceinline__ void rms_row_to_bf16(const float* xrow, const float* g, bf16* orow, int lane) {
    const f32x4* xr = (const f32x4*)xrow + lane; const f32x4* gr = (const f32x4*)g + lane;
    f32x4 v[8]; float s = 0.f;
#pragma unroll
    for (int j = 0; j < 8; ++j) { v[j] = __builtin_nontemporal_load(xr + 64 * j); s += (v[j].x * v[j].x + v[j].y * v[j].y) + (v[j].z * v[j].z + v[j].w * v[j].w); }
    const float rstd = rsqrtf(wave_sum(s) * (1.f / D) + NORM_EPS);
    v2u* o8 = (v2u*)orow + lane;
#pragma unroll
    for (int j = 0; j < 8; ++j) { const f32x4 gg = gr[64 * j]; v2u o; o.x = pk2(v[j].x * rstd * gg.x, v[j].y * rstd * gg.y); o.y = pk2(v[j].z * rstd * gg.z, v[j].w * rstd * gg.w); o8[64 * j] = o; }
}
__device__ __forceinline__ void p0_prologue(const Frame& F, const Args& a) {
    LAS float* scr = (LAS float*)(F.lds + F.wave * 16896);
    const int gw = F.vcu * 8 + F.wave, NGW = F.G * 8;
    bf16* Wt_in = (bf16*)(F.ws + WS_WIN); bf16* Wt_ba = (bf16*)(F.ws + WS_WBA); bf16* Wt_bb = (bf16*)(F.ws + WS_WBB); bf16* Wt_out = (bf16*)(F.ws + WS_WOUT);
    constexpr int NB_IN = PLD / 32;
    constexpr int I_IN = (D / 64) * NB_IN, I_BA = (RW / 64) * (D / 32), I_BB = I_BA, I_OUT = (D / 64) * (D / 32);
    constexpr int NITEMS = I_IN + I_BA + I_BB + I_OUT;
    {
        constexpr int NBF = IN_COLS / 32;
        constexpr int J_IN = (D / 128) * NBF, J_BA = (RW / 128) * (D / 32), J_BB = J_BA, J_OUT = (D / 128) * (D / 32), NJ = J_IN + J_BA + J_BB + J_OUT;
        LAS float* t2 = (LAS float*)(F.lds + F.wave * 16384);
        for (int it = gw; it < NJ; it += NGW) {
            const float* W = nullptr; int ldw = 0, k0 = 0, n0 = 0, ldk = 0; bf16* dst = nullptr; int r = it;
            if (r < J_IN) { const int kb = r / NBF, nb = r % NBF; W = a.in[I_WIN]; ldw = IN_COLS; k0 = 128 * kb; n0 = 32 * nb; dst = Wt_in + (size_t)n0 * DP; ldk = DP; }
            else if ((r -= J_IN) < J_BA) { const int kb = r / (D / 32), nb = r % (D / 32); W = a.in[I_WBR]; ldw = D; k0 = 128 * kb; n0 = 32 * nb; dst = Wt_ba + (size_t)n0 * RW; ldk = RW; }
            else if ((r -= J_BA) < J_BB) { const int kb = r / (D / 32), nb = r % (D / 32); W = a.in[I_WBG]; ldw = D; k0 = 128 * kb; n0 = 32 * nb; dst = Wt_bb + (size_t)n0 * GVW; ldk = GVW; }
            else { r -= J_BB; const int kb = r / (D / 32), nb = r % (D / 32); W = a.in[I_WOUT]; ldw = D; k0 = 128 * kb; n0 = 32 * nb; dst = Wt_out + (size_t)n0 * D; ldk = D; }
            cv_issue_dma(W, ldw, k0, n0, F.lane, t2);
            asm volatile("s_waitcnt vmcnt(0)" ::: "memory");
            cvb_finish_dma(k0, dst, ldk, t2, F.lane); asm volatile("s_waitcnt lgkmcnt(0)" ::: "memory");
        }
        __syncthreads();
        for (int it = gw; it < (D / 64) * 2; it += NGW) { const int kb = it >> 1, nb = NBF + (it & 1); tr_item(a.in[I_WIN], IN_COLS, IN_COLS, 64 * kb, 32 * nb, Wt_in + (size_t)(32 * nb) * DP, DP, scr, F.lane); }
    }
    bf16* Hh = (bf16*)(F.ws + WS_H);
    for (int m = gw; m < T; m += NGW) rms_row_to_bf16(a.in[I_X] + (size_t)m * D, a.in[I_NMG], Hh + (size_t)m * DP, F.lane);
    const int gt = F.vcu * 512 + F.tid, NGT = F.G * 512;
    bf16* Wl_wa = (bf16*)(F.ws + WS_WLWA); bf16* Wl_g = (bf16*)(F.ws + WS_WLG);
    for (int i = gt; i < 2048 * 256; i += NGT) { const int n = i >> 8, k = i & 255; float v = 0.f;
        if (n < 1024) { if (k < DLORA) v = a.in[I_W2][(size_t)k * RW + n]; } else { if (k >= DLORA && k < 2 * DLORA) v = a.in[I_A2][(size_t)(k - DLORA) * RW + (n - 1024)]; }
        Wl_wa[i] = (bf16)f2bf(v); }
    for (int i = gt; i < 1024 * 256; i += NGT) { const int n = i >> 8, k = i & 255; Wl_g[i] = (bf16)f2bf(a.in[I_G2][(size_t)k * RW + n]); }
    float* Wr = (float*)(F.ws + WS_WR);
    for (int i = gt; i < 8 * 32 * 64 * 4; i += NGT) { const int ii = i & 3, l = (i >> 2) & 63, e = (i >> 8) & 31, j = i >> 13; const int k = 256 * j + 4 * l + ii;
        Wr[i] = a.in[I_NFG][k] * a.in[I_WROUTER][(size_t)k * NE + e]; }
}

__device__ __forceinline__ void cv_queue_run(const Frame& F, const Args& a, unsigned* stop) {
    unsigned* q = F.ctl + CW_CVQ; const int lane = F.lane;
    f32x4 ca[16], cb[16];
    int cur = __builtin_amdgcn_readfirstlane((int)cvq_issue(q, lane)); unsigned nraw = cvq_issue(q, lane); int pos = 0; bool stopped = false;
#define CVQ_NEXT(idx) do { if (pos == CVQ_CH) { cur = __builtin_amdgcn_readfirstlane((int)nraw); pos = 0; \
        if (stop && !stopped && __hip_atomic_load(stop, RLX_AGENT) != 0u) stopped = true; \
        nraw = stopped ? 0x7fffffffu : cvq_issue(q, lane); } \
        idx = cur < CVQ_NCH ? cur * CVQ_CH + pos++ : -1; } while (0)
    int xa, xb; CvItem ia, ib;
    CVQ_NEXT(xa); if (xa < 0) return;
    ia = cv_item(a, F.ws, xa); cvr_load(ia.W, ia.ldw, ia.k0, ia.n0, lane, ca);
    CVQ_NEXT(xb); ib = ia; if (xb >= 0) { ib = cv_item(a, F.ws, xb); cvr_load(ib.W, ib.ldw, ib.k0, ib.n0, lane, cb); }
    while (xa >= 0) {
        cvr_store(ca, ia.k0, ia.dst, ia.ldk, lane, WQ_SCALE);
        xa = -1; if (xb >= 0) { CVQ_NEXT(xa); if (xa >= 0) { ia = cv_item(a, F.ws, xa); cvr_load(ia.W, ia.ldw, ia.k0, ia.n0, lane, ca); } }
        if (xb >= 0) { cvr_store(cb, ib.k0, ib.dst, ib.ldk, lane, WQ_SCALE);
            xb = -1; if (xa >= 0) { CVQ_NEXT(xb); if (xb >= 0) { ib = cv_item(a, F.ws, xb); cvr_load(ib.W, ib.ldw, ib.k0, ib.n0, lane, cb); } } }
    }
#undef CVQ_NEXT
}
constexpr int CVW_SH = 3;
__device__ __forceinline__ void p1_gemm_in(const Frame& F, const Args& a) {
    const bool split = (F.G == 256);
    const int bx = (int)blockIdx.x, grp = bx >> 3;
    if (split && (grp & ((1 << CVW_SH) - 1)) == (1 << CVW_SH) - 1) { cv_queue_run(F, a, F.ctl + CW_CVSTOP); return; }
    pg8::Gemm g{(const bf16*)(F.ws + WS_H), (const bf16*)(F.ws + WS_WIN), DP, DP, D, nullptr}; pg8::StaticOrder S;
    if (split) S.init(T, PLD, 256 - (256 >> CVW_SH), (grp - (grp >> CVW_SH)) * 8 + (bx & 7)); else S.init(T, PLD, F.G, bx);
    pg8::EpiBf16 E{(bf16*)(F.ws + WS_P), PLD, nullptr, 0, 1.f};
    pg8::gemm_phase(F.lds, g, S, E);
    if (F.tid == 0) __hip_atomic_fetch_add(F.ctl + CW_CVSTOP, 1u, RLX_AGENT);
}
__device__ __forceinline__ void p2_lora_in(const Frame& F, const Args& a) {
    const int gw = F.vcu * 8 + F.wave, NGW = F.G * 8, lane = F.lane;
    const bf16* P = (const bf16*)(F.ws + WS_P); bf16* A2 = (bf16*)(F.ws + WS_A2);
    const int kind = lane < 12 ? 0 : (lane < 24 ? 1 : (lane < 32 ? 2 : 3));
    const int src = lane < 24 ? (C_WL + 8 * lane) : (C_GL + 8 * (lane - 32));
    float mu[8];
    if (kind != 2) {
#pragma unroll
        for (int j = 0; j < 8; ++j) mu[j] = a.in[I_MU][src + j];
    }
    for (int t = gw; t < T; t += NGW) {
        v4u o = {0u, 0u, 0u, 0u};
        if (kind != 2) {
            const v4u c = *(const v4u*)(P + (size_t)t * PLD + src);
            v4u pv = {0u, 0u, 0u, 0u};
            if ((t & (SEQ - 1)) != 0) pv = *(const v4u*)(P + (size_t)(t - 1) * PLD + src);
            float x[8] = {bflo(c.x), bfhi(c.x), bflo(c.y), bfhi(c.y), bflo(c.z), bfhi(c.z), bflo(c.w), bfhi(c.w)};
            float q[8] = {bflo(pv.x), bfhi(pv.x), bflo(pv.y), bfhi(pv.y), bflo(pv.z), bfhi(pv.z), bflo(pv.w), bfhi(pv.w)};
#pragma unroll
            for (int j = 0; j < 8; ++j) { float m = x[j] + (q[j] - x[j]) * mu[j]; x[j] = kind == 0 ? tanhf(m) : (kind == 1 ? m : sigmoidf_(m)); }
            o.x = pk2(x[0], x[1]); o.y = pk2(x[2], x[3]); o.z = pk2(x[4], x[5]); o.w = pk2(x[6], x[7]);
        }
        *(v4u*)(A2 + (size_t)t * 512 + 8 * lane) = o;
    }
}

#define DPPF(x, ctrl) __builtin_bit_cast(float, __builtin_amdgcn_update_dpp(0, __builtin_bit_cast(int, (x)), (ctrl), 0xF, 0xF, false))
__device__ __forceinline__ float dpp_sum16(float x) { x += DPPF(x, 0xB1); x += DPPF(x, 0x4E); x += DPPF(x, 0x141); x += DPPF(x, 0x140); return x; }
__device__ __forceinline__ float wave_sum_dpp(float x) {
    x = dpp_sum16(x); const int xi = __builtin_bit_cast(int, x);
    return (__builtin_bit_cast(float, __builtin_amdgcn_readlane(xi, 0)) + __builtin_bit_cast(float, __builtin_amdgcn_readlane(xi, 16))) +
           (__builtin_bit_cast(float, __builtin_amdgcn_readlane(xi, 32)) + __builtin_bit_cast(float, __builtin_amdgcn_readlane(xi, 48)));
}
__device__ __forceinline__ float quad_sum(float x) { x += DPPF(x, 0xB1); x += DPPF(x, 0x4E); return x; }
__device__ __forceinline__ void unpack8(const v4u u, float (&f)[8]) { f[0] = bflo(u.x); f[1] = bfhi(u.x); f[2] = bflo(u.y); f[3] = bfhi(u.y); f[4] = bflo(u.z); f[5] = bfhi(u.z); f[6] = bflo(u.w); f[7] = bfhi(u.w); }
__device__ __forceinline__ v4u pack8(const float (&f)[8]) { v4u u; u.x = pk2(f[0], f[1]); u.y = pk2(f[2], f[3]); u.z = pk2(f[4], f[5]); u.w = pk2(f[6], f[7]); return u; }
__device__ __forceinline__ void p4_rwkv_prep(const Frame& F, const Args& a) {
    const int gw = F.vcu * 8 + F.wave, NGW = F.G * 8, lane = F.lane;
    const bf16* P = (const bf16*)(F.ws + WS_P); const bf16* WA = (const bf16*)(F.ws + WS_WAO); bf16* SC = (bf16*)(F.ws + WS_SCAN); float* BON = (float*)(F.ws + WS_BON);
    const int h = lane >> 2, q = lane & 3, c0 = h * RN + 16 * q;
    for (int t = gw; t < T; t += NGW) {
        const bool first = (t & (SEQ - 1)) == 0;
        const bf16* pr = P + (size_t)t * PLD + c0; const bf16* pp = first ? pr : pr - PLD;
        v4u ur[2], uk[2], uv[2], ur1[2], uk1[2], uv1[2], uw[2], ua[2];
#pragma unroll
        for (int j = 0; j < 2; ++j) { ur[j] = *(const v4u*)(pr + C_R + 8 * j); uk[j] = *(const v4u*)(pr + C_K + 8 * j); uv[j] = *(const v4u*)(pr + C_V + 8 * j);
            ur1[j] = *(const v4u*)(pp + C_R + 8 * j); uk1[j] = *(const v4u*)(pp + C_K + 8 * j); uv1[j] = *(const v4u*)(pp + C_V + 8 * j);
            uw[j] = __builtin_nontemporal_load((const v4u*)(WA + (size_t)t * 2048 + c0 + 8 * j)); ua[j] = __builtin_nontemporal_load((const v4u*)(WA + (size_t)t * 2048 + 1024 + c0 + 8 * j)); }
        float r[2][8], k[2][8], v[2][8], kk[2][8], dec[2][8], aa[2][8];
        float n2 = 0.f;
#pragma unroll
        for (int j = 0; j < 2; ++j) { float x[8], x1[8], wv[8], av[8];
            unpack8(ur[j], x); unpack8(ur1[j], x1);
#pragma unroll
            for (int i = 0; i < 8; ++i) { const float m = a.in[I_MU][C_R + c0 + 8 * j + i]; r[j][i] = x[i] + ((first ? 0.f : x1[i]) - x[i]) * m; }
            unpack8(uk[j], x); unpack8(uk1[j], x1);
#pragma unroll
            for (int i = 0; i < 8; ++i) { const float m = a.in[I_MU][C_K + c0 + 8 * j + i]; k[j][i] = x[i] + ((first ? 0.f : x1[i]) - x[i]) * m; }
            unpack8(uv[j], x); unpack8(uv1[j], x1);
#pragma unroll
            for (int i = 0; i < 8; ++i) { const float m = a.in[I_MU][C_V + c0 + 8 * j + i]; v[j][i] = x[i] + ((first ? 0.f : x1[i]) - x[i]) * m; }
            unpack8(uw[j], wv); unpack8(ua[j], av);
#pragma unroll
            for (int i = 0; i < 8; ++i) { const int c = c0 + 8 * j + i;
                dec[j][i] = __expf(-0.60653066f * sigmoidf_(a.in[I_W0][c] + wv[i]));
                aa[j][i] = sigmoidf_(a.in[I_A0][c] + av[i]);
                const float kq = k[j][i] * a.in[I_KK][c]; kk[j][i] = kq; n2 += kq * kq; } }
        n2 = quad_sum(n2);
        const float inv = rsqrtf(fmaxf(n2, 1e-24f));
        float bon = 0.f; float o0[2][8], o2[2][8], o3[2][8];
#pragma unroll
        for (int j = 0; j < 2; ++j)
#pragma unroll
            for (int i = 0; i < 8; ++i) { const int c = c0 + 8 * j + i; const float kn = kk[j][i] * inv; const float kf = k[j][i] * (1.f + (aa[j][i] - 1.f) * a.in[I_KA][c]);
                o0[j][i] = -kn; o2[j][i] = kn * aa[j][i]; o3[j][i] = kf; bon += r[j][i] * kf * a.in[I_RK][c]; }
        bon = quad_sum(bon);
        const int bh = (t >> 11) * RH + h, ts = t & (SEQ - 1);
        bf16* o = SC + ((size_t)(bh * SEQ + ts) * 6) * 64 + 16 * q;
#pragma unroll
        for (int j = 0; j < 2; ++j) { *(v4u*)(o + 8 * j) = pack8(o0[j]); *(v4u*)(o + 64 + 8 * j) = pack8(dec[j]); *(v4u*)(o + 128 + 8 * j) = pack8(o2[j]);
            *(v4u*)(o + 192 + 8 * j) = pack8(o3[j]); *(v4u*)(o + 256 + 8 * j) = pack8(r[j]); *(v4u*)(o + 320 + 8 * j) = pack8(v[j]); }
        if (q == 0) BON[(size_t)t * RH + h] = bon;
    }
}
__device__ __forceinline__ void p5_rwkv_scan(const Frame& F, const Args& a) {
    constexpr int TB = 16, NBLK = SEQ / TB, STF = 384, BLKF = TB * STF;
    const bf16* SC = (const bf16*)(F.ws + WS_SCAN); float* YR = (float*)(F.ws + WS_YRAW);
    LAS float* buf = (LAS float*)F.lds;
    volatile LAS int* hs = (volatile LAS int*)(F.lds + MOE_OFF + 2048);
    const int lane = F.lane;
    for (int u = F.vcu; u < 256; u += F.G) {
        const int bh = u >> 2, vg = u & 3, b = bh >> 4, h = bh & 15;
        const int role = F.wave < 4 ? 0 : (F.wave == 4 ? 1 : 2);
        const int cw = F.wave - 5;
        const bf16* src = SC + (size_t)bh * SEQ * STF;
        const int rl = lane >> 4, kq = lane & 15, row = 16 * vg + 4 * F.wave + rl;
        __syncthreads();
        if (F.tid < 8) hs[F.tid] = 0;
        __syncthreads();
#define HS_WAIT(cond) do { unsigned sp_ = 0; while (!(cond)) { __builtin_amdgcn_s_sleep(1); if (++sp_ > (1u << 24)) break; } asm volatile("" ::: "memory"); } while (0)
        if (role == 1) {
            v4u xb[12];
            { const v4u* s4 = (const v4u*)src;
#pragma unroll
              for (int i = 0; i < 12; ++i) xb[i] = s4[lane + 64 * i]; }
            for (int m = 0; m < NBLK; ++m) {
                if (m >= 4) HS_WAIT(hs[1] >= m - 3 && hs[2] >= m - 3 && hs[3] >= m - 3 && hs[4] >= m - 3);
                LAS f32x4* d4 = (LAS f32x4*)(buf + (m & 3) * BLKF);
#pragma unroll
                for (int i = 0; i < 12; ++i) { const int c = lane + 64 * i;
                    d4[2 * c] = (f32x4){bflo(xb[i].x), bfhi(xb[i].x), bflo(xb[i].y), bfhi(xb[i].y)}; d4[2 * c + 1] = (f32x4){bflo(xb[i].z), bfhi(xb[i].z), bflo(xb[i].w), bfhi(xb[i].w)}; }
                asm volatile("s_waitcnt lgkmcnt(0)" ::: "memory");
                if (lane == 0) hs[0] = m + 1;
                if (m + 1 < NBLK) { const v4u* s4 = (const v4u*)(src + (size_t)(m + 1) * BLKF);
#pragma unroll
                    for (int i = 0; i < 12; ++i) xb[i] = s4[lane + 64 * i]; }
            }
        } else if (role == 2) {
            cv_queue_run(F, a, nullptr);
        } else {
            float S0 = 0.f, S1 = 0.f, S2 = 0.f, S3 = 0.f;
            for (int n = 0; n < NBLK; ++n) {
                HS_WAIT(hs[0] >= n + 1);
                const LAS float* bb = buf + (n & 3) * BLKF;
                float* yo = YR + ((size_t)(b * SEQ + n * TB)) * RW + h * RN + row;
                f32x4 al = *(const LAS f32x4*)(bb + 4 * kq), w = *(const LAS f32x4*)(bb + 64 + 4 * kq), be = *(const LAS f32x4*)(bb + 128 + 4 * kq);
                f32x4 kf = *(const LAS f32x4*)(bb + 192 + 4 * kq), r = *(const LAS f32x4*)(bb + 256 + 4 * kq); float vv = bb[320 + row];
                float ykeep = 0.f, yp = 0.f;
#pragma unroll
                for (int j = 0; j < TB; ++j) {
                    f32x4 al_n = al, w_n = w, be_n = be, kf_n = kf, r_n = r; float vv_n = vv;
                    if (j + 1 < TB) { const LAS float* st = bb + (j + 1) * STF;
                        al_n = *(const LAS f32x4*)(st + 4 * kq); w_n = *(const LAS f32x4*)(st + 64 + 4 * kq); be_n = *(const LAS f32x4*)(st + 128 + 4 * kq);
                        kf_n = *(const LAS f32x4*)(st + 192 + 4 * kq); r_n = *(const LAS f32x4*)(st + 256 + 4 * kq); vv_n = st[320 + row]; }
                    float sa = (S0 * al.x + S1 * al.y) + (S2 * al.z + S3 * al.w);
                    float yq = yp;
                    sa += DPPF(sa, 0xB1); if (j > 0) yq += DPPF(yq, 0xB1);
                    sa += DPPF(sa, 0x4E); if (j > 0) yq += DPPF(yq, 0x4E);
                    sa += DPPF(sa, 0x141); if (j > 0) yq += DPPF(yq, 0x141);
                    sa += DPPF(sa, 0x140); if (j > 0) yq += DPPF(yq, 0x140);
                    if (j > 0) ykeep = __builtin_bit_cast(float, __builtin_amdgcn_update_dpp(__builtin_bit_cast(int, yq), __builtin_bit_cast(int, ykeep), 0x111, 0xF, 0xF, false));
                    S0 = S0 * w.x + (sa * be.x + vv * kf.x); S1 = S1 * w.y + (sa * be.y + vv * kf.y);
                    S2 = S2 * w.z + (sa * be.z + vv * kf.z); S3 = S3 * w.w + (sa * be.w + vv * kf.w);
                    yp = (S0 * r.x + S1 * r.y) + (S2 * r.z + S3 * r.w);
                    al = al_n; w = w_n; be = be_n; kf = kf_n; r = r_n; vv = vv_n;
                }
                const float yl = dpp_sum16(yp);
                ykeep = __builtin_bit_cast(float, __builtin_amdgcn_update_dpp(__builtin_bit_cast(int, yl), __builtin_bit_cast(int, ykeep), 0x111, 0xF, 0xF, false));
                yo[(size_t)(TB - 1 - kq) * RW] = ykeep;
                asm volatile("s_waitcnt lgkmcnt(0)" ::: "memory");
                if (lane == 0) hs[1 + F.wave] = n + 1;
            }
            __builtin_amdgcn_s_setprio(0);
        }
#undef HS_WAIT
        __syncthreads();
    }
    if (F.G != 256) { LAS float* scr = (LAS float*)(F.lds + F.wave * 16896); __syncthreads();
        for (int it = F.vcu * 8 + F.wave; it < CV_ITEMS; it += F.G * 8) { const CvItem c2 = cv_item(a, F.ws, it); f32x4 c3[16]; cv_load(c2.W, c2.ldw, c2.k0, c2.n0, lane, c3); cv_finish(c3, c2.k0, c2.dst, c2.ldk, scr, lane, WQ_SCALE); } }
}

__device__ __forceinline__ void p6_rwkv_post(const Frame& F, const Args& a) {
    const int gw = F.vcu * 8 + F.wave, NGW = F.G * 8, lane = F.lane;
    const bf16* SC = (const bf16*)(F.ws + WS_SCAN); const float* YR = (const float*)(F.ws + WS_YRAW); const float* BON = (const float*)(F.ws + WS_BON);
    const bf16* GO = (const bf16*)(F.ws + WS_GO); bf16* YA = (bf16*)(F.ws + WS_YA);
    const int h = lane >> 2, q = lane & 3, c0 = h * RN + 16 * q;
    f32x4 lg[4], lb[4];
#pragma unroll
    for (int j = 0; j < 4; ++j) { lg[j] = *(const f32x4*)(a.in[I_LNG] + c0 + 4 * j); lb[j] = *(const f32x4*)(a.in[I_LNB] + c0 + 4 * j); }
    for (int t = gw; t < T; t += NGW) {
        const int bh = (t >> 11) * RH + h, ts = t & (SEQ - 1);
        f32x4 y[4]; v4u uv[2], ug[2];
#pragma unroll
        for (int j = 0; j < 4; ++j) y[j] = __builtin_nontemporal_load((const f32x4*)(YR + (size_t)t * RW + c0 + 4 * j));
#pragma unroll
        for (int j = 0; j < 2; ++j) { uv[j] = *(const v4u*)(SC + ((size_t)(bh * SEQ + ts) * 6 + 5) * 64 + 16 * q + 8 * j); ug[j] = *(const v4u*)(GO + (size_t)t * RW + c0 + 8 * j); }
        const float bo = BON[(size_t)t * RH + h];
        float s = 0.f;
#pragma unroll
        for (int j = 0; j < 4; ++j) s += (y[j].x + y[j].y) + (y[j].z + y[j].w);
        const float mean = quad_sum(s) * (1.f / RN);
        float s2 = 0.f;
#pragma unroll
        for (int j = 0; j < 4; ++j) { y[j] = y[j] - mean; s2 += (y[j].x * y[j].x + y[j].y * y[j].y) + (y[j].z * y[j].z + y[j].w * y[j].w); }
        const float rstd = rsqrtf(quad_sum(s2) * (1.f / RN) + GN_EPS);
        float vv[2][8], gg[2][8], o[2][8];
        unpack8(uv[0], vv[0]); unpack8(uv[1], vv[1]); unpack8(ug[0], gg[0]); unpack8(ug[1], gg[1]);
#pragma unroll
        for (int j = 0; j < 4; ++j)
#pragma unroll
            for (int i = 0; i < 4; ++i) o[j >> 1][4 * (j & 1) + i] = (y[j][i] * rstd * lg[j][i] + lb[j][i] + bo * vv[j >> 1][4 * (j & 1) + i]) * gg[j >> 1][4 * (j & 1) + i];
        *(v4u*)(YA + (size_t)t * RW + c0) = pack8(o[0]); *(v4u*)(YA + (size_t)t * RW + c0 + 8) = pack8(o[1]);
    }
}

constexpr int G_BC = 0;
constexpr int G_ALF = 32768;
constexpr int G_RED = 36864;
constexpr int G_TOT = 38912;
constexpr int G_QT = 40960;
constexpr int G_KT = 58368;
constexpr int G_VT = 76800;
constexpr int G_AT = 113664;
__device__ __forceinline__ void gla_bcum(const Frame& F, const Args& a, const bf16* P, int t0, int h) {
    LAS float* bc = (LAS float*)(F.lds + G_BC); LAS float* alf = (LAS float*)(F.lds + G_ALF); LAS float* tot = (LAS float*)(F.lds + G_TOT);
    const int tid = F.tid;
    __syncthreads();
    { const int j = tid >> 3, i2 = (tid & 7) * 2; const unsigned u = *(const unsigned*)(P + (size_t)(t0 + j) * PLD + C_GAL + i2); alf[j * 16 + i2] = bflo(u); alf[j * 16 + i2 + 1] = bfhi(u); }
    const int d = tid & 127, jq = tid >> 7, hd = h * GDK + d;
    float wv[16];
#pragma unroll
    for (int i = 0; i < 16; ++i) wv[i] = a.in[I_GWA2][(size_t)i * GKW + hd];
    const float bb = a.in[I_GBA][hd];
    __syncthreads();
    float run = 0.f;
    for (int jj = 0; jj < 16; ++jj) { const int j = jq * 16 + jj; float x = bb;
#pragma unroll
        for (int i = 0; i < 16; ++i) x += alf[j * 16 + i] * wv[i];
        run += -softplusf_(-x) * (1.f / 16.f); bc[j * 128 + d] = run; }
    tot[jq * 128 + d] = run;
    __syncthreads();
    float pre = 0.f;
    for (int q = 0; q < jq; ++q) pre += tot[q * 128 + d];
    if (jq > 0) { for (int jj = 0; jj < 16; ++jj) bc[(jq * 16 + jj) * 128 + d] += pre; }
    __syncthreads();
}
constexpr int G_VP = 264, G_KP = 136;
__device__ __forceinline__ void gla_stage_v(const Frame& F, const bf16* P, int t0, int h) {
    LAS bf16* VR = (LAS bf16*)(F.lds + G_VT);
    const int j = F.tid >> 3, e0 = (F.tid & 7) * 32;
    const bf16* src = P + (size_t)(t0 + j) * PLD + C_GV + h * GDV + e0;
#pragma unroll
    for (int q = 0; q < 4; ++q) *(LAS v4u*)(VR + j * G_VP + e0 + 8 * q) = *(const v4u*)(src + 8 * q);
}
typedef short s16x4g __attribute__((ext_vector_type(4)));
__device__ __forceinline__ bf16x8 tr_frag(const LAS bf16* img, int pitch, int row0, int col0, int lane) {
    const LAS bf16* p = img + (row0 + 8 * (lane >> 4) + ((lane & 15) >> 2)) * pitch + col0 + 4 * (lane & 3);
    const s16x4g lo = __builtin_amdgcn_ds_read_tr16_b64_v4i16((LAS s16x4g*)p);
    const s16x4g hi = __builtin_amdgcn_ds_read_tr16_b64_v4i16((LAS s16x4g*)(p + 4 * pitch));
    return __builtin_shufflevector(lo, hi, 0, 1, 2, 3, 4, 5, 6, 7);
}
#define MMA16(a_, b_, c_) __builtin_amdgcn_mfma_f32_16x16x32_bf16(a_, b_, c_, 0, 0, 0)
__device__ __forceinline__ void gla_pass_a(const Frame& F, const Args& a) {
    const bf16* P = (const bf16*)(F.ws + WS_P); float* HT = (float*)(F.ws + WS_GHT); float* DEC = (float*)(F.ws + WS_GDEC);
    LAS float* bc = (LAS float*)(F.lds + G_BC); LAS bf16* KH = (LAS bf16*)(F.lds + G_KT); LAS bf16* VR = (LAS bf16*)(F.lds + G_VT);
    const int fr = F.lane & 15, fq = F.lane >> 4;
    for (int it = F.vcu; it < BATCH * GH * NCH; it += F.G) {
        const int c = it & 31, h = (it >> 5) & 3, b = it >> 7, t0 = b * SEQ + c * CHUNK;
        gla_bcum(F, a, P, t0, h);
        if (F.tid < 128) DEC[(size_t)it * 128 + F.tid] = __expf(bc[63 * 128 + F.tid]);
        { f32x4* gbc = (f32x4*)(F.ws + WS_GBC) + (size_t)it * 2048;
#pragma unroll
          for (int i = 0; i < 4; ++i) gbc[F.tid + 512 * i] = ((const LAS f32x4*)bc)[F.tid + 512 * i]; }
        { const int j = F.tid >> 3, d0 = (F.tid & 7) * 16; const bf16* src = P + (size_t)(t0 + j) * PLD + C_GK + h * GDK + d0;
#pragma unroll
          for (int q = 0; q < 2; ++q) { const v4u u = *(const v4u*)(src + 8 * q); float kv[8]; unpack8(u, kv);
#pragma unroll
            for (int i = 0; i < 8; ++i) { const int d = d0 + 8 * q + i; kv[i] *= __expf(bc[63 * 128 + d] - bc[j * 128 + d]); }
            *(LAS v4u*)(KH + j * G_KP + d0 + 8 * q) = pack8(kv); } }
        gla_stage_v(F, P, t0, h);
        __syncthreads();
        f32x4 acc[8][2];
#pragma unroll
        for (int m = 0; m < 8; ++m)
#pragma unroll
            for (int n = 0; n < 2; ++n) acc[m][n] = (f32x4){0.f, 0.f, 0.f, 0.f};
#pragma unroll
        for (int ks = 0; ks < 2; ++ks) {
            bf16x8 vf[2];
#pragma unroll
            for (int n = 0; n < 2; ++n) vf[n] = tr_frag(VR, G_VP, ks * 32, F.wave * 32 + n * 16, F.lane);
#pragma unroll
            for (int m = 0; m < 8; ++m) { const bf16x8 kf = tr_frag(KH, G_KP, ks * 32, m * 16, F.lane);
#pragma unroll
                for (int n = 0; n < 2; ++n) acc[m][n] = MMA16(kf, vf[n], acc[m][n]); }
        }
        float* o = HT + (size_t)it * (GDV * GDK);
#pragma unroll
        for (int m = 0; m < 8; ++m)
#pragma unroll
            for (int n = 0; n < 2; ++n) *(f32x4*)(o + (size_t)(F.wave * 32 + n * 16 + fr) * GDK + m * 16 + 4 * fq) = acc[m][n];
    }
}
__device__ __forceinline__ void gla_pass_b(const Frame& F, int lo, int hi, int wg, int nwg) {
    const float* HT = (const float*)(F.ws + WS_GHT); const float* DEC = (const float*)(F.ws + WS_GDEC); bf16* ST = (bf16*)(F.ws + WS_GST);
    const int gt = wg * 512 + F.tid, NGT = nwg * 512;
    for (int i = lo + gt; i < hi; i += NGT) {
        const int bh = i >> 15, ed = i & 32767, d = ed & 127;
        float s = 0.f;
        for (int c = 0; c < NCH; ++c) { const size_t it = (size_t)bh * NCH + c;
            ST[it * (GDV * GDK) + ed] = (bf16)f2bf(s);
            s = s * DEC[it * 128 + d] + HT[it * (GDV * GDK) + ed]; }
    }
}
__device__ __forceinline__ void gla_pass_c(const Frame& F, const Args& a) {
    const bf16* P = (const bf16*)(F.ws + WS_P); const bf16* ST = (const bf16*)(F.ws + WS_GST); bf16* YB = (bf16*)(F.ws + WS_YB);
    LAS float* bc = (LAS float*)(F.lds + G_BC); LAS float* red = (LAS float*)(F.lds + G_RED);
    LAS bf16* QT = (LAS bf16*)(F.lds + G_QT); LAS bf16* KT = (LAS bf16*)(F.lds + G_KT); LAS bf16* VR = (LAS bf16*)(F.lds + G_VT); LAS bf16* AT = (LAS bf16*)(F.lds + G_AT);
    const int fr = F.lane & 15, fq = F.lane >> 4, w = F.wave;
    const float scale = 0.08838834764831845f;
    for (int it = F.vcu; it < BATCH * GH * NCH; it += F.G) {
        const int c = it & 31, h = (it >> 5) & 3, b = it >> 7, t0 = b * SEQ + c * CHUNK;
        __syncthreads();
        { const f32x4* gbc = (const f32x4*)(F.ws + WS_GBC) + (size_t)it * 2048;
#pragma unroll
          for (int i = 0; i < 4; ++i) ((LAS f32x4*)bc)[F.tid + 512 * i] = gbc[F.tid + 512 * i]; }
        const bf16* Sg = ST + (size_t)it * (GDV * GDK);
        bf16x8 sfr[4][2];
#pragma unroll
        for (int ks = 0; ks < 4; ++ks)
#pragma unroll
            for (int n = 0; n < 2; ++n) sfr[ks][n] = *(const bf16x8*)(Sg + (size_t)(w * 32 + n * 16 + fr) * GDK + ks * 32 + fq * 8);
        f32x4 gng[2];
#pragma unroll
        for (int n = 0; n < 2; ++n) gng[n] = *(const f32x4*)(a.in[I_GNG] + w * 32 + n * 16 + 4 * fq);
        v2u ogu[4][2];
#pragma unroll
        for (int m = 0; m < 4; ++m)
#pragma unroll
            for (int n = 0; n < 2; ++n) ogu[m][n] = __builtin_nontemporal_load((const v2u*)(P + (size_t)(t0 + m * 16 + fr) * PLD + C_OG + h * GDV + w * 32 + n * 16 + 4 * fq));
        __syncthreads();
        { const int j = F.tid >> 3, d0 = (F.tid & 7) * 16;
          const bf16* sq = P + (size_t)(t0 + j) * PLD + C_GQ + h * GDK + d0; const bf16* sk = P + (size_t)(t0 + j) * PLD + C_GK + h * GDK + d0;
#pragma unroll
          for (int q = 0; q < 2; ++q) { const v4u uq = *(const v4u*)(sq + 8 * q), uk = *(const v4u*)(sk + 8 * q); float fq8[8], fk8[8]; unpack8(uq, fq8); unpack8(uk, fk8);
#pragma unroll
            for (int i = 0; i < 8; ++i) { const float bv = bc[j * 128 + d0 + 8 * q + i]; fq8[i] *= scale * __expf(bv); fk8[i] *= __expf(-bv); }
            *(LAS v4u*)(QT + j * 136 + d0 + 8 * q) = pack8(fq8); *(LAS v4u*)(KT + j * 136 + d0 + 8 * q) = pack8(fk8); } }
        gla_stage_v(F, P, t0, h);
        __syncthreads();
        { const int mt = w >> 1;
#pragma unroll
          for (int q = 0; q < 2; ++q) { const int nt = (w & 1) * 2 + q; f32x4 sacc = {0.f, 0.f, 0.f, 0.f};
            if (nt <= mt) {
#pragma unroll
                for (int ks = 0; ks < 4; ++ks) { const bf16x8 kfr = *(const LAS bf16x8*)(KT + (nt * 16 + fr) * 136 + ks * 32 + fq * 8); const bf16x8 qfr = *(const LAS bf16x8*)(QT + (mt * 16 + fr) * 136 + ks * 32 + fq * 8);
                    sacc = MMA16(kfr, qfr, sacc); } }
            const int i = mt * 16 + fr, j0 = nt * 16 + 4 * fq; float v4[4];
#pragma unroll
            for (int jj = 0; jj < 4; ++jj) v4[jj] = (j0 + jj <= i) ? sacc[jj] : 0.f;
            v2u pk; pk.x = pk2(v4[0], v4[1]); pk.y = pk2(v4[2], v4[3]); *(LAS v2u*)(AT + i * 72 + j0) = pk; } }
        __syncthreads();
        f32x4 acc[2][4];
#pragma unroll
        for (int n = 0; n < 2; ++n)
#pragma unroll
            for (int m = 0; m < 4; ++m) acc[n][m] = (f32x4){0.f, 0.f, 0.f, 0.f};
#pragma unroll
        for (int ks = 0; ks < 2; ++ks) {
            bf16x8 vf[2];
#pragma unroll
            for (int n = 0; n < 2; ++n) vf[n] = tr_frag(VR, G_VP, ks * 32, w * 32 + n * 16, F.lane);
#pragma unroll
            for (int m = 0; m < 4; ++m) { const bf16x8 af = *(const LAS bf16x8*)(AT + (m * 16 + fr) * 72 + ks * 32 + fq * 8);
#pragma unroll
                for (int n = 0; n < 2; ++n) acc[n][m] = MMA16(vf[n], af, acc[n][m]); }
        }
#pragma unroll
        for (int ks = 0; ks < 4; ++ks) {
#pragma unroll
            for (int m = 0; m < 4; ++m) { const bf16x8 qf = *(const LAS bf16x8*)(QT + (m * 16 + fr) * 136 + ks * 32 + fq * 8);
#pragma unroll
                for (int n = 0; n < 2; ++n) acc[n][m] = MMA16(sfr[ks][n], qf, acc[n][m]); }
        }
        float ssq[4];
#pragma unroll
        for (int m = 0; m < 4; ++m) { float ss = 0.f;
#pragma unroll
            for (int n = 0; n < 2; ++n) ss += (acc[n][m][0] * acc[n][m][0] + acc[n][m][1] * acc[n][m][1]) + (acc[n][m][2] * acc[n][m][2] + acc[n][m][3] * acc[n][m][3]);
            ss += __shfl_xor(ss, 16); ss += __shfl_xor(ss, 32); ssq[m] = ss;
            if (fq == 0) red[(m * 16 + fr) * 8 + w] = ss; }
        __syncthreads();
#pragma unroll
        for (int m = 0; m < 4; ++m) { const int i = m * 16 + fr; float tot = 0.f;
#pragma unroll
            for (int q = 0; q < 8; ++q) tot += red[i * 8 + q];
            const float rstd = rsqrtf(tot * (1.f / GDV) + NORM_EPS);
#pragma unroll
            for (int n = 0; n < 2; ++n) { const int e = w * 32 + n * 16 + 4 * fq;
                const float og[4] = {bflo(ogu[m][n].x), bfhi(ogu[m][n].x), bflo(ogu[m][n].y), bfhi(ogu[m][n].y)}; float r4[4];
#pragma unroll
                for (int jj = 0; jj < 4; ++jj) r4[jj] = acc[n][m][jj] * rstd * gng[n][jj] * (og[jj] * sigmoidf_(og[jj]));
                v2u pk; pk.x = pk2(r4[0], r4[1]); pk.y = pk2(r4[2], r4[3]); *(v2u*)(YB + (size_t)(t0 + i) * GVW + h * GDV + e) = pk; } }
    }
}

__device__ __forceinline__ void p11_router(const Frame& F, const Args& a) {
    const int lane = F.lane, w = F.wave;
    const float* X1 = (const float*)(F.ws + WS_X1); unsigned char* H2 = (unsigned char*)(F.ws + WS_H2); const float* Wr = (const float*)(F.ws + WS_WR);
    int* SEL_E = (int*)(F.ws + WS_ROUTE); float* SEL_W = (float*)(F.ws + WS_ROUTE + 256 * 1024); int* SEL_R = (int*)(F.ws + WS_ROUTE + 512 * 1024);
    volatile LAS int* hist = (volatile LAS int*)(F.lds + MOE_OFF + 1024); volatile LAS int* base = (volatile LAS int*)(F.lds + MOE_OFF + 1280);
    int* LIST = (int*)(F.ws + WS_ROUTE + 1024 * 1024);
    LAS float* part = (LAS float*)F.lds;
    LAS float* ssq = (LAS float*)(F.lds + 16384);
    __syncthreads();
    if (F.tid < 32) hist[F.tid] = 0;
    __syncthreads();
    const int mt = w & 1, ks = w >> 1, r = lane & 15, kq = lane >> 4;
    const int grp = lane >> 4, el = lane & 15;
    const float br0 = a.in[I_BROUTER][el], br1 = a.in[I_BROUTER][16 + el];
    for (int tile = F.vcu; tile < T / 32; tile += F.G) {
        const int tb = tile * 32;
        {
            const float* xp = X1 + (size_t)(tb + 16 * mt + r) * D + 512 * ks + 8 * kq;
            const float* bp = Wr + (size_t)(2 * ks) * 8192 + r * 256 + 8 * kq;
            f32x4 acc0 = {0.f, 0.f, 0.f, 0.f}, acc1 = {0.f, 0.f, 0.f, 0.f}; float ss = 0.f;
#pragma unroll 4
            for (int s = 0; s < 16; ++s) {
                const f32x4 xa = *(const f32x4*)(xp + 32 * s), xb = *(const f32x4*)(xp + 32 * s + 4);
                const float* bs = bp + (s >> 3) * 8192 + 32 * (s & 7);
                const f32x4 b00 = *(const f32x4*)bs, b01 = *(const f32x4*)(bs + 4), b10 = *(const f32x4*)(bs + 4096), b11 = *(const f32x4*)(bs + 4096 + 4);
                ss += ((xa.x * xa.x + xa.y * xa.y) + (xa.z * xa.z + xa.w * xa.w)) + ((xb.x * xb.x + xb.y * xb.y) + (xb.z * xb.z + xb.w * xb.w));
#pragma unroll
                for (int i = 0; i < 4; ++i) { acc0 = __builtin_amdgcn_mfma_f32_16x16x4f32(xa[i], b00[i], acc0, 0, 0, 0); acc1 = __builtin_amdgcn_mfma_f32_16x16x4f32(xa[i], b10[i], acc1, 0, 0, 0); }
#pragma unroll
                for (int i = 0; i < 4; ++i) { acc0 = __builtin_amdgcn_mfma_f32_16x16x4f32(xb[i], b01[i], acc0, 0, 0, 0); acc1 = __builtin_amdgcn_mfma_f32_16x16x4f32(xb[i], b11[i], acc1, 0, 0, 0); }
            }
#pragma unroll
            for (int j = 0; j < 4; ++j) { LAS float* pr = part + ((ks * 32 + 16 * mt + 4 * kq + j) * 32); pr[r] = acc0[j]; pr[16 + r] = acc1[j]; }
            ss += __shfl_xor(ss, 16); ss += __shfl_xor(ss, 32);
            if (kq == 0) ssq[ks * 32 + 16 * mt + r] = ss;
        }
        __syncthreads();
        {
            const int tk = 4 * w + grp;
            const float rstd = rsqrtf(((ssq[tk] + ssq[32 + tk]) + (ssq[64 + tk] + ssq[96 + tk])) * (1.f / D) + NORM_EPS);
            const LAS float* pr = part + tk * 32;
            float c0 = ((pr[el] + pr[1024 + el]) + (pr[2048 + el] + pr[3072 + el])) * rstd + br0;
            float c1 = ((pr[16 + el] + pr[1024 + 16 + el]) + (pr[2048 + 16 + el] + pr[3072 + 16 + el])) * rstd + br1;
            float tv[4]; int ti[4];
#pragma unroll
            for (int k = 0; k < 4; ++k) { float bv = c0; int bi = el; if (c1 > c0) { bv = c1; bi = 16 + el; }
#pragma unroll
                for (int o = 1; o < 16; o <<= 1) { const float ov = __shfl_xor(bv, o); const int oi = __shfl_xor(bi, o); if (ov > bv || (ov == bv && oi < bi)) { bv = ov; bi = oi; } }
                tv[k] = bv; ti[k] = bi; if (bi == el) c0 = -3.0e38f; if (bi == 16 + el) c1 = -3.0e38f; }
            const float e1 = __expf(tv[1] - tv[0]), e2 = __expf(tv[2] - tv[0]), e3 = __expf(tv[3] - tv[0]); const float inv = 1.f / (1.f + e1 + e2 + e3);
            if (el < 4) { const int k = el; const float wk = (k == 0 ? 1.f : (k == 1 ? e1 : (k == 2 ? e2 : e3))) * inv; const int ek = (k == 0 ? ti[0] : (k == 1 ? ti[1] : (k == 2 ? ti[2] : ti[3])));
                const int lr = __hip_atomic_fetch_add((LAS int*)&hist[ek], 1, __ATOMIC_RELAXED, __HIP_MEMORY_SCOPE_WORKGROUP);
                SEL_E[(tb + tk) * 4 + k] = ek; SEL_W[(tb + tk) * 4 + k] = wk; SEL_R[(tb + tk) * 4 + k] = lr; }
        }
#pragma unroll
        for (int rr = 0; rr < 4; ++rr) { const int tk = 4 * w + rr;
            const float rstd = rsqrtf(((ssq[tk] + ssq[32 + tk]) + (ssq[64 + tk] + ssq[96 + tk])) * (1.f / D) + NORM_EPS);
            const f32x4* xr = (const f32x4*)(X1 + (size_t)(tb + tk) * D) + lane; unsigned* hr = (unsigned*)(H2 + (size_t)(tb + tk) * D) + lane;
#pragma unroll
            for (int j = 0; j < 8; ++j) { const f32x4 xv = __builtin_nontemporal_load(xr + 64 * j); const f32x4 gg = ((const f32x4*)a.in[I_NFG])[64 * j + lane];
                hr[64 * j] = pk4_fp8(xv.x * rstd * gg.x, xv.y * rstd * gg.y, xv.z * rstd * gg.z, xv.w * rstd * gg.w); } }
        __syncthreads();
    }
    if (F.tid < 32) base[F.tid] = (int)__hip_atomic_fetch_add(F.ctl + CW_CNT + F.tid, (unsigned)hist[F.tid], RLX_AGENT);
    __syncthreads();
    for (int tile = F.vcu; tile < T / 32; tile += F.G) {
        if (F.tid < 128) { const int tk = tile * 32 + (F.tid >> 2); const int idx = tk * 4 + (F.tid & 3);
            const int e_ = __hip_atomic_load(SEL_E + idx, RLX_AGENT); const int rk_ = __hip_atomic_load(SEL_R + idx, RLX_AGENT) + base[e_]; SEL_R[idx] = rk_; LIST[e_ * 8192 + rk_] = tk; }
    }
}
__device__ __forceinline__ void moe_tables(const Frame& F, int nct) {
    volatile LAS int* tab = (volatile LAS int*)(F.lds + MOE_OFF);
    __syncthreads();
    if (F.tid == 0) { int run = 0, units = 0;
        for (int e = 0; e < NE; ++e) { const int cnt = (int)__hip_atomic_load(F.ctl + CW_CNT + e, RLX_AGENT); const int nt = (cnt + 255) >> 8;
            tab[e] = units; tab[36 + e] = run * 256; tab[72 + e] = nt > 0 ? nt : 1; tab[108 + e] = cnt; run += nt; units += nt * nct; }
        tab[32] = units; }
    __syncthreads();
}
__device__ __forceinline__ void p12_scatter(const Frame& F) {
    const int gw = F.vcu * 8 + F.wave, NGW = F.G * 8, lane = F.lane;
    const unsigned char* H2 = (const unsigned char*)(F.ws + WS_H2); unsigned char* XS = (unsigned char*)(F.ws + WS_XS);
    const int* SEL_E = (const int*)(F.ws + WS_ROUTE); const int* SEL_R = (const int*)(F.ws + WS_ROUTE + 512 * 1024); int* DEST = (int*)(F.ws + WS_ROUTE + 768 * 1024);
    moe_tables(F, 1);
    volatile LAS int* tab = (volatile LAS int*)(F.lds + MOE_OFF);
    for (int it = gw; it < T * TOPK; it += NGW) {
        const int t = it >> 2; const int e = SEL_E[it], dest = tab[36 + e] + SEL_R[it];
        const v4u* s = (const v4u*)(H2 + (size_t)t * D) + lane; v4u* d = (v4u*)(XS + (size_t)dest * D) + lane;
        d[0] = s[0]; d[64] = s[64];
        if (lane == 0) DEST[it] = dest;
    }
}
__device__ __forceinline__ void p15_combine(const Frame& F, const Args& a) {
    const int gw = F.vcu * 8 + F.wave, NGW = F.G * 8, lane = F.lane;
    const float* X1 = (const float*)(F.ws + WS_X1); const bf16* Y = (const bf16*)(F.ws + WS_Y);
    const float* SEL_W = (const float*)(F.ws + WS_ROUTE + 256 * 1024); const int* SEL_E = (const int*)(F.ws + WS_ROUTE); const int* SEL_R = (const int*)(F.ws + WS_ROUTE + 512 * 1024);
    moe_tables(F, 1);
    volatile LAS int* tab = (volatile LAS int*)(F.lds + MOE_OFF);
    for (int t = gw; t < T; t += NGW) {
        f32x4 v[8];
        const f32x4* xr = (const f32x4*)(X1 + (size_t)t * D) + lane;
#pragma unroll
        for (int j = 0; j < 8; ++j) v[j] = __builtin_nontemporal_load(xr + 64 * j);
#pragma unroll
        for (int k = 0; k < 4; ++k) { const float wk = SEL_W[t * 4 + k]; const v2u* yr = (const v2u*)(Y + (size_t)(tab[36 + SEL_E[t * 4 + k]] + SEL_R[t * 4 + k]) * D) + lane;
#pragma unroll
            for (int j = 0; j < 8; ++j) { const v2u u = __builtin_nontemporal_load(yr + 64 * j); v[j].x += wk * bflo(u.x); v[j].y += wk * bfhi(u.x); v[j].z += wk * bflo(u.y); v[j].w += wk * bfhi(u.y); } }
        float s = 0.f;
#pragma unroll
        for (int j = 0; j < 8; ++j) s += (v[j].x * v[j].x + v[j].y * v[j].y) + (v[j].z * v[j].z + v[j].w * v[j].w);
        const float rstd = rsqrtf(wave_sum(s) * (1.f / D) + NORM_EPS);
        f32x4* o = (f32x4*)(a.out + (size_t)t * D) + lane;
#pragma unroll
        for (int j = 0; j < 8; ++j) { const f32x4 gg = ((const f32x4*)a.in[I_NFINAL])[64 * j + lane]; __builtin_nontemporal_store(v[j] * rstd * gg, o + 64 * j); }
    }
}

__global__ void __launch_bounds__(512, 2) __attribute__((amdgpu_num_sgpr(96))) fwd(Args args) {
    extern __shared__ __attribute__((aligned(16))) unsigned char lds[];
    Frame F;
    F.lds = (LAS unsigned char*)lds; F.ws = args.ws; F.ctl = (unsigned*)(args.ws + WS_CTL);
    F.tid = threadIdx.x; F.lane = F.tid & 63; F.wave = __builtin_amdgcn_readfirstlane(F.tid >> 6);
    F.G = gridDim.x; { const int bx = blockIdx.x; F.vcu = (F.G % 8 == 0) ? (bx % 8) * (F.G / 8) + bx / 8 : bx; }
    for (int u = F.tid; u < (LDS_BYTES - LDSCTL_OFF) / 4; u += 512) ((LAS unsigned*)(F.lds + LDSCTL_OFF))[u] = 0u;
    __syncthreads();
    volatile LAS unsigned* MISC = (volatile LAS unsigned*)(F.lds + MISC_OFF);
#if MK_PER_PHASE
#define GRID_BAR() do { } while (0)
#else
    XcdBarrier bar = xcd_barrier_post(F.ctl + CW_BAR, MISC + 8);
#define GRID_BAR() xcd_barrier(bar)
#endif
    const int lo = args.ph_lo, hi = args.ph_hi;
#define IN(k) (lo <= (k) && (k) < hi)
#define SEAM(k) do { if (IN(k) && IN((k) + 1)) GRID_BAR(); } while (0)
#define DUP(k) (((PROBE_DUP) >> (k)) & 1)
#define PH_BEGIN {
#define PH_END }
    const bf16* P = (const bf16*)(F.ws + WS_P);

    if (IN(0)) { PH_BEGIN  p0_prologue(F, args);  PH_END if (DUP(0)) { GRID_BAR(); PH_BEGIN  p0_prologue(F, args);  PH_END } } SEAM(0);
    if (IN(1)) { PH_BEGIN  p1_gemm_in(F, args);  PH_END if (DUP(1)) { GRID_BAR(); PH_BEGIN  p1_gemm_in(F, args);  PH_END } } SEAM(1);
    if (PROBE_GEMM >= 0 && IN(1)) {
        pg8::Gemm g{(const bf16*)(F.ws + WS_H), (const bf16*)(F.ws + WS_WIN), DP, DP, D, nullptr}; pg8::ProbeOrder S; S.so.init(T, PLD, F.G, (int)blockIdx.x); S.mode = PROBE_GEMM;
        pg8::EpiProbe E{(bf16*)(F.ws + WS_XS)}; pg8::gemm_phase(F.lds, g, S, E); GRID_BAR();
    }
    if (IN(2)) { PH_BEGIN  p2_lora_in(F, args); gla_pass_a(F, args);  PH_END if (DUP(2)) { GRID_BAR(); PH_BEGIN  p2_lora_in(F, args); gla_pass_a(F, args);  PH_END } } SEAM(2);
    if (IN(3)) { PH_BEGIN
        { pg8::Gemm g{(const bf16*)(F.ws + WS_A2), (const bf16*)(F.ws + WS_WLWA), 512, 256, 256, nullptr}; pg8::StaticOrder S; S.init(T, 2048, F.G, (int)blockIdx.x);
          pg8::EpiBf16 E{(bf16*)(F.ws + WS_WAO), 2048, nullptr, 0, 1.f}; pg8::gemm_phase(F.lds, g, S, E); }
        { pg8::Gemm g{(const bf16*)(F.ws + WS_A2) + 256, (const bf16*)(F.ws + WS_WLG), 512, 256, 256, nullptr}; pg8::StaticOrder S; S.init(T, 1024, F.G, (int)blockIdx.x);
          pg8::EpiBf16 E{(bf16*)(F.ws + WS_GO), 1024, nullptr, 0, 1.f}; pg8::gemm_phase(F.lds, g, S, E); }
        {
            constexpr int NEL = BATCH * GH * GDV * GDK, HEAD = (NEL / 4 / 65536) * 65536; const int bx = (int)blockIdx.x;
            if (F.G == 256) { if (bx >= 128) gla_pass_b(F, 0, HEAD, bx - 128, 128); gla_pass_b(F, HEAD, NEL, F.vcu, F.G); } else gla_pass_b(F, 0, NEL, F.vcu, F.G); }
     PH_END if (DUP(3)) { GRID_BAR(); PH_BEGIN
        { pg8::Gemm g{(const bf16*)(F.ws + WS_A2), (const bf16*)(F.ws + WS_WLWA), 512, 256, 256, nullptr}; pg8::StaticOrder S; S.init(T, 2048, F.G, (int)blockIdx.x);
          pg8::EpiBf16 E{(bf16*)(F.ws + WS_WAO), 2048, nullptr, 0, 1.f}; pg8::gemm_phase(F.lds, g, S, E); }
        { pg8::Gemm g{(const bf16*)(F.ws + WS_A2) + 256, (const bf16*)(F.ws + WS_WLG), 512, 256, 256, nullptr}; pg8::StaticOrder S; S.init(T, 1024, F.G, (int)blockIdx.x);
          pg8::EpiBf16 E{(bf16*)(F.ws + WS_GO), 1024, nullptr, 0, 1.f}; pg8::gemm_phase(F.lds, g, S, E); }
        {
            constexpr int NEL = BATCH * GH * GDV * GDK, HEAD = (NEL / 4 / 65536) * 65536; const int bx = (int)blockIdx.x;
            if (F.G == 256) { if (bx >= 128) gla_pass_b(F, 0, HEAD, bx - 128, 128); gla_pass_b(F, HEAD, NEL, F.vcu, F.G); } else gla_pass_b(F, 0, NEL, F.vcu, F.G); }
     PH_END } } SEAM(3);
    if (IN(4)) { PH_BEGIN  p4_rwkv_prep(F, args); gla_pass_c(F, args);  PH_END if (DUP(4)) { GRID_BAR(); PH_BEGIN  p4_rwkv_prep(F, args); gla_pass_c(F, args);  PH_END } } SEAM(4);
    if (IN(5)) { PH_BEGIN  p5_rwkv_scan(F, args);  PH_END if (DUP(5)) { GRID_BAR(); PH_BEGIN  p5_rwkv_scan(F, args);  PH_END } } SEAM(5);
    if (IN(6)) { PH_BEGIN  p6_rwkv_post(F, args);  PH_END if (DUP(6)) { GRID_BAR(); PH_BEGIN  p6_rwkv_post(F, args);  PH_END } } SEAM(6);
    if (IN(7)) { PH_BEGIN
        { pg8::Gemm g{(const bf16*)(F.ws + WS_YA), (const bf16*)(F.ws + WS_WBA), RW, RW, RW, nullptr}; pg8::StaticOrder S; S.init(T, D, F.G, (int)blockIdx.x);
          pg8::EpiGate<false> E{(bf16*)(F.ws + WS_MRG), P, args.in[I_BM], C_GATE}; pg8::gemm_phase(F.lds, g, S, E); }
        { pg8::Gemm g{(const bf16*)(F.ws + WS_YB), (const bf16*)(F.ws + WS_WBB), GVW, GVW, GVW, nullptr}; pg8::StaticOrder S; S.init(T, D, F.G, (int)blockIdx.x);
          pg8::EpiGate<true> E{(bf16*)(F.ws + WS_MRG), P, args.in[I_BM] + D, C_GATE + D}; pg8::gemm_phase(F.lds, g, S, E); }
     PH_END if (DUP(7)) { GRID_BAR(); PH_BEGIN
        { pg8::Gemm g{(const bf16*)(F.ws + WS_YA), (const bf16*)(F.ws + WS_WBA), RW, RW, RW, nullptr}; pg8::StaticOrder S; S.init(T, D, F.G, (int)blockIdx.x);
          pg8::EpiGate<false> E{(bf16*)(F.ws + WS_MRG), P, args.in[I_BM], C_GATE}; pg8::gemm_phase(F.lds, g, S, E); }
        { pg8::Gemm g{(const bf16*)(F.ws + WS_YB), (const bf16*)(F.ws + WS_WBB), GVW, GVW, GVW, nullptr}; pg8::StaticOrder S; S.init(T, D, F.G, (int)blockIdx.x);
          pg8::EpiGate<true> E{(bf16*)(F.ws + WS_MRG), P, args.in[I_BM] + D, C_GATE + D}; pg8::gemm_phase(F.lds, g, S, E); }
     PH_END } } SEAM(7);
    if (IN(8)) { PH_BEGIN
        pg8::Gemm g{(const bf16*)(F.ws + WS_MRG), (const bf16*)(F.ws + WS_WOUT), D, D, D, nullptr}; pg8::StaticOrder S; S.init(T, D, F.G, (int)blockIdx.x);
        pg8::EpiResF32 E{(float*)(F.ws + WS_X1), args.in[I_X]}; pg8::gemm_phase(F.lds, g, S, E);
     PH_END if (DUP(8)) { GRID_BAR(); PH_BEGIN
        pg8::Gemm g{(const bf16*)(F.ws + WS_MRG), (const bf16*)(F.ws + WS_WOUT), D, D, D, nullptr}; pg8::StaticOrder S; S.init(T, D, F.G, (int)blockIdx.x);
        pg8::EpiResF32 E{(float*)(F.ws + WS_X1), args.in[I_X]}; pg8::gemm_phase(F.lds, g, S, E);
     PH_END } } SEAM(8);
    if (IN(9)) { PH_BEGIN  p11_router(F, args);  PH_END if (DUP(9)) { GRID_BAR(); PH_BEGIN  p11_router(F, args);  PH_END } } SEAM(9);
    if (IN(10)) { PH_BEGIN
        moe_tables(F, 16);
        pg8::Gemm g{(const bf16*)(F.ws + WS_H2), (const bf16*)(F.ws + WS_WGU), D, D, D, (const int*)(F.ws + WS_ROUTE + 1024 * 1024)};
        pg8::MoeOrder S{(const volatile LAS int*)(F.lds + MOE_OFF), 16, 4096, F.G, F.vcu};
        pg8::EpiGluQ E{(unsigned char*)(F.ws + WS_HH), args.in[I_BGATE], args.in[I_BUP]}; pg8::gemm_phase<pg8::EpiGluQ, pg8::MoeOrder, 1, true>(F.lds, g, S, E);
     PH_END if (DUP(10)) { GRID_BAR(); PH_BEGIN
        moe_tables(F, 16);
        pg8::Gemm g{(const bf16*)(F.ws + WS_H2), (const bf16*)(F.ws + WS_WGU), D, D, D, (const int*)(F.ws + WS_ROUTE + 1024 * 1024)};
        pg8::MoeOrder S{(const volatile LAS int*)(F.lds + MOE_OFF), 16, 4096, F.G, F.vcu};
        pg8::EpiGluQ E{(unsigned char*)(F.ws + WS_HH), args.in[I_BGATE], args.in[I_BUP]}; pg8::gemm_phase<pg8::EpiGluQ, pg8::MoeOrder, 1, true>(F.lds, g, S, E);
     PH_END } } SEAM(10);
    if (IN(11)) { PH_BEGIN
        moe_tables(F, 8);
        pg8::Gemm g{(const bf16*)(F.ws + WS_HH), (const bf16*)(F.ws + WS_WD), FF, FF, FF, nullptr};
        pg8::MoeOrder S{(const volatile LAS int*)(F.lds + MOE_OFF), 8, 2048, F.G, F.vcu};
        pg8::EpiBf16 E{(bf16*)(F.ws + WS_Y), D, args.in[I_BDOWN], D, WQ_INV}; pg8::gemm_phase<pg8::EpiBf16, pg8::MoeOrder, 1>(F.lds, g, S, E);
     PH_END if (DUP(11)) { GRID_BAR(); PH_BEGIN
        moe_tables(F, 8);
        pg8::Gemm g{(const bf16*)(F.ws + WS_HH), (const bf16*)(F.ws + WS_WD), FF, FF, FF, nullptr};
        pg8::MoeOrder S{(const volatile LAS int*)(F.lds + MOE_OFF), 8, 2048, F.G, F.vcu};
        pg8::EpiBf16 E{(bf16*)(F.ws + WS_Y), D, args.in[I_BDOWN], D, WQ_INV}; pg8::gemm_phase<pg8::EpiBf16, pg8::MoeOrder, 1>(F.lds, g, S, E);
     PH_END } } SEAM(11);
    if (IN(12)) { PH_BEGIN  p15_combine(F, args);  PH_END if (DUP(12)) { GRID_BAR(); PH_BEGIN  p15_combine(F, args);  PH_END } }
#undef IN
#undef SEAM
}
constexpr int N_PHASES = 13;

extern "C" void kernel_launch(void* const* d_in, const int* in_sizes, int n_in, void* d_out, int out_size, void* d_ws, size_t ws_size, hipStream_t stream) {
    static int grid = 0;
    if (grid == 0) {
        if (n_in != 31 || in_sizes[0] != T * D || out_size != T * D || ws_size < WS_END) { fprintf(stderr, "kernel_launch: unexpected shapes (n_in %d, ws %zu)\n", n_in, ws_size); grid = -1; return; }
        int dev = 0, cus = 0, per_cu = 0;
        if (hipGetDevice(&dev) != hipSuccess || hipDeviceGetAttribute(&cus, hipDeviceAttributeMultiprocessorCount, dev) != hipSuccess) { grid = -1; return; }
        if (hipFuncSetAttribute((const void*)fwd, hipFuncAttributeMaxDynamicSharedMemorySize, LDS_BYTES) != hipSuccess) { fprintf(stderr, "kernel_launch: hipFuncSetAttribute failed\n"); grid = -1; return; }
        if (hipOccupancyMaxActiveBlocksPerMultiprocessor(&per_cu, (const void*)fwd, 512, LDS_BYTES) != hipSuccess || per_cu < 1) { fprintf(stderr, "kernel_launch: occupancy query says %d\n", per_cu); }
        (void)hipGetLastError();
        grid = cus;
    }
    if (grid < 0) return;
    (void)hipMemsetAsync((char*)d_ws + WS_CTL, 0, CTL_ZERO_BYTES, stream);
    Args a{};
    for (int i = 0; i < 31; ++i) a.in[i] = (const float*)d_in[i];
    a.out = (float*)d_out; a.ws = (unsigned char*)d_ws;
#if MK_PER_PHASE
    for (int p = 0; p < N_PHASES; ++p) { a.ph_lo = p; a.ph_hi = p + 1; hipLaunchKernelGGL(fwd, dim3(grid), dim3(512), LDS_BYTES, stream, a); }
#else
    a.ph_lo = 0; a.ph_hi = N_PHASES;
    hipLaunchKernelGGL(fwd, dim3(grid), dim3(512), LDS_BYTES, stream, a);
#endif
}
```

```cpp
#include <hip/hip_runtime.h>
#include <cstdio>
#include <cstdint>

#ifndef MK_PER_PHASE
#define MK_PER_PHASE 0
#endif

#ifndef PROBE_GEMM
#define PROBE_GEMM -1
#endif
#ifndef PROBE_DUP
#define PROBE_DUP 0
#endif
#define GAS __attribute__((address_space(1)))
#define LAS __attribute__((address_space(3)))
typedef unsigned short bf16;
typedef unsigned v4u __attribute__((ext_vector_type(4)));
typedef unsigned v2u __attribute__((ext_vector_type(2)));
typedef float f32x4 __attribute__((ext_vector_type(4)));
typedef float f32x2 __attribute__((ext_vector_type(2)));
typedef short bf16x8 __attribute__((ext_vector_type(8)));
typedef long i64x2 __attribute__((ext_vector_type(2)));
typedef int v4i __attribute__((ext_vector_type(4)));
typedef int v8i __attribute__((ext_vector_type(8)));
#define RLX_AGENT __ATOMIC_RELAXED, __HIP_MEMORY_SCOPE_AGENT
#define LDS_WAIT() asm volatile("s_waitcnt lgkmcnt(0)" ::: "memory")
#define VM_WAIT() asm volatile("s_waitcnt vmcnt(0)" ::: "memory")

constexpr int D = 2048, BATCH = 4, SEQ = 2048, T = BATCH * SEQ;
constexpr int RW = 1024, RH = 16, RN = 64;
constexpr int DLORA = 96, GLORA = 256;
constexpr int RWKV_COLS = 3 * RW + 2 * DLORA + GLORA;
constexpr int GH = 4, GDK = 128, GDV = 256, GKW = GH * GDK, GVW = GH * GDV, GAL = 16;
constexpr int GLA_COLS = 2 * GKW + 2 * GVW + GAL;
constexpr int IN_COLS = RWKV_COLS + GLA_COLS + 2 * D;
constexpr int PLD = 10752;
constexpr int DP = D + 64;
constexpr int C_R = 0, C_K = 1024, C_V = 2048, C_WL = 3072, C_AL = 3168, C_GL = 3264;
constexpr int C_GQ = 3520, C_GK = 4032, C_GV = 4544, C_OG = 5568, C_GAL = 6592, C_GATE = 6608;
constexpr int NE = 32, TOPK = 4, FF = 2048;
constexpr int XS_ROWS = T * TOPK + NE * 256;
constexpr int CHUNK = 64, NCH = SEQ / CHUNK;
constexpr float NORM_EPS = 1e-5f, GN_EPS = 64e-5f;
constexpr float WQ_SCALE = 64.f, WQ_INV = 1.f / 64.f;

constexpr size_t MiB = 1u << 20;
constexpr size_t WS_CTL = 0, CTL_ZERO_BYTES = 1 * MiB;
constexpr size_t WS_WR = 1 * MiB;
constexpr size_t WS_WLWA = 2 * MiB;
constexpr size_t WS_WLG = 3 * MiB;
constexpr size_t WS_WBA = 4 * MiB, WS_WBB = 8 * MiB;
constexpr size_t WS_WOUT = 12 * MiB;
constexpr size_t WS_WIN = 64 * MiB;
constexpr size_t WS_WGU = 192 * MiB;
constexpr size_t WS_WD = 448 * MiB;
constexpr size_t WS_H = 128 * MiB;
constexpr size_t WS_P = 864 * MiB;
constexpr size_t WS_Y = WS_P;
constexpr size_t WS_A2 = 1032 * MiB;
constexpr size_t WS_WAO = 1040 * MiB;
constexpr size_t WS_GO = 1072 * MiB;
constexpr size_t WS_SCAN = 1088 * MiB;
constexpr size_t WS_BON = 1200 * MiB;
constexpr size_t WS_YRAW = 1280 * MiB;
constexpr size_t WS_GHT = 1312 * MiB;
constexpr size_t WS_GST = 1376 * MiB;
constexpr size_t WS_GDEC = 1408 * MiB;
constexpr size_t WS_GBC = 576 * MiB;
constexpr size_t WS_YA = 1410 * MiB, WS_YB = 1426 * MiB;
constexpr size_t WS_MRG = 1442 * MiB;
constexpr size_t WS_X1 = 1474 * MiB;
constexpr size_t WS_H2 = 832 * MiB;
constexpr size_t WS_ROUTE = 1570 * MiB;
constexpr size_t WS_XS = 1572 * MiB;
constexpr size_t WS_HH = 1732 * MiB;
constexpr size_t WS_END = 1892 * MiB;
constexpr int CW_BAR = 4096;
constexpr int CW_CNT = 16384;
constexpr int CW_CVQ = 20480, CW_CVSTOP = 20544;

constexpr int RING_BYTES = 131072;
constexpr int LDSCTL_OFF = 159744, MISC_OFF = LDSCTL_OFF + 320;
constexpr int MOE_OFF = LDSCTL_OFF + 1024;
constexpr int LDS_BYTES = 163840;

__device__ __forceinline__ unsigned f2bf(float f) { unsigned u = __builtin_bit_cast(unsigned, f); return (u + 0x7fffu + ((u >> 16) & 1u)) >> 16; }
__device__ __forceinline__ unsigned pk2(float lo, float hi) { return f2bf(lo) | (f2bf(hi) << 16); }
__device__ __forceinline__ unsigned pk4_fp8(float a, float b, float c, float d) { int w = 0; w = __builtin_amdgcn_cvt_pk_fp8_f32(a, b, w, false); w = __builtin_amdgcn_cvt_pk_fp8_f32(c, d, w, true); return (unsigned)w; }
__device__ __forceinline__ float bflo(unsigned u) { return __builtin_bit_cast(float, u << 16); }
__device__ __forceinline__ float bfhi(unsigned u) { return __builtin_bit_cast(float, u & 0xffff0000u); }
__device__ __forceinline__ float bf2f(bf16 b) { return __builtin_bit_cast(float, ((unsigned)b) << 16); }
__device__ __forceinline__ float wave_sum(float v) {
#pragma unroll
    for (int o = 1; o < 64; o <<= 1) v += __shfl_xor(v, o);
    return v;
}
__device__ __forceinline__ float sigmoidf_(float x) { return 1.f / (1.f + __expf(-x)); }
__device__ __forceinline__ float softplusf_(float x) { return fmaxf(x, 0.f) + log1pf(__expf(-fabsf(x))); }

namespace pg8 {
constexpr int BM = 256, BK = 64, HALF = 128, HTB = HALF * BK * 2, STAGE_BYTES = 8 * HTB, NXCD = 8, WGM = 8;
__host__ __device__ __forceinline__ int lds_byte(int r, int c) { return r * 128 + (((c >> 3) ^ ((r >> 1) & 7)) << 4) + (c & 7) * 2; }
__host__ __device__ __forceinline__ void stage_rc(int b, int& R, int& C) { R = b >> 7; C = ((((b & 127) >> 4) ^ ((R >> 1) & 7)) << 3); }
__host__ __device__ __forceinline__ int perm32(int rho) { const int n = rho >> 4, i = rho & 15; return 8 * (i >> 2) + 4 * n + (i & 3); }

struct Unit { int rowA, rowB, pn, e, rk0, cnt; };
struct Gemm { const bf16* A; const bf16* Bt; int lda, ldb, K; const int* list; };

struct StaticOrder {
    int nM, nN, nwg, G, c;
    __device__ void init(int M, int N, int G_, int c_) { nM = M / BM; nN = N / BM; nwg = nM * nN; G = G_; c = c_; }
    __device__ bool next(int i, Unit& u) const {
        const long L = (long)i * G + c; if (L >= nwg) return false;
        int wgid = (int)L; { const int q = nwg / NXCD, r = nwg % NXCD, xcd = wgid % NXCD, off = wgid / NXCD; wgid = (xcd < r ? xcd * (q + 1) : r * (q + 1) + (xcd - r) * q) + off; }
        const int nig = WGM * nN, gid = wgid / nig, fm = gid * WGM, gsz = (nM - fm) < WGM ? (nM - fm) : WGM;
        const int pm = fm + ((wgid % nig) % gsz); u.pn = (wgid % nig) / gsz; u.rowA = pm * BM; u.rowB = u.pn * BM; u.e = 0; u.rk0 = 0; u.cnt = 0; return true;
    }
};
struct ProbeOrder {
    StaticOrder so; int mode;
    __device__ bool next(int i, Unit& u) const { if (!so.next(i, u)) return false; u.e = (u.rowA >> 8) * 64 + u.pn; if (mode & 1) u.rowA = 0; if (mode & 2) u.rowB = 0; return true; }
};
struct MoeOrder {
    const volatile LAS int* tab; int nct, rowsB, G, c;
    __device__ bool next(int i, Unit& u) const {
        const int L = i * G + c; const int total = __builtin_amdgcn_readfirstlane(tab[32]); if (L >= total) return false;
        int e = 0;
        for (; e < 31; ++e) { if (L < __builtin_amdgcn_readfirstlane(tab[e + 1])) break; }
        const int local = L - __builtin_amdgcn_readfirstlane(tab[e]); const int nt = __builtin_amdgcn_readfirstlane(tab[72 + e]);
        const int ct = local / nt, rt = local - ct * nt;
        u.rowA = __builtin_amdgcn_readfirstlane(tab[36 + e]) + rt * BM; u.rowB = e * rowsB + ct * BM; u.pn = ct; u.e = e; u.rk0 = rt * BM; u.cnt = __builtin_amdgcn_readfirstlane(tab[108 + e]); return true;
    }
};

__device__ __forceinline__ unsigned cvt_pk_bf16(float lo, float hi) { unsigned r; asm volatile("v_cvt_pk_bf16_f32 %0, %1, %2" : "=v"(r) : "v"(lo), "v"(hi)); return r; }

struct EpiBf16 {
    static constexpr bool PERM = true;
    bf16* O; int ldc; const float* bias; int bias_estride; float scale;
    __device__ __forceinline__ void operator()(const f32x4 (&acc)[2][2][4][2], const Unit& u, int wr, int wc, int fr, int fq) const {
        const int row0 = u.rowA + wr * 64 + fr, col0 = u.pn * BM + wc * 32 + 8 * fq;
        f32x4 bv[2][2];
#pragma unroll
        for (int bj = 0; bj < 2; ++bj)
#pragma unroll
            for (int n = 0; n < 2; ++n) bv[bj][n] = bias ? *(const f32x4*)(bias + (size_t)u.e * bias_estride + col0 + bj * HALF + 4 * n) : (f32x4){0.f, 0.f, 0.f, 0.f};
#pragma unroll
        for (int ai = 0; ai < 2; ++ai)
#pragma unroll
            for (int m = 0; m < 4; ++m) { bf16* rowp = O + (size_t)(row0 + ai * HALF + m * 16) * ldc + col0;
#pragma unroll
                for (int bj = 0; bj < 2; ++bj) { const f32x4 v0 = acc[ai][bj][m][0] * scale + bv[bj][0], v1 = acc[ai][bj][m][1] * scale + bv[bj][1];
                    v4u w; w.x = cvt_pk_bf16(v0[0], v0[1]); w.y = cvt_pk_bf16(v0[2], v0[3]); w.z = cvt_pk_bf16(v1[0], v1[1]); w.w = cvt_pk_bf16(v1[2], v1[3]);
                    *(v4u*)(rowp + bj * HALF) = w; } }
    }
};
struct EpiProbe {
    static constexpr bool PERM = true;
    bf16* O;
    __device__ __forceinline__ void operator()(const f32x4 (&acc)[2][2][4][2], const Unit& u, int wr, int wc, int fr, int fq) const {
        const int pm = u.e >> 6, pn = u.e & 63; const int row0 = pm * BM + wr * 64 + fr, col0 = pn * BM + wc * 32 + 8 * fq;
#pragma unroll
        for (int ai = 0; ai < 2; ++ai)
#pragma unroll
            for (int m = 0; m < 4; ++m) { bf16* rowp = O + (size_t)(row0 + ai * HALF + m * 16) * PLD + col0;
#pragma unroll
                for (int bj = 0; bj < 2; ++bj) { const f32x4 v0 = acc[ai][bj][m][0], v1 = acc[ai][bj][m][1];
                    v4u w; w.x = cvt_pk_bf16(v0[0], v0[1]); w.y = cvt_pk_bf16(v0[2], v0[3]); w.z = cvt_pk_bf16(v1[0], v1[1]); w.w = cvt_pk_bf16(v1[2], v1[3]);
                    *(v4u*)(rowp + bj * HALF) = w; } }
    }
};
template <bool ADD> struct EpiGate {
    static constexpr bool PERM = true;
    bf16* O; const bf16* P; const float* bm; int gcol;
    __device__ __forceinline__ void operator()(const f32x4 (&acc)[2][2][4][2], const Unit& u, int wr, int wc, int fr, int fq) const {
        const int row0 = u.rowA + wr * 64 + fr, col0 = u.pn * BM + wc * 32 + 8 * fq;
        f32x4 bv[2][2];
#pragma unroll
        for (int bj = 0; bj < 2; ++bj)
#pragma unroll
            for (int n = 0; n < 2; ++n) bv[bj][n] = *(const f32x4*)(bm + col0 + bj * HALF + 4 * n);
#pragma unroll
        for (int ai = 0; ai < 2; ++ai)
#pragma unroll
            for (int m = 0; m < 4; ++m) { const size_t row = (size_t)(row0 + ai * HALF + m * 16);
#pragma unroll
                for (int bj = 0; bj < 2; ++bj) {
                    const v4u pg = *(const v4u*)(P + row * PLD + gcol + col0 + bj * HALF);
                    bf16* op = O + row * D + col0 + bj * HALF;
                    float g[8] = {bflo(pg.x), bfhi(pg.x), bflo(pg.y), bfhi(pg.y), bflo(pg.z), bfhi(pg.z), bflo(pg.w), bfhi(pg.w)};
                    float r[8];
#pragma unroll
                    for (int j = 0; j < 4; ++j) { r[j] = sigmoidf_(g[j] + bv[bj][0][j]) * acc[ai][bj][m][0][j]; r[4 + j] = sigmoidf_(g[4 + j] + bv[bj][1][j]) * acc[ai][bj][m][1][j]; }
                    if (ADD) { const v4u pv = *(const v4u*)op;
                        r[0] += bflo(pv.x); r[1] += bfhi(pv.x); r[2] += bflo(pv.y); r[3] += bfhi(pv.y); r[4] += bflo(pv.z); r[5] += bfhi(pv.z); r[6] += bflo(pv.w); r[7] += bfhi(pv.w); }
                    v4u w; w.x = cvt_pk_bf16(r[0], r[1]); w.y = cvt_pk_bf16(r[2], r[3]); w.z = cvt_pk_bf16(r[4], r[5]); w.w = cvt_pk_bf16(r[6], r[7]);
                    *(v4u*)op = w; } }
    }
};
struct EpiResF32 {
    static constexpr bool PERM = false;
    float* O; const float* X;
    __device__ __forceinline__ void operator()(const f32x4 (&acc)[2][2][4][2], const Unit& u, int wr, int wc, int fr, int fq) const {
        const int row0 = u.rowA + wr * 64 + fr, col0 = u.pn * BM + wc * 32 + 4 * fq;
#pragma unroll
        for (int ai = 0; ai < 2; ++ai)
#pragma unroll
            for (int m = 0; m < 4; ++m) { const size_t ro = (size_t)(row0 + ai * HALF + m * 16) * D + col0;
#pragma unroll
                for (int bj = 0; bj < 2; ++bj)
#pragma unroll
                    for (int n = 0; n < 2; ++n) *(f32x4*)(O + ro + bj * HALF + n * 16) = acc[ai][bj][m][n] + __builtin_nontemporal_load((const f32x4*)(X + ro + bj * HALF + n * 16)); }
    }
};
struct EpiGlu {
    static constexpr bool PERM = true;
    bf16* O; const float* bg; const float* bu;
    __device__ __forceinline__ void operator()(const f32x4 (&acc)[2][2][4][2], const Unit& u, int wr, int wc, int fr, int fq) const {
        const int row0 = u.rowA + wr * 64 + fr, col0 = u.pn * HALF + wc * 32 + 8 * fq;
        f32x4 gb[2], ub[2];
#pragma unroll
        for (int n = 0; n < 2; ++n) { gb[n] = *(const f32x4*)(bg + (size_t)u.e * FF + col0 + 4 * n); ub[n] = *(const f32x4*)(bu + (size_t)u.e * FF + col0 + 4 * n); }
#pragma unroll
        for (int ai = 0; ai < 2; ++ai)
#pragma unroll
            for (int m = 0; m < 4; ++m) { bf16* op = O + (size_t)(row0 + ai * HALF + m * 16) * FF + col0;
                float r[8];
#pragma unroll
                for (int n = 0; n < 2; ++n)
#pragma unroll
                    for (int j = 0; j < 4; ++j) { float g = fminf(acc[ai][0][m][n][j] + gb[n][j], 7.f); float up = fminf(fmaxf(acc[ai][1][m][n][j] + ub[n][j], -7.f), 7.f);
                        r[4 * n + j] = (up + 1.f) * g * sigmoidf_(1.702f * g); }
                v4u w; w.x = cvt_pk_bf16(r[0], r[1]); w.y = cvt_pk_bf16(r[2], r[3]); w.z = cvt_pk_bf16(r[4], r[5]); w.w = cvt_pk_bf16(r[6], r[7]);
                *(v4u*)op = w; }
    }
};

struct EpiGluQ {
    static constexpr bool PERM = true;
    unsigned char* O; const float* bg; const float* bu;
    __device__ __forceinline__ void operator()(const f32x4 (&acc)[2][2][4][2], const Unit& u, int wr, int wc, int fr, int fq) const {
        const int row0 = u.rowA + wr * 64 + fr, col0 = u.pn * HALF + wc * 32 + 8 * fq;
        f32x4 gb[2], ub[2];
#pragma unroll
        for (int n = 0; n < 2; ++n) { gb[n] = *(const f32x4*)(bg + (size_t)u.e * FF + col0 + 4 * n); ub[n] = *(const f32x4*)(bu + (size_t)u.e * FF + col0 + 4 * n); }
#pragma unroll
        for (int ai = 0; ai < 2; ++ai)
#pragma unroll
            for (int m = 0; m < 4; ++m) { unsigned char* op = O + (size_t)(row0 + ai * HALF + m * 16) * FF + col0;
                float r[8];
#pragma unroll
                for (int n = 0; n < 2; ++n)
#pragma unroll
                    for (int j = 0; j < 4; ++j) { float g = fminf(acc[ai][0][m][n][j] * WQ_INV + gb[n][j], 7.f); float up = fminf(fmaxf(acc[ai][1][m][n][j] * WQ_INV + ub[n][j], -7.f), 7.f);
                        r[4 * n + j] = (up + 1.f) * g * sigmoidf_(1.702f * g); }
                v2u w; w.x = pk4_fp8(r[0], r[1], r[2], r[3]); w.y = pk4_fp8(r[4], r[5], r[6], r[7]);
                *(v2u*)op = w; }
    }
};

template <class Epi, class Sched, int ESZ = 2, bool GATHER = false, bool ALIGN_EPI = true>
__device__ __forceinline__ void gemm_phase(LAS unsigned char* lds, const Gemm g, const Sched& S, const Epi& E) {
    const int tid = threadIdx.x, wid = __builtin_amdgcn_readfirstlane(tid >> 6), lane = tid & 63, wr = wid >> 2, wc = wid & 3, fr = lane & 15, fq = lane >> 4;
    const int K = g.K, nt = K * ESZ / (BK * 2);
    unsigned voffA[2], voffB[2]; int Rst[2], Cst[2];
#pragma unroll
    for (int i = 0; i < 2; ++i) { int R, C; stage_rc(tid * 16 + i * 8192, R, C); const int Rb = Epi::PERM ? ((R & ~31) + perm32(R & 31)) : R; Rst[i] = R; Cst[i] = C * 2;
        voffA[i] = (unsigned)(R * g.lda * ESZ + C * 2); voffB[i] = (unsigned)(Rb * g.ldb * ESZ + C * 2); }
    const size_t kstep = (size_t)(BK * 2);
    const size_t hstepA = (size_t)HALF * g.lda * ESZ, hstepB = (size_t)HALF * g.ldb * ESZ;
    const unsigned ldsw = (unsigned)wid * 1024u;
    const int aoff = lds_byte(wr * 64 + fr, fq * 8), boff = lds_byte(wc * 32 + fr, fq * 8);
#define PG8_SA(b, h) (((b) * 2 + (h)) * HTB)
#define PG8_SB(b, h) ((4 + (b) * 2 + (h)) * HTB)
#define PG8_STAGE(bufoff, gbase, voff) do { _Pragma("unroll") for (int _i = 0; _i < 2; ++_i) \
        __builtin_amdgcn_global_load_lds((const unsigned*)((const char*)(gbase) + (voff)[_i]), (LAS unsigned*)(lds + (bufoff) + ldsw + _i * 8192), 16, 0, 0); } while (0)
#define PG8_GOFF(u_, v_) do { _Pragma("unroll") for (int h_ = 0; h_ < 2; ++h_) _Pragma("unroll") for (int i_ = 0; i_ < 2; ++i_) { const int rk_ = (u_).rk0 + 128 * h_ + Rst[i_]; \
        const int tok_ = rk_ < (u_).cnt ? g.list[(u_).e * 8192 + rk_] : 0; (v_)[h_][i_] = (unsigned)tok_ * (unsigned)(g.lda * ESZ) + (unsigned)Cst[i_]; } } while (0)
#define PG8_STAGE_A(bufoff, isnext, tt, h) do { if constexpr (GATHER) { unsigned vo_[2] = {(isnext) ? vN[h][0] : vA[h][0], (isnext) ? vN[h][1] : vA[h][1]}; PG8_STAGE(bufoff, (const char*)g.A + (size_t)(tt) * kstep, vo_); } \
        else PG8_STAGE(bufoff, ((isnext) ? nA : cA) + (size_t)(tt) * kstep + (size_t)(h) * hstepA, voffA); } while (0)
#define PG8_LD16(off_) (*(const LAS v4i*)(lds + (off_)))
#define PG8_LDA(dst, b, h) do { if constexpr (ESZ == 2) { _Pragma("unroll") for (int m = 0; m < 4; ++m) _Pragma("unroll") for (int k = 0; k < 2; ++k) dst[m][k] = *(const LAS bf16x8*)(lds + PG8_SA(b, h) + (k ? (aoff ^ 64) : aoff) + m * 2048); } \
        else { _Pragma("unroll") for (int m = 0; m < 4; ++m) dst##8[m] = __builtin_shufflevector(PG8_LD16(PG8_SA(b, h) + aoff + m * 2048), PG8_LD16(PG8_SA(b, h) + (aoff ^ 64) + m * 2048), 0, 1, 2, 3, 4, 5, 6, 7); } } while (0)
#define PG8_LDB(dst, b, h) do { if constexpr (ESZ == 2) { _Pragma("unroll") for (int n = 0; n < 2; ++n) _Pragma("unroll") for (int k = 0; k < 2; ++k) dst[n][k] = *(const LAS bf16x8*)(lds + PG8_SB(b, h) + (k ? (boff ^ 64) : boff) + n * 2048); } \
        else { _Pragma("unroll") for (int n = 0; n < 2; ++n) dst##8[n] = __builtin_shufflevector(PG8_LD16(PG8_SB(b, h) + boff + n * 2048), PG8_LD16(PG8_SB(b, h) + (boff ^ 64) + n * 2048), 0, 1, 2, 3, 4, 5, 6, 7); } } while (0)
#define PG8_MMA(ai, bj, At, Bt) do { __builtin_amdgcn_s_setprio(1); _Pragma("unroll") for (int m = 0; m < 4; ++m) _Pragma("unroll") for (int n = 0; n < 2; ++n) { \
        if constexpr (ESZ == 2) { _Pragma("unroll") for (int k = 0; k < 2; ++k) acc[ai][bj][m][n] = __builtin_amdgcn_mfma_f32_16x16x32_bf16(Bt[n][k], At[m][k], acc[ai][bj][m][n], 0, 0, 0); } \
        else asm volatile("s_nop 1\n\tv_mfma_scale_f32_16x16x128_f8f6f4 %0, %1, %2, %0, %3, %3 op_sel_hi:[0,0,0]" : "+v"(acc[ai][bj][m][n]) : "v"(Bt##8[n]), "v"(At##8[m]), "v"(one_scale)); } \
        __builtin_amdgcn_s_setprio(0); } while (0)
#define PG8_WAIT_V(n) asm volatile("s_waitcnt vmcnt(" #n ")" ::: "memory")
#define PG8_WAIT_L(n) asm volatile("s_waitcnt lgkmcnt(" #n ")" ::: "memory")
#define PG8_BAR __builtin_amdgcn_s_barrier()
#define PG8_SCHED __builtin_amdgcn_sched_barrier(0)
    Unit cur, nxt; int ui = 0;
    if (!S.next(0, cur)) return;
    f32x4 acc[2][2][4][2];
#pragma unroll
    for (int a = 0; a < 2; ++a)
#pragma unroll
        for (int b = 0; b < 2; ++b)
#pragma unroll
            for (int m = 0; m < 4; ++m)
#pragma unroll
                for (int n = 0; n < 2; ++n) acc[a][b][m][n] = (f32x4){0.f, 0.f, 0.f, 0.f};
    const int one_scale = 0x7F7F7F7F;
    bf16x8 At[4][2], B0[2][2], B1[2][2]; v8i At8[4], B08[2], B18[2];
    const char* cA = (const char*)g.A + (size_t)cur.rowA * g.lda * ESZ; const char* cB = (const char*)g.Bt + (size_t)cur.rowB * g.ldb * ESZ;
    unsigned vA[2][2] = {{0u, 0u}, {0u, 0u}}, vN[2][2] = {{0u, 0u}, {0u, 0u}}; const char* nA = cA;
    if constexpr (GATHER) PG8_GOFF(cur, vA);
    PG8_STAGE(PG8_SB(0, 0), cB, voffB); PG8_STAGE(PG8_SB(0, 1), cB + hstepB, voffB); PG8_STAGE_A(PG8_SA(0, 0), false, 0, 0); PG8_STAGE_A(PG8_SA(0, 1), false, 0, 1);
    if (wr == 1) PG8_BAR;
    PG8_WAIT_V(2); PG8_BAR;
    PG8_STAGE(PG8_SB(1, 0), cB + kstep, voffB); PG8_STAGE_A(PG8_SA(1, 0), false, 1, 0); PG8_STAGE(PG8_SB(1, 1), cB + hstepB + kstep, voffB);
    PG8_WAIT_V(6); PG8_BAR;
    for (;;) {
        const bool has_next = S.next(ui + 1, nxt);
        nA = has_next ? (const char*)g.A + (size_t)nxt.rowA * g.lda * ESZ : cA; const char* nB = has_next ? (const char*)g.Bt + (size_t)nxt.rowB * g.ldb * ESZ : cB;
        if constexpr (GATHER) { if (has_next) PG8_GOFF(nxt, vN); else { vN[0][0] = vA[0][0]; vN[0][1] = vA[0][1]; vN[1][0] = vA[1][0]; vN[1][1] = vA[1][1]; } }
        for (int t = 0; t < nt; t += 2) {
            const bool last = (t == nt - 2);
            const char* b2 = last ? nB : cB + (size_t)(t + 2) * kstep; const char* b3 = b2 + kstep;
            const int t2 = last ? 0 : t + 2, t3 = last ? 1 : t + 3;
            PG8_LDB(B0, 0, 0); PG8_LDB(B1, 0, 1); PG8_SCHED; PG8_LDA(At, 0, 0); PG8_STAGE_A(PG8_SA(1, 1), false, t + 1, 1);
            PG8_WAIT_V(8); PG8_WAIT_L(0); PG8_BAR; PG8_MMA(0, 0, At, B0); PG8_MMA(0, 1, At, B1); PG8_BAR; PG8_SCHED;
            PG8_LDA(At, 0, 1); PG8_STAGE(PG8_SB(0, 0), b2, voffB); PG8_STAGE(PG8_SB(0, 1), b2 + hstepB, voffB); PG8_STAGE_A(PG8_SA(0, 0), last, t2, 0);
            PG8_WAIT_V(8); PG8_WAIT_L(0); PG8_BAR; PG8_MMA(1, 0, At, B0); PG8_MMA(1, 1, At, B1); PG8_BAR; PG8_SCHED;
            PG8_LDB(B0, 1, 0); PG8_LDB(B1, 1, 1); PG8_SCHED; PG8_LDA(At, 1, 0); PG8_STAGE_A(PG8_SA(0, 1), last, t2, 1);
            PG8_WAIT_V(8); PG8_WAIT_L(0); PG8_BAR; PG8_MMA(0, 0, At, B0); PG8_MMA(0, 1, At, B1); PG8_BAR; PG8_SCHED;
            PG8_LDA(At, 1, 1); PG8_STAGE(PG8_SB(1, 0), b3, voffB); PG8_STAGE(PG8_SB(1, 1), b3 + hstepB, voffB); PG8_STAGE_A(PG8_SA(1, 0), last, t3, 0);
            PG8_WAIT_V(8); PG8_WAIT_L(0); PG8_BAR; PG8_MMA(1, 0, At, B0); PG8_MMA(1, 1, At, B1); PG8_BAR; PG8_SCHED;
        }
        if constexpr (ESZ == 1) asm volatile("s_nop 15\n\ts_nop 15" ::: "memory");
        if constexpr (ALIGN_EPI) { if (wr == 0) PG8_BAR; }
        E(acc, cur, wr, wc, fr, fq);
        if (!has_next) break;
#pragma unroll
        for (int a = 0; a < 2; ++a)
#pragma unroll
            for (int b = 0; b < 2; ++b)
#pragma unroll
                for (int m = 0; m < 4; ++m)
#pragma unroll
                    for (int n = 0; n < 2; ++n) acc[a][b][m][n] = (f32x4){0.f, 0.f, 0.f, 0.f};
        cur = nxt; cA = nA; cB = nB; ++ui;
        if constexpr (GATHER) { vA[0][0] = vN[0][0]; vA[0][1] = vN[0][1]; vA[1][0] = vN[1][0]; vA[1][1] = vN[1][1]; }
        if constexpr (ALIGN_EPI) { if (wr == 1) PG8_BAR; }
    }
    PG8_WAIT_V(0);
    if constexpr (!ALIGN_EPI) { if (wr == 0) PG8_BAR; }
    PG8_BAR;
#undef PG8_SA
#undef PG8_SB
#undef PG8_STAGE
#undef PG8_LDA
#undef PG8_LD16
#undef PG8_GOFF
#undef PG8_STAGE_A
#undef PG8_LDB
#undef PG8_MMA
#undef PG8_WAIT_V
#undef PG8_WAIT_L
#undef PG8_BAR
#undef PG8_SCHED
}

typedef short s16x4 __attribute__((ext_vector_type(4)));
struct UnitF { int rowA, pn, e; const float* b0; const float* b1; };
struct GemmF { const bf16* A; int lda, K, ldbn; };
struct MoeOrderF {
    const volatile LAS int* tab; int nct, G, c; const float* w0; const float* w1; size_t estride; int cstep;
    __device__ bool next(int i, UnitF& u) const {
        const int L = i * G + c; const int total = __builtin_amdgcn_readfirstlane(tab[32]); if (L >= total) return false;
        int e = 0;
        for (; e < 31; ++e) { if (L < __builtin_amdgcn_readfirstlane(tab[e + 1])) break; }
        const int local = L - __builtin_amdgcn_readfirstlane(tab[e]); const int nt = __builtin_amdgcn_readfirstlane(tab[72 + e]);
        const int ct = local / nt, rt = local - ct * nt;
        u.rowA = __builtin_amdgcn_readfirstlane(tab[36 + e]) + rt * BM; u.pn = ct; u.e = e;
        u.b0 = w0 + (size_t)e * estride + (size_t)ct * cstep; u.b1 = w1 + (size_t)e * estride + (size_t)ct * cstep; return true;
    }
};
struct EpiGluNP {
    bf16* O; const float* bg; const float* bu;
    __device__ __forceinline__ void operator()(const f32x4 (&acc)[2][2][4][2], const UnitF& u, int wr, int wc, int fr, int fq) const {
        const int row0 = u.rowA + wr * 64 + fr, col0 = u.pn * HALF + wc * 32 + 4 * fq;
        f32x4 gb[2], ub[2];
#pragma unroll
        for (int n = 0; n < 2; ++n) { gb[n] = *(const f32x4*)(bg + (size_t)u.e * FF + col0 + 16 * n); ub[n] = *(const f32x4*)(bu + (size_t)u.e * FF + col0 + 16 * n); }
#pragma unroll
        for (int ai = 0; ai < 2; ++ai)
#pragma unroll
            for (int m = 0; m < 4; ++m) { bf16* op = O + (size_t)(row0 + ai * HALF + m * 16) * FF + col0;
#pragma unroll
                for (int n = 0; n < 2; ++n) { float r[4];
#pragma unroll
                    for (int j = 0; j < 4; ++j) { const float gg = fminf(acc[ai][0][m][n][j] + gb[n][j], 7.f); const float up = fminf(fmaxf(acc[ai][1][m][n][j] + ub[n][j], -7.f), 7.f);
                        r[j] = (up + 1.f) * gg * sigmoidf_(1.702f * gg); }
                    v2u w; w.x = cvt_pk_bf16(r[0], r[1]); w.y = cvt_pk_bf16(r[2], r[3]); *(v2u*)(op + 16 * n) = w; } }
    }
};
struct EpiBf16NP {
    bf16* O; int ldc; const float* bias; int bias_estride;
    __device__ __forceinline__ void operator()(const f32x4 (&acc)[2][2][4][2], const UnitF& u, int wr, int wc, int fr, int fq) const {
        const int row0 = u.rowA + wr * 64 + fr, col0 = u.pn * BM + wc * 32 + 4 * fq;
        f32x4 bv[2][2];
#pragma unroll
        for (int bj = 0; bj < 2; ++bj)
#pragma unroll
            for (int n = 0; n < 2; ++n) bv[bj][n] = *(const f32x4*)(bias + (size_t)u.e * bias_estride + col0 + bj * HALF + 16 * n);
#pragma unroll
        for (int ai = 0; ai < 2; ++ai)
#pragma unroll
            for (int m = 0; m < 4; ++m) { bf16* rowp = O + (size_t)(row0 + ai * HALF + m * 16) * ldc + col0;
#pragma unroll
                for (int bj = 0; bj < 2; ++bj)
#pragma unroll
                    for (int n = 0; n < 2; ++n) { const f32x4 v = acc[ai][bj][m][n] + bv[bj][n]; v2u w; w.x = cvt_pk_bf16(v[0], v[1]); w.y = cvt_pk_bf16(v[2], v[3]); *(v2u*)(rowp + bj * HALF + 16 * n) = w; } }
    }
};
template <class Epi, class Sched>
__device__ __forceinline__ void gemm_phase_f32b(LAS unsigned char* lds, const GemmF g, const Sched& S, const Epi& E) {
    const int tid = threadIdx.x, wid = __builtin_amdgcn_readfirstlane(tid >> 6), lane = tid & 63, wr = wid >> 2, wc = wid & 3, fr = lane & 15, fq = lane >> 4;
    const int K = g.K, nt = K / BK;
    unsigned voffA[2];
#pragma unroll
    for (int i = 0; i < 2; ++i) { int R, C; stage_rc(tid * 16 + i * 8192, R, C); voffA[i] = (unsigned)(R * g.lda + C) * 2u; }
    const size_t kstep = (size_t)(BK * 2);
    const size_t hstepA = (size_t)HALF * g.lda * 2;
    const unsigned ldsw = (unsigned)wid * 1024u;
    const int aoff = lds_byte(wr * 64 + fr, fq * 8);
    const int ldsb = (int)(uintptr_t)lds;
    const int q4 = (lane & 15) >> 2, p4 = lane & 3;
    const int fsw = q4 | ((fq & 1) << 2);
    int rbase[2];
#pragma unroll
    for (int n = 0; n < 2; ++n) rbase[n] = (8 * fq + q4) * 256 + ((((wc * 2) ^ fsw) ^ n) * 32) + 8 * p4;
    const int hB = wid >> 2, r0 = 2 * (wid & 3) + (lane >> 5), l31 = lane & 31;
    const int wslot = (l31 >> 2) ^ (r0 & 3);
    const int wb0 = hB * HTB + r0 * 256 + wslot * 32 + (lane & 3) * 8, wb1 = hB * HTB + r0 * 256 + (wslot ^ 4) * 32 + (lane & 3) * 8;
    const unsigned laneoffB = (unsigned)(r0 * g.ldbn + 4 * l31) * 4u;
    const size_t rstep8 = (size_t)8 * g.ldbn * 4, tstepB = (size_t)64 * g.ldbn * 4;
#define PG8_SA(b, h) (((b) * 2 + (h)) * HTB)
#define PG8_SB(b, h) ((4 + (b) * 2 + (h)) * HTB)
#define PG8_STAGE(bufoff, gbase, voff) do { _Pragma("unroll") for (int _i = 0; _i < 2; ++_i) { unsigned keep_; \
        asm volatile("s_mov_b32 %0, m0\n\ts_mov_b32 m0, %2\n\ts_nop 0\n\tglobal_load_lds_dwordx4 %1, off\n\ts_mov_b32 m0, %0" : "=&s"(keep_) \
            : "v"((const char*)(gbase) + (voff)[_i]), "s"(__builtin_amdgcn_readfirstlane(ldsb + (bufoff) + (int)ldsw + _i * 8192)) : "memory"); } } while (0)
#define PG8_LDA(dst, b, h) do { _Pragma("unroll") for (int m = 0; m < 4; ++m) _Pragma("unroll") for (int k = 0; k < 2; ++k) dst[m][k] = *(const LAS bf16x8*)(lds + PG8_SA(b, h) + (k ? (aoff ^ 64) : aoff) + m * 2048); } while (0)
#define PG8_LDBT(dst, b, h) do { _Pragma("unroll") for (int n = 0; n < 2; ++n) _Pragma("unroll") for (int k = 0; k < 2; ++k) { \
        const s16x4 lo_ = __builtin_amdgcn_ds_read_tr16_b64_v4i16((LAS s16x4*)(lds + PG8_SB(b, h) + rbase[n] + k * 8192)); \
        const s16x4 hi_ = __builtin_amdgcn_ds_read_tr16_b64_v4i16((LAS s16x4*)(lds + PG8_SB(b, h) + rbase[n] + k * 8192 + 1024)); \
        dst[n][k] = __builtin_shufflevector(lo_, hi_, 0, 1, 2, 3, 4, 5, 6, 7); } } while (0)
#define PG8_BPTR(p0, p1, tt) ((const char*)(hB ? (p1) : (p0)) + (size_t)(tt) * tstepB)
#define PG8_LOADB1(pb, i) dreg[i] = *(const f32x4*)((pb) + (size_t)(i) * rstep8 + laneoffB)
#define PG8_LOADB(p0, p1, tt) do { const char* pb_ = PG8_BPTR(p0, p1, tt); _Pragma("unroll") for (int _i = 0; _i < 8; ++_i) PG8_LOADB1(pb_, _i); } while (0)
#define PG8_WRITEB1(b, i) do { v2u pk_; pk_.x = cvt_pk_bf16(dreg[i].x, dreg[i].y); pk_.y = cvt_pk_bf16(dreg[i].z, dreg[i].w); \
        *(LAS v2u*)(lds + PG8_SB(b, 0) + (((i) & 1) ? wb1 : wb0) + (i) * 2048) = pk_; } while (0)
#define PG8_WRITEB(b) do { _Pragma("unroll") for (int _i = 0; _i < 8; ++_i) PG8_WRITEB1(b, _i); } while (0)
#define PG8_MF(ai, bj, m, At, Bt) do { _Pragma("unroll") for (int n = 0; n < 2; ++n) _Pragma("unroll") for (int k = 0; k < 2; ++k) \
        acc[ai][bj][m][n] = __builtin_amdgcn_mfma_f32_16x16x32_bf16(Bt[n][k], At[m][k], acc[ai][bj][m][n], 0, 0, 0); } while (0)
#define PG8_MMA(ai, bj, At, Bt) do { __builtin_amdgcn_s_setprio(1); _Pragma("unroll") for (int m = 0; m < 4; ++m) PG8_MF(ai, bj, m, At, Bt); __builtin_amdgcn_s_setprio(0); } while (0)
#define PG8_MMA_CVT(ai, bj, At, Bt, b) do { __builtin_amdgcn_s_setprio(1); _Pragma("unroll") for (int m = 0; m < 4; ++m) { PG8_MF(ai, bj, m, At, Bt); PG8_WRITEB1(b, 2 * m); PG8_WRITEB1(b, 2 * m + 1); PG8_SCHED; } __builtin_amdgcn_s_setprio(0); } while (0)
#define PG8_MMA_LD(ai, bj, At, Bt, pb) do { __builtin_amdgcn_s_setprio(1); _Pragma("unroll") for (int m = 0; m < 4; ++m) { PG8_MF(ai, bj, m, At, Bt); PG8_LOADB1(pb, 2 * m); PG8_LOADB1(pb, 2 * m + 1); PG8_SCHED; } __builtin_amdgcn_s_setprio(0); } while (0)
#define PG8_WAIT_V(n) asm volatile("s_waitcnt vmcnt(" #n ")" ::: "memory")
#define PG8_WAIT_L(n) asm volatile("s_waitcnt lgkmcnt(" #n ")" ::: "memory")
#define PG8_BAR __builtin_amdgcn_s_barrier()
#define PG8_SCHED __builtin_amdgcn_sched_barrier(0)
#define PG8_BS0(T) ((T) >= nt ? nb0 : cur.b0)
#define PG8_BS1(T) ((T) >= nt ? nb1 : cur.b1)
#define PG8_BT(T) ((T) >= nt ? (T) - nt : (T))
    UnitF cur, nxt; int ui = 0;
    if (!S.next(0, cur)) return;
    f32x4 acc[2][2][4][2];
#pragma unroll
    for (int a = 0; a < 2; ++a)
#pragma unroll
        for (int b = 0; b < 2; ++b)
#pragma unroll
            for (int m = 0; m < 4; ++m)
#pragma unroll
                for (int n = 0; n < 2; ++n) acc[a][b][m][n] = (f32x4){0.f, 0.f, 0.f, 0.f};
    bf16x8 At[4][2], B0[2][2], B1[2][2];
    f32x4 dreg[8];
    const char* cA = (const char*)g.A + (size_t)cur.rowA * g.lda * 2;
    PG8_STAGE(PG8_SA(0, 0), cA, voffA); PG8_STAGE(PG8_SA(0, 1), cA + hstepA, voffA); PG8_STAGE(PG8_SA(1, 0), cA + kstep, voffA);
    PG8_LOADB(cur.b0, cur.b1, 0); PG8_WRITEB(0); PG8_LOADB(cur.b0, cur.b1, 1); PG8_WRITEB(1); PG8_LOADB(cur.b0, cur.b1, 2);
    PG8_WAIT_V(8); PG8_WAIT_L(0);
    if (wr == 1) PG8_BAR;
    PG8_BAR;
    for (;;) {
        const bool has_next = S.next(ui + 1, nxt);
        const char* nA = has_next ? (const char*)g.A + (size_t)nxt.rowA * g.lda * 2 : cA;
        const float* nb0 = has_next ? nxt.b0 : cur.b0; const float* nb1 = has_next ? nxt.b1 : cur.b1;
        for (int t = 0; t < nt; t += 2) {
            const bool last = (t == nt - 2);
            const char* a1 = cA + (size_t)(t + 1) * kstep;
            const char* a2 = last ? nA : cA + (size_t)(t + 2) * kstep;
            const char* a3 = a2 + kstep;
            const char* pb3 = PG8_BPTR(PG8_BS0(t + 3), PG8_BS1(t + 3), PG8_BT(t + 3));
            const char* pb4 = PG8_BPTR(PG8_BS0(t + 4), PG8_BS1(t + 4), PG8_BT(t + 4));
            PG8_LDBT(B0, 0, 0); PG8_LDBT(B1, 0, 1); PG8_SCHED; PG8_LDA(At, 0, 0); PG8_STAGE(PG8_SA(1, 1), a1 + hstepA, voffA);
            PG8_WAIT_V(12); PG8_WAIT_L(0); PG8_SCHED; PG8_BAR; PG8_MMA(0, 0, At, B0); PG8_MMA(0, 1, At, B1); PG8_BAR; PG8_SCHED;
            PG8_LDA(At, 0, 1);
            PG8_WAIT_V(10); PG8_WAIT_L(0); PG8_SCHED; PG8_BAR; PG8_MMA_CVT(1, 0, At, B0, 0); PG8_STAGE(PG8_SA(0, 0), a2, voffA); PG8_MMA_LD(1, 1, At, B1, pb3); PG8_BAR; PG8_SCHED;
            PG8_LDBT(B0, 1, 0); PG8_LDBT(B1, 1, 1); PG8_SCHED; PG8_LDA(At, 1, 0); PG8_STAGE(PG8_SA(0, 1), a2 + hstepA, voffA);
            PG8_WAIT_V(12); PG8_WAIT_L(0); PG8_SCHED; PG8_BAR; PG8_MMA(0, 0, At, B0); PG8_MMA(0, 1, At, B1); PG8_BAR; PG8_SCHED;
            PG8_LDA(At, 1, 1);
            PG8_WAIT_V(10); PG8_WAIT_L(0); PG8_SCHED; PG8_BAR; PG8_MMA_CVT(1, 0, At, B0, 1); PG8_STAGE(PG8_SA(1, 0), a3, voffA); PG8_MMA_LD(1, 1, At, B1, pb4); PG8_BAR; PG8_SCHED;
        }
        if (wr == 0) PG8_BAR;
        E(acc, cur, wr, wc, fr, fq);
        if (!has_next) break;
#pragma unroll
        for (int a = 0; a < 2; ++a)
#pragma unroll
            for (int b = 0; b < 2; ++b)
#pragma unroll
                for (int m = 0; m < 4; ++m)
#pragma unroll
                    for (int n = 0; n < 2; ++n) acc[a][b][m][n] = (f32x4){0.f, 0.f, 0.f, 0.f};
        cur = nxt; cA = nA; ++ui;
        if (wr == 1) PG8_BAR;
    }
    PG8_WAIT_V(0);
    asm volatile("" :: "v"(dreg[0]), "v"(dreg[7]));
    PG8_BAR;
#undef PG8_SA
#undef PG8_SB
#undef PG8_STAGE
#undef PG8_LDA
#undef PG8_LDBT
#undef PG8_BPTR
#undef PG8_LOADB1
#undef PG8_LOADB
#undef PG8_WRITEB1
#undef PG8_WRITEB
#undef PG8_MF
#undef PG8_MMA
#undef PG8_MMA_CVT
#undef PG8_MMA_LD
#undef PG8_WAIT_V
#undef PG8_WAIT_L
#undef PG8_BAR
#undef PG8_SCHED
#undef PG8_BS0
#undef PG8_BS1
#undef PG8_BT
}
}

#define XB_TMO      128
#define XB_XCNT(j)  (256  + 64 * (j))
#define XB_XSUB(j)  (1280 + 64 * (j))
#define XB_XGEN(j)  (2304 + 64 * (j))
#define XB_TOP      3328
#define XB_TOPGEN   3392
#define XCD_BAR_WORDS 3456
#define XB_SPIN_CAP (1u << 18)
__device__ __forceinline__ unsigned xb_ld(unsigned* p)              { return __hip_atomic_load(p, __ATOMIC_RELAXED, __HIP_MEMORY_SCOPE_AGENT); }
__device__ __forceinline__ unsigned xb_add(unsigned* p, unsigned v) { return __hip_atomic_fetch_add(p, v, __ATOMIC_RELAXED, __HIP_MEMORY_SCOPE_AGENT); }
__device__ __forceinline__ unsigned xb_xcc_id() { return (unsigned)__builtin_amdgcn_s_getreg((3 << 11) | 20) & 0xFu; }
#define XB_SPIN(cond, bar) do { unsigned _sp = 0; while (cond) { __builtin_amdgcn_s_sleep(1); \
    if ((++_sp & 255u) == 0u) { if (xb_ld(&(bar)[XB_TMO])) break; if (_sp > XB_SPIN_CAP) { atomicAdd(&(bar)[XB_TMO], 1u); break; } } } } while (0)
struct XcdBarrier { unsigned* bar; unsigned x; volatile LAS unsigned* st; };
__device__ __forceinline__ XcdBarrier xcd_barrier_post(unsigned* bar, volatile LAS unsigned* st) {
    XcdBarrier b; b.bar = bar; b.x = xb_xcc_id(); b.st = st;
    if (threadIdx.x == 0) (void)xb_add(&bar[XB_XCNT(b.x)], 1u);
    return b;
}
__device__ __forceinline__ void xcd_barrier_complete(unsigned* bar, unsigned x, unsigned& nloc, unsigned& nx) {
    const unsigned G = gridDim.x * gridDim.y * gridDim.z;
    unsigned sum, cnt, mine, sp = 0u;
    for (;;) {
        sum = 0u; cnt = 0u; mine = 0u;
#pragma unroll
        for (unsigned j = 0; j < 16; ++j) { const unsigned c = xb_ld(&bar[XB_XCNT(j)]); sum += c; cnt += (c > 0u) ? 1u : 0u; mine = (j == x) ? c : mine; }
        if (sum == G) break;
        __builtin_amdgcn_s_sleep(1);
        if ((++sp & 255u) == 0u) { if (xb_ld(&bar[XB_TMO])) break; if (sp > XB_SPIN_CAP) { atomicAdd(&bar[XB_TMO], 1u); break; } }
    }
    nloc = mine > 0u ? mine : 1u; nx = cnt > 0u ? cnt : 1u;
}
__device__ __forceinline__ void xcd_barrier(const XcdBarrier& b) {
    asm volatile("s_waitcnt vmcnt(0)" ::: "memory");
    __syncthreads();
    if (threadIdx.x == 0) {
        unsigned* bar = b.bar;
        __builtin_amdgcn_s_waitcnt(0);
        unsigned nloc = b.st[0], nx = b.st[1];
        if (nloc == 0u) { xcd_barrier_complete(bar, b.x, nloc, nx); b.st[0] = nloc; b.st[1] = nx; }
        const unsigned old = xb_add(&bar[XB_XSUB(b.x)], 1u);
        const unsigned gen = old / nloc;
        if (old + 1u == (gen + 1u) * nloc) {
            __builtin_amdgcn_fence(__ATOMIC_RELEASE, "agent");
            asm volatile("s_waitcnt vmcnt(0)" ::: "memory");
            const unsigned og = xb_add(&bar[XB_TOP], 1u);
            const unsigned tg = og / nx;
            if (og + 1u == (tg + 1u) * nx) xb_add(&bar[XB_TOPGEN], 1u);
            else XB_SPIN(xb_ld(&bar[XB_TOPGEN]) == tg, bar);
            __builtin_amdgcn_fence(__ATOMIC_ACQUIRE, "agent");
            xb_add(&bar[XB_XGEN(b.x)], 1u);
            asm volatile("s_waitcnt vmcnt(0)" ::: "memory");
        } else {
            XB_SPIN(xb_ld(&bar[XB_XGEN(b.x)]) == gen, bar);
            __builtin_amdgcn_fence(__ATOMIC_ACQUIRE, "agent");
            asm volatile("s_waitcnt vmcnt(0)" ::: "memory");
        }
    }
    __syncthreads();
}

struct Args { const float* in[31]; float* out; unsigned char* ws; int ph_lo, ph_hi; };
enum { I_X = 0, I_NMG, I_WIN, I_MU, I_W0, I_W2, I_A0, I_A2, I_G2, I_KK, I_KA, I_RK, I_LNG, I_LNB, I_GWA2, I_GBA, I_GNG, I_BM, I_WBR, I_WBG, I_WOUT, I_NFG,
       I_WROUTER, I_BROUTER, I_WGATE, I_BGATE, I_WUP, I_BUP, I_WDOWN, I_BDOWN, I_NFINAL };
struct Frame {
    LAS unsigned char* lds; unsigned char* ws; unsigned* ctl;
    int tid, lane, wave, vcu, G;
};

__device__ __forceinline__ void tr_item(const float* W, int ldw, int nvalid, int k0, int n0, bf16* dst, int ldk, LAS float* scr, int lane) {
    const int c = lane & 31;
    const bool ok = (n0 + c) < nvalid;
#pragma unroll 8
    for (int i = 0; i < 32; ++i) { const int kk = 2 * i + (lane >> 5); scr[kk * 33 + c] = ok ? W[(size_t)(k0 + kk) * ldw + n0 + c] : 0.f; }
    LDS_WAIT(); asm volatile("" ::: "memory");
    const int c8 = lane & 7;
#pragma unroll
    for (int j = 0; j < 4; ++j) { const int n = (lane >> 3) + 8 * j; const LAS float* s = scr + (8 * c8) * 33 + n;
        v4u o; o.x = pk2(s[0 * 33], s[1 * 33]); o.y = pk2(s[2 * 33], s[3 * 33]); o.z = pk2(s[4 * 33], s[5 * 33]); o.w = pk2(s[6 * 33], s[7 * 33]);
        *(v4u*)(dst + (size_t)n * ldk + k0 + 8 * c8) = o; }
    LDS_WAIT(); asm volatile("" ::: "memory");
}
__device__ __forceinline__ void cv_load(const float* W, int ldw, int k0, int n0, int lane, f32x4 (&cr)[16]) {
    const unsigned laneoff = (unsigned)((lane >> 3) * ldw + n0 + 4 * (lane & 7)) * 4u;
#pragma unroll
    for (int i = 0; i < 16; ++i) { const char* rowp = (const char*)W + (size_t)(k0 + 8 * i) * ldw * 4; cr[i] = *(const f32x4*)(rowp + laneoff); }
}
__device__ __forceinline__ void cv_finish(const f32x4 (&cr)[16], int k0, unsigned char* dst, int ldk, LAS float* scr, int lane, float scale) {
    const int rr = lane >> 3, ch = lane & 7;
#pragma unroll
    for (int i = 0; i < 16; ++i) { LAS float* d = scr + (8 * i + rr) * 33 + 4 * ch; d[0] = cr[i].x * scale; d[1] = cr[i].y * scale; d[2] = cr[i].z * scale; d[3] = cr[i].w * scale; }
    LDS_WAIT(); asm volatile("" ::: "memory");
#pragma unroll
    for (int j = 0; j < 4; ++j) { const int n = rr + 8 * j; const LAS float* sp = scr + (16 * ch) * 33 + n;
        v4u o; o.x = pk4_fp8(sp[0 * 33], sp[1 * 33], sp[2 * 33], sp[3 * 33]); o.y = pk4_fp8(sp[4 * 33], sp[5 * 33], sp[6 * 33], sp[7 * 33]);
        o.z = pk4_fp8(sp[8 * 33], sp[9 * 33], sp[10 * 33], sp[11 * 33]); o.w = pk4_fp8(sp[12 * 33], sp[13 * 33], sp[14 * 33], sp[15 * 33]);
        *(v4u*)(dst + (size_t)n * ldk + k0 + 16 * ch) = o; }
    LDS_WAIT(); asm volatile("" ::: "memory");
}
__device__ __forceinline__ void cv_issue_dma(const float* W, int ldw, int k0, int n0, int lane, LAS float* scr) {
#pragma unroll
    for (int i = 0; i < 16; ++i) { const char* rowp = (const char*)W + (size_t)(k0 + 8 * i) * ldw * 4;
        const unsigned off = (unsigned)((lane >> 3) * ldw + n0 + 4 * ((lane & 7) ^ (i >> 1))) * 4u;
        __builtin_amdgcn_global_load_lds((const unsigned*)(rowp + off), (LAS unsigned*)(scr + i * 256), 16, 0, 2); }
}
__device__ __forceinline__ void cv_finish_dma(int k0, unsigned char* dst, int ldk, const LAS float* scr, int lane, float scale) {
    const int rr = lane >> 3, ch = lane & 7;
#pragma unroll
    for (int j = 0; j < 4; ++j) { const int n = rr + 8 * j; const LAS float* sp = scr + (16 * ch) * 32 + ((((n >> 2) ^ ch) << 2) | (n & 3));
        float f[16];
#pragma unroll
        for (int i = 0; i < 16; ++i) f[i] = sp[i * 32] * scale;
        v4u o; o.x = pk4_fp8(f[0], f[1], f[2], f[3]); o.y = pk4_fp8(f[4], f[5], f[6], f[7]); o.z = pk4_fp8(f[8], f[9], f[10], f[11]); o.w = pk4_fp8(f[12], f[13], f[14], f[15]);
        *(v4u*)(dst + (size_t)n * ldk + k0 + 16 * ch) = o; }
}
__device__ __forceinline__ void cvb_finish_dma(int k0, bf16* dst, int ldk, const LAS float* scr, int lane) {
    const int rr = lane >> 3, ch = lane & 7;
#pragma unroll
    for (int j = 0; j < 4; ++j) { const int n = rr + 8 * j; const LAS float* sp = scr + (16 * ch) * 32 + ((((n >> 2) ^ ch) << 2) | (n & 3));
        float f[16];
#pragma unroll
        for (int i = 0; i < 16; ++i) f[i] = sp[i * 32];
        v4u o0, o1; o0.x = pk2(f[0], f[1]); o0.y = pk2(f[2], f[3]); o0.z = pk2(f[4], f[5]); o0.w = pk2(f[6], f[7]); o1.x = pk2(f[8], f[9]); o1.y = pk2(f[10], f[11]); o1.z = pk2(f[12], f[13]); o1.w = pk2(f[14], f[15]);
        bf16* d = dst + (size_t)n * ldk + k0 + 16 * ch; *(v4u*)d = o0; *(v4u*)(d + 8) = o1; }
}
__device__ __forceinline__ void cvr_load(const float* W, int ldw, int k0, int n0, int lane, f32x4 (&cr)[16]) {
    const unsigned laneoff = (unsigned)((16 * (lane >> 3)) * ldw + n0 + 4 * (lane & 7)) * 4u;
#pragma unroll
    for (int i = 0; i < 16; ++i) { const char* rowp = (const char*)W + (size_t)(k0 + i) * ldw * 4; cr[i] = __builtin_nontemporal_load((const f32x4*)(rowp + laneoff)); }
}
__device__ __forceinline__ void cvr_store(const f32x4 (&cr)[16], int k0, unsigned char* dst, int ldk, int lane, float scale) {
    unsigned char* d = dst + (size_t)(4 * (lane & 7)) * ldk + k0 + 16 * (lane >> 3);
#pragma unroll
    for (int j = 0; j < 4; ++j) { v4u o;
        o.x = pk4_fp8(cr[0][j] * scale, cr[1][j] * scale, cr[2][j] * scale, cr[3][j] * scale); o.y = pk4_fp8(cr[4][j] * scale, cr[5][j] * scale, cr[6][j] * scale, cr[7][j] * scale);
        o.z = pk4_fp8(cr[8][j] * scale, cr[9][j] * scale, cr[10][j] * scale, cr[11][j] * scale); o.w = pk4_fp8(cr[12][j] * scale, cr[13][j] * scale, cr[14][j] * scale, cr[15][j] * scale);
        __builtin_nontemporal_store(o, (v4u*)(d + (size_t)j * ldk)); }
}
struct CvItem { const float* W; unsigned char* dst; int ldw, ldk, k0, n0; };
__device__ __forceinline__ CvItem cv_item(const Args& a, unsigned char* ws, int idx) {
    constexpr int I_EXP = (D / 128) * (FF / 32);
    int r = idx; const int mat = r / (NE * I_EXP); r -= mat * (NE * I_EXP); const int e = r / I_EXP; r -= e * I_EXP;
    const int kb = r / (FF / 32), nb = r % (FF / 32), n0 = 32 * nb;
    CvItem it; it.k0 = 128 * kb; it.n0 = n0;
    if (mat == 0) { it.W = a.in[I_WGATE] + (size_t)e * D * FF; it.ldw = FF; it.dst = ws + WS_WGU + ((size_t)e * 4096 + (n0 >> 7) * 256 + (n0 & 127)) * D; it.ldk = D; }
    else if (mat == 1) { it.W = a.in[I_WUP] + (size_t)e * D * FF; it.ldw = FF; it.dst = ws + WS_WGU + ((size_t)e * 4096 + (n0 >> 7) * 256 + 128 + (n0 & 127)) * D; it.ldk = D; }
    else { it.W = a.in[I_WDOWN] + (size_t)e * FF * D; it.ldw = D; it.dst = ws + WS_WD + ((size_t)e * 2048 + n0) * FF; it.ldk = FF; }
    return it;
}
constexpr int CV_ITEMS = 3 * NE * (D / 128) * (FF / 32);
constexpr int CVQ_CH = 4, CVQ_NCH = CV_ITEMS / CVQ_CH;
__device__ __forceinline__ unsigned cvq_issue(unsigned* q, int lane) { unsigned c = 0; if (lane == 0) c = __hip_atomic_fetch_add(q, 1u, RLX_AGENT); return c; }
__device__ __forceinline__ void rms_row_to_bf16(const float* xrow, const float* g, bf16* orow, int lane) {
    const f32x4* xr = (const f32x4*)xrow + lane; const f32x4* gr = (const f32x4*)g + lane;
    f32x4 v[8]; float s = 0.f;
#pragma unroll
    for (int j = 0; j < 8; ++j) { v[j] = __builtin_nontemporal_load(xr + 64 * j); s += (v[j].x * v[j].x + v[j].y * v[j].y) + (v[j].z * v[j].z + v[j].w * v[j].w); }
    const float rstd = rsqrtf(wave_sum(s) * (1.f / D) + NORM_EPS);
    v2u* o8 = (v2u*)orow + lane;
#pragma unroll
    for (int j = 0; j < 8; ++j) { const f32x4 gg = gr[64 * j]; v2u o; o.x = pk2(v[j].x * rstd * gg.x, v[j].y * rstd * gg.y); o.y = pk2(v[j].z * rstd * gg.z, v[j].w * rstd * gg.w); o8[64 * j] = o; }
}
__device__ __forceinline__ void p0_prologue(const Frame& F, const Args& a) {
    LAS float* scr = (LAS float*)(F.lds + F.wave * 16896);
    const int gw = F.vcu * 8 + F.wave, NGW = F.G * 8;
    bf16* Wt_in = (bf16*)(F.ws + WS_WIN); bf16* Wt_ba = (bf16*)(F.ws + WS_WBA); bf16* Wt_bb = (bf16*)(F.ws + WS_WBB); bf16* Wt_out = (bf16*)(F.ws + WS_WOUT);
    constexpr int NB_IN = PLD / 32;
    constexpr int I_IN = (D / 64) * NB_IN, I_BA = (RW / 64) * (D / 32), I_BB = I_BA, I_OUT = (D / 64) * (D / 32);
    constexpr int NITEMS = I_IN + I_BA + I_BB + I_OUT;
    {
        constexpr int NBF = IN_COLS / 32;
        constexpr int J_IN = (D / 128) * NBF, J_BA = (RW / 128) * (D / 32), J_BB = J_BA, J_OUT = (D / 128) * (D / 32), NJ = J_IN + J_BA + J_BB + J_OUT;
        LAS float* t2 = (LAS float*)(F.lds + F.wave * 16384);
        for (int it = gw; it < NJ; it += NGW) {
            const float* W = nullptr; int ldw = 0, k0 = 0, n0 = 0, ldk = 0; bf16* dst = nullptr; int r = it;
            if (r < J_IN) { const int kb = r / NBF, nb = r % NBF; W = a.in[I_WIN]; ldw = IN_COLS; k0 = 128 * kb; n0 = 32 * nb; dst = Wt_in + (size_t)n0 * DP; ldk = DP; }
            else if ((r -= J_IN) < J_BA) { const int kb = r / (D / 32), nb = r % (D / 32); W = a.in[I_WBR]; ldw = D; k0 = 128 * kb; n0 = 32 * nb; dst = Wt_ba + (size_t)n0 * RW; ldk = RW; }
            else if ((r -= J_BA) < J_BB) { const int kb = r / (D / 32), nb = r % (D / 32); W = a.in[I_WBG]; ldw = D; k0 = 128 * kb; n0 = 32 * nb; dst = Wt_bb + (size_t)n0 * GVW; ldk = GVW; }
            else { r -= J_BB; const int kb = r / (D / 32), nb = r % (D / 32); W = a.in[I_WOUT]; ldw = D; k0 = 128 * kb; n0 = 32 * nb; dst = Wt_out + (size_t)n0 * D; ldk = D; }
            cv_issue_dma(W, ldw, k0, n0, F.lane, t2);
            asm volatile("s_waitcnt vmcnt(0)" ::: "memory");
            cvb_finish_dma(k0, dst, ldk, t2, F.lane); asm volatile("s_waitcnt lgkmcnt(0)" ::: "memory");
        }
        __syncthreads();
        for (int it = gw; it < (D / 64) * 2; it += NGW) { const int kb = it >> 1, nb = NBF + (it & 1); tr_item(a.in[I_WIN], IN_COLS, IN_COLS, 64 * kb, 32 * nb, Wt_in + (size_t)(32 * nb) * DP, DP, scr, F.lane); }
    }
    bf16* Hh = (bf16*)(F.ws + WS_H);
    for (int m = gw; m < T; m += NGW) rms_row_to_bf16(a.in[I_X] + (size_t)m * D, a.in[I_NMG], Hh + (size_t)m * DP, F.lane);
    const int gt = F.vcu * 512 + F.tid, NGT = F.G * 512;
    bf16* Wl_wa = (bf16*)(F.ws + WS_WLWA); bf16* Wl_g = (bf16*)(F.ws + WS_WLG);
    for (int i = gt; i < 2048 * 256; i += NGT) { const int n = i >> 8, k = i & 255; float v = 0.f;
        if (n < 1024) { if (k < DLORA) v = a.in[I_W2][(size_t)k * RW + n]; } else { if (k >= DLORA && k < 2 * DLORA) v = a.in[I_A2][(size_t)(k - DLORA) * RW + (n - 1024)]; }
        Wl_wa[i] = (bf16)f2bf(v); }
    for (int i = gt; i < 1024 * 256; i += NGT) { const int n = i >> 8, k = i & 255; Wl_g[i] = (bf16)f2bf(a.in[I_G2][(size_t)k * RW + n]); }
    float* Wr = (float*)(F.ws + WS_WR);
    for (int i = gt; i < 8 * 32 * 64 * 4; i += NGT) { const int ii = i & 3, l = (i >> 2) & 63, e = (i >> 8) & 31, j = i >> 13; const int k = 256 * j + 4 * l + ii;
        Wr[i] = a.in[I_NFG][k] * a.in[I_WROUTER][(size_t)k * NE + e]; }
}

__device__ __forceinline__ void cv_queue_run(const Frame& F, const Args& a, unsigned* stop) {
    unsigned* q = F.ctl + CW_CVQ; const int lane = F.lane;
    f32x4 ca[16], cb[16];
    int cur = __builtin_amdgcn_readfirstlane((int)cvq_issue(q, lane)); unsigned nraw = cvq_issue(q, lane); int pos = 0; bool stopped = false;
#define CVQ_NEXT(idx) do { if (pos == CVQ_CH) { cur = __builtin_amdgcn_readfirstlane((int)nraw); pos = 0; \
        if (stop && !stopped && __hip_atomic_load(stop, RLX_AGENT) != 0u) stopped = true; \
        nraw = stopped ? 0x7fffffffu : cvq_issue(q, lane); } \
        idx = cur < CVQ_NCH ? cur * CVQ_CH + pos++ : -1; } while (0)
    int xa, xb; CvItem ia, ib;
    CVQ_NEXT(xa); if (xa < 0) return;
    ia = cv_item(a, F.ws, xa); cvr_load(ia.W, ia.ldw, ia.k0, ia.n0, lane, ca);
    CVQ_NEXT(xb); ib = ia; if (xb >= 0) { ib = cv_item(a, F.ws, xb); cvr_load(ib.W, ib.ldw, ib.k0, ib.n0, lane, cb); }
    while (xa >= 0) {
        cvr_store(ca, ia.k0, ia.dst, ia.ldk, lane, WQ_SCALE);
        xa = -1; if (xb >= 0) { CVQ_NEXT(xa); if (xa >= 0) { ia = cv_item(a, F.ws, xa); cvr_load(ia.W, ia.ldw, ia.k0, ia.n0, lane, ca); } }
        if (xb >= 0) { cvr_store(cb, ib.k0, ib.dst, ib.ldk, lane, WQ_SCALE);
            xb = -1; if (xa >= 0) { CVQ_NEXT(xb); if (xb >= 0) { ib = cv_item(a, F.ws, xb); cvr_load(ib.W, ib.ldw, ib.k0, ib.n0, lane, cb); } } }
    }
#undef CVQ_NEXT
}
constexpr int CVW_SH = 3;
__device__ __forceinline__ void p1_gemm_in(const Frame& F, const Args& a) {
    const bool split = (F.G == 256);
    const int bx = (int)blockIdx.x, grp = bx >> 3;
    if (split && (grp & ((1 << CVW_SH) - 1)) == (1 << CVW_SH) - 1) { cv_queue_run(F, a, F.ctl + CW_CVSTOP); return; }
    pg8::Gemm g{(const bf16*)(F.ws + WS_H), (const bf16*)(F.ws + WS_WIN), DP, DP, D, nullptr}; pg8::StaticOrder S;
    if (split) S.init(T, PLD, 256 - (256 >> CVW_SH), (grp - (grp >> CVW_SH)) * 8 + (bx & 7)); else S.init(T, PLD, F.G, bx);
    pg8::EpiBf16 E{(bf16*)(F.ws + WS_P), PLD, nullptr, 0, 1.f};
    pg8::gemm_phase(F.lds, g, S, E);
    if (F.tid == 0) __hip_atomic_fetch_add(F.ctl + CW_CVSTOP, 1u, RLX_AGENT);
}
__device__ __forceinline__ void p2_lora_in(const Frame& F, const Args& a) {
    const int gw = F.vcu * 8 + F.wave, NGW = F.G * 8, lane = F.lane;
    const bf16* P = (const bf16*)(F.ws + WS_P); bf16* A2 = (bf16*)(F.ws + WS_A2);
    const int kind = lane < 12 ? 0 : (lane < 24 ? 1 : (lane < 32 ? 2 : 3));
    const int src = lane < 24 ? (C_WL + 8 * lane) : (C_GL + 8 * (lane - 32));
    float mu[8];
    if (kind != 2) {
#pragma unroll
        for (int j = 0; j < 8; ++j) mu[j] = a.in[I_MU][src + j];
    }
    for (int t = gw; t < T; t += NGW) {
        v4u o = {0u, 0u, 0u, 0u};
        if (kind != 2) {
            const v4u c = *(const v4u*)(P + (size_t)t * PLD + src);
            v4u pv = {0u, 0u, 0u, 0u};
            if ((t & (SEQ - 1)) != 0) pv = *(const v4u*)(P + (size_t)(t - 1) * PLD + src);
            float x[8] = {bflo(c.x), bfhi(c.x), bflo(c.y), bfhi(c.y), bflo(c.z), bfhi(c.z), bflo(c.w), bfhi(c.w)};
            float q[8] = {bflo(pv.x), bfhi(pv.x), bflo(pv.y), bfhi(pv.y), bflo(pv.z), bfhi(pv.z), bflo(pv.w), bfhi(pv.w)};
#pragma unroll
            for (int j = 0; j < 8; ++j) { float m = x[j] + (q[j] - x[j]) * mu[j]; x[j] = kind == 0 ? tanhf(m) : (kind == 1 ? m : sigmoidf_(m)); }
            o.x = pk2(x[0], x[1]); o.y = pk2(x[2], x[3]); o.z = pk2(x[4], x[5]); o.w = pk2(x[6], x[7]);
        }
        *(v4u*)(A2 + (size_t)t * 512 + 8 * lane) = o;
    }
}

#define DPPF(x, ctrl) __builtin_bit_cast(float, __builtin_amdgcn_update_dpp(0, __builtin_bit_cast(int, (x)), (ctrl), 0xF, 0xF, false))
__device__ __forceinline__ float dpp_sum16(float x) { x += DPPF(x, 0xB1); x += DPPF(x, 0x4E); x += DPPF(x, 0x141); x += DPPF(x, 0x140); return x; }
__device__ __forceinline__ float wave_sum_dpp(float x) {
    x = dpp_sum16(x); const int xi = __builtin_bit_cast(int, x);
    return (__builtin_bit_cast(float, __builtin_amdgcn_readlane(xi, 0)) + __builtin_bit_cast(float, __builtin_amdgcn_readlane(xi, 16))) +
           (__builtin_bit_cast(float, __builtin_amdgcn_readlane(xi, 32)) + __builtin_bit_cast(float, __builtin_amdgcn_readlane(xi, 48)));
}
__device__ __forceinline__ float quad_sum(float x) { x += DPPF(x, 0xB1); x += DPPF(x, 0x4E); return x; }
__device__ __forceinline__ void unpack8(const v4u u, float (&f)[8]) { f[0] = bflo(u.x); f[1] = bfhi(u.x); f[2] = bflo(u.y); f[3] = bfhi(u.y); f[4] = bflo(u.z); f[5] = bfhi(u.z); f[6] = bflo(u.w); f[7] = bfhi(u.w); }
__device__ __forceinline__ v4u pack8(const float (&f)[8]) { v4u u; u.x = pk2(f[0], f[1]); u.y = pk2(f[2], f[3]); u.z = pk2(f[4], f[5]); u.w = pk2(f[6], f[7]); return u; }
__device__ __forceinline__ void p4_rwkv_prep(const Frame& F, const Args& a) {
    const int gw = F.vcu * 8 + F.wave, NGW = F.G * 8, lane = F.lane;
    const bf16* P = (const bf16*)(F.ws + WS_P); const bf16* WA = (const bf16*)(F.ws + WS_WAO); bf16* SC = (bf16*)(F.ws + WS_SCAN); float* BON = (float*)(F.ws + WS_BON);
    const int h = lane >> 2, q = lane & 3, c0 = h * RN + 16 * q;
    for (int t = gw; t < T; t += NGW) {
        const bool first = (t & (SEQ - 1)) == 0;
        const bf16* pr = P + (size_t)t * PLD + c0; const bf16* pp = first ? pr : pr - PLD;
        v4u ur[2], uk[2], uv[2], ur1[2], uk1[2], uv1[2], uw[2], ua[2];
#pragma unroll
        for (int j = 0; j < 2; ++j) { ur[j] = *(const v4u*)(pr + C_R + 8 * j); uk[j] = *(const v4u*)(pr + C_K + 8 * j); uv[j] = *(const v4u*)(pr + C_V + 8 * j);
            ur1[j] = *(const v4u*)(pp + C_R + 8 * j); uk1[j] = *(const v4u*)(pp + C_K + 8 * j); uv1[j] = *(const v4u*)(pp + C_V + 8 * j);
            uw[j] = __builtin_nontemporal_load((const v4u*)(WA + (size_t)t * 2048 + c0 + 8 * j)); ua[j] = __builtin_nontemporal_load((const v4u*)(WA + (size_t)t * 2048 + 1024 + c0 + 8 * j)); }
        float r[2][8], k[2][8], v[2][8], kk[2][8], dec[2][8], aa[2][8];
        float n2 = 0.f;
#pragma unroll
        for (int j = 0; j < 2; ++j) { float x[8], x1[8], wv[8], av[8];
            unpack8(ur[j], x); unpack8(ur1[j], x1);
#pragma unroll
            for (int i = 0; i < 8; ++i) { const float m = a.in[I_MU][C_R + c0 + 8 * j + i]; r[j][i] = x[i] + ((first ? 0.f : x1[i]) - x[i]) * m; }
            unpack8(uk[j], x); unpack8(uk1[j], x1);
#pragma unroll
            for (int i = 0; i < 8; ++i) { const float m = a.in[I_MU][C_K + c0 + 8 * j + i]; k[j][i] = x[i] + ((first ? 0.f : x1[i]) - x[i]) * m; }
            unpack8(uv[j], x); unpack8(uv1[j], x1);
#pragma unroll
            for (int i = 0; i < 8; ++i) { const float m = a.in[I_MU][C_V + c0 + 8 * j + i]; v[j][i] = x[i] + ((first ? 0.f : x1[i]) - x[i]) * m; }
            unpack8(uw[j], wv); unpack8(ua[j], av);
#pragma unroll
            for (int i = 0; i < 8; ++i) { const int c = c0 + 8 * j + i;
                dec[j][i] = __expf(-0.60653066f * sigmoidf_(a.in[I_W0][c] + wv[i]));
                aa[j][i] = sigmoidf_(a.in[I_A0][c] + av[i]);
                const float kq = k[j][i] * a.in[I_KK][c]; kk[j][i] = kq; n2 += kq * kq; } }
        n2 = quad_sum(n2);
        const float inv = rsqrtf(fmaxf(n2, 1e-24f));
        float bon = 0.f; float o0[2][8], o2[2][8], o3[2][8];
#pragma unroll
        for (int j = 0; j < 2; ++j)
#pragma unroll
            for (int i = 0; i < 8; ++i) { const int c = c0 + 8 * j + i; const float kn = kk[j][i] * inv; const float kf = k[j][i] * (1.f + (aa[j][i] - 1.f) * a.in[I_KA][c]);
                o0[j][i] = -kn; o2[j][i] = kn * aa[j][i]; o3[j][i] = kf; bon += r[j][i] * kf * a.in[I_RK][c]; }
        bon = quad_sum(bon);
        const int bh = (t >> 11) * RH + h, ts = t & (SEQ - 1);
        bf16* o = SC + ((size_t)(bh * SEQ + ts) * 6) * 64 + 16 * q;
#pragma unroll
        for (int j = 0; j < 2; ++j) { *(v4u*)(o + 8 * j) = pack8(o0[j]); *(v4u*)(o + 64 + 8 * j) = pack8(dec[j]); *(v4u*)(o + 128 + 8 * j) = pack8(o2[j]);
            *(v4u*)(o + 192 + 8 * j) = pack8(o3[j]); *(v4u*)(o + 256 + 8 * j) = pack8(r[j]); *(v4u*)(o + 320 + 8 * j) = pack8(v[j]); }
        if (q == 0) BON[(size_t)t * RH + h] = bon;
    }
}
__device__ __forceinline__ void p5_rwkv_scan(const Frame& F, const Args& a) {
    constexpr int TB = 16, NBLK = SEQ / TB, STF = 384, BLKF = TB * STF;
    const bf16* SC = (const bf16*)(F.ws + WS_SCAN); float* YR = (float*)(F.ws + WS_YRAW);
    LAS float* buf = (LAS float*)F.lds;
    volatile LAS int* hs = (volatile LAS int*)(F.lds + MOE_OFF + 2048);
    const int lane = F.lane;
    for (int u = F.vcu; u < 256; u += F.G) {
        const int bh = u >> 2, vg = u & 3, b = bh >> 4, h = bh & 15;
        const int role = F.wave < 4 ? 0 : (F.wave == 4 ? 1 : 2);
        const int cw = F.wave - 5;
        const bf16* src = SC + (size_t)bh * SEQ * STF;
        const int rl = lane >> 4, kq = lane & 15, row = 16 * vg + 4 * F.wave + rl;
        __syncthreads();
        if (F.tid < 8) hs[F.tid] = 0;
        __syncthreads();
#define HS_WAIT(cond) do { unsigned sp_ = 0; while (!(cond)) { __builtin_amdgcn_s_sleep(1); if (++sp_ > (1u << 24)) break; } asm volatile("" ::: "memory"); } while (0)
        if (role == 1) {
            v4u xb[12];
            { const v4u* s4 = (const v4u*)src;
#pragma unroll
              for (int i = 0; i < 12; ++i) xb[i] = s4[lane + 64 * i]; }
            for (int m = 0; m < NBLK; ++m) {
                if (m >= 4) HS_WAIT(hs[1] >= m - 3 && hs[2] >= m - 3 && hs[3] >= m - 3 && hs[4] >= m - 3);
                LAS f32x4* d4 = (LAS f32x4*)(buf + (m & 3) * BLKF);
#pragma unroll
                for (int i = 0; i < 12; ++i) { const int c = lane + 64 * i;
                    d4[2 * c] = (f32x4){bflo(xb[i].x), bfhi(xb[i].x), bflo(xb[i].y), bfhi(xb[i].y)}; d4[2 * c + 1] = (f32x4){bflo(xb[i].z), bfhi(xb[i].z), bflo(xb[i].w), bfhi(xb[i].w)}; }
                asm volatile("s_waitcnt lgkmcnt(0)" ::: "memory");
                if (lane == 0) hs[0] = m + 1;
                if (m + 1 < NBLK) { const v4u* s4 = (const v4u*)(src + (size_t)(m + 1) * BLKF);
#pragma unroll
                    for (int i = 0; i < 12; ++i) xb[i] = s4[lane + 64 * i]; }
            }
        } else if (role == 2) {
            cv_queue_run(F, a, nullptr);
        } else {
            float S0 = 0.f, S1 = 0.f, S2 = 0.f, S3 = 0.f;
            for (int n = 0; n < NBLK; ++n) {
                HS_WAIT(hs[0] >= n + 1);
                const LAS float* bb = buf + (n & 3) * BLKF;
                float* yo = YR + ((size_t)(b * SEQ + n * TB)) * RW + h * RN + row;
                f32x4 al = *(const LAS f32x4*)(bb + 4 * kq), w = *(const LAS f32x4*)(bb + 64 + 4 * kq), be = *(const LAS f32x4*)(bb + 128 + 4 * kq);
                f32x4 kf = *(const LAS f32x4*)(bb + 192 + 4 * kq), r = *(const LAS f32x4*)(bb + 256 + 4 * kq); float vv = bb[320 + row];
                float ykeep = 0.f, yp = 0.f;
#pragma unroll
                for (int j = 0; j < TB; ++j) {
                    f32x4 al_n = al, w_n = w, be_n = be, kf_n = kf, r_n = r; float vv_n = vv;
                    if (j + 1 < TB) { const LAS float* st = bb + (j + 1) * STF;
                        al_n = *(const LAS f32x4*)(st + 4 * kq); w_n = *(const LAS f32x4*)(st + 64 + 4 * kq); be_n = *(const LAS f32x4*)(st + 128 + 4 * kq);
                        kf_n = *(const LAS f32x4*)(st + 192 + 4 * kq); r_n = *(const LAS f32x4*)(st + 256 + 4 * kq); vv_n = st[320 + row]; }
                    float sa = (S0 * al.x + S1 * al.y) + (S2 * al.z + S3 * al.w);
                    float yq = yp;
                    sa += DPPF(sa, 0xB1); if (j > 0) yq += DPPF(yq, 0xB1);
                    sa += DPPF(sa, 0x4E); if (j > 0) yq += DPPF(yq, 0x4E);
                    sa += DPPF(sa, 0x141); if (j > 0) yq += DPPF(yq, 0x141);
                    sa += DPPF(sa, 0x140); if (j > 0) yq += DPPF(yq, 0x140);
                    if (j > 0) ykeep = __builtin_bit_cast(float, __builtin_amdgcn_update_dpp(__builtin_bit_cast(int, yq), __builtin_bit_cast(int, ykeep), 0x111, 0xF, 0xF, false));
                    S0 = S0 * w.x + (sa * be.x + vv * kf.x); S1 = S1 * w.y + (sa * be.y + vv * kf.y);
                    S2 = S2 * w.z + (sa * be.z + vv * kf.z); S3 = S3 * w.w + (sa * be.w + vv * kf.w);
                    yp = (S0 * r.x + S1 * r.y) + (S2 * r.z + S3 * r.w);
                    al = al_n; w = w_n; be = be_n; kf = kf_n; r = r_n; vv = vv_n;
                }
                const float yl = dpp_sum16(yp);
                ykeep = __builtin_bit_cast(float, __builtin_amdgcn_update_dpp(__builtin_bit_cast(int, yl), __builtin_bit_cast(int, ykeep), 0x111, 0xF, 0xF, false));
                yo[(size_t)(TB - 1 - kq) * RW] = ykeep;
                asm volatile("s_waitcnt lgkmcnt(0)" ::: "memory");
                if (lane == 0) hs[1 + F.wave] = n + 1;
            }
            __builtin_amdgcn_s_setprio(0);
        }
#undef HS_WAIT
        __syncthreads();
    }
    if (F.G != 256) { LAS float* scr = (LAS float*)(F.lds + F.wave * 16896); __syncthreads();
        for (int it = F.vcu * 8 + F.wave; it < CV_ITEMS; it += F.G * 8) { const CvItem c2 = cv_item(a, F.ws, it); f32x4 c3[16]; cv_load(c2.W, c2.ldw, c2.k0, c2.n0, lane, c3); cv_finish(c3, c2.k0, c2.dst, c2.ldk, scr, lane, WQ_SCALE); } }
}

__device__ __forceinline__ void p6_rwkv_post(const Frame& F, const Args& a) {
    const int gw = F.vcu * 8 + F.wave, NGW = F.G * 8, lane = F.lane;
    const bf16* SC = (const bf16*)(F.ws + WS_SCAN); const float* YR = (const float*)(F.ws + WS_YRAW); const float* BON = (const float*)(F.ws + WS_BON);
    const bf16* GO = (const bf16*)(F.ws + WS_GO); bf16* YA = (bf16*)(F.ws + WS_YA);
    const int h = lane >> 2, q = lane & 3, c0 = h * RN + 16 * q;
    f32x4 lg[4], lb[4];
#pragma unroll
    for (int j = 0; j < 4; ++j) { lg[j] = *(const f32x4*)(a.in[I_LNG] + c0 + 4 * j); lb[j] = *(const f32x4*)(a.in[I_LNB] + c0 + 4 * j); }
    for (int t = gw; t < T; t += NGW) {
        const int bh = (t >> 11) * RH + h, ts = t & (SEQ - 1);
        f32x4 y[4]; v4u uv[2], ug[2];
#pragma unroll
        for (int j = 0; j < 4; ++j) y[j] = __builtin_nontemporal_load((const f32x4*)(YR + (size_t)t * RW + c0 + 4 * j));
#pragma unroll
        for (int j = 0; j < 2; ++j) { uv[j] = *(const v4u*)(SC + ((size_t)(bh * SEQ + ts) * 6 + 5) * 64 + 16 * q + 8 * j); ug[j] = *(const v4u*)(GO + (size_t)t * RW + c0 + 8 * j); }
        const float bo = BON[(size_t)t * RH + h];
        float s = 0.f;
#pragma unroll
        for (int j = 0; j < 4; ++j) s += (y[j].x + y[j].y) + (y[j].z + y[j].w);
        const float mean = quad_sum(s) * (1.f / RN);
        float s2 = 0.f;
#pragma unroll
        for (int j = 0; j < 4; ++j) { y[j] = y[j] - mean; s2 += (y[j].x * y[j].x + y[j].y * y[j].y) + (y[j].z * y[j].z + y[j].w * y[j].w); }
        const float rstd = rsqrtf(quad_sum(s2) * (1.f / RN) + GN_EPS);
        float vv[2][8], gg[2][8], o[2][8];
        unpack8(uv[0], vv[0]); unpack8(uv[1], vv[1]); unpack8(ug[0], gg[0]); unpack8(ug[1], gg[1]);
#pragma unroll
        for (int j = 0; j < 4; ++j)
#pragma unroll
            for (int i = 0; i < 4; ++i) o[j >> 1][4 * (j & 1) + i] = (y[j][i] * rstd * lg[j][i] + lb[j][i] + bo * vv[j >> 1][4 * (j & 1) + i]) * gg[j >> 1][4 * (j & 1) + i];
        *(v4u*)(YA + (size_t)t * RW + c0) = pack8(o[0]); *(v4u*)(YA + (size_t)t * RW + c0 + 8) = pack8(o[1]);
    }
}

constexpr int G_BC = 0;
constexpr int G_ALF = 32768;
constexpr int G_RED = 36864;
constexpr int G_TOT = 38912;
constexpr int G_QT = 40960;
constexpr int G_KT = 58368;
constexpr int G_VT = 76800;
constexpr int G_AT = 113664;
__device__ __forceinline__ void gla_bcum(const Frame& F, const Args& a, const bf16* P, int t0, int h) {
    LAS float* bc = (LAS float*)(F.lds + G_BC); LAS float* alf = (LAS float*)(F.lds + G_ALF); LAS float* tot = (LAS float*)(F.lds + G_TOT);
    const int tid = F.tid;
    __syncthreads();
    { const int j = tid >> 3, i2 = (tid & 7) * 2; const unsigned u = *(const unsigned*)(P + (size_t)(t0 + j) * PLD + C_GAL + i2); alf[j * 16 + i2] = bflo(u); alf[j * 16 + i2 + 1] = bfhi(u); }
    const int d = tid & 127, jq = tid >> 7, hd = h * GDK + d;
    float wv[16];
#pragma unroll
    for (int i = 0; i < 16; ++i) wv[i] = a.in[I_GWA2][(size_t)i * GKW + hd];
    const float bb = a.in[I_GBA][hd];
    __syncthreads();
    float run = 0.f;
    for (int jj = 0; jj < 16; ++jj) { const int j = jq * 16 + jj; float x = bb;
#pragma unroll
        for (int i = 0; i < 16; ++i) x += alf[j * 16 + i] * wv[i];
        run += -softplusf_(-x) * (1.f / 16.f); bc[j * 128 + d] = run; }
    tot[jq * 128 + d] = run;
    __syncthreads();
    float pre = 0.f;
    for (int q = 0; q < jq; ++q) pre += tot[q * 128 + d];
    if (jq > 0) { for (int jj = 0; jj < 16; ++jj) bc[(jq * 16 + jj) * 128 + d] += pre; }
    __syncthreads();
}
constexpr int G_VP = 264, G_KP = 136;
__device__ __forceinline__ void gla_stage_v(const Frame& F, const bf16* P, int t0, int h) {
    LAS bf16* VR = (LAS bf16*)(F.lds + G_VT);
    const int j = F.tid >> 3, e0 = (F.tid & 7) * 32;
    const bf16* src = P + (size_t)(t0 + j) * PLD + C_GV + h * GDV + e0;
#pragma unroll
    for (int q = 0; q < 4; ++q) *(LAS v4u*)(VR + j * G_VP + e0 + 8 * q) = *(const v4u*)(src + 8 * q);
}
typedef short s16x4g __attribute__((ext_vector_type(4)));
__device__ __forceinline__ bf16x8 tr_frag(const LAS bf16* img, int pitch, int row0, int col0, int lane) {
    const LAS bf16* p = img + (row0 + 8 * (lane >> 4) + ((lane & 15) >> 2)) * pitch + col0 + 4 * (lane & 3);
    const s16x4g lo = __builtin_amdgcn_ds_read_tr16_b64_v4i16((LAS s16x4g*)p);
    const s16x4g hi = __builtin_amdgcn_ds_read_tr16_b64_v4i16((LAS s16x4g*)(p + 4 * pitch));
    return __builtin_shufflevector(lo, hi, 0, 1, 2, 3, 4, 5, 6, 7);
}
#define MMA16(a_, b_, c_) __builtin_amdgcn_mfma_f32_16x16x32_bf16(a_, b_, c_, 0, 0, 0)
__device__ __forceinline__ void gla_pass_a(const Frame& F, const Args& a) {
    const bf16* P = (const bf16*)(F.ws + WS_P); bf16* HT = (bf16*)(F.ws + WS_GHT); float* DEC = (float*)(F.ws + WS_GDEC);
    LAS float* bc = (LAS float*)(F.lds + G_BC); LAS bf16* KH = (LAS bf16*)(F.lds + G_KT); LAS bf16* VR = (LAS bf16*)(F.lds + G_VT);
    const int fr = F.lane & 15, fq = F.lane >> 4;
    for (int it = F.vcu; it < BATCH * GH * NCH; it += F.G) {
        const int c = it & 31, h = (it >> 5) & 3, b = it >> 7, t0 = b * SEQ + c * CHUNK;
        gla_bcum(F, a, P, t0, h);
        if (F.tid < 128) DEC[(size_t)it * 128 + F.tid] = __expf(bc[63 * 128 + F.tid]);
        { f32x4* gbc = (f32x4*)(F.ws + WS_GBC) + (size_t)it * 2048;
#pragma unroll
          for (int i = 0; i < 4; ++i) gbc[F.tid + 512 * i] = ((const LAS f32x4*)bc)[F.tid + 512 * i]; }
        { const int j = F.tid >> 3, d0 = (F.tid & 7) * 16; const bf16* src = P + (size_t)(t0 + j) * PLD + C_GK + h * GDK + d0;
#pragma unroll
          for (int q = 0; q < 2; ++q) { const v4u u = *(const v4u*)(src + 8 * q); float kv[8]; unpack8(u, kv);
#pragma unroll
            for (int i = 0; i < 8; ++i) { const int d = d0 + 8 * q + i; kv[i] *= __expf(bc[63 * 128 + d] - bc[j * 128 + d]); }
            *(LAS v4u*)(KH + j * G_KP + d0 + 8 * q) = pack8(kv); } }
        gla_stage_v(F, P, t0, h);
        __syncthreads();
        f32x4 acc[8][2];
#pragma unroll
        for (int m = 0; m < 8; ++m)
#pragma unroll
            for (int n = 0; n < 2; ++n) acc[m][n] = (f32x4){0.f, 0.f, 0.f, 0.f};
#pragma unroll
        for (int ks = 0; ks < 2; ++ks) {
            bf16x8 vf[2];
#pragma unroll
            for (int n = 0; n < 2; ++n) vf[n] = tr_frag(VR, G_VP, ks * 32, F.wave * 32 + n * 16, F.lane);
#pragma unroll
            for (int m = 0; m < 8; ++m) { const bf16x8 kf = tr_frag(KH, G_KP, ks * 32, m * 16, F.lane);
#pragma unroll
                for (int n = 0; n < 2; ++n) acc[m][n] = MMA16(kf, vf[n], acc[m][n]); }
        }
        bf16* o = HT + (size_t)it * (GDV * GDK);
#pragma unroll
        for (int m = 0; m < 8; ++m)
#pragma unroll
            for (int n = 0; n < 2; ++n) { v2u pk; pk.x = pk2(acc[m][n][0], acc[m][n][1]); pk.y = pk2(acc[m][n][2], acc[m][n][3]); *(v2u*)(o + (size_t)(F.wave * 32 + n * 16 + fr) * GDK + m * 16 + 4 * fq) = pk; }
    }
}
__device__ __forceinline__ void gla_pass_b(const Frame& F, int lo, int hi, int wg, int nwg) {
    const bf16* HT = (const bf16*)(F.ws + WS_GHT); const float* DEC = (const float*)(F.ws + WS_GDEC); bf16* ST = (bf16*)(F.ws + WS_GST);
    const int gt = wg * 512 + F.tid, NGT = nwg * 512;
    for (int i = (lo >> 1) + gt; i < (hi >> 1); i += NGT) {
        const int bh = i >> 14, ed = (i & 16383) * 2, d = ed & 127;
        float s0 = 0.f, s1 = 0.f;
#pragma unroll 8
        for (int c = 0; c < NCH; ++c) { const size_t it = (size_t)bh * NCH + c;
            const unsigned hv = __builtin_nontemporal_load((const unsigned*)(HT + it * (GDV * GDK) + ed)); const float d0 = DEC[it * 128 + d], d1 = DEC[it * 128 + d + 1];
            *(unsigned*)(ST + it * (GDV * GDK) + ed) = pk2(s0, s1);
            s0 = s0 * d0 + bflo(hv); s1 = s1 * d1 + bfhi(hv); }
    }
}
__device__ __forceinline__ void gla_pass_c(const Frame& F, const Args& a) {
    const bf16* P = (const bf16*)(F.ws + WS_P); const bf16* ST = (const bf16*)(F.ws + WS_GST); bf16* YB = (bf16*)(F.ws + WS_YB);
    LAS float* bc = (LAS float*)(F.lds + G_BC); LAS float* red = (LAS float*)(F.lds + G_RED);
    LAS bf16* QT = (LAS bf16*)(F.lds + G_QT); LAS bf16* KT = (LAS bf16*)(F.lds + G_KT); LAS bf16* VR = (LAS bf16*)(F.lds + G_VT); LAS bf16* AT = (LAS bf16*)(F.lds + G_AT);
    const int fr = F.lane & 15, fq = F.lane >> 4, w = F.wave;
    const float scale = 0.08838834764831845f;
    for (int it = F.vcu; it < BATCH * GH * NCH; it += F.G) {
        const int c = it & 31, h = (it >> 5) & 3, b = it >> 7, t0 = b * SEQ + c * CHUNK;
        __syncthreads();
        { const f32x4* gbc = (const f32x4*)(F.ws + WS_GBC) + (size_t)it * 2048;
#pragma unroll
          for (int i = 0; i < 4; ++i) ((LAS f32x4*)bc)[F.tid + 512 * i] = gbc[F.tid + 512 * i]; }
        const bf16* Sg = ST + (size_t)it * (GDV * GDK);
        bf16x8 sfr[4][2];
#pragma unroll
        for (int ks = 0; ks < 4; ++ks)
#pragma unroll
            for (int n = 0; n < 2; ++n) sfr[ks][n] = *(const bf16x8*)(Sg + (size_t)(w * 32 + n * 16 + fr) * GDK + ks * 32 + fq * 8);
        f32x4 gng[2];
#pragma unroll
        for (int n = 0; n < 2; ++n) gng[n] = *(const f32x4*)(a.in[I_GNG] + w * 32 + n * 16 + 4 * fq);
        v2u ogu[4][2];
#pragma unroll
        for (int m = 0; m < 4; ++m)
#pragma unroll
            for (int n = 0; n < 2; ++n) ogu[m][n] = __builtin_nontemporal_load((const v2u*)(P + (size_t)(t0 + m * 16 + fr) * PLD + C_OG + h * GDV + w * 32 + n * 16 + 4 * fq));
        __syncthreads();
        { const int j = F.tid >> 3, d0 = (F.tid & 7) * 16;
          const bf16* sq = P + (size_t)(t0 + j) * PLD + C_GQ + h * GDK + d0; const bf16* sk = P + (size_t)(t0 + j) * PLD + C_GK + h * GDK + d0;
#pragma unroll
          for (int q = 0; q < 2; ++q) { const v4u uq = *(const v4u*)(sq + 8 * q), uk = *(const v4u*)(sk + 8 * q); float fq8[8], fk8[8]; unpack8(uq, fq8); unpack8(uk, fk8);
#pragma unroll
            for (int i = 0; i < 8; ++i) { const float bv = bc[j * 128 + d0 + 8 * q + i]; fq8[i] *= scale * __expf(bv); fk8[i] *= __expf(-bv); }
            *(LAS v4u*)(QT + j * 136 + d0 + 8 * q) = pack8(fq8); *(LAS v4u*)(KT + j * 136 + d0 + 8 * q) = pack8(fk8); } }
        gla_stage_v(F, P, t0, h);
        __syncthreads();
        { const int mt = w >> 1;
#pragma unroll
          for (int q = 0; q < 2; ++q) { const int nt = (w & 1) * 2 + q; f32x4 sacc = {0.f, 0.f, 0.f, 0.f};
            if (nt <= mt) {
#pragma unroll
                for (int ks = 0; ks < 4; ++ks) { const bf16x8 kfr = *(const LAS bf16x8*)(KT + (nt * 16 + fr) * 136 + ks * 32 + fq * 8); const bf16x8 qfr = *(const LAS bf16x8*)(QT + (mt * 16 + fr) * 136 + ks * 32 + fq * 8);
                    sacc = MMA16(kfr, qfr, sacc); } }
            const int i = mt * 16 + fr, j0 = nt * 16 + 4 * fq; float v4[4];
#pragma unroll
            for (int jj = 0; jj < 4; ++jj) v4[jj] = (j0 + jj <= i) ? sacc[jj] : 0.f;
            v2u pk; pk.x = pk2(v4[0], v4[1]); pk.y = pk2(v4[2], v4[3]); *(LAS v2u*)(AT + i * 72 + j0) = pk; } }
        __syncthreads();
        f32x4 acc[2][4];
#pragma unroll
        for (int n = 0; n < 2; ++n)
#pragma unroll
            for (int m = 0; m < 4; ++m) acc[n][m] = (f32x4){0.f, 0.f, 0.f, 0.f};
#pragma unroll
        for (int ks = 0; ks < 2; ++ks) {
            bf16x8 vf[2];
#pragma unroll
            for (int n = 0; n < 2; ++n) vf[n] = tr_frag(VR, G_VP, ks * 32, w * 32 + n * 16, F.lane);
#pragma unroll
            for (int m = 0; m < 4; ++m) { const bf16x8 af = *(const LAS bf16x8*)(AT + (m * 16 + fr) * 72 + ks * 32 + fq * 8);
#pragma unroll
                for (int n = 0; n < 2; ++n) acc[n][m] = MMA16(vf[n], af, acc[n][m]); }
        }
#pragma unroll
        for (int ks = 0; ks < 4; ++ks) {
#pragma unroll
            for (int m = 0; m < 4; ++m) { const bf16x8 qf = *(const LAS bf16x8*)(QT + (m * 16 + fr) * 136 + ks * 32 + fq * 8);
#pragma unroll
                for (int n = 0; n < 2; ++n) acc[n][m] = MMA16(sfr[ks][n], qf, acc[n][m]); }
        }
        float ssq[4];
#pragma unroll
        for (int m = 0; m < 4; ++m) { float ss = 0.f;
#pragma unroll
            for (int n = 0; n < 2; ++n) ss += (acc[n][m][0] * acc[n][m][0] + acc[n][m][1] * acc[n][m][1]) + (acc[n][m][2] * acc[n][m][2] + acc[n][m][3] * acc[n][m][3]);
            ss += __shfl_xor(ss, 16); ss += __shfl_xor(ss, 32); ssq[m] = ss;
            if (fq == 0) red[(m * 16 + fr) * 8 + w] = ss; }
        __syncthreads();
#pragma unroll
        for (int m = 0; m < 4; ++m) { const int i = m * 16 + fr; float tot = 0.f;
#pragma unroll
            for (int q = 0; q < 8; ++q) tot += red[i * 8 + q];
            const float rstd = rsqrtf(tot * (1.f / GDV) + NORM_EPS);
#pragma unroll
            for (int n = 0; n < 2; ++n) { const int e = w * 32 + n * 16 + 4 * fq;
                const float og[4] = {bflo(ogu[m][n].x), bfhi(ogu[m][n].x), bflo(ogu[m][n].y), bfhi(ogu[m][n].y)}; float r4[4];
#pragma unroll
                for (int jj = 0; jj < 4; ++jj) r4[jj] = acc[n][m][jj] * rstd * gng[n][jj] * (og[jj] * sigmoidf_(og[jj]));
                v2u pk; pk.x = pk2(r4[0], r4[1]); pk.y = pk2(r4[2], r4[3]); *(v2u*)(YB + (size_t)(t0 + i) * GVW + h * GDV + e) = pk; } }
    }
}

__device__ __forceinline__ void p11_router(const Frame& F, const Args& a) {
    const int lane = F.lane, w = F.wave;
    const float* X1 = (const float*)(F.ws + WS_X1); unsigned char* H2 = (unsigned char*)(F.ws + WS_H2); const float* Wr = (const float*)(F.ws + WS_WR);
    int* SEL_E = (int*)(F.ws + WS_ROUTE); float* SEL_W = (float*)(F.ws + WS_ROUTE + 256 * 1024); int* SEL_R = (int*)(F.ws + WS_ROUTE + 512 * 1024);
    volatile LAS int* hist = (volatile LAS int*)(F.lds + MOE_OFF + 1024); volatile LAS int* base = (volatile LAS int*)(F.lds + MOE_OFF + 1280);
    int* LIST = (int*)(F.ws + WS_ROUTE + 1024 * 1024);
    LAS float* part = (LAS float*)F.lds;
    LAS float* ssq = (LAS float*)(F.lds + 16384);
    __syncthreads();
    if (F.tid < 32) hist[F.tid] = 0;
    __syncthreads();
    const int mt = w & 1, ks = w >> 1, r = lane & 15, kq = lane >> 4;
    const int grp = lane >> 4, el = lane & 15;
    const float br0 = a.in[I_BROUTER][el], br1 = a.in[I_BROUTER][16 + el];
    for (int tile = F.vcu; tile < T / 32; tile += F.G) {
        const int tb = tile * 32;
        {
            const float* xp = X1 + (size_t)(tb + 16 * mt + r) * D + 512 * ks + 8 * kq;
            const float* bp = Wr + (size_t)(2 * ks) * 8192 + r * 256 + 8 * kq;
            f32x4 acc0 = {0.f, 0.f, 0.f, 0.f}, acc1 = {0.f, 0.f, 0.f, 0.f}; float ss = 0.f;
#pragma unroll 4
            for (int s = 0; s < 16; ++s) {
                const f32x4 xa = *(const f32x4*)(xp + 32 * s), xb = *(const f32x4*)(xp + 32 * s + 4);
                const float* bs = bp + (s >> 3) * 8192 + 32 * (s & 7);
                const f32x4 b00 = *(const f32x4*)bs, b01 = *(const f32x4*)(bs + 4), b10 = *(const f32x4*)(bs + 4096), b11 = *(const f32x4*)(bs + 4096 + 4);
                ss += ((xa.x * xa.x + xa.y * xa.y) + (xa.z * xa.z + xa.w * xa.w)) + ((xb.x * xb.x + xb.y * xb.y) + (xb.z * xb.z + xb.w * xb.w));
#pragma unroll
                for (int i = 0; i < 4; ++i) { acc0 = __builtin_amdgcn_mfma_f32_16x16x4f32(xa[i], b00[i], acc0, 0, 0, 0); acc1 = __builtin_amdgcn_mfma_f32_16x16x4f32(xa[i], b10[i], acc1, 0, 0, 0); }
#pragma unroll
                for (int i = 0; i < 4; ++i) { acc0 = __builtin_amdgcn_mfma_f32_16x16x4f32(xb[i], b01[i], acc0, 0, 0, 0); acc1 = __builtin_amdgcn_mfma_f32_16x16x4f32(xb[i], b11[i], acc1, 0, 0, 0); }
            }
#pragma unroll
            for (int j = 0; j < 4; ++j) { LAS float* pr = part + ((ks * 32 + 16 * mt + 4 * kq + j) * 32); pr[r] = acc0[j]; pr[16 + r] = acc1[j]; }
            ss += __shfl_xor(ss, 16); ss += __shfl_xor(ss, 32);
            if (kq == 0) ssq[ks * 32 + 16 * mt + r] = ss;
        }
        __syncthreads();
        {
            const int tk = 4 * w + grp;
            const float rstd = rsqrtf(((ssq[tk] + ssq[32 + tk]) + (ssq[64 + tk] + ssq[96 + tk])) * (1.f / D) + NORM_EPS);
            const LAS float* pr = part + tk * 32;
            float c0 = ((pr[el] + pr[1024 + el]) + (pr[2048 + el] + pr[3072 + el])) * rstd + br0;
            float c1 = ((pr[16 + el] + pr[1024 + 16 + el]) + (pr[2048 + 16 + el] + pr[3072 + 16 + el])) * rstd + br1;
            float tv[4]; int ti[4];
#pragma unroll
            for (int k = 0; k < 4; ++k) { float bv = c0; int bi = el; if (c1 > c0) { bv = c1; bi = 16 + el; }
#pragma unroll
                for (int o = 1; o < 16; o <<= 1) { const float ov = __shfl_xor(bv, o); const int oi = __shfl_xor(bi, o); if (ov > bv || (ov == bv && oi < bi)) { bv = ov; bi = oi; } }
                tv[k] = bv; ti[k] = bi; if (bi == el) c0 = -3.0e38f; if (bi == 16 + el) c1 = -3.0e38f; }
            const float e1 = __expf(tv[1] - tv[0]), e2 = __expf(tv[2] - tv[0]), e3 = __expf(tv[3] - tv[0]); const float inv = 1.f / (1.f + e1 + e2 + e3);
            if (el < 4) { const int k = el; const float wk = (k == 0 ? 1.f : (k == 1 ? e1 : (k == 2 ? e2 : e3))) * inv; const int ek = (k == 0 ? ti[0] : (k == 1 ? ti[1] : (k == 2 ? ti[2] : ti[3])));
                const int lr = __hip_atomic_fetch_add((LAS int*)&hist[ek], 1, __ATOMIC_RELAXED, __HIP_MEMORY_SCOPE_WORKGROUP);
                SEL_E[(tb + tk) * 4 + k] = ek; SEL_W[(tb + tk) * 4 + k] = wk; SEL_R[(tb + tk) * 4 + k] = lr; }
        }
#pragma unroll
        for (int rr = 0; rr < 4; ++rr) { const int tk = 4 * w + rr;
            const float rstd = rsqrtf(((ssq[tk] + ssq[32 + tk]) + (ssq[64 + tk] + ssq[96 + tk])) * (1.f / D) + NORM_EPS);
            const f32x4* xr = (const f32x4*)(X1 + (size_t)(tb + tk) * D) + lane; unsigned* hr = (unsigned*)(H2 + (size_t)(tb + tk) * D) + lane;
#pragma unroll
            for (int j = 0; j < 8; ++j) { const f32x4 xv = __builtin_nontemporal_load(xr + 64 * j); const f32x4 gg = ((const f32x4*)a.in[I_NFG])[64 * j + lane];
                hr[64 * j] = pk4_fp8(xv.x * rstd * gg.x, xv.y * rstd * gg.y, xv.z * rstd * gg.z, xv.w * rstd * gg.w); } }
        __syncthreads();
    }
    if (F.tid < 32) base[F.tid] = (int)__hip_atomic_fetch_add(F.ctl + CW_CNT + F.tid, (unsigned)hist[F.tid], RLX_AGENT);
    __syncthreads();
    for (int tile = F.vcu; tile < T / 32; tile += F.G) {
        if (F.tid < 128) { const int tk = tile * 32 + (F.tid >> 2); const int idx = tk * 4 + (F.tid & 3);
            const int e_ = __hip_atomic_load(SEL_E + idx, RLX_AGENT); const int rk_ = __hip_atomic_load(SEL_R + idx, RLX_AGENT) + base[e_]; SEL_R[idx] = rk_; LIST[e_ * 8192 + rk_] = tk; }
    }
}
__device__ __forceinline__ void moe_tables(const Frame& F, int nct) {
    volatile LAS int* tab = (volatile LAS int*)(F.lds + MOE_OFF);
    __syncthreads();
    if (F.tid == 0) { int run = 0, units = 0;
        for (int e = 0; e < NE; ++e) { const int cnt = (int)__hip_atomic_load(F.ctl + CW_CNT + e, RLX_AGENT); const int nt = (cnt + 255) >> 8;
            tab[e] = units; tab[36 + e] = run * 256; tab[72 + e] = nt > 0 ? nt : 1; tab[108 + e] = cnt; run += nt; units += nt * nct; }
        tab[32] = units; }
    __syncthreads();
}
__device__ __forceinline__ void p12_scatter(const Frame& F) {
    const int gw = F.vcu * 8 + F.wave, NGW = F.G * 8, lane = F.lane;
    const unsigned char* H2 = (const unsigned char*)(F.ws + WS_H2); unsigned char* XS = (unsigned char*)(F.ws + WS_XS);
    const int* SEL_E = (const int*)(F.ws + WS_ROUTE); const int* SEL_R = (const int*)(F.ws + WS_ROUTE + 512 * 1024); int* DEST = (int*)(F.ws + WS_ROUTE + 768 * 1024);
    moe_tables(F, 1);
    volatile LAS int* tab = (volatile LAS int*)(F.lds + MOE_OFF);
    for (int it = gw; it < T * TOPK; it += NGW) {
        const int t = it >> 2; const int e = SEL_E[it], dest = tab[36 + e] + SEL_R[it];
        const v4u* s = (const v4u*)(H2 + (size_t)t * D) + lane; v4u* d = (v4u*)(XS + (size_t)dest * D) + lane;
        d[0] = s[0]; d[64] = s[64];
        if (lane == 0) DEST[it] = dest;
    }
}
__device__ __forceinline__ void p15_combine(const Frame& F, const Args& a) {
    const int gw = F.vcu * 8 + F.wave, NGW = F.G * 8, lane = F.lane;
    const float* X1 = (const float*)(F.ws + WS_X1); const bf16* Y = (const bf16*)(F.ws + WS_Y);
    const float* SEL_W = (const float*)(F.ws + WS_ROUTE + 256 * 1024); const int* SEL_E = (const int*)(F.ws + WS_ROUTE); const int* SEL_R = (const int*)(F.ws + WS_ROUTE + 512 * 1024);
    moe_tables(F, 1);
    volatile LAS int* tab = (volatile LAS int*)(F.lds + MOE_OFF);
    for (int t = gw; t < T; t += NGW) {
        f32x4 v[8];
        const f32x4* xr = (const f32x4*)(X1 + (size_t)t * D) + lane;
#pragma unroll
        for (int j = 0; j < 8; ++j) v[j] = __builtin_nontemporal_load(xr + 64 * j);
#pragma unroll
        for (int k = 0; k < 4; ++k) { const float wk = SEL_W[t * 4 + k]; const v2u* yr = (const v2u*)(Y + (size_t)(tab[36 + SEL_E[t * 4 + k]] + SEL_R[t * 4 + k]) * D) + lane;
#pragma unroll
            for (int j = 0; j < 8; ++j) { const v2u u = __builtin_nontemporal_load(yr + 64 * j); v[j].x += wk * bflo(u.x); v[j].y += wk * bfhi(u.x); v[j].z += wk * bflo(u.y); v[j].w += wk * bfhi(u.y); } }
        float s = 0.f;
#pragma unroll
        for (int j = 0; j < 8; ++j) s += (v[j].x * v[j].x + v[j].y * v[j].y) + (v[j].z * v[j].z + v[j].w * v[j].w);
        const float rstd = rsqrtf(wave_sum(s) * (1.f / D) + NORM_EPS);
        f32x4* o = (f32x4*)(a.out + (size_t)t * D) + lane;
#pragma unroll
        for (int j = 0; j < 8; ++j) { const f32x4 gg = ((const f32x4*)a.in[I_NFINAL])[64 * j + lane]; __builtin_nontemporal_store(v[j] * rstd * gg, o + 64 * j); }
    }
}

__global__ void __launch_bounds__(512, 2) __attribute__((amdgpu_num_sgpr(96))) fwd(Args args) {
    extern __shared__ __attribute__((aligned(16))) unsigned char lds[];
    Frame F;
    F.lds = (LAS unsigned char*)lds; F.ws = args.ws; F.ctl = (unsigned*)(args.ws + WS_CTL);
    F.tid = threadIdx.x; F.lane = F.tid & 63; F.wave = __builtin_amdgcn_readfirstlane(F.tid >> 6);
    F.G = gridDim.x; { const int bx = blockIdx.x; F.vcu = (F.G % 8 == 0) ? (bx % 8) * (F.G / 8) + bx / 8 : bx; }
    for (int u = F.tid; u < (LDS_BYTES - LDSCTL_OFF) / 4; u += 512) ((LAS unsigned*)(F.lds + LDSCTL_OFF))[u] = 0u;
    __syncthreads();
    volatile LAS unsigned* MISC = (volatile LAS unsigned*)(F.lds + MISC_OFF);
#if MK_PER_PHASE
#define GRID_BAR() do { } while (0)
#else
    XcdBarrier bar = xcd_barrier_post(F.ctl + CW_BAR, MISC + 8);
#define GRID_BAR() xcd_barrier(bar)
#endif
    const int lo = args.ph_lo, hi = args.ph_hi;
#define IN(k) (lo <= (k) && (k) < hi)
#define SEAM(k) do { if (IN(k) && IN((k) + 1)) GRID_BAR(); } while (0)
#define DUP(k) (((PROBE_DUP) >> (k)) & 1)
#define PH_BEGIN {
#define PH_END }
    const bf16* P = (const bf16*)(F.ws + WS_P);

    if (IN(0)) { PH_BEGIN  p0_prologue(F, args);  PH_END if (DUP(0)) { GRID_BAR(); PH_BEGIN  p0_prologue(F, args);  PH_END } } SEAM(0);
    if (IN(1)) { PH_BEGIN  p1_gemm_in(F, args);  PH_END if (DUP(1)) { GRID_BAR(); PH_BEGIN  p1_gemm_in(F, args);  PH_END } } SEAM(1);
    if (PROBE_GEMM >= 0 && IN(1)) {
        pg8::Gemm g{(const bf16*)(F.ws + WS_H), (const bf16*)(F.ws + WS_WIN), DP, DP, D, nullptr}; pg8::ProbeOrder S; S.so.init(T, PLD, F.G, (int)blockIdx.x); S.mode = PROBE_GEMM;
        pg8::EpiProbe E{(bf16*)(F.ws + WS_XS)}; pg8::gemm_phase(F.lds, g, S, E); GRID_BAR();
    }
    if (IN(2)) { PH_BEGIN  p2_lora_in(F, args); gla_pass_a(F, args);  PH_END if (DUP(2)) { GRID_BAR(); PH_BEGIN  p2_lora_in(F, args); gla_pass_a(F, args);  PH_END } } SEAM(2);
    if (IN(3)) { PH_BEGIN
        { pg8::Gemm g{(const bf16*)(F.ws + WS_A2), (const bf16*)(F.ws + WS_WLWA), 512, 256, 256, nullptr}; pg8::StaticOrder S; S.init(T, 2048, F.G, (int)blockIdx.x);
          pg8::EpiBf16 E{(bf16*)(F.ws + WS_WAO), 2048, nullptr, 0, 1.f}; pg8::gemm_phase(F.lds, g, S, E); }
        { pg8::Gemm g{(const bf16*)(F.ws + WS_A2) + 256, (const bf16*)(F.ws + WS_WLG), 512, 256, 256, nullptr}; pg8::StaticOrder S; S.init(T, 1024, F.G, (int)blockIdx.x);
          pg8::EpiBf16 E{(bf16*)(F.ws + WS_GO), 1024, nullptr, 0, 1.f}; pg8::gemm_phase(F.lds, g, S, E); }
        {
            constexpr int NEL = BATCH * GH * GDV * GDK, HEAD = (NEL / 4 / 65536) * 65536; const int bx = (int)blockIdx.x;
            if (F.G == 256) { if (bx >= 128) gla_pass_b(F, 0, HEAD, bx - 128, 128); gla_pass_b(F, HEAD, NEL, F.vcu, F.G); } else gla_pass_b(F, 0, NEL, F.vcu, F.G); }
     PH_END if (DUP(3)) { GRID_BAR(); PH_BEGIN
        { pg8::Gemm g{(const bf16*)(F.ws + WS_A2), (const bf16*)(F.ws + WS_WLWA), 512, 256, 256, nullptr}; pg8::StaticOrder S; S.init(T, 2048, F.G, (int)blockIdx.x);
          pg8::EpiBf16 E{(bf16*)(F.ws + WS_WAO), 2048, nullptr, 0, 1.f}; pg8::gemm_phase(F.lds, g, S, E); }
        { pg8::Gemm g{(const bf16*)(F.ws + WS_A2) + 256, (const bf16*)(F.ws + WS_WLG), 512, 256, 256, nullptr}; pg8::StaticOrder S; S.init(T, 1024, F.G, (int)blockIdx.x);
          pg8::EpiBf16 E{(bf16*)(F.ws + WS_GO), 1024, nullptr, 0, 1.f}; pg8::gemm_phase(F.lds, g, S, E); }
        {
            constexpr int NEL = BATCH * GH * GDV * GDK, HEAD = (NEL / 4 / 65536) * 65536; const int bx = (int)blockIdx.x;
            if (F.G == 256) { if (bx >= 128) gla_pass_b(F, 0, HEAD, bx - 128, 128); gla_pass_b(F, HEAD, NEL, F.vcu, F.G); } else gla_pass_b(F, 0, NEL, F.vcu, F.G); }
     PH_END } } SEAM(3);
    if (IN(4)) { PH_BEGIN  p4_rwkv_prep(F, args); gla_pass_c(F, args);  PH_END if (DUP(4)) { GRID_BAR(); PH_BEGIN  p4_rwkv_prep(F, args); gla_pass_c(F, args);  PH_END } } SEAM(4);
    if (IN(5)) { PH_BEGIN  p5_rwkv_scan(F, args);  PH_END if (DUP(5)) { GRID_BAR(); PH_BEGIN  p5_rwkv_scan(F, args);  PH_END } } SEAM(5);
    if (IN(6)) { PH_BEGIN  p6_rwkv_post(F, args);  PH_END if (DUP(6)) { GRID_BAR(); PH_BEGIN  p6_rwkv_post(F, args);  PH_END } } SEAM(6);
    if (IN(7)) { PH_BEGIN
        { pg8::Gemm g{(const bf16*)(F.ws + WS_YA), (const bf16*)(F.ws + WS_WBA), RW, RW, RW, nullptr}; pg8::StaticOrder S; S.init(T, D, F.G, (int)blockIdx.x);
          pg8::EpiGate<false> E{(bf16*)(F.ws + WS_MRG), P, args.in[I_BM], C_GATE}; pg8::gemm_phase(F.lds, g, S, E); }
        { pg8::Gemm g{(const bf16*)(F.ws + WS_YB), (const bf16*)(F.ws + WS_WBB), GVW, GVW, GVW, nullptr}; pg8::StaticOrder S; S.init(T, D, F.G, (int)blockIdx.x);
          pg8::EpiGate<true> E{(bf16*)(F.ws + WS_MRG), P, args.in[I_BM] + D, C_GATE + D}; pg8::gemm_phase(F.lds, g, S, E); }
     PH_END if (DUP(7)) { GRID_BAR(); PH_BEGIN
        { pg8::Gemm g{(const bf16*)(F.ws + WS_YA), (const bf16*)(F.ws + WS_WBA), RW, RW, RW, nullptr}; pg8::StaticOrder S; S.init(T, D, F.G, (int)blockIdx.x);
          pg8::EpiGate<false> E{(bf16*)(F.ws + WS_MRG), P, args.in[I_BM], C_GATE}; pg8::gemm_phase(F.lds, g, S, E); }
        { pg8::Gemm g{(const bf16*)(F.ws + WS_YB), (const bf16*)(F.ws + WS_WBB), GVW, GVW, GVW, nullptr}; pg8::StaticOrder S; S.init(T, D, F.G, (int)blockIdx.x);
          pg8::EpiGate<true> E{(bf16*)(F.ws + WS_MRG), P, args.in[I_BM] + D, C_GATE + D}; pg8::gemm_phase(F.lds, g, S, E); }
     PH_END } } SEAM(7);
    if (IN(8)) { PH_BEGIN
        pg8::Gemm g{(const bf16*)(F.ws + WS_MRG), (const bf16*)(F.ws + WS_WOUT), D, D, D, nullptr}; pg8::StaticOrder S; S.init(T, D, F.G, (int)blockIdx.x);
        pg8::EpiResF32 E{(float*)(F.ws + WS_X1), args.in[I_X]}; pg8::gemm_phase(F.lds, g, S, E);
     PH_END if (DUP(8)) { GRID_BAR(); PH_BEGIN
        pg8::Gemm g{(const bf16*)(F.ws + WS_MRG), (const bf16*)(F.ws + WS_WOUT), D, D, D, nullptr}; pg8::StaticOrder S; S.init(T, D, F.G, (int)blockIdx.x);
        pg8::EpiResF32 E{(float*)(F.ws + WS_X1), args.in[I_X]}; pg8::gemm_phase(F.lds, g, S, E);
     PH_END } } SEAM(8);
    if (IN(9)) { PH_BEGIN  p11_router(F, args);  PH_END if (DUP(9)) { GRID_BAR(); PH_BEGIN  p11_router(F, args);  PH_END } } SEAM(9);
    if (IN(10)) { PH_BEGIN
        moe_tables(F, 16);
        pg8::Gemm g{(const bf16*)(F.ws + WS_H2), (const bf16*)(F.ws + WS_WGU), D, D, D, (const int*)(F.ws + WS_ROUTE + 1024 * 1024)};
        pg8::MoeOrder S{(const volatile LAS int*)(F.lds + MOE_OFF), 16, 4096, F.G, F.vcu};
        pg8::EpiGluQ E{(unsigned char*)(F.ws + WS_HH), args.in[I_BGATE], args.in[I_BUP]}; pg8::gemm_phase<pg8::EpiGluQ, pg8::MoeOrder, 1, true>(F.lds, g, S, E);
     PH_END if (DUP(10)) { GRID_BAR(); PH_BEGIN
        moe_tables(F, 16);
        pg8::Gemm g{(const bf16*)(F.ws + WS_H2), (const bf16*)(F.ws + WS_WGU), D, D, D, (const int*)(F.ws + WS_ROUTE + 1024 * 1024)};
        pg8::MoeOrder S{(const volatile LAS int*)(F.lds + MOE_OFF), 16, 4096, F.G, F.vcu};
        pg8::EpiGluQ E{(unsigned char*)(F.ws + WS_HH), args.in[I_BGATE], args.in[I_BUP]}; pg8::gemm_phase<pg8::EpiGluQ, pg8::MoeOrder, 1, true>(F.lds, g, S, E);
     PH_END } } SEAM(10);
    if (IN(11)) { PH_BEGIN
        moe_tables(F, 8);
        pg8::Gemm g{(const bf16*)(F.ws + WS_HH), (const bf16*)(F.ws + WS_WD), FF, FF, FF, nullptr};
        pg8::MoeOrder S{(const volatile LAS int*)(F.lds + MOE_OFF), 8, 2048, F.G, F.vcu};
        pg8::EpiBf16 E{(bf16*)(F.ws + WS_Y), D, args.in[I_BDOWN], D, WQ_INV}; pg8::gemm_phase<pg8::EpiBf16, pg8::MoeOrder, 1>(F.lds, g, S, E);
     PH_END if (DUP(11)) { GRID_BAR(); PH_BEGIN
        moe_tables(F, 8);
        pg8::Gemm g{(const bf16*)(F.ws + WS_HH), (const bf16*)(F.ws + WS_WD), FF, FF, FF, nullptr};
        pg8::MoeOrder S{(const volatile LAS int*)(F.lds + MOE_OFF), 8, 2048, F.G, F.vcu};
        pg8::EpiBf16 E{(bf16*)(F.ws + WS_Y), D, args.in[I_BDOWN], D, WQ_INV}; pg8::gemm_phase<pg8::EpiBf16, pg8::MoeOrder, 1>(F.lds, g, S, E);
     PH_END } } SEAM(11);
    if (IN(12)) { PH_BEGIN  p15_combine(F, args);  PH_END if (DUP(12)) { GRID_BAR(); PH_BEGIN  p15_combine(F, args);  PH_END } }
#undef IN
#undef SEAM
}
constexpr int N_PHASES = 13;

extern "C" void kernel_launch(void* const* d_in, const int* in_sizes, int n_in, void* d_out, int out_size, void* d_ws, size_t ws_size, hipStream_t stream) {
    static int grid = 0;
    if (grid == 0) {
        if (n_in != 31 || in_sizes[0] != T * D || out_size != T * D || ws_size < WS_END) { fprintf(stderr, "kernel_launch: unexpected shapes (n_in %d, ws %zu)\n", n_in, ws_size); grid = -1; return; }
        int dev = 0, cus = 0, per_cu = 0;
        if (hipGetDevice(&dev) != hipSuccess || hipDeviceGetAttribute(&cus, hipDeviceAttributeMultiprocessorCount, dev) != hipSuccess) { grid = -1; return; }
        if (hipFuncSetAttribute((const void*)fwd, hipFuncAttributeMaxDynamicSharedMemorySize, LDS_BYTES) != hipSuccess) { fprintf(stderr, "kernel_launch: hipFuncSetAttribute failed\n"); grid = -1; return; }
        if (hipOccupancyMaxActiveBlocksPerMultiprocessor(&per_cu, (const void*)fwd, 512, LDS_BYTES) != hipSuccess || per_cu < 1) { fprintf(stderr, "kernel_launch: occupancy query says %d\n", per_cu); }
        (void)hipGetLastError();
        grid = cus;
    }
    if (grid < 0) return;
    (void)hipMemsetAsync((char*)d_ws + WS_CTL, 0, CTL_ZERO_BYTES, stream);
    Args a{};
    for (int i = 0; i < 31; ++i) a.in[i] = (const float*)d_in[i];
    a.out = (float*)d_out; a.ws = (unsigned char*)d_ws;
#if MK_PER_PHASE
    for (int p = 0; p < N_PHASES; ++p) { a.ph_lo = p; a.ph_hi = p + 1; hipLaunchKernelGGL(fwd, dim3(grid), dim3(512), LDS_BYTES, stream, a); }
#else
    a.ph_lo = 0; a.ph_hi = N_PHASES;
    hipLaunchKernelGGL(fwd, dim3(grid), dim3(512), LDS_BYTES, stream, a);
#endif
}
```

```cpp
#include <hip/hip_runtime.h>
#include <cstdio>
#include <cstdint>

#ifndef MK_PER_PHASE
#define MK_PER_PHASE 0
#endif

#ifndef PROBE_GEMM
#define PROBE_GEMM -1
#endif
#ifndef PROBE_DUP
#define PROBE_DUP 0
#endif
#define GAS __attribute__((address_space(1)))
#define LAS __attribute__((address_space(3)))
typedef unsigned short bf16;
typedef unsigned v4u __attribute__((ext_vector_type(4)));
typedef unsigned v2u __attribute__((ext_vector_type(2)));
typedef float f32x4 __attribute__((ext_vector_type(4)));
typedef float f32x2 __attribute__((ext_vector_type(2)));
typedef short bf16x8 __attribute__((ext_vector_type(8)));
typedef long i64x2 __attribute__((ext_vector_type(2)));
typedef int v4i __attribute__((ext_vector_type(4)));
typedef int v8i __attribute__((ext_vector_type(8)));
#define RLX_AGENT __ATOMIC_RELAXED, __HIP_MEMORY_SCOPE_AGENT
#define LDS_WAIT() asm volatile("s_waitcnt lgkmcnt(0)" ::: "memory")
#define VM_WAIT() asm volatile("s_waitcnt vmcnt(0)" ::: "memory")

constexpr int D = 2048, BATCH = 4, SEQ = 2048, T = BATCH * SEQ;
constexpr int RW = 1024, RH = 16, RN = 64;
constexpr int DLORA = 96, GLORA = 256;
constexpr int RWKV_COLS = 3 * RW + 2 * DLORA + GLORA;
constexpr int GH = 4, GDK = 128, GDV = 256, GKW = GH * GDK, GVW = GH * GDV, GAL = 16;
constexpr int GLA_COLS = 2 * GKW + 2 * GVW + GAL;
constexpr int IN_COLS = RWKV_COLS + GLA_COLS + 2 * D;
constexpr int PLD = 10752;
constexpr int DP = D + 64;
constexpr int C_R = 0, C_K = 1024, C_V = 2048, C_WL = 3072, C_AL = 3168, C_GL = 3264;
constexpr int C_GQ = 3520, C_GK = 4032, C_GV = 4544, C_OG = 5568, C_GAL = 6592, C_GATE = 6608;
constexpr int NE = 32, TOPK = 4, FF = 2048;
constexpr int XS_ROWS = T * TOPK + NE * 256;
constexpr int CHUNK = 64, NCH = SEQ / CHUNK;
constexpr float NORM_EPS = 1e-5f, GN_EPS = 64e-5f;
constexpr float WQ_SCALE = 64.f, WQ_INV = 1.f / 64.f;

constexpr size_t MiB = 1u << 20;
constexpr size_t WS_CTL = 0, CTL_ZERO_BYTES = 1 * MiB;
constexpr size_t WS_WR = 1 * MiB;
constexpr size_t WS_WLWA = 2 * MiB;
constexpr size_t WS_WLG = 3 * MiB;
constexpr size_t WS_WBA = 4 * MiB, WS_WBB = 8 * MiB;
constexpr size_t WS_WOUT = 12 * MiB;
constexpr size_t WS_WIN = 64 * MiB;
constexpr size_t WS_WGU = 192 * MiB;
constexpr size_t WS_WD = 448 * MiB;
constexpr size_t WS_H = 128 * MiB;
constexpr size_t WS_P = 864 * MiB;
constexpr size_t WS_Y = WS_P;
constexpr size_t WS_A2 = 1032 * MiB;
constexpr size_t WS_WAO = 1040 * MiB;
constexpr size_t WS_GO = 1072 * MiB;
constexpr size_t WS_SCAN = 1088 * MiB;
constexpr size_t WS_BON = 1200 * MiB;
constexpr size_t WS_YRAW = 1280 * MiB;
constexpr size_t WS_GHT = 1312 * MiB;
constexpr size_t WS_GST = 1376 * MiB;
constexpr size_t WS_GDEC = 1408 * MiB;
constexpr size_t WS_GBC = 576 * MiB;
constexpr size_t WS_YA = 1410 * MiB, WS_YB = 1426 * MiB;
constexpr size_t WS_MRG = 1442 * MiB;
constexpr size_t WS_X1 = 1474 * MiB;
constexpr size_t WS_H2 = 832 * MiB;
constexpr size_t WS_ROUTE = 1570 * MiB;
constexpr size_t WS_XS = 1572 * MiB;
constexpr size_t WS_HH = 1732 * MiB;
constexpr size_t WS_END = 1892 * MiB;
constexpr int CW_BAR = 4096;
constexpr int CW_CNT = 16384;
constexpr int CW_CVQ = 20480, CW_CVSTOP = 20544;

constexpr int RING_BYTES = 131072;
constexpr int LDSCTL_OFF = 159744, MISC_OFF = LDSCTL_OFF + 320;
constexpr int MOE_OFF = LDSCTL_OFF + 1024;
constexpr int LDS_BYTES = 163840;

__device__ __forceinline__ unsigned f2bf(float f) { unsigned u = __builtin_bit_cast(unsigned, f); return (u + 0x7fffu + ((u >> 16) & 1u)) >> 16; }
__device__ __forceinline__ unsigned pk2(float lo, float hi) { return f2bf(lo) | (f2bf(hi) << 16); }
__device__ __forceinline__ unsigned pk4_fp8(float a, float b, float c, float d) { int w = 0; w = __builtin_amdgcn_cvt_pk_fp8_f32(a, b, w, false); w = __builtin_amdgcn_cvt_pk_fp8_f32(c, d, w, true); return (unsigned)w; }
__device__ __forceinline__ float bflo(unsigned u) { return __builtin_bit_cast(float, u << 16); }
__device__ __forceinline__ float bfhi(unsigned u) { return __builtin_bit_cast(float, u & 0xffff0000u); }
__device__ __forceinline__ float bf2f(bf16 b) { return __builtin_bit_cast(float, ((unsigned)b) << 16); }
__device__ __forceinline__ float wave_sum(float v) {
#pragma unroll
    for (int o = 1; o < 64; o <<= 1) v += __shfl_xor(v, o);
    return v;
}
__device__ __forceinline__ float sigmoidf_(float x) { return 1.f / (1.f + __expf(-x)); }
__device__ __forceinline__ float softplusf_(float x) { return fmaxf(x, 0.f) + log1pf(__expf(-fabsf(x))); }

namespace pg8 {
constexpr int BM = 256, BK = 64, HALF = 128, HTB = HALF * BK * 2, STAGE_BYTES = 8 * HTB, NXCD = 8, WGM = 8;
__host__ __device__ __forceinline__ int lds_byte(int r, int c) { return r * 128 + (((c >> 3) ^ ((r >> 1) & 7)) << 4) + (c & 7) * 2; }
__host__ __device__ __forceinline__ void stage_rc(int b, int& R, int& C) { R = b >> 7; C = ((((b & 127) >> 4) ^ ((R >> 1) & 7)) << 3); }
__host__ __device__ __forceinline__ int perm32(int rho) { const int n = rho >> 4, i = rho & 15; return 8 * (i >> 2) + 4 * n + (i & 3); }

struct Unit { int rowA, rowB, pn, e, rk0, cnt, hn; };
struct Gemm { const bf16* A; const bf16* Bt; int lda, ldb, K; const int* list; };

struct StaticOrder {
    int nM, nN, nwg, G, c;
    __device__ void init(int M, int N, int G_, int c_) { nM = M / BM; nN = N / BM; nwg = nM * nN; G = G_; c = c_; }
    __device__ bool next(int i, Unit& u) const {
        const long L = (long)i * G + c; if (L >= nwg) return false;
        int wgid = (int)L; { const int q = nwg / NXCD, r = nwg % NXCD, xcd = wgid % NXCD, off = wgid / NXCD; wgid = (xcd < r ? xcd * (q + 1) : r * (q + 1) + (xcd - r) * q) + off; }
        const int nig = WGM * nN, gid = wgid / nig, fm = gid * WGM, gsz = (nM - fm) < WGM ? (nM - fm) : WGM;
        const int pm = fm + ((wgid % nig) % gsz); u.pn = (wgid % nig) / gsz; u.rowA = pm * BM; u.rowB = u.pn * BM; u.e = 0; u.rk0 = 0; u.cnt = 0; u.hn = 0; return true;
    }
};
struct ProbeOrder {
    StaticOrder so; int mode;
    __device__ bool next(int i, Unit& u) const { if (!so.next(i, u)) return false; u.e = (u.rowA >> 8) * 64 + u.pn; if (mode & 1) u.rowA = 0; if (mode & 2) u.rowB = 0; return true; }
};
struct MoeOrder {
    const volatile LAS int* tab; int nct, rowsB, G, c;
    bool nsplit;
    __device__ bool next(int i, Unit& u) const {
        int L = i * G + c; const int total = __builtin_amdgcn_readfirstlane(tab[32]); int hn = 0;
        if (nsplit) { const int rf = (total / G) * G, r = total - rf;
            if (r > 0 && 2 * r <= G && L >= rf) { const int j = L - rf; if (j >= 2 * r) return false; L = rf + (j >> 1); hn = 1 + (j & 1); } }
        if (L >= total) return false;
        u.hn = hn;
        int e = 0;
        for (; e < 31; ++e) { if (L < __builtin_amdgcn_readfirstlane(tab[e + 1])) break; }
        const int local = L - __builtin_amdgcn_readfirstlane(tab[e]); const int nt = __builtin_amdgcn_readfirstlane(tab[72 + e]);
        const int ct = local / nt, rt = local - ct * nt;
        u.rowA = __builtin_amdgcn_readfirstlane(tab[36 + e]) + rt * BM; u.rowB = e * rowsB + ct * BM + (hn == 2 ? HALF : 0); u.pn = ct; u.e = e; u.rk0 = rt * BM; u.cnt = __builtin_amdgcn_readfirstlane(tab[108 + e]); return true;
    }
};

__device__ __forceinline__ unsigned cvt_pk_bf16(float lo, float hi) { unsigned r; asm volatile("v_cvt_pk_bf16_f32 %0, %1, %2" : "=v"(r) : "v"(lo), "v"(hi)); return r; }

struct EpiBf16 {
    static constexpr bool PERM = true;
    bf16* O; int ldc; const float* bias; int bias_estride; float scale;
    __device__ __forceinline__ void operator()(const f32x4 (&acc)[2][2][4][2], const Unit& u, int wr, int wc, int fr, int fq) const {
        const int row0 = u.rowA + wr * 64 + fr, col0 = u.pn * BM + wc * 32 + 8 * fq;
        f32x4 bv[2][2];
#pragma unroll
        for (int bj = 0; bj < 2; ++bj)
#pragma unroll
            for (int n = 0; n < 2; ++n) bv[bj][n] = bias ? *(const f32x4*)(bias + (size_t)u.e * bias_estride + col0 + bj * HALF + 4 * n) : (f32x4){0.f, 0.f, 0.f, 0.f};
#pragma unroll
        for (int ai = 0; ai < 2; ++ai)
#pragma unroll
            for (int m = 0; m < 4; ++m) { bf16* rowp = O + (size_t)(row0 + ai * HALF + m * 16) * ldc + col0;
#pragma unroll
                for (int bj = 0; bj < 2; ++bj) { const f32x4 v0 = acc[ai][bj][m][0] * scale + bv[bj][0], v1 = acc[ai][bj][m][1] * scale + bv[bj][1];
                    v4u w; w.x = cvt_pk_bf16(v0[0], v0[1]); w.y = cvt_pk_bf16(v0[2], v0[3]); w.z = cvt_pk_bf16(v1[0], v1[1]); w.w = cvt_pk_bf16(v1[2], v1[3]);
                    *(v4u*)(rowp + bj * HALF) = w; } }
    }
};
struct EpiBf16H {
    static constexpr bool PERM = true;
    bf16* O; int ldc; const float* bias; int bias_estride; float scale;
    __device__ __forceinline__ void operator()(const f32x4 (&acc)[2][2][4][2], const Unit& u, int wr, int wc, int fr, int fq) const {
        const int row0 = u.rowA + wr * 64 + fr, col0 = u.pn * BM + wc * 32 + 8 * fq + (u.hn == 2 ? HALF : 0);
#pragma unroll
        for (int bj = 0; bj < 2; ++bj) { if (bj == 1 && u.hn != 0) break;
            f32x4 bv[2];
#pragma unroll
            for (int n = 0; n < 2; ++n) bv[n] = *(const f32x4*)(bias + (size_t)u.e * bias_estride + col0 + bj * HALF + 4 * n);
#pragma unroll
            for (int ai = 0; ai < 2; ++ai)
#pragma unroll
                for (int m = 0; m < 4; ++m) { bf16* rowp = O + (size_t)(row0 + ai * HALF + m * 16) * ldc + col0;
                    const f32x4 v0 = acc[ai][bj][m][0] * scale + bv[0], v1 = acc[ai][bj][m][1] * scale + bv[1];
                    v4u w; w.x = cvt_pk_bf16(v0[0], v0[1]); w.y = cvt_pk_bf16(v0[2], v0[3]); w.z = cvt_pk_bf16(v1[0], v1[1]); w.w = cvt_pk_bf16(v1[2], v1[3]);
                    *(v4u*)(rowp + bj * HALF) = w; } }
    }
};
struct EpiProbe {
    static constexpr bool PERM = true;
    bf16* O;
    __device__ __forceinline__ void operator()(const f32x4 (&acc)[2][2][4][2], const Unit& u, int wr, int wc, int fr, int fq) const {
        const int pm = u.e >> 6, pn = u.e & 63; const int row0 = pm * BM + wr * 64 + fr, col0 = pn * BM + wc * 32 + 8 * fq;
#pragma unroll
        for (int ai = 0; ai < 2; ++ai)
#pragma unroll
            for (int m = 0; m < 4; ++m) { bf16* rowp = O + (size_t)(row0 + ai * HALF + m * 16) * PLD + col0;
#pragma unroll
                for (int bj = 0; bj < 2; ++bj) { const f32x4 v0 = acc[ai][bj][m][0], v1 = acc[ai][bj][m][1];
                    v4u w; w.x = cvt_pk_bf16(v0[0], v0[1]); w.y = cvt_pk_bf16(v0[2], v0[3]); w.z = cvt_pk_bf16(v1[0], v1[1]); w.w = cvt_pk_bf16(v1[2], v1[3]);
                    *(v4u*)(rowp + bj * HALF) = w; } }
    }
};
template <bool ADD> struct EpiGate {
    static constexpr bool PERM = true;
    bf16* O; const bf16* P; const float* bm; int gcol;
    __device__ __forceinline__ void operator()(const f32x4 (&acc)[2][2][4][2], const Unit& u, int wr, int wc, int fr, int fq) const {
        const int row0 = u.rowA + wr * 64 + fr, col0 = u.pn * BM + wc * 32 + 8 * fq;
        f32x4 bv[2][2];
#pragma unroll
        for (int bj = 0; bj < 2; ++bj)
#pragma unroll
            for (int n = 0; n < 2; ++n) bv[bj][n] = *(const f32x4*)(bm + col0 + bj * HALF + 4 * n);
#pragma unroll
        for (int ai = 0; ai < 2; ++ai)
#pragma unroll
            for (int m = 0; m < 4; ++m) { const size_t row = (size_t)(row0 + ai * HALF + m * 16);
#pragma unroll
                for (int bj = 0; bj < 2; ++bj) {
                    const v4u pg = *(const v4u*)(P + row * PLD + gcol + col0 + bj * HALF);
                    bf16* op = O + row * D + col0 + bj * HALF;
                    float g[8] = {bflo(pg.x), bfhi(pg.x), bflo(pg.y), bfhi(pg.y), bflo(pg.z), bfhi(pg.z), bflo(pg.w), bfhi(pg.w)};
                    float r[8];
#pragma unroll
                    for (int j = 0; j < 4; ++j) { r[j] = sigmoidf_(g[j] + bv[bj][0][j]) * acc[ai][bj][m][0][j]; r[4 + j] = sigmoidf_(g[4 + j] + bv[bj][1][j]) * acc[ai][bj][m][1][j]; }
                    if (ADD) { const v4u pv = *(const v4u*)op;
                        r[0] += bflo(pv.x); r[1] += bfhi(pv.x); r[2] += bflo(pv.y); r[3] += bfhi(pv.y); r[4] += bflo(pv.z); r[5] += bfhi(pv.z); r[6] += bflo(pv.w); r[7] += bfhi(pv.w); }
                    v4u w; w.x = cvt_pk_bf16(r[0], r[1]); w.y = cvt_pk_bf16(r[2], r[3]); w.z = cvt_pk_bf16(r[4], r[5]); w.w = cvt_pk_bf16(r[6], r[7]);
                    *(v4u*)op = w; } }
    }
};
struct EpiResF32 {
    static constexpr bool PERM = false;
    float* O; const float* X;
    __device__ __forceinline__ void operator()(const f32x4 (&acc)[2][2][4][2], const Unit& u, int wr, int wc, int fr, int fq) const {
        const int row0 = u.rowA + wr * 64 + fr, col0 = u.pn * BM + wc * 32 + 4 * fq;
#pragma unroll
        for (int ai = 0; ai < 2; ++ai)
#pragma unroll
            for (int m = 0; m < 4; ++m) { const size_t ro = (size_t)(row0 + ai * HALF + m * 16) * D + col0;
#pragma unroll
                for (int bj = 0; bj < 2; ++bj)
#pragma unroll
                    for (int n = 0; n < 2; ++n) *(f32x4*)(O + ro + bj * HALF + n * 16) = acc[ai][bj][m][n] + __builtin_nontemporal_load((const f32x4*)(X + ro + bj * HALF + n * 16)); }
    }
};
struct EpiGlu {
    static constexpr bool PERM = true;
    bf16* O; const float* bg; const float* bu;
    __device__ __forceinline__ void operator()(const f32x4 (&acc)[2][2][4][2], const Unit& u, int wr, int wc, int fr, int fq) const {
        const int row0 = u.rowA + wr * 64 + fr, col0 = u.pn * HALF + wc * 32 + 8 * fq;
        f32x4 gb[2], ub[2];
#pragma unroll
        for (int n = 0; n < 2; ++n) { gb[n] = *(const f32x4*)(bg + (size_t)u.e * FF + col0 + 4 * n); ub[n] = *(const f32x4*)(bu + (size_t)u.e * FF + col0 + 4 * n); }
#pragma unroll
        for (int ai = 0; ai < 2; ++ai)
#pragma unroll
            for (int m = 0; m < 4; ++m) { bf16* op = O + (size_t)(row0 + ai * HALF + m * 16) * FF + col0;
                float r[8];
#pragma unroll
                for (int n = 0; n < 2; ++n)
#pragma unroll
                    for (int j = 0; j < 4; ++j) { float g = fminf(acc[ai][0][m][n][j] + gb[n][j], 7.f); float up = fminf(fmaxf(acc[ai][1][m][n][j] + ub[n][j], -7.f), 7.f);
                        r[4 * n + j] = (up + 1.f) * g * sigmoidf_(1.702f * g); }
                v4u w; w.x = cvt_pk_bf16(r[0], r[1]); w.y = cvt_pk_bf16(r[2], r[3]); w.z = cvt_pk_bf16(r[4], r[5]); w.w = cvt_pk_bf16(r[6], r[7]);
                *(v4u*)op = w; }
    }
};

struct EpiGluQ {
    static constexpr bool PERM = true;
    unsigned char* O; const float* bg; const float* bu;
    __device__ __forceinline__ void operator()(const f32x4 (&acc)[2][2][4][2], const Unit& u, int wr, int wc, int fr, int fq) const {
        const int row0 = u.rowA + wr * 64 + fr, col0 = u.pn * HALF + wc * 32 + 8 * fq;
        f32x4 gb[2], ub[2];
#pragma unroll
        for (int n = 0; n < 2; ++n) { gb[n] = *(const f32x4*)(bg + (size_t)u.e * FF + col0 + 4 * n); ub[n] = *(const f32x4*)(bu + (size_t)u.e * FF + col0 + 4 * n); }
#pragma unroll
        for (int ai = 0; ai < 2; ++ai)
#pragma unroll
            for (int m = 0; m < 4; ++m) { unsigned char* op = O + (size_t)(row0 + ai * HALF + m * 16) * FF + col0;
                float r[8];
#pragma unroll
                for (int n = 0; n < 2; ++n)
#pragma unroll
                    for (int j = 0; j < 4; ++j) { float g = fminf(acc[ai][0][m][n][j] * WQ_INV + gb[n][j], 7.f); float up = fminf(fmaxf(acc[ai][1][m][n][j] * WQ_INV + ub[n][j], -7.f), 7.f);
                        r[4 * n + j] = (up + 1.f) * g * sigmoidf_(1.702f * g); }
                v2u w; w.x = pk4_fp8(r[0], r[1], r[2], r[3]); w.y = pk4_fp8(r[4], r[5], r[6], r[7]);
                *(v2u*)op = w; }
    }
};

template <class Epi, class Sched, int ESZ = 2, bool GATHER = false, bool ALIGN_EPI = true, bool NSPLIT = false>
__device__ __forceinline__ void gemm_phase(LAS unsigned char* lds, const Gemm g, const Sched& S, const Epi& E) {
    const int tid = threadIdx.x, wid = __builtin_amdgcn_readfirstlane(tid >> 6), lane = tid & 63, wr = wid >> 2, wc = wid & 3, fr = lane & 15, fq = lane >> 4;
    const int K = g.K, nt = K * ESZ / (BK * 2);
    unsigned voffA[2], voffB[2]; int Rst[2], Cst[2];
#pragma unroll
    for (int i = 0; i < 2; ++i) { int R, C; stage_rc(tid * 16 + i * 8192, R, C); const int Rb = Epi::PERM ? ((R & ~31) + perm32(R & 31)) : R; Rst[i] = R; Cst[i] = C * 2;
        voffA[i] = (unsigned)(R * g.lda * ESZ + C * 2); voffB[i] = (unsigned)(Rb * g.ldb * ESZ + C * 2); }
    const size_t kstep = (size_t)(BK * 2);
    const size_t hstepA = (size_t)HALF * g.lda * ESZ, hstepB = (size_t)HALF * g.ldb * ESZ;
    const unsigned ldsw = (unsigned)wid * 1024u;
    const int aoff = lds_byte(wr * 64 + fr, fq * 8), boff = lds_byte(wc * 32 + fr, fq * 8);
#define PG8_SA(b, h) (((b) * 2 + (h)) * HTB)
#define PG8_SB(b, h) ((4 + (b) * 2 + (h)) * HTB)
#define PG8_STAGE(bufoff, gbase, voff) do { _Pragma("unroll") for (int _i = 0; _i < 2; ++_i) \
        __builtin_amdgcn_global_load_lds((const unsigned*)((const char*)(gbase) + (voff)[_i]), (LAS unsigned*)(lds + (bufoff) + ldsw + _i * 8192), 16, 0, 0); } while (0)
#define PG8_GOFF(u_, v_) do { _Pragma("unroll") for (int h_ = 0; h_ < 2; ++h_) _Pragma("unroll") for (int i_ = 0; i_ < 2; ++i_) { const int rk_ = (u_).rk0 + 128 * h_ + Rst[i_]; \
        const int tok_ = rk_ < (u_).cnt ? g.list[(u_).e * 8192 + rk_] : 0; (v_)[h_][i_] = (unsigned)tok_ * (unsigned)(g.lda * ESZ) + (unsigned)Cst[i_]; } } while (0)
#define PG8_STAGE_A(bufoff, isnext, tt, h) do { if constexpr (GATHER) { unsigned vo_[2] = {(isnext) ? vN[h][0] : vA[h][0], (isnext) ? vN[h][1] : vA[h][1]}; PG8_STAGE(bufoff, (const char*)g.A + (size_t)(tt) * kstep, vo_); } \
        else PG8_STAGE(bufoff, ((isnext) ? nA : cA) + (size_t)(tt) * kstep + (size_t)(h) * hstepA, voffA); } while (0)
#define PG8_LD16(off_) (*(const LAS v4i*)(lds + (off_)))
#define PG8_LDA(dst, b, h) do { if constexpr (ESZ == 2) { _Pragma("unroll") for (int m = 0; m < 4; ++m) _Pragma("unroll") for (int k = 0; k < 2; ++k) dst[m][k] = *(const LAS bf16x8*)(lds + PG8_SA(b, h) + (k ? (aoff ^ 64) : aoff) + m * 2048); } \
        else { _Pragma("unroll") for (int m = 0; m < 4; ++m) dst##8[m] = __builtin_shufflevector(PG8_LD16(PG8_SA(b, h) + aoff + m * 2048), PG8_LD16(PG8_SA(b, h) + (aoff ^ 64) + m * 2048), 0, 1, 2, 3, 4, 5, 6, 7); } } while (0)
#define PG8_LDB(dst, b, h) do { if constexpr (ESZ == 2) { _Pragma("unroll") for (int n = 0; n < 2; ++n) _Pragma("unroll") for (int k = 0; k < 2; ++k) dst[n][k] = *(const LAS bf16x8*)(lds + PG8_SB(b, h) + (k ? (boff ^ 64) : boff) + n * 2048); } \
        else { _Pragma("unroll") for (int n = 0; n < 2; ++n) dst##8[n] = __builtin_shufflevector(PG8_LD16(PG8_SB(b, h) + boff + n * 2048), PG8_LD16(PG8_SB(b, h) + (boff ^ 64) + n * 2048), 0, 1, 2, 3, 4, 5, 6, 7); } } while (0)
#define PG8_MMA(ai, bj, At, Bt) do { __builtin_amdgcn_s_setprio(1); _Pragma("unroll") for (int m = 0; m < 4; ++m) _Pragma("unroll") for (int n = 0; n < 2; ++n) { \
        if constexpr (ESZ == 2) { _Pragma("unroll") for (int k = 0; k < 2; ++k) acc[ai][bj][m][n] = __builtin_amdgcn_mfma_f32_16x16x32_bf16(Bt[n][k], At[m][k], acc[ai][bj][m][n], 0, 0, 0); } \
        else asm volatile("s_nop 1\n\tv_mfma_scale_f32_16x16x128_f8f6f4 %0, %1, %2, %0, %3, %3 op_sel_hi:[0,0,0]" : "+v"(acc[ai][bj][m][n]) : "v"(Bt##8[n]), "v"(At##8[m]), "v"(one_scale)); } \
        __builtin_amdgcn_s_setprio(0); } while (0)
#define PG8_WAIT_V(n) asm volatile("s_waitcnt vmcnt(" #n ")" ::: "memory")
#define PG8_WAIT_L(n) asm volatile("s_waitcnt lgkmcnt(" #n ")" ::: "memory")
#define PG8_BAR __builtin_amdgcn_s_barrier()
#define PG8_SCHED __builtin_amdgcn_sched_barrier(0)
    Unit cur, nxt; int ui = 0;
    if (!S.next(0, cur)) return;
    f32x4 acc[2][2][4][2];
#pragma unroll
    for (int a = 0; a < 2; ++a)
#pragma unroll
        for (int b = 0; b < 2; ++b)
#pragma unroll
            for (int m = 0; m < 4; ++m)
#pragma unroll
                for (int n = 0; n < 2; ++n) acc[a][b][m][n] = (f32x4){0.f, 0.f, 0.f, 0.f};
    const int one_scale = 0x7F7F7F7F;
    bf16x8 At[4][2], B0[2][2], B1[2][2]; v8i At8[4], B08[2], B18[2];
    const char* cA = (const char*)g.A + (size_t)cur.rowA * g.lda * ESZ; const char* cB = (const char*)g.Bt + (size_t)cur.rowB * g.ldb * ESZ;
    unsigned vA[2][2] = {{0u, 0u}, {0u, 0u}}, vN[2][2] = {{0u, 0u}, {0u, 0u}}; const char* nA = cA;
    if constexpr (GATHER) PG8_GOFF(cur, vA);
    PG8_STAGE(PG8_SB(0, 0), cB, voffB); PG8_STAGE(PG8_SB(0, 1), cB + hstepB, voffB); PG8_STAGE_A(PG8_SA(0, 0), false, 0, 0); PG8_STAGE_A(PG8_SA(0, 1), false, 0, 1);
    if (wr == 1) PG8_BAR;
    PG8_WAIT_V(2); PG8_BAR;
    PG8_STAGE(PG8_SB(1, 0), cB + kstep, voffB); PG8_STAGE_A(PG8_SA(1, 0), false, 1, 0); PG8_STAGE(PG8_SB(1, 1), cB + hstepB + kstep, voffB);
    PG8_WAIT_V(6); PG8_BAR;
    for (;;) {
        const bool has_next = S.next(ui + 1, nxt);
        nA = has_next ? (const char*)g.A + (size_t)nxt.rowA * g.lda * ESZ : cA; const char* nB = has_next ? (const char*)g.Bt + (size_t)nxt.rowB * g.ldb * ESZ : cB;
        if constexpr (GATHER) { if (has_next) PG8_GOFF(nxt, vN); else { vN[0][0] = vA[0][0]; vN[0][1] = vA[0][1]; vN[1][0] = vA[1][0]; vN[1][1] = vA[1][1]; } }
        const bool hnz = NSPLIT && cur.hn != 0;
        for (int t = 0; t < nt; t += 2) {
            const bool last = (t == nt - 2);
            const char* b2 = last ? nB : cB + (size_t)(t + 2) * kstep; const char* b3 = b2 + kstep;
            const int t2 = last ? 0 : t + 2, t3 = last ? 1 : t + 3;
            PG8_LDB(B0, 0, 0); if (NSPLIT ? !hnz : true) PG8_LDB(B1, 0, 1); PG8_SCHED; PG8_LDA(At, 0, 0); PG8_STAGE_A(PG8_SA(1, 1), false, t + 1, 1);
            PG8_WAIT_V(8); PG8_WAIT_L(0); PG8_BAR; PG8_MMA(0, 0, At, B0); if (NSPLIT ? !hnz : true) PG8_MMA(0, 1, At, B1); PG8_BAR; PG8_SCHED;
            PG8_LDA(At, 0, 1); PG8_STAGE(PG8_SB(0, 0), b2, voffB); PG8_STAGE(PG8_SB(0, 1), b2 + hstepB, voffB); PG8_STAGE_A(PG8_SA(0, 0), last, t2, 0);
            PG8_WAIT_V(8); PG8_WAIT_L(0); PG8_BAR; PG8_MMA(1, 0, At, B0); if (NSPLIT ? !hnz : true) PG8_MMA(1, 1, At, B1); PG8_BAR; PG8_SCHED;
            PG8_LDB(B0, 1, 0); if (NSPLIT ? !hnz : true) PG8_LDB(B1, 1, 1); PG8_SCHED; PG8_LDA(At, 1, 0); PG8_STAGE_A(PG8_SA(0, 1), last, t2, 1);
            PG8_WAIT_V(8); PG8_WAIT_L(0); PG8_BAR; PG8_MMA(0, 0, At, B0); if (NSPLIT ? !hnz : true) PG8_MMA(0, 1, At, B1); PG8_BAR; PG8_SCHED;
            PG8_LDA(At, 1, 1); PG8_STAGE(PG8_SB(1, 0), b3, voffB); PG8_STAGE(PG8_SB(1, 1), b3 + hstepB, voffB); PG8_STAGE_A(PG8_SA(1, 0), last, t3, 0);
            PG8_WAIT_V(8); PG8_WAIT_L(0); PG8_BAR; PG8_MMA(1, 0, At, B0); if (NSPLIT ? !hnz : true) PG8_MMA(1, 1, At, B1); PG8_BAR; PG8_SCHED;
        }
        if constexpr (ESZ == 1) asm volatile("s_nop 15\n\ts_nop 15" ::: "memory");
        if constexpr (ALIGN_EPI) { if (wr == 0) PG8_BAR; }
        E(acc, cur, wr, wc, fr, fq);
        if (!has_next) break;
#pragma unroll
        for (int a = 0; a < 2; ++a)
#pragma unroll
            for (int b = 0; b < 2; ++b)
#pragma unroll
                for (int m = 0; m < 4; ++m)
#pragma unroll
                    for (int n = 0; n < 2; ++n) acc[a][b][m][n] = (f32x4){0.f, 0.f, 0.f, 0.f};
        cur = nxt; cA = nA; cB = nB; ++ui;
        if constexpr (GATHER) { vA[0][0] = vN[0][0]; vA[0][1] = vN[0][1]; vA[1][0] = vN[1][0]; vA[1][1] = vN[1][1]; }
        if constexpr (ALIGN_EPI) { if (wr == 1) PG8_BAR; }
    }
    PG8_WAIT_V(0);
    if constexpr (!ALIGN_EPI) { if (wr == 0) PG8_BAR; }
    PG8_BAR;
#undef PG8_SA
#undef PG8_SB
#undef PG8_STAGE
#undef PG8_LDA
#undef PG8_LD16
#undef PG8_GOFF
#undef PG8_STAGE_A
#undef PG8_LDB
#undef PG8_MMA
#undef PG8_WAIT_V
#undef PG8_WAIT_L
#undef PG8_BAR
#undef PG8_SCHED
}

typedef short s16x4 __attribute__((ext_vector_type(4)));
struct UnitF { int rowA, pn, e; const float* b0; const float* b1; };
struct GemmF { const bf16* A; int lda, K, ldbn; };
struct MoeOrderF {
    const volatile LAS int* tab; int nct, G, c; const float* w0; const float* w1; size_t estride; int cstep;
    __device__ bool next(int i, UnitF& u) const {
        const int L = i * G + c; const int total = __builtin_amdgcn_readfirstlane(tab[32]); if (L >= total) return false;
        int e = 0;
        for (; e < 31; ++e) { if (L < __builtin_amdgcn_readfirstlane(tab[e + 1])) break; }
        const int local = L - __builtin_amdgcn_readfirstlane(tab[e]); const int nt = __builtin_amdgcn_readfirstlane(tab[72 + e]);
        const int ct = local / nt, rt = local - ct * nt;
        u.rowA = __builtin_amdgcn_readfirstlane(tab[36 + e]) + rt * BM; u.pn = ct; u.e = e;
        u.b0 = w0 + (size_t)e * estride + (size_t)ct * cstep; u.b1 = w1 + (size_t)e * estride + (size_t)ct * cstep; return true;
    }
};
struct EpiGluNP {
    bf16* O; const float* bg; const float* bu;
    __device__ __forceinline__ void operator()(const f32x4 (&acc)[2][2][4][2], const UnitF& u, int wr, int wc, int fr, int fq) const {
        const int row0 = u.rowA + wr * 64 + fr, col0 = u.pn * HALF + wc * 32 + 4 * fq;
        f32x4 gb[2], ub[2];
#pragma unroll
        for (int n = 0; n < 2; ++n) { gb[n] = *(const f32x4*)(bg + (size_t)u.e * FF + col0 + 16 * n); ub[n] = *(const f32x4*)(bu + (size_t)u.e * FF + col0 + 16 * n); }
#pragma unroll
        for (int ai = 0; ai < 2; ++ai)
#pragma unroll
            for (int m = 0; m < 4; ++m) { bf16* op = O + (size_t)(row0 + ai * HALF + m * 16) * FF + col0;
#pragma unroll
                for (int n = 0; n < 2; ++n) { float r[4];
#pragma unroll
                    for (int j = 0; j < 4; ++j) { const float gg = fminf(acc[ai][0][m][n][j] + gb[n][j], 7.f); const float up = fminf(fmaxf(acc[ai][1][m][n][j] + ub[n][j], -7.f), 7.f);
                        r[j] = (up + 1.f) * gg * sigmoidf_(1.702f * gg); }
                    v2u w; w.x = cvt_pk_bf16(r[0], r[1]); w.y = cvt_pk_bf16(r[2], r[3]); *(v2u*)(op + 16 * n) = w; } }
    }
};
struct EpiBf16NP {
    bf16* O; int ldc; const float* bias; int bias_estride;
    __device__ __forceinline__ void operator()(const f32x4 (&acc)[2][2][4][2], const UnitF& u, int wr, int wc, int fr, int fq) const {
        const int row0 = u.rowA + wr * 64 + fr, col0 = u.pn * BM + wc * 32 + 4 * fq;
        f32x4 bv[2][2];
#pragma unroll
        for (int bj = 0; bj < 2; ++bj)
#pragma unroll
            for (int n = 0; n < 2; ++n) bv[bj][n] = *(const f32x4*)(bias + (size_t)u.e * bias_estride + col0 + bj * HALF + 16 * n);
#pragma unroll
        for (int ai = 0; ai < 2; ++ai)
#pragma unroll
            for (int m = 0; m < 4; ++m) { bf16* rowp = O + (size_t)(row0 + ai * HALF + m * 16) * ldc + col0;
#pragma unroll
                for (int bj = 0; bj < 2; ++bj)
#pragma unroll
                    for (int n = 0; n < 2; ++n) { const f32x4 v = acc[ai][bj][m][n] + bv[bj][n]; v2u w; w.x = cvt_pk_bf16(v[0], v[1]); w.y = cvt_pk_bf16(v[2], v[3]); *(v2u*)(rowp + bj * HALF + 16 * n) = w; } }
    }
};
template <class Epi, class Sched>
__device__ __forceinline__ void gemm_phase_f32b(LAS unsigned char* lds, const GemmF g, const Sched& S, const Epi& E) {
    const int tid = threadIdx.x, wid = __builtin_amdgcn_readfirstlane(tid >> 6), lane = tid & 63, wr = wid >> 2, wc = wid & 3, fr = lane & 15, fq = lane >> 4;
    const int K = g.K, nt = K / BK;
    unsigned voffA[2];
#pragma unroll
    for (int i = 0; i < 2; ++i) { int R, C; stage_rc(tid * 16 + i * 8192, R, C); voffA[i] = (unsigned)(R * g.lda + C) * 2u; }
    const size_t kstep = (size_t)(BK * 2);
    const size_t hstepA = (size_t)HALF * g.lda * 2;
    const unsigned ldsw = (unsigned)wid * 1024u;
    const int aoff = lds_byte(wr * 64 + fr, fq * 8);
    const int ldsb = (int)(uintptr_t)lds;
    const int q4 = (lane & 15) >> 2, p4 = lane & 3;
    const int fsw = q4 | ((fq & 1) << 2);
    int rbase[2];
#pragma unroll
    for (int n = 0; n < 2; ++n) rbase[n] = (8 * fq + q4) * 256 + ((((wc * 2) ^ fsw) ^ n) * 32) + 8 * p4;
    const int hB = wid >> 2, r0 = 2 * (wid & 3) + (lane >> 5), l31 = lane & 31;
    const int wslot = (l31 >> 2) ^ (r0 & 3);
    const int wb0 = hB * HTB + r0 * 256 + wslot * 32 + (lane & 3) * 8, wb1 = hB * HTB + r0 * 256 + (wslot ^ 4) * 32 + (lane & 3) * 8;
    const unsigned laneoffB = (unsigned)(r0 * g.ldbn + 4 * l31) * 4u;
    const size_t rstep8 = (size_t)8 * g.ldbn * 4, tstepB = (size_t)64 * g.ldbn * 4;
#define PG8_SA(b, h) (((b) * 2 + (h)) * HTB)
#define PG8_SB(b, h) ((4 + (b) * 2 + (h)) * HTB)
#define PG8_STAGE(bufoff, gbase, voff) do { _Pragma("unroll") for (int _i = 0; _i < 2; ++_i) { unsigned keep_; \
        asm volatile("s_mov_b32 %0, m0\n\ts_mov_b32 m0, %2\n\ts_nop 0\n\tglobal_load_lds_dwordx4 %1, off\n\ts_mov_b32 m0, %0" : "=&s"(keep_) \
            : "v"((const char*)(gbase) + (voff)[_i]), "s"(__builtin_amdgcn_readfirstlane(ldsb + (bufoff) + (int)ldsw + _i * 8192)) : "memory"); } } while (0)
#define PG8_LDA(dst, b, h) do { _Pragma("unroll") for (int m = 0; m < 4; ++m) _Pragma("unroll") for (int k = 0; k < 2; ++k) dst[m][k] = *(const LAS bf16x8*)(lds + PG8_SA(b, h) + (k ? (aoff ^ 64) : aoff) + m * 2048); } while (0)
#define PG8_LDBT(dst, b, h) do { _Pragma("unroll") for (int n = 0; n < 2; ++n) _Pragma("unroll") for (int k = 0; k < 2; ++k) { \
        const s16x4 lo_ = __builtin_amdgcn_ds_read_tr16_b64_v4i16((LAS s16x4*)(lds + PG8_SB(b, h) + rbase[n] + k * 8192)); \
        const s16x4 hi_ = __builtin_amdgcn_ds_read_tr16_b64_v4i16((LAS s16x4*)(lds + PG8_SB(b, h) + rbase[n] + k * 8192 + 1024)); \
        dst[n][k] = __builtin_shufflevector(lo_, hi_, 0, 1, 2, 3, 4, 5, 6, 7); } } while (0)
#define PG8_BPTR(p0, p1, tt) ((const char*)(hB ? (p1) : (p0)) + (size_t)(tt) * tstepB)
#define PG8_LOADB1(pb, i) dreg[i] = *(const f32x4*)((pb) + (size_t)(i) * rstep8 + laneoffB)
#define PG8_LOADB(p0, p1, tt) do { const char* pb_ = PG8_BPTR(p0, p1, tt); _Pragma("unroll") for (int _i = 0; _i < 8; ++_i) PG8_LOADB1(pb_, _i); } while (0)
#define PG8_WRITEB1(b, i) do { v2u pk_; pk_.x = cvt_pk_bf16(dreg[i].x, dreg[i].y); pk_.y = cvt_pk_bf16(dreg[i].z, dreg[i].w); \
        *(LAS v2u*)(lds + PG8_SB(b, 0) + (((i) & 1) ? wb1 : wb0) + (i) * 2048) = pk_; } while (0)
#define PG8_WRITEB(b) do { _Pragma("unroll") for (int _i = 0; _i < 8; ++_i) PG8_WRITEB1(b, _i); } while (0)
#define PG8_MF(ai, bj, m, At, Bt) do { _Pragma("unroll") for (int n = 0; n < 2; ++n) _Pragma("unroll") for (int k = 0; k < 2; ++k) \
        acc[ai][bj][m][n] = __builtin_amdgcn_mfma_f32_16x16x32_bf16(Bt[n][k], At[m][k], acc[ai][bj][m][n], 0, 0, 0); } while (0)
#define PG8_MMA(ai, bj, At, Bt) do { __builtin_amdgcn_s_setprio(1); _Pragma("unroll") for (int m = 0; m < 4; ++m) PG8_MF(ai, bj, m, At, Bt); __builtin_amdgcn_s_setprio(0); } while (0)
#define PG8_MMA_CVT(ai, bj, At, Bt, b) do { __builtin_amdgcn_s_setprio(1); _Pragma("unroll") for (int m = 0; m < 4; ++m) { PG8_MF(ai, bj, m, At, Bt); PG8_WRITEB1(b, 2 * m); PG8_WRITEB1(b, 2 * m + 1); PG8_SCHED; } __builtin_amdgcn_s_setprio(0); } while (0)
#define PG8_MMA_LD(ai, bj, At, Bt, pb) do { __builtin_amdgcn_s_setprio(1); _Pragma("unroll") for (int m = 0; m < 4; ++m) { PG8_MF(ai, bj, m, At, Bt); PG8_LOADB1(pb, 2 * m); PG8_LOADB1(pb, 2 * m + 1); PG8_SCHED; } __builtin_amdgcn_s_setprio(0); } while (0)
#define PG8_WAIT_V(n) asm volatile("s_waitcnt vmcnt(" #n ")" ::: "memory")
#define PG8_WAIT_L(n) asm volatile("s_waitcnt lgkmcnt(" #n ")" ::: "memory")
#define PG8_BAR __builtin_amdgcn_s_barrier()
#define PG8_SCHED __builtin_amdgcn_sched_barrier(0)
#define PG8_BS0(T) ((T) >= nt ? nb0 : cur.b0)
#define PG8_BS1(T) ((T) >= nt ? nb1 : cur.b1)
#define PG8_BT(T) ((T) >= nt ? (T) - nt : (T))
    UnitF cur, nxt; int ui = 0;
    if (!S.next(0, cur)) return;
    f32x4 acc[2][2][4][2];
#pragma unroll
    for (int a = 0; a < 2; ++a)
#pragma unroll
        for (int b = 0; b < 2; ++b)
#pragma unroll
            for (int m = 0; m < 4; ++m)
#pragma unroll
                for (int n = 0; n < 2; ++n) acc[a][b][m][n] = (f32x4){0.f, 0.f, 0.f, 0.f};
    bf16x8 At[4][2], B0[2][2], B1[2][2];
    f32x4 dreg[8];
    const char* cA = (const char*)g.A + (size_t)cur.rowA * g.lda * 2;
    PG8_STAGE(PG8_SA(0, 0), cA, voffA); PG8_STAGE(PG8_SA(0, 1), cA + hstepA, voffA); PG8_STAGE(PG8_SA(1, 0), cA + kstep, voffA);
    PG8_LOADB(cur.b0, cur.b1, 0); PG8_WRITEB(0); PG8_LOADB(cur.b0, cur.b1, 1); PG8_WRITEB(1); PG8_LOADB(cur.b0, cur.b1, 2);
    PG8_WAIT_V(8); PG8_WAIT_L(0);
    if (wr == 1) PG8_BAR;
    PG8_BAR;
    for (;;) {
        const bool has_next = S.next(ui + 1, nxt);
        const char* nA = has_next ? (const char*)g.A + (size_t)nxt.rowA * g.lda * 2 : cA;
        const float* nb0 = has_next ? nxt.b0 : cur.b0; const float* nb1 = has_next ? nxt.b1 : cur.b1;
        for (int t = 0; t < nt; t += 2) {
            const bool last = (t == nt - 2);
            const char* a1 = cA + (size_t)(t + 1) * kstep;
            const char* a2 = last ? nA : cA + (size_t)(t + 2) * kstep;
            const char* a3 = a2 + kstep;
            const char* pb3 = PG8_BPTR(PG8_BS0(t + 3), PG8_BS1(t + 3), PG8_BT(t + 3));
            const char* pb4 = PG8_BPTR(PG8_BS0(t + 4), PG8_BS1(t + 4), PG8_BT(t + 4));
            PG8_LDBT(B0, 0, 0); PG8_LDBT(B1, 0, 1); PG8_SCHED; PG8_LDA(At, 0, 0); PG8_STAGE(PG8_SA(1, 1), a1 + hstepA, voffA);
            PG8_WAIT_V(12); PG8_WAIT_L(0); PG8_SCHED; PG8_BAR; PG8_MMA(0, 0, At, B0); PG8_MMA(0, 1, At, B1); PG8_BAR; PG8_SCHED;
            PG8_LDA(At, 0, 1);
            PG8_WAIT_V(10); PG8_WAIT_L(0); PG8_SCHED; PG8_BAR; PG8_MMA_CVT(1, 0, At, B0, 0); PG8_STAGE(PG8_SA(0, 0), a2, voffA); PG8_MMA_LD(1, 1, At, B1, pb3); PG8_BAR; PG8_SCHED;
            PG8_LDBT(B0, 1, 0); PG8_LDBT(B1, 1, 1); PG8_SCHED; PG8_LDA(At, 1, 0); PG8_STAGE(PG8_SA(0, 1), a2 + hstepA, voffA);
            PG8_WAIT_V(12); PG8_WAIT_L(0); PG8_SCHED; PG8_BAR; PG8_MMA(0, 0, At, B0); PG8_MMA(0, 1, At, B1); PG8_BAR; PG8_SCHED;
            PG8_LDA(At, 1, 1);
            PG8_WAIT_V(10); PG8_WAIT_L(0); PG8_SCHED; PG8_BAR; PG8_MMA_CVT(1, 0, At, B0, 1); PG8_STAGE(PG8_SA(1, 0), a3, voffA); PG8_MMA_LD(1, 1, At, B1, pb4); PG8_BAR; PG8_SCHED;
        }
        if (wr == 0) PG8_BAR;
        E(acc, cur, wr, wc, fr, fq);
        if (!has_next) break;
#pragma unroll
        for (int a = 0; a < 2; ++a)
#pragma unroll
            for (int b = 0; b < 2; ++b)
#pragma unroll
                for (int m = 0; m < 4; ++m)
#pragma unroll
                    for (int n = 0; n < 2; ++n) acc[a][b][m][n] = (f32x4){0.f, 0.f, 0.f, 0.f};
        cur = nxt; cA = nA; ++ui;
        if (wr == 1) PG8_BAR;
    }
    PG8_WAIT_V(0);
    asm volatile("" :: "v"(dreg[0]), "v"(dreg[7]));
    PG8_BAR;
#undef PG8_SA
#undef PG8_SB
#undef PG8_STAGE
#undef PG8_LDA
#undef PG8_LDBT
#undef PG8_BPTR
#undef PG8_LOADB1
#undef PG8_LOADB
#undef PG8_WRITEB1
#undef PG8_WRITEB
#undef PG8_MF
#undef PG8_MMA
#undef PG8_MMA_CVT
#undef PG8_MMA_LD
#undef PG8_WAIT_V
#undef PG8_WAIT_L
#undef PG8_BAR
#undef PG8_SCHED
#undef PG8_BS0
#undef PG8_BS1
#undef PG8_BT
}
}

#define XB_TMO      128
#define XB_XCNT(j)  (256  + 64 * (j))
#define XB_XSUB(j)  (1280 + 64 * (j))
#define XB_XGEN(j)  (2304 + 64 * (j))
#define XB_TOP      3328
#define XB_TOPGEN   3392
#define XCD_BAR_WORDS 3456
#define XB_SPIN_CAP (1u << 18)
__device__ __forceinline__ unsigned xb_ld(unsigned* p)              { return __hip_atomic_load(p, __ATOMIC_RELAXED, __HIP_MEMORY_SCOPE_AGENT); }
__device__ __forceinline__ unsigned xb_add(unsigned* p, unsigned v) { return __hip_atomic_fetch_add(p, v, __ATOMIC_RELAXED, __HIP_MEMORY_SCOPE_AGENT); }
__device__ __forceinline__ unsigned xb_xcc_id() { return (unsigned)__builtin_amdgcn_s_getreg((3 << 11) | 20) & 0xFu; }
#define XB_SPIN(cond, bar) do { unsigned _sp = 0; while (cond) { __builtin_amdgcn_s_sleep(1); \
    if ((++_sp & 255u) == 0u) { if (xb_ld(&(bar)[XB_TMO])) break; if (_sp > XB_SPIN_CAP) { atomicAdd(&(bar)[XB_TMO], 1u); break; } } } } while (0)
struct XcdBarrier { unsigned* bar; unsigned x; volatile LAS unsigned* st; };
__device__ __forceinline__ XcdBarrier xcd_barrier_post(unsigned* bar, volatile LAS unsigned* st) {
    XcdBarrier b; b.bar = bar; b.x = xb_xcc_id(); b.st = st;
    if (threadIdx.x == 0) (void)xb_add(&bar[XB_XCNT(b.x)], 1u);
    return b;
}
__device__ __forceinline__ void xcd_barrier_complete(unsigned* bar, unsigned x, unsigned& nloc, unsigned& nx) {
    const unsigned G = gridDim.x * gridDim.y * gridDim.z;
    unsigned sum, cnt, mine, sp = 0u;
    for (;;) {
        sum = 0u; cnt = 0u; mine = 0u;
#pragma unroll
        for (unsigned j = 0; j < 16; ++j) { const unsigned c = xb_ld(&bar[XB_XCNT(j)]); sum += c; cnt += (c > 0u) ? 1u : 0u; mine = (j == x) ? c : mine; }
        if (sum == G) break;
        __builtin_amdgcn_s_sleep(1);
        if ((++sp & 255u) == 0u) { if (xb_ld(&bar[XB_TMO])) break; if (sp > XB_SPIN_CAP) { atomicAdd(&bar[XB_TMO], 1u); break; } }
    }
    nloc = mine > 0u ? mine : 1u; nx = cnt > 0u ? cnt : 1u;
}
__device__ __forceinline__ void xcd_barrier(const XcdBarrier& b) {
    asm volatile("s_waitcnt vmcnt(0)" ::: "memory");
    __syncthreads();
    if (threadIdx.x == 0) {
        unsigned* bar = b.bar;
        __builtin_amdgcn_s_waitcnt(0);
        unsigned nloc = b.st[0], nx = b.st[1];
        if (nloc == 0u) { xcd_barrier_complete(bar, b.x, nloc, nx); b.st[0] = nloc; b.st[1] = nx; }
        const unsigned old = xb_add(&bar[XB_XSUB(b.x)], 1u);
        const unsigned gen = old / nloc;
        if (old + 1u == (gen + 1u) * nloc) {
            __builtin_amdgcn_fence(__ATOMIC_RELEASE, "agent");
            asm volatile("s_waitcnt vmcnt(0)" ::: "memory");
            const unsigned og = xb_add(&bar[XB_TOP], 1u);
            const unsigned tg = og / nx;
            if (og + 1u == (tg + 1u) * nx) xb_add(&bar[XB_TOPGEN], 1u);
            else XB_SPIN(xb_ld(&bar[XB_TOPGEN]) == tg, bar);
            __builtin_amdgcn_fence(__ATOMIC_ACQUIRE, "agent");
            xb_add(&bar[XB_XGEN(b.x)], 1u);
            asm volatile("s_waitcnt vmcnt(0)" ::: "memory");
        } else {
            XB_SPIN(xb_ld(&bar[XB_XGEN(b.x)]) == gen, bar);
            __builtin_amdgcn_fence(__ATOMIC_ACQUIRE, "agent");
            asm volatile("s_waitcnt vmcnt(0)" ::: "memory");
        }
    }
    __syncthreads();
}

struct Args { const float* in[31]; float* out; unsigned char* ws; int ph_lo, ph_hi; };
enum { I_X = 0, I_NMG, I_WIN, I_MU, I_W0, I_W2, I_A0, I_A2, I_G2, I_KK, I_KA, I_RK, I_LNG, I_LNB, I_GWA2, I_GBA, I_GNG, I_BM, I_WBR, I_WBG, I_WOUT, I_NFG,
       I_WROUTER, I_BROUTER, I_WGATE, I_BGATE, I_WUP, I_BUP, I_WDOWN, I_BDOWN, I_NFINAL };
struct Frame {
    LAS unsigned char* lds; unsigned char* ws; unsigned* ctl;
    int tid, lane, wave, vcu, G;
};

__device__ __forceinline__ void tr_item(const float* W, int ldw, int nvalid, int k0, int n0, bf16* dst, int ldk, LAS float* scr, int lane) {
    const int c = lane & 31;
    const bool ok = (n0 + c) < nvalid;
#pragma unroll 8
    for (int i = 0; i < 32; ++i) { const int kk = 2 * i + (lane >> 5); scr[kk * 33 + c] = ok ? W[(size_t)(k0 + kk) * ldw + n0 + c] : 0.f; }
    LDS_WAIT(); asm volatile("" ::: "memory");
    const int c8 = lane & 7;
#pragma unroll
    for (int j = 0; j < 4; ++j) { const int n = (lane >> 3) + 8 * j; const LAS float* s = scr + (8 * c8) * 33 + n;
        v4u o; o.x = pk2(s[0 * 33], s[1 * 33]); o.y = pk2(s[2 * 33], s[3 * 33]); o.z = pk2(s[4 * 33], s[5 * 33]); o.w = pk2(s[6 * 33], s[7 * 33]);
        *(v4u*)(dst + (size_t)n * ldk + k0 + 8 * c8) = o; }
    LDS_WAIT(); asm volatile("" ::: "memory");
}
__device__ __forceinline__ void cv_load(const float* W, int ldw, int k0, int n0, int lane, f32x4 (&cr)[16]) {
    const unsigned laneoff = (unsigned)((lane >> 3) * ldw + n0 + 4 * (lane & 7)) * 4u;
#pragma unroll
    for (int i = 0; i < 16; ++i) { const char* rowp = (const char*)W + (size_t)(k0 + 8 * i) * ldw * 4; cr[i] = *(const f32x4*)(rowp + laneoff); }
}
__device__ __forceinline__ void cv_finish(const f32x4 (&cr)[16], int k0, unsigned char* dst, int ldk, LAS float* scr, int lane, float scale) {
    const int rr = lane >> 3, ch = lane & 7;
#pragma unroll
    for (int i = 0; i < 16; ++i) { LAS float* d = scr + (8 * i + rr) * 33 + 4 * ch; d[0] = cr[i].x * scale; d[1] = cr[i].y * scale; d[2] = cr[i].z * scale; d[3] = cr[i].w * scale; }
    LDS_WAIT(); asm volatile("" ::: "memory");
#pragma unroll
    for (int j = 0; j < 4; ++j) { const int n = rr + 8 * j; const LAS float* sp = scr + (16 * ch) * 33 + n;
        v4u o; o.x = pk4_fp8(sp[0 * 33], sp[1 * 33], sp[2 * 33], sp[3 * 33]); o.y = pk4_fp8(sp[4 * 33], sp[5 * 33], sp[6 * 33], sp[7 * 33]);
        o.z = pk4_fp8(sp[8 * 33], sp[9 * 33], sp[10 * 33], sp[11 * 33]); o.w = pk4_fp8(sp[12 * 33], sp[13 * 33], sp[14 * 33], sp[15 * 33]);
        *(v4u*)(dst + (size_t)n * ldk + k0 + 16 * ch) = o; }
    LDS_WAIT(); asm volatile("" ::: "memory");
}
__device__ __forceinline__ void cv_issue_dma(const float* W, int ldw, int k0, int n0, int lane, LAS float* scr) {
#pragma unroll
    for (int i = 0; i < 16; ++i) { const char* rowp = (const char*)W + (size_t)(k0 + 8 * i) * ldw * 4;
        const unsigned off = (unsigned)((lane >> 3) * ldw + n0 + 4 * ((lane & 7) ^ (i >> 1))) * 4u;
        __builtin_amdgcn_global_load_lds((const unsigned*)(rowp + off), (LAS unsigned*)(scr + i * 256), 16, 0, 2); }
}
__device__ __forceinline__ void cv_finish_dma(int k0, unsigned char* dst, int ldk, const LAS float* scr, int lane, float scale) {
    const int rr = lane >> 3, ch = lane & 7;
#pragma unroll
    for (int j = 0; j < 4; ++j) { const int n = rr + 8 * j; const LAS float* sp = scr + (16 * ch) * 32 + ((((n >> 2) ^ ch) << 2) | (n & 3));
        float f[16];
#pragma unroll
        for (int i = 0; i < 16; ++i) f[i] = sp[i * 32] * scale;
        v4u o; o.x = pk4_fp8(f[0], f[1], f[2], f[3]); o.y = pk4_fp8(f[4], f[5], f[6], f[7]); o.z = pk4_fp8(f[8], f[9], f[10], f[11]); o.w = pk4_fp8(f[12], f[13], f[14], f[15]);
        *(v4u*)(dst + (size_t)n * ldk + k0 + 16 * ch) = o; }
}
__device__ __forceinline__ void cvb_finish_dma(int k0, bf16* dst, int ldk, const LAS float* scr, int lane) {
    const int rr = lane >> 3, ch = lane & 7;
#pragma unroll
    for (int j = 0; j < 4; ++j) { const int n = rr + 8 * j; const LAS float* sp = scr + (16 * ch) * 32 + ((((n >> 2) ^ ch) << 2) | (n & 3));
        float f[16];
#pragma unroll
        for (int i = 0; i < 16; ++i) f[i] = sp[i * 32];
        v4u o0, o1; o0.x = pk2(f[0], f[1]); o0.y = pk2(f[2], f[3]); o0.z = pk2(f[4], f[5]); o0.w = pk2(f[6], f[7]); o1.x = pk2(f[8], f[9]); o1.y = pk2(f[10], f[11]); o1.z = pk2(f[12], f[13]); o1.w = pk2(f[14], f[15]);
        bf16* d = dst + (size_t)n * ldk + k0 + 16 * ch; *(v4u*)d = o0; *(v4u*)(d + 8) = o1; }
}
__device__ __forceinline__ void cvr_load(const float* W, int ldw, int k0, int n0, int lane, f32x4 (&cr)[16]) {
    const unsigned laneoff = (unsigned)((16 * (lane >> 3)) * ldw + n0 + 4 * (lane & 7)) * 4u;
#pragma unroll
    for (int i = 0; i < 16; ++i) { const char* rowp = (const char*)W + (size_t)(k0 + i) * ldw * 4; cr[i] = __builtin_nontemporal_load((const f32x4*)(rowp + laneoff)); }
}
__device__ __forceinline__ void cvr_store(const f32x4 (&cr)[16], int k0, unsigned char* dst, int ldk, int lane, float scale) {
    unsigned char* d = dst + (size_t)(4 * (lane & 7)) * ldk + k0 + 16 * (lane >> 3);
#pragma unroll
    for (int j = 0; j < 4; ++j) { v4u o;
        o.x = pk4_fp8(cr[0][j] * scale, cr[1][j] * scale, cr[2][j] * scale, cr[3][j] * scale); o.y = pk4_fp8(cr[4][j] * scale, cr[5][j] * scale, cr[6][j] * scale, cr[7][j] * scale);
        o.z = pk4_fp8(cr[8][j] * scale, cr[9][j] * scale, cr[10][j] * scale, cr[11][j] * scale); o.w = pk4_fp8(cr[12][j] * scale, cr[13][j] * scale, cr[14][j] * scale, cr[15][j] * scale);
        __builtin_nontemporal_store(o, (v4u*)(d + (size_t)j * ldk)); }
}
struct CvItem { const float* W; unsigned char* dst; int ldw, ldk, k0, n0; };
__device__ __forceinline__ CvItem cv_item(const Args& a, unsigned char* ws, int idx) {
    constexpr int I_EXP = (D / 128) * (FF / 32);
    int r = idx; const int mat = r / (NE * I_EXP); r -= mat * (NE * I_EXP); const int e = r / I_EXP; r -= e * I_EXP;
    const int kb = r / (FF / 32), nb = r % (FF / 32), n0 = 32 * nb;
    CvItem it; it.k0 = 128 * kb; it.n0 = n0;
    if (mat == 0) { it.W = a.in[I_WGATE] + (size_t)e * D * FF; it.ldw = FF; it.dst = ws + WS_WGU + ((size_t)e * 4096 + (n0 >> 7) * 256 + (n0 & 127)) * D; it.ldk = D; }
    else if (mat == 1) { it.W = a.in[I_WUP] + (size_t)e * D * FF; it.ldw = FF; it.dst = ws + WS_WGU + ((size_t)e * 4096 + (n0 >> 7) * 256 + 128 + (n0 & 127)) * D; it.ldk = D; }
    else { it.W = a.in[I_WDOWN] + (size_t)e * FF * D; it.ldw = D; it.dst = ws + WS_WD + ((size_t)e * 2048 + n0) * FF; it.ldk = FF; }
    return it;
}
constexpr int CV_ITEMS = 3 * NE * (D / 128) * (FF / 32);
constexpr int CVQ_CH = 4, CVQ_NCH = CV_ITEMS / CVQ_CH;
__device__ __forceinline__ unsigned cvq_issue(unsigned* q, int lane) { unsigned c = 0; if (lane == 0) c = __hip_atomic_fetch_add(q, 1u, RLX_AGENT); return c; }
__device__ __forceinline__ void rms_row_to_bf16(const float* xrow, const float* g, bf16* orow, int lane) {
    const f32x4* xr = (const f32x4*)xrow + lane; const f32x4* gr = (const f32x4*)g + lane;
    f32x4 v[8]; float s = 0.f;
#pragma unroll
    for (int j = 0; j < 8; ++j) { v[j] = __builtin_nontemporal_load(xr + 64 * j); s += (v[j].x * v[j].x + v[j].y * v[j].y) + (v[j].z * v[j].z + v[j].w * v[j].w); }
    const float rstd = rsqrtf(wave_sum(s) * (1.f / D) + NORM_EPS);
    v2u* o8 = (v2u*)orow + lane;
#pragma unroll
    for (int j = 0; j < 8; ++j) { const f32x4 gg = gr[64 * j]; v2u o; o.x = pk2(v[j].x * rstd * gg.x, v[j].y * rstd * gg.y); o.y = pk2(v[j].z * rstd * gg.z, v[j].w * rstd * gg.w); o8[64 * j] = o; }
}
__device__ __forceinline__ void p0_prologue(const Frame& F, const Args& a) {
    LAS float* scr = (LAS float*)(F.lds + F.wave * 16896);
    const int gw = F.vcu * 8 + F.wave, NGW = F.G * 8;
    bf16* Wt_in = (bf16*)(F.ws + WS_WIN); bf16* Wt_ba = (bf16*)(F.ws + WS_WBA); bf16* Wt_bb = (bf16*)(F.ws + WS_WBB); bf16* Wt_out = (bf16*)(F.ws + WS_WOUT);
    constexpr int NB_IN = PLD / 32;
    constexpr int I_IN = (D / 64) * NB_IN, I_BA = (RW / 64) * (D / 32), I_BB = I_BA, I_OUT = (D / 64) * (D / 32);
    constexpr int NITEMS = I_IN + I_BA + I_BB + I_OUT;
    {
        constexpr int NBF = IN_COLS / 32;
        constexpr int J_IN = (D / 128) * NBF, J_BA = (RW / 128) * (D / 32), J_BB = J_BA, J_OUT = (D / 128) * (D / 32), NJ = J_IN + J_BA + J_BB + J_OUT;
        LAS float* t2 = (LAS float*)(F.lds + F.wave * 16384);
        for (int it = gw; it < NJ; it += NGW) {
            const float* W = nullptr; int ldw = 0, k0 = 0, n0 = 0, ldk = 0; bf16* dst = nullptr; int r = it;
            if (r < J_IN) { const int kb = r / NBF, nb = r % NBF; W = a.in[I_WIN]; ldw = IN_COLS; k0 = 128 * kb; n0 = 32 * nb; dst = Wt_in + (size_t)n0 * DP; ldk = DP; }
            else if ((r -= J_IN) < J_BA) { const int kb = r / (D / 32), nb = r % (D / 32); W = a.in[I_WBR]; ldw = D; k0 = 128 * kb; n0 = 32 * nb; dst = Wt_ba + (size_t)n0 * RW; ldk = RW; }
            else if ((r -= J_BA) < J_BB) { const int kb = r / (D / 32), nb = r % (D / 32); W = a.in[I_WBG]; ldw = D; k0 = 128 * kb; n0 = 32 * nb; dst = Wt_bb + (size_t)n0 * GVW; ldk = GVW; }
            else { r -= J_BB; const int kb = r / (D / 32), nb = r % (D / 32); W = a.in[I_WOUT]; ldw = D; k0 = 128 * kb; n0 = 32 * nb; dst = Wt_out + (size_t)n0 * D; ldk = D; }
            cv_issue_dma(W, ldw, k0, n0, F.lane, t2);
            asm volatile("s_waitcnt vmcnt(0)" ::: "memory");
            cvb_finish_dma(k0, dst, ldk, t2, F.lane); asm volatile("s_waitcnt lgkmcnt(0)" ::: "memory");
        }
        __syncthreads();
        for (int it = gw; it < (D / 64) * 2; it += NGW) { const int kb = it >> 1, nb = NBF + (it & 1); tr_item(a.in[I_WIN], IN_COLS, IN_COLS, 64 * kb, 32 * nb, Wt_in + (size_t)(32 * nb) * DP, DP, scr, F.lane); }
    }
    bf16* Hh = (bf16*)(F.ws + WS_H);
    for (int m = gw; m < T; m += NGW) rms_row_to_bf16(a.in[I_X] + (size_t)m * D, a.in[I_NMG], Hh + (size_t)m * DP, F.lane);
    const int gt = F.vcu * 512 + F.tid, NGT = F.G * 512;
    bf16* Wl_wa = (bf16*)(F.ws + WS_WLWA); bf16* Wl_g = (bf16*)(F.ws + WS_WLG);
    for (int i = gt; i < 2048 * 256; i += NGT) { const int n = i >> 8, k = i & 255; float v = 0.f;
        if (n < 1024) { if (k < DLORA) v = a.in[I_W2][(size_t)k * RW + n]; } else { if (k >= DLORA && k < 2 * DLORA) v = a.in[I_A2][(size_t)(k - DLORA) * RW + (n - 1024)]; }
        Wl_wa[i] = (bf16)f2bf(v); }
    for (int i = gt; i < 1024 * 256; i += NGT) { const int n = i >> 8, k = i & 255; Wl_g[i] = (bf16)f2bf(a.in[I_G2][(size_t)k * RW + n]); }
    float* Wr = (float*)(F.ws + WS_WR);
    for (int i = gt; i < 8 * 32 * 64 * 4; i += NGT) { const int ii = i & 3, l = (i >> 2) & 63, e = (i >> 8) & 31, j = i >> 13; const int k = 256 * j + 4 * l + ii;
        Wr[i] = a.in[I_NFG][k] * a.in[I_WROUTER][(size_t)k * NE + e]; }
}

__device__ __forceinline__ void cv_queue_run(const Frame& F, const Args& a, unsigned* stop) {
    unsigned* q = F.ctl + CW_CVQ; const int lane = F.lane;
    f32x4 ca[16], cb[16];
    int cur = __builtin_amdgcn_readfirstlane((int)cvq_issue(q, lane)); unsigned nraw = cvq_issue(q, lane); int pos = 0; bool stopped = false;
#define CVQ_NEXT(idx) do { if (pos == CVQ_CH) { cur = __builtin_amdgcn_readfirstlane((int)nraw); pos = 0; \
        if (stop && !stopped && __hip_atomic_load(stop, RLX_AGENT) != 0u) stopped = true; \
        nraw = stopped ? 0x7fffffffu : cvq_issue(q, lane); } \
        idx = cur < CVQ_NCH ? cur * CVQ_CH + pos++ : -1; } while (0)
    int xa, xb; CvItem ia, ib;
    CVQ_NEXT(xa); if (xa < 0) return;
    ia = cv_item(a, F.ws, xa); cvr_load(ia.W, ia.ldw, ia.k0, ia.n0, lane, ca);
    CVQ_NEXT(xb); ib = ia; if (xb >= 0) { ib = cv_item(a, F.ws, xb); cvr_load(ib.W, ib.ldw, ib.k0, ib.n0, lane, cb); }
    while (xa >= 0) {
        cvr_store(ca, ia.k0, ia.dst, ia.ldk, lane, WQ_SCALE);
        xa = -1; if (xb >= 0) { CVQ_NEXT(xa); if (xa >= 0) { ia = cv_item(a, F.ws, xa); cvr_load(ia.W, ia.ldw, ia.k0, ia.n0, lane, ca); } }
        if (xb >= 0) { cvr_store(cb, ib.k0, ib.dst, ib.ldk, lane, WQ_SCALE);
            xb = -1; if (xa >= 0) { CVQ_NEXT(xb); if (xb >= 0) { ib = cv_item(a, F.ws, xb); cvr_load(ib.W, ib.ldw, ib.k0, ib.n0, lane, cb); } } }
    }
#undef CVQ_NEXT
}
constexpr int CVW_SH = 3;
__device__ __forceinline__ void p1_gemm_in(const Frame& F, const Args& a) {
    const bool split = (F.G == 256);
    const int bx = (int)blockIdx.x, grp = bx >> 3;
    if (split && (grp & ((1 << CVW_SH) - 1)) == (1 << CVW_SH) - 1) { cv_queue_run(F, a, F.ctl + CW_CVSTOP); return; }
    pg8::Gemm g{(const bf16*)(F.ws + WS_H), (const bf16*)(F.ws + WS_WIN), DP, DP, D, nullptr}; pg8::StaticOrder S;
    if (split) S.init(T, PLD, 256 - (256 >> CVW_SH), (grp - (grp >> CVW_SH)) * 8 + (bx & 7)); else S.init(T, PLD, F.G, bx);
    pg8::EpiBf16 E{(bf16*)(F.ws + WS_P), PLD, nullptr, 0, 1.f};
    pg8::gemm_phase(F.lds, g, S, E);
    if (F.tid == 0) __hip_atomic_fetch_add(F.ctl + CW_CVSTOP, 1u, RLX_AGENT);
}
__device__ __forceinline__ void p2_lora_in(const Frame& F, const Args& a) {
    const int gw = F.vcu * 8 + F.wave, NGW = F.G * 8, lane = F.lane;
    const bf16* P = (const bf16*)(F.ws + WS_P); bf16* A2 = (bf16*)(F.ws + WS_A2);
    const int kind = lane < 12 ? 0 : (lane < 24 ? 1 : (lane < 32 ? 2 : 3));
    const int src = lane < 24 ? (C_WL + 8 * lane) : (C_GL + 8 * (lane - 32));
    float mu[8];
    if (kind != 2) {
#pragma unroll
        for (int j = 0; j < 8; ++j) mu[j] = a.in[I_MU][src + j];
    }
    for (int t = gw; t < T; t += NGW) {
        v4u o = {0u, 0u, 0u, 0u};
        if (kind != 2) {
            const v4u c = *(const v4u*)(P + (size_t)t * PLD + src);
            v4u pv = {0u, 0u, 0u, 0u};
            if ((t & (SEQ - 1)) != 0) pv = *(const v4u*)(P + (size_t)(t - 1) * PLD + src);
            float x[8] = {bflo(c.x), bfhi(c.x), bflo(c.y), bfhi(c.y), bflo(c.z), bfhi(c.z), bflo(c.w), bfhi(c.w)};
            float q[8] = {bflo(pv.x), bfhi(pv.x), bflo(pv.y), bfhi(pv.y), bflo(pv.z), bfhi(pv.z), bflo(pv.w), bfhi(pv.w)};
#pragma unroll
            for (int j = 0; j < 8; ++j) { float m = x[j] + (q[j] - x[j]) * mu[j]; x[j] = kind == 0 ? tanhf(m) : (kind == 1 ? m : sigmoidf_(m)); }
            o.x = pk2(x[0], x[1]); o.y = pk2(x[2], x[3]); o.z = pk2(x[4], x[5]); o.w = pk2(x[6], x[7]);
        }
        *(v4u*)(A2 + (size_t)t * 512 + 8 * lane) = o;
    }
}

#define DPPF(x, ctrl) __builtin_bit_cast(float, __builtin_amdgcn_update_dpp(0, __builtin_bit_cast(int, (x)), (ctrl), 0xF, 0xF, false))
__device__ __forceinline__ float dpp_sum16(float x) { x += DPPF(x, 0xB1); x += DPPF(x, 0x4E); x += DPPF(x, 0x141); x += DPPF(x, 0x140); return x; }
__device__ __forceinline__ float wave_sum_dpp(float x) {
    x = dpp_sum16(x); const int xi = __builtin_bit_cast(int, x);
    return (__builtin_bit_cast(float, __builtin_amdgcn_readlane(xi, 0)) + __builtin_bit_cast(float, __builtin_amdgcn_readlane(xi, 16))) +
           (__builtin_bit_cast(float, __builtin_amdgcn_readlane(xi, 32)) + __builtin_bit_cast(float, __builtin_amdgcn_readlane(xi, 48)));
}
__device__ __forceinline__ float quad_sum(float x) { x += DPPF(x, 0xB1); x += DPPF(x, 0x4E); return x; }
__device__ __forceinline__ void unpack8(const v4u u, float (&f)[8]) { f[0] = bflo(u.x); f[1] = bfhi(u.x); f[2] = bflo(u.y); f[3] = bfhi(u.y); f[4] = bflo(u.z); f[5] = bfhi(u.z); f[6] = bflo(u.w); f[7] = bfhi(u.w); }
__device__ __forceinline__ v4u pack8(const float (&f)[8]) { v4u u; u.x = pk2(f[0], f[1]); u.y = pk2(f[2], f[3]); u.z = pk2(f[4], f[5]); u.w = pk2(f[6], f[7]); return u; }
__device__ __forceinline__ void p4_rwkv_prep(const Frame& F, const Args& a) {
    const int gw = F.vcu * 8 + F.wave, NGW = F.G * 8, lane = F.lane;
    const bf16* P = (const bf16*)(F.ws + WS_P); const bf16* WA = (const bf16*)(F.ws + WS_WAO); bf16* SC = (bf16*)(F.ws + WS_SCAN); float* BON = (float*)(F.ws + WS_BON);
    const int h = lane >> 2, q = lane & 3, c0 = h * RN + 16 * q;
    for (int t = gw; t < T; t += NGW) {
        const bool first = (t & (SEQ - 1)) == 0;
        const bf16* pr = P + (size_t)t * PLD + c0; const bf16* pp = first ? pr : pr - PLD;
        v4u ur[2], uk[2], uv[2], ur1[2], uk1[2], uv1[2], uw[2], ua[2];
#pragma unroll
        for (int j = 0; j < 2; ++j) { ur[j] = *(const v4u*)(pr + C_R + 8 * j); uk[j] = *(const v4u*)(pr + C_K + 8 * j); uv[j] = *(const v4u*)(pr + C_V + 8 * j);
            ur1[j] = *(const v4u*)(pp + C_R + 8 * j); uk1[j] = *(const v4u*)(pp + C_K + 8 * j); uv1[j] = *(const v4u*)(pp + C_V + 8 * j);
            uw[j] = __builtin_nontemporal_load((const v4u*)(WA + (size_t)t * 2048 + c0 + 8 * j)); ua[j] = __builtin_nontemporal_load((const v4u*)(WA + (size_t)t * 2048 + 1024 + c0 + 8 * j)); }
        float r[2][8], k[2][8], v[2][8], kk[2][8], dec[2][8], aa[2][8];
        float n2 = 0.f;
#pragma unroll
        for (int j = 0; j < 2; ++j) { float x[8], x1[8], wv[8], av[8];
            unpack8(ur[j], x); unpack8(ur1[j], x1);
#pragma unroll
            for (int i = 0; i < 8; ++i) { const float m = a.in[I_MU][C_R + c0 + 8 * j + i]; r[j][i] = x[i] + ((first ? 0.f : x1[i]) - x[i]) * m; }
            unpack8(uk[j], x); unpack8(uk1[j], x1);
#pragma unroll
            for (int i = 0; i < 8; ++i) { const float m = a.in[I_MU][C_K + c0 + 8 * j + i]; k[j][i] = x[i] + ((first ? 0.f : x1[i]) - x[i]) * m; }
            unpack8(uv[j], x); unpack8(uv1[j], x1);
#pragma unroll
            for (int i = 0; i < 8; ++i) { const float m = a.in[I_MU][C_V + c0 + 8 * j + i]; v[j][i] = x[i] + ((first ? 0.f : x1[i]) - x[i]) * m; }
            unpack8(uw[j], wv); unpack8(ua[j], av);
#pragma unroll
            for (int i = 0; i < 8; ++i) { const int c = c0 + 8 * j + i;
                dec[j][i] = __expf(-0.60653066f * sigmoidf_(a.in[I_W0][c] + wv[i]));
                aa[j][i] = sigmoidf_(a.in[I_A0][c] + av[i]);
                const float kq = k[j][i] * a.in[I_KK][c]; kk[j][i] = kq; n2 += kq * kq; } }
        n2 = quad_sum(n2);
        const float inv = rsqrtf(fmaxf(n2, 1e-24f));
        float bon = 0.f; float o0[2][8], o2[2][8], o3[2][8];
#pragma unroll
        for (int j = 0; j < 2; ++j)
#pragma unroll
            for (int i = 0; i < 8; ++i) { const int c = c0 + 8 * j + i; const float kn = kk[j][i] * inv; const float kf = k[j][i] * (1.f + (aa[j][i] - 1.f) * a.in[I_KA][c]);
                o0[j][i] = -kn; o2[j][i] = kn * aa[j][i]; o3[j][i] = kf; bon += r[j][i] * kf * a.in[I_RK][c]; }
        bon = quad_sum(bon);
        const int bh = (t >> 11) * RH + h, ts = t & (SEQ - 1);
        bf16* o = SC + ((size_t)(bh * SEQ + ts) * 6) * 64 + 16 * q;
#pragma unroll
        for (int j = 0; j < 2; ++j) { *(v4u*)(o + 8 * j) = pack8(o0[j]); *(v4u*)(o + 64 + 8 * j) = pack8(dec[j]); *(v4u*)(o + 128 + 8 * j) = pack8(o2[j]);
            *(v4u*)(o + 192 + 8 * j) = pack8(o3[j]); *(v4u*)(o + 256 + 8 * j) = pack8(r[j]); *(v4u*)(o + 320 + 8 * j) = pack8(v[j]); }
        if (q == 0) BON[(size_t)t * RH + h] = bon;
    }
}
__device__ __forceinline__ void p5_rwkv_scan(const Frame& F, const Args& a) {
    constexpr int TB = 16, NBLK = SEQ / TB, STF = 384, BLKF = TB * STF;
    const bf16* SC = (const bf16*)(F.ws + WS_SCAN); float* YR = (float*)(F.ws + WS_YRAW);
    LAS float* buf = (LAS float*)F.lds;
    volatile LAS int* hs = (volatile LAS int*)(F.lds + MOE_OFF + 2048);
    const int lane = F.lane;
    for (int u = F.vcu; u < 256; u += F.G) {
        const int bh = u >> 2, vg = u & 3, b = bh >> 4, h = bh & 15;
        const int role = F.wave < 4 ? 0 : (F.wave == 4 ? 1 : 2);
        const int cw = F.wave - 5;
        const bf16* src = SC + (size_t)bh * SEQ * STF;
        const int rl = lane >> 4, kq = lane & 15, row = 16 * vg + 4 * F.wave + rl;
        __syncthreads();
        if (F.tid < 8) hs[F.tid] = 0;
        __syncthreads();
#define HS_WAIT(cond) do { unsigned sp_ = 0; while (!(cond)) { __builtin_amdgcn_s_sleep(1); if (++sp_ > (1u << 24)) break; } asm volatile("" ::: "memory"); } while (0)
        if (role == 1) {
            v4u xb[12];
            { const v4u* s4 = (const v4u*)src;
#pragma unroll
              for (int i = 0; i < 12; ++i) xb[i] = s4[lane + 64 * i]; }
            for (int m = 0; m < NBLK; ++m) {
                if (m >= 4) HS_WAIT(hs[1] >= m - 3 && hs[2] >= m - 3 && hs[3] >= m - 3 && hs[4] >= m - 3);
                LAS f32x4* d4 = (LAS f32x4*)(buf + (m & 3) * BLKF);
#pragma unroll
                for (int i = 0; i < 12; ++i) { const int c = lane + 64 * i;
                    d4[2 * c] = (f32x4){bflo(xb[i].x), bfhi(xb[i].x), bflo(xb[i].y), bfhi(xb[i].y)}; d4[2 * c + 1] = (f32x4){bflo(xb[i].z), bfhi(xb[i].z), bflo(xb[i].w), bfhi(xb[i].w)}; }
                asm volatile("s_waitcnt lgkmcnt(0)" ::: "memory");
                if (lane == 0) hs[0] = m + 1;
                if (m + 1 < NBLK) { const v4u* s4 = (const v4u*)(src + (size_t)(m + 1) * BLKF);
#pragma unroll
                    for (int i = 0; i < 12; ++i) xb[i] = s4[lane + 64 * i]; }
            }
        } else if (role == 2) {
            cv_queue_run(F, a, nullptr);
        } else {
            float S0 = 0.f, S1 = 0.f, S2 = 0.f, S3 = 0.f;
            for (int n = 0; n < NBLK; ++n) {
                HS_WAIT(hs[0] >= n + 1);
                const LAS float* bb = buf + (n & 3) * BLKF;
                float* yo = YR + ((size_t)(b * SEQ + n * TB)) * RW + h * RN + row;
                f32x4 al = *(const LAS f32x4*)(bb + 4 * kq), w = *(const LAS f32x4*)(bb + 64 + 4 * kq), be = *(const LAS f32x4*)(bb + 128 + 4 * kq);
                f32x4 kf = *(const LAS f32x4*)(bb + 192 + 4 * kq), r = *(const LAS f32x4*)(bb + 256 + 4 * kq); float vv = bb[320 + row];
                float ykeep = 0.f, yp = 0.f;
#pragma unroll
                for (int j = 0; j < TB; ++j) {
                    f32x4 al_n = al, w_n = w, be_n = be, kf_n = kf, r_n = r; float vv_n = vv;
                    if (j + 1 < TB) { const LAS float* st = bb + (j + 1) * STF;
                        al_n = *(const LAS f32x4*)(st + 4 * kq); w_n = *(const LAS f32x4*)(st + 64 + 4 * kq); be_n = *(const LAS f32x4*)(st + 128 + 4 * kq);
                        kf_n = *(const LAS f32x4*)(st + 192 + 4 * kq); r_n = *(const LAS f32x4*)(st + 256 + 4 * kq); vv_n = st[320 + row]; }
                    float sa = (S0 * al.x + S1 * al.y) + (S2 * al.z + S3 * al.w);
                    float yq = yp;
                    sa += DPPF(sa, 0xB1); if (j > 0) yq += DPPF(yq, 0xB1);
                    sa += DPPF(sa, 0x4E); if (j > 0) yq += DPPF(yq, 0x4E);
                    sa += DPPF(sa, 0x141); if (j > 0) yq += DPPF(yq, 0x141);
                    sa += DPPF(sa, 0x140); if (j > 0) yq += DPPF(yq, 0x140);
                    if (j > 0) ykeep = __builtin_bit_cast(float, __builtin_amdgcn_update_dpp(__builtin_bit_cast(int, yq), __builtin_bit_cast(int, ykeep), 0x111, 0xF, 0xF, false));
                    S0 = S0 * w.x + (sa * be.x + vv * kf.x); S1 = S1 * w.y + (sa * be.y + vv * kf.y);
                    S2 = S2 * w.z + (sa * be.z + vv * kf.z); S3 = S3 * w.w + (sa * be.w + vv * kf.w);
                    yp = (S0 * r.x + S1 * r.y) + (S2 * r.z + S3 * r.w);
                    al = al_n; w = w_n; be = be_n; kf = kf_n; r = r_n; vv = vv_n;
                }
                const float yl = dpp_sum16(yp);
                ykeep = __builtin_bit_cast(float, __builtin_amdgcn_update_dpp(__builtin_bit_cast(int, yl), __builtin_bit_cast(int, ykeep), 0x111, 0xF, 0xF, false));
                yo[(size_t)(TB - 1 - kq) * RW] = ykeep;
                asm volatile("s_waitcnt lgkmcnt(0)" ::: "memory");
                if (lane == 0) hs[1 + F.wave] = n + 1;
            }
            __builtin_amdgcn_s_setprio(0);
        }
#undef HS_WAIT
        __syncthreads();
    }
    if (F.G != 256) { LAS float* scr = (LAS float*)(F.lds + F.wave * 16896); __syncthreads();
        for (int it = F.vcu * 8 + F.wave; it < CV_ITEMS; it += F.G * 8) { const CvItem c2 = cv_item(a, F.ws, it); f32x4 c3[16]; cv_load(c2.W, c2.ldw, c2.k0, c2.n0, lane, c3); cv_finish(c3, c2.k0, c2.dst, c2.ldk, scr, lane, WQ_SCALE); } }
}

__device__ __forceinline__ void p6_rwkv_post(const Frame& F, const Args& a) {
    const int gw = F.vcu * 8 + F.wave, NGW = F.G * 8, lane = F.lane;
    const bf16* SC = (const bf16*)(F.ws + WS_SCAN); const float* YR = (const float*)(F.ws + WS_YRAW); const float* BON = (const float*)(F.ws + WS_BON);
    const bf16* GO = (const bf16*)(F.ws + WS_GO); bf16* YA = (bf16*)(F.ws + WS_YA);
    const int h = lane >> 2, q = lane & 3, c0 = h * RN + 16 * q;
    f32x4 lg[4], lb[4];
#pragma unroll
    for (int j = 0; j < 4; ++j) { lg[j] = *(const f32x4*)(a.in[I_LNG] + c0 + 4 * j); lb[j] = *(const f32x4*)(a.in[I_LNB] + c0 + 4 * j); }
    for (int t = gw; t < T; t += NGW) {
        const int bh = (t >> 11) * RH + h, ts = t & (SEQ - 1);
        f32x4 y[4]; v4u uv[2], ug[2];
#pragma unroll
        for (int j = 0; j < 4; ++j) y[j] = __builtin_nontemporal_load((const f32x4*)(YR + (size_t)t * RW + c0 + 4 * j));
#pragma unroll
        for (int j = 0; j < 2; ++j) { uv[j] = *(const v4u*)(SC + ((size_t)(bh * SEQ + ts) * 6 + 5) * 64 + 16 * q + 8 * j); ug[j] = *(const v4u*)(GO + (size_t)t * RW + c0 + 8 * j); }
        const float bo = BON[(size_t)t * RH + h];
        float s = 0.f;
#pragma unroll
        for (int j = 0; j < 4; ++j) s += (y[j].x + y[j].y) + (y[j].z + y[j].w);
        const float mean = quad_sum(s) * (1.f / RN);
        float s2 = 0.f;
#pragma unroll
        for (int j = 0; j < 4; ++j) { y[j] = y[j] - mean; s2 += (y[j].x * y[j].x + y[j].y * y[j].y) + (y[j].z * y[j].z + y[j].w * y[j].w); }
        const float rstd = rsqrtf(quad_sum(s2) * (1.f / RN) + GN_EPS);
        float vv[2][8], gg[2][8], o[2][8];
        unpack8(uv[0], vv[0]); unpack8(uv[1], vv[1]); unpack8(ug[0], gg[0]); unpack8(ug[1], gg[1]);
#pragma unroll
        for (int j = 0; j < 4; ++j)
#pragma unroll
            for (int i = 0; i < 4; ++i) o[j >> 1][4 * (j & 1) + i] = (y[j][i] * rstd * lg[j][i] + lb[j][i] + bo * vv[j >> 1][4 * (j & 1) + i]) * gg[j >> 1][4 * (j & 1) + i];
        *(v4u*)(YA + (size_t)t * RW + c0) = pack8(o[0]); *(v4u*)(YA + (size_t)t * RW + c0 + 8) = pack8(o[1]);
    }
}

constexpr int G_BC = 0;
constexpr int G_ALF = 32768;
constexpr int G_RED = 36864;
constexpr int G_TOT = 38912;
constexpr int G_QT = 40960;
constexpr int G_KT = 58368;
constexpr int G_VT = 76800;
constexpr int G_AT = 113664;
__device__ __forceinline__ void gla_bcum(const Frame& F, const Args& a, const bf16* P, int t0, int h) {
    LAS float* bc = (LAS float*)(F.lds + G_BC); LAS float* alf = (LAS float*)(F.lds + G_ALF); LAS float* tot = (LAS float*)(F.lds + G_TOT);
    const int tid = F.tid;
    __syncthreads();
    { const int j = tid >> 3, i2 = (tid & 7) * 2; const unsigned u = *(const unsigned*)(P + (size_t)(t0 + j) * PLD + C_GAL + i2); alf[j * 16 + i2] = bflo(u); alf[j * 16 + i2 + 1] = bfhi(u); }
    const int d = tid & 127, jq = tid >> 7, hd = h * GDK + d;
    float wv[16];
#pragma unroll
    for (int i = 0; i < 16; ++i) wv[i] = a.in[I_GWA2][(size_t)i * GKW + hd];
    const float bb = a.in[I_GBA][hd];
    __syncthreads();
    float run = 0.f;
    for (int jj = 0; jj < 16; ++jj) { const int j = jq * 16 + jj; float x = bb;
#pragma unroll
        for (int i = 0; i < 16; ++i) x += alf[j * 16 + i] * wv[i];
        run += -softplusf_(-x) * (1.f / 16.f); bc[j * 128 + d] = run; }
    tot[jq * 128 + d] = run;
    __syncthreads();
    float pre = 0.f;
    for (int q = 0; q < jq; ++q) pre += tot[q * 128 + d];
    if (jq > 0) { for (int jj = 0; jj < 16; ++jj) bc[(jq * 16 + jj) * 128 + d] += pre; }
    __syncthreads();
}
constexpr int G_VP = 264, G_KP = 136;
__device__ __forceinline__ void gla_stage_v(const Frame& F, const bf16* P, int t0, int h) {
    LAS bf16* VR = (LAS bf16*)(F.lds + G_VT);
    const int j = F.tid >> 3, e0 = (F.tid & 7) * 32;
    const bf16* src = P + (size_t)(t0 + j) * PLD + C_GV + h * GDV + e0;
#pragma unroll
    for (int q = 0; q < 4; ++q) *(LAS v4u*)(VR + j * G_VP + e0 + 8 * q) = *(const v4u*)(src + 8 * q);
}
typedef short s16x4g __attribute__((ext_vector_type(4)));
__device__ __forceinline__ bf16x8 tr_frag(const LAS bf16* img, int pitch, int row0, int col0, int lane) {
    const LAS bf16* p = img + (row0 + 8 * (lane >> 4) + ((lane & 15) >> 2)) * pitch + col0 + 4 * (lane & 3);
    const s16x4g lo = __builtin_amdgcn_ds_read_tr16_b64_v4i16((LAS s16x4g*)p);
    const s16x4g hi = __builtin_amdgcn_ds_read_tr16_b64_v4i16((LAS s16x4g*)(p + 4 * pitch));
    return __builtin_shufflevector(lo, hi, 0, 1, 2, 3, 4, 5, 6, 7);
}
#define MMA16(a_, b_, c_) __builtin_amdgcn_mfma_f32_16x16x32_bf16(a_, b_, c_, 0, 0, 0)
__device__ __forceinline__ void gla_pass_a(const Frame& F, const Args& a) {
    const bf16* P = (const bf16*)(F.ws + WS_P); bf16* HT = (bf16*)(F.ws + WS_GHT); float* DEC = (float*)(F.ws + WS_GDEC);
    LAS float* bc = (LAS float*)(F.lds + G_BC); LAS bf16* KH = (LAS bf16*)(F.lds + G_KT); LAS bf16* VR = (LAS bf16*)(F.lds + G_VT);
    const int fr = F.lane & 15, fq = F.lane >> 4;
    for (int it = F.vcu; it < BATCH * GH * NCH; it += F.G) {
        const int c = it & 31, h = (it >> 5) & 3, b = it >> 7, t0 = b * SEQ + c * CHUNK;
        gla_bcum(F, a, P, t0, h);
        if (F.tid < 128) DEC[(size_t)it * 128 + F.tid] = __expf(bc[63 * 128 + F.tid]);
        { f32x4* gbc = (f32x4*)(F.ws + WS_GBC) + (size_t)it * 2048;
#pragma unroll
          for (int i = 0; i < 4; ++i) gbc[F.tid + 512 * i] = ((const LAS f32x4*)bc)[F.tid + 512 * i]; }
        { const int j = F.tid >> 3, d0 = (F.tid & 7) * 16; const bf16* src = P + (size_t)(t0 + j) * PLD + C_GK + h * GDK + d0;
#pragma unroll
          for (int q = 0; q < 2; ++q) { const v4u u = *(const v4u*)(src + 8 * q); float kv[8]; unpack8(u, kv);
#pragma unroll
            for (int i = 0; i < 8; ++i) { const int d = d0 + 8 * q + i; kv[i] *= __expf(bc[63 * 128 + d] - bc[j * 128 + d]); }
            *(LAS v4u*)(KH + j * G_KP + d0 + 8 * q) = pack8(kv); } }
        gla_stage_v(F, P, t0, h);
        __syncthreads();
        f32x4 acc[8][2];
#pragma unroll
        for (int m = 0; m < 8; ++m)
#pragma unroll
            for (int n = 0; n < 2; ++n) acc[m][n] = (f32x4){0.f, 0.f, 0.f, 0.f};
#pragma unroll
        for (int ks = 0; ks < 2; ++ks) {
            bf16x8 vf[2];
#pragma unroll
            for (int n = 0; n < 2; ++n) vf[n] = tr_frag(VR, G_VP, ks * 32, F.wave * 32 + n * 16, F.lane);
#pragma unroll
            for (int m = 0; m < 8; ++m) { const bf16x8 kf = tr_frag(KH, G_KP, ks * 32, m * 16, F.lane);
#pragma unroll
                for (int n = 0; n < 2; ++n) acc[m][n] = MMA16(kf, vf[n], acc[m][n]); }
        }
        bf16* o = HT + (size_t)it * (GDV * GDK);
#pragma unroll
        for (int m = 0; m < 8; ++m)
#pragma unroll
            for (int n = 0; n < 2; ++n) { v2u pk; pk.x = pk2(acc[m][n][0], acc[m][n][1]); pk.y = pk2(acc[m][n][2], acc[m][n][3]); *(v2u*)(o + (size_t)(F.wave * 32 + n * 16 + fr) * GDK + m * 16 + 4 * fq) = pk; }
    }
}
__device__ __forceinline__ void gla_pass_b(const Frame& F, int lo, int hi, int wg, int nwg) {
    const bf16* HT = (const bf16*)(F.ws + WS_GHT); const float* DEC = (const float*)(F.ws + WS_GDEC); bf16* ST = (bf16*)(F.ws + WS_GST);
    const int gt = wg * 512 + F.tid, NGT = nwg * 512;
    for (int i = (lo >> 1) + gt; i < (hi >> 1); i += NGT) {
        const int bh = i >> 14, ed = (i & 16383) * 2, d = ed & 127;
        float s0 = 0.f, s1 = 0.f;
#pragma unroll 8
        for (int c = 0; c < NCH; ++c) { const size_t it = (size_t)bh * NCH + c;
            const unsigned hv = __builtin_nontemporal_load((const unsigned*)(HT + it * (GDV * GDK) + ed)); const float d0 = DEC[it * 128 + d], d1 = DEC[it * 128 + d + 1];
            *(unsigned*)(ST + it * (GDV * GDK) + ed) = pk2(s0, s1);
            s0 = s0 * d0 + bflo(hv); s1 = s1 * d1 + bfhi(hv); }
    }
}
__device__ __forceinline__ void gla_pass_c(const Frame& F, const Args& a) {
    const bf16* P = (const bf16*)(F.ws + WS_P); const bf16* ST = (const bf16*)(F.ws + WS_GST); bf16* YB = (bf16*)(F.ws + WS_YB);
    LAS float* bc = (LAS float*)(F.lds + G_BC); LAS float* red = (LAS float*)(F.lds + G_RED);
    LAS bf16* QT = (LAS bf16*)(F.lds + G_QT); LAS bf16* KT = (LAS bf16*)(F.lds + G_KT); LAS bf16* VR = (LAS bf16*)(F.lds + G_VT); LAS bf16* AT = (LAS bf16*)(F.lds + G_AT);
    const int fr = F.lane & 15, fq = F.lane >> 4, w = F.wave;
    const float scale = 0.08838834764831845f;
    for (int it = F.vcu; it < BATCH * GH * NCH; it += F.G) {
        const int c = it & 31, h = (it >> 5) & 3, b = it >> 7, t0 = b * SEQ + c * CHUNK;
        __syncthreads();
        { const f32x4* gbc = (const f32x4*)(F.ws + WS_GBC) + (size_t)it * 2048;
#pragma unroll
          for (int i = 0; i < 4; ++i) ((LAS f32x4*)bc)[F.tid + 512 * i] = gbc[F.tid + 512 * i]; }
        const bf16* Sg = ST + (size_t)it * (GDV * GDK);
        bf16x8 sfr[4][2];
#pragma unroll
        for (int ks = 0; ks < 4; ++ks)
#pragma unroll
            for (int n = 0; n < 2; ++n) sfr[ks][n] = *(const bf16x8*)(Sg + (size_t)(w * 32 + n * 16 + fr) * GDK + ks * 32 + fq * 8);
        f32x4 gng[2];
#pragma unroll
        for (int n = 0; n < 2; ++n) gng[n] = *(const f32x4*)(a.in[I_GNG] + w * 32 + n * 16 + 4 * fq);
        v2u ogu[4][2];
#pragma unroll
        for (int m = 0; m < 4; ++m)
#pragma unroll
            for (int n = 0; n < 2; ++n) ogu[m][n] = __builtin_nontemporal_load((const v2u*)(P + (size_t)(t0 + m * 16 + fr) * PLD + C_OG + h * GDV + w * 32 + n * 16 + 4 * fq));
        __syncthreads();
        { const int j = F.tid >> 3, d0 = (F.tid & 7) * 16;
          const bf16* sq = P + (size_t)(t0 + j) * PLD + C_GQ + h * GDK + d0; const bf16* sk = P + (size_t)(t0 + j) * PLD + C_GK + h * GDK + d0;
#pragma unroll
          for (int q = 0; q < 2; ++q) { const v4u uq = *(const v4u*)(sq + 8 * q), uk = *(const v4u*)(sk + 8 * q); float fq8[8], fk8[8]; unpack8(uq, fq8); unpack8(uk, fk8);
#pragma unroll
            for (int i = 0; i < 8; ++i) { const float bv = bc[j * 128 + d0 + 8 * q + i]; fq8[i] *= scale * __expf(bv); fk8[i] *= __expf(-bv); }
            *(LAS v4u*)(QT + j * 136 + d0 + 8 * q) = pack8(fq8); *(LAS v4u*)(KT + j * 136 + d0 + 8 * q) = pack8(fk8); } }
        gla_stage_v(F, P, t0, h);
        __syncthreads();
        { const int mt = w >> 1;
#pragma unroll
          for (int q = 0; q < 2; ++q) { const int nt = (w & 1) * 2 + q; f32x4 sacc = {0.f, 0.f, 0.f, 0.f};
            if (nt <= mt) {
#pragma unroll
                for (int ks = 0; ks < 4; ++ks) { const bf16x8 kfr = *(const LAS bf16x8*)(KT + (nt * 16 + fr) * 136 + ks * 32 + fq * 8); const bf16x8 qfr = *(const LAS bf16x8*)(QT + (mt * 16 + fr) * 136 + ks * 32 + fq * 8);
                    sacc = MMA16(kfr, qfr, sacc); } }
            const int i = mt * 16 + fr, j0 = nt * 16 + 4 * fq; float v4[4];
#pragma unroll
            for (int jj = 0; jj < 4; ++jj) v4[jj] = (j0 + jj <= i) ? sacc[jj] : 0.f;
            v2u pk; pk.x = pk2(v4[0], v4[1]); pk.y = pk2(v4[2], v4[3]); *(LAS v2u*)(AT + i * 72 + j0) = pk; } }
        __syncthreads();
        f32x4 acc[2][4];
#pragma unroll
        for (int n = 0; n < 2; ++n)
#pragma unroll
            for (int m = 0; m < 4; ++m) acc[n][m] = (f32x4){0.f, 0.f, 0.f, 0.f};
#pragma unroll
        for (int ks = 0; ks < 2; ++ks) {
            bf16x8 vf[2];
#pragma unroll
            for (int n = 0; n < 2; ++n) vf[n] = tr_frag(VR, G_VP, ks * 32, w * 32 + n * 16, F.lane);
#pragma unroll
            for (int m = 0; m < 4; ++m) { const bf16x8 af = *(const LAS bf16x8*)(AT + (m * 16 + fr) * 72 + ks * 32 + fq * 8);
#pragma unroll
                for (int n = 0; n < 2; ++n) acc[n][m] = MMA16(vf[n], af, acc[n][m]); }
        }
#pragma unroll
        for (int ks = 0; ks < 4; ++ks) {
#pragma unroll
            for (int m = 0; m < 4; ++m) { const bf16x8 qf = *(const LAS bf16x8*)(QT + (m * 16 + fr) * 136 + ks * 32 + fq * 8);
#pragma unroll
                for (int n = 0; n < 2; ++n) acc[n][m] = MMA16(sfr[ks][n], qf, acc[n][m]); }
        }
        float ssq[4];
#pragma unroll
        for (int m = 0; m < 4; ++m) { float ss = 0.f;
#pragma unroll
            for (int n = 0; n < 2; ++n) ss += (acc[n][m][0] * acc[n][m][0] + acc[n][m][1] * acc[n][m][1]) + (acc[n][m][2] * acc[n][m][2] + acc[n][m][3] * acc[n][m][3]);
            ss += __shfl_xor(ss, 16); ss += __shfl_xor(ss, 32); ssq[m] = ss;
            if (fq == 0) red[(m * 16 + fr) * 8 + w] = ss; }
        __syncthreads();
#pragma unroll
        for (int m = 0; m < 4; ++m) { const int i = m * 16 + fr; float tot = 0.f;
#pragma unroll
            for (int q = 0; q < 8; ++q) tot += red[i * 8 + q];
            const float rstd = rsqrtf(tot * (1.f / GDV) + NORM_EPS);
#pragma unroll
            for (int n = 0; n < 2; ++n) { const int e = w * 32 + n * 16 + 4 * fq;
                const float og[4] = {bflo(ogu[m][n].x), bfhi(ogu[m][n].x), bflo(ogu[m][n].y), bfhi(ogu[m][n].y)}; float r4[4];
#pragma unroll
                for (int jj = 0; jj < 4; ++jj) r4[jj] = acc[n][m][jj] * rstd * gng[n][jj] * (og[jj] * sigmoidf_(og[jj]));
                v2u pk; pk.x = pk2(r4[0], r4[1]); pk.y = pk2(r4[2], r4[3]); *(v2u*)(YB + (size_t)(t0 + i) * GVW + h * GDV + e) = pk; } }
    }
}

__device__ __forceinline__ void p11_router(const Frame& F, const Args& a) {
    const int lane = F.lane, w = F.wave;
    const float* X1 = (const float*)(F.ws + WS_X1); unsigned char* H2 = (unsigned char*)(F.ws + WS_H2); const float* Wr = (const float*)(F.ws + WS_WR);
    int* SEL_E = (int*)(F.ws + WS_ROUTE); float* SEL_W = (float*)(F.ws + WS_ROUTE + 256 * 1024); int* SEL_R = (int*)(F.ws + WS_ROUTE + 512 * 1024);
    volatile LAS int* hist = (volatile LAS int*)(F.lds + MOE_OFF + 1024); volatile LAS int* base = (volatile LAS int*)(F.lds + MOE_OFF + 1280);
    int* LIST = (int*)(F.ws + WS_ROUTE + 1024 * 1024);
    LAS float* part = (LAS float*)F.lds;
    LAS float* ssq = (LAS float*)(F.lds + 16384);
    __syncthreads();
    if (F.tid < 32) hist[F.tid] = 0;
    __syncthreads();
    const int mt = w & 1, ks = w >> 1, r = lane & 15, kq = lane >> 4;
    const int grp = lane >> 4, el = lane & 15;
    const float br0 = a.in[I_BROUTER][el], br1 = a.in[I_BROUTER][16 + el];
    for (int tile = F.vcu; tile < T / 32; tile += F.G) {
        const int tb = tile * 32;
        {
            const float* xp = X1 + (size_t)(tb + 16 * mt + r) * D + 512 * ks + 8 * kq;
            const float* bp = Wr + (size_t)(2 * ks) * 8192 + r * 256 + 8 * kq;
            f32x4 acc0 = {0.f, 0.f, 0.f, 0.f}, acc1 = {0.f, 0.f, 0.f, 0.f}; float ss = 0.f;
#pragma unroll 4
            for (int s = 0; s < 16; ++s) {
                const f32x4 xa = *(const f32x4*)(xp + 32 * s), xb = *(const f32x4*)(xp + 32 * s + 4);
                const float* bs = bp + (s >> 3) * 8192 + 32 * (s & 7);
                const f32x4 b00 = *(const f32x4*)bs, b01 = *(const f32x4*)(bs + 4), b10 = *(const f32x4*)(bs + 4096), b11 = *(const f32x4*)(bs + 4096 + 4);
                ss += ((xa.x * xa.x + xa.y * xa.y) + (xa.z * xa.z + xa.w * xa.w)) + ((xb.x * xb.x + xb.y * xb.y) + (xb.z * xb.z + xb.w * xb.w));
#pragma unroll
                for (int i = 0; i < 4; ++i) { acc0 = __builtin_amdgcn_mfma_f32_16x16x4f32(xa[i], b00[i], acc0, 0, 0, 0); acc1 = __builtin_amdgcn_mfma_f32_16x16x4f32(xa[i], b10[i], acc1, 0, 0, 0); }
#pragma unroll
                for (int i = 0; i < 4; ++i) { acc0 = __builtin_amdgcn_mfma_f32_16x16x4f32(xb[i], b01[i], acc0, 0, 0, 0); acc1 = __builtin_amdgcn_mfma_f32_16x16x4f32(xb[i], b11[i], acc1, 0, 0, 0); }
            }
#pragma unroll
            for (int j = 0; j < 4; ++j) { LAS float* pr = part + ((ks * 32 + 16 * mt + 4 * kq + j) * 32); pr[r] = acc0[j]; pr[16 + r] = acc1[j]; }
            ss += __shfl_xor(ss, 16); ss += __shfl_xor(ss, 32);
            if (kq == 0) ssq[ks * 32 + 16 * mt + r] = ss;
        }
        __syncthreads();
        {
            const int tk = 4 * w + grp;
            const float rstd = rsqrtf(((ssq[tk] + ssq[32 + tk]) + (ssq[64 + tk] + ssq[96 + tk])) * (1.f / D) + NORM_EPS);
            const LAS float* pr = part + tk * 32;
            float c0 = ((pr[el] + pr[1024 + el]) + (pr[2048 + el] + pr[3072 + el])) * rstd + br0;
            float c1 = ((pr[16 + el] + pr[1024 + 16 + el]) + (pr[2048 + 16 + el] + pr[3072 + 16 + el])) * rstd + br1;
            float tv[4]; int ti[4];
#pragma unroll
            for (int k = 0; k < 4; ++k) { float bv = c0; int bi = el; if (c1 > c0) { bv = c1; bi = 16 + el; }
#pragma unroll
                for (int o = 1; o < 16; o <<= 1) { const float ov = __shfl_xor(bv, o); const int oi = __shfl_xor(bi, o); if (ov > bv || (ov == bv && oi < bi)) { bv = ov; bi = oi; } }
                tv[k] = bv; ti[k] = bi; if (bi == el) c0 = -3.0e38f; if (bi == 16 + el) c1 = -3.0e38f; }
            const float e1 = __expf(tv[1] - tv[0]), e2 = __expf(tv[2] - tv[0]), e3 = __expf(tv[3] - tv[0]); const float inv = 1.f / (1.f + e1 + e2 + e3);
            if (el < 4) { const int k = el; const float wk = (k == 0 ? 1.f : (k == 1 ? e1 : (k == 2 ? e2 : e3))) * inv; const int ek = (k == 0 ? ti[0] : (k == 1 ? ti[1] : (k == 2 ? ti[2] : ti[3])));
                const int lr = __hip_atomic_fetch_add((LAS int*)&hist[ek], 1, __ATOMIC_RELAXED, __HIP_MEMORY_SCOPE_WORKGROUP);
                SEL_E[(tb + tk) * 4 + k] = ek; SEL_W[(tb + tk) * 4 + k] = wk; SEL_R[(tb + tk) * 4 + k] = lr; }
        }
#pragma unroll
        for (int rr = 0; rr < 4; ++rr) { const int tk = 4 * w + rr;
            const float rstd = rsqrtf(((ssq[tk] + ssq[32 + tk]) + (ssq[64 + tk] + ssq[96 + tk])) * (1.f / D) + NORM_EPS);
            const f32x4* xr = (const f32x4*)(X1 + (size_t)(tb + tk) * D) + lane; unsigned* hr = (unsigned*)(H2 + (size_t)(tb + tk) * D) + lane;
#pragma unroll
            for (int j = 0; j < 8; ++j) { const f32x4 xv = __builtin_nontemporal_load(xr + 64 * j); const f32x4 gg = ((const f32x4*)a.in[I_NFG])[64 * j + lane];
                hr[64 * j] = pk4_fp8(xv.x * rstd * gg.x, xv.y * rstd * gg.y, xv.z * rstd * gg.z, xv.w * rstd * gg.w); } }
        __syncthreads();
    }
    if (F.tid < 32) base[F.tid] = (int)__hip_atomic_fetch_add(F.ctl + CW_CNT + F.tid, (unsigned)hist[F.tid], RLX_AGENT);
    __syncthreads();
    for (int tile = F.vcu; tile < T / 32; tile += F.G) {
        if (F.tid < 128) { const int tk = tile * 32 + (F.tid >> 2); const int idx = tk * 4 + (F.tid & 3);
            const int e_ = __hip_atomic_load(SEL_E + idx, RLX_AGENT); const int rk_ = __hip_atomic_load(SEL_R + idx, RLX_AGENT) + base[e_]; SEL_R[idx] = rk_; LIST[e_ * 8192 + rk_] = tk; }
    }
}
__device__ __forceinline__ void moe_tables(const Frame& F, int nct) {
    volatile LAS int* tab = (volatile LAS int*)(F.lds + MOE_OFF);
    __syncthreads();
    if (F.tid == 0) { int run = 0, units = 0;
        for (int e = 0; e < NE; ++e) { const int cnt = (int)__hip_atomic_load(F.ctl + CW_CNT + e, RLX_AGENT); const int nt = (cnt + 255) >> 8;
            tab[e] = units; tab[36 + e] = run * 256; tab[72 + e] = nt > 0 ? nt : 1; tab[108 + e] = cnt; run += nt; units += nt * nct; }
        tab[32] = units; }
    __syncthreads();
}
__device__ __forceinline__ void p12_scatter(const Frame& F) {
    const int gw = F.vcu * 8 + F.wave, NGW = F.G * 8, lane = F.lane;
    const unsigned char* H2 = (const unsigned char*)(F.ws + WS_H2); unsigned char* XS = (unsigned char*)(F.ws + WS_XS);
    const int* SEL_E = (const int*)(F.ws + WS_ROUTE); const int* SEL_R = (const int*)(F.ws + WS_ROUTE + 512 * 1024); int* DEST = (int*)(F.ws + WS_ROUTE + 768 * 1024);
    moe_tables(F, 1);
    volatile LAS int* tab = (volatile LAS int*)(F.lds + MOE_OFF);
    for (int it = gw; it < T * TOPK; it += NGW) {
        const int t = it >> 2; const int e = SEL_E[it], dest = tab[36 + e] + SEL_R[it];
        const v4u* s = (const v4u*)(H2 + (size_t)t * D) + lane; v4u* d = (v4u*)(XS + (size_t)dest * D) + lane;
        d[0] = s[0]; d[64] = s[64];
        if (lane == 0) DEST[it] = dest;
    }
}
__device__ __forceinline__ void p15_combine(const Frame& F, const Args& a) {
    const int gw = F.vcu * 8 + F.wave, NGW = F.G * 8, lane = F.lane;
    const float* X1 = (const float*)(F.ws + WS_X1); const bf16* Y = (const bf16*)(F.ws + WS_Y);
    const float* SEL_W = (const float*)(F.ws + WS_ROUTE + 256 * 1024); const int* SEL_E = (const int*)(F.ws + WS_ROUTE); const int* SEL_R = (const int*)(F.ws + WS_ROUTE + 512 * 1024);
    moe_tables(F, 1);
    volatile LAS int* tab = (volatile LAS int*)(F.lds + MOE_OFF);
    for (int t = gw; t < T; t += NGW) {
        f32x4 v[8];
        const f32x4* xr = (const f32x4*)(X1 + (size_t)t * D) + lane;
#pragma unroll
        for (int j = 0; j < 8; ++j) v[j] = __builtin_nontemporal_load(xr + 64 * j);
#pragma unroll
        for (int k = 0; k < 4; ++k) { const float wk = SEL_W[t * 4 + k]; const v2u* yr = (const v2u*)(Y + (size_t)(tab[36 + SEL_E[t * 4 + k]] + SEL_R[t * 4 + k]) * D) + lane;
#pragma unroll
            for (int j = 0; j < 8; ++j) { const v2u u = __builtin_nontemporal_load(yr + 64 * j); v[j].x += wk * bflo(u.x); v[j].y += wk * bfhi(u.x); v[j].z += wk * bflo(u.y); v[j].w += wk * bfhi(u.y); } }
        float s = 0.f;
#pragma unroll
        for (int j = 0; j < 8; ++j) s += (v[j].x * v[j].x + v[j].y * v[j].y) + (v[j].z * v[j].z + v[j].w * v[j].w);
        const float rstd = rsqrtf(wave_sum(s) * (1.f / D) + NORM_EPS);
        f32x4* o = (f32x4*)(a.out + (size_t)t * D) + lane;
#pragma unroll
        for (int j = 0; j < 8; ++j) { const f32x4 gg = ((const f32x4*)a.in[I_NFINAL])[64 * j + lane]; __builtin_nontemporal_store(v[j] * rstd * gg, o + 64 * j); }
    }
}

__global__ void __launch_bounds__(512, 2) __attribute__((amdgpu_num_sgpr(96))) fwd(Args args) {
    extern __shared__ __attribute__((aligned(16))) unsigned char lds[];
    Frame F;
    F.lds = (LAS unsigned char*)lds; F.ws = args.ws; F.ctl = (unsigned*)(args.ws + WS_CTL);
    F.tid = threadIdx.x; F.lane = F.tid & 63; F.wave = __builtin_amdgcn_readfirstlane(F.tid >> 6);
    F.G = gridDim.x; { const int bx = blockIdx.x; F.vcu = (F.G % 8 == 0) ? (bx % 8) * (F.G / 8) + bx / 8 : bx; }
    for (int u = F.tid; u < (LDS_BYTES - LDSCTL_OFF) / 4; u += 512) ((LAS unsigned*)(F.lds + LDSCTL_OFF))[u] = 0u;
    __syncthreads();
    volatile LAS unsigned* MISC = (volatile LAS unsigned*)(F.lds + MISC_OFF);
#if MK_PER_PHASE
#define GRID_BAR() do { } while (0)
#else
    XcdBarrier bar = xcd_barrier_post(F.ctl + CW_BAR, MISC + 8);
#define GRID_BAR() xcd_barrier(bar)
#endif
    const int lo = args.ph_lo, hi = args.ph_hi;
#define IN(k) (lo <= (k) && (k) < hi)
#define SEAM(k) do { if (IN(k) && IN((k) + 1)) GRID_BAR(); } while (0)
#define DUP(k) (((PROBE_DUP) >> (k)) & 1)
#define PH_BEGIN {
#define PH_END }
    const bf16* P = (const bf16*)(F.ws + WS_P);

    if (IN(0)) { PH_BEGIN  p0_prologue(F, args);  PH_END if (DUP(0)) { GRID_BAR(); PH_BEGIN  p0_prologue(F, args);  PH_END } } SEAM(0);
    if (IN(1)) { PH_BEGIN  p1_gemm_in(F, args);  PH_END if (DUP(1)) { GRID_BAR(); PH_BEGIN  p1_gemm_in(F, args);  PH_END } } SEAM(1);
    if (PROBE_GEMM >= 0 && IN(1)) {
        pg8::Gemm g{(const bf16*)(F.ws + WS_H), (const bf16*)(F.ws + WS_WIN), DP, DP, D, nullptr}; pg8::ProbeOrder S; S.so.init(T, PLD, F.G, (int)blockIdx.x); S.mode = PROBE_GEMM;
        pg8::EpiProbe E{(bf16*)(F.ws + WS_XS)}; pg8::gemm_phase(F.lds, g, S, E); GRID_BAR();
    }
    if (IN(2)) { PH_BEGIN  p2_lora_in(F, args); gla_pass_a(F, args);  PH_END if (DUP(2)) { GRID_BAR(); PH_BEGIN  p2_lora_in(F, args); gla_pass_a(F, args);  PH_END } } SEAM(2);
    if (IN(3)) { PH_BEGIN
        { pg8::Gemm g{(const bf16*)(F.ws + WS_A2), (const bf16*)(F.ws + WS_WLWA), 512, 256, 256, nullptr}; pg8::StaticOrder S; S.init(T, 2048, F.G, (int)blockIdx.x);
          pg8::EpiBf16 E{(bf16*)(F.ws + WS_WAO), 2048, nullptr, 0, 1.f}; pg8::gemm_phase(F.lds, g, S, E); }
        { pg8::Gemm g{(const bf16*)(F.ws + WS_A2) + 256, (const bf16*)(F.ws + WS_WLG), 512, 256, 256, nullptr}; pg8::StaticOrder S; S.init(T, 1024, F.G, (int)blockIdx.x);
          pg8::EpiBf16 E{(bf16*)(F.ws + WS_GO), 1024, nullptr, 0, 1.f}; pg8::gemm_phase(F.lds, g, S, E); }
        {
            constexpr int NEL = BATCH * GH * GDV * GDK, HEAD = (NEL / 4 / 65536) * 65536; const int bx = (int)blockIdx.x;
            if (F.G == 256) { if (bx >= 128) gla_pass_b(F, 0, HEAD, bx - 128, 128); gla_pass_b(F, HEAD, NEL, F.vcu, F.G); } else gla_pass_b(F, 0, NEL, F.vcu, F.G); }
     PH_END if (DUP(3)) { GRID_BAR(); PH_BEGIN
        { pg8::Gemm g{(const bf16*)(F.ws + WS_A2), (const bf16*)(F.ws + WS_WLWA), 512, 256, 256, nullptr}; pg8::StaticOrder S; S.init(T, 2048, F.G, (int)blockIdx.x);
          pg8::EpiBf16 E{(bf16*)(F.ws + WS_WAO), 2048, nullptr, 0, 1.f}; pg8::gemm_phase(F.lds, g, S, E); }
        { pg8::Gemm g{(const bf16*)(F.ws + WS_A2) + 256, (const bf16*)(F.ws + WS_WLG), 512, 256, 256, nullptr}; pg8::StaticOrder S; S.init(T, 1024, F.G, (int)blockIdx.x);
          pg8::EpiBf16 E{(bf16*)(F.ws + WS_GO), 1024, nullptr, 0, 1.f}; pg8::gemm_phase(F.lds, g, S, E); }
        {
            constexpr int NEL = BATCH * GH * GDV * GDK, HEAD = (NEL / 4 / 65536) * 65536; const int bx = (int)blockIdx.x;
            if (F.G == 256) { if (bx >= 128) gla_pass_b(F, 0, HEAD, bx - 128, 128); gla_pass_b(F, HEAD, NEL, F.vcu, F.G); } else gla_pass_b(F, 0, NEL, F.vcu, F.G); }
     PH_END } } SEAM(3);
    if (IN(4)) { PH_BEGIN  p4_rwkv_prep(F, args); gla_pass_c(F, args);  PH_END if (DUP(4)) { GRID_BAR(); PH_BEGIN  p4_rwkv_prep(F, args); gla_pass_c(F, args);  PH_END } } SEAM(4);
    if (IN(5)) { PH_BEGIN  p5_rwkv_scan(F, args);  PH_END if (DUP(5)) { GRID_BAR(); PH_BEGIN  p5_rwkv_scan(F, args);  PH_END } } SEAM(5);
    if (IN(6)) { PH_BEGIN  p6_rwkv_post(F, args);  PH_END if (DUP(6)) { GRID_BAR(); PH_BEGIN  p6_rwkv_post(F, args);  PH_END } } SEAM(6);
    if (IN(7)) { PH_BEGIN
        { pg8::Gemm g{(const bf16*)(F.ws + WS_YA), (const bf16*)(F.ws + WS_WBA), RW, RW, RW, nullptr}; pg8::StaticOrder S; S.init(T, D, F.G, (int)blockIdx.x);
          pg8::EpiGate<false> E{(bf16*)(F.ws + WS_MRG), P, args.in[I_BM], C_GATE}; pg8::gemm_phase(F.lds, g, S, E); }
        { pg8::Gemm g{(const bf16*)(F.ws + WS_YB), (const bf16*)(F.ws + WS_WBB), GVW, GVW, GVW, nullptr}; pg8::StaticOrder S; S.init(T, D, F.G, (int)blockIdx.x);
          pg8::EpiGate<true> E{(bf16*)(F.ws + WS_MRG), P, args.in[I_BM] + D, C_GATE + D}; pg8::gemm_phase(F.lds, g, S, E); }
     PH_END if (DUP(7)) { GRID_BAR(); PH_BEGIN
        { pg8::Gemm g{(const bf16*)(F.ws + WS_YA), (const bf16*)(F.ws + WS_WBA), RW, RW, RW, nullptr}; pg8::StaticOrder S; S.init(T, D, F.G, (int)blockIdx.x);
          pg8::EpiGate<false> E{(bf16*)(F.ws + WS_MRG), P, args.in[I_BM], C_GATE}; pg8::gemm_phase(F.lds, g, S, E); }
        { pg8::Gemm g{(const bf16*)(F.ws + WS_YB), (const bf16*)(F.ws + WS_WBB), GVW, GVW, GVW, nullptr}; pg8::StaticOrder S; S.init(T, D, F.G, (int)blockIdx.x);
          pg8::EpiGate<true> E{(bf16*)(F.ws + WS_MRG), P, args.in[I_BM] + D, C_GATE + D}; pg8::gemm_phase(F.lds, g, S, E); }
     PH_END } } SEAM(7);
    if (IN(8)) { PH_BEGIN
        pg8::Gemm g{(const bf16*)(F.ws + WS_MRG), (const bf16*)(F.ws + WS_WOUT), D, D, D, nullptr}; pg8::StaticOrder S; S.init(T, D, F.G, (int)blockIdx.x);
        pg8::EpiResF32 E{(float*)(F.ws + WS_X1), args.in[I_X]}; pg8::gemm_phase(F.lds, g, S, E);
     PH_END if (DUP(8)) { GRID_BAR(); PH_BEGIN
        pg8::Gemm g{(const bf16*)(F.ws + WS_MRG), (const bf16*)(F.ws + WS_WOUT), D, D, D, nullptr}; pg8::StaticOrder S; S.init(T, D, F.G, (int)blockIdx.x);
        pg8::EpiResF32 E{(float*)(F.ws + WS_X1), args.in[I_X]}; pg8::gemm_phase(F.lds, g, S, E);
     PH_END } } SEAM(8);
    if (IN(9)) { PH_BEGIN  p11_router(F, args);  PH_END if (DUP(9)) { GRID_BAR(); PH_BEGIN  p11_router(F, args);  PH_END } } SEAM(9);
    if (IN(10)) { PH_BEGIN
        moe_tables(F, 16);
        pg8::Gemm g{(const bf16*)(F.ws + WS_H2), (const bf16*)(F.ws + WS_WGU), D, D, D, (const int*)(F.ws + WS_ROUTE + 1024 * 1024)};
        pg8::MoeOrder S{(const volatile LAS int*)(F.lds + MOE_OFF), 16, 4096, F.G, F.vcu, false};
        pg8::EpiGluQ E{(unsigned char*)(F.ws + WS_HH), args.in[I_BGATE], args.in[I_BUP]}; pg8::gemm_phase<pg8::EpiGluQ, pg8::MoeOrder, 1, true>(F.lds, g, S, E);
     PH_END if (DUP(10)) { GRID_BAR(); PH_BEGIN
        moe_tables(F, 16);
        pg8::Gemm g{(const bf16*)(F.ws + WS_H2), (const bf16*)(F.ws + WS_WGU), D, D, D, (const int*)(F.ws + WS_ROUTE + 1024 * 1024)};
        pg8::MoeOrder S{(const volatile LAS int*)(F.lds + MOE_OFF), 16, 4096, F.G, F.vcu, false};
        pg8::EpiGluQ E{(unsigned char*)(F.ws + WS_HH), args.in[I_BGATE], args.in[I_BUP]}; pg8::gemm_phase<pg8::EpiGluQ, pg8::MoeOrder, 1, true>(F.lds, g, S, E);
     PH_END } } SEAM(10);
    if (IN(11)) { PH_BEGIN
        moe_tables(F, 8);
        pg8::Gemm g{(const bf16*)(F.ws + WS_HH), (const bf16*)(F.ws + WS_WD), FF, FF, FF, nullptr};
        pg8::MoeOrder S{(const volatile LAS int*)(F.lds + MOE_OFF), 8, 2048, F.G, F.vcu, true};
        pg8::EpiBf16H E{(bf16*)(F.ws + WS_Y), D, args.in[I_BDOWN], D, WQ_INV}; pg8::gemm_phase<pg8::EpiBf16H, pg8::MoeOrder, 1, false, true, true>(F.lds, g, S, E);
     PH_END if (DUP(11)) { GRID_BAR(); PH_BEGIN
        moe_tables(F, 8);
        pg8::Gemm g{(const bf16*)(F.ws + WS_HH), (const bf16*)(F.ws + WS_WD), FF, FF, FF, nullptr};
        pg8::MoeOrder S{(const volatile LAS int*)(F.lds + MOE_OFF), 8, 2048, F.G, F.vcu, true};
        pg8::EpiBf16H E{(bf16*)(F.ws + WS_Y), D, args.in[I_BDOWN], D, WQ_INV}; pg8::gemm_phase<pg8::EpiBf16H, pg8::MoeOrder, 1, false, true, true>(F.lds, g, S, E);
     PH_END } } SEAM(11);
    if (IN(12)) { PH_BEGIN  p15_combine(F, args);  PH_END if (DUP(12)) { GRID_BAR(); PH_BEGIN  p15_combine(F, args);  PH_END } }
#undef IN
#undef SEAM
}
constexpr int N_PHASES = 13;

extern "C" void kernel_launch(void* const* d_in, const int* in_sizes, int n_in, void* d_out, int out_size, void* d_ws, size_t ws_size, hipStream_t stream) {
    static int grid = 0;
    if (grid == 0) {
        if (n_in != 31 || in_sizes[0] != T * D || out_size != T * D || ws_size < WS_END) { fprintf(stderr, "kernel_launch: unexpected shapes (n_in %d, ws %zu)\n", n_in, ws_size); grid = -1; return; }
        int dev = 0, cus = 0, per_cu = 0;
        if (hipGetDevice(&dev) != hipSuccess || hipDeviceGetAttribute(&cus, hipDeviceAttributeMultiprocessorCount, dev) != hipSuccess) { grid = -1; return; }
        if (hipFuncSetAttribute((const void*)fwd, hipFuncAttributeMaxDynamicSharedMemorySize, LDS_BYTES) != hipSuccess) { fprintf(stderr, "kernel_launch: hipFuncSetAttribute failed\n"); grid = -1; return; }
        if (hipOccupancyMaxActiveBlocksPerMultiprocessor(&per_cu, (const void*)fwd, 512, LDS_BYTES) != hipSuccess || per_cu < 1) { fprintf(stderr, "kernel_launch: occupancy query says %d\n", per_cu); }
        (void)hipGetLastError();
        grid = cus;
    }
    if (grid < 0) return;
    (void)hipMemsetAsync((char*)d_ws + WS_CTL, 0, CTL_ZERO_BYTES, stream);
    Args a{};
    for (int i = 0; i < 31; ++i) a.in[i] = (const float*)d_in[i];
    a.out = (float*)d_out; a.ws = (unsigned char*)d_ws;
#if MK_PER_PHASE
    for (int p = 0; p < N_PHASES; ++p) { a.ph_lo = p; a.ph_hi = p + 1; hipLaunchKernelGGL(fwd, dim3(grid), dim3(512), LDS_BYTES, stream, a); }
#else
    a.ph_lo = 0; a.ph_hi = N_PHASES;
    hipLaunchKernelGGL(fwd, dim3(grid), dim3(512), LDS_BYTES, stream, a);
#endif
}
```

```cpp
#include <hip/hip_runtime.h>
#include <cstdio>
#include <cstdint>

#ifndef MK_PER_PHASE
#define MK_PER_PHASE 0
#endif

#ifndef PROBE_GEMM
#define PROBE_GEMM -1
#endif
#ifndef PROBE_DUP
#define PROBE_DUP 0
#endif
#define GAS __attribute__((address_space(1)))
#define LAS __attribute__((address_space(3)))
typedef unsigned short bf16;
typedef unsigned v4u __attribute__((ext_vector_type(4)));
typedef unsigned v2u __attribute__((ext_vector_type(2)));
typedef float f32x4 __attribute__((ext_vector_type(4)));
typedef float f32x2 __attribute__((ext_vector_type(2)));
typedef short bf16x8 __attribute__((ext_vector_type(8)));
typedef long i64x2 __attribute__((ext_vector_type(2)));
typedef int v4i __attribute__((ext_vector_type(4)));
typedef int v8i __attribute__((ext_vector_type(8)));
#define RLX_AGENT __ATOMIC_RELAXED, __HIP_MEMORY_SCOPE_AGENT
#define LDS_WAIT() asm volatile("s_waitcnt lgkmcnt(0)" ::: "memory")
#define VM_WAIT() asm volatile("s_waitcnt vmcnt(0)" ::: "memory")

constexpr int D = 2048, BATCH = 4, SEQ = 2048, T = BATCH * SEQ;
constexpr int RW = 1024, RH = 16, RN = 64;
constexpr int DLORA = 96, GLORA = 256;
constexpr int RWKV_COLS = 3 * RW + 2 * DLORA + GLORA;
constexpr int GH = 4, GDK = 128, GDV = 256, GKW = GH * GDK, GVW = GH * GDV, GAL = 16;
constexpr int GLA_COLS = 2 * GKW + 2 * GVW + GAL;
constexpr int IN_COLS = RWKV_COLS + GLA_COLS + 2 * D;
constexpr int PLD = 10752;
constexpr int DP = D + 64;
constexpr int C_R = 0, C_K = 1024, C_V = 2048, C_WL = 3072, C_AL = 3168, C_GL = 3264;
constexpr int C_GQ = 3520, C_GK = 4032, C_GV = 4544, C_OG = 5568, C_GAL = 6592, C_GATE = 6608;
constexpr int NE = 32, TOPK = 4, FF = 2048;
constexpr int XS_ROWS = T * TOPK + NE * 256;
constexpr int CHUNK = 64, NCH = SEQ / CHUNK;
constexpr float NORM_EPS = 1e-5f, GN_EPS = 64e-5f;
constexpr float WQ_SCALE = 64.f, WQ_INV = 1.f / 64.f;

constexpr size_t MiB = 1u << 20;
constexpr size_t WS_CTL = 0, CTL_ZERO_BYTES = 1 * MiB;
constexpr size_t WS_WR = 1 * MiB;
constexpr size_t WS_WLWA = 2 * MiB;
constexpr size_t WS_WLG = 3 * MiB;
constexpr size_t WS_WBA = 4 * MiB, WS_WBB = 8 * MiB;
constexpr size_t WS_WOUT = 12 * MiB;
constexpr size_t WS_WIN = 64 * MiB;
constexpr size_t WS_WGU = 192 * MiB;
constexpr size_t WS_WD = 448 * MiB;
constexpr size_t WS_H = 128 * MiB;
constexpr size_t WS_P = 864 * MiB;
constexpr size_t WS_Y = WS_P;
constexpr size_t WS_A2 = 1032 * MiB;
constexpr size_t WS_WAO = 1040 * MiB;
constexpr size_t WS_GO = 1072 * MiB;
constexpr size_t WS_SCAN = 1088 * MiB;
constexpr size_t WS_BON = 1200 * MiB;
constexpr size_t WS_YRAW = 1280 * MiB;
constexpr size_t WS_GHT = 1312 * MiB;
constexpr size_t WS_GST = 1376 * MiB;
constexpr size_t WS_GDEC = 1408 * MiB;
constexpr size_t WS_GBC = 576 * MiB;
constexpr size_t WS_YA = 1410 * MiB, WS_YB = 1426 * MiB;
constexpr size_t WS_MRG = 1442 * MiB;
constexpr size_t WS_X1 = 1474 * MiB;
constexpr size_t WS_H2 = 832 * MiB;
constexpr size_t WS_ROUTE = 1570 * MiB;
constexpr size_t WS_XS = 1572 * MiB;
constexpr size_t WS_HH = 1732 * MiB;
constexpr size_t WS_END = 1892 * MiB;
constexpr int CW_BAR = 4096;
constexpr int CW_CNT = 16384;
constexpr int CW_CVQ = 20480, CW_CVSTOP = 20544;

constexpr int RING_BYTES = 131072;
constexpr int LDSCTL_OFF = 159744, MISC_OFF = LDSCTL_OFF + 320;
constexpr int MOE_OFF = LDSCTL_OFF + 1024;
constexpr int LDS_BYTES = 163840;

__device__ __forceinline__ unsigned f2bf(float f) { unsigned u = __builtin_bit_cast(unsigned, f); return (u + 0x7fffu + ((u >> 16) & 1u)) >> 16; }
__device__ __forceinline__ unsigned pk2(float lo, float hi) { return f2bf(lo) | (f2bf(hi) << 16); }
__device__ __forceinline__ unsigned pk4_fp8(float a, float b, float c, float d) { int w = 0; w = __builtin_amdgcn_cvt_pk_fp8_f32(a, b, w, false); w = __builtin_amdgcn_cvt_pk_fp8_f32(c, d, w, true); return (unsigned)w; }
__device__ __forceinline__ float bflo(unsigned u) { return __builtin_bit_cast(float, u << 16); }
__device__ __forceinline__ float bfhi(unsigned u) { return __builtin_bit_cast(float, u & 0xffff0000u); }
__device__ __forceinline__ float bf2f(bf16 b) { return __builtin_bit_cast(float, ((unsigned)b) << 16); }
__device__ __forceinline__ float wave_sum(float v) {
#pragma unroll
    for (int o = 1; o < 64; o <<= 1) v += __shfl_xor(v, o);
    return v;
}
__device__ __forceinline__ float sigmoidf_(float x) { return 1.f / (1.f + __expf(-x)); }
__device__ __forceinline__ float softplusf_(float x) { return fmaxf(x, 0.f) + log1pf(__expf(-fabsf(x))); }

namespace pg8 {
constexpr int BM = 256, BK = 64, HALF = 128, HTB = HALF * BK * 2, STAGE_BYTES = 8 * HTB, NXCD = 8, WGM = 8;
__host__ __device__ __forceinline__ int lds_byte(int r, int c) { return r * 128 + (((c >> 3) ^ ((r >> 1) & 7)) << 4) + (c & 7) * 2; }
__host__ __device__ __forceinline__ void stage_rc(int b, int& R, int& C) { R = b >> 7; C = ((((b & 127) >> 4) ^ ((R >> 1) & 7)) << 3); }
__host__ __device__ __forceinline__ int perm32(int rho) { const int n = rho >> 4, i = rho & 15; return 8 * (i >> 2) + 4 * n + (i & 3); }

struct Unit { int rowA, rowB, pn, e, rk0, cnt, hn; };
struct Gemm { const bf16* A; const bf16* Bt; int lda, ldb, K; const int* list; };

struct StaticOrder {
    int nM, nN, nwg, G, c;
    __device__ void init(int M, int N, int G_, int c_) { nM = M / BM; nN = N / BM; nwg = nM * nN; G = G_; c = c_; }
    __device__ bool next(int i, Unit& u) const {
        const long L = (long)i * G + c; if (L >= nwg) return false;
        int wgid = (int)L; { const int q = nwg / NXCD, r = nwg % NXCD, xcd = wgid % NXCD, off = wgid / NXCD; wgid = (xcd < r ? xcd * (q + 1) : r * (q + 1) + (xcd - r) * q) + off; }
        const int nig = WGM * nN, gid = wgid / nig, fm = gid * WGM, gsz = (nM - fm) < WGM ? (nM - fm) : WGM;
        const int pm = fm + ((wgid % nig) % gsz); u.pn = (wgid % nig) / gsz; u.rowA = pm * BM; u.rowB = u.pn * BM; u.e = 0; u.rk0 = 0; u.cnt = 0; u.hn = 0; return true;
    }
};
struct ProbeOrder {
    StaticOrder so; int mode;
    __device__ bool next(int i, Unit& u) const { if (!so.next(i, u)) return false; u.e = (u.rowA >> 8) * 64 + u.pn; if (mode & 1) u.rowA = 0; if (mode & 2) u.rowB = 0; return true; }
};
struct MoeOrder {
    const volatile LAS int* tab; int nct, rowsB, G, c;
    bool nsplit;
    __device__ bool next(int i, Unit& u) const {
        int L = i * G + c; const int total = __builtin_amdgcn_readfirstlane(tab[32]); int hn = 0;
        if (nsplit) { const int rf = (total / G) * G, r = total - rf;
            if (r > 0 && 2 * r <= G && L >= rf) { const int j = L - rf; if (j >= 2 * r) return false; L = rf + (j >> 1); hn = 1 + (j & 1); } }
        if (L >= total) return false;
        u.hn = hn;
        int e = 0;
        for (; e < 31; ++e) { if (L < __builtin_amdgcn_readfirstlane(tab[e + 1])) break; }
        const int local = L - __builtin_amdgcn_readfirstlane(tab[e]); const int nt = __builtin_amdgcn_readfirstlane(tab[72 + e]);
        const int ct = local / nt, rt = local - ct * nt;
        u.rowA = __builtin_amdgcn_readfirstlane(tab[36 + e]) + rt * BM; u.rowB = e * rowsB + ct * BM + (hn == 2 ? HALF : 0); u.pn = ct; u.e = e; u.rk0 = rt * BM; u.cnt = __builtin_amdgcn_readfirstlane(tab[108 + e]); return true;
    }
};

__device__ __forceinline__ unsigned cvt_pk_bf16(float lo, float hi) { unsigned r; asm volatile("v_cvt_pk_bf16_f32 %0, %1, %2" : "=v"(r) : "v"(lo), "v"(hi)); return r; }

struct EpiBf16 {
    static constexpr bool PERM = true;
    bf16* O; int ldc; const float* bias; int bias_estride; float scale;
    __device__ __forceinline__ void operator()(const f32x4 (&acc)[2][2][4][2], const Unit& u, int wr, int wc, int fr, int fq) const {
        const int row0 = u.rowA + wr * 64 + fr, col0 = u.pn * BM + wc * 32 + 8 * fq;
        f32x4 bv[2][2];
#pragma unroll
        for (int bj = 0; bj < 2; ++bj)
#pragma unroll
            for (int n = 0; n < 2; ++n) bv[bj][n] = bias ? *(const f32x4*)(bias + (size_t)u.e * bias_estride + col0 + bj * HALF + 4 * n) : (f32x4){0.f, 0.f, 0.f, 0.f};
#pragma unroll
        for (int ai = 0; ai < 2; ++ai)
#pragma unroll
            for (int m = 0; m < 4; ++m) { bf16* rowp = O + (size_t)(row0 + ai * HALF + m * 16) * ldc + col0;
#pragma unroll
                for (int bj = 0; bj < 2; ++bj) { const f32x4 v0 = acc[ai][bj][m][0] * scale + bv[bj][0], v1 = acc[ai][bj][m][1] * scale + bv[bj][1];
                    v4u w; w.x = cvt_pk_bf16(v0[0], v0[1]); w.y = cvt_pk_bf16(v0[2], v0[3]); w.z = cvt_pk_bf16(v1[0], v1[1]); w.w = cvt_pk_bf16(v1[2], v1[3]);
                    *(v4u*)(rowp + bj * HALF) = w; } }
    }
};
struct EpiBf16H {
    static constexpr bool PERM = true;
    bf16* O; int ldc; const float* bias; int bias_estride; float scale;
    __device__ __forceinline__ void operator()(const f32x4 (&acc)[2][2][4][2], const Unit& u, int wr, int wc, int fr, int fq) const {
        const int row0 = u.rowA + wr * 64 + fr, col0 = u.pn * BM + wc * 32 + 8 * fq + (u.hn == 2 ? HALF : 0);
#pragma unroll
        for (int bj = 0; bj < 2; ++bj) { if (bj == 1 && u.hn != 0) break;
            f32x4 bv[2];
#pragma unroll
            for (int n = 0; n < 2; ++n) bv[n] = *(const f32x4*)(bias + (size_t)u.e * bias_estride + col0 + bj * HALF + 4 * n);
#pragma unroll
            for (int ai = 0; ai < 2; ++ai)
#pragma unroll
                for (int m = 0; m < 4; ++m) { bf16* rowp = O + (size_t)(row0 + ai * HALF + m * 16) * ldc + col0;
                    const f32x4 v0 = acc[ai][bj][m][0] * scale + bv[0], v1 = acc[ai][bj][m][1] * scale + bv[1];
                    v4u w; w.x = cvt_pk_bf16(v0[0], v0[1]); w.y = cvt_pk_bf16(v0[2], v0[3]); w.z = cvt_pk_bf16(v1[0], v1[1]); w.w = cvt_pk_bf16(v1[2], v1[3]);
                    *(v4u*)(rowp + bj * HALF) = w; } }
    }
};
struct EpiProbe {
    static constexpr bool PERM = true;
    bf16* O;
    __device__ __forceinline__ void operator()(const f32x4 (&acc)[2][2][4][2], const Unit& u, int wr, int wc, int fr, int fq) const {
        const int pm = u.e >> 6, pn = u.e & 63; const int row0 = pm * BM + wr * 64 + fr, col0 = pn * BM + wc * 32 + 8 * fq;
#pragma unroll
        for (int ai = 0; ai < 2; ++ai)
#pragma unroll
            for (int m = 0; m < 4; ++m) { bf16* rowp = O + (size_t)(row0 + ai * HALF + m * 16) * PLD + col0;
#pragma unroll
                for (int bj = 0; bj < 2; ++bj) { const f32x4 v0 = acc[ai][bj][m][0], v1 = acc[ai][bj][m][1];
                    v4u w; w.x = cvt_pk_bf16(v0[0], v0[1]); w.y = cvt_pk_bf16(v0[2], v0[3]); w.z = cvt_pk_bf16(v1[0], v1[1]); w.w = cvt_pk_bf16(v1[2], v1[3]);
                    *(v4u*)(rowp + bj * HALF) = w; } }
    }
};
template <bool ADD> struct EpiGate {
    static constexpr bool PERM = true;
    bf16* O; const bf16* P; const float* bm; int gcol;
    __device__ __forceinline__ void operator()(const f32x4 (&acc)[2][2][4][2], const Unit& u, int wr, int wc, int fr, int fq) const {
        const int row0 = u.rowA + wr * 64 + fr, col0 = u.pn * BM + wc * 32 + 8 * fq;
        f32x4 bv[2][2];
#pragma unroll
        for (int bj = 0; bj < 2; ++bj)
#pragma unroll
            for (int n = 0; n < 2; ++n) bv[bj][n] = *(const f32x4*)(bm + col0 + bj * HALF + 4 * n);
#pragma unroll
        for (int ai = 0; ai < 2; ++ai)
#pragma unroll
            for (int m = 0; m < 4; ++m) { const size_t row = (size_t)(row0 + ai * HALF + m * 16);
#pragma unroll
                for (int bj = 0; bj < 2; ++bj) {
                    const v4u pg = *(const v4u*)(P + row * PLD + gcol + col0 + bj * HALF);
                    bf16* op = O + row * D + col0 + bj * HALF;
                    float g[8] = {bflo(pg.x), bfhi(pg.x), bflo(pg.y), bfhi(pg.y), bflo(pg.z), bfhi(pg.z), bflo(pg.w), bfhi(pg.w)};
                    float r[8];
#pragma unroll
                    for (int j = 0; j < 4; ++j) { r[j] = sigmoidf_(g[j] + bv[bj][0][j]) * acc[ai][bj][m][0][j]; r[4 + j] = sigmoidf_(g[4 + j] + bv[bj][1][j]) * acc[ai][bj][m][1][j]; }
                    if (ADD) { const v4u pv = *(const v4u*)op;
                        r[0] += bflo(pv.x); r[1] += bfhi(pv.x); r[2] += bflo(pv.y); r[3] += bfhi(pv.y); r[4] += bflo(pv.z); r[5] += bfhi(pv.z); r[6] += bflo(pv.w); r[7] += bfhi(pv.w); }
                    v4u w; w.x = cvt_pk_bf16(r[0], r[1]); w.y = cvt_pk_bf16(r[2], r[3]); w.z = cvt_pk_bf16(r[4], r[5]); w.w = cvt_pk_bf16(r[6], r[7]);
                    *(v4u*)op = w; } }
    }
};
struct EpiResF32 {
    static constexpr bool PERM = false;
    float* O; const float* X;
    __device__ __forceinline__ void operator()(const f32x4 (&acc)[2][2][4][2], const Unit& u, int wr, int wc, int fr, int fq) const {
        const int row0 = u.rowA + wr * 64 + fr, col0 = u.pn * BM + wc * 32 + 4 * fq;
#pragma unroll
        for (int ai = 0; ai < 2; ++ai)
#pragma unroll
            for (int m = 0; m < 4; ++m) { const size_t ro = (size_t)(row0 + ai * HALF + m * 16) * D + col0;
#pragma unroll
                for (int bj = 0; bj < 2; ++bj)
#pragma unroll
                    for (int n = 0; n < 2; ++n) *(f32x4*)(O + ro + bj * HALF + n * 16) = acc[ai][bj][m][n] + __builtin_nontemporal_load((const f32x4*)(X + ro + bj * HALF + n * 16)); }
    }
};
struct EpiGlu {
    static constexpr bool PERM = true;
    bf16* O; const float* bg; const float* bu;
    __device__ __forceinline__ void operator()(const f32x4 (&acc)[2][2][4][2], const Unit& u, int wr, int wc, int fr, int fq) const {
        const int row0 = u.rowA + wr * 64 + fr, col0 = u.pn * HALF + wc * 32 + 8 * fq;
        f32x4 gb[2], ub[2];
#pragma unroll
        for (int n = 0; n < 2; ++n) { gb[n] = *(const f32x4*)(bg + (size_t)u.e * FF + col0 + 4 * n); ub[n] = *(const f32x4*)(bu + (size_t)u.e * FF + col0 + 4 * n); }
#pragma unroll
        for (int ai = 0; ai < 2; ++ai)
#pragma unroll
            for (int m = 0; m < 4; ++m) { bf16* op = O + (size_t)(row0 + ai * HALF + m * 16) * FF + col0;
                float r[8];
#pragma unroll
                for (int n = 0; n < 2; ++n)
#pragma unroll
                    for (int j = 0; j < 4; ++j) { float g = fminf(acc[ai][0][m][n][j] + gb[n][j], 7.f); float up = fminf(fmaxf(acc[ai][1][m][n][j] + ub[n][j], -7.f), 7.f);
                        r[4 * n + j] = (up + 1.f) * g * sigmoidf_(1.702f * g); }
                v4u w; w.x = cvt_pk_bf16(r[0], r[1]); w.y = cvt_pk_bf16(r[2], r[3]); w.z = cvt_pk_bf16(r[4], r[5]); w.w = cvt_pk_bf16(r[6], r[7]);
                *(v4u*)op = w; }
    }
};

struct EpiGluQ {
    static constexpr bool PERM = true;
    unsigned char* O; const float* bg; const float* bu;
    __device__ __forceinline__ void operator()(const f32x4 (&acc)[2][2][4][2], const Unit& u, int wr, int wc, int fr, int fq) const {
        const int row0 = u.rowA + wr * 64 + fr, col0 = u.pn * HALF + wc * 32 + 8 * fq;
        f32x4 gb[2], ub[2];
#pragma unroll
        for (int n = 0; n < 2; ++n) { gb[n] = *(const f32x4*)(bg + (size_t)u.e * FF + col0 + 4 * n); ub[n] = *(const f32x4*)(bu + (size_t)u.e * FF + col0 + 4 * n); }
#pragma unroll
        for (int ai = 0; ai < 2; ++ai)
#pragma unroll
            for (int m = 0; m < 4; ++m) { unsigned char* op = O + (size_t)(row0 + ai * HALF + m * 16) * FF + col0;
                float r[8];
#pragma unroll
                for (int n = 0; n < 2; ++n)
#pragma unroll
                    for (int j = 0; j < 4; ++j) { float g = fminf(acc[ai][0][m][n][j] * WQ_INV + gb[n][j], 7.f); float up = fminf(fmaxf(acc[ai][1][m][n][j] * WQ_INV + ub[n][j], -7.f), 7.f);
                        r[4 * n + j] = (up + 1.f) * g * sigmoidf_(1.702f * g); }
                v2u w; w.x = pk4_fp8(r[0], r[1], r[2], r[3]); w.y = pk4_fp8(r[4], r[5], r[6], r[7]);
                *(v2u*)op = w; }
    }
};

template <class Epi, class Sched, int ESZ = 2, bool GATHER = false, bool ALIGN_EPI = true, bool NSPLIT = false>
__device__ __forceinline__ void gemm_phase(LAS unsigned char* lds, const Gemm g, const Sched& S, const Epi& E) {
    const int tid = threadIdx.x, wid = __builtin_amdgcn_readfirstlane(tid >> 6), lane = tid & 63, wr = wid >> 2, wc = wid & 3, fr = lane & 15, fq = lane >> 4;
    const int K = g.K, nt = K * ESZ / (BK * 2);
    unsigned voffA[2], voffB[2]; int Rst[2], Cst[2];
#pragma unroll
    for (int i = 0; i < 2; ++i) { int R, C; stage_rc(tid * 16 + i * 8192, R, C); const int Rb = Epi::PERM ? ((R & ~31) + perm32(R & 31)) : R; Rst[i] = R; Cst[i] = C * 2;
        voffA[i] = (unsigned)(R * g.lda * ESZ + C * 2); voffB[i] = (unsigned)(Rb * g.ldb * ESZ + C * 2); }
    const size_t kstep = (size_t)(BK * 2);
    const size_t hstepA = (size_t)HALF * g.lda * ESZ, hstepB = (size_t)HALF * g.ldb * ESZ;
    const unsigned ldsw = (unsigned)wid * 1024u;
    const int aoff = lds_byte(wr * 64 + fr, fq * 8), boff = lds_byte(wc * 32 + fr, fq * 8);
#define PG8_SA(b, h) (((b) * 2 + (h)) * HTB)
#define PG8_SB(b, h) ((4 + (b) * 2 + (h)) * HTB)
#define PG8_STAGE(bufoff, gbase, voff) do { _Pragma("unroll") for (int _i = 0; _i < 2; ++_i) \
        __builtin_amdgcn_global_load_lds((const unsigned*)((const char*)(gbase) + (voff)[_i]), (LAS unsigned*)(lds + (bufoff) + ldsw + _i * 8192), 16, 0, 0); } while (0)
#define PG8_GOFF(u_, v_) do { _Pragma("unroll") for (int h_ = 0; h_ < 2; ++h_) _Pragma("unroll") for (int i_ = 0; i_ < 2; ++i_) { const int rk_ = (u_).rk0 + 128 * h_ + Rst[i_]; \
        const int tok_ = rk_ < (u_).cnt ? g.list[(u_).e * 8192 + rk_] : 0; (v_)[h_][i_] = (unsigned)tok_ * (unsigned)(g.lda * ESZ) + (unsigned)Cst[i_]; } } while (0)
#define PG8_STAGE_A(bufoff, isnext, tt, h) do { if constexpr (GATHER) { unsigned vo_[2] = {(isnext) ? vN[h][0] : vA[h][0], (isnext) ? vN[h][1] : vA[h][1]}; PG8_STAGE(bufoff, (const char*)g.A + (size_t)(tt) * kstep, vo_); } \
        else PG8_STAGE(bufoff, ((isnext) ? nA : cA) + (size_t)(tt) * kstep + (size_t)(h) * hstepA, voffA); } while (0)
#define PG8_LD16(off_) (*(const LAS v4i*)(lds + (off_)))
#define PG8_LDA(dst, b, h) do { if constexpr (ESZ == 2) { _Pragma("unroll") for (int m = 0; m < 4; ++m) _Pragma("unroll") for (int k = 0; k < 2; ++k) dst[m][k] = *(const LAS bf16x8*)(lds + PG8_SA(b, h) + (k ? (aoff ^ 64) : aoff) + m * 2048); } \
        else { _Pragma("unroll") for (int m = 0; m < 4; ++m) dst##8[m] = __builtin_shufflevector(PG8_LD16(PG8_SA(b, h) + aoff + m * 2048), PG8_LD16(PG8_SA(b, h) + (aoff ^ 64) + m * 2048), 0, 1, 2, 3, 4, 5, 6, 7); } } while (0)
#define PG8_LDB(dst, b, h) do { if constexpr (ESZ == 2) { _Pragma("unroll") for (int n = 0; n < 2; ++n) _Pragma("unroll") for (int k = 0; k < 2; ++k) dst[n][k] = *(const LAS bf16x8*)(lds + PG8_SB(b, h) + (k ? (boff ^ 64) : boff) + n * 2048); } \
        else { _Pragma("unroll") for (int n = 0; n < 2; ++n) dst##8[n] = __builtin_shufflevector(PG8_LD16(PG8_SB(b, h) + boff + n * 2048), PG8_LD16(PG8_SB(b, h) + (boff ^ 64) + n * 2048), 0, 1, 2, 3, 4, 5, 6, 7); } } while (0)
#define PG8_MMA(ai, bj, At, Bt) do { __builtin_amdgcn_s_setprio(1); _Pragma("unroll") for (int m = 0; m < 4; ++m) _Pragma("unroll") for (int n = 0; n < 2; ++n) { \
        if constexpr (ESZ == 2) { _Pragma("unroll") for (int k = 0; k < 2; ++k) acc[ai][bj][m][n] = __builtin_amdgcn_mfma_f32_16x16x32_bf16(Bt[n][k], At[m][k], acc[ai][bj][m][n], 0, 0, 0); } \
        else asm volatile("s_nop 1\n\tv_mfma_scale_f32_16x16x128_f8f6f4 %0, %1, %2, %0, %3, %3 op_sel_hi:[0,0,0]" : "+v"(acc[ai][bj][m][n]) : "v"(Bt##8[n]), "v"(At##8[m]), "v"(one_scale)); } \
        __builtin_amdgcn_s_setprio(0); } while (0)
#define PG8_WAIT_V(n) asm volatile("s_waitcnt vmcnt(" #n ")" ::: "memory")
#define PG8_WAIT_L(n) asm volatile("s_waitcnt lgkmcnt(" #n ")" ::: "memory")
#define PG8_BAR __builtin_amdgcn_s_barrier()
#define PG8_SCHED __builtin_amdgcn_sched_barrier(0)
    Unit cur, nxt; int ui = 0;
    if (!S.next(0, cur)) return;
    f32x4 acc[2][2][4][2];
#pragma unroll
    for (int a = 0; a < 2; ++a)
#pragma unroll
        for (int b = 0; b < 2; ++b)
#pragma unroll
            for (int m = 0; m < 4; ++m)
#pragma unroll
                for (int n = 0; n < 2; ++n) acc[a][b][m][n] = (f32x4){0.f, 0.f, 0.f, 0.f};
    const int one_scale = 0x7F7F7F7F;
    bf16x8 At[4][2], B0[2][2], B1[2][2]; v8i At8[4], B08[2], B18[2];
    const char* cA = (const char*)g.A + (size_t)cur.rowA * g.lda * ESZ; const char* cB = (const char*)g.Bt + (size_t)cur.rowB * g.ldb * ESZ;
    unsigned vA[2][2] = {{0u, 0u}, {0u, 0u}}, vN[2][2] = {{0u, 0u}, {0u, 0u}}; const char* nA = cA;
    if constexpr (GATHER) PG8_GOFF(cur, vA);
    PG8_STAGE(PG8_SB(0, 0), cB, voffB); PG8_STAGE(PG8_SB(0, 1), cB + hstepB, voffB); PG8_STAGE_A(PG8_SA(0, 0), false, 0, 0); PG8_STAGE_A(PG8_SA(0, 1), false, 0, 1);
    if (wr == 1) PG8_BAR;
    PG8_WAIT_V(2); PG8_BAR;
    PG8_STAGE(PG8_SB(1, 0), cB + kstep, voffB); PG8_STAGE_A(PG8_SA(1, 0), false, 1, 0); PG8_STAGE(PG8_SB(1, 1), cB + hstepB + kstep, voffB);
    PG8_WAIT_V(6); PG8_BAR;
    for (;;) {
        const bool has_next = S.next(ui + 1, nxt);
        nA = has_next ? (const char*)g.A + (size_t)nxt.rowA * g.lda * ESZ : cA; const char* nB = has_next ? (const char*)g.Bt + (size_t)nxt.rowB * g.ldb * ESZ : cB;
        if constexpr (GATHER) { if (has_next) PG8_GOFF(nxt, vN); else { vN[0][0] = vA[0][0]; vN[0][1] = vA[0][1]; vN[1][0] = vA[1][0]; vN[1][1] = vA[1][1]; } }
        const bool hnz = NSPLIT && cur.hn != 0;
        for (int t = 0; t < nt; t += 2) {
            const bool last = (t == nt - 2);
            const char* b2 = last ? nB : cB + (size_t)(t + 2) * kstep; const char* b3 = b2 + kstep;
            const int t2 = last ? 0 : t + 2, t3 = last ? 1 : t + 3;
            PG8_LDB(B0, 0, 0); if (NSPLIT ? !hnz : true) PG8_LDB(B1, 0, 1); PG8_SCHED; PG8_LDA(At, 0, 0); PG8_STAGE_A(PG8_SA(1, 1), false, t + 1, 1);
            PG8_WAIT_V(8); PG8_WAIT_L(0); PG8_BAR; PG8_MMA(0, 0, At, B0); if (NSPLIT ? !hnz : true) PG8_MMA(0, 1, At, B1); PG8_BAR; PG8_SCHED;
            PG8_LDA(At, 0, 1); PG8_STAGE(PG8_SB(0, 0), b2, voffB); PG8_STAGE(PG8_SB(0, 1), b2 + hstepB, voffB); PG8_STAGE_A(PG8_SA(0, 0), last, t2, 0);
            PG8_WAIT_V(8); PG8_WAIT_L(0); PG8_BAR; PG8_MMA(1, 0, At, B0); if (NSPLIT ? !hnz : true) PG8_MMA(1, 1, At, B1); PG8_BAR; PG8_SCHED;
            PG8_LDB(B0, 1, 0); if (NSPLIT ? !hnz : true) PG8_LDB(B1, 1, 1); PG8_SCHED; PG8_LDA(At, 1, 0); PG8_STAGE_A(PG8_SA(0, 1), last, t2, 1);
            PG8_WAIT_V(8); PG8_WAIT_L(0); PG8_BAR; PG8_MMA(0, 0, At, B0); if (NSPLIT ? !hnz : true) PG8_MMA(0, 1, At, B1); PG8_BAR; PG8_SCHED;
            PG8_LDA(At, 1, 1); PG8_STAGE(PG8_SB(1, 0), b3, voffB); PG8_STAGE(PG8_SB(1, 1), b3 + hstepB, voffB); PG8_STAGE_A(PG8_SA(1, 0), last, t3, 0);
            PG8_WAIT_V(8); PG8_WAIT_L(0); PG8_BAR; PG8_MMA(1, 0, At, B0); if (NSPLIT ? !hnz : true) PG8_MMA(1, 1, At, B1); PG8_BAR; PG8_SCHED;
        }
        if constexpr (ESZ == 1) asm volatile("s_nop 15\n\ts_nop 15" ::: "memory");
        if constexpr (ALIGN_EPI) { if (wr == 0) PG8_BAR; }
        E(acc, cur, wr, wc, fr, fq);
        if (!has_next) break;
#pragma unroll
        for (int a = 0; a < 2; ++a)
#pragma unroll
            for (int b = 0; b < 2; ++b)
#pragma unroll
                for (int m = 0; m < 4; ++m)
#pragma unroll
                    for (int n = 0; n < 2; ++n) acc[a][b][m][n] = (f32x4){0.f, 0.f, 0.f, 0.f};
        cur = nxt; cA = nA; cB = nB; ++ui;
        if constexpr (GATHER) { vA[0][0] = vN[0][0]; vA[0][1] = vN[0][1]; vA[1][0] = vN[1][0]; vA[1][1] = vN[1][1]; }
        if constexpr (ALIGN_EPI) { if (wr == 1) PG8_BAR; }
    }
    PG8_WAIT_V(0);
    if constexpr (!ALIGN_EPI) { if (wr == 0) PG8_BAR; }
    PG8_BAR;
#undef PG8_SA
#undef PG8_SB
#undef PG8_STAGE
#undef PG8_LDA
#undef PG8_LD16
#undef PG8_GOFF
#undef PG8_STAGE_A
#undef PG8_LDB
#undef PG8_MMA
#undef PG8_WAIT_V
#undef PG8_WAIT_L
#undef PG8_BAR
#undef PG8_SCHED
}

typedef short s16x4 __attribute__((ext_vector_type(4)));
struct UnitF { int rowA, pn, e; const float* b0; const float* b1; };
struct GemmF { const bf16* A; int lda, K, ldbn; };
struct MoeOrderF {
    const volatile LAS int* tab; int nct, G, c; const float* w0; const float* w1; size_t estride; int cstep;
    __device__ bool next(int i, UnitF& u) const {
        const int L = i * G + c; const int total = __builtin_amdgcn_readfirstlane(tab[32]); if (L >= total) return false;
        int e = 0;
        for (; e < 31; ++e) { if (L < __builtin_amdgcn_readfirstlane(tab[e + 1])) break; }
        const int local = L - __builtin_amdgcn_readfirstlane(tab[e]); const int nt = __builtin_amdgcn_readfirstlane(tab[72 + e]);
        const int ct = local / nt, rt = local - ct * nt;
        u.rowA = __builtin_amdgcn_readfirstlane(tab[36 + e]) + rt * BM; u.pn = ct; u.e = e;
        u.b0 = w0 + (size_t)e * estride + (size_t)ct * cstep; u.b1 = w1 + (size_t)e * estride + (size_t)ct * cstep; return true;
    }
};
struct EpiGluNP {
    bf16* O; const float* bg; const float* bu;
    __device__ __forceinline__ void operator()(const f32x4 (&acc)[2][2][4][2], const UnitF& u, int wr, int wc, int fr, int fq) const {
        const int row0 = u.rowA + wr * 64 + fr, col0 = u.pn * HALF + wc * 32 + 4 * fq;
        f32x4 gb[2], ub[2];
#pragma unroll
        for (int n = 0; n < 2; ++n) { gb[n] = *(const f32x4*)(bg + (size_t)u.e * FF + col0 + 16 * n); ub[n] = *(const f32x4*)(bu + (size_t)u.e * FF + col0 + 16 * n); }
#pragma unroll
        for (int ai = 0; ai < 2; ++ai)
#pragma unroll
            for (int m = 0; m < 4; ++m) { bf16* op = O + (size_t)(row0 + ai * HALF + m * 16) * FF + col0;
#pragma unroll
                for (int n = 0; n < 2; ++n) { float r[4];
#pragma unroll
                    for (int j = 0; j < 4; ++j) { const float gg = fminf(acc[ai][0][m][n][j] + gb[n][j], 7.f); const float up = fminf(fmaxf(acc[ai][1][m][n][j] + ub[n][j], -7.f), 7.f);
                        r[j] = (up + 1.f) * gg * sigmoidf_(1.702f * gg); }
                    v2u w; w.x = cvt_pk_bf16(r[0], r[1]); w.y = cvt_pk_bf16(r[2], r[3]); *(v2u*)(op + 16 * n) = w; } }
    }
};
struct EpiBf16NP {
    bf16* O; int ldc; const float* bias; int bias_estride;
    __device__ __forceinline__ void operator()(const f32x4 (&acc)[2][2][4][2], const UnitF& u, int wr, int wc, int fr, int fq) const {
        const int row0 = u.rowA + wr * 64 + fr, col0 = u.pn * BM + wc * 32 + 4 * fq;
        f32x4 bv[2][2];
#pragma unroll
        for (int bj = 0; bj < 2; ++bj)
#pragma unroll
            for (int n = 0; n < 2; ++n) bv[bj][n] = *(const f32x4*)(bias + (size_t)u.e * bias_estride + col0 + bj * HALF + 16 * n);
#pragma unroll
        for (int ai = 0; ai < 2; ++ai)
#pragma unroll
            for (int m = 0; m < 4; ++m) { bf16* rowp = O + (size_t)(row0 + ai * HALF + m * 16) * ldc + col0;
#pragma unroll
                for (int bj = 0; bj < 2; ++bj)
#pragma unroll
                    for (int n = 0; n < 2; ++n) { const f32x4 v = acc[ai][bj][m][n] + bv[bj][n]; v2u w; w.x = cvt_pk_bf16(v[0], v[1]); w.y = cvt_pk_bf16(v[2], v[3]); *(v2u*)(rowp + bj * HALF + 16 * n) = w; } }
    }
};
template <class Epi, class Sched>
__device__ __forceinline__ void gemm_phase_f32b(LAS unsigned char* lds, const GemmF g, const Sched& S, const Epi& E) {
    const int tid = threadIdx.x, wid = __builtin_amdgcn_readfirstlane(tid >> 6), lane = tid & 63, wr = wid >> 2, wc = wid & 3, fr = lane & 15, fq = lane >> 4;
    const int K = g.K, nt = K / BK;
    unsigned voffA[2];
#pragma unroll
    for (int i = 0; i < 2; ++i) { int R, C; stage_rc(tid * 16 + i * 8192, R, C); voffA[i] = (unsigned)(R * g.lda + C) * 2u; }
    const size_t kstep = (size_t)(BK * 2);
    const size_t hstepA = (size_t)HALF * g.lda * 2;
    const unsigned ldsw = (unsigned)wid * 1024u;
    const int aoff = lds_byte(wr * 64 + fr, fq * 8);
    const int ldsb = (int)(uintptr_t)lds;
    const int q4 = (lane & 15) >> 2, p4 = lane & 3;
    const int fsw = q4 | ((fq & 1) << 2);
    int rbase[2];
#pragma unroll
    for (int n = 0; n < 2; ++n) rbase[n] = (8 * fq + q4) * 256 + ((((wc * 2) ^ fsw) ^ n) * 32) + 8 * p4;
    const int hB = wid >> 2, r0 = 2 * (wid & 3) + (lane >> 5), l31 = lane & 31;
    const int wslot = (l31 >> 2) ^ (r0 & 3);
    const int wb0 = hB * HTB + r0 * 256 + wslot * 32 + (lane & 3) * 8, wb1 = hB * HTB + r0 * 256 + (wslot ^ 4) * 32 + (lane & 3) * 8;
    const unsigned laneoffB = (unsigned)(r0 * g.ldbn + 4 * l31) * 4u;
    const size_t rstep8 = (size_t)8 * g.ldbn * 4, tstepB = (size_t)64 * g.ldbn * 4;
#define PG8_SA(b, h) (((b) * 2 + (h)) * HTB)
#define PG8_SB(b, h) ((4 + (b) * 2 + (h)) * HTB)
#define PG8_STAGE(bufoff, gbase, voff) do { _Pragma("unroll") for (int _i = 0; _i < 2; ++_i) { unsigned keep_; \
        asm volatile("s_mov_b32 %0, m0\n\ts_mov_b32 m0, %2\n\ts_nop 0\n\tglobal_load_lds_dwordx4 %1, off\n\ts_mov_b32 m0, %0" : "=&s"(keep_) \
            : "v"((const char*)(gbase) + (voff)[_i]), "s"(__builtin_amdgcn_readfirstlane(ldsb + (bufoff) + (int)ldsw + _i * 8192)) : "memory"); } } while (0)
#define PG8_LDA(dst, b, h) do { _Pragma("unroll") for (int m = 0; m < 4; ++m) _Pragma("unroll") for (int k = 0; k < 2; ++k) dst[m][k] = *(const LAS bf16x8*)(lds + PG8_SA(b, h) + (k ? (aoff ^ 64) : aoff) + m * 2048); } while (0)
#define PG8_LDBT(dst, b, h) do { _Pragma("unroll") for (int n = 0; n < 2; ++n) _Pragma("unroll") for (int k = 0; k < 2; ++k) { \
        const s16x4 lo_ = __builtin_amdgcn_ds_read_tr16_b64_v4i16((LAS s16x4*)(lds + PG8_SB(b, h) + rbase[n] + k * 8192)); \
        const s16x4 hi_ = __builtin_amdgcn_ds_read_tr16_b64_v4i16((LAS s16x4*)(lds + PG8_SB(b, h) + rbase[n] + k * 8192 + 1024)); \
        dst[n][k] = __builtin_shufflevector(lo_, hi_, 0, 1, 2, 3, 4, 5, 6, 7); } } while (0)
#define PG8_BPTR(p0, p1, tt) ((const char*)(hB ? (p1) : (p0)) + (size_t)(tt) * tstepB)
#define PG8_LOADB1(pb, i) dreg[i] = *(const f32x4*)((pb) + (size_t)(i) * rstep8 + laneoffB)
#define PG8_LOADB(p0, p1, tt) do { const char* pb_ = PG8_BPTR(p0, p1, tt); _Pragma("unroll") for (int _i = 0; _i < 8; ++_i) PG8_LOADB1(pb_, _i); } while (0)
#define PG8_WRITEB1(b, i) do { v2u pk_; pk_.x = cvt_pk_bf16(dreg[i].x, dreg[i].y); pk_.y = cvt_pk_bf16(dreg[i].z, dreg[i].w); \
        *(LAS v2u*)(lds + PG8_SB(b, 0) + (((i) & 1) ? wb1 : wb0) + (i) * 2048) = pk_; } while (0)
#define PG8_WRITEB(b) do { _Pragma("unroll") for (int _i = 0; _i < 8; ++_i) PG8_WRITEB1(b, _i); } while (0)
#define PG8_MF(ai, bj, m, At, Bt) do { _Pragma("unroll") for (int n = 0; n < 2; ++n) _Pragma("unroll") for (int k = 0; k < 2; ++k) \
        acc[ai][bj][m][n] = __builtin_amdgcn_mfma_f32_16x16x32_bf16(Bt[n][k], At[m][k], acc[ai][bj][m][n], 0, 0, 0); } while (0)
#define PG8_MMA(ai, bj, At, Bt) do { __builtin_amdgcn_s_setprio(1); _Pragma("unroll") for (int m = 0; m < 4; ++m) PG8_MF(ai, bj, m, At, Bt); __builtin_amdgcn_s_setprio(0); } while (0)
#define PG8_MMA_CVT(ai, bj, At, Bt, b) do { __builtin_amdgcn_s_setprio(1); _Pragma("unroll") for (int m = 0; m < 4; ++m) { PG8_MF(ai, bj, m, At, Bt); PG8_WRITEB1(b, 2 * m); PG8_WRITEB1(b, 2 * m + 1); PG8_SCHED; } __builtin_amdgcn_s_setprio(0); } while (0)
#define PG8_MMA_LD(ai, bj, At, Bt, pb) do { __builtin_amdgcn_s_setprio(1); _Pragma("unroll") for (int m = 0; m < 4; ++m) { PG8_MF(ai, bj, m, At, Bt); PG8_LOADB1(pb, 2 * m); PG8_LOADB1(pb, 2 * m + 1); PG8_SCHED; } __builtin_amdgcn_s_setprio(0); } while (0)
#define PG8_WAIT_V(n) asm volatile("s_waitcnt vmcnt(" #n ")" ::: "memory")
#define PG8_WAIT_L(n) asm volatile("s_waitcnt lgkmcnt(" #n ")" ::: "memory")
#define PG8_BAR __builtin_amdgcn_s_barrier()
#define PG8_SCHED __builtin_amdgcn_sched_barrier(0)
#define PG8_BS0(T) ((T) >= nt ? nb0 : cur.b0)
#define PG8_BS1(T) ((T) >= nt ? nb1 : cur.b1)
#define PG8_BT(T) ((T) >= nt ? (T) - nt : (T))
    UnitF cur, nxt; int ui = 0;
    if (!S.next(0, cur)) return;
    f32x4 acc[2][2][4][2];
#pragma unroll
    for (int a = 0; a < 2; ++a)
#pragma unroll
        for (int b = 0; b < 2; ++b)
#pragma unroll
            for (int m = 0; m < 4; ++m)
#pragma unroll
                for (int n = 0; n < 2; ++n) acc[a][b][m][n] = (f32x4){0.f, 0.f, 0.f, 0.f};
    bf16x8 At[4][2], B0[2][2], B1[2][2];
    f32x4 dreg[8];
    const char* cA = (const char*)g.A + (size_t)cur.rowA * g.lda * 2;
    PG8_STAGE(PG8_SA(0, 0), cA, voffA); PG8_STAGE(PG8_SA(0, 1), cA + hstepA, voffA); PG8_STAGE(PG8_SA(1, 0), cA + kstep, voffA);
    PG8_LOADB(cur.b0, cur.b1, 0); PG8_WRITEB(0); PG8_LOADB(cur.b0, cur.b1, 1); PG8_WRITEB(1); PG8_LOADB(cur.b0, cur.b1, 2);
    PG8_WAIT_V(8); PG8_WAIT_L(0);
    if (wr == 1) PG8_BAR;
    PG8_BAR;
    for (;;) {
        const bool has_next = S.next(ui + 1, nxt);
        const char* nA = has_next ? (const char*)g.A + (size_t)nxt.rowA * g.lda * 2 : cA;
        const float* nb0 = has_next ? nxt.b0 : cur.b0; const float* nb1 = has_next ? nxt.b1 : cur.b1;
        for (int t = 0; t < nt; t += 2) {
            const bool last = (t == nt - 2);
            const char* a1 = cA + (size_t)(t + 1) * kstep;
            const char* a2 = last ? nA : cA + (size_t)(t + 2) * kstep;
            const char* a3 = a2 + kstep;
            const char* pb3 = PG8_BPTR(PG8_BS0(t + 3), PG8_BS1(t + 3), PG8_BT(t + 3));
            const char* pb4 = PG8_BPTR(PG8_BS0(t + 4), PG8_BS1(t + 4), PG8_BT(t + 4));
            PG8_LDBT(B0, 0, 0); PG8_LDBT(B1, 0, 1); PG8_SCHED; PG8_LDA(At, 0, 0); PG8_STAGE(PG8_SA(1, 1), a1 + hstepA, voffA);
            PG8_WAIT_V(12); PG8_WAIT_L(0); PG8_SCHED; PG8_BAR; PG8_MMA(0, 0, At, B0); PG8_MMA(0, 1, At, B1); PG8_BAR; PG8_SCHED;
            PG8_LDA(At, 0, 1);
            PG8_WAIT_V(10); PG8_WAIT_L(0); PG8_SCHED; PG8_BAR; PG8_MMA_CVT(1, 0, At, B0, 0); PG8_STAGE(PG8_SA(0, 0), a2, voffA); PG8_MMA_LD(1, 1, At, B1, pb3); PG8_BAR; PG8_SCHED;
            PG8_LDBT(B0, 1, 0); PG8_LDBT(B1, 1, 1); PG8_SCHED; PG8_LDA(At, 1, 0); PG8_STAGE(PG8_SA(0, 1), a2 + hstepA, voffA);
            PG8_WAIT_V(12); PG8_WAIT_L(0); PG8_SCHED; PG8_BAR; PG8_MMA(0, 0, At, B0); PG8_MMA(0, 1, At, B1); PG8_BAR; PG8_SCHED;
            PG8_LDA(At, 1, 1);
            PG8_WAIT_V(10); PG8_WAIT_L(0); PG8_SCHED; PG8_BAR; PG8_MMA_CVT(1, 0, At, B0, 1); PG8_STAGE(PG8_SA(1, 0), a3, voffA); PG8_MMA_LD(1, 1, At, B1, pb4); PG8_BAR; PG8_SCHED;
        }
        if (wr == 0) PG8_BAR;
        E(acc, cur, wr, wc, fr, fq);
        if (!has_next) break;
#pragma unroll
        for (int a = 0; a < 2; ++a)
#pragma unroll
            for (int b = 0; b < 2; ++b)
#pragma unroll
                for (int m = 0; m < 4; ++m)
#pragma unroll
                    for (int n = 0; n < 2; ++n) acc[a][b][m][n] = (f32x4){0.f, 0.f, 0.f, 0.f};
        cur = nxt; cA = nA; ++ui;
        if (wr == 1) PG8_BAR;
    }
    PG8_WAIT_V(0);
    asm volatile("" :: "v"(dreg[0]), "v"(dreg[7]));
    PG8_BAR;
#undef PG8_SA
#undef PG8_SB
#undef PG8_STAGE
#undef PG8_LDA
#undef PG8_LDBT
#undef PG8_BPTR
#undef PG8_LOADB1
#undef PG8_LOADB
#undef PG8_WRITEB1
#undef PG8_WRITEB
#undef PG8_MF
#undef PG8_MMA
#undef PG8_MMA_CVT
#undef PG8_MMA_LD
#undef PG8_WAIT_V
#undef PG8_WAIT_L
#undef PG8_BAR
#undef PG8_SCHED
#undef PG8_BS0
#undef PG8_BS1
#undef PG8_BT
}
}

#define XB_TMO      128
#define XB_XCNT(j)  (256  + 64 * (j))
#define XB_XSUB(j)  (1280 + 64 * (j))
#define XB_XGEN(j)  (2304 + 64 * (j))
#define XB_TOP      3328
#define XB_TOPGEN   3392
#define XCD_BAR_WORDS 3456
#define XB_SPIN_CAP (1u << 18)
__device__ __forceinline__ unsigned xb_ld(unsigned* p)              { return __hip_atomic_load(p, __ATOMIC_RELAXED, __HIP_MEMORY_SCOPE_AGENT); }
__device__ __forceinline__ unsigned xb_add(unsigned* p, unsigned v) { return __hip_atomic_fetch_add(p, v, __ATOMIC_RELAXED, __HIP_MEMORY_SCOPE_AGENT); }
__device__ __forceinline__ unsigned xb_xcc_id() { return (unsigned)__builtin_amdgcn_s_getreg((3 << 11) | 20) & 0xFu; }
#define XB_SPIN(cond, bar) do { unsigned _sp = 0; while (cond) { __builtin_amdgcn_s_sleep(1); \
    if ((++_sp & 255u) == 0u) { if (xb_ld(&(bar)[XB_TMO])) break; if (_sp > XB_SPIN_CAP) { atomicAdd(&(bar)[XB_TMO], 1u); break; } } } } while (0)
struct XcdBarrier { unsigned* bar; unsigned x; volatile LAS unsigned* st; };
__device__ __forceinline__ XcdBarrier xcd_barrier_post(unsigned* bar, volatile LAS unsigned* st) {
    XcdBarrier b; b.bar = bar; b.x = xb_xcc_id(); b.st = st;
    if (threadIdx.x == 0) (void)xb_add(&bar[XB_XCNT(b.x)], 1u);
    return b;
}
__device__ __forceinline__ void xcd_barrier_complete(unsigned* bar, unsigned x, unsigned& nloc, unsigned& nx) {
    const unsigned G = gridDim.x * gridDim.y * gridDim.z;
    unsigned sum, cnt, mine, sp = 0u;
    for (;;) {
        sum = 0u; cnt = 0u; mine = 0u;
#pragma unroll
        for (unsigned j = 0; j < 16; ++j) { const unsigned c = xb_ld(&bar[XB_XCNT(j)]); sum += c; cnt += (c > 0u) ? 1u : 0u; mine = (j == x) ? c : mine; }
        if (sum == G) break;
        __builtin_amdgcn_s_sleep(1);
        if ((++sp & 255u) == 0u) { if (xb_ld(&bar[XB_TMO])) break; if (sp > XB_SPIN_CAP) { atomicAdd(&bar[XB_TMO], 1u); break; } }
    }
    nloc = mine > 0u ? mine : 1u; nx = cnt > 0u ? cnt : 1u;
}
__device__ __forceinline__ void xcd_barrier(const XcdBarrier& b) {
    asm volatile("s_waitcnt vmcnt(0)" ::: "memory");
    __syncthreads();
    if (threadIdx.x == 0) {
        unsigned* bar = b.bar;
        __builtin_amdgcn_s_waitcnt(0);
        unsigned nloc = b.st[0], nx = b.st[1];
        if (nloc == 0u) { xcd_barrier_complete(bar, b.x, nloc, nx); b.st[0] = nloc; b.st[1] = nx; }
        const unsigned old = xb_add(&bar[XB_XSUB(b.x)], 1u);
        const unsigned gen = old / nloc;
        if (old + 1u == (gen + 1u) * nloc) {
            __builtin_amdgcn_fence(__ATOMIC_RELEASE, "agent");
            asm volatile("s_waitcnt vmcnt(0)" ::: "memory");
            const unsigned og = xb_add(&bar[XB_TOP], 1u);
            const unsigned tg = og / nx;
            if (og + 1u == (tg + 1u) * nx) xb_add(&bar[XB_TOPGEN], 1u);
            else XB_SPIN(xb_ld(&bar[XB_TOPGEN]) == tg, bar);
            __builtin_amdgcn_fence(__ATOMIC_ACQUIRE, "agent");
            xb_add(&bar[XB_XGEN(b.x)], 1u);
            asm volatile("s_waitcnt vmcnt(0)" ::: "memory");
        } else {
            XB_SPIN(xb_ld(&bar[XB_XGEN(b.x)]) == gen, bar);
            __builtin_amdgcn_fence(__ATOMIC_ACQUIRE, "agent");
            asm volatile("s_waitcnt vmcnt(0)" ::: "memory");
        }
    }
    __syncthreads();
}

struct Args { const float* in[31]; float* out; unsigned char* ws; int ph_lo, ph_hi; };
enum { I_X = 0, I_NMG, I_WIN, I_MU, I_W0, I_W2, I_A0, I_A2, I_G2, I_KK, I_KA, I_RK, I_LNG, I_LNB, I_GWA2, I_GBA, I_GNG, I_BM, I_WBR, I_WBG, I_WOUT, I_NFG,
       I_WROUTER, I_BROUTER, I_WGATE, I_BGATE, I_WUP, I_BUP, I_WDOWN, I_BDOWN, I_NFINAL };
struct Frame {
    LAS unsigned char* lds; unsigned char* ws; unsigned* ctl;
    int tid, lane, wave, vcu, G;
};

__device__ __forceinline__ void tr_item(const float* W, int ldw, int nvalid, int k0, int n0, bf16* dst, int ldk, LAS float* scr, int lane) {
    const int c = lane & 31;
    const bool ok = (n0 + c) < nvalid;
#pragma unroll 8
    for (int i = 0; i < 32; ++i) { const int kk = 2 * i + (lane >> 5); scr[kk * 33 + c] = ok ? W[(size_t)(k0 + kk) * ldw + n0 + c] : 0.f; }
    LDS_WAIT(); asm volatile("" ::: "memory");
    const int c8 = lane & 7;
#pragma unroll
    for (int j = 0; j < 4; ++j) { const int n = (lane >> 3) + 8 * j; const LAS float* s = scr + (8 * c8) * 33 + n;
        v4u o; o.x = pk2(s[0 * 33], s[1 * 33]); o.y = pk2(s[2 * 33], s[3 * 33]); o.z = pk2(s[4 * 33], s[5 * 33]); o.w = pk2(s[6 * 33], s[7 * 33]);
        *(v4u*)(dst + (size_t)n * ldk + k0 + 8 * c8) = o; }
    LDS_WAIT(); asm volatile("" ::: "memory");
}
__device__ __forceinline__ void cv_load(const float* W, int ldw, int k0, int n0, int lane, f32x4 (&cr)[16]) {
    const unsigned laneoff = (unsigned)((lane >> 3) * ldw + n0 + 4 * (lane & 7)) * 4u;
#pragma unroll
    for (int i = 0; i < 16; ++i) { const char* rowp = (const char*)W + (size_t)(k0 + 8 * i) * ldw * 4; cr[i] = *(const f32x4*)(rowp + laneoff); }
}
__device__ __forceinline__ void cv_finish(const f32x4 (&cr)[16], int k0, unsigned char* dst, int ldk, LAS float* scr, int lane, float scale) {
    const int rr = lane >> 3, ch = lane & 7;
#pragma unroll
    for (int i = 0; i < 16; ++i) { LAS float* d = scr + (8 * i + rr) * 33 + 4 * ch; d[0] = cr[i].x * scale; d[1] = cr[i].y * scale; d[2] = cr[i].z * scale; d[3] = cr[i].w * scale; }
    LDS_WAIT(); asm volatile("" ::: "memory");
#pragma unroll
    for (int j = 0; j < 4; ++j) { const int n = rr + 8 * j; const LAS float* sp = scr + (16 * ch) * 33 + n;
        v4u o; o.x = pk4_fp8(sp[0 * 33], sp[1 * 33], sp[2 * 33], sp[3 * 33]); o.y = pk4_fp8(sp[4 * 33], sp[5 * 33], sp[6 * 33], sp[7 * 33]);
        o.z = pk4_fp8(sp[8 * 33], sp[9 * 33], sp[10 * 33], sp[11 * 33]); o.w = pk4_fp8(sp[12 * 33], sp[13 * 33], sp[14 * 33], sp[15 * 33]);
        *(v4u*)(dst + (size_t)n * ldk + k0 + 16 * ch) = o; }
    LDS_WAIT(); asm volatile("" ::: "memory");
}
__device__ __forceinline__ void cv_issue_dma(const float* W, int ldw, int k0, int n0, int lane, LAS float* scr) {
#pragma unroll
    for (int i = 0; i < 16; ++i) { const char* rowp = (const char*)W + (size_t)(k0 + 8 * i) * ldw * 4;
        const unsigned off = (unsigned)((lane >> 3) * ldw + n0 + 4 * ((lane & 7) ^ (i >> 1))) * 4u;
        __builtin_amdgcn_global_load_lds((const unsigned*)(rowp + off), (LAS unsigned*)(scr + i * 256), 16, 0, 2); }
}
__device__ __forceinline__ void cv_finish_dma(int k0, unsigned char* dst, int ldk, const LAS float* scr, int lane, float scale) {
    const int rr = lane >> 3, ch = lane & 7;
#pragma unroll
    for (int j = 0; j < 4; ++j) { const int n = rr + 8 * j; const LAS float* sp = scr + (16 * ch) * 32 + ((((n >> 2) ^ ch) << 2) | (n & 3));
        float f[16];
#pragma unroll
        for (int i = 0; i < 16; ++i) f[i] = sp[i * 32] * scale;
        v4u o; o.x = pk4_fp8(f[0], f[1], f[2], f[3]); o.y = pk4_fp8(f[4], f[5], f[6], f[7]); o.z = pk4_fp8(f[8], f[9], f[10], f[11]); o.w = pk4_fp8(f[12], f[13], f[14], f[15]);
        *(v4u*)(dst + (size_t)n * ldk + k0 + 16 * ch) = o; }
}
__device__ __forceinline__ void cvb_finish_dma(int k0, bf16* dst, int ldk, const LAS float* scr, int lane) {
    const int rr = lane >> 3, ch = lane & 7;
#pragma unroll
    for (int j = 0; j < 4; ++j) { const int n = rr + 8 * j; const LAS float* sp = scr + (16 * ch) * 32 + ((((n >> 2) ^ ch) << 2) | (n & 3));
        float f[16];
#pragma unroll
        for (int i = 0; i < 16; ++i) f[i] = sp[i * 32];
        v4u o0, o1; o0.x = pk2(f[0], f[1]); o0.y = pk2(f[2], f[3]); o0.z = pk2(f[4], f[5]); o0.w = pk2(f[6], f[7]); o1.x = pk2(f[8], f[9]); o1.y = pk2(f[10], f[11]); o1.z = pk2(f[12], f[13]); o1.w = pk2(f[14], f[15]);
        bf16* d = dst + (size_t)n * ldk + k0 + 16 * ch; *(v4u*)d = o0; *(v4u*)(d + 8) = o1; }
}
__device__ __forceinline__ void cvr_load(const float* W, int ldw, int k0, int n0, int lane, f32x4 (&cr)[16]) {
    const unsigned laneoff = (unsigned)((16 * (lane >> 3)) * ldw + n0 + 4 * (lane & 7)) * 4u;
#pragma unroll
    for (int i = 0; i < 16; ++i) { const char* rowp = (const char*)W + (size_t)(k0 + i) * ldw * 4; cr[i] = __builtin_nontemporal_load((const f32x4*)(rowp + laneoff)); }
}
__device__ __forceinline__ void cvr_store(const f32x4 (&cr)[16], int k0, unsigned char* dst, int ldk, int lane, float scale) {
    unsigned char* d = dst + (size_t)(4 * (lane & 7)) * ldk + k0 + 16 * (lane >> 3);
#pragma unroll
    for (int j = 0; j < 4; ++j) { v4u o;
        o.x = pk4_fp8(cr[0][j] * scale, cr[1][j] * scale, cr[2][j] * scale, cr[3][j] * scale); o.y = pk4_fp8(cr[4][j] * scale, cr[5][j] * scale, cr[6][j] * scale, cr[7][j] * scale);
        o.z = pk4_fp8(cr[8][j] * scale, cr[9][j] * scale, cr[10][j] * scale, cr[11][j] * scale); o.w = pk4_fp8(cr[12][j] * scale, cr[13][j] * scale, cr[14][j] * scale, cr[15][j] * scale);
        __builtin_nontemporal_store(o, (v4u*)(d + (size_t)j * ldk)); }
}
struct CvItem { const float* W; unsigned char* dst; int ldw, ldk, k0, n0; };
__device__ __forceinline__ CvItem cv_item(const Args& a, unsigned char* ws, int idx) {
    constexpr int I_EXP = (D / 128) * (FF / 32);
    int r = idx; const int mat = r / (NE * I_EXP); r -= mat * (NE * I_EXP); const int e = r / I_EXP; r -= e * I_EXP;
    const int kb = r / (FF / 32), nb = r % (FF / 32), n0 = 32 * nb;
    CvItem it; it.k0 = 128 * kb; it.n0 = n0;
    if (mat == 0) { it.W = a.in[I_WGATE] + (size_t)e * D * FF; it.ldw = FF; it.dst = ws + WS_WGU + ((size_t)e * 4096 + (n0 >> 7) * 256 + (n0 & 127)) * D; it.ldk = D; }
    else if (mat == 1) { it.W = a.in[I_WUP] + (size_t)e * D * FF; it.ldw = FF; it.dst = ws + WS_WGU + ((size_t)e * 4096 + (n0 >> 7) * 256 + 128 + (n0 & 127)) * D; it.ldk = D; }
    else { it.W = a.in[I_WDOWN] + (size_t)e * FF * D; it.ldw = D; it.dst = ws + WS_WD + ((size_t)e * 2048 + n0) * FF; it.ldk = FF; }
    return it;
}
constexpr int CV_ITEMS = 3 * NE * (D / 128) * (FF / 32);
constexpr int CVQ_CH = 4, CVQ_NCH = CV_ITEMS / CVQ_CH;
__device__ __forceinline__ unsigned cvq_issue(unsigned* q, int lane) { unsigned c = 0; if (lane == 0) c = __hip_atomic_fetch_add(q, 1u, RLX_AGENT); return c; }
__device__ __forceinline__ void rms_row_to_bf16(const float* xrow, const float* g, bf16* orow, int lane) {
    const f32x4* xr = (const f32x4*)xrow + lane; const f32x4* gr = (const f32x4*)g + lane;
    f32x4 v[8]; float s = 0.f;
#pragma unroll
    for (int j = 0; j < 8; ++j) { v[j] = __builtin_nontemporal_load(xr + 64 * j); s += (v[j].x * v[j].x + v[j].y * v[j].y) + (v[j].z * v[j].z + v[j].w * v[j].w); }
    const float rstd = rsqrtf(wave_sum(s) * (1.f / D) + NORM_EPS);
    v2u* o8 = (v2u*)orow + lane;
#pragma unroll
    for (int j = 0; j < 8; ++j) { const f32x4 gg = gr[64 * j]; v2u o; o.x = pk2(v[j].x * rstd * gg.x, v[j].y * rstd * gg.y); o.y = pk2(v[j].z * rstd * gg.z, v[j].w * rstd * gg.w); o8[64 * j] = o; }
}
constexpr int DT_NBF = IN_COLS / 32;
constexpr int DT_IN = (D / 128) * DT_NBF, DT_BA = (RW / 128) * (D / 32), DT_BB = DT_BA, DT_OUT = (D / 128) * (D / 32), DT_ALL = DT_IN + DT_BA + DT_BB + DT_OUT;
__device__ __forceinline__ void dense_tile(const Frame& F, const Args& a, int it, LAS float* t2) {
    bf16* Wt_in = (bf16*)(F.ws + WS_WIN); bf16* Wt_ba = (bf16*)(F.ws + WS_WBA); bf16* Wt_bb = (bf16*)(F.ws + WS_WBB); bf16* Wt_out = (bf16*)(F.ws + WS_WOUT);
    const float* W = nullptr; int ldw = 0, k0 = 0, n0 = 0, ldk = 0; bf16* dst = nullptr; int r = it;
    if (r < DT_IN) { const int kb = r / DT_NBF, nb = r % DT_NBF; W = a.in[I_WIN]; ldw = IN_COLS; k0 = 128 * kb; n0 = 32 * nb; dst = Wt_in + (size_t)n0 * DP; ldk = DP; }
    else if ((r -= DT_IN) < DT_BA) { const int kb = r / (D / 32), nb = r % (D / 32); W = a.in[I_WBR]; ldw = D; k0 = 128 * kb; n0 = 32 * nb; dst = Wt_ba + (size_t)n0 * RW; ldk = RW; }
    else if ((r -= DT_BA) < DT_BB) { const int kb = r / (D / 32), nb = r % (D / 32); W = a.in[I_WBG]; ldw = D; k0 = 128 * kb; n0 = 32 * nb; dst = Wt_bb + (size_t)n0 * GVW; ldk = GVW; }
    else { r -= DT_BB; const int kb = r / (D / 32), nb = r % (D / 32); W = a.in[I_WOUT]; ldw = D; k0 = 128 * kb; n0 = 32 * nb; dst = Wt_out + (size_t)n0 * D; ldk = D; }
    cv_issue_dma(W, ldw, k0, n0, F.lane, t2);
    asm volatile("s_waitcnt vmcnt(0)" ::: "memory");
    cvb_finish_dma(k0, dst, ldk, t2, F.lane); asm volatile("s_waitcnt lgkmcnt(0)" ::: "memory");
}
__device__ __forceinline__ void p0_prologue(const Frame& F, const Args& a) {
    LAS float* scr = (LAS float*)(F.lds + F.wave * 16896);
    const int gw = F.vcu * 8 + F.wave, NGW = F.G * 8;
    bf16* Wt_in = (bf16*)(F.ws + WS_WIN); bf16* Wt_ba = (bf16*)(F.ws + WS_WBA); bf16* Wt_bb = (bf16*)(F.ws + WS_WBB); bf16* Wt_out = (bf16*)(F.ws + WS_WOUT);
    constexpr int NB_IN = PLD / 32;
    constexpr int I_IN = (D / 64) * NB_IN, I_BA = (RW / 64) * (D / 32), I_BB = I_BA, I_OUT = (D / 64) * (D / 32);
    constexpr int NITEMS = I_IN + I_BA + I_BB + I_OUT;
    {
        constexpr int NBF = DT_NBF;
        LAS float* t2 = (LAS float*)(F.lds + F.wave * 16384);
        const int ntile = (F.G == 256) ? DT_IN : DT_ALL;
        for (int it = gw; it < ntile; it += NGW) dense_tile(F, a, it, t2);
        __syncthreads();
        for (int it = gw; it < (D / 64) * 2; it += NGW) { const int kb = it >> 1, nb = NBF + (it & 1); tr_item(a.in[I_WIN], IN_COLS, IN_COLS, 64 * kb, 32 * nb, Wt_in + (size_t)(32 * nb) * DP, DP, scr, F.lane); }
    }
    bf16* Hh = (bf16*)(F.ws + WS_H);
    for (int m = gw; m < T; m += NGW) rms_row_to_bf16(a.in[I_X] + (size_t)m * D, a.in[I_NMG], Hh + (size_t)m * DP, F.lane);
    const int gt = F.vcu * 512 + F.tid, NGT = F.G * 512;
    bf16* Wl_wa = (bf16*)(F.ws + WS_WLWA); bf16* Wl_g = (bf16*)(F.ws + WS_WLG);
    for (int i = gt; i < 2048 * 256; i += NGT) { const int n = i >> 8, k = i & 255; float v = 0.f;
        if (n < 1024) { if (k < DLORA) v = a.in[I_W2][(size_t)k * RW + n]; } else { if (k >= DLORA && k < 2 * DLORA) v = a.in[I_A2][(size_t)(k - DLORA) * RW + (n - 1024)]; }
        Wl_wa[i] = (bf16)f2bf(v); }
    for (int i = gt; i < 1024 * 256; i += NGT) { const int n = i >> 8, k = i & 255; Wl_g[i] = (bf16)f2bf(a.in[I_G2][(size_t)k * RW + n]); }
    float* Wr = (float*)(F.ws + WS_WR);
    for (int i = gt; i < 8 * 32 * 64 * 4; i += NGT) { const int ii = i & 3, l = (i >> 2) & 63, e = (i >> 8) & 31, j = i >> 13; const int k = 256 * j + 4 * l + ii;
        Wr[i] = a.in[I_NFG][k] * a.in[I_WROUTER][(size_t)k * NE + e]; }
}

__device__ __forceinline__ void cv_queue_run(const Frame& F, const Args& a, unsigned* stop) {
    unsigned* q = F.ctl + CW_CVQ; const int lane = F.lane;
    f32x4 ca[16], cb[16];
    int cur = __builtin_amdgcn_readfirstlane((int)cvq_issue(q, lane)); unsigned nraw = cvq_issue(q, lane); int pos = 0; bool stopped = false;
#define CVQ_NEXT(idx) do { if (pos == CVQ_CH) { cur = __builtin_amdgcn_readfirstlane((int)nraw); pos = 0; \
        if (stop && !stopped && __hip_atomic_load(stop, RLX_AGENT) != 0u) stopped = true; \
        nraw = stopped ? 0x7fffffffu : cvq_issue(q, lane); } \
        idx = cur < CVQ_NCH ? cur * CVQ_CH + pos++ : -1; } while (0)
    int xa, xb; CvItem ia, ib;
    CVQ_NEXT(xa); if (xa < 0) return;
    ia = cv_item(a, F.ws, xa); cvr_load(ia.W, ia.ldw, ia.k0, ia.n0, lane, ca);
    CVQ_NEXT(xb); ib = ia; if (xb >= 0) { ib = cv_item(a, F.ws, xb); cvr_load(ib.W, ib.ldw, ib.k0, ib.n0, lane, cb); }
    while (xa >= 0) {
        cvr_store(ca, ia.k0, ia.dst, ia.ldk, lane, WQ_SCALE);
        xa = -1; if (xb >= 0) { CVQ_NEXT(xa); if (xa >= 0) { ia = cv_item(a, F.ws, xa); cvr_load(ia.W, ia.ldw, ia.k0, ia.n0, lane, ca); } }
        if (xb >= 0) { cvr_store(cb, ib.k0, ib.dst, ib.ldk, lane, WQ_SCALE);
            xb = -1; if (xa >= 0) { CVQ_NEXT(xb); if (xb >= 0) { ib = cv_item(a, F.ws, xb); cvr_load(ib.W, ib.ldw, ib.k0, ib.n0, lane, cb); } } }
    }
#undef CVQ_NEXT
}
constexpr int CVW_SH = 3;
__device__ __forceinline__ void p1_gemm_in(const Frame& F, const Args& a) {
    const bool split = (F.G == 256);
    const int bx = (int)blockIdx.x, grp = bx >> 3;
    if (split && (grp & ((1 << CVW_SH) - 1)) == (1 << CVW_SH) - 1) {
        constexpr int NCW = (256 >> CVW_SH) * 8;
        const int cw = ((grp >> CVW_SH) * 8 + (bx & 7)) * 8 + F.wave; LAS float* t2 = (LAS float*)(F.lds + F.wave * 16384);
        for (int it = DT_IN + cw; it < DT_ALL; it += NCW) dense_tile(F, a, it, t2);
        cv_queue_run(F, a, F.ctl + CW_CVSTOP); return; }
    pg8::Gemm g{(const bf16*)(F.ws + WS_H), (const bf16*)(F.ws + WS_WIN), DP, DP, D, nullptr}; pg8::StaticOrder S;
    if (split) S.init(T, PLD, 256 - (256 >> CVW_SH), (grp - (grp >> CVW_SH)) * 8 + (bx & 7)); else S.init(T, PLD, F.G, bx);
    pg8::EpiBf16 E{(bf16*)(F.ws + WS_P), PLD, nullptr, 0, 1.f};
    pg8::gemm_phase(F.lds, g, S, E);
    if (F.tid == 0) __hip_atomic_fetch_add(F.ctl + CW_CVSTOP, 1u, RLX_AGENT);
}
__device__ __forceinline__ void p2_lora_in(const Frame& F, const Args& a) {
    const int gw = F.vcu * 8 + F.wave, NGW = F.G * 8, lane = F.lane;
    const bf16* P = (const bf16*)(F.ws + WS_P); bf16* A2 = (bf16*)(F.ws + WS_A2);
    const int kind = lane < 12 ? 0 : (lane < 24 ? 1 : (lane < 32 ? 2 : 3));
    const int src = lane < 24 ? (C_WL + 8 * lane) : (C_GL + 8 * (lane - 32));
    float mu[8];
    if (kind != 2) {
#pragma unroll
        for (int j = 0; j < 8; ++j) mu[j] = a.in[I_MU][src + j];
    }
    for (int t = gw; t < T; t += NGW) {
        v4u o = {0u, 0u, 0u, 0u};
        if (kind != 2) {
            const v4u c = *(const v4u*)(P + (size_t)t * PLD + src);
            v4u pv = {0u, 0u, 0u, 0u};
            if ((t & (SEQ - 1)) != 0) pv = *(const v4u*)(P + (size_t)(t - 1) * PLD + src);
            float x[8] = {bflo(c.x), bfhi(c.x), bflo(c.y), bfhi(c.y), bflo(c.z), bfhi(c.z), bflo(c.w), bfhi(c.w)};
            float q[8] = {bflo(pv.x), bfhi(pv.x), bflo(pv.y), bfhi(pv.y), bflo(pv.z), bfhi(pv.z), bflo(pv.w), bfhi(pv.w)};
#pragma unroll
            for (int j = 0; j < 8; ++j) { float m = x[j] + (q[j] - x[j]) * mu[j]; x[j] = kind == 0 ? tanhf(m) : (kind == 1 ? m : sigmoidf_(m)); }
            o.x = pk2(x[0], x[1]); o.y = pk2(x[2], x[3]); o.z = pk2(x[4], x[5]); o.w = pk2(x[6], x[7]);
        }
        *(v4u*)(A2 + (size_t)t * 512 + 8 * lane) = o;
    }
}

#define DPPF(x, ctrl) __builtin_bit_cast(float, __builtin_amdgcn_update_dpp(0, __builtin_bit_cast(int, (x)), (ctrl), 0xF, 0xF, false))
__device__ __forceinline__ float dpp_sum16(float x) { x += DPPF(x, 0xB1); x += DPPF(x, 0x4E); x += DPPF(x, 0x141); x += DPPF(x, 0x140); return x; }
__device__ __forceinline__ float wave_sum_dpp(float x) {
    x = dpp_sum16(x); const int xi = __builtin_bit_cast(int, x);
    return (__builtin_bit_cast(float, __builtin_amdgcn_readlane(xi, 0)) + __builtin_bit_cast(float, __builtin_amdgcn_readlane(xi, 16))) +
           (__builtin_bit_cast(float, __builtin_amdgcn_readlane(xi, 32)) + __builtin_bit_cast(float, __builtin_amdgcn_readlane(xi, 48)));
}
__device__ __forceinline__ float quad_sum(float x) { x += DPPF(x, 0xB1); x += DPPF(x, 0x4E); return x; }
__device__ __forceinline__ void unpack8(const v4u u, float (&f)[8]) { f[0] = bflo(u.x); f[1] = bfhi(u.x); f[2] = bflo(u.y); f[3] = bfhi(u.y); f[4] = bflo(u.z); f[5] = bfhi(u.z); f[6] = bflo(u.w); f[7] = bfhi(u.w); }
__device__ __forceinline__ v4u pack8(const float (&f)[8]) { v4u u; u.x = pk2(f[0], f[1]); u.y = pk2(f[2], f[3]); u.z = pk2(f[4], f[5]); u.w = pk2(f[6], f[7]); return u; }
__device__ __forceinline__ void p4_rwkv_prep(const Frame& F, const Args& a) {
    const int gw = F.vcu * 8 + F.wave, NGW = F.G * 8, lane = F.lane;
    const bf16* P = (const bf16*)(F.ws + WS_P); const bf16* WA = (const bf16*)(F.ws + WS_WAO); bf16* SC = (bf16*)(F.ws + WS_SCAN); float* BON = (float*)(F.ws + WS_BON);
    const int h = lane >> 2, q = lane & 3, c0 = h * RN + 16 * q;
    for (int t = gw; t < T; t += NGW) {
        const bool first = (t & (SEQ - 1)) == 0;
        const bf16* pr = P + (size_t)t * PLD + c0; const bf16* pp = first ? pr : pr - PLD;
        v4u ur[2], uk[2], uv[2], ur1[2], uk1[2], uv1[2], uw[2], ua[2];
#pragma unroll
        for (int j = 0; j < 2; ++j) { ur[j] = *(const v4u*)(pr + C_R + 8 * j); uk[j] = *(const v4u*)(pr + C_K + 8 * j); uv[j] = *(const v4u*)(pr + C_V + 8 * j);
            ur1[j] = *(const v4u*)(pp + C_R + 8 * j); uk1[j] = *(const v4u*)(pp + C_K + 8 * j); uv1[j] = *(const v4u*)(pp + C_V + 8 * j);
            uw[j] = __builtin_nontemporal_load((const v4u*)(WA + (size_t)t * 2048 + c0 + 8 * j)); ua[j] = __builtin_nontemporal_load((const v4u*)(WA + (size_t)t * 2048 + 1024 + c0 + 8 * j)); }
        float r[2][8], k[2][8], v[2][8], kk[2][8], dec[2][8], aa[2][8];
        float n2 = 0.f;
#pragma unroll
        for (int j = 0; j < 2; ++j) { float x[8], x1[8], wv[8], av[8];
            unpack8(ur[j], x); unpack8(ur1[j], x1);
#pragma unroll
            for (int i = 0; i < 8; ++i) { const float m = a.in[I_MU][C_R + c0 + 8 * j + i]; r[j][i] = x[i] + ((first ? 0.f : x1[i]) - x[i]) * m; }
            unpack8(uk[j], x); unpack8(uk1[j], x1);
#pragma unroll
            for (int i = 0; i < 8; ++i) { const float m = a.in[I_MU][C_K + c0 + 8 * j + i]; k[j][i] = x[i] + ((first ? 0.f : x1[i]) - x[i]) * m; }
            unpack8(uv[j], x); unpack8(uv1[j], x1);
#pragma unroll
            for (int i = 0; i < 8; ++i) { const float m = a.in[I_MU][C_V + c0 + 8 * j + i]; v[j][i] = x[i] + ((first ? 0.f : x1[i]) - x[i]) * m; }
            unpack8(uw[j], wv); unpack8(ua[j], av);
#pragma unroll
            for (int i = 0; i < 8; ++i) { const int c = c0 + 8 * j + i;
                dec[j][i] = __expf(-0.60653066f * sigmoidf_(a.in[I_W0][c] + wv[i]));
                aa[j][i] = sigmoidf_(a.in[I_A0][c] + av[i]);
                const float kq = k[j][i] * a.in[I_KK][c]; kk[j][i] = kq; n2 += kq * kq; } }
        n2 = quad_sum(n2);
        const float inv = rsqrtf(fmaxf(n2, 1e-24f));
        float bon = 0.f; float o0[2][8], o2[2][8], o3[2][8];
#pragma unroll
        for (int j = 0; j < 2; ++j)
#pragma unroll
            for (int i = 0; i < 8; ++i) { const int c = c0 + 8 * j + i; const float kn = kk[j][i] * inv; const float kf = k[j][i] * (1.f + (aa[j][i] - 1.f) * a.in[I_KA][c]);
                o0[j][i] = -kn; o2[j][i] = kn * aa[j][i]; o3[j][i] = kf; bon += r[j][i] * kf * a.in[I_RK][c]; }
        bon = quad_sum(bon);
        const int bh = (t >> 11) * RH + h, ts = t & (SEQ - 1);
        bf16* o = SC + ((size_t)(bh * SEQ + ts) * 6) * 64 + 16 * q;
#pragma unroll
        for (int j = 0; j < 2; ++j) { *(v4u*)(o + 8 * j) = pack8(o0[j]); *(v4u*)(o + 64 + 8 * j) = pack8(dec[j]); *(v4u*)(o + 128 + 8 * j) = pack8(o2[j]);
            *(v4u*)(o + 192 + 8 * j) = pack8(o3[j]); *(v4u*)(o + 256 + 8 * j) = pack8(r[j]); *(v4u*)(o + 320 + 8 * j) = pack8(v[j]); }
        if (q == 0) BON[(size_t)t * RH + h] = bon;
    }
}
__device__ __forceinline__ void p5_rwkv_scan(const Frame& F, const Args& a) {
    constexpr int TB = 16, NBLK = SEQ / TB, STF = 384, BLKF = TB * STF;
    const bf16* SC = (const bf16*)(F.ws + WS_SCAN); float* YR = (float*)(F.ws + WS_YRAW);
    LAS float* buf = (LAS float*)F.lds;
    volatile LAS int* hs = (volatile LAS int*)(F.lds + MOE_OFF + 2048);
    const int lane = F.lane;
    for (int u = F.vcu; u < 256; u += F.G) {
        const int bh = u >> 2, vg = u & 3, b = bh >> 4, h = bh & 15;
        const int role = F.wave < 4 ? 0 : (F.wave == 4 ? 1 : 2);
        const int cw = F.wave - 5;
        const bf16* src = SC + (size_t)bh * SEQ * STF;
        const int rl = lane >> 4, kq = lane & 15, row = 16 * vg + 4 * F.wave + rl;
        __syncthreads();
        if (F.tid < 8) hs[F.tid] = 0;
        __syncthreads();
#define HS_WAIT(cond) do { unsigned sp_ = 0; while (!(cond)) { __builtin_amdgcn_s_sleep(1); if (++sp_ > (1u << 24)) break; } asm volatile("" ::: "memory"); } while (0)
        if (role == 1) {
            v4u xb[12];
            { const v4u* s4 = (const v4u*)src;
#pragma unroll
              for (int i = 0; i < 12; ++i) xb[i] = s4[lane + 64 * i]; }
            for (int m = 0; m < NBLK; ++m) {
                if (m >= 4) HS_WAIT(hs[1] >= m - 3 && hs[2] >= m - 3 && hs[3] >= m - 3 && hs[4] >= m - 3);
                LAS f32x4* d4 = (LAS f32x4*)(buf + (m & 3) * BLKF);
#pragma unroll
                for (int i = 0; i < 12; ++i) { const int c = lane + 64 * i;
                    d4[2 * c] = (f32x4){bflo(xb[i].x), bfhi(xb[i].x), bflo(xb[i].y), bfhi(xb[i].y)}; d4[2 * c + 1] = (f32x4){bflo(xb[i].z), bfhi(xb[i].z), bflo(xb[i].w), bfhi(xb[i].w)}; }
                asm volatile("s_waitcnt lgkmcnt(0)" ::: "memory");
                if (lane == 0) hs[0] = m + 1;
                if (m + 1 < NBLK) { const v4u* s4 = (const v4u*)(src + (size_t)(m + 1) * BLKF);
#pragma unroll
                    for (int i = 0; i < 12; ++i) xb[i] = s4[lane + 64 * i]; }
            }
        } else if (role == 2) {
            cv_queue_run(F, a, nullptr);
        } else {
            float S0 = 0.f, S1 = 0.f, S2 = 0.f, S3 = 0.f;
            for (int n = 0; n < NBLK; ++n) {
                HS_WAIT(hs[0] >= n + 1);
                const LAS float* bb = buf + (n & 3) * BLKF;
                float* yo = YR + ((size_t)(b * SEQ + n * TB)) * RW + h * RN + row;
                f32x4 al = *(const LAS f32x4*)(bb + 4 * kq), w = *(const LAS f32x4*)(bb + 64 + 4 * kq), be = *(const LAS f32x4*)(bb + 128 + 4 * kq);
                f32x4 kf = *(const LAS f32x4*)(bb + 192 + 4 * kq), r = *(const LAS f32x4*)(bb + 256 + 4 * kq); float vv = bb[320 + row];
                float ykeep = 0.f, yp = 0.f;
#pragma unroll
                for (int j = 0; j < TB; ++j) {
                    f32x4 al_n = al, w_n = w, be_n = be, kf_n = kf, r_n = r; float vv_n = vv;
                    if (j + 1 < TB) { const LAS float* st = bb + (j + 1) * STF;
                        al_n = *(const LAS f32x4*)(st + 4 * kq); w_n = *(const LAS f32x4*)(st + 64 + 4 * kq); be_n = *(const LAS f32x4*)(st + 128 + 4 * kq);
                        kf_n = *(const LAS f32x4*)(st + 192 + 4 * kq); r_n = *(const LAS f32x4*)(st + 256 + 4 * kq); vv_n = st[320 + row]; }
                    float sa = (S0 * al.x + S1 * al.y) + (S2 * al.z + S3 * al.w);
                    float yq = yp;
                    sa += DPPF(sa, 0xB1); if (j > 0) yq += DPPF(yq, 0xB1);
                    sa += DPPF(sa, 0x4E); if (j > 0) yq += DPPF(yq, 0x4E);
                    sa += DPPF(sa, 0x141); if (j > 0) yq += DPPF(yq, 0x141);
                    sa += DPPF(sa, 0x140); if (j > 0) yq += DPPF(yq, 0x140);
                    if (j > 0) ykeep = __builtin_bit_cast(float, __builtin_amdgcn_update_dpp(__builtin_bit_cast(int, yq), __builtin_bit_cast(int, ykeep), 0x111, 0xF, 0xF, false));
                    S0 = S0 * w.x + (sa * be.x + vv * kf.x); S1 = S1 * w.y + (sa * be.y + vv * kf.y);
                    S2 = S2 * w.z + (sa * be.z + vv * kf.z); S3 = S3 * w.w + (sa * be.w + vv * kf.w);
                    yp = (S0 * r.x + S1 * r.y) + (S2 * r.z + S3 * r.w);
                    al = al_n; w = w_n; be = be_n; kf = kf_n; r = r_n; vv = vv_n;
                }
                const float yl = dpp_sum16(yp);
                ykeep = __builtin_bit_cast(float, __builtin_amdgcn_update_dpp(__builtin_bit_cast(int, yl), __builtin_bit_cast(int, ykeep), 0x111, 0xF, 0xF, false));
                yo[(size_t)(TB - 1 - kq) * RW] = ykeep;
                asm volatile("s_waitcnt lgkmcnt(0)" ::: "memory");
                if (lane == 0) hs[1 + F.wave] = n + 1;
            }
            __builtin_amdgcn_s_setprio(0);
        }
#undef HS_WAIT
        __syncthreads();
    }
    if (F.G != 256) { LAS float* scr = (LAS float*)(F.lds + F.wave * 16896); __syncthreads();
        for (int it = F.vcu * 8 + F.wave; it < CV_ITEMS; it += F.G * 8) { const CvItem c2 = cv_item(a, F.ws, it); f32x4 c3[16]; cv_load(c2.W, c2.ldw, c2.k0, c2.n0, lane, c3); cv_finish(c3, c2.k0, c2.dst, c2.ldk, scr, lane, WQ_SCALE); } }
}

__device__ __forceinline__ void p6_rwkv_post(const Frame& F, const Args& a) {
    const int gw = F.vcu * 8 + F.wave, NGW = F.G * 8, lane = F.lane;
    const bf16* SC = (const bf16*)(F.ws + WS_SCAN); const float* YR = (const float*)(F.ws + WS_YRAW); const float* BON = (const float*)(F.ws + WS_BON);
    const bf16* GO = (const bf16*)(F.ws + WS_GO); bf16* YA = (bf16*)(F.ws + WS_YA);
    const int h = lane >> 2, q = lane & 3, c0 = h * RN + 16 * q;
    f32x4 lg[4], lb[4];
#pragma unroll
    for (int j = 0; j < 4; ++j) { lg[j] = *(const f32x4*)(a.in[I_LNG] + c0 + 4 * j); lb[j] = *(const f32x4*)(a.in[I_LNB] + c0 + 4 * j); }
    for (int t = gw; t < T; t += NGW) {
        const int bh = (t >> 11) * RH + h, ts = t & (SEQ - 1);
        f32x4 y[4]; v4u uv[2], ug[2];
#pragma unroll
        for (int j = 0; j < 4; ++j) y[j] = __builtin_nontemporal_load((const f32x4*)(YR + (size_t)t * RW + c0 + 4 * j));
#pragma unroll
        for (int j = 0; j < 2; ++j) { uv[j] = *(const v4u*)(SC + ((size_t)(bh * SEQ + ts) * 6 + 5) * 64 + 16 * q + 8 * j); ug[j] = *(const v4u*)(GO + (size_t)t * RW + c0 + 8 * j); }
        const float bo = BON[(size_t)t * RH + h];
        float s = 0.f;
#pragma unroll
        for (int j = 0; j < 4; ++j) s += (y[j].x + y[j].y) + (y[j].z + y[j].w);
        const float mean = quad_sum(s) * (1.f / RN);
        float s2 = 0.f;
#pragma unroll
        for (int j = 0; j < 4; ++j) { y[j] = y[j] - mean; s2 += (y[j].x * y[j].x + y[j].y * y[j].y) + (y[j].z * y[j].z + y[j].w * y[j].w); }
        const float rstd = rsqrtf(quad_sum(s2) * (1.f / RN) + GN_EPS);
        float vv[2][8], gg[2][8], o[2][8];
        unpack8(uv[0], vv[0]); unpack8(uv[1], vv[1]); unpack8(ug[0], gg[0]); unpack8(ug[1], gg[1]);
#pragma unroll
        for (int j = 0; j < 4; ++j)
#pragma unroll
            for (int i = 0; i < 4; ++i) o[j >> 1][4 * (j & 1) + i] = (y[j][i] * rstd * lg[j][i] + lb[j][i] + bo * vv[j >> 1][4 * (j & 1) + i]) * gg[j >> 1][4 * (j & 1) + i];
        *(v4u*)(YA + (size_t)t * RW + c0) = pack8(o[0]); *(v4u*)(YA + (size_t)t * RW + c0 + 8) = pack8(o[1]);
    }
}

constexpr int G_BC = 0;
constexpr int G_ALF = 32768;
constexpr int G_RED = 36864;
constexpr int G_TOT = 38912;
constexpr int G_QT = 40960;
constexpr int G_KT = 58368;
constexpr int G_VT = 76800;
constexpr int G_AT = 113664;
__device__ __forceinline__ void gla_bcum(const Frame& F, const Args& a, const bf16* P, int t0, int h) {
    LAS float* bc = (LAS float*)(F.lds + G_BC); LAS float* alf = (LAS float*)(F.lds + G_ALF); LAS float* tot = (LAS float*)(F.lds + G_TOT);
    const int tid = F.tid;
    __syncthreads();
    { const int j = tid >> 3, i2 = (tid & 7) * 2; const unsigned u = *(const unsigned*)(P + (size_t)(t0 + j) * PLD + C_GAL + i2); alf[j * 16 + i2] = bflo(u); alf[j * 16 + i2 + 1] = bfhi(u); }
    const int d = tid & 127, jq = tid >> 7, hd = h * GDK + d;
    float wv[16];
#pragma unroll
    for (int i = 0; i < 16; ++i) wv[i] = a.in[I_GWA2][(size_t)i * GKW + hd];
    const float bb = a.in[I_GBA][hd];
    __syncthreads();
    float run = 0.f;
    for (int jj = 0; jj < 16; ++jj) { const int j = jq * 16 + jj; float x = bb;
#pragma unroll
        for (int i = 0; i < 16; ++i) x += alf[j * 16 + i] * wv[i];
        run += -softplusf_(-x) * (1.f / 16.f); bc[j * 128 + d] = run; }
    tot[jq * 128 + d] = run;
    __syncthreads();
    float pre = 0.f;
    for (int q = 0; q < jq; ++q) pre += tot[q * 128 + d];
    if (jq > 0) { for (int jj = 0; jj < 16; ++jj) bc[(jq * 16 + jj) * 128 + d] += pre; }
    __syncthreads();
}
constexpr int G_VP = 264, G_KP = 136;
__device__ __forceinline__ void gla_stage_v(const Frame& F, const bf16* P, int t0, int h) {
    LAS bf16* VR = (LAS bf16*)(F.lds + G_VT);
    const int j = F.tid >> 3, e0 = (F.tid & 7) * 32;
    const bf16* src = P + (size_t)(t0 + j) * PLD + C_GV + h * GDV + e0;
#pragma unroll
    for (int q = 0; q < 4; ++q) *(LAS v4u*)(VR + j * G_VP + e0 + 8 * q) = *(const v4u*)(src + 8 * q);
}
typedef short s16x4g __attribute__((ext_vector_type(4)));
__device__ __forceinline__ bf16x8 tr_frag(const LAS bf16* img, int pitch, int row0, int col0, int lane) {
    const LAS bf16* p = img + (row0 + 8 * (lane >> 4) + ((lane & 15) >> 2)) * pitch + col0 + 4 * (lane & 3);
    const s16x4g lo = __builtin_amdgcn_ds_read_tr16_b64_v4i16((LAS s16x4g*)p);
    const s16x4g hi = __builtin_amdgcn_ds_read_tr16_b64_v4i16((LAS s16x4g*)(p + 4 * pitch));
    return __builtin_shufflevector(lo, hi, 0, 1, 2, 3, 4, 5, 6, 7);
}
#define MMA16(a_, b_, c_) __builtin_amdgcn_mfma_f32_16x16x32_bf16(a_, b_, c_, 0, 0, 0)
__device__ __forceinline__ void gla_pass_a(const Frame& F, const Args& a) {
    const bf16* P = (const bf16*)(F.ws + WS_P); bf16* HT = (bf16*)(F.ws + WS_GHT); float* DEC = (float*)(F.ws + WS_GDEC);
    LAS float* bc = (LAS float*)(F.lds + G_BC); LAS bf16* KH = (LAS bf16*)(F.lds + G_KT); LAS bf16* VR = (LAS bf16*)(F.lds + G_VT);
    const int fr = F.lane & 15, fq = F.lane >> 4;
    for (int it = F.vcu; it < BATCH * GH * NCH; it += F.G) {
        const int c = it & 31, h = (it >> 5) & 3, b = it >> 7, t0 = b * SEQ + c * CHUNK;
        gla_bcum(F, a, P, t0, h);
        if (F.tid < 128) DEC[(size_t)it * 128 + F.tid] = __expf(bc[63 * 128 + F.tid]);
        { f32x4* gbc = (f32x4*)(F.ws + WS_GBC) + (size_t)it * 2048;
#pragma unroll
          for (int i = 0; i < 4; ++i) gbc[F.tid + 512 * i] = ((const LAS f32x4*)bc)[F.tid + 512 * i]; }
        { const int j = F.tid >> 3, d0 = (F.tid & 7) * 16; const bf16* src = P + (size_t)(t0 + j) * PLD + C_GK + h * GDK + d0;
#pragma unroll
          for (int q = 0; q < 2; ++q) { const v4u u = *(const v4u*)(src + 8 * q); float kv[8]; unpack8(u, kv);
#pragma unroll
            for (int i = 0; i < 8; ++i) { const int d = d0 + 8 * q + i; kv[i] *= __expf(bc[63 * 128 + d] - bc[j * 128 + d]); }
            *(LAS v4u*)(KH + j * G_KP + d0 + 8 * q) = pack8(kv); } }
        gla_stage_v(F, P, t0, h);
        __syncthreads();
        f32x4 acc[8][2];
#pragma unroll
        for (int m = 0; m < 8; ++m)
#pragma unroll
            for (int n = 0; n < 2; ++n) acc[m][n] = (f32x4){0.f, 0.f, 0.f, 0.f};
#pragma unroll
        for (int ks = 0; ks < 2; ++ks) {
            bf16x8 vf[2];
#pragma unroll
            for (int n = 0; n < 2; ++n) vf[n] = tr_frag(VR, G_VP, ks * 32, F.wave * 32 + n * 16, F.lane);
#pragma unroll
            for (int m = 0; m < 8; ++m) { const bf16x8 kf = tr_frag(KH, G_KP, ks * 32, m * 16, F.lane);
#pragma unroll
                for (int n = 0; n < 2; ++n) acc[m][n] = MMA16(kf, vf[n], acc[m][n]); }
        }
        bf16* o = HT + (size_t)it * (GDV * GDK);
#pragma unroll
        for (int m = 0; m < 8; ++m)
#pragma unroll
            for (int n = 0; n < 2; ++n) { v2u pk; pk.x = pk2(acc[m][n][0], acc[m][n][1]); pk.y = pk2(acc[m][n][2], acc[m][n][3]); *(v2u*)(o + (size_t)(F.wave * 32 + n * 16 + fr) * GDK + m * 16 + 4 * fq) = pk; }
    }
}
__device__ __forceinline__ void gla_pass_b(const Frame& F, int lo, int hi, int wg, int nwg) {
    const bf16* HT = (const bf16*)(F.ws + WS_GHT); const float* DEC = (const float*)(F.ws + WS_GDEC); bf16* ST = (bf16*)(F.ws + WS_GST);
    const int gt = wg * 512 + F.tid, NGT = nwg * 512;
    for (int i = (lo >> 1) + gt; i < (hi >> 1); i += NGT) {
        const int bh = i >> 14, ed = (i & 16383) * 2, d = ed & 127;
        float s0 = 0.f, s1 = 0.f;
#pragma unroll 8
        for (int c = 0; c < NCH; ++c) { const size_t it = (size_t)bh * NCH + c;
            const unsigned hv = __builtin_nontemporal_load((const unsigned*)(HT + it * (GDV * GDK) + ed)); const float d0 = DEC[it * 128 + d], d1 = DEC[it * 128 + d + 1];
            *(unsigned*)(ST + it * (GDV * GDK) + ed) = pk2(s0, s1);
            s0 = s0 * d0 + bflo(hv); s1 = s1 * d1 + bfhi(hv); }
    }
}
__device__ __forceinline__ void gla_pass_c(const Frame& F, const Args& a) {
    const bf16* P = (const bf16*)(F.ws + WS_P); const bf16* ST = (const bf16*)(F.ws + WS_GST); bf16* YB = (bf16*)(F.ws + WS_YB);
    LAS float* bc = (LAS float*)(F.lds + G_BC); LAS float* red = (LAS float*)(F.lds + G_RED);
    LAS bf16* QT = (LAS bf16*)(F.lds + G_QT); LAS bf16* KT = (LAS bf16*)(F.lds + G_KT); LAS bf16* VR = (LAS bf16*)(F.lds + G_VT); LAS bf16* AT = (LAS bf16*)(F.lds + G_AT);
    const int fr = F.lane & 15, fq = F.lane >> 4, w = F.wave;
    const float scale = 0.08838834764831845f;
    for (int it = F.vcu; it < BATCH * GH * NCH; it += F.G) {
        const int c = it & 31, h = (it >> 5) & 3, b = it >> 7, t0 = b * SEQ + c * CHUNK;
        __syncthreads();
        { const f32x4* gbc = (const f32x4*)(F.ws + WS_GBC) + (size_t)it * 2048;
#pragma unroll
          for (int i = 0; i < 4; ++i) ((LAS f32x4*)bc)[F.tid + 512 * i] = gbc[F.tid + 512 * i]; }
        const bf16* Sg = ST + (size_t)it * (GDV * GDK);
        bf16x8 sfr[4][2];
#pragma unroll
        for (int ks = 0; ks < 4; ++ks)
#pragma unroll
            for (int n = 0; n < 2; ++n) sfr[ks][n] = *(const bf16x8*)(Sg + (size_t)(w * 32 + n * 16 + fr) * GDK + ks * 32 + fq * 8);
        f32x4 gng[2];
#pragma unroll
        for (int n = 0; n < 2; ++n) gng[n] = *(const f32x4*)(a.in[I_GNG] + w * 32 + n * 16 + 4 * fq);
        v2u ogu[4][2];
#pragma unroll
        for (int m = 0; m < 4; ++m)
#pragma unroll
            for (int n = 0; n < 2; ++n) ogu[m][n] = __builtin_nontemporal_load((const v2u*)(P + (size_t)(t0 + m * 16 + fr) * PLD + C_OG + h * GDV + w * 32 + n * 16 + 4 * fq));
        __syncthreads();
        { const int j = F.tid >> 3, d0 = (F.tid & 7) * 16;
          const bf16* sq = P + (size_t)(t0 + j) * PLD + C_GQ + h * GDK + d0; const bf16* sk = P + (size_t)(t0 + j) * PLD + C_GK + h * GDK + d0;
#pragma unroll
          for (int q = 0; q < 2; ++q) { const v4u uq = *(const v4u*)(sq + 8 * q), uk = *(const v4u*)(sk + 8 * q); float fq8[8], fk8[8]; unpack8(uq, fq8); unpack8(uk, fk8);
#pragma unroll
            for (int i = 0; i < 8; ++i) { const float bv = bc[j * 128 + d0 + 8 * q + i]; fq8[i] *= scale * __expf(bv); fk8[i] *= __expf(-bv); }
            *(LAS v4u*)(QT + j * 136 + d0 + 8 * q) = pack8(fq8); *(LAS v4u*)(KT + j * 136 + d0 + 8 * q) = pack8(fk8); } }
        gla_stage_v(F, P, t0, h);
        __syncthreads();
        { const int mt = w >> 1;
#pragma unroll
          for (int q = 0; q < 2; ++q) { const int nt = (w & 1) * 2 + q; f32x4 sacc = {0.f, 0.f, 0.f, 0.f};
            if (nt <= mt) {
#pragma unroll
                for (int ks = 0; ks < 4; ++ks) { const bf16x8 kfr = *(const LAS bf16x8*)(KT + (nt * 16 + fr) * 136 + ks * 32 + fq * 8); const bf16x8 qfr = *(const LAS bf16x8*)(QT + (mt * 16 + fr) * 136 + ks * 32 + fq * 8);
                    sacc = MMA16(kfr, qfr, sacc); } }
            const int i = mt * 16 + fr, j0 = nt * 16 + 4 * fq; float v4[4];
#pragma unroll
            for (int jj = 0; jj < 4; ++jj) v4[jj] = (j0 + jj <= i) ? sacc[jj] : 0.f;
            v2u pk; pk.x = pk2(v4[0], v4[1]); pk.y = pk2(v4[2], v4[3]); *(LAS v2u*)(AT + i * 72 + j0) = pk; } }
        __syncthreads();
        f32x4 acc[2][4];
#pragma unroll
        for (int n = 0; n < 2; ++n)
#pragma unroll
            for (int m = 0; m < 4; ++m) acc[n][m] = (f32x4){0.f, 0.f, 0.f, 0.f};
#pragma unroll
        for (int ks = 0; ks < 2; ++ks) {
            bf16x8 vf[2];
#pragma unroll
            for (int n = 0; n < 2; ++n) vf[n] = tr_frag(VR, G_VP, ks * 32, w * 32 + n * 16, F.lane);
#pragma unroll
            for (int m = 0; m < 4; ++m) { const bf16x8 af = *(const LAS bf16x8*)(AT + (m * 16 + fr) * 72 + ks * 32 + fq * 8);
#pragma unroll
                for (int n = 0; n < 2; ++n) acc[n][m] = MMA16(vf[n], af, acc[n][m]); }
        }
#pragma unroll
        for (int ks = 0; ks < 4; ++ks) {
#pragma unroll
            for (int m = 0; m < 4; ++m) { const bf16x8 qf = *(const LAS bf16x8*)(QT + (m * 16 + fr) * 136 + ks * 32 + fq * 8);
#pragma unroll
                for (int n = 0; n < 2; ++n) acc[n][m] = MMA16(sfr[ks][n], qf, acc[n][m]); }
        }
        float ssq[4];
#pragma unroll
        for (int m = 0; m < 4; ++m) { float ss = 0.f;
#pragma unroll
            for (int n = 0; n < 2; ++n) ss += (acc[n][m][0] * acc[n][m][0] + acc[n][m][1] * acc[n][m][1]) + (acc[n][m][2] * acc[n][m][2] + acc[n][m][3] * acc[n][m][3]);
            ss += __shfl_xor(ss, 16); ss += __shfl_xor(ss, 32); ssq[m] = ss;
            if (fq == 0) red[(m * 16 + fr) * 8 + w] = ss; }
        __syncthreads();
#pragma unroll
        for (int m = 0; m < 4; ++m) { const int i = m * 16 + fr; float tot = 0.f;
#pragma unroll
            for (int q = 0; q < 8; ++q) tot += red[i * 8 + q];
            const float rstd = rsqrtf(tot * (1.f / GDV) + NORM_EPS);
#pragma unroll
            for (int n = 0; n < 2; ++n) { const int e = w * 32 + n * 16 + 4 * fq;
                const float og[4] = {bflo(ogu[m][n].x), bfhi(ogu[m][n].x), bflo(ogu[m][n].y), bfhi(ogu[m][n].y)}; float r4[4];
#pragma unroll
                for (int jj = 0; jj < 4; ++jj) r4[jj] = acc[n][m][jj] * rstd * gng[n][jj] * (og[jj] * sigmoidf_(og[jj]));
                v2u pk; pk.x = pk2(r4[0], r4[1]); pk.y = pk2(r4[2], r4[3]); *(v2u*)(YB + (size_t)(t0 + i) * GVW + h * GDV + e) = pk; } }
    }
}

__device__ __forceinline__ void p11_router(const Frame& F, const Args& a) {
    const int lane = F.lane, w = F.wave;
    const float* X1 = (const float*)(F.ws + WS_X1); unsigned char* H2 = (unsigned char*)(F.ws + WS_H2); const float* Wr = (const float*)(F.ws + WS_WR);
    int* SEL_E = (int*)(F.ws + WS_ROUTE); float* SEL_W = (float*)(F.ws + WS_ROUTE + 256 * 1024); int* SEL_R = (int*)(F.ws + WS_ROUTE + 512 * 1024);
    volatile LAS int* hist = (volatile LAS int*)(F.lds + MOE_OFF + 1024); volatile LAS int* base = (volatile LAS int*)(F.lds + MOE_OFF + 1280);
    int* LIST = (int*)(F.ws + WS_ROUTE + 1024 * 1024);
    LAS float* part = (LAS float*)F.lds;
    LAS float* ssq = (LAS float*)(F.lds + 16384);
    __syncthreads();
    if (F.tid < 32) hist[F.tid] = 0;
    __syncthreads();
    const int mt = w & 1, ks = w >> 1, r = lane & 15, kq = lane >> 4;
    const int grp = lane >> 4, el = lane & 15;
    const float br0 = a.in[I_BROUTER][el], br1 = a.in[I_BROUTER][16 + el];
    for (int tile = F.vcu; tile < T / 32; tile += F.G) {
        const int tb = tile * 32;
        {
            const float* xp = X1 + (size_t)(tb + 16 * mt + r) * D + 512 * ks + 8 * kq;
            const float* bp = Wr + (size_t)(2 * ks) * 8192 + r * 256 + 8 * kq;
            f32x4 acc0 = {0.f, 0.f, 0.f, 0.f}, acc1 = {0.f, 0.f, 0.f, 0.f}; float ss = 0.f;
#pragma unroll 4
            for (int s = 0; s < 16; ++s) {
                const f32x4 xa = *(const f32x4*)(xp + 32 * s), xb = *(const f32x4*)(xp + 32 * s + 4);
                const float* bs = bp + (s >> 3) * 8192 + 32 * (s & 7);
                const f32x4 b00 = *(const f32x4*)bs, b01 = *(const f32x4*)(bs + 4), b10 = *(const f32x4*)(bs + 4096), b11 = *(const f32x4*)(bs + 4096 + 4);
                ss += ((xa.x * xa.x + xa.y * xa.y) + (xa.z * xa.z + xa.w * xa.w)) + ((xb.x * xb.x + xb.y * xb.y) + (xb.z * xb.z + xb.w * xb.w));
#pragma unroll
                for (int i = 0; i < 4; ++i) { acc0 = __builtin_amdgcn_mfma_f32_16x16x4f32(xa[i], b00[i], acc0, 0, 0, 0); acc1 = __builtin_amdgcn_mfma_f32_16x16x4f32(xa[i], b10[i], acc1, 0, 0, 0); }
#pragma unroll
                for (int i = 0; i < 4; ++i) { acc0 = __builtin_amdgcn_mfma_f32_16x16x4f32(xb[i], b01[i], acc0, 0, 0, 0); acc1 = __builtin_amdgcn_mfma_f32_16x16x4f32(xb[i], b11[i], acc1, 0, 0, 0); }
            }
#pragma unroll
            for (int j = 0; j < 4; ++j) { LAS float* pr = part + ((ks * 32 + 16 * mt + 4 * kq + j) * 32); pr[r] = acc0[j]; pr[16 + r] = acc1[j]; }
            ss += __shfl_xor(ss, 16); ss += __shfl_xor(ss, 32);
            if (kq == 0) ssq[ks * 32 + 16 * mt + r] = ss;
        }
        __syncthreads();
        {
            const int tk = 4 * w + grp;
            const float rstd = rsqrtf(((ssq[tk] + ssq[32 + tk]) + (ssq[64 + tk] + ssq[96 + tk])) * (1.f / D) + NORM_EPS);
            const LAS float* pr = part + tk * 32;
            float c0 = ((pr[el] + pr[1024 + el]) + (pr[2048 + el] + pr[3072 + el])) * rstd + br0;
            float c1 = ((pr[16 + el] + pr[1024 + 16 + el]) + (pr[2048 + 16 + el] + pr[3072 + 16 + el])) * rstd + br1;
            float tv[4]; int ti[4];
#pragma unroll
            for (int k = 0; k < 4; ++k) { float bv = c0; int bi = el; if (c1 > c0) { bv = c1; bi = 16 + el; }
#pragma unroll
                for (int o = 1; o < 16; o <<= 1) { const float ov = __shfl_xor(bv, o); const int oi = __shfl_xor(bi, o); if (ov > bv || (ov == bv && oi < bi)) { bv = ov; bi = oi; } }
                tv[k] = bv; ti[k] = bi; if (bi == el) c0 = -3.0e38f; if (bi == 16 + el) c1 = -3.0e38f; }
            const float e1 = __expf(tv[1] - tv[0]), e2 = __expf(tv[2] - tv[0]), e3 = __expf(tv[3] - tv[0]); const float inv = 1.f / (1.f + e1 + e2 + e3);
            if (el < 4) { const int k = el; const float wk = (k == 0 ? 1.f : (k == 1 ? e1 : (k == 2 ? e2 : e3))) * inv; const int ek = (k == 0 ? ti[0] : (k == 1 ? ti[1] : (k == 2 ? ti[2] : ti[3])));
                const int lr = __hip_atomic_fetch_add((LAS int*)&hist[ek], 1, __ATOMIC_RELAXED, __HIP_MEMORY_SCOPE_WORKGROUP);
                SEL_E[(tb + tk) * 4 + k] = ek; SEL_W[(tb + tk) * 4 + k] = wk; SEL_R[(tb + tk) * 4 + k] = lr; }
        }
#pragma unroll
        for (int rr = 0; rr < 4; ++rr) { const int tk = 4 * w + rr;
            const float rstd = rsqrtf(((ssq[tk] + ssq[32 + tk]) + (ssq[64 + tk] + ssq[96 + tk])) * (1.f / D) + NORM_EPS);
            const f32x4* xr = (const f32x4*)(X1 + (size_t)(tb + tk) * D) + lane; unsigned* hr = (unsigned*)(H2 + (size_t)(tb + tk) * D) + lane;
#pragma unroll
            for (int j = 0; j < 8; ++j) { const f32x4 xv = __builtin_nontemporal_load(xr + 64 * j); const f32x4 gg = ((const f32x4*)a.in[I_NFG])[64 * j + lane];
                hr[64 * j] = pk4_fp8(xv.x * rstd * gg.x, xv.y * rstd * gg.y, xv.z * rstd * gg.z, xv.w * rstd * gg.w); } }
        __syncthreads();
    }
    if (F.tid < 32) base[F.tid] = (int)__hip_atomic_fetch_add(F.ctl + CW_CNT + F.tid, (unsigned)hist[F.tid], RLX_AGENT);
    __syncthreads();
    for (int tile = F.vcu; tile < T / 32; tile += F.G) {
        if (F.tid < 128) { const int tk = tile * 32 + (F.tid >> 2); const int idx = tk * 4 + (F.tid & 3);
            const int e_ = __hip_atomic_load(SEL_E + idx, RLX_AGENT); const int rk_ = __hip_atomic_load(SEL_R + idx, RLX_AGENT) + base[e_]; SEL_R[idx] = rk_; LIST[e_ * 8192 + rk_] = tk; }
    }
}
__device__ __forceinline__ void moe_tables(const Frame& F, int nct) {
    volatile LAS int* tab = (volatile LAS int*)(F.lds + MOE_OFF);
    __syncthreads();
    if (F.tid == 0) { int run = 0, units = 0;
        for (int e = 0; e < NE; ++e) { const int cnt = (int)__hip_atomic_load(F.ctl + CW_CNT + e, RLX_AGENT); const int nt = (cnt + 255) >> 8;
            tab[e] = units; tab[36 + e] = run * 256; tab[72 + e] = nt > 0 ? nt : 1; tab[108 + e] = cnt; run += nt; units += nt * nct; }
        tab[32] = units; }
    __syncthreads();
}
__device__ __forceinline__ void p12_scatter(const Frame& F) {
    const int gw = F.vcu * 8 + F.wave, NGW = F.G * 8, lane = F.lane;
    const unsigned char* H2 = (const unsigned char*)(F.ws + WS_H2); unsigned char* XS = (unsigned char*)(F.ws + WS_XS);
    const int* SEL_E = (const int*)(F.ws + WS_ROUTE); const int* SEL_R = (const int*)(F.ws + WS_ROUTE + 512 * 1024); int* DEST = (int*)(F.ws + WS_ROUTE + 768 * 1024);
    moe_tables(F, 1);
    volatile LAS int* tab = (volatile LAS int*)(F.lds + MOE_OFF);
    for (int it = gw; it < T * TOPK; it += NGW) {
        const int t = it >> 2; const int e = SEL_E[it], dest = tab[36 + e] + SEL_R[it];
        const v4u* s = (const v4u*)(H2 + (size_t)t * D) + lane; v4u* d = (v4u*)(XS + (size_t)dest * D) + lane;
        d[0] = s[0]; d[64] = s[64];
        if (lane == 0) DEST[it] = dest;
    }
}
__device__ __forceinline__ void p15_combine(const Frame& F, const Args& a) {
    const int gw = F.vcu * 8 + F.wave, NGW = F.G * 8, lane = F.lane;
    const float* X1 = (const float*)(F.ws + WS_X1); const bf16* Y = (const bf16*)(F.ws + WS_Y);
    const float* SEL_W = (const float*)(F.ws + WS_ROUTE + 256 * 1024); const int* SEL_E = (const int*)(F.ws + WS_ROUTE); const int* SEL_R = (const int*)(F.ws + WS_ROUTE + 512 * 1024);
    moe_tables(F, 1);
    volatile LAS int* tab = (volatile LAS int*)(F.lds + MOE_OFF);
    for (int t = gw; t < T; t += NGW) {
        f32x4 v[8];
        const f32x4* xr = (const f32x4*)(X1 + (size_t)t * D) + lane;
#pragma unroll
        for (int j = 0; j < 8; ++j) v[j] = __builtin_nontemporal_load(xr + 64 * j);
#pragma unroll
        for (int k = 0; k < 4; ++k) { const float wk = SEL_W[t * 4 + k]; const v2u* yr = (const v2u*)(Y + (size_t)(tab[36 + SEL_E[t * 4 + k]] + SEL_R[t * 4 + k]) * D) + lane;
#pragma unroll
            for (int j = 0; j < 8; ++j) { const v2u u = __builtin_nontemporal_load(yr + 64 * j); v[j].x += wk * bflo(u.x); v[j].y += wk * bfhi(u.x); v[j].z += wk * bflo(u.y); v[j].w += wk * bfhi(u.y); } }
        float s = 0.f;
#pragma unroll
        for (int j = 0; j < 8; ++j) s += (v[j].x * v[j].x + v[j].y * v[j].y) + (v[j].z * v[j].z + v[j].w * v[j].w);
        const float rstd = rsqrtf(wave_sum(s) * (1.f / D) + NORM_EPS);
        f32x4* o = (f32x4*)(a.out + (size_t)t * D) + lane;
#pragma unroll
        for (int j = 0; j < 8; ++j) { const f32x4 gg = ((const f32x4*)a.in[I_NFINAL])[64 * j + lane]; __builtin_nontemporal_store(v[j] * rstd * gg, o + 64 * j); }
    }
}

__global__ void __launch_bounds__(512, 2) __attribute__((amdgpu_num_sgpr(96))) fwd(Args args) {
    extern __shared__ __attribute__((aligned(16))) unsigned char lds[];
    Frame F;
    F.lds = (LAS unsigned char*)lds; F.ws = args.ws; F.ctl = (unsigned*)(args.ws + WS_CTL);
    F.tid = threadIdx.x; F.lane = F.tid & 63; F.wave = __builtin_amdgcn_readfirstlane(F.tid >> 6);
    F.G = gridDim.x; { const int bx = blockIdx.x; F.vcu = (F.G % 8 == 0) ? (bx % 8) * (F.G / 8) + bx / 8 : bx; }
    for (int u = F.tid; u < (LDS_BYTES - LDSCTL_OFF) / 4; u += 512) ((LAS unsigned*)(F.lds + LDSCTL_OFF))[u] = 0u;
    __syncthreads();
    volatile LAS unsigned* MISC = (volatile LAS unsigned*)(F.lds + MISC_OFF);
#if MK_PER_PHASE
#define GRID_BAR() do { } while (0)
#else
    XcdBarrier bar = xcd_barrier_post(F.ctl + CW_BAR, MISC + 8);
#define GRID_BAR() xcd_barrier(bar)
#endif
    const int lo = args.ph_lo, hi = args.ph_hi;
#define IN(k) (lo <= (k) && (k) < hi)
#define SEAM(k) do { if (IN(k) && IN((k) + 1)) GRID_BAR(); } while (0)
#define DUP(k) (((PROBE_DUP) >> (k)) & 1)
#define PH_BEGIN {
#define PH_END }
    const bf16* P = (const bf16*)(F.ws + WS_P);

    if (IN(0)) { PH_BEGIN  p0_prologue(F, args);  PH_END if (DUP(0)) { GRID_BAR(); PH_BEGIN  p0_prologue(F, args);  PH_END } } SEAM(0);
    if (IN(1)) { PH_BEGIN  p1_gemm_in(F, args);  PH_END if (DUP(1)) { GRID_BAR(); PH_BEGIN  p1_gemm_in(F, args);  PH_END } } SEAM(1);
    if (PROBE_GEMM >= 0 && IN(1)) {
        pg8::Gemm g{(const bf16*)(F.ws + WS_H), (const bf16*)(F.ws + WS_WIN), DP, DP, D, nullptr}; pg8::ProbeOrder S; S.so.init(T, PLD, F.G, (int)blockIdx.x); S.mode = PROBE_GEMM;
        pg8::EpiProbe E{(bf16*)(F.ws + WS_XS)}; pg8::gemm_phase(F.lds, g, S, E); GRID_BAR();
    }
    if (IN(2)) { PH_BEGIN  p2_lora_in(F, args); gla_pass_a(F, args);  PH_END if (DUP(2)) { GRID_BAR(); PH_BEGIN  p2_lora_in(F, args); gla_pass_a(F, args);  PH_END } } SEAM(2);
    if (IN(3)) { PH_BEGIN
        { pg8::Gemm g{(const bf16*)(F.ws + WS_A2), (const bf16*)(F.ws + WS_WLWA), 512, 256, 256, nullptr}; pg8::StaticOrder S; S.init(T, 2048, F.G, (int)blockIdx.x);
          pg8::EpiBf16 E{(bf16*)(F.ws + WS_WAO), 2048, nullptr, 0, 1.f}; pg8::gemm_phase(F.lds, g, S, E); }
        { pg8::Gemm g{(const bf16*)(F.ws + WS_A2) + 256, (const bf16*)(F.ws + WS_WLG), 512, 256, 256, nullptr}; pg8::StaticOrder S; S.init(T, 1024, F.G, (int)blockIdx.x);
          pg8::EpiBf16 E{(bf16*)(F.ws + WS_GO), 1024, nullptr, 0, 1.f}; pg8::gemm_phase(F.lds, g, S, E); }
        {
            constexpr int NEL = BATCH * GH * GDV * GDK, HEAD = (NEL / 4 / 65536) * 65536; const int bx = (int)blockIdx.x;
            if (F.G == 256) { if (bx >= 128) gla_pass_b(F, 0, HEAD, bx - 128, 128); gla_pass_b(F, HEAD, NEL, F.vcu, F.G); } else gla_pass_b(F, 0, NEL, F.vcu, F.G); }
     PH_END if (DUP(3)) { GRID_BAR(); PH_BEGIN
        { pg8::Gemm g{(const bf16*)(F.ws + WS_A2), (const bf16*)(F.ws + WS_WLWA), 512, 256, 256, nullptr}; pg8::StaticOrder S; S.init(T, 2048, F.G, (int)blockIdx.x);
          pg8::EpiBf16 E{(bf16*)(F.ws + WS_WAO), 2048, nullptr, 0, 1.f}; pg8::gemm_phase(F.lds, g, S, E); }
        { pg8::Gemm g{(const bf16*)(F.ws + WS_A2) + 256, (const bf16*)(F.ws + WS_WLG), 512, 256, 256, nullptr}; pg8::StaticOrder S; S.init(T, 1024, F.G, (int)blockIdx.x);
          pg8::EpiBf16 E{(bf16*)(F.ws + WS_GO), 1024, nullptr, 0, 1.f}; pg8::gemm_phase(F.lds, g, S, E); }
        {
            constexpr int NEL = BATCH * GH * GDV * GDK, HEAD = (NEL / 4 / 65536) * 65536; const int bx = (int)blockIdx.x;
            if (F.G == 256) { if (bx >= 128) gla_pass_b(F, 0, HEAD, bx - 128, 128); gla_pass_b(F, HEAD, NEL, F.vcu, F.G); } else gla_pass_b(F, 0, NEL, F.vcu, F.G); }
     PH_END } } SEAM(3);
    if (IN(4)) { PH_BEGIN  p4_rwkv_prep(F, args); gla_pass_c(F, args);  PH_END if (DUP(4)) { GRID_BAR(); PH_BEGIN  p4_rwkv_prep(F, args); gla_pass_c(F, args);  PH_END } } SEAM(4);
    if (IN(5)) { PH_BEGIN  p5_rwkv_scan(F, args);  PH_END if (DUP(5)) { GRID_BAR(); PH_BEGIN  p5_rwkv_scan(F, args);  PH_END } } SEAM(5);
    if (IN(6)) { PH_BEGIN  p6_rwkv_post(F, args);  PH_END if (DUP(6)) { GRID_BAR(); PH_BEGIN  p6_rwkv_post(F, args);  PH_END } } SEAM(6);
    if (IN(7)) { PH_BEGIN
        { pg8::Gemm g{(const bf16*)(F.ws + WS_YA), (const bf16*)(F.ws + WS_WBA), RW, RW, RW, nullptr}; pg8::StaticOrder S; S.init(T, D, F.G, (int)blockIdx.x);
          pg8::EpiGate<false> E{(bf16*)(F.ws + WS_MRG), P, args.in[I_BM], C_GATE}; pg8::gemm_phase(F.lds, g, S, E); }
        { pg8::Gemm g{(const bf16*)(F.ws + WS_YB), (const bf16*)(F.ws + WS_WBB), GVW, GVW, GVW, nullptr}; pg8::StaticOrder S; S.init(T, D, F.G, (int)blockIdx.x);
          pg8::EpiGate<true> E{(bf16*)(F.ws + WS_MRG), P, args.in[I_BM] + D, C_GATE + D}; pg8::gemm_phase(F.lds, g, S, E); }
     PH_END if (DUP(7)) { GRID_BAR(); PH_BEGIN
        { pg8::Gemm g{(const bf16*)(F.ws + WS_YA), (const bf16*)(F.ws + WS_WBA), RW, RW, RW, nullptr}; pg8::StaticOrder S; S.init(T, D, F.G, (int)blockIdx.x);
          pg8::EpiGate<false> E{(bf16*)(F.ws + WS_MRG), P, args.in[I_BM], C_GATE}; pg8::gemm_phase(F.lds, g, S, E); }
        { pg8::Gemm g{(const bf16*)(F.ws + WS_YB), (const bf16*)(F.ws + WS_WBB), GVW, GVW, GVW, nullptr}; pg8::StaticOrder S; S.init(T, D, F.G, (int)blockIdx.x);
          pg8::EpiGate<true> E{(bf16*)(F.ws + WS_MRG), P, args.in[I_BM] + D, C_GATE + D}; pg8::gemm_phase(F.lds, g, S, E); }
     PH_END } } SEAM(7);
    if (IN(8)) { PH_BEGIN
        pg8::Gemm g{(const bf16*)(F.ws + WS_MRG), (const bf16*)(F.ws + WS_WOUT), D, D, D, nullptr}; pg8::StaticOrder S; S.init(T, D, F.G, (int)blockIdx.x);
        pg8::EpiResF32 E{(float*)(F.ws + WS_X1), args.in[I_X]}; pg8::gemm_phase(F.lds, g, S, E);
     PH_END if (DUP(8)) { GRID_BAR(); PH_BEGIN
        pg8::Gemm g{(const bf16*)(F.ws + WS_MRG), (const bf16*)(F.ws + WS_WOUT), D, D, D, nullptr}; pg8::StaticOrder S; S.init(T, D, F.G, (int)blockIdx.x);
        pg8::EpiResF32 E{(float*)(F.ws + WS_X1), args.in[I_X]}; pg8::gemm_phase(F.lds, g, S, E);
     PH_END } } SEAM(8);
    if (IN(9)) { PH_BEGIN  p11_router(F, args);  PH_END if (DUP(9)) { GRID_BAR(); PH_BEGIN  p11_router(F, args);  PH_END } } SEAM(9);
    if (IN(10)) { PH_BEGIN
        moe_tables(F, 16);
        pg8::Gemm g{(const bf16*)(F.ws + WS_H2), (const bf16*)(F.ws + WS_WGU), D, D, D, (const int*)(F.ws + WS_ROUTE + 1024 * 1024)};
        pg8::MoeOrder S{(const volatile LAS int*)(F.lds + MOE_OFF), 16, 4096, F.G, F.vcu, false};
        pg8::EpiGluQ E{(unsigned char*)(F.ws + WS_HH), args.in[I_BGATE], args.in[I_BUP]}; pg8::gemm_phase<pg8::EpiGluQ, pg8::MoeOrder, 1, true>(F.lds, g, S, E);
     PH_END if (DUP(10)) { GRID_BAR(); PH_BEGIN
        moe_tables(F, 16);
        pg8::Gemm g{(const bf16*)(F.ws + WS_H2), (const bf16*)(F.ws + WS_WGU), D, D, D, (const int*)(F.ws + WS_ROUTE + 1024 * 1024)};
        pg8::MoeOrder S{(const volatile LAS int*)(F.lds + MOE_OFF), 16, 4096, F.G, F.vcu, false};
        pg8::EpiGluQ E{(unsigned char*)(F.ws + WS_HH), args.in[I_BGATE], args.in[I_BUP]}; pg8::gemm_phase<pg8::EpiGluQ, pg8::MoeOrder, 1, true>(F.lds, g, S, E);
     PH_END } } SEAM(10);
    if (IN(11)) { PH_BEGIN
        moe_tables(F, 8);
        pg8::Gemm g{(const bf16*)(F.ws + WS_HH), (const bf16*)(F.ws + WS_WD), FF, FF, FF, nullptr};
        pg8::MoeOrder S{(const volatile LAS int*)(F.lds + MOE_OFF), 8, 2048, F.G, F.vcu, true};
        pg8::EpiBf16H E{(bf16*)(F.ws + WS_Y), D, args.in[I_BDOWN], D, WQ_INV}; pg8::gemm_phase<pg8::EpiBf16H, pg8::MoeOrder, 1, false, true, true>(F.lds, g, S, E);
     PH_END if (DUP(11)) { GRID_BAR(); PH_BEGIN
        moe_tables(F, 8);
        pg8::Gemm g{(const bf16*)(F.ws + WS_HH), (const bf16*)(F.ws + WS_WD), FF, FF, FF, nullptr};
        pg8::MoeOrder S{(const volatile LAS int*)(F.lds + MOE_OFF), 8, 2048, F.G, F.vcu, true};
        pg8::EpiBf16H E{(bf16*)(F.ws + WS_Y), D, args.in[I_BDOWN], D, WQ_INV}; pg8::gemm_phase<pg8::EpiBf16H, pg8::MoeOrder, 1, false, true, true>(F.lds, g, S, E);
     PH_END } } SEAM(11);
    if (IN(12)) { PH_BEGIN  p15_combine(F, args);  PH_END if (DUP(12)) { GRID_BAR(); PH_BEGIN  p15_combine(F, args);  PH_END } }
#undef IN
#undef SEAM
}
constexpr int N_PHASES = 13;

extern "C" void kernel_launch(void* const* d_in, const int* in_sizes, int n_in, void* d_out, int out_size, void* d_ws, size_t ws_size, hipStream_t stream) {
    static int grid = 0;
    if (grid == 0) {
        if (n_in != 31 || in_sizes[0] != T * D || out_size != T * D || ws_size < WS_END) { fprintf(stderr, "kernel_launch: unexpected shapes (n_in %d, ws %zu)\n", n_in, ws_size); grid = -1; return; }
        int dev = 0, cus = 0, per_cu = 0;
        if (hipGetDevice(&dev) != hipSuccess || hipDeviceGetAttribute(&cus, hipDeviceAttributeMultiprocessorCount, dev) != hipSuccess) { grid = -1; return; }
        if (hipFuncSetAttribute((const void*)fwd, hipFuncAttributeMaxDynamicSharedMemorySize, LDS_BYTES) != hipSuccess) { fprintf(stderr, "kernel_launch: hipFuncSetAttribute failed\n"); grid = -1; return; }
        if (hipOccupancyMaxActiveBlocksPerMultiprocessor(&per_cu, (const void*)fwd, 512, LDS_BYTES) != hipSuccess || per_cu < 1) { fprintf(stderr, "kernel_launch: occupancy query says %d\n", per_cu); }
        (void)hipGetLastError();
        grid = cus;
    }
    if (grid < 0) return;
    (void)hipMemsetAsync((char*)d_ws + WS_CTL, 0, CTL_ZERO_BYTES, stream);
    Args a{};
    for (int i = 0; i < 31; ++i) a.in[i] = (const float*)d_in[i];
    a.out = (float*)d_out; a.ws = (unsigned char*)d_ws;
#if MK_PER_PHASE
    for (int p = 0; p < N_PHASES; ++p) { a.ph_lo = p; a.ph_hi = p + 1; hipLaunchKernelGGL(fwd, dim3(grid), dim3(512), LDS_BYTES, stream, a); }
#else
    a.ph_lo = 0; a.ph_hi = N_PHASES;
    hipLaunchKernelGGL(fwd, dim3(grid), dim3(512), LDS_BYTES, stream, a);
#endif
}
```

```cpp
#include <hip/hip_runtime.h>
#include <cstdio>
#include <cstdint>

#ifndef MK_PER_PHASE
#define MK_PER_PHASE 0
#endif

#ifndef PROBE_GEMM
#define PROBE_GEMM -1
#endif
#ifndef PROBE_DUP
#define PROBE_DUP 0
#endif
#define GAS __attribute__((address_space(1)))
#define LAS __attribute__((address_space(3)))
typedef unsigned short bf16;
typedef unsigned v4u __attribute__((ext_vector_type(4)));
typedef unsigned v2u __attribute__((ext_vector_type(2)));
typedef float f32x4 __attribute__((ext_vector_type(4)));
typedef float f32x2 __attribute__((ext_vector_type(2)));
typedef short bf16x8 __attribute__((ext_vector_type(8)));
typedef long i64x2 __attribute__((ext_vector_type(2)));
typedef int v4i __attribute__((ext_vector_type(4)));
typedef int v8i __attribute__((ext_vector_type(8)));
#define RLX_AGENT __ATOMIC_RELAXED, __HIP_MEMORY_SCOPE_AGENT
#define LDS_WAIT() asm volatile("s_waitcnt lgkmcnt(0)" ::: "memory")
#define VM_WAIT() asm volatile("s_waitcnt vmcnt(0)" ::: "memory")

constexpr int D = 2048, BATCH = 4, SEQ = 2048, T = BATCH * SEQ;
constexpr int RW = 1024, RH = 16, RN = 64;
constexpr int DLORA = 96, GLORA = 256;
constexpr int RWKV_COLS = 3 * RW + 2 * DLORA + GLORA;
constexpr int GH = 4, GDK = 128, GDV = 256, GKW = GH * GDK, GVW = GH * GDV, GAL = 16;
constexpr int GLA_COLS = 2 * GKW + 2 * GVW + GAL;
constexpr int IN_COLS = RWKV_COLS + GLA_COLS + 2 * D;
constexpr int PLD = 10752;
constexpr int DP = D + 64;
constexpr int C_R = 0, C_K = 1024, C_V = 2048, C_WL = 3072, C_AL = 3168, C_GL = 3264;
constexpr int C_GQ = 3520, C_GK = 4032, C_GV = 4544, C_OG = 5568, C_GAL = 6592, C_GATE = 6608;
constexpr int NE = 32, TOPK = 4, FF = 2048;
constexpr int XS_ROWS = T * TOPK + NE * 256;
constexpr int CHUNK = 64, NCH = SEQ / CHUNK;
constexpr float NORM_EPS = 1e-5f, GN_EPS = 64e-5f;
constexpr float WQ_SCALE = 64.f, WQ_INV = 1.f / 64.f;

constexpr size_t MiB = 1u << 20;
constexpr size_t WS_CTL = 0, CTL_ZERO_BYTES = 1 * MiB;
constexpr size_t WS_WR = 1 * MiB;
constexpr size_t WS_WLWA = 2 * MiB;
constexpr size_t WS_WLG = 3 * MiB;
constexpr size_t WS_WBA = 4 * MiB, WS_WBB = 8 * MiB;
constexpr size_t WS_WOUT = 12 * MiB;
constexpr size_t WS_WIN = 64 * MiB;
constexpr size_t WS_WGU = 192 * MiB;
constexpr size_t WS_WD = 448 * MiB;
constexpr size_t WS_H = 128 * MiB;
constexpr size_t WS_P = 864 * MiB;
constexpr size_t WS_Y = WS_P;
constexpr size_t WS_A2 = 1032 * MiB;
constexpr size_t WS_WAO = 1040 * MiB;
constexpr size_t WS_GO = 1072 * MiB;
constexpr size_t WS_SCAN = 1088 * MiB;
constexpr size_t WS_BON = 1200 * MiB;
constexpr size_t WS_YRAW = 1280 * MiB;
constexpr size_t WS_GHT = 1312 * MiB;
constexpr size_t WS_GST = 1376 * MiB;
constexpr size_t WS_GDEC = 1408 * MiB;
constexpr size_t WS_GBC = 576 * MiB;
constexpr size_t WS_YA = 1410 * MiB, WS_YB = 1426 * MiB;
constexpr size_t WS_MRG = 1442 * MiB;
constexpr size_t WS_X1 = 1474 * MiB;
constexpr size_t WS_H2 = 832 * MiB;
constexpr size_t WS_ROUTE = 1570 * MiB;
constexpr size_t WS_XS = 1572 * MiB;
constexpr size_t WS_HH = 1732 * MiB;
constexpr size_t WS_END = 1892 * MiB;
constexpr int CW_BAR = 4096;
constexpr int CW_CNT = 16384;
constexpr int CW_CVQ = 20480, CW_CVSTOP = 20544;

constexpr int RING_BYTES = 131072;
constexpr int LDSCTL_OFF = 159744, MISC_OFF = LDSCTL_OFF + 320;
constexpr int MOE_OFF = LDSCTL_OFF + 1024;
constexpr int LDS_BYTES = 163840;

__device__ __forceinline__ unsigned f2bf(float f) { unsigned u = __builtin_bit_cast(unsigned, f); return (u + 0x7fffu + ((u >> 16) & 1u)) >> 16; }
__device__ __forceinline__ unsigned pk2(float lo, float hi) { return f2bf(lo) | (f2bf(hi) << 16); }
__device__ __forceinline__ unsigned pk4_fp8(float a, float b, float c, float d) { int w = 0; w = __builtin_amdgcn_cvt_pk_fp8_f32(a, b, w, false); w = __builtin_amdgcn_cvt_pk_fp8_f32(c, d, w, true); return (unsigned)w; }
__device__ __forceinline__ float bflo(unsigned u) { return __builtin_bit_cast(float, u << 16); }
__device__ __forceinline__ float bfhi(unsigned u) { return __builtin_bit_cast(float, u & 0xffff0000u); }
__device__ __forceinline__ float bf2f(bf16 b) { return __builtin_bit_cast(float, ((unsigned)b) << 16); }
__device__ __forceinline__ float wave_sum(float v) {
#pragma unroll
    for (int o = 1; o < 64; o <<= 1) v += __shfl_xor(v, o);
    return v;
}
__device__ __forceinline__ float sigmoidf_(float x) { return 1.f / (1.f + __expf(-x)); }
__device__ __forceinline__ float softplusf_(float x) { return fmaxf(x, 0.f) + log1pf(__expf(-fabsf(x))); }

namespace pg8 {
constexpr int BM = 256, BK = 64, HALF = 128, HTB = HALF * BK * 2, STAGE_BYTES = 8 * HTB, NXCD = 8, WGM = 8;
__host__ __device__ __forceinline__ int lds_byte(int r, int c) { return r * 128 + (((c >> 3) ^ ((r >> 1) & 7)) << 4) + (c & 7) * 2; }
__host__ __device__ __forceinline__ void stage_rc(int b, int& R, int& C) { R = b >> 7; C = ((((b & 127) >> 4) ^ ((R >> 1) & 7)) << 3); }
__host__ __device__ __forceinline__ int perm32(int rho) { const int n = rho >> 4, i = rho & 15; return 8 * (i >> 2) + 4 * n + (i & 3); }

struct Unit { int rowA, rowB, pn, e, rk0, cnt, hn; };
struct Gemm { const bf16* A; const bf16* Bt; int lda, ldb, K; const int* list; };

struct StaticOrder {
    int nM, nN, nwg, G, c;
    __device__ void init(int M, int N, int G_, int c_) { nM = M / BM; nN = N / BM; nwg = nM * nN; G = G_; c = c_; }
    __device__ bool next(int i, Unit& u) const {
        const long L = (long)i * G + c; if (L >= nwg) return false;
        int wgid = (int)L; { const int q = nwg / NXCD, r = nwg % NXCD, xcd = wgid % NXCD, off = wgid / NXCD; wgid = (xcd < r ? xcd * (q + 1) : r * (q + 1) + (xcd - r) * q) + off; }
        const int nig = WGM * nN, gid = wgid / nig, fm = gid * WGM, gsz = (nM - fm) < WGM ? (nM - fm) : WGM;
        const int pm = fm + ((wgid % nig) % gsz); u.pn = (wgid % nig) / gsz; u.rowA = pm * BM; u.rowB = u.pn * BM; u.e = 0; u.rk0 = 0; u.cnt = 0; u.hn = 0; return true;
    }
};
struct ProbeOrder {
    StaticOrder so; int mode;
    __device__ bool next(int i, Unit& u) const { if (!so.next(i, u)) return false; u.e = (u.rowA >> 8) * 64 + u.pn; if (mode & 1) u.rowA = 0; if (mode & 2) u.rowB = 0; return true; }
};
struct MoeOrder {
    const volatile LAS int* tab; int nct, rowsB, G, c;
    bool nsplit;
    __device__ bool next(int i, Unit& u) const {
        int L = i * G + c; const int total = __builtin_amdgcn_readfirstlane(tab[32]); int hn = 0;
        if (nsplit) { const int rf = (total / G) * G, r = total - rf;
            if (r > 0 && 2 * r <= G && L >= rf) { const int j = L - rf; if (j >= 2 * r) return false; L = rf + (j >> 1); hn = 1 + (j & 1); } }
        if (L >= total) return false;
        u.hn = hn;
        int e = 0;
        for (; e < 31; ++e) { if (L < __builtin_amdgcn_readfirstlane(tab[e + 1])) break; }
        const int local = L - __builtin_amdgcn_readfirstlane(tab[e]); const int nt = __builtin_amdgcn_readfirstlane(tab[72 + e]);
        const int ct = local / nt, rt = local - ct * nt;
        u.rowA = __builtin_amdgcn_readfirstlane(tab[36 + e]) + rt * BM; u.rowB = e * rowsB + ct * BM + (hn == 2 ? HALF : 0); u.pn = ct; u.e = e; u.rk0 = rt * BM; u.cnt = __builtin_amdgcn_readfirstlane(tab[108 + e]); return true;
    }
};

__device__ __forceinline__ unsigned cvt_pk_bf16(float lo, float hi) { unsigned r; asm volatile("v_cvt_pk_bf16_f32 %0, %1, %2" : "=v"(r) : "v"(lo), "v"(hi)); return r; }

struct EpiBf16 {
    static constexpr bool PERM = true;
    bf16* O; int ldc; const float* bias; int bias_estride; float scale;
    __device__ __forceinline__ void operator()(const f32x4 (&acc)[2][2][4][2], const Unit& u, int wr, int wc, int fr, int fq) const {
        const int row0 = u.rowA + wr * 64 + fr, col0 = u.pn * BM + wc * 32 + 8 * fq;
        f32x4 bv[2][2];
#pragma unroll
        for (int bj = 0; bj < 2; ++bj)
#pragma unroll
            for (int n = 0; n < 2; ++n) bv[bj][n] = bias ? *(const f32x4*)(bias + (size_t)u.e * bias_estride + col0 + bj * HALF + 4 * n) : (f32x4){0.f, 0.f, 0.f, 0.f};
#pragma unroll
        for (int ai = 0; ai < 2; ++ai)
#pragma unroll
            for (int m = 0; m < 4; ++m) { bf16* rowp = O + (size_t)(row0 + ai * HALF + m * 16) * ldc + col0;
#pragma unroll
                for (int bj = 0; bj < 2; ++bj) { const f32x4 v0 = acc[ai][bj][m][0] * scale + bv[bj][0], v1 = acc[ai][bj][m][1] * scale + bv[bj][1];
                    v4u w; w.x = cvt_pk_bf16(v0[0], v0[1]); w.y = cvt_pk_bf16(v0[2], v0[3]); w.z = cvt_pk_bf16(v1[0], v1[1]); w.w = cvt_pk_bf16(v1[2], v1[3]);
                    *(v4u*)(rowp + bj * HALF) = w; } }
    }
};
struct EpiBf16H {
    static constexpr bool PERM = true;
    bf16* O; int ldc; const float* bias; int bias_estride; float scale;
    __device__ __forceinline__ void operator()(const f32x4 (&acc)[2][2][4][2], const Unit& u, int wr, int wc, int fr, int fq) const {
        const int row0 = u.rowA + wr * 64 + fr, col0 = u.pn * BM + wc * 32 + 8 * fq + (u.hn == 2 ? HALF : 0);
#pragma unroll
        for (int bj = 0; bj < 2; ++bj) { if (bj == 1 && u.hn != 0) break;
            f32x4 bv[2];
#pragma unroll
            for (int n = 0; n < 2; ++n) bv[n] = *(const f32x4*)(bias + (size_t)u.e * bias_estride + col0 + bj * HALF + 4 * n);
#pragma unroll
            for (int ai = 0; ai < 2; ++ai)
#pragma unroll
                for (int m = 0; m < 4; ++m) { bf16* rowp = O + (size_t)(row0 + ai * HALF + m * 16) * ldc + col0;
                    const f32x4 v0 = acc[ai][bj][m][0] * scale + bv[0], v1 = acc[ai][bj][m][1] * scale + bv[1];
                    v4u w; w.x = cvt_pk_bf16(v0[0], v0[1]); w.y = cvt_pk_bf16(v0[2], v0[3]); w.z = cvt_pk_bf16(v1[0], v1[1]); w.w = cvt_pk_bf16(v1[2], v1[3]);
                    *(v4u*)(rowp + bj * HALF) = w; } }
    }
};
struct EpiProbe {
    static constexpr bool PERM = true;
    bf16* O;
    __device__ __forceinline__ void operator()(const f32x4 (&acc)[2][2][4][2], const Unit& u, int wr, int wc, int fr, int fq) const {
        const int pm = u.e >> 6, pn = u.e & 63; const int row0 = pm * BM + wr * 64 + fr, col0 = pn * BM + wc * 32 + 8 * fq;
#pragma unroll
        for (int ai = 0; ai < 2; ++ai)
#pragma unroll
            for (int m = 0; m < 4; ++m) { bf16* rowp = O + (size_t)(row0 + ai * HALF + m * 16) * PLD + col0;
#pragma unroll
                for (int bj = 0; bj < 2; ++bj) { const f32x4 v0 = acc[ai][bj][m][0], v1 = acc[ai][bj][m][1];
                    v4u w; w.x = cvt_pk_bf16(v0[0], v0[1]); w.y = cvt_pk_bf16(v0[2], v0[3]); w.z = cvt_pk_bf16(v1[0], v1[1]); w.w = cvt_pk_bf16(v1[2], v1[3]);
                    *(v4u*)(rowp + bj * HALF) = w; } }
    }
};
template <bool ADD> struct EpiGate {
    static constexpr bool PERM = true;
    bf16* O; const bf16* P; const float* bm; int gcol;
    __device__ __forceinline__ void operator()(const f32x4 (&acc)[2][2][4][2], const Unit& u, int wr, int wc, int fr, int fq) const {
        const int row0 = u.rowA + wr * 64 + fr, col0 = u.pn * BM + wc * 32 + 8 * fq;
        f32x4 bv[2][2];
#pragma unroll
        for (int bj = 0; bj < 2; ++bj)
#pragma unroll
            for (int n = 0; n < 2; ++n) bv[bj][n] = *(const f32x4*)(bm + col0 + bj * HALF + 4 * n);
#pragma unroll
        for (int ai = 0; ai < 2; ++ai)
#pragma unroll
            for (int m = 0; m < 4; ++m) { const size_t row = (size_t)(row0 + ai * HALF + m * 16);
#pragma unroll
                for (int bj = 0; bj < 2; ++bj) {
                    const v4u pg = *(const v4u*)(P + row * PLD + gcol + col0 + bj * HALF);
                    bf16* op = O + row * D + col0 + bj * HALF;
                    float g[8] = {bflo(pg.x), bfhi(pg.x), bflo(pg.y), bfhi(pg.y), bflo(pg.z), bfhi(pg.z), bflo(pg.w), bfhi(pg.w)};
                    float r[8];
#pragma unroll
                    for (int j = 0; j < 4; ++j) { r[j] = sigmoidf_(g[j] + bv[bj][0][j]) * acc[ai][bj][m][0][j]; r[4 + j] = sigmoidf_(g[4 + j] + bv[bj][1][j]) * acc[ai][bj][m][1][j]; }
                    if (ADD) { const v4u pv = *(const v4u*)op;
                        r[0] += bflo(pv.x); r[1] += bfhi(pv.x); r[2] += bflo(pv.y); r[3] += bfhi(pv.y); r[4] += bflo(pv.z); r[5] += bfhi(pv.z); r[6] += bflo(pv.w); r[7] += bfhi(pv.w); }
                    v4u w; w.x = cvt_pk_bf16(r[0], r[1]); w.y = cvt_pk_bf16(r[2], r[3]); w.z = cvt_pk_bf16(r[4], r[5]); w.w = cvt_pk_bf16(r[6], r[7]);
                    *(v4u*)op = w; } }
    }
};
struct EpiResF32 {
    static constexpr bool PERM = false;
    float* O; const float* X;
    __device__ __forceinline__ void operator()(const f32x4 (&acc)[2][2][4][2], const Unit& u, int wr, int wc, int fr, int fq) const {
        const int row0 = u.rowA + wr * 64 + fr, col0 = u.pn * BM + wc * 32 + 4 * fq;
#pragma unroll
        for (int ai = 0; ai < 2; ++ai)
#pragma unroll
            for (int m = 0; m < 4; ++m) { const size_t ro = (size_t)(row0 + ai * HALF + m * 16) * D + col0;
#pragma unroll
                for (int bj = 0; bj < 2; ++bj)
#pragma unroll
                    for (int n = 0; n < 2; ++n) *(f32x4*)(O + ro + bj * HALF + n * 16) = acc[ai][bj][m][n] + __builtin_nontemporal_load((const f32x4*)(X + ro + bj * HALF + n * 16)); }
    }
};
struct EpiGlu {
    static constexpr bool PERM = true;
    bf16* O; const float* bg; const float* bu;
    __device__ __forceinline__ void operator()(const f32x4 (&acc)[2][2][4][2], const Unit& u, int wr, int wc, int fr, int fq) const {
        const int row0 = u.rowA + wr * 64 + fr, col0 = u.pn * HALF + wc * 32 + 8 * fq;
        f32x4 gb[2], ub[2];
#pragma unroll
        for (int n = 0; n < 2; ++n) { gb[n] = *(const f32x4*)(bg + (size_t)u.e * FF + col0 + 4 * n); ub[n] = *(const f32x4*)(bu + (size_t)u.e * FF + col0 + 4 * n); }
#pragma unroll
        for (int ai = 0; ai < 2; ++ai)
#pragma unroll
            for (int m = 0; m < 4; ++m) { bf16* op = O + (size_t)(row0 + ai * HALF + m * 16) * FF + col0;
                float r[8];
#pragma unroll
                for (int n = 0; n < 2; ++n)
#pragma unroll
                    for (int j = 0; j < 4; ++j) { float g = fminf(acc[ai][0][m][n][j] + gb[n][j], 7.f); float up = fminf(fmaxf(acc[ai][1][m][n][j] + ub[n][j], -7.f), 7.f);
                        r[4 * n + j] = (up + 1.f) * g * sigmoidf_(1.702f * g); }
                v4u w; w.x = cvt_pk_bf16(r[0], r[1]); w.y = cvt_pk_bf16(r[2], r[3]); w.z = cvt_pk_bf16(r[4], r[5]); w.w = cvt_pk_bf16(r[6], r[7]);
                *(v4u*)op = w; }
    }
};

struct EpiGluQ {
    static constexpr bool PERM = true;
    unsigned char* O; const float* bg; const float* bu;
    __device__ __forceinline__ void operator()(const f32x4 (&acc)[2][2][4][2], const Unit& u, int wr, int wc, int fr, int fq) const {
        const int row0 = u.rowA + wr * 64 + fr, col0 = u.pn * HALF + wc * 32 + 8 * fq;
        f32x4 gb[2], ub[2];
#pragma unroll
        for (int n = 0; n < 2; ++n) { gb[n] = *(const f32x4*)(bg + (size_t)u.e * FF + col0 + 4 * n); ub[n] = *(const f32x4*)(bu + (size_t)u.e * FF + col0 + 4 * n); }
#pragma unroll
        for (int ai = 0; ai < 2; ++ai)
#pragma unroll
            for (int m = 0; m < 4; ++m) { unsigned char* op = O + (size_t)(row0 + ai * HALF + m * 16) * FF + col0;
                float r[8];
#pragma unroll
                for (int n = 0; n < 2; ++n)
#pragma unroll
                    for (int j = 0; j < 4; ++j) { float g = fminf(acc[ai][0][m][n][j] * WQ_INV + gb[n][j], 7.f); float up = fminf(fmaxf(acc[ai][1][m][n][j] * WQ_INV + ub[n][j], -7.f), 7.f);
                        r[4 * n + j] = (up + 1.f) * g * sigmoidf_(1.702f * g); }
                v2u w; w.x = pk4_fp8(r[0], r[1], r[2], r[3]); w.y = pk4_fp8(r[4], r[5], r[6], r[7]);
                *(v2u*)op = w; }
    }
};

template <class Epi, class Sched, int ESZ = 2, bool GATHER = false, bool ALIGN_EPI = true, bool NSPLIT = false>
__device__ __forceinline__ void gemm_phase(LAS unsigned char* lds, const Gemm g, const Sched& S, const Epi& E) {
    const int tid = threadIdx.x, wid = __builtin_amdgcn_readfirstlane(tid >> 6), lane = tid & 63, wr = wid >> 2, wc = wid & 3, fr = lane & 15, fq = lane >> 4;
    const int K = g.K, nt = K * ESZ / (BK * 2);
    unsigned voffA[2], voffB[2]; int Rst[2], Cst[2];
#pragma unroll
    for (int i = 0; i < 2; ++i) { int R, C; stage_rc(tid * 16 + i * 8192, R, C); const int Rb = Epi::PERM ? ((R & ~31) + perm32(R & 31)) : R; Rst[i] = R; Cst[i] = C * 2;
        voffA[i] = (unsigned)(R * g.lda * ESZ + C * 2); voffB[i] = (unsigned)(Rb * g.ldb * ESZ + C * 2); }
    const size_t kstep = (size_t)(BK * 2);
    const size_t hstepA = (size_t)HALF * g.lda * ESZ, hstepB = (size_t)HALF * g.ldb * ESZ;
    const unsigned ldsw = (unsigned)wid * 1024u;
    const int aoff = lds_byte(wr * 64 + fr, fq * 8), boff = lds_byte(wc * 32 + fr, fq * 8);
#define PG8_SA(b, h) (((b) * 2 + (h)) * HTB)
#define PG8_SB(b, h) ((4 + (b) * 2 + (h)) * HTB)
#define PG8_STAGE(bufoff, gbase, voff) do { _Pragma("unroll") for (int _i = 0; _i < 2; ++_i) \
        __builtin_amdgcn_global_load_lds((const unsigned*)((const char*)(gbase) + (voff)[_i]), (LAS unsigned*)(lds + (bufoff) + ldsw + _i * 8192), 16, 0, 0); } while (0)
#define PG8_GOFF(u_, v_) do { _Pragma("unroll") for (int h_ = 0; h_ < 2; ++h_) _Pragma("unroll") for (int i_ = 0; i_ < 2; ++i_) { const int rk_ = (u_).rk0 + 128 * h_ + Rst[i_]; \
        const int tok_ = rk_ < (u_).cnt ? g.list[(u_).e * 8192 + rk_] : 0; (v_)[h_][i_] = (unsigned)tok_ * (unsigned)(g.lda * ESZ) + (unsigned)Cst[i_]; } } while (0)
#define PG8_STAGE_A(bufoff, isnext, tt, h) do { if constexpr (GATHER) { unsigned vo_[2] = {(isnext) ? vN[h][0] : vA[h][0], (isnext) ? vN[h][1] : vA[h][1]}; PG8_STAGE(bufoff, (const char*)g.A + (size_t)(tt) * kstep, vo_); } \
        else PG8_STAGE(bufoff, ((isnext) ? nA : cA) + (size_t)(tt) * kstep + (size_t)(h) * hstepA, voffA); } while (0)
#define PG8_LD16(off_) (*(const LAS v4i*)(lds + (off_)))
#define PG8_LDA(dst, b, h) do { if constexpr (ESZ == 2) { _Pragma("unroll") for (int m = 0; m < 4; ++m) _Pragma("unroll") for (int k = 0; k < 2; ++k) dst[m][k] = *(const LAS bf16x8*)(lds + PG8_SA(b, h) + (k ? (aoff ^ 64) : aoff) + m * 2048); } \
        else { _Pragma("unroll") for (int m = 0; m < 4; ++m) dst##8[m] = __builtin_shufflevector(PG8_LD16(PG8_SA(b, h) + aoff + m * 2048), PG8_LD16(PG8_SA(b, h) + (aoff ^ 64) + m * 2048), 0, 1, 2, 3, 4, 5, 6, 7); } } while (0)
#define PG8_LDB(dst, b, h) do { if constexpr (ESZ == 2) { _Pragma("unroll") for (int n = 0; n < 2; ++n) _Pragma("unroll") for (int k = 0; k < 2; ++k) dst[n][k] = *(const LAS bf16x8*)(lds + PG8_SB(b, h) + (k ? (boff ^ 64) : boff) + n * 2048); } \
        else { _Pragma("unroll") for (int n = 0; n < 2; ++n) dst##8[n] = __builtin_shufflevector(PG8_LD16(PG8_SB(b, h) + boff + n * 2048), PG8_LD16(PG8_SB(b, h) + (boff ^ 64) + n * 2048), 0, 1, 2, 3, 4, 5, 6, 7); } } while (0)
#define PG8_MMA(ai, bj, At, Bt) do { __builtin_amdgcn_s_setprio(1); _Pragma("unroll") for (int m = 0; m < 4; ++m) _Pragma("unroll") for (int n = 0; n < 2; ++n) { \
        if constexpr (ESZ == 2) { _Pragma("unroll") for (int k = 0; k < 2; ++k) acc[ai][bj][m][n] = __builtin_amdgcn_mfma_f32_16x16x32_bf16(Bt[n][k], At[m][k], acc[ai][bj][m][n], 0, 0, 0); } \
        else asm volatile("s_nop 1\n\tv_mfma_scale_f32_16x16x128_f8f6f4 %0, %1, %2, %0, %3, %3 op_sel_hi:[0,0,0]" : "+v"(acc[ai][bj][m][n]) : "v"(Bt##8[n]), "v"(At##8[m]), "v"(one_scale)); } \
        __builtin_amdgcn_s_setprio(0); } while (0)
#define PG8_WAIT_V(n) asm volatile("s_waitcnt vmcnt(" #n ")" ::: "memory")
#define PG8_WAIT_L(n) asm volatile("s_waitcnt lgkmcnt(" #n ")" ::: "memory")
#define PG8_BAR __builtin_amdgcn_s_barrier()
#define PG8_SCHED __builtin_amdgcn_sched_barrier(0)
    Unit cur, nxt; int ui = 0;
    if (!S.next(0, cur)) return;
    f32x4 acc[2][2][4][2];
#pragma unroll
    for (int a = 0; a < 2; ++a)
#pragma unroll
        for (int b = 0; b < 2; ++b)
#pragma unroll
            for (int m = 0; m < 4; ++m)
#pragma unroll
                for (int n = 0; n < 2; ++n) acc[a][b][m][n] = (f32x4){0.f, 0.f, 0.f, 0.f};
    const int one_scale = 0x7F7F7F7F;
    bf16x8 At[4][2], B0[2][2], B1[2][2]; v8i At8[4], B08[2], B18[2];
    const char* cA = (const char*)g.A + (size_t)cur.rowA * g.lda * ESZ; const char* cB = (const char*)g.Bt + (size_t)cur.rowB * g.ldb * ESZ;
    unsigned vA[2][2] = {{0u, 0u}, {0u, 0u}}, vN[2][2] = {{0u, 0u}, {0u, 0u}}; const char* nA = cA;
    if constexpr (GATHER) PG8_GOFF(cur, vA);
    PG8_STAGE(PG8_SB(0, 0), cB, voffB); PG8_STAGE(PG8_SB(0, 1), cB + hstepB, voffB); PG8_STAGE_A(PG8_SA(0, 0), false, 0, 0); PG8_STAGE_A(PG8_SA(0, 1), false, 0, 1);
    if (wr == 1) PG8_BAR;
    PG8_WAIT_V(2); PG8_BAR;
    PG8_STAGE(PG8_SB(1, 0), cB + kstep, voffB); PG8_STAGE_A(PG8_SA(1, 0), false, 1, 0); PG8_STAGE(PG8_SB(1, 1), cB + hstepB + kstep, voffB);
    PG8_WAIT_V(6); PG8_BAR;
    for (;;) {
        const bool has_next = S.next(ui + 1, nxt);
        nA = has_next ? (const char*)g.A + (size_t)nxt.rowA * g.lda * ESZ : cA; const char* nB = has_next ? (const char*)g.Bt + (size_t)nxt.rowB * g.ldb * ESZ : cB;
        if constexpr (GATHER) { if (has_next) PG8_GOFF(nxt, vN); else { vN[0][0] = vA[0][0]; vN[0][1] = vA[0][1]; vN[1][0] = vA[1][0]; vN[1][1] = vA[1][1]; } }
        const bool hnz = NSPLIT && cur.hn != 0;
        for (int t = 0; t < nt; t += 2) {
            const bool last = (t == nt - 2);
            const char* b2 = last ? nB : cB + (size_t)(t + 2) * kstep; const char* b3 = b2 + kstep;
            const int t2 = last ? 0 : t + 2, t3 = last ? 1 : t + 3;
            PG8_LDB(B0, 0, 0); if (NSPLIT ? !hnz : true) PG8_LDB(B1, 0, 1); PG8_SCHED; PG8_LDA(At, 0, 0); PG8_STAGE_A(PG8_SA(1, 1), false, t + 1, 1);
            PG8_WAIT_V(8); PG8_WAIT_L(0); PG8_BAR; PG8_MMA(0, 0, At, B0); if (NSPLIT ? !hnz : true) PG8_MMA(0, 1, At, B1); PG8_BAR; PG8_SCHED;
            PG8_LDA(At, 0, 1); PG8_STAGE(PG8_SB(0, 0), b2, voffB); PG8_STAGE(PG8_SB(0, 1), b2 + hstepB, voffB); PG8_STAGE_A(PG8_SA(0, 0), last, t2, 0);
            PG8_WAIT_V(8); PG8_WAIT_L(0); PG8_BAR; PG8_MMA(1, 0, At, B0); if (NSPLIT ? !hnz : true) PG8_MMA(1, 1, At, B1); PG8_BAR; PG8_SCHED;
            PG8_LDB(B0, 1, 0); if (NSPLIT ? !hnz : true) PG8_LDB(B1, 1, 1); PG8_SCHED; PG8_LDA(At, 1, 0); PG8_STAGE_A(PG8_SA(0, 1), last, t2, 1);
            PG8_WAIT_V(8); PG8_WAIT_L(0); PG8_BAR; PG8_MMA(0, 0, At, B0); if (NSPLIT ? !hnz : true) PG8_MMA(0, 1, At, B1); PG8_BAR; PG8_SCHED;
            PG8_LDA(At, 1, 1); PG8_STAGE(PG8_SB(1, 0), b3, voffB); PG8_STAGE(PG8_SB(1, 1), b3 + hstepB, voffB); PG8_STAGE_A(PG8_SA(1, 0), last, t3, 0);
            PG8_WAIT_V(8); PG8_WAIT_L(0); PG8_BAR; PG8_MMA(1, 0, At, B0); if (NSPLIT ? !hnz : true) PG8_MMA(1, 1, At, B1); PG8_BAR; PG8_SCHED;
        }
        if constexpr (ESZ == 1) asm volatile("s_nop 15\n\ts_nop 15" ::: "memory");
        if constexpr (ALIGN_EPI) { if (wr == 0) PG8_BAR; }
        E(acc, cur, wr, wc, fr, fq);
        if (!has_next) break;
#pragma unroll
        for (int a = 0; a < 2; ++a)
#pragma unroll
            for (int b = 0; b < 2; ++b)
#pragma unroll
                for (int m = 0; m < 4; ++m)
#pragma unroll
                    for (int n = 0; n < 2; ++n) acc[a][b][m][n] = (f32x4){0.f, 0.f, 0.f, 0.f};
        cur = nxt; cA = nA; cB = nB; ++ui;
        if constexpr (GATHER) { vA[0][0] = vN[0][0]; vA[0][1] = vN[0][1]; vA[1][0] = vN[1][0]; vA[1][1] = vN[1][1]; }
        if constexpr (ALIGN_EPI) { if (wr == 1) PG8_BAR; }
    }
    PG8_WAIT_V(0);
    if constexpr (!ALIGN_EPI) { if (wr == 0) PG8_BAR; }
    PG8_BAR;
#undef PG8_SA
#undef PG8_SB
#undef PG8_STAGE
#undef PG8_LDA
#undef PG8_LD16
#undef PG8_GOFF
#undef PG8_STAGE_A
#undef PG8_LDB
#undef PG8_MMA
#undef PG8_WAIT_V
#undef PG8_WAIT_L
#undef PG8_BAR
#undef PG8_SCHED
}

typedef short s16x4 __attribute__((ext_vector_type(4)));
struct UnitF { int rowA, pn, e; const float* b0; const float* b1; };
struct GemmF { const bf16* A; int lda, K, ldbn; };
struct MoeOrderF {
    const volatile LAS int* tab; int nct, G, c; const float* w0; const float* w1; size_t estride; int cstep;
    __device__ bool next(int i, UnitF& u) const {
        const int L = i * G + c; const int total = __builtin_amdgcn_readfirstlane(tab[32]); if (L >= total) return false;
        int e = 0;
        for (; e < 31; ++e) { if (L < __builtin_amdgcn_readfirstlane(tab[e + 1])) break; }
        const int local = L - __builtin_amdgcn_readfirstlane(tab[e]); const int nt = __builtin_amdgcn_readfirstlane(tab[72 + e]);
        const int ct = local / nt, rt = local - ct * nt;
        u.rowA = __builtin_amdgcn_readfirstlane(tab[36 + e]) + rt * BM; u.pn = ct; u.e = e;
        u.b0 = w0 + (size_t)e * estride + (size_t)ct * cstep; u.b1 = w1 + (size_t)e * estride + (size_t)ct * cstep; return true;
    }
};
struct EpiGluNP {
    bf16* O; const float* bg; const float* bu;
    __device__ __forceinline__ void operator()(const f32x4 (&acc)[2][2][4][2], const UnitF& u, int wr, int wc, int fr, int fq) const {
        const int row0 = u.rowA + wr * 64 + fr, col0 = u.pn * HALF + wc * 32 + 4 * fq;
        f32x4 gb[2], ub[2];
#pragma unroll
        for (int n = 0; n < 2; ++n) { gb[n] = *(const f32x4*)(bg + (size_t)u.e * FF + col0 + 16 * n); ub[n] = *(const f32x4*)(bu + (size_t)u.e * FF + col0 + 16 * n); }
#pragma unroll
        for (int ai = 0; ai < 2; ++ai)
#pragma unroll
            for (int m = 0; m < 4; ++m) { bf16* op = O + (size_t)(row0 + ai * HALF + m * 16) * FF + col0;
#pragma unroll
                for (int n = 0; n < 2; ++n) { float r[4];
#pragma unroll
                    for (int j = 0; j < 4; ++j) { const float gg = fminf(acc[ai][0][m][n][j] + gb[n][j], 7.f); const float up = fminf(fmaxf(acc[ai][1][m][n][j] + ub[n][j], -7.f), 7.f);
                        r[j] = (up + 1.f) * gg * sigmoidf_(1.702f * gg); }
                    v2u w; w.x = cvt_pk_bf16(r[0], r[1]); w.y = cvt_pk_bf16(r[2], r[3]); *(v2u*)(op + 16 * n) = w; } }
    }
};
struct EpiBf16NP {
    bf16* O; int ldc; const float* bias; int bias_estride;
    __device__ __forceinline__ void operator()(const f32x4 (&acc)[2][2][4][2], const UnitF& u, int wr, int wc, int fr, int fq) const {
        const int row0 = u.rowA + wr * 64 + fr, col0 = u.pn * BM + wc * 32 + 4 * fq;
        f32x4 bv[2][2];
#pragma unroll
        for (int bj = 0; bj < 2; ++bj)
#pragma unroll
            for (int n = 0; n < 2; ++n) bv[bj][n] = *(const f32x4*)(bias + (size_t)u.e * bias_estride + col0 + bj * HALF + 16 * n);
#pragma unroll
        for (int ai = 0; ai < 2; ++ai)
#pragma unroll
            for (int m = 0; m < 4; ++m) { bf16* rowp = O + (size_t)(row0 + ai * HALF + m * 16) * ldc + col0;
#pragma unroll
                for (int bj = 0; bj < 2; ++bj)
#pragma unroll
                    for (int n = 0; n < 2; ++n) { const f32x4 v = acc[ai][bj][m][n] + bv[bj][n]; v2u w; w.x = cvt_pk_bf16(v[0], v[1]); w.y = cvt_pk_bf16(v[2], v[3]); *(v2u*)(rowp + bj * HALF + 16 * n) = w; } }
    }
};
template <class Epi, class Sched>
__device__ __forceinline__ void gemm_phase_f32b(LAS unsigned char* lds, const GemmF g, const Sched& S, const Epi& E) {
    const int tid = threadIdx.x, wid = __builtin_amdgcn_readfirstlane(tid >> 6), lane = tid & 63, wr = wid >> 2, wc = wid & 3, fr = lane & 15, fq = lane >> 4;
    const int K = g.K, nt = K / BK;
    unsigned voffA[2];
#pragma unroll
    for (int i = 0; i < 2; ++i) { int R, C; stage_rc(tid * 16 + i * 8192, R, C); voffA[i] = (unsigned)(R * g.lda + C) * 2u; }
    const size_t kstep = (size_t)(BK * 2);
    const size_t hstepA = (size_t)HALF * g.lda * 2;
    const unsigned ldsw = (unsigned)wid * 1024u;
    const int aoff = lds_byte(wr * 64 + fr, fq * 8);
    const int ldsb = (int)(uintptr_t)lds;
    const int q4 = (lane & 15) >> 2, p4 = lane & 3;
    const int fsw = q4 | ((fq & 1) << 2);
    int rbase[2];
#pragma unroll
    for (int n = 0; n < 2; ++n) rbase[n] = (8 * fq + q4) * 256 + ((((wc * 2) ^ fsw) ^ n) * 32) + 8 * p4;
    const int hB = wid >> 2, r0 = 2 * (wid & 3) + (lane >> 5), l31 = lane & 31;
    const int wslot = (l31 >> 2) ^ (r0 & 3);
    const int wb0 = hB * HTB + r0 * 256 + wslot * 32 + (lane & 3) * 8, wb1 = hB * HTB + r0 * 256 + (wslot ^ 4) * 32 + (lane & 3) * 8;
    const unsigned laneoffB = (unsigned)(r0 * g.ldbn + 4 * l31) * 4u;
    const size_t rstep8 = (size_t)8 * g.ldbn * 4, tstepB = (size_t)64 * g.ldbn * 4;
#define PG8_SA(b, h) (((b) * 2 + (h)) * HTB)
#define PG8_SB(b, h) ((4 + (b) * 2 + (h)) * HTB)
#define PG8_STAGE(bufoff, gbase, voff) do { _Pragma("unroll") for (int _i = 0; _i < 2; ++_i) { unsigned keep_; \
        asm volatile("s_mov_b32 %0, m0\n\ts_mov_b32 m0, %2\n\ts_nop 0\n\tglobal_load_lds_dwordx4 %1, off\n\ts_mov_b32 m0, %0" : "=&s"(keep_) \
            : "v"((const char*)(gbase) + (voff)[_i]), "s"(__builtin_amdgcn_readfirstlane(ldsb + (bufoff) + (int)ldsw + _i * 8192)) : "memory"); } } while (0)
#define PG8_LDA(dst, b, h) do { _Pragma("unroll") for (int m = 0; m < 4; ++m) _Pragma("unroll") for (int k = 0; k < 2; ++k) dst[m][k] = *(const LAS bf16x8*)(lds + PG8_SA(b, h) + (k ? (aoff ^ 64) : aoff) + m * 2048); } while (0)
#define PG8_LDBT(dst, b, h) do { _Pragma("unroll") for (int n = 0; n < 2; ++n) _Pragma("unroll") for (int k = 0; k < 2; ++k) { \
        const s16x4 lo_ = __builtin_amdgcn_ds_read_tr16_b64_v4i16((LAS s16x4*)(lds + PG8_SB(b, h) + rbase[n] + k * 8192)); \
        const s16x4 hi_ = __builtin_amdgcn_ds_read_tr16_b64_v4i16((LAS s16x4*)(lds + PG8_SB(b, h) + rbase[n] + k * 8192 + 1024)); \
        dst[n][k] = __builtin_shufflevector(lo_, hi_, 0, 1, 2, 3, 4, 5, 6, 7); } } while (0)
#define PG8_BPTR(p0, p1, tt) ((const char*)(hB ? (p1) : (p0)) + (size_t)(tt) * tstepB)
#define PG8_LOADB1(pb, i) dreg[i] = *(const f32x4*)((pb) + (size_t)(i) * rstep8 + laneoffB)
#define PG8_LOADB(p0, p1, tt) do { const char* pb_ = PG8_BPTR(p0, p1, tt); _Pragma("unroll") for (int _i = 0; _i < 8; ++_i) PG8_LOADB1(pb_, _i); } while (0)
#define PG8_WRITEB1(b, i) do { v2u pk_; pk_.x = cvt_pk_bf16(dreg[i].x, dreg[i].y); pk_.y = cvt_pk_bf16(dreg[i].z, dreg[i].w); \
        *(LAS v2u*)(lds + PG8_SB(b, 0) + (((i) & 1) ? wb1 : wb0) + (i) * 2048) = pk_; } while (0)
#define PG8_WRITEB(b) do { _Pragma("unroll") for (int _i = 0; _i < 8; ++_i) PG8_WRITEB1(b, _i); } while (0)
#define PG8_MF(ai, bj, m, At, Bt) do { _Pragma("unroll") for (int n = 0; n < 2; ++n) _Pragma("unroll") for (int k = 0; k < 2; ++k) \
        acc[ai][bj][m][n] = __builtin_amdgcn_mfma_f32_16x16x32_bf16(Bt[n][k], At[m][k], acc[ai][bj][m][n], 0, 0, 0); } while (0)
#define PG8_MMA(ai, bj, At, Bt) do { __builtin_amdgcn_s_setprio(1); _Pragma("unroll") for (int m = 0; m < 4; ++m) PG8_MF(ai, bj, m, At, Bt); __builtin_amdgcn_s_setprio(0); } while (0)
#define PG8_MMA_CVT(ai, bj, At, Bt, b) do { __builtin_amdgcn_s_setprio(1); _Pragma("unroll") for (int m = 0; m < 4; ++m) { PG8_MF(ai, bj, m, At, Bt); PG8_WRITEB1(b, 2 * m); PG8_WRITEB1(b, 2 * m + 1); PG8_SCHED; } __builtin_amdgcn_s_setprio(0); } while (0)
#define PG8_MMA_LD(ai, bj, At, Bt, pb) do { __builtin_amdgcn_s_setprio(1); _Pragma("unroll") for (int m = 0; m < 4; ++m) { PG8_MF(ai, bj, m, At, Bt); PG8_LOADB1(pb, 2 * m); PG8_LOADB1(pb, 2 * m + 1); PG8_SCHED; } __builtin_amdgcn_s_setprio(0); } while (0)
#define PG8_WAIT_V(n) asm volatile("s_waitcnt vmcnt(" #n ")" ::: "memory")
#define PG8_WAIT_L(n) asm volatile("s_waitcnt lgkmcnt(" #n ")" ::: "memory")
#define PG8_BAR __builtin_amdgcn_s_barrier()
#define PG8_SCHED __builtin_amdgcn_sched_barrier(0)
#define PG8_BS0(T) ((T) >= nt ? nb0 : cur.b0)
#define PG8_BS1(T) ((T) >= nt ? nb1 : cur.b1)
#define PG8_BT(T) ((T) >= nt ? (T) - nt : (T))
    UnitF cur, nxt; int ui = 0;
    if (!S.next(0, cur)) return;
    f32x4 acc[2][2][4][2];
#pragma unroll
    for (int a = 0; a < 2; ++a)
#pragma unroll
        for (int b = 0; b < 2; ++b)
#pragma unroll
            for (int m = 0; m < 4; ++m)
#pragma unroll
                for (int n = 0; n < 2; ++n) acc[a][b][m][n] = (f32x4){0.f, 0.f, 0.f, 0.f};
    bf16x8 At[4][2], B0[2][2], B1[2][2];
    f32x4 dreg[8];
    const char* cA = (const char*)g.A + (size_t)cur.rowA * g.lda * 2;
    PG8_STAGE(PG8_SA(0, 0), cA, voffA); PG8_STAGE(PG8_SA(0, 1), cA + hstepA, voffA); PG8_STAGE(PG8_SA(1, 0), cA + kstep, voffA);
    PG8_LOADB(cur.b0, cur.b1, 0); PG8_WRITEB(0); PG8_LOADB(cur.b0, cur.b1, 1); PG8_WRITEB(1); PG8_LOADB(cur.b0, cur.b1, 2);
    PG8_WAIT_V(8); PG8_WAIT_L(0);
    if (wr == 1) PG8_BAR;
    PG8_BAR;
    for (;;) {
        const bool has_next = S.next(ui + 1, nxt);
        const char* nA = has_next ? (const char*)g.A + (size_t)nxt.rowA * g.lda * 2 : cA;
        const float* nb0 = has_next ? nxt.b0 : cur.b0; const float* nb1 = has_next ? nxt.b1 : cur.b1;
        for (int t = 0; t < nt; t += 2) {
            const bool last = (t == nt - 2);
            const char* a1 = cA + (size_t)(t + 1) * kstep;
            const char* a2 = last ? nA : cA + (size_t)(t + 2) * kstep;
            const char* a3 = a2 + kstep;
            const char* pb3 = PG8_BPTR(PG8_BS0(t + 3), PG8_BS1(t + 3), PG8_BT(t + 3));
            const char* pb4 = PG8_BPTR(PG8_BS0(t + 4), PG8_BS1(t + 4), PG8_BT(t + 4));
            PG8_LDBT(B0, 0, 0); PG8_LDBT(B1, 0, 1); PG8_SCHED; PG8_LDA(At, 0, 0); PG8_STAGE(PG8_SA(1, 1), a1 + hstepA, voffA);
            PG8_WAIT_V(12); PG8_WAIT_L(0); PG8_SCHED; PG8_BAR; PG8_MMA(0, 0, At, B0); PG8_MMA(0, 1, At, B1); PG8_BAR; PG8_SCHED;
            PG8_LDA(At, 0, 1);
            PG8_WAIT_V(10); PG8_WAIT_L(0); PG8_SCHED; PG8_BAR; PG8_MMA_CVT(1, 0, At, B0, 0); PG8_STAGE(PG8_SA(0, 0), a2, voffA); PG8_MMA_LD(1, 1, At, B1, pb3); PG8_BAR; PG8_SCHED;
            PG8_LDBT(B0, 1, 0); PG8_LDBT(B1, 1, 1); PG8_SCHED; PG8_LDA(At, 1, 0); PG8_STAGE(PG8_SA(0, 1), a2 + hstepA, voffA);
            PG8_WAIT_V(12); PG8_WAIT_L(0); PG8_SCHED; PG8_BAR; PG8_MMA(0, 0, At, B0); PG8_MMA(0, 1, At, B1); PG8_BAR; PG8_SCHED;
            PG8_LDA(At, 1, 1);
            PG8_WAIT_V(10); PG8_WAIT_L(0); PG8_SCHED; PG8_BAR; PG8_MMA_CVT(1, 0, At, B0, 1); PG8_STAGE(PG8_SA(1, 0), a3, voffA); PG8_MMA_LD(1, 1, At, B1, pb4); PG8_BAR; PG8_SCHED;
        }
        if (wr == 0) PG8_BAR;
        E(acc, cur, wr, wc, fr, fq);
        if (!has_next) break;
#pragma unroll
        for (int a = 0; a < 2; ++a)
#pragma unroll
            for (int b = 0; b < 2; ++b)
#pragma unroll
                for (int m = 0; m < 4; ++m)
#pragma unroll
                    for (int n = 0; n < 2; ++n) acc[a][b][m][n] = (f32x4){0.f, 0.f, 0.f, 0.f};
        cur = nxt; cA = nA; ++ui;
        if (wr == 1) PG8_BAR;
    }
    PG8_WAIT_V(0);
    asm volatile("" :: "v"(dreg[0]), "v"(dreg[7]));
    PG8_BAR;
#undef PG8_SA
#undef PG8_SB
#undef PG8_STAGE
#undef PG8_LDA
#undef PG8_LDBT
#undef PG8_BPTR
#undef PG8_LOADB1
#undef PG8_LOADB
#undef PG8_WRITEB1
#undef PG8_WRITEB
#undef PG8_MF
#undef PG8_MMA
#undef PG8_MMA_CVT
#undef PG8_MMA_LD
#undef PG8_WAIT_V
#undef PG8_WAIT_L
#undef PG8_BAR
#undef PG8_SCHED
#undef PG8_BS0
#undef PG8_BS1
#undef PG8_BT
}
}

#define XB_TMO      128
#define XB_XCNT(j)  (256  + 64 * (j))
#define XB_XSUB(j)  (1280 + 64 * (j))
#define XB_XGEN(j)  (2304 + 64 * (j))
#define XB_TOP      3328
#define XB_TOPGEN   3392
#define XCD_BAR_WORDS 3456
#define XB_SPIN_CAP (1u << 18)
__device__ __forceinline__ unsigned xb_ld(unsigned* p)              { return __hip_atomic_load(p, __ATOMIC_RELAXED, __HIP_MEMORY_SCOPE_AGENT); }
__device__ __forceinline__ unsigned xb_add(unsigned* p, unsigned v) { return __hip_atomic_fetch_add(p, v, __ATOMIC_RELAXED, __HIP_MEMORY_SCOPE_AGENT); }
__device__ __forceinline__ unsigned xb_xcc_id() { return (unsigned)__builtin_amdgcn_s_getreg((3 << 11) | 20) & 0xFu; }
#define XB_SPIN(cond, bar) do { unsigned _sp = 0; while (cond) { __builtin_amdgcn_s_sleep(1); \
    if ((++_sp & 255u) == 0u) { if (xb_ld(&(bar)[XB_TMO])) break; if (_sp > XB_SPIN_CAP) { atomicAdd(&(bar)[XB_TMO], 1u); break; } } } } while (0)
struct XcdBarrier { unsigned* bar; unsigned x; volatile LAS unsigned* st; };
__device__ __forceinline__ XcdBarrier xcd_barrier_post(unsigned* bar, volatile LAS unsigned* st) {
    XcdBarrier b; b.bar = bar; b.x = xb_xcc_id(); b.st = st;
    if (threadIdx.x == 0) (void)xb_add(&bar[XB_XCNT(b.x)], 1u);
    return b;
}
__device__ __forceinline__ void xcd_barrier_complete(unsigned* bar, unsigned x, unsigned& nloc, unsigned& nx) {
    const unsigned G = gridDim.x * gridDim.y * gridDim.z;
    unsigned sum, cnt, mine, sp = 0u;
    for (;;) {
        sum = 0u; cnt = 0u; mine = 0u;
#pragma unroll
        for (unsigned j = 0; j < 16; ++j) { const unsigned c = xb_ld(&bar[XB_XCNT(j)]); sum += c; cnt += (c > 0u) ? 1u : 0u; mine = (j == x) ? c : mine; }
        if (sum == G) break;
        __builtin_amdgcn_s_sleep(1);
        if ((++sp & 255u) == 0u) { if (xb_ld(&bar[XB_TMO])) break; if (sp > XB_SPIN_CAP) { atomicAdd(&bar[XB_TMO], 1u); break; } }
    }
    nloc = mine > 0u ? mine : 1u; nx = cnt > 0u ? cnt : 1u;
}
__device__ __forceinline__ void xcd_barrier(const XcdBarrier& b) {
    asm volatile("s_waitcnt vmcnt(0)" ::: "memory");
    __syncthreads();
    if (threadIdx.x == 0) {
        unsigned* bar = b.bar;
        __builtin_amdgcn_s_waitcnt(0);
        unsigned nloc = b.st[0], nx = b.st[1];
        if (nloc == 0u) { xcd_barrier_complete(bar, b.x, nloc, nx); b.st[0] = nloc; b.st[1] = nx; }
        const unsigned old = xb_add(&bar[XB_XSUB(b.x)], 1u);
        const unsigned gen = old / nloc;
        if (old + 1u == (gen + 1u) * nloc) {
            __builtin_amdgcn_fence(__ATOMIC_RELEASE, "agent");
            asm volatile("s_waitcnt vmcnt(0)" ::: "memory");
            const unsigned og = xb_add(&bar[XB_TOP], 1u);
            const unsigned tg = og / nx;
            if (og + 1u == (tg + 1u) * nx) xb_add(&bar[XB_TOPGEN], 1u);
            else XB_SPIN(xb_ld(&bar[XB_TOPGEN]) == tg, bar);
            __builtin_amdgcn_fence(__ATOMIC_ACQUIRE, "agent");
            xb_add(&bar[XB_XGEN(b.x)], 1u);
            asm volatile("s_waitcnt vmcnt(0)" ::: "memory");
        } else {
            XB_SPIN(xb_ld(&bar[XB_XGEN(b.x)]) == gen, bar);
            __builtin_amdgcn_fence(__ATOMIC_ACQUIRE, "agent");
            asm volatile("s_waitcnt vmcnt(0)" ::: "memory");
        }
    }
    __syncthreads();
}

struct Args { const float* in[31]; float* out; unsigned char* ws; int ph_lo, ph_hi; };
enum { I_X = 0, I_NMG, I_WIN, I_MU, I_W0, I_W2, I_A0, I_A2, I_G2, I_KK, I_KA, I_RK, I_LNG, I_LNB, I_GWA2, I_GBA, I_GNG, I_BM, I_WBR, I_WBG, I_WOUT, I_NFG,
       I_WROUTER, I_BROUTER, I_WGATE, I_BGATE, I_WUP, I_BUP, I_WDOWN, I_BDOWN, I_NFINAL };
struct Frame {
    LAS unsigned char* lds; unsigned char* ws; unsigned* ctl;
    int tid, lane, wave, vcu, G;
};

__device__ __forceinline__ void tr_item(const float* W, int ldw, int nvalid, int k0, int n0, bf16* dst, int ldk, LAS float* scr, int lane) {
    const int c = lane & 31;
    const bool ok = (n0 + c) < nvalid;
#pragma unroll 8
    for (int i = 0; i < 32; ++i) { const int kk = 2 * i + (lane >> 5); scr[kk * 33 + c] = ok ? W[(size_t)(k0 + kk) * ldw + n0 + c] : 0.f; }
    LDS_WAIT(); asm volatile("" ::: "memory");
    const int c8 = lane & 7;
#pragma unroll
    for (int j = 0; j < 4; ++j) { const int n = (lane >> 3) + 8 * j; const LAS float* s = scr + (8 * c8) * 33 + n;
        v4u o; o.x = pk2(s[0 * 33], s[1 * 33]); o.y = pk2(s[2 * 33], s[3 * 33]); o.z = pk2(s[4 * 33], s[5 * 33]); o.w = pk2(s[6 * 33], s[7 * 33]);
        *(v4u*)(dst + (size_t)n * ldk + k0 + 8 * c8) = o; }
    LDS_WAIT(); asm volatile("" ::: "memory");
}
__device__ __forceinline__ void cv_load(const float* W, int ldw, int k0, int n0, int lane, f32x4 (&cr)[16]) {
    const unsigned laneoff = (unsigned)((lane >> 3) * ldw + n0 + 4 * (lane & 7)) * 4u;
#pragma unroll
    for (int i = 0; i < 16; ++i) { const char* rowp = (const char*)W + (size_t)(k0 + 8 * i) * ldw * 4; cr[i] = *(const f32x4*)(rowp + laneoff); }
}
__device__ __forceinline__ void cv_finish(const f32x4 (&cr)[16], int k0, unsigned char* dst, int ldk, LAS float* scr, int lane, float scale) {
    const int rr = lane >> 3, ch = lane & 7;
#pragma unroll
    for (int i = 0; i < 16; ++i) { LAS float* d = scr + (8 * i + rr) * 33 + 4 * ch; d[0] = cr[i].x * scale; d[1] = cr[i].y * scale; d[2] = cr[i].z * scale; d[3] = cr[i].w * scale; }
    LDS_WAIT(); asm volatile("" ::: "memory");
#pragma unroll
    for (int j = 0; j < 4; ++j) { const int n = rr + 8 * j; const LAS float* sp = scr + (16 * ch) * 33 + n;
        v4u o; o.x = pk4_fp8(sp[0 * 33], sp[1 * 33], sp[2 * 33], sp[3 * 33]); o.y = pk4_fp8(sp[4 * 33], sp[5 * 33], sp[6 * 33], sp[7 * 33]);
        o.z = pk4_fp8(sp[8 * 33], sp[9 * 33], sp[10 * 33], sp[11 * 33]); o.w = pk4_fp8(sp[12 * 33], sp[13 * 33], sp[14 * 33], sp[15 * 33]);
        *(v4u*)(dst + (size_t)n * ldk + k0 + 16 * ch) = o; }
    LDS_WAIT(); asm volatile("" ::: "memory");
}
__device__ __forceinline__ void cv_issue_dma(const float* W, int ldw, int k0, int n0, int lane, LAS float* scr) {
#pragma unroll
    for (int i = 0; i < 16; ++i) { const char* rowp = (const char*)W + (size_t)(k0 + 8 * i) * ldw * 4;
        const unsigned off = (unsigned)((lane >> 3) * ldw + n0 + 4 * ((lane & 7) ^ (i >> 1))) * 4u;
        __builtin_amdgcn_global_load_lds((const unsigned*)(rowp + off), (LAS unsigned*)(scr + i * 256), 16, 0, 2); }
}
__device__ __forceinline__ void cv_finish_dma(int k0, unsigned char* dst, int ldk, const LAS float* scr, int lane, float scale) {
    const int rr = lane >> 3, ch = lane & 7;
#pragma unroll
    for (int j = 0; j < 4; ++j) { const int n = rr + 8 * j; const LAS float* sp = scr + (16 * ch) * 32 + ((((n >> 2) ^ ch) << 2) | (n & 3));
        float f[16];
#pragma unroll
        for (int i = 0; i < 16; ++i) f[i] = sp[i * 32] * scale;
        v4u o; o.x = pk4_fp8(f[0], f[1], f[2], f[3]); o.y = pk4_fp8(f[4], f[5], f[6], f[7]); o.z = pk4_fp8(f[8], f[9], f[10], f[11]); o.w = pk4_fp8(f[12], f[13], f[14], f[15]);
        *(v4u*)(dst + (size_t)n * ldk + k0 + 16 * ch) = o; }
}
__device__ __forceinline__ void cvb_finish_dma(int k0, bf16* dst, int ldk, const LAS float* scr, int lane) {
    const int rr = lane >> 3, ch = lane & 7;
#pragma unroll
    for (int j = 0; j < 4; ++j) { const int n = rr + 8 * j; const LAS float* sp = scr + (16 * ch) * 32 + ((((n >> 2) ^ ch) << 2) | (n & 3));
        float f[16];
#pragma unroll
        for (int i = 0; i < 16; ++i) f[i] = sp[i * 32];
        v4u o0, o1; o0.x = pk2(f[0], f[1]); o0.y = pk2(f[2], f[3]); o0.z = pk2(f[4], f[5]); o0.w = pk2(f[6], f[7]); o1.x = pk2(f[8], f[9]); o1.y = pk2(f[10], f[11]); o1.z = pk2(f[12], f[13]); o1.w = pk2(f[14], f[15]);
        bf16* d = dst + (size_t)n * ldk + k0 + 16 * ch; *(v4u*)d = o0; *(v4u*)(d + 8) = o1; }
}
__device__ __forceinline__ void cvr_load(const float* W, int ldw, int k0, int n0, int lane, f32x4 (&cr)[16]) {
    const unsigned laneoff = (unsigned)((16 * (lane >> 3)) * ldw + n0 + 4 * (lane & 7)) * 4u;
#pragma unroll
    for (int i = 0; i < 16; ++i) { const char* rowp = (const char*)W + (size_t)(k0 + i) * ldw * 4; cr[i] = __builtin_nontemporal_load((const f32x4*)(rowp + laneoff)); }
}
__device__ __forceinline__ void cvr_store(const f32x4 (&cr)[16], int k0, unsigned char* dst, int ldk, int lane, float scale) {
    unsigned char* d = dst + (size_t)(4 * (lane & 7)) * ldk + k0 + 16 * (lane >> 3);
#pragma unroll
    for (int j = 0; j < 4; ++j) { v4u o;
        o.x = pk4_fp8(cr[0][j] * scale, cr[1][j] * scale, cr[2][j] * scale, cr[3][j] * scale); o.y = pk4_fp8(cr[4][j] * scale, cr[5][j] * scale, cr[6][j] * scale, cr[7][j] * scale);
        o.z = pk4_fp8(cr[8][j] * scale, cr[9][j] * scale, cr[10][j] * scale, cr[11][j] * scale); o.w = pk4_fp8(cr[12][j] * scale, cr[13][j] * scale, cr[14][j] * scale, cr[15][j] * scale);
        __builtin_nontemporal_store(o, (v4u*)(d + (size_t)j * ldk)); }
}
struct CvItem { const float* W; unsigned char* dst; int ldw, ldk, k0, n0; };
__device__ __forceinline__ CvItem cv_item(const Args& a, unsigned char* ws, int idx) {
    constexpr int I_EXP = (D / 128) * (FF / 32);
    int r = idx; const int mat = r / (NE * I_EXP); r -= mat * (NE * I_EXP); const int e = r / I_EXP; r -= e * I_EXP;
    const int kb = r / (FF / 32), nb = r % (FF / 32), n0 = 32 * nb;
    CvItem it; it.k0 = 128 * kb; it.n0 = n0;
    if (mat == 0) { it.W = a.in[I_WGATE] + (size_t)e * D * FF; it.ldw = FF; it.dst = ws + WS_WGU + ((size_t)e * 4096 + (n0 >> 7) * 256 + (n0 & 127)) * D; it.ldk = D; }
    else if (mat == 1) { it.W = a.in[I_WUP] + (size_t)e * D * FF; it.ldw = FF; it.dst = ws + WS_WGU + ((size_t)e * 4096 + (n0 >> 7) * 256 + 128 + (n0 & 127)) * D; it.ldk = D; }
    else { it.W = a.in[I_WDOWN] + (size_t)e * FF * D; it.ldw = D; it.dst = ws + WS_WD + ((size_t)e * 2048 + n0) * FF; it.ldk = FF; }
    return it;
}
constexpr int CV_ITEMS = 3 * NE * (D / 128) * (FF / 32);
constexpr int CVQ_CH = 4, CVQ_NCH = CV_ITEMS / CVQ_CH;
__device__ __forceinline__ unsigned cvq_issue(unsigned* q, int lane) { unsigned c = 0; if (lane == 0) c = __hip_atomic_fetch_add(q, 1u, RLX_AGENT); return c; }
__device__ __forceinline__ void rms_row_to_bf16(const float* xrow, const float* g, bf16* orow, int lane) {
    const f32x4* xr = (const f32x4*)xrow + lane; const f32x4* gr = (const f32x4*)g + lane;
    f32x4 v[8]; float s = 0.f;
#pragma unroll
    for (int j = 0; j < 8; ++j) { v[j] = __builtin_nontemporal_load(xr + 64 * j); s += (v[j].x * v[j].x + v[j].y * v[j].y) + (v[j].z * v[j].z + v[j].w * v[j].w); }
    const float rstd = rsqrtf(wave_sum(s) * (1.f / D) + NORM_EPS);
    v2u* o8 = (v2u*)orow + lane;
#pragma unroll
    for (int j = 0; j < 8; ++j) { const f32x4 gg = gr[64 * j]; v2u o; o.x = pk2(v[j].x * rstd * gg.x, v[j].y * rstd * gg.y); o.y = pk2(v[j].z * rstd * gg.z, v[j].w * rstd * gg.w); o8[64 * j] = o; }
}
constexpr int DT_NBF = IN_COLS / 32;
constexpr int DT_IN = (D / 128) * DT_NBF, DT_BA = (RW / 128) * (D / 32), DT_BB = DT_BA, DT_OUT = (D / 128) * (D / 32), DT_ALL = DT_IN + DT_BA + DT_BB + DT_OUT;
__device__ __forceinline__ void dense_tile(const Frame& F, const Args& a, int it, LAS float* t2) {
    bf16* Wt_in = (bf16*)(F.ws + WS_WIN); bf16* Wt_ba = (bf16*)(F.ws + WS_WBA); bf16* Wt_bb = (bf16*)(F.ws + WS_WBB); bf16* Wt_out = (bf16*)(F.ws + WS_WOUT);
    const float* W = nullptr; int ldw = 0, k0 = 0, n0 = 0, ldk = 0; bf16* dst = nullptr; int r = it;
    if (r < DT_IN) { const int kb = r / DT_NBF, nb = r % DT_NBF; W = a.in[I_WIN]; ldw = IN_COLS; k0 = 128 * kb; n0 = 32 * nb; dst = Wt_in + (size_t)n0 * DP; ldk = DP; }
    else if ((r -= DT_IN) < DT_BA) { const int kb = r / (D / 32), nb = r % (D / 32); W = a.in[I_WBR]; ldw = D; k0 = 128 * kb; n0 = 32 * nb; dst = Wt_ba + (size_t)n0 * RW; ldk = RW; }
    else if ((r -= DT_BA) < DT_BB) { const int kb = r / (D / 32), nb = r % (D / 32); W = a.in[I_WBG]; ldw = D; k0 = 128 * kb; n0 = 32 * nb; dst = Wt_bb + (size_t)n0 * GVW; ldk = GVW; }
    else { r -= DT_BB; const int kb = r / (D / 32), nb = r % (D / 32); W = a.in[I_WOUT]; ldw = D; k0 = 128 * kb; n0 = 32 * nb; dst = Wt_out + (size_t)n0 * D; ldk = D; }
    cv_issue_dma(W, ldw, k0, n0, F.lane, t2);
    asm volatile("s_waitcnt vmcnt(0)" ::: "memory");
    cvb_finish_dma(k0, dst, ldk, t2, F.lane); asm volatile("s_waitcnt lgkmcnt(0)" ::: "memory");
}
__device__ __forceinline__ void p0_prologue(const Frame& F, const Args& a) {
    LAS float* scr = (LAS float*)(F.lds + F.wave * 16896);
    const int gw = F.vcu * 8 + F.wave, NGW = F.G * 8;
    bf16* Wt_in = (bf16*)(F.ws + WS_WIN); bf16* Wt_ba = (bf16*)(F.ws + WS_WBA); bf16* Wt_bb = (bf16*)(F.ws + WS_WBB); bf16* Wt_out = (bf16*)(F.ws + WS_WOUT);
    constexpr int NB_IN = PLD / 32;
    constexpr int I_IN = (D / 64) * NB_IN, I_BA = (RW / 64) * (D / 32), I_BB = I_BA, I_OUT = (D / 64) * (D / 32);
    constexpr int NITEMS = I_IN + I_BA + I_BB + I_OUT;
    {
        constexpr int NBF = DT_NBF;
        LAS float* t2 = (LAS float*)(F.lds + F.wave * 16384);
        const int ntile = (F.G == 256) ? DT_IN : DT_ALL;
        for (int it = gw; it < ntile; it += NGW) dense_tile(F, a, it, t2);
        __syncthreads();
        for (int it = gw; it < (D / 64) * 2; it += NGW) { const int kb = it >> 1, nb = NBF + (it & 1); tr_item(a.in[I_WIN], IN_COLS, IN_COLS, 64 * kb, 32 * nb, Wt_in + (size_t)(32 * nb) * DP, DP, scr, F.lane); }
    }
    bf16* Hh = (bf16*)(F.ws + WS_H);
    for (int m = gw; m < T; m += NGW) rms_row_to_bf16(a.in[I_X] + (size_t)m * D, a.in[I_NMG], Hh + (size_t)m * DP, F.lane);
    const int gt = F.vcu * 512 + F.tid, NGT = F.G * 512;
    bf16* Wl_wa = (bf16*)(F.ws + WS_WLWA); bf16* Wl_g = (bf16*)(F.ws + WS_WLG);
    for (int i = gt; i < 2048 * 256; i += NGT) { const int n = i >> 8, k = i & 255; float v = 0.f;
        if (n < 1024) { if (k < DLORA) v = a.in[I_W2][(size_t)k * RW + n]; } else { if (k >= DLORA && k < 2 * DLORA) v = a.in[I_A2][(size_t)(k - DLORA) * RW + (n - 1024)]; }
        Wl_wa[i] = (bf16)f2bf(v); }
    for (int i = gt; i < 1024 * 256; i += NGT) { const int n = i >> 8, k = i & 255; Wl_g[i] = (bf16)f2bf(a.in[I_G2][(size_t)k * RW + n]); }
    float* Wr = (float*)(F.ws + WS_WR);
    for (int i = gt; i < 8 * 32 * 64 * 4; i += NGT) { const int ii = i & 3, l = (i >> 2) & 63, e = (i >> 8) & 31, j = i >> 13; const int k = 256 * j + 4 * l + ii;
        Wr[i] = a.in[I_NFG][k] * a.in[I_WROUTER][(size_t)k * NE + e]; }
}

__device__ __forceinline__ void cv_queue_run(const Frame& F, const Args& a, unsigned* stop) {
    unsigned* q = F.ctl + CW_CVQ; const int lane = F.lane;
    f32x4 ca[16], cb[16];
    int cur = __builtin_amdgcn_readfirstlane((int)cvq_issue(q, lane)); unsigned nraw = cvq_issue(q, lane); int pos = 0; bool stopped = false;
#define CVQ_NEXT(idx) do { if (pos == CVQ_CH) { cur = __builtin_amdgcn_readfirstlane((int)nraw); pos = 0; \
        if (stop && !stopped && __hip_atomic_load(stop, RLX_AGENT) != 0u) stopped = true; \
        nraw = stopped ? 0x7fffffffu : cvq_issue(q, lane); } \
        idx = cur < CVQ_NCH ? cur * CVQ_CH + pos++ : -1; } while (0)
    int xa, xb; CvItem ia, ib;
    CVQ_NEXT(xa); if (xa < 0) return;
    ia = cv_item(a, F.ws, xa); cvr_load(ia.W, ia.ldw, ia.k0, ia.n0, lane, ca);
    CVQ_NEXT(xb); ib = ia; if (xb >= 0) { ib = cv_item(a, F.ws, xb); cvr_load(ib.W, ib.ldw, ib.k0, ib.n0, lane, cb); }
    while (xa >= 0) {
        cvr_store(ca, ia.k0, ia.dst, ia.ldk, lane, WQ_SCALE);
        xa = -1; if (xb >= 0) { CVQ_NEXT(xa); if (xa >= 0) { ia = cv_item(a, F.ws, xa); cvr_load(ia.W, ia.ldw, ia.k0, ia.n0, lane, ca); } }
        if (xb >= 0) { cvr_store(cb, ib.k0, ib.dst, ib.ldk, lane, WQ_SCALE);
            xb = -1; if (xa >= 0) { CVQ_NEXT(xb); if (xb >= 0) { ib = cv_item(a, F.ws, xb); cvr_load(ib.W, ib.ldw, ib.k0, ib.n0, lane, cb); } } }
    }
#undef CVQ_NEXT
}
constexpr int CVW_SH = 3;
__device__ __forceinline__ void p1_gemm_in(const Frame& F, const Args& a) {
    const bool split = (F.G == 256);
    const int bx = (int)blockIdx.x, grp = bx >> 3;
    if (split && (grp & ((1 << CVW_SH) - 1)) == (1 << CVW_SH) - 1) {
        constexpr int NCW = (256 >> CVW_SH) * 8;
        const int cw = ((grp >> CVW_SH) * 8 + (bx & 7)) * 8 + F.wave; LAS float* t2 = (LAS float*)(F.lds + F.wave * 16384);
        for (int it = DT_IN + cw; it < DT_ALL; it += NCW) dense_tile(F, a, it, t2);
        cv_queue_run(F, a, F.ctl + CW_CVSTOP); return; }
    pg8::Gemm g{(const bf16*)(F.ws + WS_H), (const bf16*)(F.ws + WS_WIN), DP, DP, D, nullptr}; pg8::StaticOrder S;
    if (split) S.init(T, PLD, 256 - (256 >> CVW_SH), (grp - (grp >> CVW_SH)) * 8 + (bx & 7)); else S.init(T, PLD, F.G, bx);
    pg8::EpiBf16 E{(bf16*)(F.ws + WS_P), PLD, nullptr, 0, 1.f};
    pg8::gemm_phase(F.lds, g, S, E);
    if (F.tid == 0) __hip_atomic_fetch_add(F.ctl + CW_CVSTOP, 1u, RLX_AGENT);
}
__device__ __forceinline__ void p2_lora_in(const Frame& F, const Args& a) {
    const int gw = F.vcu * 8 + F.wave, NGW = F.G * 8, lane = F.lane;
    const bf16* P = (const bf16*)(F.ws + WS_P); bf16* A2 = (bf16*)(F.ws + WS_A2);
    const int kind = lane < 12 ? 0 : (lane < 24 ? 1 : (lane < 32 ? 2 : 3));
    const int src = lane < 24 ? (C_WL + 8 * lane) : (C_GL + 8 * (lane - 32));
    float mu[8];
    if (kind != 2) {
#pragma unroll
        for (int j = 0; j < 8; ++j) mu[j] = a.in[I_MU][src + j];
    }
    for (int t = gw; t < T; t += NGW) {
        v4u o = {0u, 0u, 0u, 0u};
        if (kind != 2) {
            const v4u c = *(const v4u*)(P + (size_t)t * PLD + src);
            v4u pv = {0u, 0u, 0u, 0u};
            if ((t & (SEQ - 1)) != 0) pv = *(const v4u*)(P + (size_t)(t - 1) * PLD + src);
            float x[8] = {bflo(c.x), bfhi(c.x), bflo(c.y), bfhi(c.y), bflo(c.z), bfhi(c.z), bflo(c.w), bfhi(c.w)};
            float q[8] = {bflo(pv.x), bfhi(pv.x), bflo(pv.y), bfhi(pv.y), bflo(pv.z), bfhi(pv.z), bflo(pv.w), bfhi(pv.w)};
#pragma unroll
            for (int j = 0; j < 8; ++j) { float m = x[j] + (q[j] - x[j]) * mu[j]; x[j] = kind == 0 ? tanhf(m) : (kind == 1 ? m : sigmoidf_(m)); }
            o.x = pk2(x[0], x[1]); o.y = pk2(x[2], x[3]); o.z = pk2(x[4], x[5]); o.w = pk2(x[6], x[7]);
        }
        *(v4u*)(A2 + (size_t)t * 512 + 8 * lane) = o;
    }
}

#define DPPF(x, ctrl) __builtin_bit_cast(float, __builtin_amdgcn_update_dpp(0, __builtin_bit_cast(int, (x)), (ctrl), 0xF, 0xF, false))
__device__ __forceinline__ float dpp_sum16(float x) { x += DPPF(x, 0xB1); x += DPPF(x, 0x4E); x += DPPF(x, 0x141); x += DPPF(x, 0x140); return x; }
__device__ __forceinline__ float wave_sum_dpp(float x) {
    x = dpp_sum16(x); const int xi = __builtin_bit_cast(int, x);
    return (__builtin_bit_cast(float, __builtin_amdgcn_readlane(xi, 0)) + __builtin_bit_cast(float, __builtin_amdgcn_readlane(xi, 16))) +
           (__builtin_bit_cast(float, __builtin_amdgcn_readlane(xi, 32)) + __builtin_bit_cast(float, __builtin_amdgcn_readlane(xi, 48)));
}
__device__ __forceinline__ float quad_sum(float x) { x += DPPF(x, 0xB1); x += DPPF(x, 0x4E); return x; }
__device__ __forceinline__ void unpack8(const v4u u, float (&f)[8]) { f[0] = bflo(u.x); f[1] = bfhi(u.x); f[2] = bflo(u.y); f[3] = bfhi(u.y); f[4] = bflo(u.z); f[5] = bfhi(u.z); f[6] = bflo(u.w); f[7] = bfhi(u.w); }
__device__ __forceinline__ v4u pack8(const float (&f)[8]) { v4u u; u.x = pk2(f[0], f[1]); u.y = pk2(f[2], f[3]); u.z = pk2(f[4], f[5]); u.w = pk2(f[6], f[7]); return u; }
__device__ __forceinline__ void p4_rwkv_prep(const Frame& F, const Args& a) {
    const int gw = F.vcu * 8 + F.wave, NGW = F.G * 8, lane = F.lane;
    const bf16* P = (const bf16*)(F.ws + WS_P); const bf16* WA = (const bf16*)(F.ws + WS_WAO); bf16* SC = (bf16*)(F.ws + WS_SCAN); float* BON = (float*)(F.ws + WS_BON);
    const int h = lane >> 2, q = lane & 3, c0 = h * RN + 16 * q;
    for (int t = gw; t < T; t += NGW) {
        const bool first = (t & (SEQ - 1)) == 0;
        const bf16* pr = P + (size_t)t * PLD + c0; const bf16* pp = first ? pr : pr - PLD;
        v4u ur[2], uk[2], uv[2], ur1[2], uk1[2], uv1[2], uw[2], ua[2];
#pragma unroll
        for (int j = 0; j < 2; ++j) { ur[j] = *(const v4u*)(pr + C_R + 8 * j); uk[j] = *(const v4u*)(pr + C_K + 8 * j); uv[j] = *(const v4u*)(pr + C_V + 8 * j);
            ur1[j] = *(const v4u*)(pp + C_R + 8 * j); uk1[j] = *(const v4u*)(pp + C_K + 8 * j); uv1[j] = *(const v4u*)(pp + C_V + 8 * j);
            uw[j] = __builtin_nontemporal_load((const v4u*)(WA + (size_t)t * 2048 + c0 + 8 * j)); ua[j] = __builtin_nontemporal_load((const v4u*)(WA + (size_t)t * 2048 + 1024 + c0 + 8 * j)); }
        float r[2][8], k[2][8], v[2][8], kk[2][8], dec[2][8], aa[2][8];
        float n2 = 0.f;
#pragma unroll
        for (int j = 0; j < 2; ++j) { float x[8], x1[8], wv[8], av[8];
            unpack8(ur[j], x); unpack8(ur1[j], x1);
#pragma unroll
            for (int i = 0; i < 8; ++i) { const float m = a.in[I_MU][C_R + c0 + 8 * j + i]; r[j][i] = x[i] + ((first ? 0.f : x1[i]) - x[i]) * m; }
            unpack8(uk[j], x); unpack8(uk1[j], x1);
#pragma unroll
            for (int i = 0; i < 8; ++i) { const float m = a.in[I_MU][C_K + c0 + 8 * j + i]; k[j][i] = x[i] + ((first ? 0.f : x1[i]) - x[i]) * m; }
            unpack8(uv[j], x); unpack8(uv1[j], x1);
#pragma unroll
            for (int i = 0; i < 8; ++i) { const float m = a.in[I_MU][C_V + c0 + 8 * j + i]; v[j][i] = x[i] + ((first ? 0.f : x1[i]) - x[i]) * m; }
            unpack8(uw[j], wv); unpack8(ua[j], av);
#pragma unroll
            for (int i = 0; i < 8; ++i) { const int c = c0 + 8 * j + i;
                dec[j][i] = __expf(-0.60653066f * sigmoidf_(a.in[I_W0][c] + wv[i]));
                aa[j][i] = sigmoidf_(a.in[I_A0][c] + av[i]);
                const float kq = k[j][i] * a.in[I_KK][c]; kk[j][i] = kq; n2 += kq * kq; } }
        n2 = quad_sum(n2);
        const float inv = rsqrtf(fmaxf(n2, 1e-24f));
        float bon = 0.f; float o0[2][8], o2[2][8], o3[2][8];
#pragma unroll
        for (int j = 0; j < 2; ++j)
#pragma unroll
            for (int i = 0; i < 8; ++i) { const int c = c0 + 8 * j + i; const float kn = kk[j][i] * inv; const float kf = k[j][i] * (1.f + (aa[j][i] - 1.f) * a.in[I_KA][c]);
                o0[j][i] = -kn; o2[j][i] = kn * aa[j][i]; o3[j][i] = kf; bon += r[j][i] * kf * a.in[I_RK][c]; }
        bon = quad_sum(bon);
        const int bh = (t >> 11) * RH + h, ts = t & (SEQ - 1);
        bf16* o = SC + ((size_t)(bh * SEQ + ts) * 6) * 64 + 16 * q;
#pragma unroll
        for (int j = 0; j < 2; ++j) { *(v4u*)(o + 8 * j) = pack8(o0[j]); *(v4u*)(o + 64 + 8 * j) = pack8(dec[j]); *(v4u*)(o + 128 + 8 * j) = pack8(o2[j]);
            *(v4u*)(o + 192 + 8 * j) = pack8(o3[j]); *(v4u*)(o + 256 + 8 * j) = pack8(r[j]); *(v4u*)(o + 320 + 8 * j) = pack8(v[j]); }
        if (q == 0) BON[(size_t)t * RH + h] = bon;
    }
}
__device__ __forceinline__ void p5_rwkv_scan(const Frame& F, const Args& a) {
    constexpr int TB = 16, NBLK = SEQ / TB, STF = 384, BLKF = TB * STF;
    const bf16* SC = (const bf16*)(F.ws + WS_SCAN); float* YR = (float*)(F.ws + WS_YRAW);
    LAS float* buf = (LAS float*)F.lds;
    volatile LAS int* hs = (volatile LAS int*)(F.lds + MOE_OFF + 2048);
    const int lane = F.lane;
    for (int u = F.vcu; u < 256; u += F.G) {
        const int bh = u >> 2, vg = u & 3, b = bh >> 4, h = bh & 15;
        const int role = F.wave < 4 ? 0 : (F.wave == 4 ? 1 : 2);
        const int cw = F.wave - 5;
        const bf16* src = SC + (size_t)bh * SEQ * STF;
        const int rl = lane >> 4, kq = lane & 15, row = 16 * vg + 4 * F.wave + rl;
        __syncthreads();
        if (F.tid < 8) hs[F.tid] = 0;
        __syncthreads();
#define HS_WAIT(cond) do { unsigned sp_ = 0; while (!(cond)) { __builtin_amdgcn_s_sleep(1); if (++sp_ > (1u << 24)) break; } asm volatile("" ::: "memory"); } while (0)
        if (role == 1) {
            v4u xb[12];
            { const v4u* s4 = (const v4u*)src;
#pragma unroll
              for (int i = 0; i < 12; ++i) xb[i] = s4[lane + 64 * i]; }
            for (int m = 0; m < NBLK; ++m) {
                if (m >= 4) HS_WAIT(hs[1] >= m - 3 && hs[2] >= m - 3 && hs[3] >= m - 3 && hs[4] >= m - 3);
                LAS f32x4* d4 = (LAS f32x4*)(buf + (m & 3) * BLKF);
#pragma unroll
                for (int i = 0; i < 12; ++i) { const int c = lane + 64 * i;
                    d4[2 * c] = (f32x4){bflo(xb[i].x), bfhi(xb[i].x), bflo(xb[i].y), bfhi(xb[i].y)}; d4[2 * c + 1] = (f32x4){bflo(xb[i].z), bfhi(xb[i].z), bflo(xb[i].w), bfhi(xb[i].w)}; }
                asm volatile("s_waitcnt lgkmcnt(0)" ::: "memory");
                if (lane == 0) hs[0] = m + 1;
                if (m + 1 < NBLK) { const v4u* s4 = (const v4u*)(src + (size_t)(m + 1) * BLKF);
#pragma unroll
                    for (int i = 0; i < 12; ++i) xb[i] = s4[lane + 64 * i]; }
            }
        } else if (role == 2) {
            cv_queue_run(F, a, nullptr);
        } else {
            float S0 = 0.f, S1 = 0.f, S2 = 0.f, S3 = 0.f;
            for (int n = 0; n < NBLK; ++n) {
                HS_WAIT(hs[0] >= n + 1);
                const LAS float* bb = buf + (n & 3) * BLKF;
                float* yo = YR + ((size_t)(b * SEQ + n * TB)) * RW + h * RN + row;
                f32x4 al = *(const LAS f32x4*)(bb + 4 * kq), w = *(const LAS f32x4*)(bb + 64 + 4 * kq), be = *(const LAS f32x4*)(bb + 128 + 4 * kq);
                f32x4 kf = *(const LAS f32x4*)(bb + 192 + 4 * kq), r = *(const LAS f32x4*)(bb + 256 + 4 * kq); float vv = bb[320 + row];
                float ykeep = 0.f, yp = 0.f;
#pragma unroll
                for (int j = 0; j < TB; ++j) {
                    f32x4 al_n = al, w_n = w, be_n = be, kf_n = kf, r_n = r; float vv_n = vv;
                    if (j + 1 < TB) { const LAS float* st = bb + (j + 1) * STF;
                        al_n = *(const LAS f32x4*)(st + 4 * kq); w_n = *(const LAS f32x4*)(st + 64 + 4 * kq); be_n = *(const LAS f32x4*)(st + 128 + 4 * kq);
                        kf_n = *(const LAS f32x4*)(st + 192 + 4 * kq); r_n = *(const LAS f32x4*)(st + 256 + 4 * kq); vv_n = st[320 + row]; }
                    float sa = (S0 * al.x + S1 * al.y) + (S2 * al.z + S3 * al.w);
                    float yq = yp;
                    sa += DPPF(sa, 0xB1); if (j > 0) yq += DPPF(yq, 0xB1);
                    sa += DPPF(sa, 0x4E); if (j > 0) yq += DPPF(yq, 0x4E);
                    sa += DPPF(sa, 0x141); if (j > 0) yq += DPPF(yq, 0x141);
                    sa += DPPF(sa, 0x140); if (j > 0) yq += DPPF(yq, 0x140);
                    if (j > 0) ykeep = __builtin_bit_cast(float, __builtin_amdgcn_update_dpp(__builtin_bit_cast(int, yq), __builtin_bit_cast(int, ykeep), 0x111, 0xF, 0xF, false));
                    S0 = S0 * w.x + (sa * be.x + vv * kf.x); S1 = S1 * w.y + (sa * be.y + vv * kf.y);
                    S2 = S2 * w.z + (sa * be.z + vv * kf.z); S3 = S3 * w.w + (sa * be.w + vv * kf.w);
                    yp = (S0 * r.x + S1 * r.y) + (S2 * r.z + S3 * r.w);
                    al = al_n; w = w_n; be = be_n; kf = kf_n; r = r_n; vv = vv_n;
                }
                const float yl = dpp_sum16(yp);
                ykeep = __builtin_bit_cast(float, __builtin_amdgcn_update_dpp(__builtin_bit_cast(int, yl), __builtin_bit_cast(int, ykeep), 0x111, 0xF, 0xF, false));
                yo[(size_t)(TB - 1 - kq) * RW] = ykeep;
                asm volatile("s_waitcnt lgkmcnt(0)" ::: "memory");
                if (lane == 0) hs[1 + F.wave] = n + 1;
            }
            __builtin_amdgcn_s_setprio(0);
        }
#undef HS_WAIT
        __syncthreads();
    }
    if (F.G != 256) { LAS float* scr = (LAS float*)(F.lds + F.wave * 16896); __syncthreads();
        for (int it = F.vcu * 8 + F.wave; it < CV_ITEMS; it += F.G * 8) { const CvItem c2 = cv_item(a, F.ws, it); f32x4 c3[16]; cv_load(c2.W, c2.ldw, c2.k0, c2.n0, lane, c3); cv_finish(c3, c2.k0, c2.dst, c2.ldk, scr, lane, WQ_SCALE); } }
}

__device__ __forceinline__ void p6_rwkv_post(const Frame& F, const Args& a) {
    const int gw = F.vcu * 8 + F.wave, NGW = F.G * 8, lane = F.lane;
    const bf16* SC = (const bf16*)(F.ws + WS_SCAN); const float* YR = (const float*)(F.ws + WS_YRAW); const float* BON = (const float*)(F.ws + WS_BON);
    const bf16* GO = (const bf16*)(F.ws + WS_GO); bf16* YA = (bf16*)(F.ws + WS_YA);
    const int h = lane >> 2, q = lane & 3, c0 = h * RN + 16 * q;
    f32x4 lg[4], lb[4];
#pragma unroll
    for (int j = 0; j < 4; ++j) { lg[j] = *(const f32x4*)(a.in[I_LNG] + c0 + 4 * j); lb[j] = *(const f32x4*)(a.in[I_LNB] + c0 + 4 * j); }
    for (int t = gw; t < T; t += NGW) {
        const int bh = (t >> 11) * RH + h, ts = t & (SEQ - 1);
        f32x4 y[4]; v4u uv[2], ug[2];
#pragma unroll
        for (int j = 0; j < 4; ++j) y[j] = __builtin_nontemporal_load((const f32x4*)(YR + (size_t)t * RW + c0 + 4 * j));
#pragma unroll
        for (int j = 0; j < 2; ++j) { uv[j] = *(const v4u*)(SC + ((size_t)(bh * SEQ + ts) * 6 + 5) * 64 + 16 * q + 8 * j); ug[j] = *(const v4u*)(GO + (size_t)t * RW + c0 + 8 * j); }
        const float bo = BON[(size_t)t * RH + h];
        float s = 0.f;
#pragma unroll
        for (int j = 0; j < 4; ++j) s += (y[j].x + y[j].y) + (y[j].z + y[j].w);
        const float mean = quad_sum(s) * (1.f / RN);
        float s2 = 0.f;
#pragma unroll
        for (int j = 0; j < 4; ++j) { y[j] = y[j] - mean; s2 += (y[j].x * y[j].x + y[j].y * y[j].y) + (y[j].z * y[j].z + y[j].w * y[j].w); }
        const float rstd = rsqrtf(quad_sum(s2) * (1.f / RN) + GN_EPS);
        float vv[2][8], gg[2][8], o[2][8];
        unpack8(uv[0], vv[0]); unpack8(uv[1], vv[1]); unpack8(ug[0], gg[0]); unpack8(ug[1], gg[1]);
#pragma unroll
        for (int j = 0; j < 4; ++j)
#pragma unroll
            for (int i = 0; i < 4; ++i) o[j >> 1][4 * (j & 1) + i] = (y[j][i] * rstd * lg[j][i] + lb[j][i] + bo * vv[j >> 1][4 * (j & 1) + i]) * gg[j >> 1][4 * (j & 1) + i];
        *(v4u*)(YA + (size_t)t * RW + c0) = pack8(o[0]); *(v4u*)(YA + (size_t)t * RW + c0 + 8) = pack8(o[1]);
    }
}

constexpr int G_BC = 0;
constexpr int G_ALF = 32768;
constexpr int G_RED = 36864;
constexpr int G_TOT = 38912;
constexpr int G_QT = 40960;
constexpr int G_KT = 58368;
constexpr int G_VT = 76800;
constexpr int G_AT = 113664;
__device__ __forceinline__ void gla_bcum(const Frame& F, const Args& a, const bf16* P, int t0, int h) {
    LAS float* bc = (LAS float*)(F.lds + G_BC); LAS float* alf = (LAS float*)(F.lds + G_ALF); LAS float* tot = (LAS float*)(F.lds + G_TOT);
    const int tid = F.tid;
    __syncthreads();
    { const int j = tid >> 3, i2 = (tid & 7) * 2; const unsigned u = *(const unsigned*)(P + (size_t)(t0 + j) * PLD + C_GAL + i2); alf[j * 16 + i2] = bflo(u); alf[j * 16 + i2 + 1] = bfhi(u); }
    const int d = tid & 127, jq = tid >> 7, hd = h * GDK + d;
    float wv[16];
#pragma unroll
    for (int i = 0; i < 16; ++i) wv[i] = a.in[I_GWA2][(size_t)i * GKW + hd];
    const float bb = a.in[I_GBA][hd];
    __syncthreads();
    float run = 0.f;
    for (int jj = 0; jj < 16; ++jj) { const int j = jq * 16 + jj; float x = bb;
#pragma unroll
        for (int i = 0; i < 16; ++i) x += alf[j * 16 + i] * wv[i];
        run += -softplusf_(-x) * (1.f / 16.f); bc[j * 128 + d] = run; }
    tot[jq * 128 + d] = run;
    __syncthreads();
    float pre = 0.f;
    for (int q = 0; q < jq; ++q) pre += tot[q * 128 + d];
    if (jq > 0) { for (int jj = 0; jj < 16; ++jj) bc[(jq * 16 + jj) * 128 + d] += pre; }
    __syncthreads();
}
constexpr int G_VP = 264, G_KP = 136;
__device__ __forceinline__ void gla_stage_v(const Frame& F, const bf16* P, int t0, int h) {
    LAS bf16* VR = (LAS bf16*)(F.lds + G_VT);
    const int j = F.tid >> 3, e0 = (F.tid & 7) * 32;
    const bf16* src = P + (size_t)(t0 + j) * PLD + C_GV + h * GDV + e0;
#pragma unroll
    for (int q = 0; q < 4; ++q) *(LAS v4u*)(VR + j * G_VP + e0 + 8 * q) = *(const v4u*)(src + 8 * q);
}
typedef short s16x4g __attribute__((ext_vector_type(4)));
__device__ __forceinline__ bf16x8 tr_frag(const LAS bf16* img, int pitch, int row0, int col0, int lane) {
    const LAS bf16* p = img + (row0 + 8 * (lane >> 4) + ((lane & 15) >> 2)) * pitch + col0 + 4 * (lane & 3);
    const s16x4g lo = __builtin_amdgcn_ds_read_tr16_b64_v4i16((LAS s16x4g*)p);
    const s16x4g hi = __builtin_amdgcn_ds_read_tr16_b64_v4i16((LAS s16x4g*)(p + 4 * pitch));
    return __builtin_shufflevector(lo, hi, 0, 1, 2, 3, 4, 5, 6, 7);
}
#define MMA16(a_, b_, c_) __builtin_amdgcn_mfma_f32_16x16x32_bf16(a_, b_, c_, 0, 0, 0)
__device__ __forceinline__ void gla_pass_a(const Frame& F, const Args& a) {
    const bf16* P = (const bf16*)(F.ws + WS_P); bf16* HT = (bf16*)(F.ws + WS_GHT); float* DEC = (float*)(F.ws + WS_GDEC);
    LAS float* bc = (LAS float*)(F.lds + G_BC); LAS bf16* KH = (LAS bf16*)(F.lds + G_KT); LAS bf16* VR = (LAS bf16*)(F.lds + G_VT);
    const int fr = F.lane & 15, fq = F.lane >> 4;
    for (int it = F.vcu; it < BATCH * GH * NCH; it += F.G) {
        const int c = it & 31, h = (it >> 5) & 3, b = it >> 7, t0 = b * SEQ + c * CHUNK;
        gla_bcum(F, a, P, t0, h);
        if (F.tid < 128) DEC[(size_t)it * 128 + F.tid] = __expf(bc[63 * 128 + F.tid]);
        { f32x4* gbc = (f32x4*)(F.ws + WS_GBC) + (size_t)it * 2048;
#pragma unroll
          for (int i = 0; i < 4; ++i) gbc[F.tid + 512 * i] = ((const LAS f32x4*)bc)[F.tid + 512 * i]; }
        { const int j = F.tid >> 3, d0 = (F.tid & 7) * 16; const bf16* src = P + (size_t)(t0 + j) * PLD + C_GK + h * GDK + d0;
#pragma unroll
          for (int q = 0; q < 2; ++q) { const v4u u = *(const v4u*)(src + 8 * q); float kv[8]; unpack8(u, kv);
#pragma unroll
            for (int i = 0; i < 8; ++i) { const int d = d0 + 8 * q + i; kv[i] *= __expf(bc[63 * 128 + d] - bc[j * 128 + d]); }
            *(LAS v4u*)(KH + j * G_KP + d0 + 8 * q) = pack8(kv); } }
        gla_stage_v(F, P, t0, h);
        __syncthreads();
        f32x4 acc[8][2];
#pragma unroll
        for (int m = 0; m < 8; ++m)
#pragma unroll
            for (int n = 0; n < 2; ++n) acc[m][n] = (f32x4){0.f, 0.f, 0.f, 0.f};
#pragma unroll
        for (int ks = 0; ks < 2; ++ks) {
            bf16x8 vf[2];
#pragma unroll
            for (int n = 0; n < 2; ++n) vf[n] = tr_frag(VR, G_VP, ks * 32, F.wave * 32 + n * 16, F.lane);
#pragma unroll
            for (int m = 0; m < 8; ++m) { const bf16x8 kf = tr_frag(KH, G_KP, ks * 32, m * 16, F.lane);
#pragma unroll
                for (int n = 0; n < 2; ++n) acc[m][n] = MMA16(kf, vf[n], acc[m][n]); }
        }
        bf16* o = HT + (size_t)it * (GDV * GDK);
#pragma unroll
        for (int m = 0; m < 8; ++m)
#pragma unroll
            for (int n = 0; n < 2; ++n) { v2u pk; pk.x = pk2(acc[m][n][0], acc[m][n][1]); pk.y = pk2(acc[m][n][2], acc[m][n][3]); *(v2u*)(o + (size_t)(F.wave * 32 + n * 16 + fr) * GDK + m * 16 + 4 * fq) = pk; }
    }
}
__device__ __forceinline__ void gla_pass_b(const Frame& F, int lo, int hi, int wg, int nwg) {
    const bf16* HT = (const bf16*)(F.ws + WS_GHT); const float* DEC = (const float*)(F.ws + WS_GDEC); bf16* ST = (bf16*)(F.ws + WS_GST);
    const int gt = wg * 512 + F.tid, NGT = nwg * 512;
    for (int i = (lo >> 1) + gt; i < (hi >> 1); i += NGT) {
        const int bh = i >> 14, ed = (i & 16383) * 2, d = ed & 127;
        float s0 = 0.f, s1 = 0.f;
#pragma unroll 8
        for (int c = 0; c < NCH; ++c) { const size_t it = (size_t)bh * NCH + c;
            const unsigned hv = __builtin_nontemporal_load((const unsigned*)(HT + it * (GDV * GDK) + ed)); const float d0 = DEC[it * 128 + d], d1 = DEC[it * 128 + d + 1];
            *(unsigned*)(ST + it * (GDV * GDK) + ed) = pk2(s0, s1);
            s0 = s0 * d0 + bflo(hv); s1 = s1 * d1 + bfhi(hv); }
    }
}
__device__ __forceinline__ void gla_pass_c(const Frame& F, const Args& a) {
    const bf16* P = (const bf16*)(F.ws + WS_P); const bf16* ST = (const bf16*)(F.ws + WS_GST); bf16* YB = (bf16*)(F.ws + WS_YB);
    LAS float* bc = (LAS float*)(F.lds + G_BC); LAS float* red = (LAS float*)(F.lds + G_RED);
    LAS bf16* QT = (LAS bf16*)(F.lds + G_QT); LAS bf16* KT = (LAS bf16*)(F.lds + G_KT); LAS bf16* VR = (LAS bf16*)(F.lds + G_VT); LAS bf16* AT = (LAS bf16*)(F.lds + G_AT);
    const int fr = F.lane & 15, fq = F.lane >> 4, w = F.wave;
    const float scale = 0.08838834764831845f;
    for (int it = F.vcu; it < BATCH * GH * NCH; it += F.G) {
        const int c = it & 31, h = (it >> 5) & 3, b = it >> 7, t0 = b * SEQ + c * CHUNK;
        __syncthreads();
        { const f32x4* gbc = (const f32x4*)(F.ws + WS_GBC) + (size_t)it * 2048;
#pragma unroll
          for (int i = 0; i < 4; ++i) ((LAS f32x4*)bc)[F.tid + 512 * i] = gbc[F.tid + 512 * i]; }
        const bf16* Sg = ST + (size_t)it * (GDV * GDK);
        bf16x8 sfr[4][2];
#pragma unroll
        for (int ks = 0; ks < 4; ++ks)
#pragma unroll
            for (int n = 0; n < 2; ++n) sfr[ks][n] = *(const bf16x8*)(Sg + (size_t)(w * 32 + n * 16 + fr) * GDK + ks * 32 + fq * 8);
        f32x4 gng[2];
#pragma unroll
        for (int n = 0; n < 2; ++n) gng[n] = *(const f32x4*)(a.in[I_GNG] + w * 32 + n * 16 + 4 * fq);
        v2u ogu[4][2];
#pragma unroll
        for (int m = 0; m < 4; ++m)
#pragma unroll
            for (int n = 0; n < 2; ++n) ogu[m][n] = __builtin_nontemporal_load((const v2u*)(P + (size_t)(t0 + m * 16 + fr) * PLD + C_OG + h * GDV + w * 32 + n * 16 + 4 * fq));
        __syncthreads();
        { const int j = F.tid >> 3, d0 = (F.tid & 7) * 16;
          const bf16* sq = P + (size_t)(t0 + j) * PLD + C_GQ + h * GDK + d0; const bf16* sk = P + (size_t)(t0 + j) * PLD + C_GK + h * GDK + d0;
#pragma unroll
          for (int q = 0; q < 2; ++q) { const v4u uq = *(const v4u*)(sq + 8 * q), uk = *(const v4u*)(sk + 8 * q); float fq8[8], fk8[8]; unpack8(uq, fq8); unpack8(uk, fk8);
#pragma unroll
            for (int i = 0; i < 8; ++i) { const float bv = bc[j * 128 + d0 + 8 * q + i]; fq8[i] *= scale * __expf(bv); fk8[i] *= __expf(-bv); }
            *(LAS v4u*)(QT + j * 136 + d0 + 8 * q) = pack8(fq8); *(LAS v4u*)(KT + j * 136 + d0 + 8 * q) = pack8(fk8); } }
        gla_stage_v(F, P, t0, h);
        __syncthreads();
        { const int mt = w >> 1;
#pragma unroll
          for (int q = 0; q < 2; ++q) { const int nt = (w & 1) * 2 + q; f32x4 sacc = {0.f, 0.f, 0.f, 0.f};
            if (nt <= mt) {
#pragma unroll
                for (int ks = 0; ks < 4; ++ks) { const bf16x8 kfr = *(const LAS bf16x8*)(KT + (nt * 16 + fr) * 136 + ks * 32 + fq * 8); const bf16x8 qfr = *(const LAS bf16x8*)(QT + (mt * 16 + fr) * 136 + ks * 32 + fq * 8);
                    sacc = MMA16(kfr, qfr, sacc); } }
            const int i = mt * 16 + fr, j0 = nt * 16 + 4 * fq; float v4[4];
#pragma unroll
            for (int jj = 0; jj < 4; ++jj) v4[jj] = (j0 + jj <= i) ? sacc[jj] : 0.f;
            v2u pk; pk.x = pk2(v4[0], v4[1]); pk.y = pk2(v4[2], v4[3]); *(LAS v2u*)(AT + i * 72 + j0) = pk; } }
        __syncthreads();
        f32x4 acc[2][4];
#pragma unroll
        for (int n = 0; n < 2; ++n)
#pragma unroll
            for (int m = 0; m < 4; ++m) acc[n][m] = (f32x4){0.f, 0.f, 0.f, 0.f};
#pragma unroll
        for (int ks = 0; ks < 2; ++ks) {
            bf16x8 vf[2];
#pragma unroll
            for (int n = 0; n < 2; ++n) vf[n] = tr_frag(VR, G_VP, ks * 32, w * 32 + n * 16, F.lane);
#pragma unroll
            for (int m = 0; m < 4; ++m) { const bf16x8 af = *(const LAS bf16x8*)(AT + (m * 16 + fr) * 72 + ks * 32 + fq * 8);
#pragma unroll
                for (int n = 0; n < 2; ++n) acc[n][m] = MMA16(vf[n], af, acc[n][m]); }
        }
#pragma unroll
        for (int ks = 0; ks < 4; ++ks) {
#pragma unroll
            for (int m = 0; m < 4; ++m) { const bf16x8 qf = *(const LAS bf16x8*)(QT + (m * 16 + fr) * 136 + ks * 32 + fq * 8);
#pragma unroll
                for (int n = 0; n < 2; ++n) acc[n][m] = MMA16(sfr[ks][n], qf, acc[n][m]); }
        }
        float ssq[4];
#pragma unroll
        for (int m = 0; m < 4; ++m) { float ss = 0.f;
#pragma unroll
            for (int n = 0; n < 2; ++n) ss += (acc[n][m][0] * acc[n][m][0] + acc[n][m][1] * acc[n][m][1]) + (acc[n][m][2] * acc[n][m][2] + acc[n][m][3] * acc[n][m][3]);
            ss += __shfl_xor(ss, 16); ss += __shfl_xor(ss, 32); ssq[m] = ss;
            if (fq == 0) red[(m * 16 + fr) * 8 + w] = ss; }
        __syncthreads();
#pragma unroll
        for (int m = 0; m < 4; ++m) { const int i = m * 16 + fr; float tot = 0.f;
#pragma unroll
            for (int q = 0; q < 8; ++q) tot += red[i * 8 + q];
            const float rstd = rsqrtf(tot * (1.f / GDV) + NORM_EPS);
#pragma unroll
            for (int n = 0; n < 2; ++n) { const int e = w * 32 + n * 16 + 4 * fq;
                const float og[4] = {bflo(ogu[m][n].x), bfhi(ogu[m][n].x), bflo(ogu[m][n].y), bfhi(ogu[m][n].y)}; float r4[4];
#pragma unroll
                for (int jj = 0; jj < 4; ++jj) r4[jj] = acc[n][m][jj] * rstd * gng[n][jj] * (og[jj] * sigmoidf_(og[jj]));
                v2u pk; pk.x = pk2(r4[0], r4[1]); pk.y = pk2(r4[2], r4[3]); *(v2u*)(YB + (size_t)(t0 + i) * GVW + h * GDV + e) = pk; } }
    }
}

__device__ __forceinline__ void p11_router(const Frame& F, const Args& a) {
    const int lane = F.lane, w = F.wave;
    const float* X1 = (const float*)(F.ws + WS_X1); unsigned char* H2 = (unsigned char*)(F.ws + WS_H2); const float* Wr = (const float*)(F.ws + WS_WR);
    int* SEL_E = (int*)(F.ws + WS_ROUTE); float* SEL_W = (float*)(F.ws + WS_ROUTE + 256 * 1024); int* SEL_R = (int*)(F.ws + WS_ROUTE + 512 * 1024);
    volatile LAS int* hist = (volatile LAS int*)(F.lds + MOE_OFF + 1024); volatile LAS int* base = (volatile LAS int*)(F.lds + MOE_OFF + 1280);
    int* LIST = (int*)(F.ws + WS_ROUTE + 1024 * 1024);
    constexpr int RP = 36;
    LAS float* XL = (LAS float*)(F.lds + w * (2 * 32 * RP * 4)); LAS float* TL = XL + 32 * RP;
    LAS float* part = (LAS float*)(F.lds + 8 * (2 * 32 * RP * 4));
    LAS float* ssq = part + 8 * 1024;
    __syncthreads();
    if (F.tid < 32) hist[F.tid] = 0;
    __syncthreads();
    const int r = lane & 15, kq = lane >> 4, row8 = lane >> 3, seg = lane & 7;
    const int grp = lane >> 4, el = lane & 15;
    const float br0 = a.in[I_BROUTER][el], br1 = a.in[I_BROUTER][16 + el];
    for (int tile = F.vcu; tile < T / 32; tile += F.G) {
        const int tb = tile * 32;
        {
            const float* xg = X1 + (size_t)(tb + row8) * D + 256 * w + 4 * seg;
            const float* tg = Wr + (size_t)w * 8192 + row8 * 256 + 4 * seg;
            f32x4 acc[2][2]; float ssl[4] = {0.f, 0.f, 0.f, 0.f};
#pragma unroll
            for (int m = 0; m < 2; ++m)
#pragma unroll
                for (int n = 0; n < 2; ++n) acc[m][n] = (f32x4){0.f, 0.f, 0.f, 0.f};
            f32x4 gx[4], gt[4];
#pragma unroll
            for (int q = 0; q < 4; ++q) { gx[q] = *(const f32x4*)(xg + (size_t)(8 * q) * D); gt[q] = *(const f32x4*)(tg + (8 * q) * 256); }
#pragma unroll 1
            for (int c = 0; c < 8; ++c) {
#pragma unroll
                for (int q = 0; q < 4; ++q) { *(LAS f32x4*)(XL + (8 * q + row8) * RP + 4 * seg) = gx[q]; *(LAS f32x4*)(TL + (8 * q + row8) * RP + 4 * seg) = gt[q];
                    ssl[q] += (gx[q].x * gx[q].x + gx[q].y * gx[q].y) + (gx[q].z * gx[q].z + gx[q].w * gx[q].w); }
                if (c < 7) {
#pragma unroll
                    for (int q = 0; q < 4; ++q) { gx[q] = *(const f32x4*)(xg + (size_t)(8 * q) * D + 32 * (c + 1)); gt[q] = *(const f32x4*)(tg + (8 * q) * 256 + 32 * (c + 1)); } }
                f32x4 xa[2], xb[2], ba[2], bb[2];
#pragma unroll
                for (int m = 0; m < 2; ++m) { xa[m] = *(const LAS f32x4*)(XL + (16 * m + r) * RP + 8 * kq); xb[m] = *(const LAS f32x4*)(XL + (16 * m + r) * RP + 8 * kq + 4);
                    ba[m] = *(const LAS f32x4*)(TL + (16 * m + r) * RP + 8 * kq); bb[m] = *(const LAS f32x4*)(TL + (16 * m + r) * RP + 8 * kq + 4); }
#pragma unroll
                for (int i = 0; i < 4; ++i)
#pragma unroll
                    for (int m = 0; m < 2; ++m)
#pragma unroll
                        for (int n = 0; n < 2; ++n) acc[m][n] = __builtin_amdgcn_mfma_f32_16x16x4f32(xa[m][i], ba[n][i], acc[m][n], 0, 0, 0);
#pragma unroll
                for (int i = 0; i < 4; ++i)
#pragma unroll
                    for (int m = 0; m < 2; ++m)
#pragma unroll
                        for (int n = 0; n < 2; ++n) acc[m][n] = __builtin_amdgcn_mfma_f32_16x16x4f32(xb[m][i], bb[n][i], acc[m][n], 0, 0, 0);
            }
#pragma unroll
            for (int m = 0; m < 2; ++m)
#pragma unroll
                for (int j = 0; j < 4; ++j) { LAS float* pr = part + ((w * 32 + 16 * m + 4 * kq + j) * 32); pr[r] = acc[m][0][j]; pr[16 + r] = acc[m][1][j]; }
#pragma unroll
            for (int q = 0; q < 4; ++q) { float v = ssl[q]; v += __shfl_xor(v, 1); v += __shfl_xor(v, 2); v += __shfl_xor(v, 4); if (seg == 0) ssq[w * 32 + 8 * q + row8] = v; }
        }
        __syncthreads();
        {
            const int tk = 4 * w + grp;
            float sq = 0.f, p0 = 0.f, p1 = 0.f; const LAS float* pr = part + tk * 32;
#pragma unroll
            for (int k8 = 0; k8 < 8; ++k8) { sq += ssq[32 * k8 + tk]; p0 += pr[1024 * k8 + el]; p1 += pr[1024 * k8 + 16 + el]; }
            const float rstd = rsqrtf(sq * (1.f / D) + NORM_EPS);
            float c0 = p0 * rstd + br0, c1 = p1 * rstd + br1;
            float tv[4]; int ti[4];
#pragma unroll
            for (int k = 0; k < 4; ++k) { float bv = c0; int bi = el; if (c1 > c0) { bv = c1; bi = 16 + el; }
#pragma unroll
                for (int o = 1; o < 16; o <<= 1) { const float ov = __shfl_xor(bv, o); const int oi = __shfl_xor(bi, o); if (ov > bv || (ov == bv && oi < bi)) { bv = ov; bi = oi; } }
                tv[k] = bv; ti[k] = bi; if (bi == el) c0 = -3.0e38f; if (bi == 16 + el) c1 = -3.0e38f; }
            const float e1 = __expf(tv[1] - tv[0]), e2 = __expf(tv[2] - tv[0]), e3 = __expf(tv[3] - tv[0]); const float inv = 1.f / (1.f + e1 + e2 + e3);
            if (el < 4) { const int k = el; const float wk = (k == 0 ? 1.f : (k == 1 ? e1 : (k == 2 ? e2 : e3))) * inv; const int ek = (k == 0 ? ti[0] : (k == 1 ? ti[1] : (k == 2 ? ti[2] : ti[3])));
                const int lr = __hip_atomic_fetch_add((LAS int*)&hist[ek], 1, __ATOMIC_RELAXED, __HIP_MEMORY_SCOPE_WORKGROUP);
                SEL_E[(tb + tk) * 4 + k] = ek; SEL_W[(tb + tk) * 4 + k] = wk; SEL_R[(tb + tk) * 4 + k] = lr; }
        }
#pragma unroll
        for (int rr = 0; rr < 4; ++rr) { const int tk = 4 * w + rr;
            float sq = 0.f;
#pragma unroll
            for (int k8 = 0; k8 < 8; ++k8) sq += ssq[32 * k8 + tk];
            const float rstd = rsqrtf(sq * (1.f / D) + NORM_EPS);
            const f32x4* xr = (const f32x4*)(X1 + (size_t)(tb + tk) * D) + lane; unsigned* hr = (unsigned*)(H2 + (size_t)(tb + tk) * D) + lane;
#pragma unroll
            for (int j = 0; j < 8; ++j) { const f32x4 xv = __builtin_nontemporal_load(xr + 64 * j); const f32x4 gg = ((const f32x4*)a.in[I_NFG])[64 * j + lane];
                hr[64 * j] = pk4_fp8(xv.x * rstd * gg.x, xv.y * rstd * gg.y, xv.z * rstd * gg.z, xv.w * rstd * gg.w); } }
        __syncthreads();
    }
    if (F.tid < 32) base[F.tid] = (int)__hip_atomic_fetch_add(F.ctl + CW_CNT + F.tid, (unsigned)hist[F.tid], RLX_AGENT);
    __syncthreads();
    for (int tile = F.vcu; tile < T / 32; tile += F.G) {
        if (F.tid < 128) { const int tk = tile * 32 + (F.tid >> 2); const int idx = tk * 4 + (F.tid & 3);
            const int e_ = __hip_atomic_load(SEL_E + idx, RLX_AGENT); const int rk_ = __hip_atomic_load(SEL_R + idx, RLX_AGENT) + base[e_]; SEL_R[idx] = rk_; LIST[e_ * 8192 + rk_] = tk; }
    }
}
__device__ __forceinline__ void moe_tables(const Frame& F, int nct) {
    volatile LAS int* tab = (volatile LAS int*)(F.lds + MOE_OFF);
    __syncthreads();
    if (F.tid == 0) { int run = 0, units = 0;
        for (int e = 0; e < NE; ++e) { const int cnt = (int)__hip_atomic_load(F.ctl + CW_CNT + e, RLX_AGENT); const int nt = (cnt + 255) >> 8;
            tab[e] = units; tab[36 + e] = run * 256; tab[72 + e] = nt > 0 ? nt : 1; tab[108 + e] = cnt; run += nt; units += nt * nct; }
        tab[32] = units; }
    __syncthreads();
}
__device__ __forceinline__ void p12_scatter(const Frame& F) {
    const int gw = F.vcu * 8 + F.wave, NGW = F.G * 8, lane = F.lane;
    const unsigned char* H2 = (const unsigned char*)(F.ws + WS_H2); unsigned char* XS = (unsigned char*)(F.ws + WS_XS);
    const int* SEL_E = (const int*)(F.ws + WS_ROUTE); const int* SEL_R = (const int*)(F.ws + WS_ROUTE + 512 * 1024); int* DEST = (int*)(F.ws + WS_ROUTE + 768 * 1024);
    moe_tables(F, 1);
    volatile LAS int* tab = (volatile LAS int*)(F.lds + MOE_OFF);
    for (int it = gw; it < T * TOPK; it += NGW) {
        const int t = it >> 2; const int e = SEL_E[it], dest = tab[36 + e] + SEL_R[it];
        const v4u* s = (const v4u*)(H2 + (size_t)t * D) + lane; v4u* d = (v4u*)(XS + (size_t)dest * D) + lane;
        d[0] = s[0]; d[64] = s[64];
        if (lane == 0) DEST[it] = dest;
    }
}
__device__ __forceinline__ void p15_combine(const Frame& F, const Args& a) {
    const int gw = F.vcu * 8 + F.wave, NGW = F.G * 8, lane = F.lane;
    const float* X1 = (const float*)(F.ws + WS_X1); const bf16* Y = (const bf16*)(F.ws + WS_Y);
    const float* SEL_W = (const float*)(F.ws + WS_ROUTE + 256 * 1024); const int* SEL_E = (const int*)(F.ws + WS_ROUTE); const int* SEL_R = (const int*)(F.ws + WS_ROUTE + 512 * 1024);
    moe_tables(F, 1);
    volatile LAS int* tab = (volatile LAS int*)(F.lds + MOE_OFF);
    for (int t = gw; t < T; t += NGW) {
        f32x4 v[8];
        const f32x4* xr = (const f32x4*)(X1 + (size_t)t * D) + lane;
#pragma unroll
        for (int j = 0; j < 8; ++j) v[j] = __builtin_nontemporal_load(xr + 64 * j);
#pragma unroll
        for (int k = 0; k < 4; ++k) { const float wk = SEL_W[t * 4 + k]; const v2u* yr = (const v2u*)(Y + (size_t)(tab[36 + SEL_E[t * 4 + k]] + SEL_R[t * 4 + k]) * D) + lane;
#pragma unroll
            for (int j = 0; j < 8; ++j) { const v2u u = __builtin_nontemporal_load(yr + 64 * j); v[j].x += wk * bflo(u.x); v[j].y += wk * bfhi(u.x); v[j].z += wk * bflo(u.y); v[j].w += wk * bfhi(u.y); } }
        float s = 0.f;
#pragma unroll
        for (int j = 0; j < 8; ++j) s += (v[j].x * v[j].x + v[j].y * v[j].y) + (v[j].z * v[j].z + v[j].w * v[j].w);
        const float rstd = rsqrtf(wave_sum(s) * (1.f / D) + NORM_EPS);
        f32x4* o = (f32x4*)(a.out + (size_t)t * D) + lane;
#pragma unroll
        for (int j = 0; j < 8; ++j) { const f32x4 gg = ((const f32x4*)a.in[I_NFINAL])[64 * j + lane]; __builtin_nontemporal_store(v[j] * rstd * gg, o + 64 * j); }
    }
}

__global__ void __launch_bounds__(512, 2) __attribute__((amdgpu_num_sgpr(96))) fwd(Args args) {
    extern __shared__ __attribute__((aligned(16))) unsigned char lds[];
    Frame F;
    F.lds = (LAS unsigned char*)lds; F.ws = args.ws; F.ctl = (unsigned*)(args.ws + WS_CTL);
    F.tid = threadIdx.x; F.lane = F.tid & 63; F.wave = __builtin_amdgcn_readfirstlane(F.tid >> 6);
    F.G = gridDim.x; { const int bx = blockIdx.x; F.vcu = (F.G % 8 == 0) ? (bx % 8) * (F.G / 8) + bx / 8 : bx; }
    for (int u = F.tid; u < (LDS_BYTES - LDSCTL_OFF) / 4; u += 512) ((LAS unsigned*)(F.lds + LDSCTL_OFF))[u] = 0u;
    __syncthreads();
    volatile LAS unsigned* MISC = (volatile LAS unsigned*)(F.lds + MISC_OFF);
#if MK_PER_PHASE
#define GRID_BAR() do { } while (0)
#else
    XcdBarrier bar = xcd_barrier_post(F.ctl + CW_BAR, MISC + 8);
#define GRID_BAR() xcd_barrier(bar)
#endif
    const int lo = args.ph_lo, hi = args.ph_hi;
#define IN(k) (lo <= (k) && (k) < hi)
#define SEAM(k) do { if (IN(k) && IN((k) + 1)) GRID_BAR(); } while (0)
#define DUP(k) (((PROBE_DUP) >> (k)) & 1)
#define PH_BEGIN {
#define PH_END }
    const bf16* P = (const bf16*)(F.ws + WS_P);

    if (IN(0)) { PH_BEGIN  p0_prologue(F, args);  PH_END if (DUP(0)) { GRID_BAR(); PH_BEGIN  p0_prologue(F, args);  PH_END } } SEAM(0);
    if (IN(1)) { PH_BEGIN  p1_gemm_in(F, args);  PH_END if (DUP(1)) { GRID_BAR(); PH_BEGIN  p1_gemm_in(F, args);  PH_END } } SEAM(1);
    if (PROBE_GEMM >= 0 && IN(1)) {
        pg8::Gemm g{(const bf16*)(F.ws + WS_H), (const bf16*)(F.ws + WS_WIN), DP, DP, D, nullptr}; pg8::ProbeOrder S; S.so.init(T, PLD, F.G, (int)blockIdx.x); S.mode = PROBE_GEMM;
        pg8::EpiProbe E{(bf16*)(F.ws + WS_XS)}; pg8::gemm_phase(F.lds, g, S, E); GRID_BAR();
    }
    if (IN(2)) { PH_BEGIN  p2_lora_in(F, args); gla_pass_a(F, args);  PH_END if (DUP(2)) { GRID_BAR(); PH_BEGIN  p2_lora_in(F, args); gla_pass_a(F, args);  PH_END } } SEAM(2);
    if (IN(3)) { PH_BEGIN
        { pg8::Gemm g{(const bf16*)(F.ws + WS_A2), (const bf16*)(F.ws + WS_WLWA), 512, 256, 256, nullptr}; pg8::StaticOrder S; S.init(T, 2048, F.G, (int)blockIdx.x);
          pg8::EpiBf16 E{(bf16*)(F.ws + WS_WAO), 2048, nullptr, 0, 1.f}; pg8::gemm_phase(F.lds, g, S, E); }
        { pg8::Gemm g{(const bf16*)(F.ws + WS_A2) + 256, (const bf16*)(F.ws + WS_WLG), 512, 256, 256, nullptr}; pg8::StaticOrder S; S.init(T, 1024, F.G, (int)blockIdx.x);
          pg8::EpiBf16 E{(bf16*)(F.ws + WS_GO), 1024, nullptr, 0, 1.f}; pg8::gemm_phase(F.lds, g, S, E); }
        {
            constexpr int NEL = BATCH * GH * GDV * GDK, HEAD = (NEL / 4 / 65536) * 65536; const int bx = (int)blockIdx.x;
            if (F.G == 256) { if (bx >= 128) gla_pass_b(F, 0, HEAD, bx - 128, 128); gla_pass_b(F, HEAD, NEL, F.vcu, F.G); } else gla_pass_b(F, 0, NEL, F.vcu, F.G); }
     PH_END if (DUP(3)) { GRID_BAR(); PH_BEGIN
        { pg8::Gemm g{(const bf16*)(F.ws + WS_A2), (const bf16*)(F.ws + WS_WLWA), 512, 256, 256, nullptr}; pg8::StaticOrder S; S.init(T, 2048, F.G, (int)blockIdx.x);
          pg8::EpiBf16 E{(bf16*)(F.ws + WS_WAO), 2048, nullptr, 0, 1.f}; pg8::gemm_phase(F.lds, g, S, E); }
        { pg8::Gemm g{(const bf16*)(F.ws + WS_A2) + 256, (const bf16*)(F.ws + WS_WLG), 512, 256, 256, nullptr}; pg8::StaticOrder S; S.init(T, 1024, F.G, (int)blockIdx.x);
          pg8::EpiBf16 E{(bf16*)(F.ws + WS_GO), 1024, nullptr, 0, 1.f}; pg8::gemm_phase(F.lds, g, S, E); }
        {
            constexpr int NEL = BATCH * GH * GDV * GDK, HEAD = (NEL / 4 / 65536) * 65536; const int bx = (int)blockIdx.x;
            if (F.G == 256) { if (bx >= 128) gla_pass_b(F, 0, HEAD, bx - 128, 128); gla_pass_b(F, HEAD, NEL, F.vcu, F.G); } else gla_pass_b(F, 0, NEL, F.vcu, F.G); }
     PH_END } } SEAM(3);
    if (IN(4)) { PH_BEGIN  p4_rwkv_prep(F, args); gla_pass_c(F, args);  PH_END if (DUP(4)) { GRID_BAR(); PH_BEGIN  p4_rwkv_prep(F, args); gla_pass_c(F, args);  PH_END } } SEAM(4);
    if (IN(5)) { PH_BEGIN  p5_rwkv_scan(F, args);  PH_END if (DUP(5)) { GRID_BAR(); PH_BEGIN  p5_rwkv_scan(F, args);  PH_END } } SEAM(5);
    if (IN(6)) { PH_BEGIN  p6_rwkv_post(F, args);  PH_END if (DUP(6)) { GRID_BAR(); PH_BEGIN  p6_rwkv_post(F, args);  PH_END } } SEAM(6);
    if (IN(7)) { PH_BEGIN
        { pg8::Gemm g{(const bf16*)(F.ws + WS_YA), (const bf16*)(F.ws + WS_WBA), RW, RW, RW, nullptr}; pg8::StaticOrder S; S.init(T, D, F.G, (int)blockIdx.x);
          pg8::EpiGate<false> E{(bf16*)(F.ws + WS_MRG), P, args.in[I_BM], C_GATE}; pg8::gemm_phase(F.lds, g, S, E); }
        { pg8::Gemm g{(const bf16*)(F.ws + WS_YB), (const bf16*)(F.ws + WS_WBB), GVW, GVW, GVW, nullptr}; pg8::StaticOrder S; S.init(T, D, F.G, (int)blockIdx.x);
          pg8::EpiGate<true> E{(bf16*)(F.ws + WS_MRG), P, args.in[I_BM] + D, C_GATE + D}; pg8::gemm_phase(F.lds, g, S, E); }
     PH_END if (DUP(7)) { GRID_BAR(); PH_BEGIN
        { pg8::Gemm g{(const bf16*)(F.ws + WS_YA), (const bf16*)(F.ws + WS_WBA), RW, RW, RW, nullptr}; pg8::StaticOrder S; S.init(T, D, F.G, (int)blockIdx.x);
          pg8::EpiGate<false> E{(bf16*)(F.ws + WS_MRG), P, args.in[I_BM], C_GATE}; pg8::gemm_phase(F.lds, g, S, E); }
        { pg8::Gemm g{(const bf16*)(F.ws + WS_YB), (const bf16*)(F.ws + WS_WBB), GVW, GVW, GVW, nullptr}; pg8::StaticOrder S; S.init(T, D, F.G, (int)blockIdx.x);
          pg8::EpiGate<true> E{(bf16*)(F.ws + WS_MRG), P, args.in[I_BM] + D, C_GATE + D}; pg8::gemm_phase(F.lds, g, S, E); }
     PH_END } } SEAM(7);
    if (IN(8)) { PH_BEGIN
        pg8::Gemm g{(const bf16*)(F.ws + WS_MRG), (const bf16*)(F.ws + WS_WOUT), D, D, D, nullptr}; pg8::StaticOrder S; S.init(T, D, F.G, (int)blockIdx.x);
        pg8::EpiResF32 E{(float*)(F.ws + WS_X1), args.in[I_X]}; pg8::gemm_phase(F.lds, g, S, E);
     PH_END if (DUP(8)) { GRID_BAR(); PH_BEGIN
        pg8::Gemm g{(const bf16*)(F.ws + WS_MRG), (const bf16*)(F.ws + WS_WOUT), D, D, D, nullptr}; pg8::StaticOrder S; S.init(T, D, F.G, (int)blockIdx.x);
        pg8::EpiResF32 E{(float*)(F.ws + WS_X1), args.in[I_X]}; pg8::gemm_phase(F.lds, g, S, E);
     PH_END } } SEAM(8);
    if (IN(9)) { PH_BEGIN  p11_router(F, args);  PH_END if (DUP(9)) { GRID_BAR(); PH_BEGIN  p11_router(F, args);  PH_END } } SEAM(9);
    if (IN(10)) { PH_BEGIN
        moe_tables(F, 16);
        pg8::Gemm g{(const bf16*)(F.ws + WS_H2), (const bf16*)(F.ws + WS_WGU), D, D, D, (const int*)(F.ws + WS_ROUTE + 1024 * 1024)};
        pg8::MoeOrder S{(const volatile LAS int*)(F.lds + MOE_OFF), 16, 4096, F.G, F.vcu, false};
        pg8::EpiGluQ E{(unsigned char*)(F.ws + WS_HH), args.in[I_BGATE], args.in[I_BUP]}; pg8::gemm_phase<pg8::EpiGluQ, pg8::MoeOrder, 1, true>(F.lds, g, S, E);
     PH_END if (DUP(10)) { GRID_BAR(); PH_BEGIN
        moe_tables(F, 16);
        pg8::Gemm g{(const bf16*)(F.ws + WS_H2), (const bf16*)(F.ws + WS_WGU), D, D, D, (const int*)(F.ws + WS_ROUTE + 1024 * 1024)};
        pg8::MoeOrder S{(const volatile LAS int*)(F.lds + MOE_OFF), 16, 4096, F.G, F.vcu, false};
        pg8::EpiGluQ E{(unsigned char*)(F.ws + WS_HH), args.in[I_BGATE], args.in[I_BUP]}; pg8::gemm_phase<pg8::EpiGluQ, pg8::MoeOrder, 1, true>(F.lds, g, S, E);
     PH_END } } SEAM(10);
    if (IN(11)) { PH_BEGIN
        moe_tables(F, 8);
        pg8::Gemm g{(const bf16*)(F.ws + WS_HH), (const bf16*)(F.ws + WS_WD), FF, FF, FF, nullptr};
        pg8::MoeOrder S{(const volatile LAS int*)(F.lds + MOE_OFF), 8, 2048, F.G, F.vcu, true};
        pg8::EpiBf16H E{(bf16*)(F.ws + WS_Y), D, args.in[I_BDOWN], D, WQ_INV}; pg8::gemm_phase<pg8::EpiBf16H, pg8::MoeOrder, 1, false, true, true>(F.lds, g, S, E);
     PH_END if (DUP(11)) { GRID_BAR(); PH_BEGIN
        moe_tables(F, 8);
        pg8::Gemm g{(const bf16*)(F.ws + WS_HH), (const bf16*)(F.ws + WS_WD), FF, FF, FF, nullptr};
        pg8::MoeOrder S{(const volatile LAS int*)(F.lds + MOE_OFF), 8, 2048, F.G, F.vcu, true};
        pg8::EpiBf16H E{(bf16*)(F.ws + WS_Y), D, args.in[I_BDOWN], D, WQ_INV}; pg8::gemm_phase<pg8::EpiBf16H, pg8::MoeOrder, 1, false, true, true>(F.lds, g, S, E);
     PH_END } } SEAM(11);
    if (IN(12)) { PH_BEGIN  p15_combine(F, args);  PH_END if (DUP(12)) { GRID_BAR(); PH_BEGIN  p15_combine(F, args);  PH_END } }
#undef IN
#undef SEAM
}
constexpr int N_PHASES = 13;

extern "C" void kernel_launch(void* const* d_in, const int* in_sizes, int n_in, void* d_out, int out_size, void* d_ws, size_t ws_size, hipStream_t stream) {
    static int grid = 0;
    if (grid == 0) {
        if (n_in != 31 || in_sizes[0] != T * D || out_size != T * D || ws_size < WS_END) { fprintf(stderr, "kernel_launch: unexpected shapes (n_in %d, ws %zu)\n", n_in, ws_size); grid = -1; return; }
        int dev = 0, cus = 0, per_cu = 0;
        if (hipGetDevice(&dev) != hipSuccess || hipDeviceGetAttribute(&cus, hipDeviceAttributeMultiprocessorCount, dev) != hipSuccess) { grid = -1; return; }
        if (hipFuncSetAttribute((const void*)fwd, hipFuncAttributeMaxDynamicSharedMemorySize, LDS_BYTES) != hipSuccess) { fprintf(stderr, "kernel_launch: hipFuncSetAttribute failed\n"); grid = -1; return; }
        if (hipOccupancyMaxActiveBlocksPerMultiprocessor(&per_cu, (const void*)fwd, 512, LDS_BYTES) != hipSuccess || per_cu < 1) { fprintf(stderr, "kernel_launch: occupancy query says %d\n", per_cu); }
        (void)hipGetLastError();
        grid = cus;
    }
    if (grid < 0) return;
    (void)hipMemsetAsync((char*)d_ws + WS_CTL, 0, CTL_ZERO_BYTES, stream);
    Args a{};
    for (int i = 0; i < 31; ++i) a.in[i] = (const float*)d_in[i];
    a.out = (float*)d_out; a.ws = (unsigned char*)d_ws;
#if MK_PER_PHASE
    for (int p = 0; p < N_PHASES; ++p) { a.ph_lo = p; a.ph_hi = p + 1; hipLaunchKernelGGL(fwd, dim3(grid), dim3(512), LDS_BYTES, stream, a); }
#else
    a.ph_lo = 0; a.ph_hi = N_PHASES;
    hipLaunchKernelGGL(fwd, dim3(grid), dim3(512), LDS_BYTES, stream, a);
#endif
}
```

```cpp
#include <hip/hip_runtime.h>
#include <cstdio>
#include <cstdint>

#ifndef MK_PER_PHASE
#define MK_PER_PHASE 0
#endif

#ifndef PROBE_GEMM
#define PROBE_GEMM -1
#endif
#ifndef PROBE_DUP
#define PROBE_DUP 0
#endif
#define GAS __attribute__((address_space(1)))
#define LAS __attribute__((address_space(3)))
typedef unsigned short bf16;
typedef unsigned v4u __attribute__((ext_vector_type(4)));
typedef unsigned v2u __attribute__((ext_vector_type(2)));
typedef float f32x4 __attribute__((ext_vector_type(4)));
typedef float f32x2 __attribute__((ext_vector_type(2)));
typedef short bf16x8 __attribute__((ext_vector_type(8)));
typedef long i64x2 __attribute__((ext_vector_type(2)));
typedef int v4i __attribute__((ext_vector_type(4)));
typedef int v8i __attribute__((ext_vector_type(8)));
#define RLX_AGENT __ATOMIC_RELAXED, __HIP_MEMORY_SCOPE_AGENT
#define LDS_WAIT() asm volatile("s_waitcnt lgkmcnt(0)" ::: "memory")
#define VM_WAIT() asm volatile("s_waitcnt vmcnt(0)" ::: "memory")

constexpr int D = 2048, BATCH = 4, SEQ = 2048, T = BATCH * SEQ;
constexpr int RW = 1024, RH = 16, RN = 64;
constexpr int DLORA = 96, GLORA = 256;
constexpr int RWKV_COLS = 3 * RW + 2 * DLORA + GLORA;
constexpr int GH = 4, GDK = 128, GDV = 256, GKW = GH * GDK, GVW = GH * GDV, GAL = 16;
constexpr int GLA_COLS = 2 * GKW + 2 * GVW + GAL;
constexpr int IN_COLS = RWKV_COLS + GLA_COLS + 2 * D;
constexpr int PLD = 10752;
constexpr int DP = D + 64;
constexpr int C_R = 0, C_K = 1024, C_V = 2048, C_WL = 3072, C_AL = 3168, C_GL = 3264;
constexpr int C_GQ = 3520, C_GK = 4032, C_GV = 4544, C_OG = 5568, C_GAL = 6592, C_GATE = 6608;
constexpr int NE = 32, TOPK = 4, FF = 2048;
constexpr int XS_ROWS = T * TOPK + NE * 256;
constexpr int CHUNK = 64, NCH = SEQ / CHUNK;
constexpr float NORM_EPS = 1e-5f, GN_EPS = 64e-5f;
constexpr float WQ_SCALE = 64.f, WQ_INV = 1.f / 64.f;

constexpr size_t MiB = 1u << 20;
constexpr size_t WS_CTL = 0, CTL_ZERO_BYTES = 1 * MiB;
constexpr size_t WS_WR = 1 * MiB;
constexpr size_t WS_WLWA = 2 * MiB;
constexpr size_t WS_WLG = 3 * MiB;
constexpr size_t WS_WBA = 4 * MiB, WS_WBB = 8 * MiB;
constexpr size_t WS_WOUT = 12 * MiB;
constexpr size_t WS_WIN = 64 * MiB;
constexpr size_t WS_WGU = 192 * MiB;
constexpr size_t WS_WD = 448 * MiB;
constexpr size_t WS_H = 128 * MiB;
constexpr size_t WS_P = 864 * MiB;
constexpr size_t WS_Y = WS_P;
constexpr size_t WS_A2 = 1032 * MiB;
constexpr size_t WS_WAO = 1040 * MiB;
constexpr size_t WS_GO = 1072 * MiB;
constexpr size_t WS_SCAN = 1088 * MiB;
constexpr size_t WS_BON = 1200 * MiB;
constexpr size_t WS_YRAW = 1280 * MiB;
constexpr size_t WS_GHT = 1312 * MiB;
constexpr size_t WS_GST = 1376 * MiB;
constexpr size_t WS_GDEC = 1408 * MiB;
constexpr size_t WS_GBC = 576 * MiB;
constexpr size_t WS_YA = 1410 * MiB, WS_YB = 1426 * MiB;
constexpr size_t WS_MRG = 1442 * MiB;
constexpr size_t WS_X1 = 1474 * MiB;
constexpr size_t WS_H2 = 832 * MiB;
constexpr size_t WS_ROUTE = 1570 * MiB;
constexpr size_t WS_XS = 1572 * MiB;
constexpr size_t WS_HH = 1732 * MiB;
constexpr size_t WS_END = 1892 * MiB;
constexpr int CW_BAR = 4096;
constexpr int CW_CNT = 16384;
constexpr int CW_CVQ = 20480, CW_CVSTOP = 20544;

constexpr int RING_BYTES = 131072;
constexpr int LDSCTL_OFF = 159744, MISC_OFF = LDSCTL_OFF + 320;
constexpr int MOE_OFF = LDSCTL_OFF + 1024;
constexpr int LDS_BYTES = 163840;

__device__ __forceinline__ unsigned f2bf(float f) { unsigned u = __builtin_bit_cast(unsigned, f); return (u + 0x7fffu + ((u >> 16) & 1u)) >> 16; }
__device__ __forceinline__ unsigned pk2(float lo, float hi) { return f2bf(lo) | (f2bf(hi) << 16); }
__device__ __forceinline__ unsigned pk4_fp8(float a, float b, float c, float d) { int w = 0; w = __builtin_amdgcn_cvt_pk_fp8_f32(a, b, w, false); w = __builtin_amdgcn_cvt_pk_fp8_f32(c, d, w, true); return (unsigned)w; }
__device__ __forceinline__ float bflo(unsigned u) { return __builtin_bit_cast(float, u << 16); }
__device__ __forceinline__ float bfhi(unsigned u) { return __builtin_bit_cast(float, u & 0xffff0000u); }
__device__ __forceinline__ float bf2f(bf16 b) { return __builtin_bit_cast(float, ((unsigned)b) << 16); }
__device__ __forceinline__ float wave_sum(float v) {
#pragma unroll
    for (int o = 1; o < 64; o <<= 1) v += __shfl_xor(v, o);
    return v;
}
__device__ __forceinline__ float sigmoidf_(float x) { return 1.f / (1.f + __expf(-x)); }
__device__ __forceinline__ float softplusf_(float x) { return fmaxf(x, 0.f) + log1pf(__expf(-fabsf(x))); }

namespace pg8 {
constexpr int RING_BYTES_ = 131072;
constexpr int BM = 256, BK = 64, HALF = 128, HTB = HALF * BK * 2, STAGE_BYTES = 8 * HTB, NXCD = 8, WGM = 8;
__host__ __device__ __forceinline__ int lds_byte(int r, int c) { return r * 128 + (((c >> 3) ^ ((r >> 1) & 7)) << 4) + (c & 7) * 2; }
__host__ __device__ __forceinline__ void stage_rc(int b, int& R, int& C) { R = b >> 7; C = ((((b & 127) >> 4) ^ ((R >> 1) & 7)) << 3); }
__host__ __device__ __forceinline__ int perm32(int rho) { const int n = rho >> 4, i = rho & 15; return 8 * (i >> 2) + 4 * n + (i & 3); }

struct Unit { int rowA, rowB, pn, e, rk0, cnt, hn; };
struct Gemm { const bf16* A; const bf16* Bt; int lda, ldb, K; const int* list; };

struct StaticOrder {
    int nM, nN, nwg, G, c;
    __device__ void init(int M, int N, int G_, int c_) { nM = M / BM; nN = N / BM; nwg = nM * nN; G = G_; c = c_; }
    __device__ bool next(int i, Unit& u) const {
        const long L = (long)i * G + c; if (L >= nwg) return false;
        int wgid = (int)L; { const int q = nwg / NXCD, r = nwg % NXCD, xcd = wgid % NXCD, off = wgid / NXCD; wgid = (xcd < r ? xcd * (q + 1) : r * (q + 1) + (xcd - r) * q) + off; }
        const int nig = WGM * nN, gid = wgid / nig, fm = gid * WGM, gsz = (nM - fm) < WGM ? (nM - fm) : WGM;
        const int pm = fm + ((wgid % nig) % gsz); u.pn = (wgid % nig) / gsz; u.rowA = pm * BM; u.rowB = u.pn * BM; u.e = 0; u.rk0 = 0; u.cnt = 0; u.hn = 0; return true;
    }
};
struct ProbeOrder {
    StaticOrder so; int mode;
    __device__ bool next(int i, Unit& u) const { if (!so.next(i, u)) return false; u.e = (u.rowA >> 8) * 64 + u.pn; if (mode & 1) u.rowA = 0; if (mode & 2) u.rowB = 0; return true; }
};
struct MoeOrder {
    const volatile LAS int* tab; int nct, rowsB, G, c;
    bool nsplit;
    __device__ bool next(int i, Unit& u) const {
        int L = i * G + c; const int total = __builtin_amdgcn_readfirstlane(tab[32]); int hn = 0;
        if (nsplit) { const int rf = (total / G) * G, r = total - rf;
            if (r > 0 && 2 * r <= G && L >= rf) { const int j = L - rf; if (j >= 2 * r) return false; L = rf + (j >> 1); hn = 1 + (j & 1); } }
        if (L >= total) return false;
        u.hn = hn;
        int e = 0;
        for (; e < 31; ++e) { if (L < __builtin_amdgcn_readfirstlane(tab[e + 1])) break; }
        const int local = L - __builtin_amdgcn_readfirstlane(tab[e]); const int nt = __builtin_amdgcn_readfirstlane(tab[72 + e]);
        const int ct = local / nt, rt = local - ct * nt;
        u.rowA = __builtin_amdgcn_readfirstlane(tab[36 + e]) + rt * BM; u.rowB = e * rowsB + ct * BM + (hn == 2 ? HALF : 0); u.pn = ct; u.e = e; u.rk0 = rt * BM; u.cnt = __builtin_amdgcn_readfirstlane(tab[108 + e]); return true;
    }
};

__device__ __forceinline__ unsigned cvt_pk_bf16(float lo, float hi) { unsigned r; asm volatile("v_cvt_pk_bf16_f32 %0, %1, %2" : "=v"(r) : "v"(lo), "v"(hi)); return r; }

struct EpiBf16 {
    static constexpr bool PERM = true;
    bf16* O; int ldc; const float* bias; int bias_estride; float scale;
    __device__ __forceinline__ void operator()(const f32x4 (&acc)[2][2][4][2], const Unit& u, int wr, int wc, int fr, int fq) const {
        const int row0 = u.rowA + wr * 64 + fr, col0 = u.pn * BM + wc * 32 + 8 * fq;
        f32x4 bv[2][2];
#pragma unroll
        for (int bj = 0; bj < 2; ++bj)
#pragma unroll
            for (int n = 0; n < 2; ++n) bv[bj][n] = bias ? *(const f32x4*)(bias + (size_t)u.e * bias_estride + col0 + bj * HALF + 4 * n) : (f32x4){0.f, 0.f, 0.f, 0.f};
#pragma unroll
        for (int ai = 0; ai < 2; ++ai)
#pragma unroll
            for (int m = 0; m < 4; ++m) { bf16* rowp = O + (size_t)(row0 + ai * HALF + m * 16) * ldc + col0;
#pragma unroll
                for (int bj = 0; bj < 2; ++bj) { const f32x4 v0 = acc[ai][bj][m][0] * scale + bv[bj][0], v1 = acc[ai][bj][m][1] * scale + bv[bj][1];
                    v4u w; w.x = cvt_pk_bf16(v0[0], v0[1]); w.y = cvt_pk_bf16(v0[2], v0[3]); w.z = cvt_pk_bf16(v1[0], v1[1]); w.w = cvt_pk_bf16(v1[2], v1[3]);
                    *(v4u*)(rowp + bj * HALF) = w; } }
    }
};
struct EpiBf16H {
    static constexpr bool PERM = true;
    bf16* O; int ldc; const float* bias; int bias_estride; float scale;
    __device__ __forceinline__ void operator()(const f32x4 (&acc)[2][2][4][2], const Unit& u, int wr, int wc, int fr, int fq) const {
        const int row0 = u.rowA + wr * 64 + fr, col0 = u.pn * BM + wc * 32 + 8 * fq + (u.hn == 2 ? HALF : 0);
#pragma unroll
        for (int bj = 0; bj < 2; ++bj) { if (bj == 1 && u.hn != 0) break;
            f32x4 bv[2];
#pragma unroll
            for (int n = 0; n < 2; ++n) bv[n] = *(const f32x4*)(bias + (size_t)u.e * bias_estride + col0 + bj * HALF + 4 * n);
#pragma unroll
            for (int ai = 0; ai < 2; ++ai)
#pragma unroll
                for (int m = 0; m < 4; ++m) { bf16* rowp = O + (size_t)(row0 + ai * HALF + m * 16) * ldc + col0;
                    const f32x4 v0 = acc[ai][bj][m][0] * scale + bv[0], v1 = acc[ai][bj][m][1] * scale + bv[1];
                    v4u w; w.x = cvt_pk_bf16(v0[0], v0[1]); w.y = cvt_pk_bf16(v0[2], v0[3]); w.z = cvt_pk_bf16(v1[0], v1[1]); w.w = cvt_pk_bf16(v1[2], v1[3]);
                    *(v4u*)(rowp + bj * HALF) = w; } }
    }
};
struct EpiProbe {
    static constexpr bool PERM = true;
    bf16* O;
    __device__ __forceinline__ void operator()(const f32x4 (&acc)[2][2][4][2], const Unit& u, int wr, int wc, int fr, int fq) const {
        const int pm = u.e >> 6, pn = u.e & 63; const int row0 = pm * BM + wr * 64 + fr, col0 = pn * BM + wc * 32 + 8 * fq;
#pragma unroll
        for (int ai = 0; ai < 2; ++ai)
#pragma unroll
            for (int m = 0; m < 4; ++m) { bf16* rowp = O + (size_t)(row0 + ai * HALF + m * 16) * PLD + col0;
#pragma unroll
                for (int bj = 0; bj < 2; ++bj) { const f32x4 v0 = acc[ai][bj][m][0], v1 = acc[ai][bj][m][1];
                    v4u w; w.x = cvt_pk_bf16(v0[0], v0[1]); w.y = cvt_pk_bf16(v0[2], v0[3]); w.z = cvt_pk_bf16(v1[0], v1[1]); w.w = cvt_pk_bf16(v1[2], v1[3]);
                    *(v4u*)(rowp + bj * HALF) = w; } }
    }
};
template <bool ADD> struct EpiGate {
    static constexpr bool PERM = true;
    bf16* O; const bf16* P; const float* bm; int gcol;
    __device__ __forceinline__ void operator()(const f32x4 (&acc)[2][2][4][2], const Unit& u, int wr, int wc, int fr, int fq) const {
        const int row0 = u.rowA + wr * 64 + fr, col0 = u.pn * BM + wc * 32 + 8 * fq;
        f32x4 bv[2][2];
#pragma unroll
        for (int bj = 0; bj < 2; ++bj)
#pragma unroll
            for (int n = 0; n < 2; ++n) bv[bj][n] = *(const f32x4*)(bm + col0 + bj * HALF + 4 * n);
#pragma unroll
        for (int ai = 0; ai < 2; ++ai)
#pragma unroll
            for (int m = 0; m < 4; ++m) { const size_t row = (size_t)(row0 + ai * HALF + m * 16);
#pragma unroll
                for (int bj = 0; bj < 2; ++bj) {
                    const v4u pg = *(const v4u*)(P + row * PLD + gcol + col0 + bj * HALF);
                    bf16* op = O + row * D + col0 + bj * HALF;
                    float g[8] = {bflo(pg.x), bfhi(pg.x), bflo(pg.y), bfhi(pg.y), bflo(pg.z), bfhi(pg.z), bflo(pg.w), bfhi(pg.w)};
                    float r[8];
#pragma unroll
                    for (int j = 0; j < 4; ++j) { r[j] = sigmoidf_(g[j] + bv[bj][0][j]) * acc[ai][bj][m][0][j]; r[4 + j] = sigmoidf_(g[4 + j] + bv[bj][1][j]) * acc[ai][bj][m][1][j]; }
                    if (ADD) { const v4u pv = *(const v4u*)op;
                        r[0] += bflo(pv.x); r[1] += bfhi(pv.x); r[2] += bflo(pv.y); r[3] += bfhi(pv.y); r[4] += bflo(pv.z); r[5] += bfhi(pv.z); r[6] += bflo(pv.w); r[7] += bfhi(pv.w); }
                    v4u w; w.x = cvt_pk_bf16(r[0], r[1]); w.y = cvt_pk_bf16(r[2], r[3]); w.z = cvt_pk_bf16(r[4], r[5]); w.w = cvt_pk_bf16(r[6], r[7]);
                    *(v4u*)op = w; } }
    }
};
struct EpiResF32 {
    static constexpr bool PERM = false;
    float* O; const float* X; LAS unsigned char* lds;
    __device__ __forceinline__ void operator()(const f32x4 (&acc)[2][2][4][2], const Unit& u, int wr, int wc, int fr, int fq) const {
        constexpr int RP = 36;
        LAS float* t = (LAS float*)(lds + RING_BYTES_ + (wr * 4 + wc) * (16 * RP * 4));
        const int lane = fr + 16 * fq, row8 = lane >> 3, seg = lane & 7;
        const int row0 = u.rowA + wr * 64, col0 = u.pn * BM + wc * 32;
#pragma unroll
        for (int ai = 0; ai < 2; ++ai)
#pragma unroll
            for (int m = 0; m < 4; ++m)
#pragma unroll
                for (int bj = 0; bj < 2; ++bj) {
                    const size_t go = (size_t)(row0 + ai * HALF + m * 16 + row8) * D + col0 + bj * HALF + 4 * seg;
                    const f32x4 x0 = __builtin_nontemporal_load((const f32x4*)(X + go)), x1 = __builtin_nontemporal_load((const f32x4*)(X + go + (size_t)8 * D));
                    *(LAS f32x4*)(t + fr * RP + 4 * fq) = acc[ai][bj][m][0]; *(LAS f32x4*)(t + fr * RP + 16 + 4 * fq) = acc[ai][bj][m][1];
                    const f32x4 v0 = *(const LAS f32x4*)(t + row8 * RP + 4 * seg), v1 = *(const LAS f32x4*)(t + (8 + row8) * RP + 4 * seg);
                    *(f32x4*)(O + go) = v0 + x0; *(f32x4*)(O + go + (size_t)8 * D) = v1 + x1;
                }
    }
};
struct EpiGlu {
    static constexpr bool PERM = true;
    bf16* O; const float* bg; const float* bu;
    __device__ __forceinline__ void operator()(const f32x4 (&acc)[2][2][4][2], const Unit& u, int wr, int wc, int fr, int fq) const {
        const int row0 = u.rowA + wr * 64 + fr, col0 = u.pn * HALF + wc * 32 + 8 * fq;
        f32x4 gb[2], ub[2];
#pragma unroll
        for (int n = 0; n < 2; ++n) { gb[n] = *(const f32x4*)(bg + (size_t)u.e * FF + col0 + 4 * n); ub[n] = *(const f32x4*)(bu + (size_t)u.e * FF + col0 + 4 * n); }
#pragma unroll
        for (int ai = 0; ai < 2; ++ai)
#pragma unroll
            for (int m = 0; m < 4; ++m) { bf16* op = O + (size_t)(row0 + ai * HALF + m * 16) * FF + col0;
                float r[8];
#pragma unroll
                for (int n = 0; n < 2; ++n)
#pragma unroll
                    for (int j = 0; j < 4; ++j) { float g = fminf(acc[ai][0][m][n][j] + gb[n][j], 7.f); float up = fminf(fmaxf(acc[ai][1][m][n][j] + ub[n][j], -7.f), 7.f);
                        r[4 * n + j] = (up + 1.f) * g * sigmoidf_(1.702f * g); }
                v4u w; w.x = cvt_pk_bf16(r[0], r[1]); w.y = cvt_pk_bf16(r[2], r[3]); w.z = cvt_pk_bf16(r[4], r[5]); w.w = cvt_pk_bf16(r[6], r[7]);
                *(v4u*)op = w; }
    }
};

struct EpiGluQ {
    static constexpr bool PERM = true;
    unsigned char* O; const float* bg; const float* bu;
    __device__ __forceinline__ void operator()(const f32x4 (&acc)[2][2][4][2], const Unit& u, int wr, int wc, int fr, int fq) const {
        const int row0 = u.rowA + wr * 64 + fr, col0 = u.pn * HALF + wc * 32 + 8 * fq;
        f32x4 gb[2], ub[2];
#pragma unroll
        for (int n = 0; n < 2; ++n) { gb[n] = *(const f32x4*)(bg + (size_t)u.e * FF + col0 + 4 * n); ub[n] = *(const f32x4*)(bu + (size_t)u.e * FF + col0 + 4 * n); }
#pragma unroll
        for (int ai = 0; ai < 2; ++ai)
#pragma unroll
            for (int m = 0; m < 4; ++m) { unsigned char* op = O + (size_t)(row0 + ai * HALF + m * 16) * FF + col0;
                float r[8];
#pragma unroll
                for (int n = 0; n < 2; ++n)
#pragma unroll
                    for (int j = 0; j < 4; ++j) { float g = fminf(acc[ai][0][m][n][j] * WQ_INV + gb[n][j], 7.f); float up = fminf(fmaxf(acc[ai][1][m][n][j] * WQ_INV + ub[n][j], -7.f), 7.f);
                        r[4 * n + j] = (up + 1.f) * g * sigmoidf_(1.702f * g); }
                v2u w; w.x = pk4_fp8(r[0], r[1], r[2], r[3]); w.y = pk4_fp8(r[4], r[5], r[6], r[7]);
                *(v2u*)op = w; }
    }
};

template <class Epi, class Sched, int ESZ = 2, bool GATHER = false, bool ALIGN_EPI = true, bool NSPLIT = false>
__device__ __forceinline__ void gemm_phase(LAS unsigned char* lds, const Gemm g, const Sched& S, const Epi& E) {
    const int tid = threadIdx.x, wid = __builtin_amdgcn_readfirstlane(tid >> 6), lane = tid & 63, wr = wid >> 2, wc = wid & 3, fr = lane & 15, fq = lane >> 4;
    const int K = g.K, nt = K * ESZ / (BK * 2);
    unsigned voffA[2], voffB[2]; int Rst[2], Cst[2];
#pragma unroll
    for (int i = 0; i < 2; ++i) { int R, C; stage_rc(tid * 16 + i * 8192, R, C); const int Rb = Epi::PERM ? ((R & ~31) + perm32(R & 31)) : R; Rst[i] = R; Cst[i] = C * 2;
        voffA[i] = (unsigned)(R * g.lda * ESZ + C * 2); voffB[i] = (unsigned)(Rb * g.ldb * ESZ + C * 2); }
    const size_t kstep = (size_t)(BK * 2);
    const size_t hstepA = (size_t)HALF * g.lda * ESZ, hstepB = (size_t)HALF * g.ldb * ESZ;
    const unsigned ldsw = (unsigned)wid * 1024u;
    const int aoff = lds_byte(wr * 64 + fr, fq * 8), boff = lds_byte(wc * 32 + fr, fq * 8);
#define PG8_SA(b, h) (((b) * 2 + (h)) * HTB)
#define PG8_SB(b, h) ((4 + (b) * 2 + (h)) * HTB)
#define PG8_STAGE(bufoff, gbase, voff) do { _Pragma("unroll") for (int _i = 0; _i < 2; ++_i) \
        __builtin_amdgcn_global_load_lds((const unsigned*)((const char*)(gbase) + (voff)[_i]), (LAS unsigned*)(lds + (bufoff) + ldsw + _i * 8192), 16, 0, 0); } while (0)
#define PG8_GOFF(u_, v_) do { _Pragma("unroll") for (int h_ = 0; h_ < 2; ++h_) _Pragma("unroll") for (int i_ = 0; i_ < 2; ++i_) { const int rk_ = (u_).rk0 + 128 * h_ + Rst[i_]; \
        const int tok_ = rk_ < (u_).cnt ? g.list[(u_).e * 8192 + rk_] : 0; (v_)[h_][i_] = (unsigned)tok_ * (unsigned)(g.lda * ESZ) + (unsigned)Cst[i_]; } } while (0)
#define PG8_STAGE_A(bufoff, isnext, tt, h) do { if constexpr (GATHER) { unsigned vo_[2] = {(isnext) ? vN[h][0] : vA[h][0], (isnext) ? vN[h][1] : vA[h][1]}; PG8_STAGE(bufoff, (const char*)g.A + (size_t)(tt) * kstep, vo_); } \
        else PG8_STAGE(bufoff, ((isnext) ? nA : cA) + (size_t)(tt) * kstep + (size_t)(h) * hstepA, voffA); } while (0)
#define PG8_LD16(off_) (*(const LAS v4i*)(lds + (off_)))
#define PG8_LDA(dst, b, h) do { if constexpr (ESZ == 2) { _Pragma("unroll") for (int m = 0; m < 4; ++m) _Pragma("unroll") for (int k = 0; k < 2; ++k) dst[m][k] = *(const LAS bf16x8*)(lds + PG8_SA(b, h) + (k ? (aoff ^ 64) : aoff) + m * 2048); } \
        else { _Pragma("unroll") for (int m = 0; m < 4; ++m) dst##8[m] = __builtin_shufflevector(PG8_LD16(PG8_SA(b, h) + aoff + m * 2048), PG8_LD16(PG8_SA(b, h) + (aoff ^ 64) + m * 2048), 0, 1, 2, 3, 4, 5, 6, 7); } } while (0)
#define PG8_LDB(dst, b, h) do { if constexpr (ESZ == 2) { _Pragma("unroll") for (int n = 0; n < 2; ++n) _Pragma("unroll") for (int k = 0; k < 2; ++k) dst[n][k] = *(const LAS bf16x8*)(lds + PG8_SB(b, h) + (k ? (boff ^ 64) : boff) + n * 2048); } \
        else { _Pragma("unroll") for (int n = 0; n < 2; ++n) dst##8[n] = __builtin_shufflevector(PG8_LD16(PG8_SB(b, h) + boff + n * 2048), PG8_LD16(PG8_SB(b, h) + (boff ^ 64) + n * 2048), 0, 1, 2, 3, 4, 5, 6, 7); } } while (0)
#define PG8_MMA(ai, bj, At, Bt) do { __builtin_amdgcn_s_setprio(1); _Pragma("unroll") for (int m = 0; m < 4; ++m) _Pragma("unroll") for (int n = 0; n < 2; ++n) { \
        if constexpr (ESZ == 2) { _Pragma("unroll") for (int k = 0; k < 2; ++k) acc[ai][bj][m][n] = __builtin_amdgcn_mfma_f32_16x16x32_bf16(Bt[n][k], At[m][k], acc[ai][bj][m][n], 0, 0, 0); } \
        else asm volatile("s_nop 1\n\tv_mfma_scale_f32_16x16x128_f8f6f4 %0, %1, %2, %0, %3, %3 op_sel_hi:[0,0,0]" : "+v"(acc[ai][bj][m][n]) : "v"(Bt##8[n]), "v"(At##8[m]), "v"(one_scale)); } \
        __builtin_amdgcn_s_setprio(0); } while (0)
#define PG8_WAIT_V(n) asm volatile("s_waitcnt vmcnt(" #n ")" ::: "memory")
#define PG8_WAIT_L(n) asm volatile("s_waitcnt lgkmcnt(" #n ")" ::: "memory")
#define PG8_BAR __builtin_amdgcn_s_barrier()
#define PG8_SCHED __builtin_amdgcn_sched_barrier(0)
    Unit cur, nxt; int ui = 0;
    if (!S.next(0, cur)) return;
    f32x4 acc[2][2][4][2];
#pragma unroll
    for (int a = 0; a < 2; ++a)
#pragma unroll
        for (int b = 0; b < 2; ++b)
#pragma unroll
            for (int m = 0; m < 4; ++m)
#pragma unroll
                for (int n = 0; n < 2; ++n) acc[a][b][m][n] = (f32x4){0.f, 0.f, 0.f, 0.f};
    const int one_scale = 0x7F7F7F7F;
    bf16x8 At[4][2], B0[2][2], B1[2][2]; v8i At8[4], B08[2], B18[2];
    const char* cA = (const char*)g.A + (size_t)cur.rowA * g.lda * ESZ; const char* cB = (const char*)g.Bt + (size_t)cur.rowB * g.ldb * ESZ;
    unsigned vA[2][2] = {{0u, 0u}, {0u, 0u}}, vN[2][2] = {{0u, 0u}, {0u, 0u}}; const char* nA = cA;
    if constexpr (GATHER) PG8_GOFF(cur, vA);
    PG8_STAGE(PG8_SB(0, 0), cB, voffB); PG8_STAGE(PG8_SB(0, 1), cB + hstepB, voffB); PG8_STAGE_A(PG8_SA(0, 0), false, 0, 0); PG8_STAGE_A(PG8_SA(0, 1), false, 0, 1);
    if (wr == 1) PG8_BAR;
    PG8_WAIT_V(2); PG8_BAR;
    PG8_STAGE(PG8_SB(1, 0), cB + kstep, voffB); PG8_STAGE_A(PG8_SA(1, 0), false, 1, 0); PG8_STAGE(PG8_SB(1, 1), cB + hstepB + kstep, voffB);
    PG8_WAIT_V(6); PG8_BAR;
    for (;;) {
        const bool has_next = S.next(ui + 1, nxt);
        nA = has_next ? (const char*)g.A + (size_t)nxt.rowA * g.lda * ESZ : cA; const char* nB = has_next ? (const char*)g.Bt + (size_t)nxt.rowB * g.ldb * ESZ : cB;
        if constexpr (GATHER) { if (has_next) PG8_GOFF(nxt, vN); else { vN[0][0] = vA[0][0]; vN[0][1] = vA[0][1]; vN[1][0] = vA[1][0]; vN[1][1] = vA[1][1]; } }
        const bool hnz = NSPLIT && cur.hn != 0;
        for (int t = 0; t < nt; t += 2) {
            const bool last = (t == nt - 2);
            const char* b2 = last ? nB : cB + (size_t)(t + 2) * kstep; const char* b3 = b2 + kstep;
            const int t2 = last ? 0 : t + 2, t3 = last ? 1 : t + 3;
            PG8_LDB(B0, 0, 0); if (NSPLIT ? !hnz : true) PG8_LDB(B1, 0, 1); PG8_SCHED; PG8_LDA(At, 0, 0); PG8_STAGE_A(PG8_SA(1, 1), false, t + 1, 1);
            PG8_WAIT_V(8); PG8_WAIT_L(0); PG8_BAR; PG8_MMA(0, 0, At, B0); if (NSPLIT ? !hnz : true) PG8_MMA(0, 1, At, B1); PG8_BAR; PG8_SCHED;
            PG8_LDA(At, 0, 1); PG8_STAGE(PG8_SB(0, 0), b2, voffB); PG8_STAGE(PG8_SB(0, 1), b2 + hstepB, voffB); PG8_STAGE_A(PG8_SA(0, 0), last, t2, 0);
            PG8_WAIT_V(8); PG8_WAIT_L(0); PG8_BAR; PG8_MMA(1, 0, At, B0); if (NSPLIT ? !hnz : true) PG8_MMA(1, 1, At, B1); PG8_BAR; PG8_SCHED;
            PG8_LDB(B0, 1, 0); if (NSPLIT ? !hnz : true) PG8_LDB(B1, 1, 1); PG8_SCHED; PG8_LDA(At, 1, 0); PG8_STAGE_A(PG8_SA(0, 1), last, t2, 1);
            PG8_WAIT_V(8); PG8_WAIT_L(0); PG8_BAR; PG8_MMA(0, 0, At, B0); if (NSPLIT ? !hnz : true) PG8_MMA(0, 1, At, B1); PG8_BAR; PG8_SCHED;
            PG8_LDA(At, 1, 1); PG8_STAGE(PG8_SB(1, 0), b3, voffB); PG8_STAGE(PG8_SB(1, 1), b3 + hstepB, voffB); PG8_STAGE_A(PG8_SA(1, 0), last, t3, 0);
            PG8_WAIT_V(8); PG8_WAIT_L(0); PG8_BAR; PG8_MMA(1, 0, At, B0); if (NSPLIT ? !hnz : true) PG8_MMA(1, 1, At, B1); PG8_BAR; PG8_SCHED;
        }
        if constexpr (ESZ == 1) asm volatile("s_nop 15\n\ts_nop 15" ::: "memory");
        if constexpr (ALIGN_EPI) { if (wr == 0) PG8_BAR; }
        E(acc, cur, wr, wc, fr, fq);
        if (!has_next) break;
#pragma unroll
        for (int a = 0; a < 2; ++a)
#pragma unroll
            for (int b = 0; b < 2; ++b)
#pragma unroll
                for (int m = 0; m < 4; ++m)
#pragma unroll
                    for (int n = 0; n < 2; ++n) acc[a][b][m][n] = (f32x4){0.f, 0.f, 0.f, 0.f};
        cur = nxt; cA = nA; cB = nB; ++ui;
        if constexpr (GATHER) { vA[0][0] = vN[0][0]; vA[0][1] = vN[0][1]; vA[1][0] = vN[1][0]; vA[1][1] = vN[1][1]; }
        if constexpr (ALIGN_EPI) { if (wr == 1) PG8_BAR; }
    }
    PG8_WAIT_V(0);
    if constexpr (!ALIGN_EPI) { if (wr == 0) PG8_BAR; }
    PG8_BAR;
#undef PG8_SA
#undef PG8_SB
#undef PG8_STAGE
#undef PG8_LDA
#undef PG8_LD16
#undef PG8_GOFF
#undef PG8_STAGE_A
#undef PG8_LDB
#undef PG8_MMA
#undef PG8_WAIT_V
#undef PG8_WAIT_L
#undef PG8_BAR
#undef PG8_SCHED
}

typedef short s16x4 __attribute__((ext_vector_type(4)));
struct UnitF { int rowA, pn, e; const float* b0; const float* b1; };
struct GemmF { const bf16* A; int lda, K, ldbn; };
struct MoeOrderF {
    const volatile LAS int* tab; int nct, G, c; const float* w0; const float* w1; size_t estride; int cstep;
    __device__ bool next(int i, UnitF& u) const {
        const int L = i * G + c; const int total = __builtin_amdgcn_readfirstlane(tab[32]); if (L >= total) return false;
        int e = 0;
        for (; e < 31; ++e) { if (L < __builtin_amdgcn_readfirstlane(tab[e + 1])) break; }
        const int local = L - __builtin_amdgcn_readfirstlane(tab[e]); const int nt = __builtin_amdgcn_readfirstlane(tab[72 + e]);
        const int ct = local / nt, rt = local - ct * nt;
        u.rowA = __builtin_amdgcn_readfirstlane(tab[36 + e]) + rt * BM; u.pn = ct; u.e = e;
        u.b0 = w0 + (size_t)e * estride + (size_t)ct * cstep; u.b1 = w1 + (size_t)e * estride + (size_t)ct * cstep; return true;
    }
};
struct EpiGluNP {
    bf16* O; const float* bg; const float* bu;
    __device__ __forceinline__ void operator()(const f32x4 (&acc)[2][2][4][2], const UnitF& u, int wr, int wc, int fr, int fq) const {
        const int row0 = u.rowA + wr * 64 + fr, col0 = u.pn * HALF + wc * 32 + 4 * fq;
        f32x4 gb[2], ub[2];
#pragma unroll
        for (int n = 0; n < 2; ++n) { gb[n] = *(const f32x4*)(bg + (size_t)u.e * FF + col0 + 16 * n); ub[n] = *(const f32x4*)(bu + (size_t)u.e * FF + col0 + 16 * n); }
#pragma unroll
        for (int ai = 0; ai < 2; ++ai)
#pragma unroll
            for (int m = 0; m < 4; ++m) { bf16* op = O + (size_t)(row0 + ai * HALF + m * 16) * FF + col0;
#pragma unroll
                for (int n = 0; n < 2; ++n) { float r[4];
#pragma unroll
                    for (int j = 0; j < 4; ++j) { const float gg = fminf(acc[ai][0][m][n][j] + gb[n][j], 7.f); const float up = fminf(fmaxf(acc[ai][1][m][n][j] + ub[n][j], -7.f), 7.f);
                        r[j] = (up + 1.f) * gg * sigmoidf_(1.702f * gg); }
                    v2u w; w.x = cvt_pk_bf16(r[0], r[1]); w.y = cvt_pk_bf16(r[2], r[3]); *(v2u*)(op + 16 * n) = w; } }
    }
};
struct EpiBf16NP {
    bf16* O; int ldc; const float* bias; int bias_estride;
    __device__ __forceinline__ void operator()(const f32x4 (&acc)[2][2][4][2], const UnitF& u, int wr, int wc, int fr, int fq) const {
        const int row0 = u.rowA + wr * 64 + fr, col0 = u.pn * BM + wc * 32 + 4 * fq;
        f32x4 bv[2][2];
#pragma unroll
        for (int bj = 0; bj < 2; ++bj)
#pragma unroll
            for (int n = 0; n < 2; ++n) bv[bj][n] = *(const f32x4*)(bias + (size_t)u.e * bias_estride + col0 + bj * HALF + 16 * n);
#pragma unroll
        for (int ai = 0; ai < 2; ++ai)
#pragma unroll
            for (int m = 0; m < 4; ++m) { bf16* rowp = O + (size_t)(row0 + ai * HALF + m * 16) * ldc + col0;
#pragma unroll
                for (int bj = 0; bj < 2; ++bj)
#pragma unroll
                    for (int n = 0; n < 2; ++n) { const f32x4 v = acc[ai][bj][m][n] + bv[bj][n]; v2u w; w.x = cvt_pk_bf16(v[0], v[1]); w.y = cvt_pk_bf16(v[2], v[3]); *(v2u*)(rowp + bj * HALF + 16 * n) = w; } }
    }
};
template <class Epi, class Sched>
__device__ __forceinline__ void gemm_phase_f32b(LAS unsigned char* lds, const GemmF g, const Sched& S, const Epi& E) {
    const int tid = threadIdx.x, wid = __builtin_amdgcn_readfirstlane(tid >> 6), lane = tid & 63, wr = wid >> 2, wc = wid & 3, fr = lane & 15, fq = lane >> 4;
    const int K = g.K, nt = K / BK;
    unsigned voffA[2];
#pragma unroll
    for (int i = 0; i < 2; ++i) { int R, C; stage_rc(tid * 16 + i * 8192, R, C); voffA[i] = (unsigned)(R * g.lda + C) * 2u; }
    const size_t kstep = (size_t)(BK * 2);
    const size_t hstepA = (size_t)HALF * g.lda * 2;
    const unsigned ldsw = (unsigned)wid * 1024u;
    const int aoff = lds_byte(wr * 64 + fr, fq * 8);
    const int ldsb = (int)(uintptr_t)lds;
    const int q4 = (lane & 15) >> 2, p4 = lane & 3;
    const int fsw = q4 | ((fq & 1) << 2);
    int rbase[2];
#pragma unroll
    for (int n = 0; n < 2; ++n) rbase[n] = (8 * fq + q4) * 256 + ((((wc * 2) ^ fsw) ^ n) * 32) + 8 * p4;
    const int hB = wid >> 2, r0 = 2 * (wid & 3) + (lane >> 5), l31 = lane & 31;
    const int wslot = (l31 >> 2) ^ (r0 & 3);
    const int wb0 = hB * HTB + r0 * 256 + wslot * 32 + (lane & 3) * 8, wb1 = hB * HTB + r0 * 256 + (wslot ^ 4) * 32 + (lane & 3) * 8;
    const unsigned laneoffB = (unsigned)(r0 * g.ldbn + 4 * l31) * 4u;
    const size_t rstep8 = (size_t)8 * g.ldbn * 4, tstepB = (size_t)64 * g.ldbn * 4;
#define PG8_SA(b, h) (((b) * 2 + (h)) * HTB)
#define PG8_SB(b, h) ((4 + (b) * 2 + (h)) * HTB)
#define PG8_STAGE(bufoff, gbase, voff) do { _Pragma("unroll") for (int _i = 0; _i < 2; ++_i) { unsigned keep_; \
        asm volatile("s_mov_b32 %0, m0\n\ts_mov_b32 m0, %2\n\ts_nop 0\n\tglobal_load_lds_dwordx4 %1, off\n\ts_mov_b32 m0, %0" : "=&s"(keep_) \
            : "v"((const char*)(gbase) + (voff)[_i]), "s"(__builtin_amdgcn_readfirstlane(ldsb + (bufoff) + (int)ldsw + _i * 8192)) : "memory"); } } while (0)
#define PG8_LDA(dst, b, h) do { _Pragma("unroll") for (int m = 0; m < 4; ++m) _Pragma("unroll") for (int k = 0; k < 2; ++k) dst[m][k] = *(const LAS bf16x8*)(lds + PG8_SA(b, h) + (k ? (aoff ^ 64) : aoff) + m * 2048); } while (0)
#define PG8_LDBT(dst, b, h) do { _Pragma("unroll") for (int n = 0; n < 2; ++n) _Pragma("unroll") for (int k = 0; k < 2; ++k) { \
        const s16x4 lo_ = __builtin_amdgcn_ds_read_tr16_b64_v4i16((LAS s16x4*)(lds + PG8_SB(b, h) + rbase[n] + k * 8192)); \
        const s16x4 hi_ = __builtin_amdgcn_ds_read_tr16_b64_v4i16((LAS s16x4*)(lds + PG8_SB(b, h) + rbase[n] + k * 8192 + 1024)); \
        dst[n][k] = __builtin_shufflevector(lo_, hi_, 0, 1, 2, 3, 4, 5, 6, 7); } } while (0)
#define PG8_BPTR(p0, p1, tt) ((const char*)(hB ? (p1) : (p0)) + (size_t)(tt) * tstepB)
#define PG8_LOADB1(pb, i) dreg[i] = *(const f32x4*)((pb) + (size_t)(i) * rstep8 + laneoffB)
#define PG8_LOADB(p0, p1, tt) do { const char* pb_ = PG8_BPTR(p0, p1, tt); _Pragma("unroll") for (int _i = 0; _i < 8; ++_i) PG8_LOADB1(pb_, _i); } while (0)
#define PG8_WRITEB1(b, i) do { v2u pk_; pk_.x = cvt_pk_bf16(dreg[i].x, dreg[i].y); pk_.y = cvt_pk_bf16(dreg[i].z, dreg[i].w); \
        *(LAS v2u*)(lds + PG8_SB(b, 0) + (((i) & 1) ? wb1 : wb0) + (i) * 2048) = pk_; } while (0)
#define PG8_WRITEB(b) do { _Pragma("unroll") for (int _i = 0; _i < 8; ++_i) PG8_WRITEB1(b, _i); } while (0)
#define PG8_MF(ai, bj, m, At, Bt) do { _Pragma("unroll") for (int n = 0; n < 2; ++n) _Pragma("unroll") for (int k = 0; k < 2; ++k) \
        acc[ai][bj][m][n] = __builtin_amdgcn_mfma_f32_16x16x32_bf16(Bt[n][k], At[m][k], acc[ai][bj][m][n], 0, 0, 0); } while (0)
#define PG8_MMA(ai, bj, At, Bt) do { __builtin_amdgcn_s_setprio(1); _Pragma("unroll") for (int m = 0; m < 4; ++m) PG8_MF(ai, bj, m, At, Bt); __builtin_amdgcn_s_setprio(0); } while (0)
#define PG8_MMA_CVT(ai, bj, At, Bt, b) do { __builtin_amdgcn_s_setprio(1); _Pragma("unroll") for (int m = 0; m < 4; ++m) { PG8_MF(ai, bj, m, At, Bt); PG8_WRITEB1(b, 2 * m); PG8_WRITEB1(b, 2 * m + 1); PG8_SCHED; } __builtin_amdgcn_s_setprio(0); } while (0)
#define PG8_MMA_LD(ai, bj, At, Bt, pb) do { __builtin_amdgcn_s_setprio(1); _Pragma("unroll") for (int m = 0; m < 4; ++m) { PG8_MF(ai, bj, m, At, Bt); PG8_LOADB1(pb, 2 * m); PG8_LOADB1(pb, 2 * m + 1); PG8_SCHED; } __builtin_amdgcn_s_setprio(0); } while (0)
#define PG8_WAIT_V(n) asm volatile("s_waitcnt vmcnt(" #n ")" ::: "memory")
#define PG8_WAIT_L(n) asm volatile("s_waitcnt lgkmcnt(" #n ")" ::: "memory")
#define PG8_BAR __builtin_amdgcn_s_barrier()
#define PG8_SCHED __builtin_amdgcn_sched_barrier(0)
#define PG8_BS0(T) ((T) >= nt ? nb0 : cur.b0)
#define PG8_BS1(T) ((T) >= nt ? nb1 : cur.b1)
#define PG8_BT(T) ((T) >= nt ? (T) - nt : (T))
    UnitF cur, nxt; int ui = 0;
    if (!S.next(0, cur)) return;
    f32x4 acc[2][2][4][2];
#pragma unroll
    for (int a = 0; a < 2; ++a)
#pragma unroll
        for (int b = 0; b < 2; ++b)
#pragma unroll
            for (int m = 0; m < 4; ++m)
#pragma unroll
                for (int n = 0; n < 2; ++n) acc[a][b][m][n] = (f32x4){0.f, 0.f, 0.f, 0.f};
    bf16x8 At[4][2], B0[2][2], B1[2][2];
    f32x4 dreg[8];
    const char* cA = (const char*)g.A + (size_t)cur.rowA * g.lda * 2;
    PG8_STAGE(PG8_SA(0, 0), cA, voffA); PG8_STAGE(PG8_SA(0, 1), cA + hstepA, voffA); PG8_STAGE(PG8_SA(1, 0), cA + kstep, voffA);
    PG8_LOADB(cur.b0, cur.b1, 0); PG8_WRITEB(0); PG8_LOADB(cur.b0, cur.b1, 1); PG8_WRITEB(1); PG8_LOADB(cur.b0, cur.b1, 2);
    PG8_WAIT_V(8); PG8_WAIT_L(0);
    if (wr == 1) PG8_BAR;
    PG8_BAR;
    for (;;) {
        const bool has_next = S.next(ui + 1, nxt);
        const char* nA = has_next ? (const char*)g.A + (size_t)nxt.rowA * g.lda * 2 : cA;
        const float* nb0 = has_next ? nxt.b0 : cur.b0; const float* nb1 = has_next ? nxt.b1 : cur.b1;
        for (int t = 0; t < nt; t += 2) {
            const bool last = (t == nt - 2);
            const char* a1 = cA + (size_t)(t + 1) * kstep;
            const char* a2 = last ? nA : cA + (size_t)(t + 2) * kstep;
            const char* a3 = a2 + kstep;
            const char* pb3 = PG8_BPTR(PG8_BS0(t + 3), PG8_BS1(t + 3), PG8_BT(t + 3));
            const char* pb4 = PG8_BPTR(PG8_BS0(t + 4), PG8_BS1(t + 4), PG8_BT(t + 4));
            PG8_LDBT(B0, 0, 0); PG8_LDBT(B1, 0, 1); PG8_SCHED; PG8_LDA(At, 0, 0); PG8_STAGE(PG8_SA(1, 1), a1 + hstepA, voffA);
            PG8_WAIT_V(12); PG8_WAIT_L(0); PG8_SCHED; PG8_BAR; PG8_MMA(0, 0, At, B0); PG8_MMA(0, 1, At, B1); PG8_BAR; PG8_SCHED;
            PG8_LDA(At, 0, 1);
            PG8_WAIT_V(10); PG8_WAIT_L(0); PG8_SCHED; PG8_BAR; PG8_MMA_CVT(1, 0, At, B0, 0); PG8_STAGE(PG8_SA(0, 0), a2, voffA); PG8_MMA_LD(1, 1, At, B1, pb3); PG8_BAR; PG8_SCHED;
            PG8_LDBT(B0, 1, 0); PG8_LDBT(B1, 1, 1); PG8_SCHED; PG8_LDA(At, 1, 0); PG8_STAGE(PG8_SA(0, 1), a2 + hstepA, voffA);
            PG8_WAIT_V(12); PG8_WAIT_L(0); PG8_SCHED; PG8_BAR; PG8_MMA(0, 0, At, B0); PG8_MMA(0, 1, At, B1); PG8_BAR; PG8_SCHED;
            PG8_LDA(At, 1, 1);
            PG8_WAIT_V(10); PG8_WAIT_L(0); PG8_SCHED; PG8_BAR; PG8_MMA_CVT(1, 0, At, B0, 1); PG8_STAGE(PG8_SA(1, 0), a3, voffA); PG8_MMA_LD(1, 1, At, B1, pb4); PG8_BAR; PG8_SCHED;
        }
        if (wr == 0) PG8_BAR;
        E(acc, cur, wr, wc, fr, fq);
        if (!has_next) break;
#pragma unroll
        for (int a = 0; a < 2; ++a)
#pragma unroll
            for (int b = 0; b < 2; ++b)
#pragma unroll
                for (int m = 0; m < 4; ++m)
#pragma unroll
                    for (int n = 0; n < 2; ++n) acc[a][b][m][n] = (f32x4){0.f, 0.f, 0.f, 0.f};
        cur = nxt; cA = nA; ++ui;
        if (wr == 1) PG8_BAR;
    }
    PG8_WAIT_V(0);
    asm volatile("" :: "v"(dreg[0]), "v"(dreg[7]));
    PG8_BAR;
#undef PG8_SA
#undef PG8_SB
#undef PG8_STAGE
#undef PG8_LDA
#undef PG8_LDBT
#undef PG8_BPTR
#undef PG8_LOADB1
#undef PG8_LOADB
#undef PG8_WRITEB1
#undef PG8_WRITEB
#undef PG8_MF
#undef PG8_MMA
#undef PG8_MMA_CVT
#undef PG8_MMA_LD
#undef PG8_WAIT_V
#undef PG8_WAIT_L
#undef PG8_BAR
#undef PG8_SCHED
#undef PG8_BS0
#undef PG8_BS1
#undef PG8_BT
}
}

#define XB_TMO      128
#define XB_XCNT(j)  (256  + 64 * (j))
#define XB_XSUB(j)  (1280 + 64 * (j))
#define XB_XGEN(j)  (2304 + 64 * (j))
#define XB_TOP      3328
#define XB_TOPGEN   3392
#define XCD_BAR_WORDS 3456
#define XB_SPIN_CAP (1u << 18)
__device__ __forceinline__ unsigned xb_ld(unsigned* p)              { return __hip_atomic_load(p, __ATOMIC_RELAXED, __HIP_MEMORY_SCOPE_AGENT); }
__device__ __forceinline__ unsigned xb_add(unsigned* p, unsigned v) { return __hip_atomic_fetch_add(p, v, __ATOMIC_RELAXED, __HIP_MEMORY_SCOPE_AGENT); }
__device__ __forceinline__ unsigned xb_xcc_id() { return (unsigned)__builtin_amdgcn_s_getreg((3 << 11) | 20) & 0xFu; }
#define XB_SPIN(cond, bar) do { unsigned _sp = 0; while (cond) { __builtin_amdgcn_s_sleep(1); \
    if ((++_sp & 255u) == 0u) { if (xb_ld(&(bar)[XB_TMO])) break; if (_sp > XB_SPIN_CAP) { atomicAdd(&(bar)[XB_TMO], 1u); break; } } } } while (0)
struct XcdBarrier { unsigned* bar; unsigned x; volatile LAS unsigned* st; };
__device__ __forceinline__ XcdBarrier xcd_barrier_post(unsigned* bar, volatile LAS unsigned* st) {
    XcdBarrier b; b.bar = bar; b.x = xb_xcc_id(); b.st = st;
    if (threadIdx.x == 0) (void)xb_add(&bar[XB_XCNT(b.x)], 1u);
    return b;
}
__device__ __forceinline__ void xcd_barrier_complete(unsigned* bar, unsigned x, unsigned& nloc, unsigned& nx) {
    const unsigned G = gridDim.x * gridDim.y * gridDim.z;
    unsigned sum, cnt, mine, sp = 0u;
    for (;;) {
        sum = 0u; cnt = 0u; mine = 0u;
#pragma unroll
        for (unsigned j = 0; j < 16; ++j) { const unsigned c = xb_ld(&bar[XB_XCNT(j)]); sum += c; cnt += (c > 0u) ? 1u : 0u; mine = (j == x) ? c : mine; }
        if (sum == G) break;
        __builtin_amdgcn_s_sleep(1);
        if ((++sp & 255u) == 0u) { if (xb_ld(&bar[XB_TMO])) break; if (sp > XB_SPIN_CAP) { atomicAdd(&bar[XB_TMO], 1u); break; } }
    }
    nloc = mine > 0u ? mine : 1u; nx = cnt > 0u ? cnt : 1u;
}
__device__ __forceinline__ void xcd_barrier(const XcdBarrier& b) {
    asm volatile("s_waitcnt vmcnt(0)" ::: "memory");
    __syncthreads();
    if (threadIdx.x == 0) {
        unsigned* bar = b.bar;
        __builtin_amdgcn_s_waitcnt(0);
        unsigned nloc = b.st[0], nx = b.st[1];
        if (nloc == 0u) { xcd_barrier_complete(bar, b.x, nloc, nx); b.st[0] = nloc; b.st[1] = nx; }
        const unsigned old = xb_add(&bar[XB_XSUB(b.x)], 1u);
        const unsigned gen = old / nloc;
        if (old + 1u == (gen + 1u) * nloc) {
            __builtin_amdgcn_fence(__ATOMIC_RELEASE, "agent");
            asm volatile("s_waitcnt vmcnt(0)" ::: "memory");
            const unsigned og = xb_add(&bar[XB_TOP], 1u);
            const unsigned tg = og / nx;
            if (og + 1u == (tg + 1u) * nx) xb_add(&bar[XB_TOPGEN], 1u);
            else XB_SPIN(xb_ld(&bar[XB_TOPGEN]) == tg, bar);
            __builtin_amdgcn_fence(__ATOMIC_ACQUIRE, "agent");
            xb_add(&bar[XB_XGEN(b.x)], 1u);
            asm volatile("s_waitcnt vmcnt(0)" ::: "memory");
        } else {
            XB_SPIN(xb_ld(&bar[XB_XGEN(b.x)]) == gen, bar);
            __builtin_amdgcn_fence(__ATOMIC_ACQUIRE, "agent");
            asm volatile("s_waitcnt vmcnt(0)" ::: "memory");
        }
    }
    __syncthreads();
}

struct Args { const float* in[31]; float* out; unsigned char* ws; int ph_lo, ph_hi; };
enum { I_X = 0, I_NMG, I_WIN, I_MU, I_W0, I_W2, I_A0, I_A2, I_G2, I_KK, I_KA, I_RK, I_LNG, I_LNB, I_GWA2, I_GBA, I_GNG, I_BM, I_WBR, I_WBG, I_WOUT, I_NFG,
       I_WROUTER, I_BROUTER, I_WGATE, I_BGATE, I_WUP, I_BUP, I_WDOWN, I_BDOWN, I_NFINAL };
struct Frame {
    LAS unsigned char* lds; unsigned char* ws; unsigned* ctl;
    int tid, lane, wave, vcu, G;
};

__device__ __forceinline__ void tr_item(const float* W, int ldw, int nvalid, int k0, int n0, bf16* dst, int ldk, LAS float* scr, int lane) {
    const int c = lane & 31;
    const bool ok = (n0 + c) < nvalid;
#pragma unroll 8
    for (int i = 0; i < 32; ++i) { const int kk = 2 * i + (lane >> 5); scr[kk * 33 + c] = ok ? W[(size_t)(k0 + kk) * ldw + n0 + c] : 0.f; }
    LDS_WAIT(); asm volatile("" ::: "memory");
    const int c8 = lane & 7;
#pragma unroll
    for (int j = 0; j < 4; ++j) { const int n = (lane >> 3) + 8 * j; const LAS float* s = scr + (8 * c8) * 33 + n;
        v4u o; o.x = pk2(s[0 * 33], s[1 * 33]); o.y = pk2(s[2 * 33], s[3 * 33]); o.z = pk2(s[4 * 33], s[5 * 33]); o.w = pk2(s[6 * 33], s[7 * 33]);
        *(v4u*)(dst + (size_t)n * ldk + k0 + 8 * c8) = o; }
    LDS_WAIT(); asm volatile("" ::: "memory");
}
__device__ __forceinline__ void cv_load(const float* W, int ldw, int k0, int n0, int lane, f32x4 (&cr)[16]) {
    const unsigned laneoff = (unsigned)((lane >> 3) * ldw + n0 + 4 * (lane & 7)) * 4u;
#pragma unroll
    for (int i = 0; i < 16; ++i) { const char* rowp = (const char*)W + (size_t)(k0 + 8 * i) * ldw * 4; cr[i] = *(const f32x4*)(rowp + laneoff); }
}
__device__ __forceinline__ void cv_finish(const f32x4 (&cr)[16], int k0, unsigned char* dst, int ldk, LAS float* scr, int lane, float scale) {
    const int rr = lane >> 3, ch = lane & 7;
#pragma unroll
    for (int i = 0; i < 16; ++i) { LAS float* d = scr + (8 * i + rr) * 33 + 4 * ch; d[0] = cr[i].x * scale; d[1] = cr[i].y * scale; d[2] = cr[i].z * scale; d[3] = cr[i].w * scale; }
    LDS_WAIT(); asm volatile("" ::: "memory");
#pragma unroll
    for (int j = 0; j < 4; ++j) { const int n = rr + 8 * j; const LAS float* sp = scr + (16 * ch) * 33 + n;
        v4u o; o.x = pk4_fp8(sp[0 * 33], sp[1 * 33], sp[2 * 33], sp[3 * 33]); o.y = pk4_fp8(sp[4 * 33], sp[5 * 33], sp[6 * 33], sp[7 * 33]);
        o.z = pk4_fp8(sp[8 * 33], sp[9 * 33], sp[10 * 33], sp[11 * 33]); o.w = pk4_fp8(sp[12 * 33], sp[13 * 33], sp[14 * 33], sp[15 * 33]);
        *(v4u*)(dst + (size_t)n * ldk + k0 + 16 * ch) = o; }
    LDS_WAIT(); asm volatile("" ::: "memory");
}
__device__ __forceinline__ void cv_issue_dma(const float* W, int ldw, int k0, int n0, int lane, LAS float* scr) {
#pragma unroll
    for (int i = 0; i < 16; ++i) { const char* rowp = (const char*)W + (size_t)(k0 + 8 * i) * ldw * 4;
        const unsigned off = (unsigned)((lane >> 3) * ldw + n0 + 4 * ((lane & 7) ^ (i >> 1))) * 4u;
        __builtin_amdgcn_global_load_lds((const unsigned*)(rowp + off), (LAS unsigned*)(scr + i * 256), 16, 0, 2); }
}
__device__ __forceinline__ void cv_finish_dma(int k0, unsigned char* dst, int ldk, const LAS float* scr, int lane, float scale) {
    const int rr = lane >> 3, ch = lane & 7;
#pragma unroll
    for (int j = 0; j < 4; ++j) { const int n = rr + 8 * j; const LAS float* sp = scr + (16 * ch) * 32 + ((((n >> 2) ^ ch) << 2) | (n & 3));
        float f[16];
#pragma unroll
        for (int i = 0; i < 16; ++i) f[i] = sp[i * 32] * scale;
        v4u o; o.x = pk4_fp8(f[0], f[1], f[2], f[3]); o.y = pk4_fp8(f[4], f[5], f[6], f[7]); o.z = pk4_fp8(f[8], f[9], f[10], f[11]); o.w = pk4_fp8(f[12], f[13], f[14], f[15]);
        *(v4u*)(dst + (size_t)n * ldk + k0 + 16 * ch) = o; }
}
__device__ __forceinline__ void cvb_finish_dma(int k0, bf16* dst, int ldk, const LAS float* scr, int lane) {
    const int rr = lane >> 3, ch = lane & 7;
#pragma unroll
    for (int j = 0; j < 4; ++j) { const int n = rr + 8 * j; const LAS float* sp = scr + (16 * ch) * 32 + ((((n >> 2) ^ ch) << 2) | (n & 3));
        float f[16];
#pragma unroll
        for (int i = 0; i < 16; ++i) f[i] = sp[i * 32];
        v4u o0, o1; o0.x = pk2(f[0], f[1]); o0.y = pk2(f[2], f[3]); o0.z = pk2(f[4], f[5]); o0.w = pk2(f[6], f[7]); o1.x = pk2(f[8], f[9]); o1.y = pk2(f[10], f[11]); o1.z = pk2(f[12], f[13]); o1.w = pk2(f[14], f[15]);
        bf16* d = dst + (size_t)n * ldk + k0 + 16 * ch; *(v4u*)d = o0; *(v4u*)(d + 8) = o1; }
}
__device__ __forceinline__ void cvr_load(const float* W, int ldw, int k0, int n0, int lane, f32x4 (&cr)[16]) {
    const unsigned laneoff = (unsigned)((16 * (lane >> 3)) * ldw + n0 + 4 * (lane & 7)) * 4u;
#pragma unroll
    for (int i = 0; i < 16; ++i) { const char* rowp = (const char*)W + (size_t)(k0 + i) * ldw * 4; cr[i] = __builtin_nontemporal_load((const f32x4*)(rowp + laneoff)); }
}
__device__ __forceinline__ void cvr_store(const f32x4 (&cr)[16], int k0, unsigned char* dst, int ldk, int lane, float scale) {
    unsigned char* d = dst + (size_t)(4 * (lane & 7)) * ldk + k0 + 16 * (lane >> 3);
#pragma unroll
    for (int j = 0; j < 4; ++j) { v4u o;
        o.x = pk4_fp8(cr[0][j] * scale, cr[1][j] * scale, cr[2][j] * scale, cr[3][j] * scale); o.y = pk4_fp8(cr[4][j] * scale, cr[5][j] * scale, cr[6][j] * scale, cr[7][j] * scale);
        o.z = pk4_fp8(cr[8][j] * scale, cr[9][j] * scale, cr[10][j] * scale, cr[11][j] * scale); o.w = pk4_fp8(cr[12][j] * scale, cr[13][j] * scale, cr[14][j] * scale, cr[15][j] * scale);
        __builtin_nontemporal_store(o, (v4u*)(d + (size_t)j * ldk)); }
}
struct CvItem { const float* W; unsigned char* dst; int ldw, ldk, k0, n0; };
__device__ __forceinline__ CvItem cv_item(const Args& a, unsigned char* ws, int idx) {
    constexpr int I_EXP = (D / 128) * (FF / 32);
    int r = idx; const int mat = r / (NE * I_EXP); r -= mat * (NE * I_EXP); const int e = r / I_EXP; r -= e * I_EXP;
    const int kb = r / (FF / 32), nb = r % (FF / 32), n0 = 32 * nb;
    CvItem it; it.k0 = 128 * kb; it.n0 = n0;
    if (mat == 0) { it.W = a.in[I_WGATE] + (size_t)e * D * FF; it.ldw = FF; it.dst = ws + WS_WGU + ((size_t)e * 4096 + (n0 >> 7) * 256 + (n0 & 127)) * D; it.ldk = D; }
    else if (mat == 1) { it.W = a.in[I_WUP] + (size_t)e * D * FF; it.ldw = FF; it.dst = ws + WS_WGU + ((size_t)e * 4096 + (n0 >> 7) * 256 + 128 + (n0 & 127)) * D; it.ldk = D; }
    else { it.W = a.in[I_WDOWN] + (size_t)e * FF * D; it.ldw = D; it.dst = ws + WS_WD + ((size_t)e * 2048 + n0) * FF; it.ldk = FF; }
    return it;
}
constexpr int CV_ITEMS = 3 * NE * (D / 128) * (FF / 32);
constexpr int CVQ_CH = 4, CVQ_NCH = CV_ITEMS / CVQ_CH;
__device__ __forceinline__ unsigned cvq_issue(unsigned* q, int lane) { unsigned c = 0; if (lane == 0) c = __hip_atomic_fetch_add(q, 1u, RLX_AGENT); return c; }
__device__ __forceinline__ void rms_row_to_bf16(const float* xrow, const float* g, bf16* orow, int lane) {
    const f32x4* xr = (const f32x4*)xrow + lane; const f32x4* gr = (const f32x4*)g + lane;
    f32x4 v[8]; float s = 0.f;
#pragma unroll
    for (int j = 0; j < 8; ++j) { v[j] = __builtin_nontemporal_load(xr + 64 * j); s += (v[j].x * v[j].x + v[j].y * v[j].y) + (v[j].z * v[j].z + v[j].w * v[j].w); }
    const float rstd = rsqrtf(wave_sum(s) * (1.f / D) + NORM_EPS);
    v2u* o8 = (v2u*)orow + lane;
#pragma unroll
    for (int j = 0; j < 8; ++j) { const f32x4 gg = gr[64 * j]; v2u o; o.x = pk2(v[j].x * rstd * gg.x, v[j].y * rstd * gg.y); o.y = pk2(v[j].z * rstd * gg.z, v[j].w * rstd * gg.w); o8[64 * j] = o; }
}
constexpr int DT_NBF = IN_COLS / 32;
constexpr int DT_IN = (D / 128) * DT_NBF, DT_BA = (RW / 128) * (D / 32), DT_BB = DT_BA, DT_OUT = (D / 128) * (D / 32), DT_ALL = DT_IN + DT_BA + DT_BB + DT_OUT;
__device__ __forceinline__ void dense_tile(const Frame& F, const Args& a, int it, LAS float* t2) {
    bf16* Wt_in = (bf16*)(F.ws + WS_WIN); bf16* Wt_ba = (bf16*)(F.ws + WS_WBA); bf16* Wt_bb = (bf16*)(F.ws + WS_WBB); bf16* Wt_out = (bf16*)(F.ws + WS_WOUT);
    const float* W = nullptr; int ldw = 0, k0 = 0, n0 = 0, ldk = 0; bf16* dst = nullptr; int r = it;
    if (r < DT_IN) { const int kb = r / DT_NBF, nb = r % DT_NBF; W = a.in[I_WIN]; ldw = IN_COLS; k0 = 128 * kb; n0 = 32 * nb; dst = Wt_in + (size_t)n0 * DP; ldk = DP; }
    else if ((r -= DT_IN) < DT_BA) { const int kb = r / (D / 32), nb = r % (D / 32); W = a.in[I_WBR]; ldw = D; k0 = 128 * kb; n0 = 32 * nb; dst = Wt_ba + (size_t)n0 * RW; ldk = RW; }
    else if ((r -= DT_BA) < DT_BB) { const int kb = r / (D / 32), nb = r % (D / 32); W = a.in[I_WBG]; ldw = D; k0 = 128 * kb; n0 = 32 * nb; dst = Wt_bb + (size_t)n0 * GVW; ldk = GVW; }
    else { r -= DT_BB; const int kb = r / (D / 32), nb = r % (D / 32); W = a.in[I_WOUT]; ldw = D; k0 = 128 * kb; n0 = 32 * nb; dst = Wt_out + (size_t)n0 * D; ldk = D; }
    cv_issue_dma(W, ldw, k0, n0, F.lane, t2);
    asm volatile("s_waitcnt vmcnt(0)" ::: "memory");
    cvb_finish_dma(k0, dst, ldk, t2, F.lane); asm volatile("s_waitcnt lgkmcnt(0)" ::: "memory");
}
__device__ __forceinline__ void p0_prologue(const Frame& F, const Args& a) {
    LAS float* scr = (LAS float*)(F.lds + F.wave * 16896);
    const int gw = F.vcu * 8 + F.wave, NGW = F.G * 8;
    bf16* Wt_in = (bf16*)(F.ws + WS_WIN); bf16* Wt_ba = (bf16*)(F.ws + WS_WBA); bf16* Wt_bb = (bf16*)(F.ws + WS_WBB); bf16* Wt_out = (bf16*)(F.ws + WS_WOUT);
    constexpr int NB_IN = PLD / 32;
    constexpr int I_IN = (D / 64) * NB_IN, I_BA = (RW / 64) * (D / 32), I_BB = I_BA, I_OUT = (D / 64) * (D / 32);
    constexpr int NITEMS = I_IN + I_BA + I_BB + I_OUT;
    {
        constexpr int NBF = DT_NBF;
        LAS float* t2 = (LAS float*)(F.lds + F.wave * 16384);
        const int ntile = (F.G == 256) ? DT_IN : DT_ALL;
        for (int it = gw; it < ntile; it += NGW) dense_tile(F, a, it, t2);
        __syncthreads();
        for (int it = gw; it < (D / 64) * 2; it += NGW) { const int kb = it >> 1, nb = NBF + (it & 1); tr_item(a.in[I_WIN], IN_COLS, IN_COLS, 64 * kb, 32 * nb, Wt_in + (size_t)(32 * nb) * DP, DP, scr, F.lane); }
    }
    bf16* Hh = (bf16*)(F.ws + WS_H);
    for (int m = gw; m < T; m += NGW) rms_row_to_bf16(a.in[I_X] + (size_t)m * D, a.in[I_NMG], Hh + (size_t)m * DP, F.lane);
    const int gt = F.vcu * 512 + F.tid, NGT = F.G * 512;
    bf16* Wl_wa = (bf16*)(F.ws + WS_WLWA); bf16* Wl_g = (bf16*)(F.ws + WS_WLG);
    for (int i = gt; i < 2048 * 256; i += NGT) { const int n = i >> 8, k = i & 255; float v = 0.f;
        if (n < 1024) { if (k < DLORA) v = a.in[I_W2][(size_t)k * RW + n]; } else { if (k >= DLORA && k < 2 * DLORA) v = a.in[I_A2][(size_t)(k - DLORA) * RW + (n - 1024)]; }
        Wl_wa[i] = (bf16)f2bf(v); }
    for (int i = gt; i < 1024 * 256; i += NGT) { const int n = i >> 8, k = i & 255; Wl_g[i] = (bf16)f2bf(a.in[I_G2][(size_t)k * RW + n]); }
    float* Wr = (float*)(F.ws + WS_WR);
    for (int i = gt; i < 8 * 32 * 64 * 4; i += NGT) { const int ii = i & 3, l = (i >> 2) & 63, e = (i >> 8) & 31, j = i >> 13; const int k = 256 * j + 4 * l + ii;
        Wr[i] = a.in[I_NFG][k] * a.in[I_WROUTER][(size_t)k * NE + e]; }
}

__device__ __forceinline__ void cv_queue_run(const Frame& F, const Args& a, unsigned* stop) {
    unsigned* q = F.ctl + CW_CVQ; const int lane = F.lane;
    f32x4 ca[16], cb[16];
    int cur = __builtin_amdgcn_readfirstlane((int)cvq_issue(q, lane)); unsigned nraw = cvq_issue(q, lane); int pos = 0; bool stopped = false;
#define CVQ_NEXT(idx) do { if (pos == CVQ_CH) { cur = __builtin_amdgcn_readfirstlane((int)nraw); pos = 0; \
        if (stop && !stopped && __hip_atomic_load(stop, RLX_AGENT) != 0u) stopped = true; \
        nraw = stopped ? 0x7fffffffu : cvq_issue(q, lane); } \
        idx = cur < CVQ_NCH ? cur * CVQ_CH + pos++ : -1; } while (0)
    int xa, xb; CvItem ia, ib;
    CVQ_NEXT(xa); if (xa < 0) return;
    ia = cv_item(a, F.ws, xa); cvr_load(ia.W, ia.ldw, ia.k0, ia.n0, lane, ca);
    CVQ_NEXT(xb); ib = ia; if (xb >= 0) { ib = cv_item(a, F.ws, xb); cvr_load(ib.W, ib.ldw, ib.k0, ib.n0, lane, cb); }
    while (xa >= 0) {
        cvr_store(ca, ia.k0, ia.dst, ia.ldk, lane, WQ_SCALE);
        xa = -1; if (xb >= 0) { CVQ_NEXT(xa); if (xa >= 0) { ia = cv_item(a, F.ws, xa); cvr_load(ia.W, ia.ldw, ia.k0, ia.n0, lane, ca); } }
        if (xb >= 0) { cvr_store(cb, ib.k0, ib.dst, ib.ldk, lane, WQ_SCALE);
            xb = -1; if (xa >= 0) { CVQ_NEXT(xb); if (xb >= 0) { ib = cv_item(a, F.ws, xb); cvr_load(ib.W, ib.ldw, ib.k0, ib.n0, lane, cb); } } }
    }
#undef CVQ_NEXT
}
constexpr int CVW_SH = 3;
__device__ __forceinline__ void p1_gemm_in(const Frame& F, const Args& a) {
    const bool split = (F.G == 256);
    const int bx = (int)blockIdx.x, grp = bx >> 3;
    if (split && (grp & ((1 << CVW_SH) - 1)) == (1 << CVW_SH) - 1) {
        constexpr int NCW = (256 >> CVW_SH) * 8;
        const int cw = ((grp >> CVW_SH) * 8 + (bx & 7)) * 8 + F.wave; LAS float* t2 = (LAS float*)(F.lds + F.wave * 16384);
        for (int it = DT_IN + cw; it < DT_ALL; it += NCW) dense_tile(F, a, it, t2);
        cv_queue_run(F, a, F.ctl + CW_CVSTOP); return; }
    pg8::Gemm g{(const bf16*)(F.ws + WS_H), (const bf16*)(F.ws + WS_WIN), DP, DP, D, nullptr}; pg8::StaticOrder S;
    if (split) S.init(T, PLD, 256 - (256 >> CVW_SH), (grp - (grp >> CVW_SH)) * 8 + (bx & 7)); else S.init(T, PLD, F.G, bx);
    pg8::EpiBf16 E{(bf16*)(F.ws + WS_P), PLD, nullptr, 0, 1.f};
    pg8::gemm_phase(F.lds, g, S, E);
    if (F.tid == 0) __hip_atomic_fetch_add(F.ctl + CW_CVSTOP, 1u, RLX_AGENT);
}
__device__ __forceinline__ void p2_lora_in(const Frame& F, const Args& a) {
    const int gw = F.vcu * 8 + F.wave, NGW = F.G * 8, lane = F.lane;
    const bf16* P = (const bf16*)(F.ws + WS_P); bf16* A2 = (bf16*)(F.ws + WS_A2);
    const int kind = lane < 12 ? 0 : (lane < 24 ? 1 : (lane < 32 ? 2 : 3));
    const int src = lane < 24 ? (C_WL + 8 * lane) : (C_GL + 8 * (lane - 32));
    float mu[8];
    if (kind != 2) {
#pragma unroll
        for (int j = 0; j < 8; ++j) mu[j] = a.in[I_MU][src + j];
    }
    for (int t = gw; t < T; t += NGW) {
        v4u o = {0u, 0u, 0u, 0u};
        if (kind != 2) {
            const v4u c = *(const v4u*)(P + (size_t)t * PLD + src);
            v4u pv = {0u, 0u, 0u, 0u};
            if ((t & (SEQ - 1)) != 0) pv = *(const v4u*)(P + (size_t)(t - 1) * PLD + src);
            float x[8] = {bflo(c.x), bfhi(c.x), bflo(c.y), bfhi(c.y), bflo(c.z), bfhi(c.z), bflo(c.w), bfhi(c.w)};
            float q[8] = {bflo(pv.x), bfhi(pv.x), bflo(pv.y), bfhi(pv.y), bflo(pv.z), bfhi(pv.z), bflo(pv.w), bfhi(pv.w)};
#pragma unroll
            for (int j = 0; j < 8; ++j) { float m = x[j] + (q[j] - x[j]) * mu[j]; x[j] = kind == 0 ? tanhf(m) : (kind == 1 ? m : sigmoidf_(m)); }
            o.x = pk2(x[0], x[1]); o.y = pk2(x[2], x[3]); o.z = pk2(x[4], x[5]); o.w = pk2(x[6], x[7]);
        }
        *(v4u*)(A2 + (size_t)t * 512 + 8 * lane) = o;
    }
}

#define DPPF(x, ctrl) __builtin_bit_cast(float, __builtin_amdgcn_update_dpp(0, __builtin_bit_cast(int, (x)), (ctrl), 0xF, 0xF, false))
__device__ __forceinline__ float dpp_sum16(float x) { x += DPPF(x, 0xB1); x += DPPF(x, 0x4E); x += DPPF(x, 0x141); x += DPPF(x, 0x140); return x; }
__device__ __forceinline__ float wave_sum_dpp(float x) {
    x = dpp_sum16(x); const int xi = __builtin_bit_cast(int, x);
    return (__builtin_bit_cast(float, __builtin_amdgcn_readlane(xi, 0)) + __builtin_bit_cast(float, __builtin_amdgcn_readlane(xi, 16))) +
           (__builtin_bit_cast(float, __builtin_amdgcn_readlane(xi, 32)) + __builtin_bit_cast(float, __builtin_amdgcn_readlane(xi, 48)));
}
__device__ __forceinline__ float quad_sum(float x) { x += DPPF(x, 0xB1); x += DPPF(x, 0x4E); return x; }
__device__ __forceinline__ void unpack8(const v4u u, float (&f)[8]) { f[0] = bflo(u.x); f[1] = bfhi(u.x); f[2] = bflo(u.y); f[3] = bfhi(u.y); f[4] = bflo(u.z); f[5] = bfhi(u.z); f[6] = bflo(u.w); f[7] = bfhi(u.w); }
__device__ __forceinline__ v4u pack8(const float (&f)[8]) { v4u u; u.x = pk2(f[0], f[1]); u.y = pk2(f[2], f[3]); u.z = pk2(f[4], f[5]); u.w = pk2(f[6], f[7]); return u; }
__device__ __forceinline__ void p4_rwkv_prep(const Frame& F, const Args& a) {
    const int gw = F.vcu * 8 + F.wave, NGW = F.G * 8, lane = F.lane;
    const bf16* P = (const bf16*)(F.ws + WS_P); const bf16* WA = (const bf16*)(F.ws + WS_WAO); bf16* SC = (bf16*)(F.ws + WS_SCAN); float* BON = (float*)(F.ws + WS_BON);
    const int h = lane >> 2, q = lane & 3, c0 = h * RN + 16 * q;
    for (int t = gw; t < T; t += NGW) {
        const bool first = (t & (SEQ - 1)) == 0;
        const bf16* pr = P + (size_t)t * PLD + c0; const bf16* pp = first ? pr : pr - PLD;
        v4u ur[2], uk[2], uv[2], ur1[2], uk1[2], uv1[2], uw[2], ua[2];
#pragma unroll
        for (int j = 0; j < 2; ++j) { ur[j] = *(const v4u*)(pr + C_R + 8 * j); uk[j] = *(const v4u*)(pr + C_K + 8 * j); uv[j] = *(const v4u*)(pr + C_V + 8 * j);
            ur1[j] = *(const v4u*)(pp + C_R + 8 * j); uk1[j] = *(const v4u*)(pp + C_K + 8 * j); uv1[j] = *(const v4u*)(pp + C_V + 8 * j);
            uw[j] = __builtin_nontemporal_load((const v4u*)(WA + (size_t)t * 2048 + c0 + 8 * j)); ua[j] = __builtin_nontemporal_load((const v4u*)(WA + (size_t)t * 2048 + 1024 + c0 + 8 * j)); }
        float r[2][8], k[2][8], v[2][8], kk[2][8], dec[2][8], aa[2][8];
        float n2 = 0.f;
#pragma unroll
        for (int j = 0; j < 2; ++j) { float x[8], x1[8], wv[8], av[8];
            unpack8(ur[j], x); unpack8(ur1[j], x1);
#pragma unroll
            for (int i = 0; i < 8; ++i) { const float m = a.in[I_MU][C_R + c0 + 8 * j + i]; r[j][i] = x[i] + ((first ? 0.f : x1[i]) - x[i]) * m; }
            unpack8(uk[j], x); unpack8(uk1[j], x1);
#pragma unroll
            for (int i = 0; i < 8; ++i) { const float m = a.in[I_MU][C_K + c0 + 8 * j + i]; k[j][i] = x[i] + ((first ? 0.f : x1[i]) - x[i]) * m; }
            unpack8(uv[j], x); unpack8(uv1[j], x1);
#pragma unroll
            for (int i = 0; i < 8; ++i) { const float m = a.in[I_MU][C_V + c0 + 8 * j + i]; v[j][i] = x[i] + ((first ? 0.f : x1[i]) - x[i]) * m; }
            unpack8(uw[j], wv); unpack8(ua[j], av);
#pragma unroll
            for (int i = 0; i < 8; ++i) { const int c = c0 + 8 * j + i;
                dec[j][i] = __expf(-0.60653066f * sigmoidf_(a.in[I_W0][c] + wv[i]));
                aa[j][i] = sigmoidf_(a.in[I_A0][c] + av[i]);
                const float kq = k[j][i] * a.in[I_KK][c]; kk[j][i] = kq; n2 += kq * kq; } }
        n2 = quad_sum(n2);
        const float inv = rsqrtf(fmaxf(n2, 1e-24f));
        float bon = 0.f; float o0[2][8], o2[2][8], o3[2][8];
#pragma unroll
        for (int j = 0; j < 2; ++j)
#pragma unroll
            for (int i = 0; i < 8; ++i) { const int c = c0 + 8 * j + i; const float kn = kk[j][i] * inv; const float kf = k[j][i] * (1.f + (aa[j][i] - 1.f) * a.in[I_KA][c]);
                o0[j][i] = -kn; o2[j][i] = kn * aa[j][i]; o3[j][i] = kf; bon += r[j][i] * kf * a.in[I_RK][c]; }
        bon = quad_sum(bon);
        const int bh = (t >> 11) * RH + h, ts = t & (SEQ - 1);
        bf16* o = SC + ((size_t)(bh * SEQ + ts) * 6) * 64 + 16 * q;
#pragma unroll
        for (int j = 0; j < 2; ++j) { *(v4u*)(o + 8 * j) = pack8(o0[j]); *(v4u*)(o + 64 + 8 * j) = pack8(dec[j]); *(v4u*)(o + 128 + 8 * j) = pack8(o2[j]);
            *(v4u*)(o + 192 + 8 * j) = pack8(o3[j]); *(v4u*)(o + 256 + 8 * j) = pack8(r[j]); *(v4u*)(o + 320 + 8 * j) = pack8(v[j]); }
        if (q == 0) BON[(size_t)t * RH + h] = bon;
    }
}
__device__ __forceinline__ void p5_rwkv_scan(const Frame& F, const Args& a) {
    constexpr int TB = 16, NBLK = SEQ / TB, STF = 384, BLKF = TB * STF;
    const bf16* SC = (const bf16*)(F.ws + WS_SCAN); float* YR = (float*)(F.ws + WS_YRAW);
    LAS float* buf = (LAS float*)F.lds;
    volatile LAS int* hs = (volatile LAS int*)(F.lds + MOE_OFF + 2048);
    const int lane = F.lane;
    for (int u = F.vcu; u < 256; u += F.G) {
        const int bh = u >> 2, vg = u & 3, b = bh >> 4, h = bh & 15;
        const int role = F.wave < 4 ? 0 : (F.wave == 4 ? 1 : 2);
        const int cw = F.wave - 5;
        const bf16* src = SC + (size_t)bh * SEQ * STF;
        const int rl = lane >> 4, kq = lane & 15, row = 16 * vg + 4 * F.wave + rl;
        __syncthreads();
        if (F.tid < 8) hs[F.tid] = 0;
        __syncthreads();
#define HS_WAIT(cond) do { unsigned sp_ = 0; while (!(cond)) { __builtin_amdgcn_s_sleep(1); if (++sp_ > (1u << 24)) break; } asm volatile("" ::: "memory"); } while (0)
        if (role == 1) {
            v4u xb[12];
            { const v4u* s4 = (const v4u*)src;
#pragma unroll
              for (int i = 0; i < 12; ++i) xb[i] = s4[lane + 64 * i]; }
            for (int m = 0; m < NBLK; ++m) {
                if (m >= 4) HS_WAIT(hs[1] >= m - 3 && hs[2] >= m - 3 && hs[3] >= m - 3 && hs[4] >= m - 3);
                LAS f32x4* d4 = (LAS f32x4*)(buf + (m & 3) * BLKF);
#pragma unroll
                for (int i = 0; i < 12; ++i) { const int c = lane + 64 * i;
                    d4[2 * c] = (f32x4){bflo(xb[i].x), bfhi(xb[i].x), bflo(xb[i].y), bfhi(xb[i].y)}; d4[2 * c + 1] = (f32x4){bflo(xb[i].z), bfhi(xb[i].z), bflo(xb[i].w), bfhi(xb[i].w)}; }
                asm volatile("s_waitcnt lgkmcnt(0)" ::: "memory");
                if (lane == 0) hs[0] = m + 1;
                if (m + 1 < NBLK) { const v4u* s4 = (const v4u*)(src + (size_t)(m + 1) * BLKF);
#pragma unroll
                    for (int i = 0; i < 12; ++i) xb[i] = s4[lane + 64 * i]; }
            }
        } else if (role == 2) {
            cv_queue_run(F, a, nullptr);
        } else {
            float S0 = 0.f, S1 = 0.f, S2 = 0.f, S3 = 0.f;
            for (int n = 0; n < NBLK; ++n) {
                HS_WAIT(hs[0] >= n + 1);
                const LAS float* bb = buf + (n & 3) * BLKF;
                float* yo = YR + ((size_t)(b * SEQ + n * TB)) * RW + h * RN + row;
                f32x4 al = *(const LAS f32x4*)(bb + 4 * kq), w = *(const LAS f32x4*)(bb + 64 + 4 * kq), be = *(const LAS f32x4*)(bb + 128 + 4 * kq);
                f32x4 kf = *(const LAS f32x4*)(bb + 192 + 4 * kq), r = *(const LAS f32x4*)(bb + 256 + 4 * kq); float vv = bb[320 + row];
                float ykeep = 0.f, yp = 0.f;
#pragma unroll
                for (int j = 0; j < TB; ++j) {
                    f32x4 al_n = al, w_n = w, be_n = be, kf_n = kf, r_n = r; float vv_n = vv;
                    if (j + 1 < TB) { const LAS float* st = bb + (j + 1) * STF;
                        al_n = *(const LAS f32x4*)(st + 4 * kq); w_n = *(const LAS f32x4*)(st + 64 + 4 * kq); be_n = *(const LAS f32x4*)(st + 128 + 4 * kq);
                        kf_n = *(const LAS f32x4*)(st + 192 + 4 * kq); r_n = *(const LAS f32x4*)(st + 256 + 4 * kq); vv_n = st[320 + row]; }
                    float sa = (S0 * al.x + S1 * al.y) + (S2 * al.z + S3 * al.w);
                    float yq = yp;
                    sa += DPPF(sa, 0xB1); if (j > 0) yq += DPPF(yq, 0xB1);
                    sa += DPPF(sa, 0x4E); if (j > 0) yq += DPPF(yq, 0x4E);
                    sa += DPPF(sa, 0x141); if (j > 0) yq += DPPF(yq, 0x141);
                    sa += DPPF(sa, 0x140); if (j > 0) yq += DPPF(yq, 0x140);
                    if (j > 0) ykeep = __builtin_bit_cast(float, __builtin_amdgcn_update_dpp(__builtin_bit_cast(int, yq), __builtin_bit_cast(int, ykeep), 0x111, 0xF, 0xF, false));
                    S0 = S0 * w.x + (sa * be.x + vv * kf.x); S1 = S1 * w.y + (sa * be.y + vv * kf.y);
                    S2 = S2 * w.z + (sa * be.z + vv * kf.z); S3 = S3 * w.w + (sa * be.w + vv * kf.w);
                    yp = (S0 * r.x + S1 * r.y) + (S2 * r.z + S3 * r.w);
                    al = al_n; w = w_n; be = be_n; kf = kf_n; r = r_n; vv = vv_n;
                }
                const float yl = dpp_sum16(yp);
                ykeep = __builtin_bit_cast(float, __builtin_amdgcn_update_dpp(__builtin_bit_cast(int, yl), __builtin_bit_cast(int, ykeep), 0x111, 0xF, 0xF, false));
                yo[(size_t)(TB - 1 - kq) * RW] = ykeep;
                asm volatile("s_waitcnt lgkmcnt(0)" ::: "memory");
                if (lane == 0) hs[1 + F.wave] = n + 1;
            }
            __builtin_amdgcn_s_setprio(0);
        }
#undef HS_WAIT
        __syncthreads();
    }
    if (F.G != 256) { LAS float* scr = (LAS float*)(F.lds + F.wave * 16896); __syncthreads();
        for (int it = F.vcu * 8 + F.wave; it < CV_ITEMS; it += F.G * 8) { const CvItem c2 = cv_item(a, F.ws, it); f32x4 c3[16]; cv_load(c2.W, c2.ldw, c2.k0, c2.n0, lane, c3); cv_finish(c3, c2.k0, c2.dst, c2.ldk, scr, lane, WQ_SCALE); } }
}

__device__ __forceinline__ void p6_rwkv_post(const Frame& F, const Args& a) {
    const int gw = F.vcu * 8 + F.wave, NGW = F.G * 8, lane = F.lane;
    const bf16* SC = (const bf16*)(F.ws + WS_SCAN); const float* YR = (const float*)(F.ws + WS_YRAW); const float* BON = (const float*)(F.ws + WS_BON);
    const bf16* GO = (const bf16*)(F.ws + WS_GO); bf16* YA = (bf16*)(F.ws + WS_YA);
    const int h = lane >> 2, q = lane & 3, c0 = h * RN + 16 * q;
    f32x4 lg[4], lb[4];
#pragma unroll
    for (int j = 0; j < 4; ++j) { lg[j] = *(const f32x4*)(a.in[I_LNG] + c0 + 4 * j); lb[j] = *(const f32x4*)(a.in[I_LNB] + c0 + 4 * j); }
    for (int t = gw; t < T; t += NGW) {
        const int bh = (t >> 11) * RH + h, ts = t & (SEQ - 1);
        f32x4 y[4]; v4u uv[2], ug[2];
#pragma unroll
        for (int j = 0; j < 4; ++j) y[j] = __builtin_nontemporal_load((const f32x4*)(YR + (size_t)t * RW + c0 + 4 * j));
#pragma unroll
        for (int j = 0; j < 2; ++j) { uv[j] = *(const v4u*)(SC + ((size_t)(bh * SEQ + ts) * 6 + 5) * 64 + 16 * q + 8 * j); ug[j] = *(const v4u*)(GO + (size_t)t * RW + c0 + 8 * j); }
        const float bo = BON[(size_t)t * RH + h];
        float s = 0.f;
#pragma unroll
        for (int j = 0; j < 4; ++j) s += (y[j].x + y[j].y) + (y[j].z + y[j].w);
        const float mean = quad_sum(s) * (1.f / RN);
        float s2 = 0.f;
#pragma unroll
        for (int j = 0; j < 4; ++j) { y[j] = y[j] - mean; s2 += (y[j].x * y[j].x + y[j].y * y[j].y) + (y[j].z * y[j].z + y[j].w * y[j].w); }
        const float rstd = rsqrtf(quad_sum(s2) * (1.f / RN) + GN_EPS);
        float vv[2][8], gg[2][8], o[2][8];
        unpack8(uv[0], vv[0]); unpack8(uv[1], vv[1]); unpack8(ug[0], gg[0]); unpack8(ug[1], gg[1]);
#pragma unroll
        for (int j = 0; j < 4; ++j)
#pragma unroll
            for (int i = 0; i < 4; ++i) o[j >> 1][4 * (j & 1) + i] = (y[j][i] * rstd * lg[j][i] + lb[j][i] + bo * vv[j >> 1][4 * (j & 1) + i]) * gg[j >> 1][4 * (j & 1) + i];
        *(v4u*)(YA + (size_t)t * RW + c0) = pack8(o[0]); *(v4u*)(YA + (size_t)t * RW + c0 + 8) = pack8(o[1]);
    }
}

constexpr int G_BC = 0;
constexpr int G_ALF = 32768;
constexpr int G_RED = 36864;
constexpr int G_TOT = 38912;
constexpr int G_QT = 40960;
constexpr int G_KT = 58368;
constexpr int G_VT = 76800;
constexpr int G_AT = 113664;
__device__ __forceinline__ void gla_bcum(const Frame& F, const Args& a, const bf16* P, int t0, int h) {
    LAS float* bc = (LAS float*)(F.lds + G_BC); LAS float* alf = (LAS float*)(F.lds + G_ALF); LAS float* tot = (LAS float*)(F.lds + G_TOT);
    const int tid = F.tid;
    __syncthreads();
    { const int j = tid >> 3, i2 = (tid & 7) * 2; const unsigned u = *(const unsigned*)(P + (size_t)(t0 + j) * PLD + C_GAL + i2); alf[j * 16 + i2] = bflo(u); alf[j * 16 + i2 + 1] = bfhi(u); }
    const int d = tid & 127, jq = tid >> 7, hd = h * GDK + d;
    float wv[16];
#pragma unroll
    for (int i = 0; i < 16; ++i) wv[i] = a.in[I_GWA2][(size_t)i * GKW + hd];
    const float bb = a.in[I_GBA][hd];
    __syncthreads();
    float run = 0.f;
    for (int jj = 0; jj < 16; ++jj) { const int j = jq * 16 + jj; float x = bb;
#pragma unroll
        for (int i = 0; i < 16; ++i) x += alf[j * 16 + i] * wv[i];
        run += -softplusf_(-x) * (1.f / 16.f); bc[j * 128 + d] = run; }
    tot[jq * 128 + d] = run;
    __syncthreads();
    float pre = 0.f;
    for (int q = 0; q < jq; ++q) pre += tot[q * 128 + d];
    if (jq > 0) { for (int jj = 0; jj < 16; ++jj) bc[(jq * 16 + jj) * 128 + d] += pre; }
    __syncthreads();
}
constexpr int G_VP = 264, G_KP = 136;
__device__ __forceinline__ void gla_stage_v(const Frame& F, const bf16* P, int t0, int h) {
    LAS bf16* VR = (LAS bf16*)(F.lds + G_VT);
    const int j = F.tid >> 3, e0 = (F.tid & 7) * 32;
    const bf16* src = P + (size_t)(t0 + j) * PLD + C_GV + h * GDV + e0;
#pragma unroll
    for (int q = 0; q < 4; ++q) *(LAS v4u*)(VR + j * G_VP + e0 + 8 * q) = *(const v4u*)(src + 8 * q);
}
typedef short s16x4g __attribute__((ext_vector_type(4)));
__device__ __forceinline__ bf16x8 tr_frag(const LAS bf16* img, int pitch, int row0, int col0, int lane) {
    const LAS bf16* p = img + (row0 + 8 * (lane >> 4) + ((lane & 15) >> 2)) * pitch + col0 + 4 * (lane & 3);
    const s16x4g lo = __builtin_amdgcn_ds_read_tr16_b64_v4i16((LAS s16x4g*)p);
    const s16x4g hi = __builtin_amdgcn_ds_read_tr16_b64_v4i16((LAS s16x4g*)(p + 4 * pitch));
    return __builtin_shufflevector(lo, hi, 0, 1, 2, 3, 4, 5, 6, 7);
}
#define MMA16(a_, b_, c_) __builtin_amdgcn_mfma_f32_16x16x32_bf16(a_, b_, c_, 0, 0, 0)
__device__ __forceinline__ void gla_pass_a(const Frame& F, const Args& a) {
    const bf16* P = (const bf16*)(F.ws + WS_P); bf16* HT = (bf16*)(F.ws + WS_GHT); float* DEC = (float*)(F.ws + WS_GDEC);
    LAS float* bc = (LAS float*)(F.lds + G_BC); LAS bf16* KH = (LAS bf16*)(F.lds + G_KT); LAS bf16* VR = (LAS bf16*)(F.lds + G_VT);
    const int fr = F.lane & 15, fq = F.lane >> 4;
    for (int it = F.vcu; it < BATCH * GH * NCH; it += F.G) {
        const int c = it & 31, h = (it >> 5) & 3, b = it >> 7, t0 = b * SEQ + c * CHUNK;
        gla_bcum(F, a, P, t0, h);
        if (F.tid < 128) DEC[(size_t)it * 128 + F.tid] = __expf(bc[63 * 128 + F.tid]);
        { f32x4* gbc = (f32x4*)(F.ws + WS_GBC) + (size_t)it * 2048;
#pragma unroll
          for (int i = 0; i < 4; ++i) gbc[F.tid + 512 * i] = ((const LAS f32x4*)bc)[F.tid + 512 * i]; }
        { const int j = F.tid >> 3, d0 = (F.tid & 7) * 16; const bf16* src = P + (size_t)(t0 + j) * PLD + C_GK + h * GDK + d0;
#pragma unroll
          for (int q = 0; q < 2; ++q) { const v4u u = *(const v4u*)(src + 8 * q); float kv[8]; unpack8(u, kv);
#pragma unroll
            for (int i = 0; i < 8; ++i) { const int d = d0 + 8 * q + i; kv[i] *= __expf(bc[63 * 128 + d] - bc[j * 128 + d]); }
            *(LAS v4u*)(KH + j * G_KP + d0 + 8 * q) = pack8(kv); } }
        gla_stage_v(F, P, t0, h);
        __syncthreads();
        f32x4 acc[8][2];
#pragma unroll
        for (int m = 0; m < 8; ++m)
#pragma unroll
            for (int n = 0; n < 2; ++n) acc[m][n] = (f32x4){0.f, 0.f, 0.f, 0.f};
#pragma unroll
        for (int ks = 0; ks < 2; ++ks) {
            bf16x8 vf[2];
#pragma unroll
            for (int n = 0; n < 2; ++n) vf[n] = tr_frag(VR, G_VP, ks * 32, F.wave * 32 + n * 16, F.lane);
#pragma unroll
            for (int m = 0; m < 8; ++m) { const bf16x8 kf = tr_frag(KH, G_KP, ks * 32, m * 16, F.lane);
#pragma unroll
                for (int n = 0; n < 2; ++n) acc[m][n] = MMA16(kf, vf[n], acc[m][n]); }
        }
        bf16* o = HT + (size_t)it * (GDV * GDK);
#pragma unroll
        for (int m = 0; m < 8; ++m)
#pragma unroll
            for (int n = 0; n < 2; ++n) { v2u pk; pk.x = pk2(acc[m][n][0], acc[m][n][1]); pk.y = pk2(acc[m][n][2], acc[m][n][3]); *(v2u*)(o + (size_t)(F.wave * 32 + n * 16 + fr) * GDK + m * 16 + 4 * fq) = pk; }
    }
}
__device__ __forceinline__ void gla_pass_b(const Frame& F, int lo, int hi, int wg, int nwg) {
    const bf16* HT = (const bf16*)(F.ws + WS_GHT); const float* DEC = (const float*)(F.ws + WS_GDEC); bf16* ST = (bf16*)(F.ws + WS_GST);
    const int gt = wg * 512 + F.tid, NGT = nwg * 512;
    for (int i = (lo >> 1) + gt; i < (hi >> 1); i += NGT) {
        const int bh = i >> 14, ed = (i & 16383) * 2, d = ed & 127;
        float s0 = 0.f, s1 = 0.f;
#pragma unroll 8
        for (int c = 0; c < NCH; ++c) { const size_t it = (size_t)bh * NCH + c;
            const unsigned hv = __builtin_nontemporal_load((const unsigned*)(HT + it * (GDV * GDK) + ed)); const float d0 = DEC[it * 128 + d], d1 = DEC[it * 128 + d + 1];
            *(unsigned*)(ST + it * (GDV * GDK) + ed) = pk2(s0, s1);
            s0 = s0 * d0 + bflo(hv); s1 = s1 * d1 + bfhi(hv); }
    }
}
__device__ __forceinline__ void gla_pass_c(const Frame& F, const Args& a) {
    const bf16* P = (const bf16*)(F.ws + WS_P); const bf16* ST = (const bf16*)(F.ws + WS_GST); bf16* YB = (bf16*)(F.ws + WS_YB);
    LAS float* bc = (LAS float*)(F.lds + G_BC); LAS float* red = (LAS float*)(F.lds + G_RED);
    LAS bf16* QT = (LAS bf16*)(F.lds + G_QT); LAS bf16* KT = (LAS bf16*)(F.lds + G_KT); LAS bf16* VR = (LAS bf16*)(F.lds + G_VT); LAS bf16* AT = (LAS bf16*)(F.lds + G_AT);
    const int fr = F.lane & 15, fq = F.lane >> 4, w = F.wave;
    const float scale = 0.08838834764831845f;
    for (int it = F.vcu; it < BATCH * GH * NCH; it += F.G) {
        const int c = it & 31, h = (it >> 5) & 3, b = it >> 7, t0 = b * SEQ + c * CHUNK;
        __syncthreads();
        { const f32x4* gbc = (const f32x4*)(F.ws + WS_GBC) + (size_t)it * 2048;
#pragma unroll
          for (int i = 0; i < 4; ++i) ((LAS f32x4*)bc)[F.tid + 512 * i] = gbc[F.tid + 512 * i]; }
        const bf16* Sg = ST + (size_t)it * (GDV * GDK);
        bf16x8 sfr[4][2];
#pragma unroll
        for (int ks = 0; ks < 4; ++ks)
#pragma unroll
            for (int n = 0; n < 2; ++n) sfr[ks][n] = *(const bf16x8*)(Sg + (size_t)(w * 32 + n * 16 + fr) * GDK + ks * 32 + fq * 8);
        f32x4 gng[2];
#pragma unroll
        for (int n = 0; n < 2; ++n) gng[n] = *(const f32x4*)(a.in[I_GNG] + w * 32 + n * 16 + 4 * fq);
        v2u ogu[4][2];
#pragma unroll
        for (int m = 0; m < 4; ++m)
#pragma unroll
            for (int n = 0; n < 2; ++n) ogu[m][n] = __builtin_nontemporal_load((const v2u*)(P + (size_t)(t0 + m * 16 + fr) * PLD + C_OG + h * GDV + w * 32 + n * 16 + 4 * fq));
        __syncthreads();
        { const int j = F.tid >> 3, d0 = (F.tid & 7) * 16;
          const bf16* sq = P + (size_t)(t0 + j) * PLD + C_GQ + h * GDK + d0; const bf16* sk = P + (size_t)(t0 + j) * PLD + C_GK + h * GDK + d0;
#pragma unroll
          for (int q = 0; q < 2; ++q) { const v4u uq = *(const v4u*)(sq + 8 * q), uk = *(const v4u*)(sk + 8 * q); float fq8[8], fk8[8]; unpack8(uq, fq8); unpack8(uk, fk8);
#pragma unroll
            for (int i = 0; i < 8; ++i) { const float bv = bc[j * 128 + d0 + 8 * q + i]; fq8[i] *= scale * __expf(bv); fk8[i] *= __expf(-bv); }
            *(LAS v4u*)(QT + j * 136 + d0 + 8 * q) = pack8(fq8); *(LAS v4u*)(KT + j * 136 + d0 + 8 * q) = pack8(fk8); } }
        gla_stage_v(F, P, t0, h);
        __syncthreads();
        { const int mt = w >> 1;
#pragma unroll
          for (int q = 0; q < 2; ++q) { const int nt = (w & 1) * 2 + q; f32x4 sacc = {0.f, 0.f, 0.f, 0.f};
            if (nt <= mt) {
#pragma unroll
                for (int ks = 0; ks < 4; ++ks) { const bf16x8 kfr = *(const LAS bf16x8*)(KT + (nt * 16 + fr) * 136 + ks * 32 + fq * 8); const bf16x8 qfr = *(const LAS bf16x8*)(QT + (mt * 16 + fr) * 136 + ks * 32 + fq * 8);
                    sacc = MMA16(kfr, qfr, sacc); } }
            const int i = mt * 16 + fr, j0 = nt * 16 + 4 * fq; float v4[4];
#pragma unroll
            for (int jj = 0; jj < 4; ++jj) v4[jj] = (j0 + jj <= i) ? sacc[jj] : 0.f;
            v2u pk; pk.x = pk2(v4[0], v4[1]); pk.y = pk2(v4[2], v4[3]); *(LAS v2u*)(AT + i * 72 + j0) = pk; } }
        __syncthreads();
        f32x4 acc[2][4];
#pragma unroll
        for (int n = 0; n < 2; ++n)
#pragma unroll
            for (int m = 0; m < 4; ++m) acc[n][m] = (f32x4){0.f, 0.f, 0.f, 0.f};
#pragma unroll
        for (int ks = 0; ks < 2; ++ks) {
            bf16x8 vf[2];
#pragma unroll
            for (int n = 0; n < 2; ++n) vf[n] = tr_frag(VR, G_VP, ks * 32, w * 32 + n * 16, F.lane);
#pragma unroll
            for (int m = 0; m < 4; ++m) { const bf16x8 af = *(const LAS bf16x8*)(AT + (m * 16 + fr) * 72 + ks * 32 + fq * 8);
#pragma unroll
                for (int n = 0; n < 2; ++n) acc[n][m] = MMA16(vf[n], af, acc[n][m]); }
        }
#pragma unroll
        for (int ks = 0; ks < 4; ++ks) {
#pragma unroll
            for (int m = 0; m < 4; ++m) { const bf16x8 qf = *(const LAS bf16x8*)(QT + (m * 16 + fr) * 136 + ks * 32 + fq * 8);
#pragma unroll
                for (int n = 0; n < 2; ++n) acc[n][m] = MMA16(sfr[ks][n], qf, acc[n][m]); }
        }
        float ssq[4];
#pragma unroll
        for (int m = 0; m < 4; ++m) { float ss = 0.f;
#pragma unroll
            for (int n = 0; n < 2; ++n) ss += (acc[n][m][0] * acc[n][m][0] + acc[n][m][1] * acc[n][m][1]) + (acc[n][m][2] * acc[n][m][2] + acc[n][m][3] * acc[n][m][3]);
            ss += __shfl_xor(ss, 16); ss += __shfl_xor(ss, 32); ssq[m] = ss;
            if (fq == 0) red[(m * 16 + fr) * 8 + w] = ss; }
        __syncthreads();
#pragma unroll
        for (int m = 0; m < 4; ++m) { const int i = m * 16 + fr; float tot = 0.f;
#pragma unroll
            for (int q = 0; q < 8; ++q) tot += red[i * 8 + q];
            const float rstd = rsqrtf(tot * (1.f / GDV) + NORM_EPS);
#pragma unroll
            for (int n = 0; n < 2; ++n) { const int e = w * 32 + n * 16 + 4 * fq;
                const float og[4] = {bflo(ogu[m][n].x), bfhi(ogu[m][n].x), bflo(ogu[m][n].y), bfhi(ogu[m][n].y)}; float r4[4];
#pragma unroll
                for (int jj = 0; jj < 4; ++jj) r4[jj] = acc[n][m][jj] * rstd * gng[n][jj] * (og[jj] * sigmoidf_(og[jj]));
                v2u pk; pk.x = pk2(r4[0], r4[1]); pk.y = pk2(r4[2], r4[3]); *(v2u*)(YB + (size_t)(t0 + i) * GVW + h * GDV + e) = pk; } }
    }
}

__device__ __forceinline__ void p11_router(const Frame& F, const Args& a) {
    const int lane = F.lane, w = F.wave;
    const float* X1 = (const float*)(F.ws + WS_X1); unsigned char* H2 = (unsigned char*)(F.ws + WS_H2); const float* Wr = (const float*)(F.ws + WS_WR);
    int* SEL_E = (int*)(F.ws + WS_ROUTE); float* SEL_W = (float*)(F.ws + WS_ROUTE + 256 * 1024); int* SEL_R = (int*)(F.ws + WS_ROUTE + 512 * 1024);
    volatile LAS int* hist = (volatile LAS int*)(F.lds + MOE_OFF + 1024); volatile LAS int* base = (volatile LAS int*)(F.lds + MOE_OFF + 1280);
    int* LIST = (int*)(F.ws + WS_ROUTE + 1024 * 1024);
    constexpr int RP = 36;
    LAS float* XL = (LAS float*)(F.lds + w * (2 * 32 * RP * 4)); LAS float* TL = XL + 32 * RP;
    LAS float* part = (LAS float*)(F.lds + 8 * (2 * 32 * RP * 4));
    LAS float* ssq = part + 8 * 1024;
    __syncthreads();
    if (F.tid < 32) hist[F.tid] = 0;
    __syncthreads();
    const int r = lane & 15, kq = lane >> 4, row8 = lane >> 3, seg = lane & 7;
    const int grp = lane >> 4, el = lane & 15;
    const float br0 = a.in[I_BROUTER][el], br1 = a.in[I_BROUTER][16 + el];
    for (int tile = F.vcu; tile < T / 32; tile += F.G) {
        const int tb = tile * 32;
        {
            const float* xg = X1 + (size_t)(tb + row8) * D + 256 * w + 4 * seg;
            const float* tg = Wr + (size_t)w * 8192 + row8 * 256 + 4 * seg;
            f32x4 acc[2][2]; float ssl[4] = {0.f, 0.f, 0.f, 0.f};
#pragma unroll
            for (int m = 0; m < 2; ++m)
#pragma unroll
                for (int n = 0; n < 2; ++n) acc[m][n] = (f32x4){0.f, 0.f, 0.f, 0.f};
            f32x4 gx[4], gt[4];
#pragma unroll
            for (int q = 0; q < 4; ++q) { gx[q] = *(const f32x4*)(xg + (size_t)(8 * q) * D); gt[q] = *(const f32x4*)(tg + (8 * q) * 256); }
#pragma unroll 1
            for (int c = 0; c < 8; ++c) {
#pragma unroll
                for (int q = 0; q < 4; ++q) { *(LAS f32x4*)(XL + (8 * q + row8) * RP + 4 * seg) = gx[q]; *(LAS f32x4*)(TL + (8 * q + row8) * RP + 4 * seg) = gt[q];
                    ssl[q] += (gx[q].x * gx[q].x + gx[q].y * gx[q].y) + (gx[q].z * gx[q].z + gx[q].w * gx[q].w); }
                if (c < 7) {
#pragma unroll
                    for (int q = 0; q < 4; ++q) { gx[q] = *(const f32x4*)(xg + (size_t)(8 * q) * D + 32 * (c + 1)); gt[q] = *(const f32x4*)(tg + (8 * q) * 256 + 32 * (c + 1)); } }
                f32x4 xa[2], xb[2], ba[2], bb[2];
#pragma unroll
                for (int m = 0; m < 2; ++m) { xa[m] = *(const LAS f32x4*)(XL + (16 * m + r) * RP + 8 * kq); xb[m] = *(const LAS f32x4*)(XL + (16 * m + r) * RP + 8 * kq + 4);
                    ba[m] = *(const LAS f32x4*)(TL + (16 * m + r) * RP + 8 * kq); bb[m] = *(const LAS f32x4*)(TL + (16 * m + r) * RP + 8 * kq + 4); }
#pragma unroll
                for (int i = 0; i < 4; ++i)
#pragma unroll
                    for (int m = 0; m < 2; ++m)
#pragma unroll
                        for (int n = 0; n < 2; ++n) acc[m][n] = __builtin_amdgcn_mfma_f32_16x16x4f32(xa[m][i], ba[n][i], acc[m][n], 0, 0, 0);
#pragma unroll
                for (int i = 0; i < 4; ++i)
#pragma unroll
                    for (int m = 0; m < 2; ++m)
#pragma unroll
                        for (int n = 0; n < 2; ++n) acc[m][n] = __builtin_amdgcn_mfma_f32_16x16x4f32(xb[m][i], bb[n][i], acc[m][n], 0, 0, 0);
            }
#pragma unroll
            for (int m = 0; m < 2; ++m)
#pragma unroll
                for (int j = 0; j < 4; ++j) { LAS float* pr = part + ((w * 32 + 16 * m + 4 * kq + j) * 32); pr[r] = acc[m][0][j]; pr[16 + r] = acc[m][1][j]; }
#pragma unroll
            for (int q = 0; q < 4; ++q) { float v = ssl[q]; v += __shfl_xor(v, 1); v += __shfl_xor(v, 2); v += __shfl_xor(v, 4); if (seg == 0) ssq[w * 32 + 8 * q + row8] = v; }
        }
        __syncthreads();
        {
            const int tk = 4 * w + grp;
            float sq = 0.f, p0 = 0.f, p1 = 0.f; const LAS float* pr = part + tk * 32;
#pragma unroll
            for (int k8 = 0; k8 < 8; ++k8) { sq += ssq[32 * k8 + tk]; p0 += pr[1024 * k8 + el]; p1 += pr[1024 * k8 + 16 + el]; }
            const float rstd = rsqrtf(sq * (1.f / D) + NORM_EPS);
            float c0 = p0 * rstd + br0, c1 = p1 * rstd + br1;
            float tv[4]; int ti[4];
#pragma unroll
            for (int k = 0; k < 4; ++k) { float bv = c0; int bi = el; if (c1 > c0) { bv = c1; bi = 16 + el; }
#pragma unroll
                for (int o = 1; o < 16; o <<= 1) { const float ov = __shfl_xor(bv, o); const int oi = __shfl_xor(bi, o); if (ov > bv || (ov == bv && oi < bi)) { bv = ov; bi = oi; } }
                tv[k] = bv; ti[k] = bi; if (bi == el) c0 = -3.0e38f; if (bi == 16 + el) c1 = -3.0e38f; }
            const float e1 = __expf(tv[1] - tv[0]), e2 = __expf(tv[2] - tv[0]), e3 = __expf(tv[3] - tv[0]); const float inv = 1.f / (1.f + e1 + e2 + e3);
            if (el < 4) { const int k = el; const float wk = (k == 0 ? 1.f : (k == 1 ? e1 : (k == 2 ? e2 : e3))) * inv; const int ek = (k == 0 ? ti[0] : (k == 1 ? ti[1] : (k == 2 ? ti[2] : ti[3])));
                const int lr = __hip_atomic_fetch_add((LAS int*)&hist[ek], 1, __ATOMIC_RELAXED, __HIP_MEMORY_SCOPE_WORKGROUP);
                SEL_E[(tb + tk) * 4 + k] = ek; SEL_W[(tb + tk) * 4 + k] = wk; SEL_R[(tb + tk) * 4 + k] = lr; }
        }
#pragma unroll
        for (int rr = 0; rr < 4; ++rr) { const int tk = 4 * w + rr;
            float sq = 0.f;
#pragma unroll
            for (int k8 = 0; k8 < 8; ++k8) sq += ssq[32 * k8 + tk];
            const float rstd = rsqrtf(sq * (1.f / D) + NORM_EPS);
            const f32x4* xr = (const f32x4*)(X1 + (size_t)(tb + tk) * D) + lane; unsigned* hr = (unsigned*)(H2 + (size_t)(tb + tk) * D) + lane;
#pragma unroll
            for (int j = 0; j < 8; ++j) { const f32x4 xv = __builtin_nontemporal_load(xr + 64 * j); const f32x4 gg = ((const f32x4*)a.in[I_NFG])[64 * j + lane];
                hr[64 * j] = pk4_fp8(xv.x * rstd * gg.x, xv.y * rstd * gg.y, xv.z * rstd * gg.z, xv.w * rstd * gg.w); } }
        __syncthreads();
    }
    if (F.tid < 32) base[F.tid] = (int)__hip_atomic_fetch_add(F.ctl + CW_CNT + F.tid, (unsigned)hist[F.tid], RLX_AGENT);
    __syncthreads();
    for (int tile = F.vcu; tile < T / 32; tile += F.G) {
        if (F.tid < 128) { const int tk = tile * 32 + (F.tid >> 2); const int idx = tk * 4 + (F.tid & 3);
            const int e_ = __hip_atomic_load(SEL_E + idx, RLX_AGENT); const int rk_ = __hip_atomic_load(SEL_R + idx, RLX_AGENT) + base[e_]; SEL_R[idx] = rk_; LIST[e_ * 8192 + rk_] = tk; }
    }
}
__device__ __forceinline__ void moe_tables(const Frame& F, int nct) {
    volatile LAS int* tab = (volatile LAS int*)(F.lds + MOE_OFF);
    __syncthreads();
    if (F.tid == 0) { int run = 0, units = 0;
        for (int e = 0; e < NE; ++e) { const int cnt = (int)__hip_atomic_load(F.ctl + CW_CNT + e, RLX_AGENT); const int nt = (cnt + 255) >> 8;
            tab[e] = units; tab[36 + e] = run * 256; tab[72 + e] = nt > 0 ? nt : 1; tab[108 + e] = cnt; run += nt; units += nt * nct; }
        tab[32] = units; }
    __syncthreads();
}
__device__ __forceinline__ void p12_scatter(const Frame& F) {
    const int gw = F.vcu * 8 + F.wave, NGW = F.G * 8, lane = F.lane;
    const unsigned char* H2 = (const unsigned char*)(F.ws + WS_H2); unsigned char* XS = (unsigned char*)(F.ws + WS_XS);
    const int* SEL_E = (const int*)(F.ws + WS_ROUTE); const int* SEL_R = (const int*)(F.ws + WS_ROUTE + 512 * 1024); int* DEST = (int*)(F.ws + WS_ROUTE + 768 * 1024);
    moe_tables(F, 1);
    volatile LAS int* tab = (volatile LAS int*)(F.lds + MOE_OFF);
    for (int it = gw; it < T * TOPK; it += NGW) {
        const int t = it >> 2; const int e = SEL_E[it], dest = tab[36 + e] + SEL_R[it];
        const v4u* s = (const v4u*)(H2 + (size_t)t * D) + lane; v4u* d = (v4u*)(XS + (size_t)dest * D) + lane;
        d[0] = s[0]; d[64] = s[64];
        if (lane == 0) DEST[it] = dest;
    }
}
__device__ __forceinline__ void p15_combine(const Frame& F, const Args& a) {
    const int gw = F.vcu * 8 + F.wave, NGW = F.G * 8, lane = F.lane;
    const float* X1 = (const float*)(F.ws + WS_X1); const bf16* Y = (const bf16*)(F.ws + WS_Y);
    const float* SEL_W = (const float*)(F.ws + WS_ROUTE + 256 * 1024); const int* SEL_E = (const int*)(F.ws + WS_ROUTE); const int* SEL_R = (const int*)(F.ws + WS_ROUTE + 512 * 1024);
    moe_tables(F, 1);
    volatile LAS int* tab = (volatile LAS int*)(F.lds + MOE_OFF);
    for (int t = gw; t < T; t += NGW) {
        f32x4 v[8];
        const f32x4* xr = (const f32x4*)(X1 + (size_t)t * D) + lane;
#pragma unroll
        for (int j = 0; j < 8; ++j) v[j] = __builtin_nontemporal_load(xr + 64 * j);
#pragma unroll
        for (int k = 0; k < 4; ++k) { const float wk = SEL_W[t * 4 + k]; const v2u* yr = (const v2u*)(Y + (size_t)(tab[36 + SEL_E[t * 4 + k]] + SEL_R[t * 4 + k]) * D) + lane;
#pragma unroll
            for (int j = 0; j < 8; ++j) { const v2u u = __builtin_nontemporal_load(yr + 64 * j); v[j].x += wk * bflo(u.x); v[j].y += wk * bfhi(u.x); v[j].z += wk * bflo(u.y); v[j].w += wk * bfhi(u.y); } }
        float s = 0.f;
#pragma unroll
        for (int j = 0; j < 8; ++j) s += (v[j].x * v[j].x + v[j].y * v[j].y) + (v[j].z * v[j].z + v[j].w * v[j].w);
        const float rstd = rsqrtf(wave_sum(s) * (1.f / D) + NORM_EPS);
        f32x4* o = (f32x4*)(a.out + (size_t)t * D) + lane;
#pragma unroll
        for (int j = 0; j < 8; ++j) { const f32x4 gg = ((const f32x4*)a.in[I_NFINAL])[64 * j + lane]; __builtin_nontemporal_store(v[j] * rstd * gg, o + 64 * j); }
    }
}

__global__ void __launch_bounds__(512, 2) __attribute__((amdgpu_num_sgpr(96))) fwd(Args args) {
    extern __shared__ __attribute__((aligned(16))) unsigned char lds[];
    Frame F;
    F.lds = (LAS unsigned char*)lds; F.ws = args.ws; F.ctl = (unsigned*)(args.ws + WS_CTL);
    F.tid = threadIdx.x; F.lane = F.tid & 63; F.wave = __builtin_amdgcn_readfirstlane(F.tid >> 6);
    F.G = gridDim.x; { const int bx = blockIdx.x; F.vcu = (F.G % 8 == 0) ? (bx % 8) * (F.G / 8) + bx / 8 : bx; }
    for (int u = F.tid; u < (LDS_BYTES - LDSCTL_OFF) / 4; u += 512) ((LAS unsigned*)(F.lds + LDSCTL_OFF))[u] = 0u;
    __syncthreads();
    volatile LAS unsigned* MISC = (volatile LAS unsigned*)(F.lds + MISC_OFF);
#if MK_PER_PHASE
#define GRID_BAR() do { } while (0)
#else
    XcdBarrier bar = xcd_barrier_post(F.ctl + CW_BAR, MISC + 8);
#define GRID_BAR() xcd_barrier(bar)
#endif
    const int lo = args.ph_lo, hi = args.ph_hi;
#define IN(k) (lo <= (k) && (k) < hi)
#define SEAM(k) do { if (IN(k) && IN((k) + 1)) GRID_BAR(); } while (0)
#define DUP(k) (((PROBE_DUP) >> (k)) & 1)
#define PH_BEGIN {
#define PH_END }
    const bf16* P = (const bf16*)(F.ws + WS_P);

    if (IN(0)) { PH_BEGIN  p0_prologue(F, args);  PH_END if (DUP(0)) { GRID_BAR(); PH_BEGIN  p0_prologue(F, args);  PH_END } } SEAM(0);
    if (IN(1)) { PH_BEGIN  p1_gemm_in(F, args);  PH_END if (DUP(1)) { GRID_BAR(); PH_BEGIN  p1_gemm_in(F, args);  PH_END } } SEAM(1);
    if (PROBE_GEMM >= 0 && IN(1)) {
        pg8::Gemm g{(const bf16*)(F.ws + WS_H), (const bf16*)(F.ws + WS_WIN), DP, DP, D, nullptr}; pg8::ProbeOrder S; S.so.init(T, PLD, F.G, (int)blockIdx.x); S.mode = PROBE_GEMM;
        pg8::EpiProbe E{(bf16*)(F.ws + WS_XS)}; pg8::gemm_phase(F.lds, g, S, E); GRID_BAR();
    }
    if (IN(2)) { PH_BEGIN  p2_lora_in(F, args); gla_pass_a(F, args);  PH_END if (DUP(2)) { GRID_BAR(); PH_BEGIN  p2_lora_in(F, args); gla_pass_a(F, args);  PH_END } } SEAM(2);
    if (IN(3)) { PH_BEGIN
        { pg8::Gemm g{(const bf16*)(F.ws + WS_A2), (const bf16*)(F.ws + WS_WLWA), 512, 256, 256, nullptr}; pg8::StaticOrder S; S.init(T, 2048, F.G, (int)blockIdx.x);
          pg8::EpiBf16 E{(bf16*)(F.ws + WS_WAO), 2048, nullptr, 0, 1.f}; pg8::gemm_phase(F.lds, g, S, E); }
        { pg8::Gemm g{(const bf16*)(F.ws + WS_A2) + 256, (const bf16*)(F.ws + WS_WLG), 512, 256, 256, nullptr}; pg8::StaticOrder S; S.init(T, 1024, F.G, (int)blockIdx.x);
          pg8::EpiBf16 E{(bf16*)(F.ws + WS_GO), 1024, nullptr, 0, 1.f}; pg8::gemm_phase(F.lds, g, S, E); }
        {
            constexpr int NEL = BATCH * GH * GDV * GDK, HEAD = (NEL / 4 / 65536) * 65536; const int bx = (int)blockIdx.x;
            if (F.G == 256) { if (bx >= 128) gla_pass_b(F, 0, HEAD, bx - 128, 128); gla_pass_b(F, HEAD, NEL, F.vcu, F.G); } else gla_pass_b(F, 0, NEL, F.vcu, F.G); }
     PH_END if (DUP(3)) { GRID_BAR(); PH_BEGIN
        { pg8::Gemm g{(const bf16*)(F.ws + WS_A2), (const bf16*)(F.ws + WS_WLWA), 512, 256, 256, nullptr}; pg8::StaticOrder S; S.init(T, 2048, F.G, (int)blockIdx.x);
          pg8::EpiBf16 E{(bf16*)(F.ws + WS_WAO), 2048, nullptr, 0, 1.f}; pg8::gemm_phase(F.lds, g, S, E); }
        { pg8::Gemm g{(const bf16*)(F.ws + WS_A2) + 256, (const bf16*)(F.ws + WS_WLG), 512, 256, 256, nullptr}; pg8::StaticOrder S; S.init(T, 1024, F.G, (int)blockIdx.x);
          pg8::EpiBf16 E{(bf16*)(F.ws + WS_GO), 1024, nullptr, 0, 1.f}; pg8::gemm_phase(F.lds, g, S, E); }
        {
            constexpr int NEL = BATCH * GH * GDV * GDK, HEAD = (NEL / 4 / 65536) * 65536; const int bx = (int)blockIdx.x;
            if (F.G == 256) { if (bx >= 128) gla_pass_b(F, 0, HEAD, bx - 128, 128); gla_pass_b(F, HEAD, NEL, F.vcu, F.G); } else gla_pass_b(F, 0, NEL, F.vcu, F.G); }
     PH_END } } SEAM(3);
    if (IN(4)) { PH_BEGIN  p4_rwkv_prep(F, args); gla_pass_c(F, args);  PH_END if (DUP(4)) { GRID_BAR(); PH_BEGIN  p4_rwkv_prep(F, args); gla_pass_c(F, args);  PH_END } } SEAM(4);
    if (IN(5)) { PH_BEGIN  p5_rwkv_scan(F, args);  PH_END if (DUP(5)) { GRID_BAR(); PH_BEGIN  p5_rwkv_scan(F, args);  PH_END } } SEAM(5);
    if (IN(6)) { PH_BEGIN  p6_rwkv_post(F, args);  PH_END if (DUP(6)) { GRID_BAR(); PH_BEGIN  p6_rwkv_post(F, args);  PH_END } } SEAM(6);
    if (IN(7)) { PH_BEGIN
        { pg8::Gemm g{(const bf16*)(F.ws + WS_YA), (const bf16*)(F.ws + WS_WBA), RW, RW, RW, nullptr}; pg8::StaticOrder S; S.init(T, D, F.G, (int)blockIdx.x);
          pg8::EpiGate<false> E{(bf16*)(F.ws + WS_MRG), P, args.in[I_BM], C_GATE}; pg8::gemm_phase(F.lds, g, S, E); }
        { pg8::Gemm g{(const bf16*)(F.ws + WS_YB), (const bf16*)(F.ws + WS_WBB), GVW, GVW, GVW, nullptr}; pg8::StaticOrder S; S.init(T, D, F.G, (int)blockIdx.x);
          pg8::EpiGate<true> E{(bf16*)(F.ws + WS_MRG), P, args.in[I_BM] + D, C_GATE + D}; pg8::gemm_phase(F.lds, g, S, E); }
     PH_END if (DUP(7)) { GRID_BAR(); PH_BEGIN
        { pg8::Gemm g{(const bf16*)(F.ws + WS_YA), (const bf16*)(F.ws + WS_WBA), RW, RW, RW, nullptr}; pg8::StaticOrder S; S.init(T, D, F.G, (int)blockIdx.x);
          pg8::EpiGate<false> E{(bf16*)(F.ws + WS_MRG), P, args.in[I_BM], C_GATE}; pg8::gemm_phase(F.lds, g, S, E); }
        { pg8::Gemm g{(const bf16*)(F.ws + WS_YB), (const bf16*)(F.ws + WS_WBB), GVW, GVW, GVW, nullptr}; pg8::StaticOrder S; S.init(T, D, F.G, (int)blockIdx.x);
          pg8::EpiGate<true> E{(bf16*)(F.ws + WS_MRG), P, args.in[I_BM] + D, C_GATE + D}; pg8::gemm_phase(F.lds, g, S, E); }
     PH_END } } SEAM(7);
    if (IN(8)) { PH_BEGIN
        pg8::Gemm g{(const bf16*)(F.ws + WS_MRG), (const bf16*)(F.ws + WS_WOUT), D, D, D, nullptr}; pg8::StaticOrder S; S.init(T, D, F.G, (int)blockIdx.x);
        pg8::EpiResF32 E{(float*)(F.ws + WS_X1), args.in[I_X], F.lds}; pg8::gemm_phase(F.lds, g, S, E);
     PH_END if (DUP(8)) { GRID_BAR(); PH_BEGIN
        pg8::Gemm g{(const bf16*)(F.ws + WS_MRG), (const bf16*)(F.ws + WS_WOUT), D, D, D, nullptr}; pg8::StaticOrder S; S.init(T, D, F.G, (int)blockIdx.x);
        pg8::EpiResF32 E{(float*)(F.ws + WS_X1), args.in[I_X], F.lds}; pg8::gemm_phase(F.lds, g, S, E);
     PH_END } } SEAM(8);
    if (IN(9)) { PH_BEGIN  p11_router(F, args);  PH_END if (DUP(9)) { GRID_BAR(); PH_BEGIN  p11_router(F, args);  PH_END } } SEAM(9);
    if (IN(10)) { PH_BEGIN
        moe_tables(F, 16);
        pg8::Gemm g{(const bf16*)(F.ws + WS_H2), (const bf16*)(F.ws + WS_WGU), D, D, D, (const int*)(F.ws + WS_ROUTE + 1024 * 1024)};
        pg8::MoeOrder S{(const volatile LAS int*)(F.lds + MOE_OFF), 16, 4096, F.G, F.vcu, false};
        pg8::EpiGluQ E{(unsigned char*)(F.ws + WS_HH), args.in[I_BGATE], args.in[I_BUP]}; pg8::gemm_phase<pg8::EpiGluQ, pg8::MoeOrder, 1, true>(F.lds, g, S, E);
     PH_END if (DUP(10)) { GRID_BAR(); PH_BEGIN
        moe_tables(F, 16);
        pg8::Gemm g{(const bf16*)(F.ws + WS_H2), (const bf16*)(F.ws + WS_WGU), D, D, D, (const int*)(F.ws + WS_ROUTE + 1024 * 1024)};
        pg8::MoeOrder S{(const volatile LAS int*)(F.lds + MOE_OFF), 16, 4096, F.G, F.vcu, false};
        pg8::EpiGluQ E{(unsigned char*)(F.ws + WS_HH), args.in[I_BGATE], args.in[I_BUP]}; pg8::gemm_phase<pg8::EpiGluQ, pg8::MoeOrder, 1, true>(F.lds, g, S, E);
     PH_END } } SEAM(10);
    if (IN(11)) { PH_BEGIN
        moe_tables(F, 8);
        pg8::Gemm g{(const bf16*)(F.ws + WS_HH), (const bf16*)(F.ws + WS_WD), FF, FF, FF, nullptr};
        pg8::MoeOrder S{(const volatile LAS int*)(F.lds + MOE_OFF), 8, 2048, F.G, F.vcu, true};
        pg8::EpiBf16H E{(bf16*)(F.ws + WS_Y), D, args.in[I_BDOWN], D, WQ_INV}; pg8::gemm_phase<pg8::EpiBf16H, pg8::MoeOrder, 1, false, true, true>(F.lds, g, S, E);
     PH_END if (DUP(11)) { GRID_BAR(); PH_BEGIN
        moe_tables(F, 8);
        pg8::Gemm g{(const bf16*)(F.ws + WS_HH), (const bf16*)(F.ws + WS_WD), FF, FF, FF, nullptr};
        pg8::MoeOrder S{(const volatile LAS int*)(F.lds + MOE_OFF), 8, 2048, F.G, F.vcu, true};
        pg8::EpiBf16H E{(bf16*)(F.ws + WS_Y), D, args.in[I_BDOWN], D, WQ_INV}; pg8::gemm_phase<pg8::EpiBf16H, pg8::MoeOrder, 1, false, true, true>(F.lds, g, S, E);
     PH_END } } SEAM(11);
    if (IN(12)) { PH_BEGIN  p15_combine(F, args);  PH_END if (DUP(12)) { GRID_BAR(); PH_BEGIN  p15_combine(F, args);  PH_END } }
#undef IN
#undef SEAM
}
constexpr int N_PHASES = 13;

extern "C" void kernel_launch(void* const* d_in, const int* in_sizes, int n_in, void* d_out, int out_size, void* d_ws, size_t ws_size, hipStream_t stream) {
    static int grid = 0;
    if (grid == 0) {
        if (n_in != 31 || in_sizes[0] != T * D || out_size != T * D || ws_size < WS_END) { fprintf(stderr, "kernel_launch: unexpected shapes (n_in %d, ws %zu)\n", n_in, ws_size); grid = -1; return; }
        int dev = 0, cus = 0, per_cu = 0;
        if (hipGetDevice(&dev) != hipSuccess || hipDeviceGetAttribute(&cus, hipDeviceAttributeMultiprocessorCount, dev) != hipSuccess) { grid = -1; return; }
        if (hipFuncSetAttribute((const void*)fwd, hipFuncAttributeMaxDynamicSharedMemorySize, LDS_BYTES) != hipSuccess) { fprintf(stderr, "kernel_launch: hipFuncSetAttribute failed\n"); grid = -1; return; }
        if (hipOccupancyMaxActiveBlocksPerMultiprocessor(&per_cu, (const void*)fwd, 512, LDS_BYTES) != hipSuccess || per_cu < 1) { fprintf(stderr, "kernel_launch: occupancy query says %d\n", per_cu); }
        (void)hipGetLastError();
        grid = cus;
    }
    if (grid < 0) return;
    (void)hipMemsetAsync((char*)d_ws + WS_CTL, 0, CTL_ZERO_BYTES, stream);
    Args a{};
    for (int i = 0; i < 31; ++i) a.in[i] = (const float*)d_in[i];
    a.out = (float*)d_out; a.ws = (unsigned char*)d_ws;
#if MK_PER_PHASE
    for (int p = 0; p < N_PHASES; ++p) { a.ph_lo = p; a.ph_hi = p + 1; hipLaunchKernelGGL(fwd, dim3(grid), dim3(512), LDS_BYTES, stream, a); }
#else
    a.ph_lo = 0; a.ph_hi = N_PHASES;
    hipLaunchKernelGGL(fwd, dim3(grid), dim3(512), LDS_BYTES, stream, a);
#endif
}
```

```cpp
#include <hip/hip_runtime.h>
#include <cstdio>
#include <cstdint>

#ifndef MK_PER_PHASE
#define MK_PER_PHASE 0
#endif

#ifndef PROBE_GEMM
#define PROBE_GEMM -1
#endif
#ifndef PROBE_DUP
#define PROBE_DUP 0
#endif
#define GAS __attribute__((address_space(1)))
#define LAS __attribute__((address_space(3)))
typedef unsigned short bf16;
typedef unsigned v4u __attribute__((ext_vector_type(4)));
typedef unsigned v2u __attribute__((ext_vector_type(2)));
typedef float f32x4 __attribute__((ext_vector_type(4)));
typedef float f32x2 __attribute__((ext_vector_type(2)));
typedef short bf16x8 __attribute__((ext_vector_type(8)));
typedef long i64x2 __attribute__((ext_vector_type(2)));
typedef int v4i __attribute__((ext_vector_type(4)));
typedef int v8i __attribute__((ext_vector_type(8)));
#define RLX_AGENT __ATOMIC_RELAXED, __HIP_MEMORY_SCOPE_AGENT
#define LDS_WAIT() asm volatile("s_waitcnt lgkmcnt(0)" ::: "memory")
#define VM_WAIT() asm volatile("s_waitcnt vmcnt(0)" ::: "memory")

constexpr int D = 2048, BATCH = 4, SEQ = 2048, T = BATCH * SEQ;
constexpr int RW = 1024, RH = 16, RN = 64;
constexpr int DLORA = 96, GLORA = 256;
constexpr int RWKV_COLS = 3 * RW + 2 * DLORA + GLORA;
constexpr int GH = 4, GDK = 128, GDV = 256, GKW = GH * GDK, GVW = GH * GDV, GAL = 16;
constexpr int GLA_COLS = 2 * GKW + 2 * GVW + GAL;
constexpr int IN_COLS = RWKV_COLS + GLA_COLS + 2 * D;
constexpr int PLD = 10752;
constexpr int DP = D + 64;
constexpr int C_R = 0, C_K = 1024, C_V = 2048, C_WL = 3072, C_AL = 3168, C_GL = 3264;
constexpr int C_GQ = 3520, C_GK = 4032, C_GV = 4544, C_OG = 5568, C_GAL = 6592, C_GATE = 6608;
constexpr int NE = 32, TOPK = 4, FF = 2048;
constexpr int XS_ROWS = T * TOPK + NE * 256;
constexpr int CHUNK = 64, NCH = SEQ / CHUNK;
constexpr float NORM_EPS = 1e-5f, GN_EPS = 64e-5f;
constexpr float WQ_SCALE = 64.f, WQ_INV = 1.f / 64.f;

constexpr size_t MiB = 1u << 20;
constexpr size_t WS_CTL = 0, CTL_ZERO_BYTES = 1 * MiB;
constexpr size_t WS_WR = 1 * MiB;
constexpr size_t WS_WLWA = 2 * MiB;
constexpr size_t WS_WLG = 3 * MiB;
constexpr size_t WS_WBA = 4 * MiB, WS_WBB = 8 * MiB;
constexpr size_t WS_WOUT = 12 * MiB;
constexpr size_t WS_WIN = 64 * MiB;
constexpr size_t WS_WGU = 192 * MiB;
constexpr size_t WS_WD = 448 * MiB;
constexpr size_t WS_H = 128 * MiB;
constexpr size_t WS_P = 864 * MiB;
constexpr size_t WS_Y = WS_P;
constexpr size_t WS_A2 = 1032 * MiB;
constexpr size_t WS_WAO = 1040 * MiB;
constexpr size_t WS_GO = 1072 * MiB;
constexpr size_t WS_SCAN = 1088 * MiB;
constexpr size_t WS_BON = 1200 * MiB;
constexpr size_t WS_YRAW = 1280 * MiB;
constexpr size_t WS_GHT = 1312 * MiB;
constexpr size_t WS_GST = 1376 * MiB;
constexpr size_t WS_GDEC = 1408 * MiB;
constexpr size_t WS_GBC = 576 * MiB;
constexpr size_t WS_YA = 1410 * MiB, WS_YB = 1426 * MiB;
constexpr size_t WS_MRG = 1442 * MiB;
constexpr size_t WS_X1 = 1474 * MiB;
constexpr size_t WS_H2 = 832 * MiB;
constexpr size_t WS_ROUTE = 1570 * MiB;
constexpr size_t WS_XS = 1572 * MiB;
constexpr size_t WS_HH = 1732 * MiB;
constexpr size_t WS_END = 1892 * MiB;
constexpr int CW_BAR = 4096;
constexpr int CW_CNT = 16384;
constexpr int CW_CVQ = 20480, CW_CVSTOP = 20544;

constexpr int RING_BYTES = 131072;
constexpr int LDSCTL_OFF = 159744, MISC_OFF = LDSCTL_OFF + 320;
constexpr int MOE_OFF = LDSCTL_OFF + 1024;
constexpr int LDS_BYTES = 163840;

__device__ __forceinline__ unsigned f2bf(float f) { unsigned u = __builtin_bit_cast(unsigned, f); return (u + 0x7fffu + ((u >> 16) & 1u)) >> 16; }
__device__ __forceinline__ unsigned pk2(float lo, float hi) { return f2bf(lo) | (f2bf(hi) << 16); }
__device__ __forceinline__ unsigned pk4_fp8(float a, float b, float c, float d) { int w = 0; w = __builtin_amdgcn_cvt_pk_fp8_f32(a, b, w, false); w = __builtin_amdgcn_cvt_pk_fp8_f32(c, d, w, true); return (unsigned)w; }
__device__ __forceinline__ float bflo(unsigned u) { return __builtin_bit_cast(float, u << 16); }
__device__ __forceinline__ float bfhi(unsigned u) { return __builtin_bit_cast(float, u & 0xffff0000u); }
__device__ __forceinline__ float bf2f(bf16 b) { return __builtin_bit_cast(float, ((unsigned)b) << 16); }
__device__ __forceinline__ float wave_sum(float v) {
#pragma unroll
    for (int o = 1; o < 64; o <<= 1) v += __shfl_xor(v, o);
    return v;
}
__device__ __forceinline__ float sigmoidf_(float x) { return 1.f / (1.f + __expf(-x)); }
__device__ __forceinline__ float softplusf_(float x) { return fmaxf(x, 0.f) + log1pf(__expf(-fabsf(x))); }

namespace pg8 {
constexpr int RING_BYTES_ = 131072;
constexpr int BM = 256, BK = 64, HALF = 128, HTB = HALF * BK * 2, STAGE_BYTES = 8 * HTB, NXCD = 8, WGM = 8;
__host__ __device__ __forceinline__ int lds_byte(int r, int c) { return r * 128 + (((c >> 3) ^ ((r >> 1) & 7)) << 4) + (c & 7) * 2; }
__host__ __device__ __forceinline__ void stage_rc(int b, int& R, int& C) { R = b >> 7; C = ((((b & 127) >> 4) ^ ((R >> 1) & 7)) << 3); }
__host__ __device__ __forceinline__ int perm32(int rho) { const int n = rho >> 4, i = rho & 15; return 8 * (i >> 2) + 4 * n + (i & 3); }

struct Unit { int rowA, rowB, pn, e, rk0, cnt, hn; };
struct Gemm { const bf16* A; const bf16* Bt; int lda, ldb, K; const int* list; };

struct StaticOrder {
    int nM, nN, nwg, G, c;
    __device__ void init(int M, int N, int G_, int c_) { nM = M / BM; nN = N / BM; nwg = nM * nN; G = G_; c = c_; }
    __device__ bool next(int i, Unit& u) const {
        const long L = (long)i * G + c; if (L >= nwg) return false;
        int wgid = (int)L; { const int q = nwg / NXCD, r = nwg % NXCD, xcd = wgid % NXCD, off = wgid / NXCD; wgid = (xcd < r ? xcd * (q + 1) : r * (q + 1) + (xcd - r) * q) + off; }
        const int nig = WGM * nN, gid = wgid / nig, fm = gid * WGM, gsz = (nM - fm) < WGM ? (nM - fm) : WGM;
        const int pm = fm + ((wgid % nig) % gsz); u.pn = (wgid % nig) / gsz; u.rowA = pm * BM; u.rowB = u.pn * BM; u.e = 0; u.rk0 = 0; u.cnt = 0; u.hn = 0; return true;
    }
};
struct ProbeOrder {
    StaticOrder so; int mode;
    __device__ bool next(int i, Unit& u) const { if (!so.next(i, u)) return false; u.e = (u.rowA >> 8) * 64 + u.pn; if (mode & 1) u.rowA = 0; if (mode & 2) u.rowB = 0; return true; }
};
struct MoeOrder {
    const volatile LAS int* tab; int nct, rowsB, G, c;
    bool nsplit;
    __device__ bool next(int i, Unit& u) const {
        int L = i * G + c; const int total = __builtin_amdgcn_readfirstlane(tab[32]); int hn = 0;
        if (nsplit) { const int rf = (total / G) * G, r = total - rf;
            if (r > 0 && 2 * r <= G && L >= rf) { const int j = L - rf; if (j >= 2 * r) return false; L = rf + (j >> 1); hn = 1 + (j & 1); } }
        if (L >= total) return false;
        u.hn = hn;
        int e = 0;
        for (; e < 31; ++e) { if (L < __builtin_amdgcn_readfirstlane(tab[e + 1])) break; }
        const int local = L - __builtin_amdgcn_readfirstlane(tab[e]); const int nt = __builtin_amdgcn_readfirstlane(tab[72 + e]);
        const int ct = local / nt, rt = local - ct * nt;
        u.rowA = __builtin_amdgcn_readfirstlane(tab[36 + e]) + rt * BM; u.rowB = e * rowsB + ct * BM + (hn == 2 ? HALF : 0); u.pn = ct; u.e = e; u.rk0 = rt * BM; u.cnt = __builtin_amdgcn_readfirstlane(tab[108 + e]); return true;
    }
};

__device__ __forceinline__ unsigned cvt_pk_bf16(float lo, float hi) { unsigned r; asm volatile("v_cvt_pk_bf16_f32 %0, %1, %2" : "=v"(r) : "v"(lo), "v"(hi)); return r; }

__device__ __forceinline__ void epi_stage(LAS unsigned char* lds, int wave, int fr, int fq, const f32x4& a0, const f32x4& a1, f32x4& v0, f32x4& v1) {
    LAS float* t = (LAS float*)(lds + RING_BYTES_ + wave * (16 * 36 * 4));
    const int lane = fr + 16 * fq;
    *(LAS f32x4*)(t + fr * 36 + 8 * fq) = a0; *(LAS f32x4*)(t + fr * 36 + 8 * fq + 4) = a1;
    v0 = *(const LAS f32x4*)(t + (lane >> 2) * 36 + 8 * (lane & 3)); v1 = *(const LAS f32x4*)(t + (lane >> 2) * 36 + 8 * (lane & 3) + 4);
}
struct EpiBf16 {
    static constexpr bool PERM = true;
    bf16* O; int ldc; const float* bias; int bias_estride; float scale; LAS unsigned char* lds;
    __device__ __forceinline__ void operator()(const f32x4 (&acc)[2][2][4][2], const Unit& u, int wr, int wc, int fr, int fq) const {
        const int lane = fr + 16 * fq, wave = wr * 4 + wc;
        const int row0 = u.rowA + wr * 64 + (lane >> 2), col0 = u.pn * BM + wc * 32 + 8 * (lane & 3);
        f32x4 bv[2][2];
#pragma unroll
        for (int bj = 0; bj < 2; ++bj)
#pragma unroll
            for (int n = 0; n < 2; ++n) bv[bj][n] = bias ? *(const f32x4*)(bias + (size_t)u.e * bias_estride + col0 + bj * HALF + 4 * n) : (f32x4){0.f, 0.f, 0.f, 0.f};
#pragma unroll
        for (int ai = 0; ai < 2; ++ai)
#pragma unroll
            for (int m = 0; m < 4; ++m) { bf16* rowp = O + (size_t)(row0 + ai * HALF + m * 16) * ldc + col0;
#pragma unroll
                for (int bj = 0; bj < 2; ++bj) { f32x4 v0, v1; epi_stage(lds, wave, fr, fq, acc[ai][bj][m][0], acc[ai][bj][m][1], v0, v1);
                    v0 = v0 * scale + bv[bj][0]; v1 = v1 * scale + bv[bj][1];
                    v4u w; w.x = cvt_pk_bf16(v0[0], v0[1]); w.y = cvt_pk_bf16(v0[2], v0[3]); w.z = cvt_pk_bf16(v1[0], v1[1]); w.w = cvt_pk_bf16(v1[2], v1[3]);
                    *(v4u*)(rowp + bj * HALF) = w; } }
    }
};
struct EpiBf16H {
    static constexpr bool PERM = true;
    bf16* O; int ldc; const float* bias; int bias_estride; float scale; LAS unsigned char* lds;
    __device__ __forceinline__ void operator()(const f32x4 (&acc)[2][2][4][2], const Unit& u, int wr, int wc, int fr, int fq) const {
        const int lane = fr + 16 * fq, wave = wr * 4 + wc;
        const int row0 = u.rowA + wr * 64 + (lane >> 2), col0 = u.pn * BM + wc * 32 + 8 * (lane & 3) + (u.hn == 2 ? HALF : 0);
#pragma unroll
        for (int bj = 0; bj < 2; ++bj) { if (bj == 1 && u.hn != 0) break;
            f32x4 bv[2];
#pragma unroll
            for (int n = 0; n < 2; ++n) bv[n] = *(const f32x4*)(bias + (size_t)u.e * bias_estride + col0 + bj * HALF + 4 * n);
#pragma unroll
            for (int ai = 0; ai < 2; ++ai)
#pragma unroll
                for (int m = 0; m < 4; ++m) { bf16* rowp = O + (size_t)(row0 + ai * HALF + m * 16) * ldc + col0;
                    f32x4 v0, v1; epi_stage(lds, wave, fr, fq, acc[ai][bj][m][0], acc[ai][bj][m][1], v0, v1);
                    v0 = v0 * scale + bv[0]; v1 = v1 * scale + bv[1];
                    v4u w; w.x = cvt_pk_bf16(v0[0], v0[1]); w.y = cvt_pk_bf16(v0[2], v0[3]); w.z = cvt_pk_bf16(v1[0], v1[1]); w.w = cvt_pk_bf16(v1[2], v1[3]);
                    *(v4u*)(rowp + bj * HALF) = w; } }
    }
};
struct EpiProbe {
    static constexpr bool PERM = true;
    bf16* O;
    __device__ __forceinline__ void operator()(const f32x4 (&acc)[2][2][4][2], const Unit& u, int wr, int wc, int fr, int fq) const {
        const int pm = u.e >> 6, pn = u.e & 63; const int row0 = pm * BM + wr * 64 + fr, col0 = pn * BM + wc * 32 + 8 * fq;
#pragma unroll
        for (int ai = 0; ai < 2; ++ai)
#pragma unroll
            for (int m = 0; m < 4; ++m) { bf16* rowp = O + (size_t)(row0 + ai * HALF + m * 16) * PLD + col0;
#pragma unroll
                for (int bj = 0; bj < 2; ++bj) { const f32x4 v0 = acc[ai][bj][m][0], v1 = acc[ai][bj][m][1];
                    v4u w; w.x = cvt_pk_bf16(v0[0], v0[1]); w.y = cvt_pk_bf16(v0[2], v0[3]); w.z = cvt_pk_bf16(v1[0], v1[1]); w.w = cvt_pk_bf16(v1[2], v1[3]);
                    *(v4u*)(rowp + bj * HALF) = w; } }
    }
};
template <bool ADD> struct EpiGate {
    static constexpr bool PERM = true;
    bf16* O; const bf16* P; const float* bm; int gcol; LAS unsigned char* lds;
    __device__ __forceinline__ void operator()(const f32x4 (&acc)[2][2][4][2], const Unit& u, int wr, int wc, int fr, int fq) const {
        const int lane = fr + 16 * fq, wave = wr * 4 + wc;
        const int row0 = u.rowA + wr * 64 + (lane >> 2), col0 = u.pn * BM + wc * 32 + 8 * (lane & 3);
        f32x4 bv[2][2];
#pragma unroll
        for (int bj = 0; bj < 2; ++bj)
#pragma unroll
            for (int n = 0; n < 2; ++n) bv[bj][n] = *(const f32x4*)(bm + col0 + bj * HALF + 4 * n);
#pragma unroll
        for (int ai = 0; ai < 2; ++ai)
#pragma unroll
            for (int m = 0; m < 4; ++m) { const size_t row = (size_t)(row0 + ai * HALF + m * 16);
#pragma unroll
                for (int bj = 0; bj < 2; ++bj) {
                    const v4u pg = *(const v4u*)(P + row * PLD + gcol + col0 + bj * HALF);
                    bf16* op = O + row * D + col0 + bj * HALF;
                    v4u pv = {0u, 0u, 0u, 0u}; if (ADD) pv = *(const v4u*)op;
                    f32x4 v0, v1; epi_stage(lds, wave, fr, fq, acc[ai][bj][m][0], acc[ai][bj][m][1], v0, v1);
                    float g[8] = {bflo(pg.x), bfhi(pg.x), bflo(pg.y), bfhi(pg.y), bflo(pg.z), bfhi(pg.z), bflo(pg.w), bfhi(pg.w)};
                    float r[8];
#pragma unroll
                    for (int j = 0; j < 4; ++j) { r[j] = sigmoidf_(g[j] + bv[bj][0][j]) * v0[j]; r[4 + j] = sigmoidf_(g[4 + j] + bv[bj][1][j]) * v1[j]; }
                    if (ADD) { r[0] += bflo(pv.x); r[1] += bfhi(pv.x); r[2] += bflo(pv.y); r[3] += bfhi(pv.y); r[4] += bflo(pv.z); r[5] += bfhi(pv.z); r[6] += bflo(pv.w); r[7] += bfhi(pv.w); }
                    v4u w; w.x = cvt_pk_bf16(r[0], r[1]); w.y = cvt_pk_bf16(r[2], r[3]); w.z = cvt_pk_bf16(r[4], r[5]); w.w = cvt_pk_bf16(r[6], r[7]);
                    *(v4u*)op = w; } }
    }
};
struct EpiResF32 {
    static constexpr bool PERM = false;
    float* O; const float* X; LAS unsigned char* lds;
    __device__ __forceinline__ void operator()(const f32x4 (&acc)[2][2][4][2], const Unit& u, int wr, int wc, int fr, int fq) const {
        constexpr int RP = 36;
        LAS float* t = (LAS float*)(lds + RING_BYTES_ + (wr * 4 + wc) * (16 * RP * 4));
        const int lane = fr + 16 * fq, row8 = lane >> 3, seg = lane & 7;
        const int row0 = u.rowA + wr * 64, col0 = u.pn * BM + wc * 32;
#pragma unroll
        for (int ai = 0; ai < 2; ++ai)
#pragma unroll
            for (int m = 0; m < 4; ++m)
#pragma unroll
                for (int bj = 0; bj < 2; ++bj) {
                    const size_t go = (size_t)(row0 + ai * HALF + m * 16 + row8) * D + col0 + bj * HALF + 4 * seg;
                    const f32x4 x0 = __builtin_nontemporal_load((const f32x4*)(X + go)), x1 = __builtin_nontemporal_load((const f32x4*)(X + go + (size_t)8 * D));
                    *(LAS f32x4*)(t + fr * RP + 4 * fq) = acc[ai][bj][m][0]; *(LAS f32x4*)(t + fr * RP + 16 + 4 * fq) = acc[ai][bj][m][1];
                    const f32x4 v0 = *(const LAS f32x4*)(t + row8 * RP + 4 * seg), v1 = *(const LAS f32x4*)(t + (8 + row8) * RP + 4 * seg);
                    *(f32x4*)(O + go) = v0 + x0; *(f32x4*)(O + go + (size_t)8 * D) = v1 + x1;
                }
    }
};
struct EpiGlu {
    static constexpr bool PERM = true;
    bf16* O; const float* bg; const float* bu;
    __device__ __forceinline__ void operator()(const f32x4 (&acc)[2][2][4][2], const Unit& u, int wr, int wc, int fr, int fq) const {
        const int row0 = u.rowA + wr * 64 + fr, col0 = u.pn * HALF + wc * 32 + 8 * fq;
        f32x4 gb[2], ub[2];
#pragma unroll
        for (int n = 0; n < 2; ++n) { gb[n] = *(const f32x4*)(bg + (size_t)u.e * FF + col0 + 4 * n); ub[n] = *(const f32x4*)(bu + (size_t)u.e * FF + col0 + 4 * n); }
#pragma unroll
        for (int ai = 0; ai < 2; ++ai)
#pragma unroll
            for (int m = 0; m < 4; ++m) { bf16* op = O + (size_t)(row0 + ai * HALF + m * 16) * FF + col0;
                float r[8];
#pragma unroll
                for (int n = 0; n < 2; ++n)
#pragma unroll
                    for (int j = 0; j < 4; ++j) { float g = fminf(acc[ai][0][m][n][j] + gb[n][j], 7.f); float up = fminf(fmaxf(acc[ai][1][m][n][j] + ub[n][j], -7.f), 7.f);
                        r[4 * n + j] = (up + 1.f) * g * sigmoidf_(1.702f * g); }
                v4u w; w.x = cvt_pk_bf16(r[0], r[1]); w.y = cvt_pk_bf16(r[2], r[3]); w.z = cvt_pk_bf16(r[4], r[5]); w.w = cvt_pk_bf16(r[6], r[7]);
                *(v4u*)op = w; }
    }
};

struct EpiGluQ {
    static constexpr bool PERM = true;
    unsigned char* O; const float* bg; const float* bu; LAS unsigned char* lds;
    __device__ __forceinline__ void operator()(const f32x4 (&acc)[2][2][4][2], const Unit& u, int wr, int wc, int fr, int fq) const {
        const int lane = fr + 16 * fq, wave = wr * 4 + wc;
        const int row0 = u.rowA + wr * 64 + (lane >> 2), col0 = u.pn * HALF + wc * 32 + 8 * (lane & 3);
        f32x4 gb[2], ub[2];
#pragma unroll
        for (int n = 0; n < 2; ++n) { gb[n] = *(const f32x4*)(bg + (size_t)u.e * FF + col0 + 4 * n); ub[n] = *(const f32x4*)(bu + (size_t)u.e * FF + col0 + 4 * n); }
#pragma unroll
        for (int ai = 0; ai < 2; ++ai)
#pragma unroll
            for (int m = 0; m < 4; ++m) { unsigned char* op = O + (size_t)(row0 + ai * HALF + m * 16) * FF + col0;
                f32x4 gv[2], uv[2]; epi_stage(lds, wave, fr, fq, acc[ai][0][m][0], acc[ai][0][m][1], gv[0], gv[1]); epi_stage(lds, wave, fr, fq, acc[ai][1][m][0], acc[ai][1][m][1], uv[0], uv[1]);
                float r[8];
#pragma unroll
                for (int n = 0; n < 2; ++n)
#pragma unroll
                    for (int j = 0; j < 4; ++j) { float g = fminf(gv[n][j] * WQ_INV + gb[n][j], 7.f); float up = fminf(fmaxf(uv[n][j] * WQ_INV + ub[n][j], -7.f), 7.f);
                        r[4 * n + j] = (up + 1.f) * g * sigmoidf_(1.702f * g); }
                v2u w; w.x = pk4_fp8(r[0], r[1], r[2], r[3]); w.y = pk4_fp8(r[4], r[5], r[6], r[7]);
                *(v2u*)op = w; }
    }
};

template <class Epi, class Sched, int ESZ = 2, bool GATHER = false, bool ALIGN_EPI = true, bool NSPLIT = false>
__device__ __forceinline__ void gemm_phase(LAS unsigned char* lds, const Gemm g, const Sched& S, const Epi& E) {
    const int tid = threadIdx.x, wid = __builtin_amdgcn_readfirstlane(tid >> 6), lane = tid & 63, wr = wid >> 2, wc = wid & 3, fr = lane & 15, fq = lane >> 4;
    const int K = g.K, nt = K * ESZ / (BK * 2);
    unsigned voffA[2], voffB[2]; int Rst[2], Cst[2];
#pragma unroll
    for (int i = 0; i < 2; ++i) { int R, C; stage_rc(tid * 16 + i * 8192, R, C); const int Rb = Epi::PERM ? ((R & ~31) + perm32(R & 31)) : R; Rst[i] = R; Cst[i] = C * 2;
        voffA[i] = (unsigned)(R * g.lda * ESZ + C * 2); voffB[i] = (unsigned)(Rb * g.ldb * ESZ + C * 2); }
    const size_t kstep = (size_t)(BK * 2);
    const size_t hstepA = (size_t)HALF * g.lda * ESZ, hstepB = (size_t)HALF * g.ldb * ESZ;
    const unsigned ldsw = (unsigned)wid * 1024u;
    const int aoff = lds_byte(wr * 64 + fr, fq * 8), boff = lds_byte(wc * 32 + fr, fq * 8);
#define PG8_SA(b, h) (((b) * 2 + (h)) * HTB)
#define PG8_SB(b, h) ((4 + (b) * 2 + (h)) * HTB)
#define PG8_STAGE(bufoff, gbase, voff) do { _Pragma("unroll") for (int _i = 0; _i < 2; ++_i) \
        __builtin_amdgcn_global_load_lds((const unsigned*)((const char*)(gbase) + (voff)[_i]), (LAS unsigned*)(lds + (bufoff) + ldsw + _i * 8192), 16, 0, 0); } while (0)
#define PG8_GOFF(u_, v_) do { _Pragma("unroll") for (int h_ = 0; h_ < 2; ++h_) _Pragma("unroll") for (int i_ = 0; i_ < 2; ++i_) { const int rk_ = (u_).rk0 + 128 * h_ + Rst[i_]; \
        const int tok_ = rk_ < (u_).cnt ? g.list[(u_).e * 8192 + rk_] : 0; (v_)[h_][i_] = (unsigned)tok_ * (unsigned)(g.lda * ESZ) + (unsigned)Cst[i_]; } } while (0)
#define PG8_STAGE_A(bufoff, isnext, tt, h) do { if constexpr (GATHER) { unsigned vo_[2] = {(isnext) ? vN[h][0] : vA[h][0], (isnext) ? vN[h][1] : vA[h][1]}; PG8_STAGE(bufoff, (const char*)g.A + (size_t)(tt) * kstep, vo_); } \
        else PG8_STAGE(bufoff, ((isnext) ? nA : cA) + (size_t)(tt) * kstep + (size_t)(h) * hstepA, voffA); } while (0)
#define PG8_LD16(off_) (*(const LAS v4i*)(lds + (off_)))
#define PG8_LDA(dst, b, h) do { if constexpr (ESZ == 2) { _Pragma("unroll") for (int m = 0; m < 4; ++m) _Pragma("unroll") for (int k = 0; k < 2; ++k) dst[m][k] = *(const LAS bf16x8*)(lds + PG8_SA(b, h) + (k ? (aoff ^ 64) : aoff) + m * 2048); } \
        else { _Pragma("unroll") for (int m = 0; m < 4; ++m) dst##8[m] = __builtin_shufflevector(PG8_LD16(PG8_SA(b, h) + aoff + m * 2048), PG8_LD16(PG8_SA(b, h) + (aoff ^ 64) + m * 2048), 0, 1, 2, 3, 4, 5, 6, 7); } } while (0)
#define PG8_LDB(dst, b, h) do { if constexpr (ESZ == 2) { _Pragma("unroll") for (int n = 0; n < 2; ++n) _Pragma("unroll") for (int k = 0; k < 2; ++k) dst[n][k] = *(const LAS bf16x8*)(lds + PG8_SB(b, h) + (k ? (boff ^ 64) : boff) + n * 2048); } \
        else { _Pragma("unroll") for (int n = 0; n < 2; ++n) dst##8[n] = __builtin_shufflevector(PG8_LD16(PG8_SB(b, h) + boff + n * 2048), PG8_LD16(PG8_SB(b, h) + (boff ^ 64) + n * 2048), 0, 1, 2, 3, 4, 5, 6, 7); } } while (0)
#define PG8_MMA(ai, bj, At, Bt) do { __builtin_amdgcn_s_setprio(1); _Pragma("unroll") for (int m = 0; m < 4; ++m) _Pragma("unroll") for (int n = 0; n < 2; ++n) { \
        if constexpr (ESZ == 2) { _Pragma("unroll") for (int k = 0; k < 2; ++k) acc[ai][bj][m][n] = __builtin_amdgcn_mfma_f32_16x16x32_bf16(Bt[n][k], At[m][k], acc[ai][bj][m][n], 0, 0, 0); } \
        else asm volatile("s_nop 1\n\tv_mfma_scale_f32_16x16x128_f8f6f4 %0, %1, %2, %0, %3, %3 op_sel_hi:[0,0,0]" : "+v"(acc[ai][bj][m][n]) : "v"(Bt##8[n]), "v"(At##8[m]), "v"(one_scale)); } \
        __builtin_amdgcn_s_setprio(0); } while (0)
#define PG8_WAIT_V(n) asm volatile("s_waitcnt vmcnt(" #n ")" ::: "memory")
#define PG8_WAIT_L(n) asm volatile("s_waitcnt lgkmcnt(" #n ")" ::: "memory")
#define PG8_BAR __builtin_amdgcn_s_barrier()
#define PG8_SCHED __builtin_amdgcn_sched_barrier(0)
    Unit cur, nxt; int ui = 0;
    if (!S.next(0, cur)) return;
    f32x4 acc[2][2][4][2];
#pragma unroll
    for (int a = 0; a < 2; ++a)
#pragma unroll
        for (int b = 0; b < 2; ++b)
#pragma unroll
            for (int m = 0; m < 4; ++m)
#pragma unroll
                for (int n = 0; n < 2; ++n) acc[a][b][m][n] = (f32x4){0.f, 0.f, 0.f, 0.f};
    const int one_scale = 0x7F7F7F7F;
    bf16x8 At[4][2], B0[2][2], B1[2][2]; v8i At8[4], B08[2], B18[2];
    const char* cA = (const char*)g.A + (size_t)cur.rowA * g.lda * ESZ; const char* cB = (const char*)g.Bt + (size_t)cur.rowB * g.ldb * ESZ;
    unsigned vA[2][2] = {{0u, 0u}, {0u, 0u}}, vN[2][2] = {{0u, 0u}, {0u, 0u}}; const char* nA = cA;
    if constexpr (GATHER) PG8_GOFF(cur, vA);
    PG8_STAGE(PG8_SB(0, 0), cB, voffB); PG8_STAGE(PG8_SB(0, 1), cB + hstepB, voffB); PG8_STAGE_A(PG8_SA(0, 0), false, 0, 0); PG8_STAGE_A(PG8_SA(0, 1), false, 0, 1);
    if (wr == 1) PG8_BAR;
    PG8_WAIT_V(2); PG8_BAR;
    PG8_STAGE(PG8_SB(1, 0), cB + kstep, voffB); PG8_STAGE_A(PG8_SA(1, 0), false, 1, 0); PG8_STAGE(PG8_SB(1, 1), cB + hstepB + kstep, voffB);
    PG8_WAIT_V(6); PG8_BAR;
    for (;;) {
        const bool has_next = S.next(ui + 1, nxt);
        nA = has_next ? (const char*)g.A + (size_t)nxt.rowA * g.lda * ESZ : cA; const char* nB = has_next ? (const char*)g.Bt + (size_t)nxt.rowB * g.ldb * ESZ : cB;
        if constexpr (GATHER) { if (has_next) PG8_GOFF(nxt, vN); else { vN[0][0] = vA[0][0]; vN[0][1] = vA[0][1]; vN[1][0] = vA[1][0]; vN[1][1] = vA[1][1]; } }
        const bool hnz = NSPLIT && cur.hn != 0;
        for (int t = 0; t < nt; t += 2) {
            const bool last = (t == nt - 2);
            const char* b2 = last ? nB : cB + (size_t)(t + 2) * kstep; const char* b3 = b2 + kstep;
            const int t2 = last ? 0 : t + 2, t3 = last ? 1 : t + 3;
            PG8_LDB(B0, 0, 0); if (NSPLIT ? !hnz : true) PG8_LDB(B1, 0, 1); PG8_SCHED; PG8_LDA(At, 0, 0); PG8_STAGE_A(PG8_SA(1, 1), false, t + 1, 1);
            PG8_WAIT_V(8); PG8_WAIT_L(0); PG8_BAR; PG8_MMA(0, 0, At, B0); if (NSPLIT ? !hnz : true) PG8_MMA(0, 1, At, B1); PG8_BAR; PG8_SCHED;
            PG8_LDA(At, 0, 1); PG8_STAGE(PG8_SB(0, 0), b2, voffB); PG8_STAGE(PG8_SB(0, 1), b2 + hstepB, voffB); PG8_STAGE_A(PG8_SA(0, 0), last, t2, 0);
            PG8_WAIT_V(8); PG8_WAIT_L(0); PG8_BAR; PG8_MMA(1, 0, At, B0); if (NSPLIT ? !hnz : true) PG8_MMA(1, 1, At, B1); PG8_BAR; PG8_SCHED;
            PG8_LDB(B0, 1, 0); if (NSPLIT ? !hnz : true) PG8_LDB(B1, 1, 1); PG8_SCHED; PG8_LDA(At, 1, 0); PG8_STAGE_A(PG8_SA(0, 1), last, t2, 1);
            PG8_WAIT_V(8); PG8_WAIT_L(0); PG8_BAR; PG8_MMA(0, 0, At, B0); if (NSPLIT ? !hnz : true) PG8_MMA(0, 1, At, B1); PG8_BAR; PG8_SCHED;
            PG8_LDA(At, 1, 1); PG8_STAGE(PG8_SB(1, 0), b3, voffB); PG8_STAGE(PG8_SB(1, 1), b3 + hstepB, voffB); PG8_STAGE_A(PG8_SA(1, 0), last, t3, 0);
            PG8_WAIT_V(8); PG8_WAIT_L(0); PG8_BAR; PG8_MMA(1, 0, At, B0); if (NSPLIT ? !hnz : true) PG8_MMA(1, 1, At, B1); PG8_BAR; PG8_SCHED;
        }
        if constexpr (ESZ == 1) asm volatile("s_nop 15\n\ts_nop 15" ::: "memory");
        if constexpr (ALIGN_EPI) { if (wr == 0) PG8_BAR; }
        E(acc, cur, wr, wc, fr, fq);
        if (!has_next) break;
#pragma unroll
        for (int a = 0; a < 2; ++a)
#pragma unroll
            for (int b = 0; b < 2; ++b)
#pragma unroll
                for (int m = 0; m < 4; ++m)
#pragma unroll
                    for (int n = 0; n < 2; ++n) acc[a][b][m][n] = (f32x4){0.f, 0.f, 0.f, 0.f};
        cur = nxt; cA = nA; cB = nB; ++ui;
        if constexpr (GATHER) { vA[0][0] = vN[0][0]; vA[0][1] = vN[0][1]; vA[1][0] = vN[1][0]; vA[1][1] = vN[1][1]; }
        if constexpr (ALIGN_EPI) { if (wr == 1) PG8_BAR; }
    }
    PG8_WAIT_V(0);
    if constexpr (!ALIGN_EPI) { if (wr == 0) PG8_BAR; }
    PG8_BAR;
#undef PG8_SA
#undef PG8_SB
#undef PG8_STAGE
#undef PG8_LDA
#undef PG8_LD16
#undef PG8_GOFF
#undef PG8_STAGE_A
#undef PG8_LDB
#undef PG8_MMA
#undef PG8_WAIT_V
#undef PG8_WAIT_L
#undef PG8_BAR
#undef PG8_SCHED
}

typedef short s16x4 __attribute__((ext_vector_type(4)));
struct UnitF { int rowA, pn, e; const float* b0; const float* b1; };
struct GemmF { const bf16* A; int lda, K, ldbn; };
struct MoeOrderF {
    const volatile LAS int* tab; int nct, G, c; const float* w0; const float* w1; size_t estride; int cstep;
    __device__ bool next(int i, UnitF& u) const {
        const int L = i * G + c; const int total = __builtin_amdgcn_readfirstlane(tab[32]); if (L >= total) return false;
        int e = 0;
        for (; e < 31; ++e) { if (L < __builtin_amdgcn_readfirstlane(tab[e + 1])) break; }
        const int local = L - __builtin_amdgcn_readfirstlane(tab[e]); const int nt = __builtin_amdgcn_readfirstlane(tab[72 + e]);
        const int ct = local / nt, rt = local - ct * nt;
        u.rowA = __builtin_amdgcn_readfirstlane(tab[36 + e]) + rt * BM; u.pn = ct; u.e = e;
        u.b0 = w0 + (size_t)e * estride + (size_t)ct * cstep; u.b1 = w1 + (size_t)e * estride + (size_t)ct * cstep; return true;
    }
};
struct EpiGluNP {
    bf16* O; const float* bg; const float* bu;
    __device__ __forceinline__ void operator()(const f32x4 (&acc)[2][2][4][2], const UnitF& u, int wr, int wc, int fr, int fq) const {
        const int row0 = u.rowA + wr * 64 + fr, col0 = u.pn * HALF + wc * 32 + 4 * fq;
        f32x4 gb[2], ub[2];
#pragma unroll
        for (int n = 0; n < 2; ++n) { gb[n] = *(const f32x4*)(bg + (size_t)u.e * FF + col0 + 16 * n); ub[n] = *(const f32x4*)(bu + (size_t)u.e * FF + col0 + 16 * n); }
#pragma unroll
        for (int ai = 0; ai < 2; ++ai)
#pragma unroll
            for (int m = 0; m < 4; ++m) { bf16* op = O + (size_t)(row0 + ai * HALF + m * 16) * FF + col0;
#pragma unroll
                for (int n = 0; n < 2; ++n) { float r[4];
#pragma unroll
                    for (int j = 0; j < 4; ++j) { const float gg = fminf(acc[ai][0][m][n][j] + gb[n][j], 7.f); const float up = fminf(fmaxf(acc[ai][1][m][n][j] + ub[n][j], -7.f), 7.f);
                        r[j] = (up + 1.f) * gg * sigmoidf_(1.702f * gg); }
                    v2u w; w.x = cvt_pk_bf16(r[0], r[1]); w.y = cvt_pk_bf16(r[2], r[3]); *(v2u*)(op + 16 * n) = w; } }
    }
};
struct EpiBf16NP {
    bf16* O; int ldc; const float* bias; int bias_estride;
    __device__ __forceinline__ void operator()(const f32x4 (&acc)[2][2][4][2], const UnitF& u, int wr, int wc, int fr, int fq) const {
        const int row0 = u.rowA + wr * 64 + fr, col0 = u.pn * BM + wc * 32 + 4 * fq;
        f32x4 bv[2][2];
#pragma unroll
        for (int bj = 0; bj < 2; ++bj)
#pragma unroll
            for (int n = 0; n < 2; ++n) bv[bj][n] = *(const f32x4*)(bias + (size_t)u.e * bias_estride + col0 + bj * HALF + 16 * n);
#pragma unroll
        for (int ai = 0; ai < 2; ++ai)
#pragma unroll
            for (int m = 0; m < 4; ++m) { bf16* rowp = O + (size_t)(row0 + ai * HALF + m * 16) * ldc + col0;
#pragma unroll
                for (int bj = 0; bj < 2; ++bj)
#pragma unroll
                    for (int n = 0; n < 2; ++n) { const f32x4 v = acc[ai][bj][m][n] + bv[bj][n]; v2u w; w.x = cvt_pk_bf16(v[0], v[1]); w.y = cvt_pk_bf16(v[2], v[3]); *(v2u*)(rowp + bj * HALF + 16 * n) = w; } }
    }
};
template <class Epi, class Sched>
__device__ __forceinline__ void gemm_phase_f32b(LAS unsigned char* lds, const GemmF g, const Sched& S, const Epi& E) {
    const int tid = threadIdx.x, wid = __builtin_amdgcn_readfirstlane(tid >> 6), lane = tid & 63, wr = wid >> 2, wc = wid & 3, fr = lane & 15, fq = lane >> 4;
    const int K = g.K, nt = K / BK;
    unsigned voffA[2];
#pragma unroll
    for (int i = 0; i < 2; ++i) { int R, C; stage_rc(tid * 16 + i * 8192, R, C); voffA[i] = (unsigned)(R * g.lda + C) * 2u; }
    const size_t kstep = (size_t)(BK * 2);
    const size_t hstepA = (size_t)HALF * g.lda * 2;
    const unsigned ldsw = (unsigned)wid * 1024u;
    const int aoff = lds_byte(wr * 64 + fr, fq * 8);
    const int ldsb = (int)(uintptr_t)lds;
    const int q4 = (lane & 15) >> 2, p4 = lane & 3;
    const int fsw = q4 | ((fq & 1) << 2);
    int rbase[2];
#pragma unroll
    for (int n = 0; n < 2; ++n) rbase[n] = (8 * fq + q4) * 256 + ((((wc * 2) ^ fsw) ^ n) * 32) + 8 * p4;
    const int hB = wid >> 2, r0 = 2 * (wid & 3) + (lane >> 5), l31 = lane & 31;
    const int wslot = (l31 >> 2) ^ (r0 & 3);
    const int wb0 = hB * HTB + r0 * 256 + wslot * 32 + (lane & 3) * 8, wb1 = hB * HTB + r0 * 256 + (wslot ^ 4) * 32 + (lane & 3) * 8;
    const unsigned laneoffB = (unsigned)(r0 * g.ldbn + 4 * l31) * 4u;
    const size_t rstep8 = (size_t)8 * g.ldbn * 4, tstepB = (size_t)64 * g.ldbn * 4;
#define PG8_SA(b, h) (((b) * 2 + (h)) * HTB)
#define PG8_SB(b, h) ((4 + (b) * 2 + (h)) * HTB)
#define PG8_STAGE(bufoff, gbase, voff) do { _Pragma("unroll") for (int _i = 0; _i < 2; ++_i) { unsigned keep_; \
        asm volatile("s_mov_b32 %0, m0\n\ts_mov_b32 m0, %2\n\ts_nop 0\n\tglobal_load_lds_dwordx4 %1, off\n\ts_mov_b32 m0, %0" : "=&s"(keep_) \
            : "v"((const char*)(gbase) + (voff)[_i]), "s"(__builtin_amdgcn_readfirstlane(ldsb + (bufoff) + (int)ldsw + _i * 8192)) : "memory"); } } while (0)
#define PG8_LDA(dst, b, h) do { _Pragma("unroll") for (int m = 0; m < 4; ++m) _Pragma("unroll") for (int k = 0; k < 2; ++k) dst[m][k] = *(const LAS bf16x8*)(lds + PG8_SA(b, h) + (k ? (aoff ^ 64) : aoff) + m * 2048); } while (0)
#define PG8_LDBT(dst, b, h) do { _Pragma("unroll") for (int n = 0; n < 2; ++n) _Pragma("unroll") for (int k = 0; k < 2; ++k) { \
        const s16x4 lo_ = __builtin_amdgcn_ds_read_tr16_b64_v4i16((LAS s16x4*)(lds + PG8_SB(b, h) + rbase[n] + k * 8192)); \
        const s16x4 hi_ = __builtin_amdgcn_ds_read_tr16_b64_v4i16((LAS s16x4*)(lds + PG8_SB(b, h) + rbase[n] + k * 8192 + 1024)); \
        dst[n][k] = __builtin_shufflevector(lo_, hi_, 0, 1, 2, 3, 4, 5, 6, 7); } } while (0)
#define PG8_BPTR(p0, p1, tt) ((const char*)(hB ? (p1) : (p0)) + (size_t)(tt) * tstepB)
#define PG8_LOADB1(pb, i) dreg[i] = *(const f32x4*)((pb) + (size_t)(i) * rstep8 + laneoffB)
#define PG8_LOADB(p0, p1, tt) do { const char* pb_ = PG8_BPTR(p0, p1, tt); _Pragma("unroll") for (int _i = 0; _i < 8; ++_i) PG8_LOADB1(pb_, _i); } while (0)
#define PG8_WRITEB1(b, i) do { v2u pk_; pk_.x = cvt_pk_bf16(dreg[i].x, dreg[i].y); pk_.y = cvt_pk_bf16(dreg[i].z, dreg[i].w); \
        *(LAS v2u*)(lds + PG8_SB(b, 0) + (((i) & 1) ? wb1 : wb0) + (i) * 2048) = pk_; } while (0)
#define PG8_WRITEB(b) do { _Pragma("unroll") for (int _i = 0; _i < 8; ++_i) PG8_WRITEB1(b, _i); } while (0)
#define PG8_MF(ai, bj, m, At, Bt) do { _Pragma("unroll") for (int n = 0; n < 2; ++n) _Pragma("unroll") for (int k = 0; k < 2; ++k) \
        acc[ai][bj][m][n] = __builtin_amdgcn_mfma_f32_16x16x32_bf16(Bt[n][k], At[m][k], acc[ai][bj][m][n], 0, 0, 0); } while (0)
#define PG8_MMA(ai, bj, At, Bt) do { __builtin_amdgcn_s_setprio(1); _Pragma("unroll") for (int m = 0; m < 4; ++m) PG8_MF(ai, bj, m, At, Bt); __builtin_amdgcn_s_setprio(0); } while (0)
#define PG8_MMA_CVT(ai, bj, At, Bt, b) do { __builtin_amdgcn_s_setprio(1); _Pragma("unroll") for (int m = 0; m < 4; ++m) { PG8_MF(ai, bj, m, At, Bt); PG8_WRITEB1(b, 2 * m); PG8_WRITEB1(b, 2 * m + 1); PG8_SCHED; } __builtin_amdgcn_s_setprio(0); } while (0)
#define PG8_MMA_LD(ai, bj, At, Bt, pb) do { __builtin_amdgcn_s_setprio(1); _Pragma("unroll") for (int m = 0; m < 4; ++m) { PG8_MF(ai, bj, m, At, Bt); PG8_LOADB1(pb, 2 * m); PG8_LOADB1(pb, 2 * m + 1); PG8_SCHED; } __builtin_amdgcn_s_setprio(0); } while (0)
#define PG8_WAIT_V(n) asm volatile("s_waitcnt vmcnt(" #n ")" ::: "memory")
#define PG8_WAIT_L(n) asm volatile("s_waitcnt lgkmcnt(" #n ")" ::: "memory")
#define PG8_BAR __builtin_amdgcn_s_barrier()
#define PG8_SCHED __builtin_amdgcn_sched_barrier(0)
#define PG8_BS0(T) ((T) >= nt ? nb0 : cur.b0)
#define PG8_BS1(T) ((T) >= nt ? nb1 : cur.b1)
#define PG8_BT(T) ((T) >= nt ? (T) - nt : (T))
    UnitF cur, nxt; int ui = 0;
    if (!S.next(0, cur)) return;
    f32x4 acc[2][2][4][2];
#pragma unroll
    for (int a = 0; a < 2; ++a)
#pragma unroll
        for (int b = 0; b < 2; ++b)
#pragma unroll
            for (int m = 0; m < 4; ++m)
#pragma unroll
                for (int n = 0; n < 2; ++n) acc[a][b][m][n] = (f32x4){0.f, 0.f, 0.f, 0.f};
    bf16x8 At[4][2], B0[2][2], B1[2][2];
    f32x4 dreg[8];
    const char* cA = (const char*)g.A + (size_t)cur.rowA * g.lda * 2;
    PG8_STAGE(PG8_SA(0, 0), cA, voffA); PG8_STAGE(PG8_SA(0, 1), cA + hstepA, voffA); PG8_STAGE(PG8_SA(1, 0), cA + kstep, voffA);
    PG8_LOADB(cur.b0, cur.b1, 0); PG8_WRITEB(0); PG8_LOADB(cur.b0, cur.b1, 1); PG8_WRITEB(1); PG8_LOADB(cur.b0, cur.b1, 2);
    PG8_WAIT_V(8); PG8_WAIT_L(0);
    if (wr == 1) PG8_BAR;
    PG8_BAR;
    for (;;) {
        const bool has_next = S.next(ui + 1, nxt);
        const char* nA = has_next ? (const char*)g.A + (size_t)nxt.rowA * g.lda * 2 : cA;
        const float* nb0 = has_next ? nxt.b0 : cur.b0; const float* nb1 = has_next ? nxt.b1 : cur.b1;
        for (int t = 0; t < nt; t += 2) {
            const bool last = (t == nt - 2);
            const char* a1 = cA + (size_t)(t + 1) * kstep;
            const char* a2 = last ? nA : cA + (size_t)(t + 2) * kstep;
            const char* a3 = a2 + kstep;
            const char* pb3 = PG8_BPTR(PG8_BS0(t + 3), PG8_BS1(t + 3), PG8_BT(t + 3));
            const char* pb4 = PG8_BPTR(PG8_BS0(t + 4), PG8_BS1(t + 4), PG8_BT(t + 4));
            PG8_LDBT(B0, 0, 0); PG8_LDBT(B1, 0, 1); PG8_SCHED; PG8_LDA(At, 0, 0); PG8_STAGE(PG8_SA(1, 1), a1 + hstepA, voffA);
            PG8_WAIT_V(12); PG8_WAIT_L(0); PG8_SCHED; PG8_BAR; PG8_MMA(0, 0, At, B0); PG8_MMA(0, 1, At, B1); PG8_BAR; PG8_SCHED;
            PG8_LDA(At, 0, 1);
            PG8_WAIT_V(10); PG8_WAIT_L(0); PG8_SCHED; PG8_BAR; PG8_MMA_CVT(1, 0, At, B0, 0); PG8_STAGE(PG8_SA(0, 0), a2, voffA); PG8_MMA_LD(1, 1, At, B1, pb3); PG8_BAR; PG8_SCHED;
            PG8_LDBT(B0, 1, 0); PG8_LDBT(B1, 1, 1); PG8_SCHED; PG8_LDA(At, 1, 0); PG8_STAGE(PG8_SA(0, 1), a2 + hstepA, voffA);
            PG8_WAIT_V(12); PG8_WAIT_L(0); PG8_SCHED; PG8_BAR; PG8_MMA(0, 0, At, B0); PG8_MMA(0, 1, At, B1); PG8_BAR; PG8_SCHED;
            PG8_LDA(At, 1, 1);
            PG8_WAIT_V(10); PG8_WAIT_L(0); PG8_SCHED; PG8_BAR; PG8_MMA_CVT(1, 0, At, B0, 1); PG8_STAGE(PG8_SA(1, 0), a3, voffA); PG8_MMA_LD(1, 1, At, B1, pb4); PG8_BAR; PG8_SCHED;
        }
        if (wr == 0) PG8_BAR;
        E(acc, cur, wr, wc, fr, fq);
        if (!has_next) break;
#pragma unroll
        for (int a = 0; a < 2; ++a)
#pragma unroll
            for (int b = 0; b < 2; ++b)
#pragma unroll
                for (int m = 0; m < 4; ++m)
#pragma unroll
                    for (int n = 0; n < 2; ++n) acc[a][b][m][n] = (f32x4){0.f, 0.f, 0.f, 0.f};
        cur = nxt; cA = nA; ++ui;
        if (wr == 1) PG8_BAR;
    }
    PG8_WAIT_V(0);
    asm volatile("" :: "v"(dreg[0]), "v"(dreg[7]));
    PG8_BAR;
#undef PG8_SA
#undef PG8_SB
#undef PG8_STAGE
#undef PG8_LDA
#undef PG8_LDBT
#undef PG8_BPTR
#undef PG8_LOADB1
#undef PG8_LOADB
#undef PG8_WRITEB1
#undef PG8_WRITEB
#undef PG8_MF
#undef PG8_MMA
#undef PG8_MMA_CVT
#undef PG8_MMA_LD
#undef PG8_WAIT_V
#undef PG8_WAIT_L
#undef PG8_BAR
#undef PG8_SCHED
#undef PG8_BS0
#undef PG8_BS1
#undef PG8_BT
}
}

#define XB_TMO      128
#define XB_XCNT(j)  (256  + 64 * (j))
#define XB_XSUB(j)  (1280 + 64 * (j))
#define XB_XGEN(j)  (2304 + 64 * (j))
#define XB_TOP      3328
#define XB_TOPGEN   3392
#define XCD_BAR_WORDS 3456
#define XB_SPIN_CAP (1u << 18)
__device__ __forceinline__ unsigned xb_ld(unsigned* p)              { return __hip_atomic_load(p, __ATOMIC_RELAXED, __HIP_MEMORY_SCOPE_AGENT); }
__device__ __forceinline__ unsigned xb_add(unsigned* p, unsigned v) { return __hip_atomic_fetch_add(p, v, __ATOMIC_RELAXED, __HIP_MEMORY_SCOPE_AGENT); }
__device__ __forceinline__ unsigned xb_xcc_id() { return (unsigned)__builtin_amdgcn_s_getreg((3 << 11) | 20) & 0xFu; }
#define XB_SPIN(cond, bar) do { unsigned _sp = 0; while (cond) { __builtin_amdgcn_s_sleep(1); \
    if ((++_sp & 255u) == 0u) { if (xb_ld(&(bar)[XB_TMO])) break; if (_sp > XB_SPIN_CAP) { atomicAdd(&(bar)[XB_TMO], 1u); break; } } } } while (0)
struct XcdBarrier { unsigned* bar; unsigned x; volatile LAS unsigned* st; };
__device__ __forceinline__ XcdBarrier xcd_barrier_post(unsigned* bar, volatile LAS unsigned* st) {
    XcdBarrier b; b.bar = bar; b.x = xb_xcc_id(); b.st = st;
    if (threadIdx.x == 0) (void)xb_add(&bar[XB_XCNT(b.x)], 1u);
    return b;
}
__device__ __forceinline__ void xcd_barrier_complete(unsigned* bar, unsigned x, unsigned& nloc, unsigned& nx) {
    const unsigned G = gridDim.x * gridDim.y * gridDim.z;
    unsigned sum, cnt, mine, sp = 0u;
    for (;;) {
        sum = 0u; cnt = 0u; mine = 0u;
#pragma unroll
        for (unsigned j = 0; j < 16; ++j) { const unsigned c = xb_ld(&bar[XB_XCNT(j)]); sum += c; cnt += (c > 0u) ? 1u : 0u; mine = (j == x) ? c : mine; }
        if (sum == G) break;
        __builtin_amdgcn_s_sleep(1);
        if ((++sp & 255u) == 0u) { if (xb_ld(&bar[XB_TMO])) break; if (sp > XB_SPIN_CAP) { atomicAdd(&bar[XB_TMO], 1u); break; } }
    }
    nloc = mine > 0u ? mine : 1u; nx = cnt > 0u ? cnt : 1u;
}
__device__ __forceinline__ void xcd_barrier(const XcdBarrier& b) {
    asm volatile("s_waitcnt vmcnt(0)" ::: "memory");
    __syncthreads();
    if (threadIdx.x == 0) {
        unsigned* bar = b.bar;
        __builtin_amdgcn_s_waitcnt(0);
        unsigned nloc = b.st[0], nx = b.st[1];
        if (nloc == 0u) { xcd_barrier_complete(bar, b.x, nloc, nx); b.st[0] = nloc; b.st[1] = nx; }
        const unsigned old = xb_add(&bar[XB_XSUB(b.x)], 1u);
        const unsigned gen = old / nloc;
        if (old + 1u == (gen + 1u) * nloc) {
            __builtin_amdgcn_fence(__ATOMIC_RELEASE, "agent");
            asm volatile("s_waitcnt vmcnt(0)" ::: "memory");
            const unsigned og = xb_add(&bar[XB_TOP], 1u);
            const unsigned tg = og / nx;
            if (og + 1u == (tg + 1u) * nx) xb_add(&bar[XB_TOPGEN], 1u);
            else XB_SPIN(xb_ld(&bar[XB_TOPGEN]) == tg, bar);
            __builtin_amdgcn_fence(__ATOMIC_ACQUIRE, "agent");
            xb_add(&bar[XB_XGEN(b.x)], 1u);
            asm volatile("s_waitcnt vmcnt(0)" ::: "memory");
        } else {
            XB_SPIN(xb_ld(&bar[XB_XGEN(b.x)]) == gen, bar);
            __builtin_amdgcn_fence(__ATOMIC_ACQUIRE, "agent");
            asm volatile("s_waitcnt vmcnt(0)" ::: "memory");
        }
    }
    __syncthreads();
}

struct Args { const float* in[31]; float* out; unsigned char* ws; int ph_lo, ph_hi; };
enum { I_X = 0, I_NMG, I_WIN, I_MU, I_W0, I_W2, I_A0, I_A2, I_G2, I_KK, I_KA, I_RK, I_LNG, I_LNB, I_GWA2, I_GBA, I_GNG, I_BM, I_WBR, I_WBG, I_WOUT, I_NFG,
       I_WROUTER, I_BROUTER, I_WGATE, I_BGATE, I_WUP, I_BUP, I_WDOWN, I_BDOWN, I_NFINAL };
struct Frame {
    LAS unsigned char* lds; unsigned char* ws; unsigned* ctl;
    int tid, lane, wave, vcu, G;
};

__device__ __forceinline__ void tr_item(const float* W, int ldw, int nvalid, int k0, int n0, bf16* dst, int ldk, LAS float* scr, int lane) {
    const int c = lane & 31;
    const bool ok = (n0 + c) < nvalid;
#pragma unroll 8
    for (int i = 0; i < 32; ++i) { const int kk = 2 * i + (lane >> 5); scr[kk * 33 + c] = ok ? W[(size_t)(k0 + kk) * ldw + n0 + c] : 0.f; }
    LDS_WAIT(); asm volatile("" ::: "memory");
    const int c8 = lane & 7;
#pragma unroll
    for (int j = 0; j < 4; ++j) { const int n = (lane >> 3) + 8 * j; const LAS float* s = scr + (8 * c8) * 33 + n;
        v4u o; o.x = pk2(s[0 * 33], s[1 * 33]); o.y = pk2(s[2 * 33], s[3 * 33]); o.z = pk2(s[4 * 33], s[5 * 33]); o.w = pk2(s[6 * 33], s[7 * 33]);
        *(v4u*)(dst + (size_t)n * ldk + k0 + 8 * c8) = o; }
    LDS_WAIT(); asm volatile("" ::: "memory");
}
__device__ __forceinline__ void cv_load(const float* W, int ldw, int k0, int n0, int lane, f32x4 (&cr)[16]) {
    const unsigned laneoff = (unsigned)((lane >> 3) * ldw + n0 + 4 * (lane & 7)) * 4u;
#pragma unroll
    for (int i = 0; i < 16; ++i) { const char* rowp = (const char*)W + (size_t)(k0 + 8 * i) * ldw * 4; cr[i] = *(const f32x4*)(rowp + laneoff); }
}
__device__ __forceinline__ void cv_finish(const f32x4 (&cr)[16], int k0, unsigned char* dst, int ldk, LAS float* scr, int lane, float scale) {
    const int rr = lane >> 3, ch = lane & 7;
#pragma unroll
    for (int i = 0; i < 16; ++i) { LAS float* d = scr + (8 * i + rr) * 33 + 4 * ch; d[0] = cr[i].x * scale; d[1] = cr[i].y * scale; d[2] = cr[i].z * scale; d[3] = cr[i].w * scale; }
    LDS_WAIT(); asm volatile("" ::: "memory");
#pragma unroll
    for (int j = 0; j < 4; ++j) { const int n = rr + 8 * j; const LAS float* sp = scr + (16 * ch) * 33 + n;
        v4u o; o.x = pk4_fp8(sp[0 * 33], sp[1 * 33], sp[2 * 33], sp[3 * 33]); o.y = pk4_fp8(sp[4 * 33], sp[5 * 33], sp[6 * 33], sp[7 * 33]);
        o.z = pk4_fp8(sp[8 * 33], sp[9 * 33], sp[10 * 33], sp[11 * 33]); o.w = pk4_fp8(sp[12 * 33], sp[13 * 33], sp[14 * 33], sp[15 * 33]);
        *(v4u*)(dst + (size_t)n * ldk + k0 + 16 * ch) = o; }
    LDS_WAIT(); asm volatile("" ::: "memory");
}
__device__ __forceinline__ void cv_issue_dma(const float* W, int ldw, int k0, int n0, int lane, LAS float* scr) {
#pragma unroll
    for (int i = 0; i < 16; ++i) { const char* rowp = (const char*)W + (size_t)(k0 + 8 * i) * ldw * 4;
        const unsigned off = (unsigned)((lane >> 3) * ldw + n0 + 4 * ((lane & 7) ^ (i >> 1))) * 4u;
        __builtin_amdgcn_global_load_lds((const unsigned*)(rowp + off), (LAS unsigned*)(scr + i * 256), 16, 0, 2); }
}
__device__ __forceinline__ void cv_finish_dma(int k0, unsigned char* dst, int ldk, const LAS float* scr, int lane, float scale) {
    const int rr = lane >> 3, ch = lane & 7;
#pragma unroll
    for (int j = 0; j < 4; ++j) { const int n = rr + 8 * j; const LAS float* sp = scr + (16 * ch) * 32 + ((((n >> 2) ^ ch) << 2) | (n & 3));
        float f[16];
#pragma unroll
        for (int i = 0; i < 16; ++i) f[i] = sp[i * 32] * scale;
        v4u o; o.x = pk4_fp8(f[0], f[1], f[2], f[3]); o.y = pk4_fp8(f[4], f[5], f[6], f[7]); o.z = pk4_fp8(f[8], f[9], f[10], f[11]); o.w = pk4_fp8(f[12], f[13], f[14], f[15]);
        *(v4u*)(dst + (size_t)n * ldk + k0 + 16 * ch) = o; }
}
__device__ __forceinline__ void cvb_finish_dma(int k0, bf16* dst, int ldk, const LAS float* scr, int lane) {
    const int rr = lane >> 3, ch = lane & 7;
#pragma unroll
    for (int j = 0; j < 4; ++j) { const int n = rr + 8 * j; const LAS float* sp = scr + (16 * ch) * 32 + ((((n >> 2) ^ ch) << 2) | (n & 3));
        float f[16];
#pragma unroll
        for (int i = 0; i < 16; ++i) f[i] = sp[i * 32];
        v4u o0, o1; o0.x = pk2(f[0], f[1]); o0.y = pk2(f[2], f[3]); o0.z = pk2(f[4], f[5]); o0.w = pk2(f[6], f[7]); o1.x = pk2(f[8], f[9]); o1.y = pk2(f[10], f[11]); o1.z = pk2(f[12], f[13]); o1.w = pk2(f[14], f[15]);
        bf16* d = dst + (size_t)n * ldk + k0 + 16 * ch; *(v4u*)d = o0; *(v4u*)(d + 8) = o1; }
}
__device__ __forceinline__ void cvr_load(const float* W, int ldw, int k0, int n0, int lane, f32x4 (&cr)[16]) {
    const unsigned laneoff = (unsigned)((16 * (lane >> 3)) * ldw + n0 + 4 * (lane & 7)) * 4u;
#pragma unroll
    for (int i = 0; i < 16; ++i) { const char* rowp = (const char*)W + (size_t)(k0 + i) * ldw * 4; cr[i] = __builtin_nontemporal_load((const f32x4*)(rowp + laneoff)); }
}
__device__ __forceinline__ void cvr_store(const f32x4 (&cr)[16], int k0, unsigned char* dst, int ldk, int lane, float scale) {
    unsigned char* d = dst + (size_t)(4 * (lane & 7)) * ldk + k0 + 16 * (lane >> 3);
#pragma unroll
    for (int j = 0; j < 4; ++j) { v4u o;
        o.x = pk4_fp8(cr[0][j] * scale, cr[1][j] * scale, cr[2][j] * scale, cr[3][j] * scale); o.y = pk4_fp8(cr[4][j] * scale, cr[5][j] * scale, cr[6][j] * scale, cr[7][j] * scale);
        o.z = pk4_fp8(cr[8][j] * scale, cr[9][j] * scale, cr[10][j] * scale, cr[11][j] * scale); o.w = pk4_fp8(cr[12][j] * scale, cr[13][j] * scale, cr[14][j] * scale, cr[15][j] * scale);
        __builtin_nontemporal_store(o, (v4u*)(d + (size_t)j * ldk)); }
}
struct CvItem { const float* W; unsigned char* dst; int ldw, ldk, k0, n0; };
__device__ __forceinline__ CvItem cv_item(const Args& a, unsigned char* ws, int idx) {
    constexpr int I_EXP = (D / 128) * (FF / 32);
    int r = idx; const int mat = r / (NE * I_EXP); r -= mat * (NE * I_EXP); const int e = r / I_EXP; r -= e * I_EXP;
    const int kb = r / (FF / 32), nb = r % (FF / 32), n0 = 32 * nb;
    CvItem it; it.k0 = 128 * kb; it.n0 = n0;
    if (mat == 0) { it.W = a.in[I_WGATE] + (size_t)e * D * FF; it.ldw = FF; it.dst = ws + WS_WGU + ((size_t)e * 4096 + (n0 >> 7) * 256 + (n0 & 127)) * D; it.ldk = D; }
    else if (mat == 1) { it.W = a.in[I_WUP] + (size_t)e * D * FF; it.ldw = FF; it.dst = ws + WS_WGU + ((size_t)e * 4096 + (n0 >> 7) * 256 + 128 + (n0 & 127)) * D; it.ldk = D; }
    else { it.W = a.in[I_WDOWN] + (size_t)e * FF * D; it.ldw = D; it.dst = ws + WS_WD + ((size_t)e * 2048 + n0) * FF; it.ldk = FF; }
    return it;
}
constexpr int CV_ITEMS = 3 * NE * (D / 128) * (FF / 32);
constexpr int CVQ_CH = 4, CVQ_NCH = CV_ITEMS / CVQ_CH;
__device__ __forceinline__ unsigned cvq_issue(unsigned* q, int lane) { unsigned c = 0; if (lane == 0) c = __hip_atomic_fetch_add(q, 1u, RLX_AGENT); return c; }
__device__ __forceinline__ void rms_row_to_bf16(const float* xrow, const float* g, bf16* orow, int lane) {
    const f32x4* xr = (const f32x4*)xrow + lane; const f32x4* gr = (const f32x4*)g + lane;
    f32x4 v[8]; float s = 0.f;
#pragma unroll
    for (int j = 0; j < 8; ++j) { v[j] = __builtin_nontemporal_load(xr + 64 * j); s += (v[j].x * v[j].x + v[j].y * v[j].y) + (v[j].z * v[j].z + v[j].w * v[j].w); }
    const float rstd = rsqrtf(wave_sum(s) * (1.f / D) + NORM_EPS);
    v2u* o8 = (v2u*)orow + lane;
#pragma unroll
    for (int j = 0; j < 8; ++j) { const f32x4 gg = gr[64 * j]; v2u o; o.x = pk2(v[j].x * rstd * gg.x, v[j].y * rstd * gg.y); o.y = pk2(v[j].z * rstd * gg.z, v[j].w * rstd * gg.w); o8[64 * j] = o; }
}
constexpr int DT_NBF = IN_COLS / 32;
constexpr int DT_IN = (D / 128) * DT_NBF, DT_BA = (RW / 128) * (D / 32), DT_BB = DT_BA, DT_OUT = (D / 128) * (D / 32), DT_ALL = DT_IN + DT_BA + DT_BB + DT_OUT;
__device__ __forceinline__ void dense_tile(const Frame& F, const Args& a, int it, LAS float* t2) {
    bf16* Wt_in = (bf16*)(F.ws + WS_WIN); bf16* Wt_ba = (bf16*)(F.ws + WS_WBA); bf16* Wt_bb = (bf16*)(F.ws + WS_WBB); bf16* Wt_out = (bf16*)(F.ws + WS_WOUT);
    const float* W = nullptr; int ldw = 0, k0 = 0, n0 = 0, ldk = 0; bf16* dst = nullptr; int r = it;
    if (r < DT_IN) { const int kb = r / DT_NBF, nb = r % DT_NBF; W = a.in[I_WIN]; ldw = IN_COLS; k0 = 128 * kb; n0 = 32 * nb; dst = Wt_in + (size_t)n0 * DP; ldk = DP; }
    else if ((r -= DT_IN) < DT_BA) { const int kb = r / (D / 32), nb = r % (D / 32); W = a.in[I_WBR]; ldw = D; k0 = 128 * kb; n0 = 32 * nb; dst = Wt_ba + (size_t)n0 * RW; ldk = RW; }
    else if ((r -= DT_BA) < DT_BB) { const int kb = r / (D / 32), nb = r % (D / 32); W = a.in[I_WBG]; ldw = D; k0 = 128 * kb; n0 = 32 * nb; dst = Wt_bb + (size_t)n0 * GVW; ldk = GVW; }
    else { r -= DT_BB; const int kb = r / (D / 32), nb = r % (D / 32); W = a.in[I_WOUT]; ldw = D; k0 = 128 * kb; n0 = 32 * nb; dst = Wt_out + (size_t)n0 * D; ldk = D; }
    cv_issue_dma(W, ldw, k0, n0, F.lane, t2);
    asm volatile("s_waitcnt vmcnt(0)" ::: "memory");
    cvb_finish_dma(k0, dst, ldk, t2, F.lane); asm volatile("s_waitcnt lgkmcnt(0)" ::: "memory");
}
__device__ __forceinline__ void p0_prologue(const Frame& F, const Args& a) {
    LAS float* scr = (LAS float*)(F.lds + F.wave * 16896);
    const int gw = F.vcu * 8 + F.wave, NGW = F.G * 8;
    bf16* Wt_in = (bf16*)(F.ws + WS_WIN); bf16* Wt_ba = (bf16*)(F.ws + WS_WBA); bf16* Wt_bb = (bf16*)(F.ws + WS_WBB); bf16* Wt_out = (bf16*)(F.ws + WS_WOUT);
    constexpr int NB_IN = PLD / 32;
    constexpr int I_IN = (D / 64) * NB_IN, I_BA = (RW / 64) * (D / 32), I_BB = I_BA, I_OUT = (D / 64) * (D / 32);
    constexpr int NITEMS = I_IN + I_BA + I_BB + I_OUT;
    {
        constexpr int NBF = DT_NBF;
        LAS float* t2 = (LAS float*)(F.lds + F.wave * 16384);
        const int ntile = (F.G == 256) ? DT_IN : DT_ALL;
        for (int it = gw; it < ntile; it += NGW) dense_tile(F, a, it, t2);
        __syncthreads();
        for (int it = gw; it < (D / 64) * 2; it += NGW) { const int kb = it >> 1, nb = NBF + (it & 1); tr_item(a.in[I_WIN], IN_COLS, IN_COLS, 64 * kb, 32 * nb, Wt_in + (size_t)(32 * nb) * DP, DP, scr, F.lane); }
    }
    bf16* Hh = (bf16*)(F.ws + WS_H);
    for (int m = gw; m < T; m += NGW) rms_row_to_bf16(a.in[I_X] + (size_t)m * D, a.in[I_NMG], Hh + (size_t)m * DP, F.lane);
    const int gt = F.vcu * 512 + F.tid, NGT = F.G * 512;
    bf16* Wl_wa = (bf16*)(F.ws + WS_WLWA); bf16* Wl_g = (bf16*)(F.ws + WS_WLG);
    for (int i = gt; i < 2048 * 256; i += NGT) { const int n = i >> 8, k = i & 255; float v = 0.f;
        if (n < 1024) { if (k < DLORA) v = a.in[I_W2][(size_t)k * RW + n]; } else { if (k >= DLORA && k < 2 * DLORA) v = a.in[I_A2][(size_t)(k - DLORA) * RW + (n - 1024)]; }
        Wl_wa[i] = (bf16)f2bf(v); }
    for (int i = gt; i < 1024 * 256; i += NGT) { const int n = i >> 8, k = i & 255; Wl_g[i] = (bf16)f2bf(a.in[I_G2][(size_t)k * RW + n]); }
    float* Wr = (float*)(F.ws + WS_WR);
    for (int i = gt; i < 8 * 32 * 64 * 4; i += NGT) { const int ii = i & 3, l = (i >> 2) & 63, e = (i >> 8) & 31, j = i >> 13; const int k = 256 * j + 4 * l + ii;
        Wr[i] = a.in[I_NFG][k] * a.in[I_WROUTER][(size_t)k * NE + e]; }
}

__device__ __forceinline__ void cv_queue_run(const Frame& F, const Args& a, unsigned* stop) {
    unsigned* q = F.ctl + CW_CVQ; const int lane = F.lane;
    f32x4 ca[16], cb[16];
    int cur = __builtin_amdgcn_readfirstlane((int)cvq_issue(q, lane)); unsigned nraw = cvq_issue(q, lane); int pos = 0; bool stopped = false;
#define CVQ_NEXT(idx) do { if (pos == CVQ_CH) { cur = __builtin_amdgcn_readfirstlane((int)nraw); pos = 0; \
        if (stop && !stopped && __hip_atomic_load(stop, RLX_AGENT) != 0u) stopped = true; \
        nraw = stopped ? 0x7fffffffu : cvq_issue(q, lane); } \
        idx = cur < CVQ_NCH ? cur * CVQ_CH + pos++ : -1; } while (0)
    int xa, xb; CvItem ia, ib;
    CVQ_NEXT(xa); if (xa < 0) return;
    ia = cv_item(a, F.ws, xa); cvr_load(ia.W, ia.ldw, ia.k0, ia.n0, lane, ca);
    CVQ_NEXT(xb); ib = ia; if (xb >= 0) { ib = cv_item(a, F.ws, xb); cvr_load(ib.W, ib.ldw, ib.k0, ib.n0, lane, cb); }
    while (xa >= 0) {
        cvr_store(ca, ia.k0, ia.dst, ia.ldk, lane, WQ_SCALE);
        xa = -1; if (xb >= 0) { CVQ_NEXT(xa); if (xa >= 0) { ia = cv_item(a, F.ws, xa); cvr_load(ia.W, ia.ldw, ia.k0, ia.n0, lane, ca); } }
        if (xb >= 0) { cvr_store(cb, ib.k0, ib.dst, ib.ldk, lane, WQ_SCALE);
            xb = -1; if (xa >= 0) { CVQ_NEXT(xb); if (xb >= 0) { ib = cv_item(a, F.ws, xb); cvr_load(ib.W, ib.ldw, ib.k0, ib.n0, lane, cb); } } }
    }
#undef CVQ_NEXT
}
constexpr int CVW_SH = 3;
__device__ __forceinline__ void p1_gemm_in(const Frame& F, const Args& a) {
    const bool split = (F.G == 256);
    const int bx = (int)blockIdx.x, grp = bx >> 3;
    if (split && (grp & ((1 << CVW_SH) - 1)) == (1 << CVW_SH) - 1) {
        constexpr int NCW = (256 >> CVW_SH) * 8;
        const int cw = ((grp >> CVW_SH) * 8 + (bx & 7)) * 8 + F.wave; LAS float* t2 = (LAS float*)(F.lds + F.wave * 16384);
        for (int it = DT_IN + cw; it < DT_ALL; it += NCW) dense_tile(F, a, it, t2);
        cv_queue_run(F, a, F.ctl + CW_CVSTOP); return; }
    pg8::Gemm g{(const bf16*)(F.ws + WS_H), (const bf16*)(F.ws + WS_WIN), DP, DP, D, nullptr}; pg8::StaticOrder S;
    if (split) S.init(T, PLD, 256 - (256 >> CVW_SH), (grp - (grp >> CVW_SH)) * 8 + (bx & 7)); else S.init(T, PLD, F.G, bx);
    pg8::EpiBf16 E{(bf16*)(F.ws + WS_P), PLD, nullptr, 0, 1.f, F.lds};
    pg8::gemm_phase(F.lds, g, S, E);
    if (F.tid == 0) __hip_atomic_fetch_add(F.ctl + CW_CVSTOP, 1u, RLX_AGENT);
}
__device__ __forceinline__ void p2_lora_in(const Frame& F, const Args& a) {
    const int gw = F.vcu * 8 + F.wave, NGW = F.G * 8, lane = F.lane;
    const bf16* P = (const bf16*)(F.ws + WS_P); bf16* A2 = (bf16*)(F.ws + WS_A2);
    const int kind = lane < 12 ? 0 : (lane < 24 ? 1 : (lane < 32 ? 2 : 3));
    const int src = lane < 24 ? (C_WL + 8 * lane) : (C_GL + 8 * (lane - 32));
    float mu[8];
    if (kind != 2) {
#pragma unroll
        for (int j = 0; j < 8; ++j) mu[j] = a.in[I_MU][src + j];
    }
    for (int t = gw; t < T; t += NGW) {
        v4u o = {0u, 0u, 0u, 0u};
        if (kind != 2) {
            const v4u c = *(const v4u*)(P + (size_t)t * PLD + src);
            v4u pv = {0u, 0u, 0u, 0u};
            if ((t & (SEQ - 1)) != 0) pv = *(const v4u*)(P + (size_t)(t - 1) * PLD + src);
            float x[8] = {bflo(c.x), bfhi(c.x), bflo(c.y), bfhi(c.y), bflo(c.z), bfhi(c.z), bflo(c.w), bfhi(c.w)};
            float q[8] = {bflo(pv.x), bfhi(pv.x), bflo(pv.y), bfhi(pv.y), bflo(pv.z), bfhi(pv.z), bflo(pv.w), bfhi(pv.w)};
#pragma unroll
            for (int j = 0; j < 8; ++j) { float m = x[j] + (q[j] - x[j]) * mu[j]; x[j] = kind == 0 ? tanhf(m) : (kind == 1 ? m : sigmoidf_(m)); }
            o.x = pk2(x[0], x[1]); o.y = pk2(x[2], x[3]); o.z = pk2(x[4], x[5]); o.w = pk2(x[6], x[7]);
        }
        *(v4u*)(A2 + (size_t)t * 512 + 8 * lane) = o;
    }
}

#define DPPF(x, ctrl) __builtin_bit_cast(float, __builtin_amdgcn_update_dpp(0, __builtin_bit_cast(int, (x)), (ctrl), 0xF, 0xF, false))
__device__ __forceinline__ float dpp_sum16(float x) { x += DPPF(x, 0xB1); x += DPPF(x, 0x4E); x += DPPF(x, 0x141); x += DPPF(x, 0x140); return x; }
__device__ __forceinline__ float wave_sum_dpp(float x) {
    x = dpp_sum16(x); const int xi = __builtin_bit_cast(int, x);
    return (__builtin_bit_cast(float, __builtin_amdgcn_readlane(xi, 0)) + __builtin_bit_cast(float, __builtin_amdgcn_readlane(xi, 16))) +
           (__builtin_bit_cast(float, __builtin_amdgcn_readlane(xi, 32)) + __builtin_bit_cast(float, __builtin_amdgcn_readlane(xi, 48)));
}
__device__ __forceinline__ float quad_sum(float x) { x += DPPF(x, 0xB1); x += DPPF(x, 0x4E); return x; }
__device__ __forceinline__ void unpack8(const v4u u, float (&f)[8]) { f[0] = bflo(u.x); f[1] = bfhi(u.x); f[2] = bflo(u.y); f[3] = bfhi(u.y); f[4] = bflo(u.z); f[5] = bfhi(u.z); f[6] = bflo(u.w); f[7] = bfhi(u.w); }
__device__ __forceinline__ v4u pack8(const float (&f)[8]) { v4u u; u.x = pk2(f[0], f[1]); u.y = pk2(f[2], f[3]); u.z = pk2(f[4], f[5]); u.w = pk2(f[6], f[7]); return u; }
__device__ __forceinline__ void p4_rwkv_prep(const Frame& F, const Args& a) {
    const int gw = F.vcu * 8 + F.wave, NGW = F.G * 8, lane = F.lane;
    const bf16* P = (const bf16*)(F.ws + WS_P); const bf16* WA = (const bf16*)(F.ws + WS_WAO); bf16* SC = (bf16*)(F.ws + WS_SCAN); float* BON = (float*)(F.ws + WS_BON);
    const int h = lane >> 2, q = lane & 3, c0 = h * RN + 16 * q;
    for (int t = gw; t < T; t += NGW) {
        const bool first = (t & (SEQ - 1)) == 0;
        const bf16* pr = P + (size_t)t * PLD + c0; const bf16* pp = first ? pr : pr - PLD;
        v4u ur[2], uk[2], uv[2], ur1[2], uk1[2], uv1[2], uw[2], ua[2];
#pragma unroll
        for (int j = 0; j < 2; ++j) { ur[j] = *(const v4u*)(pr + C_R + 8 * j); uk[j] = *(const v4u*)(pr + C_K + 8 * j); uv[j] = *(const v4u*)(pr + C_V + 8 * j);
            ur1[j] = *(const v4u*)(pp + C_R + 8 * j); uk1[j] = *(const v4u*)(pp + C_K + 8 * j); uv1[j] = *(const v4u*)(pp + C_V + 8 * j);
            uw[j] = __builtin_nontemporal_load((const v4u*)(WA + (size_t)t * 2048 + c0 + 8 * j)); ua[j] = __builtin_nontemporal_load((const v4u*)(WA + (size_t)t * 2048 + 1024 + c0 + 8 * j)); }
        float r[2][8], k[2][8], v[2][8], kk[2][8], dec[2][8], aa[2][8];
        float n2 = 0.f;
#pragma unroll
        for (int j = 0; j < 2; ++j) { float x[8], x1[8], wv[8], av[8];
            unpack8(ur[j], x); unpack8(ur1[j], x1);
#pragma unroll
            for (int i = 0; i < 8; ++i) { const float m = a.in[I_MU][C_R + c0 + 8 * j + i]; r[j][i] = x[i] + ((first ? 0.f : x1[i]) - x[i]) * m; }
            unpack8(uk[j], x); unpack8(uk1[j], x1);
#pragma unroll
            for (int i = 0; i < 8; ++i) { const float m = a.in[I_MU][C_K + c0 + 8 * j + i]; k[j][i] = x[i] + ((first ? 0.f : x1[i]) - x[i]) * m; }
            unpack8(uv[j], x); unpack8(uv1[j], x1);
#pragma unroll
            for (int i = 0; i < 8; ++i) { const float m = a.in[I_MU][C_V + c0 + 8 * j + i]; v[j][i] = x[i] + ((first ? 0.f : x1[i]) - x[i]) * m; }
            unpack8(uw[j], wv); unpack8(ua[j], av);
#pragma unroll
            for (int i = 0; i < 8; ++i) { const int c = c0 + 8 * j + i;
                dec[j][i] = __expf(-0.60653066f * sigmoidf_(a.in[I_W0][c] + wv[i]));
                aa[j][i] = sigmoidf_(a.in[I_A0][c] + av[i]);
                const float kq = k[j][i] * a.in[I_KK][c]; kk[j][i] = kq; n2 += kq * kq; } }
        n2 = quad_sum(n2);
        const float inv = rsqrtf(fmaxf(n2, 1e-24f));
        float bon = 0.f; float o0[2][8], o2[2][8], o3[2][8];
#pragma unroll
        for (int j = 0; j < 2; ++j)
#pragma unroll
            for (int i = 0; i < 8; ++i) { const int c = c0 + 8 * j + i; const float kn = kk[j][i] * inv; const float kf = k[j][i] * (1.f + (aa[j][i] - 1.f) * a.in[I_KA][c]);
                o0[j][i] = -kn; o2[j][i] = kn * aa[j][i]; o3[j][i] = kf; bon += r[j][i] * kf * a.in[I_RK][c]; }
        bon = quad_sum(bon);
        const int bh = (t >> 11) * RH + h, ts = t & (SEQ - 1);
        bf16* o = SC + ((size_t)(bh * SEQ + ts) * 6) * 64 + 16 * q;
#pragma unroll
        for (int j = 0; j < 2; ++j) { *(v4u*)(o + 8 * j) = pack8(o0[j]); *(v4u*)(o + 64 + 8 * j) = pack8(dec[j]); *(v4u*)(o + 128 + 8 * j) = pack8(o2[j]);
            *(v4u*)(o + 192 + 8 * j) = pack8(o3[j]); *(v4u*)(o + 256 + 8 * j) = pack8(r[j]); *(v4u*)(o + 320 + 8 * j) = pack8(v[j]); }
        if (q == 0) BON[(size_t)t * RH + h] = bon;
    }
}
__device__ __forceinline__ void p5_rwkv_scan(const Frame& F, const Args& a) {
    constexpr int TB = 16, NBLK = SEQ / TB, STF = 384, BLKF = TB * STF;
    const bf16* SC = (const bf16*)(F.ws + WS_SCAN); float* YR = (float*)(F.ws + WS_YRAW);
    LAS float* buf = (LAS float*)F.lds;
    volatile LAS int* hs = (volatile LAS int*)(F.lds + MOE_OFF + 2048);
    const int lane = F.lane;
    for (int u = F.vcu; u < 256; u += F.G) {
        const int bh = u >> 2, vg = u & 3, b = bh >> 4, h = bh & 15;
        const int role = F.wave < 4 ? 0 : (F.wave == 4 ? 1 : 2);
        const int cw = F.wave - 5;
        const bf16* src = SC + (size_t)bh * SEQ * STF;
        const int rl = lane >> 4, kq = lane & 15, row = 16 * vg + 4 * F.wave + rl;
        __syncthreads();
        if (F.tid < 8) hs[F.tid] = 0;
        __syncthreads();
#define HS_WAIT(cond) do { unsigned sp_ = 0; while (!(cond)) { __builtin_amdgcn_s_sleep(1); if (++sp_ > (1u << 24)) break; } asm volatile("" ::: "memory"); } while (0)
        if (role == 1) {
            v4u xb[12];
            { const v4u* s4 = (const v4u*)src;
#pragma unroll
              for (int i = 0; i < 12; ++i) xb[i] = s4[lane + 64 * i]; }
            for (int m = 0; m < NBLK; ++m) {
                if (m >= 4) HS_WAIT(hs[1] >= m - 3 && hs[2] >= m - 3 && hs[3] >= m - 3 && hs[4] >= m - 3);
                LAS f32x4* d4 = (LAS f32x4*)(buf + (m & 3) * BLKF);
#pragma unroll
                for (int i = 0; i < 12; ++i) { const int c = lane + 64 * i;
                    d4[2 * c] = (f32x4){bflo(xb[i].x), bfhi(xb[i].x), bflo(xb[i].y), bfhi(xb[i].y)}; d4[2 * c + 1] = (f32x4){bflo(xb[i].z), bfhi(xb[i].z), bflo(xb[i].w), bfhi(xb[i].w)}; }
                asm volatile("s_waitcnt lgkmcnt(0)" ::: "memory");
                if (lane == 0) hs[0] = m + 1;
                if (m + 1 < NBLK) { const v4u* s4 = (const v4u*)(src + (size_t)(m + 1) * BLKF);
#pragma unroll
                    for (int i = 0; i < 12; ++i) xb[i] = s4[lane + 64 * i]; }
            }
        } else if (role == 2) {
            cv_queue_run(F, a, nullptr);
        } else {
            float S0 = 0.f, S1 = 0.f, S2 = 0.f, S3 = 0.f;
            for (int n = 0; n < NBLK; ++n) {
                HS_WAIT(hs[0] >= n + 1);
                const LAS float* bb = buf + (n & 3) * BLKF;
                float* yo = YR + ((size_t)(b * SEQ + n * TB)) * RW + h * RN + row;
                f32x4 al = *(const LAS f32x4*)(bb + 4 * kq), w = *(const LAS f32x4*)(bb + 64 + 4 * kq), be = *(const LAS f32x4*)(bb + 128 + 4 * kq);
                f32x4 kf = *(const LAS f32x4*)(bb + 192 + 4 * kq), r = *(const LAS f32x4*)(bb + 256 + 4 * kq); float vv = bb[320 + row];
                float ykeep = 0.f, yp = 0.f;
#pragma unroll
                for (int j = 0; j < TB; ++j) {
                    f32x4 al_n = al, w_n = w, be_n = be, kf_n = kf, r_n = r; float vv_n = vv;
                    if (j + 1 < TB) { const LAS float* st = bb + (j + 1) * STF;
                        al_n = *(const LAS f32x4*)(st + 4 * kq); w_n = *(const LAS f32x4*)(st + 64 + 4 * kq); be_n = *(const LAS f32x4*)(st + 128 + 4 * kq);
                        kf_n = *(const LAS f32x4*)(st + 192 + 4 * kq); r_n = *(const LAS f32x4*)(st + 256 + 4 * kq); vv_n = st[320 + row]; }
                    float sa = (S0 * al.x + S1 * al.y) + (S2 * al.z + S3 * al.w);
                    float yq = yp;
                    sa += DPPF(sa, 0xB1); if (j > 0) yq += DPPF(yq, 0xB1);
                    sa += DPPF(sa, 0x4E); if (j > 0) yq += DPPF(yq, 0x4E);
                    sa += DPPF(sa, 0x141); if (j > 0) yq += DPPF(yq, 0x141);
                    sa += DPPF(sa, 0x140); if (j > 0) yq += DPPF(yq, 0x140);
                    if (j > 0) ykeep = __builtin_bit_cast(float, __builtin_amdgcn_update_dpp(__builtin_bit_cast(int, yq), __builtin_bit_cast(int, ykeep), 0x111, 0xF, 0xF, false));
                    S0 = S0 * w.x + (sa * be.x + vv * kf.x); S1 = S1 * w.y + (sa * be.y + vv * kf.y);
                    S2 = S2 * w.z + (sa * be.z + vv * kf.z); S3 = S3 * w.w + (sa * be.w + vv * kf.w);
                    yp = (S0 * r.x + S1 * r.y) + (S2 * r.z + S3 * r.w);
                    al = al_n; w = w_n; be = be_n; kf = kf_n; r = r_n; vv = vv_n;
                }
                const float yl = dpp_sum16(yp);
                ykeep = __builtin_bit_cast(float, __builtin_amdgcn_update_dpp(__builtin_bit_cast(int, yl), __builtin_bit_cast(int, ykeep), 0x111, 0xF, 0xF, false));
                yo[(size_t)(TB - 1 - kq) * RW] = ykeep;
                asm volatile("s_waitcnt lgkmcnt(0)" ::: "memory");
                if (lane == 0) hs[1 + F.wave] = n + 1;
            }
            __builtin_amdgcn_s_setprio(0);
        }
#undef HS_WAIT
        __syncthreads();
    }
    if (F.G != 256) { LAS float* scr = (LAS float*)(F.lds + F.wave * 16896); __syncthreads();
        for (int it = F.vcu * 8 + F.wave; it < CV_ITEMS; it += F.G * 8) { const CvItem c2 = cv_item(a, F.ws, it); f32x4 c3[16]; cv_load(c2.W, c2.ldw, c2.k0, c2.n0, lane, c3); cv_finish(c3, c2.k0, c2.dst, c2.ldk, scr, lane, WQ_SCALE); } }
}

__device__ __forceinline__ void p6_rwkv_post(const Frame& F, const Args& a) {
    const int gw = F.vcu * 8 + F.wave, NGW = F.G * 8, lane = F.lane;
    const bf16* SC = (const bf16*)(F.ws + WS_SCAN); const float* YR = (const float*)(F.ws + WS_YRAW); const float* BON = (const float*)(F.ws + WS_BON);
    const bf16* GO = (const bf16*)(F.ws + WS_GO); bf16* YA = (bf16*)(F.ws + WS_YA);
    const int h = lane >> 2, q = lane & 3, c0 = h * RN + 16 * q;
    f32x4 lg[4], lb[4];
#pragma unroll
    for (int j = 0; j < 4; ++j) { lg[j] = *(const f32x4*)(a.in[I_LNG] + c0 + 4 * j); lb[j] = *(const f32x4*)(a.in[I_LNB] + c0 + 4 * j); }
    for (int t = gw; t < T; t += NGW) {
        const int bh = (t >> 11) * RH + h, ts = t & (SEQ - 1);
        f32x4 y[4]; v4u uv[2], ug[2];
#pragma unroll
        for (int j = 0; j < 4; ++j) y[j] = __builtin_nontemporal_load((const f32x4*)(YR + (size_t)t * RW + c0 + 4 * j));
#pragma unroll
        for (int j = 0; j < 2; ++j) { uv[j] = *(const v4u*)(SC + ((size_t)(bh * SEQ + ts) * 6 + 5) * 64 + 16 * q + 8 * j); ug[j] = *(const v4u*)(GO + (size_t)t * RW + c0 + 8 * j); }
        const float bo = BON[(size_t)t * RH + h];
        float s = 0.f;
#pragma unroll
        for (int j = 0; j < 4; ++j) s += (y[j].x + y[j].y) + (y[j].z + y[j].w);
        const float mean = quad_sum(s) * (1.f / RN);
        float s2 = 0.f;
#pragma unroll
        for (int j = 0; j < 4; ++j) { y[j] = y[j] - mean; s2 += (y[j].x * y[j].x + y[j].y * y[j].y) + (y[j].z * y[j].z + y[j].w * y[j].w); }
        const float rstd = rsqrtf(quad_sum(s2) * (1.f / RN) + GN_EPS);
        float vv[2][8], gg[2][8], o[2][8];
        unpack8(uv[0], vv[0]); unpack8(uv[1], vv[1]); unpack8(ug[0], gg[0]); unpack8(ug[1], gg[1]);
#pragma unroll
        for (int j = 0; j < 4; ++j)
#pragma unroll
            for (int i = 0; i < 4; ++i) o[j >> 1][4 * (j & 1) + i] = (y[j][i] * rstd * lg[j][i] + lb[j][i] + bo * vv[j >> 1][4 * (j & 1) + i]) * gg[j >> 1][4 * (j & 1) + i];
        *(v4u*)(YA + (size_t)t * RW + c0) = pack8(o[0]); *(v4u*)(YA + (size_t)t * RW + c0 + 8) = pack8(o[1]);
    }
}

constexpr int G_BC = 0;
constexpr int G_ALF = 32768;
constexpr int G_RED = 36864;
constexpr int G_TOT = 38912;
constexpr int G_QT = 40960;
constexpr int G_KT = 58368;
constexpr int G_VT = 76800;
constexpr int G_AT = 113664;
__device__ __forceinline__ void gla_bcum(const Frame& F, const Args& a, const bf16* P, int t0, int h) {
    LAS float* bc = (LAS float*)(F.lds + G_BC); LAS float* alf = (LAS float*)(F.lds + G_ALF); LAS float* tot = (LAS float*)(F.lds + G_TOT);
    const int tid = F.tid;
    __syncthreads();
    { const int j = tid >> 3, i2 = (tid & 7) * 2; const unsigned u = *(const unsigned*)(P + (size_t)(t0 + j) * PLD + C_GAL + i2); alf[j * 16 + i2] = bflo(u); alf[j * 16 + i2 + 1] = bfhi(u); }
    const int d = tid & 127, jq = tid >> 7, hd = h * GDK + d;
    float wv[16];
#pragma unroll
    for (int i = 0; i < 16; ++i) wv[i] = a.in[I_GWA2][(size_t)i * GKW + hd];
    const float bb = a.in[I_GBA][hd];
    __syncthreads();
    float run = 0.f;
    for (int jj = 0; jj < 16; ++jj) { const int j = jq * 16 + jj; float x = bb;
#pragma unroll
        for (int i = 0; i < 16; ++i) x += alf[j * 16 + i] * wv[i];
        run += -softplusf_(-x) * (1.f / 16.f); bc[j * 128 + d] = run; }
    tot[jq * 128 + d] = run;
    __syncthreads();
    float pre = 0.f;
    for (int q = 0; q < jq; ++q) pre += tot[q * 128 + d];
    if (jq > 0) { for (int jj = 0; jj < 16; ++jj) bc[(jq * 16 + jj) * 128 + d] += pre; }
    __syncthreads();
}
constexpr int G_VP = 264, G_KP = 136;
__device__ __forceinline__ void gla_stage_v(const Frame& F, const bf16* P, int t0, int h) {
    LAS bf16* VR = (LAS bf16*)(F.lds + G_VT);
    const int j = F.tid >> 3, e0 = (F.tid & 7) * 32;
    const bf16* src = P + (size_t)(t0 + j) * PLD + C_GV + h * GDV + e0;
#pragma unroll
    for (int q = 0; q < 4; ++q) *(LAS v4u*)(VR + j * G_VP + e0 + 8 * q) = *(const v4u*)(src + 8 * q);
}
typedef short s16x4g __attribute__((ext_vector_type(4)));
__device__ __forceinline__ bf16x8 tr_frag(const LAS bf16* img, int pitch, int row0, int col0, int lane) {
    const LAS bf16* p = img + (row0 + 8 * (lane >> 4) + ((lane & 15) >> 2)) * pitch + col0 + 4 * (lane & 3);
    const s16x4g lo = __builtin_amdgcn_ds_read_tr16_b64_v4i16((LAS s16x4g*)p);
    const s16x4g hi = __builtin_amdgcn_ds_read_tr16_b64_v4i16((LAS s16x4g*)(p + 4 * pitch));
    return __builtin_shufflevector(lo, hi, 0, 1, 2, 3, 4, 5, 6, 7);
}
#define MMA16(a_, b_, c_) __builtin_amdgcn_mfma_f32_16x16x32_bf16(a_, b_, c_, 0, 0, 0)
__device__ __forceinline__ void gla_pass_a(const Frame& F, const Args& a) {
    const bf16* P = (const bf16*)(F.ws + WS_P); bf16* HT = (bf16*)(F.ws + WS_GHT); float* DEC = (float*)(F.ws + WS_GDEC);
    LAS float* bc = (LAS float*)(F.lds + G_BC); LAS bf16* KH = (LAS bf16*)(F.lds + G_KT); LAS bf16* VR = (LAS bf16*)(F.lds + G_VT);
    const int fr = F.lane & 15, fq = F.lane >> 4;
    for (int it = F.vcu; it < BATCH * GH * NCH; it += F.G) {
        const int c = it & 31, h = (it >> 5) & 3, b = it >> 7, t0 = b * SEQ + c * CHUNK;
        gla_bcum(F, a, P, t0, h);
        if (F.tid < 128) DEC[(size_t)it * 128 + F.tid] = __expf(bc[63 * 128 + F.tid]);
        { f32x4* gbc = (f32x4*)(F.ws + WS_GBC) + (size_t)it * 2048;
#pragma unroll
          for (int i = 0; i < 4; ++i) gbc[F.tid + 512 * i] = ((const LAS f32x4*)bc)[F.tid + 512 * i]; }
        { const int j = F.tid >> 3, d0 = (F.tid & 7) * 16; const bf16* src = P + (size_t)(t0 + j) * PLD + C_GK + h * GDK + d0;
#pragma unroll
          for (int q = 0; q < 2; ++q) { const v4u u = *(const v4u*)(src + 8 * q); float kv[8]; unpack8(u, kv);
#pragma unroll
            for (int i = 0; i < 8; ++i) { const int d = d0 + 8 * q + i; kv[i] *= __expf(bc[63 * 128 + d] - bc[j * 128 + d]); }
            *(LAS v4u*)(KH + j * G_KP + d0 + 8 * q) = pack8(kv); } }
        gla_stage_v(F, P, t0, h);
        __syncthreads();
        f32x4 acc[8][2];
#pragma unroll
        for (int m = 0; m < 8; ++m)
#pragma unroll
            for (int n = 0; n < 2; ++n) acc[m][n] = (f32x4){0.f, 0.f, 0.f, 0.f};
#pragma unroll
        for (int ks = 0; ks < 2; ++ks) {
            bf16x8 vf[2];
#pragma unroll
            for (int n = 0; n < 2; ++n) vf[n] = tr_frag(VR, G_VP, ks * 32, F.wave * 32 + n * 16, F.lane);
#pragma unroll
            for (int m = 0; m < 8; ++m) { const bf16x8 kf = tr_frag(KH, G_KP, ks * 32, m * 16, F.lane);
#pragma unroll
                for (int n = 0; n < 2; ++n) acc[m][n] = MMA16(kf, vf[n], acc[m][n]); }
        }
        bf16* o = HT + (size_t)it * (GDV * GDK);
#pragma unroll
        for (int m = 0; m < 8; ++m)
#pragma unroll
            for (int n = 0; n < 2; ++n) { v2u pk; pk.x = pk2(acc[m][n][0], acc[m][n][1]); pk.y = pk2(acc[m][n][2], acc[m][n][3]); *(v2u*)(o + (size_t)(F.wave * 32 + n * 16 + fr) * GDK + m * 16 + 4 * fq) = pk; }
    }
}
__device__ __forceinline__ void gla_pass_b(const Frame& F, int lo, int hi, int wg, int nwg) {
    const bf16* HT = (const bf16*)(F.ws + WS_GHT); const float* DEC = (const float*)(F.ws + WS_GDEC); bf16* ST = (bf16*)(F.ws + WS_GST);
    const int gt = wg * 512 + F.tid, NGT = nwg * 512;
    for (int i = (lo >> 1) + gt; i < (hi >> 1); i += NGT) {
        const int bh = i >> 14, ed = (i & 16383) * 2, d = ed & 127;
        float s0 = 0.f, s1 = 0.f;
#pragma unroll 8
        for (int c = 0; c < NCH; ++c) { const size_t it = (size_t)bh * NCH + c;
            const unsigned hv = __builtin_nontemporal_load((const unsigned*)(HT + it * (GDV * GDK) + ed)); const float d0 = DEC[it * 128 + d], d1 = DEC[it * 128 + d + 1];
            *(unsigned*)(ST + it * (GDV * GDK) + ed) = pk2(s0, s1);
            s0 = s0 * d0 + bflo(hv); s1 = s1 * d1 + bfhi(hv); }
    }
}
__device__ __forceinline__ void gla_pass_c(const Frame& F, const Args& a) {
    const bf16* P = (const bf16*)(F.ws + WS_P); const bf16* ST = (const bf16*)(F.ws + WS_GST); bf16* YB = (bf16*)(F.ws + WS_YB);
    LAS float* bc = (LAS float*)(F.lds + G_BC); LAS float* red = (LAS float*)(F.lds + G_RED);
    LAS bf16* QT = (LAS bf16*)(F.lds + G_QT); LAS bf16* KT = (LAS bf16*)(F.lds + G_KT); LAS bf16* VR = (LAS bf16*)(F.lds + G_VT); LAS bf16* AT = (LAS bf16*)(F.lds + G_AT);
    const int fr = F.lane & 15, fq = F.lane >> 4, w = F.wave;
    const float scale = 0.08838834764831845f;
    for (int it = F.vcu; it < BATCH * GH * NCH; it += F.G) {
        const int c = it & 31, h = (it >> 5) & 3, b = it >> 7, t0 = b * SEQ + c * CHUNK;
        __syncthreads();
        { const f32x4* gbc = (const f32x4*)(F.ws + WS_GBC) + (size_t)it * 2048;
#pragma unroll
          for (int i = 0; i < 4; ++i) ((LAS f32x4*)bc)[F.tid + 512 * i] = gbc[F.tid + 512 * i]; }
        const bf16* Sg = ST + (size_t)it * (GDV * GDK);
        bf16x8 sfr[4][2];
#pragma unroll
        for (int ks = 0; ks < 4; ++ks)
#pragma unroll
            for (int n = 0; n < 2; ++n) sfr[ks][n] = *(const bf16x8*)(Sg + (size_t)(w * 32 + n * 16 + fr) * GDK + ks * 32 + fq * 8);
        f32x4 gng[2];
#pragma unroll
        for (int n = 0; n < 2; ++n) gng[n] = *(const f32x4*)(a.in[I_GNG] + w * 32 + n * 16 + 4 * fq);
        v2u ogu[4][2];
#pragma unroll
        for (int m = 0; m < 4; ++m)
#pragma unroll
            for (int n = 0; n < 2; ++n) ogu[m][n] = __builtin_nontemporal_load((const v2u*)(P + (size_t)(t0 + m * 16 + fr) * PLD + C_OG + h * GDV + w * 32 + n * 16 + 4 * fq));
        __syncthreads();
        { const int j = F.tid >> 3, d0 = (F.tid & 7) * 16;
          const bf16* sq = P + (size_t)(t0 + j) * PLD + C_GQ + h * GDK + d0; const bf16* sk = P + (size_t)(t0 + j) * PLD + C_GK + h * GDK + d0;
#pragma unroll
          for (int q = 0; q < 2; ++q) { const v4u uq = *(const v4u*)(sq + 8 * q), uk = *(const v4u*)(sk + 8 * q); float fq8[8], fk8[8]; unpack8(uq, fq8); unpack8(uk, fk8);
#pragma unroll
            for (int i = 0; i < 8; ++i) { const float bv = bc[j * 128 + d0 + 8 * q + i]; fq8[i] *= scale * __expf(bv); fk8[i] *= __expf(-bv); }
            *(LAS v4u*)(QT + j * 136 + d0 + 8 * q) = pack8(fq8); *(LAS v4u*)(KT + j * 136 + d0 + 8 * q) = pack8(fk8); } }
        gla_stage_v(F, P, t0, h);
        __syncthreads();
        { const int mt = w >> 1;
#pragma unroll
          for (int q = 0; q < 2; ++q) { const int nt = (w & 1) * 2 + q; f32x4 sacc = {0.f, 0.f, 0.f, 0.f};
            if (nt <= mt) {
#pragma unroll
                for (int ks = 0; ks < 4; ++ks) { const bf16x8 kfr = *(const LAS bf16x8*)(KT + (nt * 16 + fr) * 136 + ks * 32 + fq * 8); const bf16x8 qfr = *(const LAS bf16x8*)(QT + (mt * 16 + fr) * 136 + ks * 32 + fq * 8);
                    sacc = MMA16(kfr, qfr, sacc); } }
            const int i = mt * 16 + fr, j0 = nt * 16 + 4 * fq; float v4[4];
#pragma unroll
            for (int jj = 0; jj < 4; ++jj) v4[jj] = (j0 + jj <= i) ? sacc[jj] : 0.f;
            v2u pk; pk.x = pk2(v4[0], v4[1]); pk.y = pk2(v4[2], v4[3]); *(LAS v2u*)(AT + i * 72 + j0) = pk; } }
        __syncthreads();
        f32x4 acc[2][4];
#pragma unroll
        for (int n = 0; n < 2; ++n)
#pragma unroll
            for (int m = 0; m < 4; ++m) acc[n][m] = (f32x4){0.f, 0.f, 0.f, 0.f};
#pragma unroll
        for (int ks = 0; ks < 2; ++ks) {
            bf16x8 vf[2];
#pragma unroll
            for (int n = 0; n < 2; ++n) vf[n] = tr_frag(VR, G_VP, ks * 32, w * 32 + n * 16, F.lane);
#pragma unroll
            for (int m = 0; m < 4; ++m) { const bf16x8 af = *(const LAS bf16x8*)(AT + (m * 16 + fr) * 72 + ks * 32 + fq * 8);
#pragma unroll
                for (int n = 0; n < 2; ++n) acc[n][m] = MMA16(vf[n], af, acc[n][m]); }
        }
#pragma unroll
        for (int ks = 0; ks < 4; ++ks) {
#pragma unroll
            for (int m = 0; m < 4; ++m) { const bf16x8 qf = *(const LAS bf16x8*)(QT + (m * 16 + fr) * 136 + ks * 32 + fq * 8);
#pragma unroll
                for (int n = 0; n < 2; ++n) acc[n][m] = MMA16(sfr[ks][n], qf, acc[n][m]); }
        }
        float ssq[4];
#pragma unroll
        for (int m = 0; m < 4; ++m) { float ss = 0.f;
#pragma unroll
            for (int n = 0; n < 2; ++n) ss += (acc[n][m][0] * acc[n][m][0] + acc[n][m][1] * acc[n][m][1]) + (acc[n][m][2] * acc[n][m][2] + acc[n][m][3] * acc[n][m][3]);
            ss += __shfl_xor(ss, 16); ss += __shfl_xor(ss, 32); ssq[m] = ss;
            if (fq == 0) red[(m * 16 + fr) * 8 + w] = ss; }
        __syncthreads();
#pragma unroll
        for (int m = 0; m < 4; ++m) { const int i = m * 16 + fr; float tot = 0.f;
#pragma unroll
            for (int q = 0; q < 8; ++q) tot += red[i * 8 + q];
            const float rstd = rsqrtf(tot * (1.f / GDV) + NORM_EPS);
#pragma unroll
            for (int n = 0; n < 2; ++n) { const int e = w * 32 + n * 16 + 4 * fq;
                const float og[4] = {bflo(ogu[m][n].x), bfhi(ogu[m][n].x), bflo(ogu[m][n].y), bfhi(ogu[m][n].y)}; float r4[4];
#pragma unroll
                for (int jj = 0; jj < 4; ++jj) r4[jj] = acc[n][m][jj] * rstd * gng[n][jj] * (og[jj] * sigmoidf_(og[jj]));
                v2u pk; pk.x = pk2(r4[0], r4[1]); pk.y = pk2(r4[2], r4[3]); *(v2u*)(YB + (size_t)(t0 + i) * GVW + h * GDV + e) = pk; } }
    }
}

__device__ __forceinline__ void p11_router(const Frame& F, const Args& a) {
    const int lane = F.lane, w = F.wave;
    const float* X1 = (const float*)(F.ws + WS_X1); unsigned char* H2 = (unsigned char*)(F.ws + WS_H2); const float* Wr = (const float*)(F.ws + WS_WR);
    int* SEL_E = (int*)(F.ws + WS_ROUTE); float* SEL_W = (float*)(F.ws + WS_ROUTE + 256 * 1024); int* SEL_R = (int*)(F.ws + WS_ROUTE + 512 * 1024);
    volatile LAS int* hist = (volatile LAS int*)(F.lds + MOE_OFF + 1024); volatile LAS int* base = (volatile LAS int*)(F.lds + MOE_OFF + 1280);
    int* LIST = (int*)(F.ws + WS_ROUTE + 1024 * 1024);
    constexpr int RP = 36;
    LAS float* XL = (LAS float*)(F.lds + w * (2 * 32 * RP * 4)); LAS float* TL = XL + 32 * RP;
    LAS float* part = (LAS float*)(F.lds + 8 * (2 * 32 * RP * 4));
    LAS float* ssq = part + 8 * 1024;
    __syncthreads();
    if (F.tid < 32) hist[F.tid] = 0;
    __syncthreads();
    const int r = lane & 15, kq = lane >> 4, row8 = lane >> 3, seg = lane & 7;
    const int grp = lane >> 4, el = lane & 15;
    const float br0 = a.in[I_BROUTER][el], br1 = a.in[I_BROUTER][16 + el];
    for (int tile = F.vcu; tile < T / 32; tile += F.G) {
        const int tb = tile * 32;
        {
            const float* xg = X1 + (size_t)(tb + row8) * D + 256 * w + 4 * seg;
            const float* tg = Wr + (size_t)w * 8192 + row8 * 256 + 4 * seg;
            f32x4 acc[2][2]; float ssl[4] = {0.f, 0.f, 0.f, 0.f};
#pragma unroll
            for (int m = 0; m < 2; ++m)
#pragma unroll
                for (int n = 0; n < 2; ++n) acc[m][n] = (f32x4){0.f, 0.f, 0.f, 0.f};
            f32x4 gx[4], gt[4];
#pragma unroll
            for (int q = 0; q < 4; ++q) { gx[q] = *(const f32x4*)(xg + (size_t)(8 * q) * D); gt[q] = *(const f32x4*)(tg + (8 * q) * 256); }
#pragma unroll 1
            for (int c = 0; c < 8; ++c) {
#pragma unroll
                for (int q = 0; q < 4; ++q) { *(LAS f32x4*)(XL + (8 * q + row8) * RP + 4 * seg) = gx[q]; *(LAS f32x4*)(TL + (8 * q + row8) * RP + 4 * seg) = gt[q];
                    ssl[q] += (gx[q].x * gx[q].x + gx[q].y * gx[q].y) + (gx[q].z * gx[q].z + gx[q].w * gx[q].w); }
                if (c < 7) {
#pragma unroll
                    for (int q = 0; q < 4; ++q) { gx[q] = *(const f32x4*)(xg + (size_t)(8 * q) * D + 32 * (c + 1)); gt[q] = *(const f32x4*)(tg + (8 * q) * 256 + 32 * (c + 1)); } }
                f32x4 xa[2], xb[2], ba[2], bb[2];
#pragma unroll
                for (int m = 0; m < 2; ++m) { xa[m] = *(const LAS f32x4*)(XL + (16 * m + r) * RP + 8 * kq); xb[m] = *(const LAS f32x4*)(XL + (16 * m + r) * RP + 8 * kq + 4);
                    ba[m] = *(const LAS f32x4*)(TL + (16 * m + r) * RP + 8 * kq); bb[m] = *(const LAS f32x4*)(TL + (16 * m + r) * RP + 8 * kq + 4); }
#pragma unroll
                for (int i = 0; i < 4; ++i)
#pragma unroll
                    for (int m = 0; m < 2; ++m)
#pragma unroll
                        for (int n = 0; n < 2; ++n) acc[m][n] = __builtin_amdgcn_mfma_f32_16x16x4f32(xa[m][i], ba[n][i], acc[m][n], 0, 0, 0);
#pragma unroll
                for (int i = 0; i < 4; ++i)
#pragma unroll
                    for (int m = 0; m < 2; ++m)
#pragma unroll
                        for (int n = 0; n < 2; ++n) acc[m][n] = __builtin_amdgcn_mfma_f32_16x16x4f32(xb[m][i], bb[n][i], acc[m][n], 0, 0, 0);
            }
#pragma unroll
            for (int m = 0; m < 2; ++m)
#pragma unroll
                for (int j = 0; j < 4; ++j) { LAS float* pr = part + ((w * 32 + 16 * m + 4 * kq + j) * 32); pr[r] = acc[m][0][j]; pr[16 + r] = acc[m][1][j]; }
#pragma unroll
            for (int q = 0; q < 4; ++q) { float v = ssl[q]; v += __shfl_xor(v, 1); v += __shfl_xor(v, 2); v += __shfl_xor(v, 4); if (seg == 0) ssq[w * 32 + 8 * q + row8] = v; }
        }
        __syncthreads();
        {
            const int tk = 4 * w + grp;
            float sq = 0.f, p0 = 0.f, p1 = 0.f; const LAS float* pr = part + tk * 32;
#pragma unroll
            for (int k8 = 0; k8 < 8; ++k8) { sq += ssq[32 * k8 + tk]; p0 += pr[1024 * k8 + el]; p1 += pr[1024 * k8 + 16 + el]; }
            const float rstd = rsqrtf(sq * (1.f / D) + NORM_EPS);
            float c0 = p0 * rstd + br0, c1 = p1 * rstd + br1;
            float tv[4]; int ti[4];
#pragma unroll
            for (int k = 0; k < 4; ++k) { float bv = c0; int bi = el; if (c1 > c0) { bv = c1; bi = 16 + el; }
#pragma unroll
                for (int o = 1; o < 16; o <<= 1) { const float ov = __shfl_xor(bv, o); const int oi = __shfl_xor(bi, o); if (ov > bv || (ov == bv && oi < bi)) { bv = ov; bi = oi; } }
                tv[k] = bv; ti[k] = bi; if (bi == el) c0 = -3.0e38f; if (bi == 16 + el) c1 = -3.0e38f; }
            const float e1 = __expf(tv[1] - tv[0]), e2 = __expf(tv[2] - tv[0]), e3 = __expf(tv[3] - tv[0]); const float inv = 1.f / (1.f + e1 + e2 + e3);
            if (el < 4) { const int k = el; const float wk = (k == 0 ? 1.f : (k == 1 ? e1 : (k == 2 ? e2 : e3))) * inv; const int ek = (k == 0 ? ti[0] : (k == 1 ? ti[1] : (k == 2 ? ti[2] : ti[3])));
                const int lr = __hip_atomic_fetch_add((LAS int*)&hist[ek], 1, __ATOMIC_RELAXED, __HIP_MEMORY_SCOPE_WORKGROUP);
                SEL_E[(tb + tk) * 4 + k] = ek; SEL_W[(tb + tk) * 4 + k] = wk; SEL_R[(tb + tk) * 4 + k] = lr; }
        }
#pragma unroll
        for (int rr = 0; rr < 4; ++rr) { const int tk = 4 * w + rr;
            float sq = 0.f;
#pragma unroll
            for (int k8 = 0; k8 < 8; ++k8) sq += ssq[32 * k8 + tk];
            const float rstd = rsqrtf(sq * (1.f / D) + NORM_EPS);
            const f32x4* xr = (const f32x4*)(X1 + (size_t)(tb + tk) * D) + lane; unsigned* hr = (unsigned*)(H2 + (size_t)(tb + tk) * D) + lane;
#pragma unroll
            for (int j = 0; j < 8; ++j) { const f32x4 xv = __builtin_nontemporal_load(xr + 64 * j); const f32x4 gg = ((const f32x4*)a.in[I_NFG])[64 * j + lane];
                hr[64 * j] = pk4_fp8(xv.x * rstd * gg.x, xv.y * rstd * gg.y, xv.z * rstd * gg.z, xv.w * rstd * gg.w); } }
        __syncthreads();
    }
    if (F.tid < 32) base[F.tid] = (int)__hip_atomic_fetch_add(F.ctl + CW_CNT + F.tid, (unsigned)hist[F.tid], RLX_AGENT);
    __syncthreads();
    for (int tile = F.vcu; tile < T / 32; tile += F.G) {
        if (F.tid < 128) { const int tk = tile * 32 + (F.tid >> 2); const int idx = tk * 4 + (F.tid & 3);
            const int e_ = __hip_atomic_load(SEL_E + idx, RLX_AGENT); const int rk_ = __hip_atomic_load(SEL_R + idx, RLX_AGENT) + base[e_]; SEL_R[idx] = rk_; LIST[e_ * 8192 + rk_] = tk; }
    }
}
__device__ __forceinline__ void moe_tables(const Frame& F, int nct) {
    volatile LAS int* tab = (volatile LAS int*)(F.lds + MOE_OFF);
    __syncthreads();
    if (F.tid == 0) { int run = 0, units = 0;
        for (int e = 0; e < NE; ++e) { const int cnt = (int)__hip_atomic_load(F.ctl + CW_CNT + e, RLX_AGENT); const int nt = (cnt + 255) >> 8;
            tab[e] = units; tab[36 + e] = run * 256; tab[72 + e] = nt > 0 ? nt : 1; tab[108 + e] = cnt; run += nt; units += nt * nct; }
        tab[32] = units; }
    __syncthreads();
}
__device__ __forceinline__ void p12_scatter(const Frame& F) {
    const int gw = F.vcu * 8 + F.wave, NGW = F.G * 8, lane = F.lane;
    const unsigned char* H2 = (const unsigned char*)(F.ws + WS_H2); unsigned char* XS = (unsigned char*)(F.ws + WS_XS);
    const int* SEL_E = (const int*)(F.ws + WS_ROUTE); const int* SEL_R = (const int*)(F.ws + WS_ROUTE + 512 * 1024); int* DEST = (int*)(F.ws + WS_ROUTE + 768 * 1024);
    moe_tables(F, 1);
    volatile LAS int* tab = (volatile LAS int*)(F.lds + MOE_OFF);
    for (int it = gw; it < T * TOPK; it += NGW) {
        const int t = it >> 2; const int e = SEL_E[it], dest = tab[36 + e] + SEL_R[it];
        const v4u* s = (const v4u*)(H2 + (size_t)t * D) + lane; v4u* d = (v4u*)(XS + (size_t)dest * D) + lane;
        d[0] = s[0]; d[64] = s[64];
        if (lane == 0) DEST[it] = dest;
    }
}
__device__ __forceinline__ void p15_combine(const Frame& F, const Args& a) {
    const int gw = F.vcu * 8 + F.wave, NGW = F.G * 8, lane = F.lane;
    const float* X1 = (const float*)(F.ws + WS_X1); const bf16* Y = (const bf16*)(F.ws + WS_Y);
    const float* SEL_W = (const float*)(F.ws + WS_ROUTE + 256 * 1024); const int* SEL_E = (const int*)(F.ws + WS_ROUTE); const int* SEL_R = (const int*)(F.ws + WS_ROUTE + 512 * 1024);
    moe_tables(F, 1);
    volatile LAS int* tab = (volatile LAS int*)(F.lds + MOE_OFF);
    for (int t = gw; t < T; t += NGW) {
        f32x4 v[8];
        const f32x4* xr = (const f32x4*)(X1 + (size_t)t * D) + lane;
#pragma unroll
        for (int j = 0; j < 8; ++j) v[j] = __builtin_nontemporal_load(xr + 64 * j);
#pragma unroll
        for (int k = 0; k < 4; ++k) { const float wk = SEL_W[t * 4 + k]; const v2u* yr = (const v2u*)(Y + (size_t)(tab[36 + SEL_E[t * 4 + k]] + SEL_R[t * 4 + k]) * D) + lane;
#pragma unroll
            for (int j = 0; j < 8; ++j) { const v2u u = __builtin_nontemporal_load(yr + 64 * j); v[j].x += wk * bflo(u.x); v[j].y += wk * bfhi(u.x); v[j].z += wk * bflo(u.y); v[j].w += wk * bfhi(u.y); } }
        float s = 0.f;
#pragma unroll
        for (int j = 0; j < 8; ++j) s += (v[j].x * v[j].x + v[j].y * v[j].y) + (v[j].z * v[j].z + v[j].w * v[j].w);
        const float rstd = rsqrtf(wave_sum(s) * (1.f / D) + NORM_EPS);
        f32x4* o = (f32x4*)(a.out + (size_t)t * D) + lane;
#pragma unroll
        for (int j = 0; j < 8; ++j) { const f32x4 gg = ((const f32x4*)a.in[I_NFINAL])[64 * j + lane]; __builtin_nontemporal_store(v[j] * rstd * gg, o + 64 * j); }
    }
}

__global__ void __launch_bounds__(512, 2) __attribute__((amdgpu_num_sgpr(96))) fwd(Args args) {
    extern __shared__ __attribute__((aligned(16))) unsigned char lds[];
    Frame F;
    F.lds = (LAS unsigned char*)lds; F.ws = args.ws; F.ctl = (unsigned*)(args.ws + WS_CTL);
    F.tid = threadIdx.x; F.lane = F.tid & 63; F.wave = __builtin_amdgcn_readfirstlane(F.tid >> 6);
    F.G = gridDim.x; { const int bx = blockIdx.x; F.vcu = (F.G % 8 == 0) ? (bx % 8) * (F.G / 8) + bx / 8 : bx; }
    for (int u = F.tid; u < (LDS_BYTES - LDSCTL_OFF) / 4; u += 512) ((LAS unsigned*)(F.lds + LDSCTL_OFF))[u] = 0u;
    __syncthreads();
    volatile LAS unsigned* MISC = (volatile LAS unsigned*)(F.lds + MISC_OFF);
#if MK_PER_PHASE
#define GRID_BAR() do { } while (0)
#else
    XcdBarrier bar = xcd_barrier_post(F.ctl + CW_BAR, MISC + 8);
#define GRID_BAR() xcd_barrier(bar)
#endif
    const int lo = args.ph_lo, hi = args.ph_hi;
#define IN(k) (lo <= (k) && (k) < hi)
#define SEAM(k) do { if (IN(k) && IN((k) + 1)) GRID_BAR(); } while (0)
#define DUP(k) (((PROBE_DUP) >> (k)) & 1)
#define PH_BEGIN {
#define PH_END }
    const bf16* P = (const bf16*)(F.ws + WS_P);

    if (IN(0)) { PH_BEGIN  p0_prologue(F, args);  PH_END if (DUP(0)) { GRID_BAR(); PH_BEGIN  p0_prologue(F, args);  PH_END } } SEAM(0);
    if (IN(1)) { PH_BEGIN  p1_gemm_in(F, args);  PH_END if (DUP(1)) { GRID_BAR(); PH_BEGIN  p1_gemm_in(F, args);  PH_END } } SEAM(1);
    if (PROBE_GEMM >= 0 && IN(1)) {
        pg8::Gemm g{(const bf16*)(F.ws + WS_H), (const bf16*)(F.ws + WS_WIN), DP, DP, D, nullptr}; pg8::ProbeOrder S; S.so.init(T, PLD, F.G, (int)blockIdx.x); S.mode = PROBE_GEMM;
        pg8::EpiProbe E{(bf16*)(F.ws + WS_XS)}; pg8::gemm_phase(F.lds, g, S, E); GRID_BAR();
    }
    if (IN(2)) { PH_BEGIN  p2_lora_in(F, args); gla_pass_a(F, args);  PH_END if (DUP(2)) { GRID_BAR(); PH_BEGIN  p2_lora_in(F, args); gla_pass_a(F, args);  PH_END } } SEAM(2);
    if (IN(3)) { PH_BEGIN
        { pg8::Gemm g{(const bf16*)(F.ws + WS_A2), (const bf16*)(F.ws + WS_WLWA), 512, 256, 256, nullptr}; pg8::StaticOrder S; S.init(T, 2048, F.G, (int)blockIdx.x);
          pg8::EpiBf16 E{(bf16*)(F.ws + WS_WAO), 2048, nullptr, 0, 1.f, F.lds}; pg8::gemm_phase(F.lds, g, S, E); }
        { pg8::Gemm g{(const bf16*)(F.ws + WS_A2) + 256, (const bf16*)(F.ws + WS_WLG), 512, 256, 256, nullptr}; pg8::StaticOrder S; S.init(T, 1024, F.G, (int)blockIdx.x);
          pg8::EpiBf16 E{(bf16*)(F.ws + WS_GO), 1024, nullptr, 0, 1.f, F.lds}; pg8::gemm_phase(F.lds, g, S, E); }
        {
            constexpr int NEL = BATCH * GH * GDV * GDK, HEAD = (NEL / 4 / 65536) * 65536; const int bx = (int)blockIdx.x;
            if (F.G == 256) { if (bx >= 128) gla_pass_b(F, 0, HEAD, bx - 128, 128); gla_pass_b(F, HEAD, NEL, F.vcu, F.G); } else gla_pass_b(F, 0, NEL, F.vcu, F.G); }
     PH_END if (DUP(3)) { GRID_BAR(); PH_BEGIN
        { pg8::Gemm g{(const bf16*)(F.ws + WS_A2), (const bf16*)(F.ws + WS_WLWA), 512, 256, 256, nullptr}; pg8::StaticOrder S; S.init(T, 2048, F.G, (int)blockIdx.x);
          pg8::EpiBf16 E{(bf16*)(F.ws + WS_WAO), 2048, nullptr, 0, 1.f, F.lds}; pg8::gemm_phase(F.lds, g, S, E); }
        { pg8::Gemm g{(const bf16*)(F.ws + WS_A2) + 256, (const bf16*)(F.ws + WS_WLG), 512, 256, 256, nullptr}; pg8::StaticOrder S; S.init(T, 1024, F.G, (int)blockIdx.x);
          pg8::EpiBf16 E{(bf16*)(F.ws + WS_GO), 1024, nullptr, 0, 1.f, F.lds}; pg8::gemm_phase(F.lds, g, S, E); }
        {
            constexpr int NEL = BATCH * GH * GDV * GDK, HEAD = (NEL / 4 / 65536) * 65536; const int bx = (int)blockIdx.x;
            if (F.G == 256) { if (bx >= 128) gla_pass_b(F, 0, HEAD, bx - 128, 128); gla_pass_b(F, HEAD, NEL, F.vcu, F.G); } else gla_pass_b(F, 0, NEL, F.vcu, F.G); }
     PH_END } } SEAM(3);
    if (IN(4)) { PH_BEGIN  p4_rwkv_prep(F, args); gla_pass_c(F, args);  PH_END if (DUP(4)) { GRID_BAR(); PH_BEGIN  p4_rwkv_prep(F, args); gla_pass_c(F, args);  PH_END } } SEAM(4);
    if (IN(5)) { PH_BEGIN  p5_rwkv_scan(F, args);  PH_END if (DUP(5)) { GRID_BAR(); PH_BEGIN  p5_rwkv_scan(F, args);  PH_END } } SEAM(5);
    if (IN(6)) { PH_BEGIN  p6_rwkv_post(F, args);  PH_END if (DUP(6)) { GRID_BAR(); PH_BEGIN  p6_rwkv_post(F, args);  PH_END } } SEAM(6);
    if (IN(7)) { PH_BEGIN
        { pg8::Gemm g{(const bf16*)(F.ws + WS_YA), (const bf16*)(F.ws + WS_WBA), RW, RW, RW, nullptr}; pg8::StaticOrder S; S.init(T, D, F.G, (int)blockIdx.x);
          pg8::EpiGate<false> E{(bf16*)(F.ws + WS_MRG), P, args.in[I_BM], C_GATE, F.lds}; pg8::gemm_phase(F.lds, g, S, E); }
        { pg8::Gemm g{(const bf16*)(F.ws + WS_YB), (const bf16*)(F.ws + WS_WBB), GVW, GVW, GVW, nullptr}; pg8::StaticOrder S; S.init(T, D, F.G, (int)blockIdx.x);
          pg8::EpiGate<true> E{(bf16*)(F.ws + WS_MRG), P, args.in[I_BM] + D, C_GATE + D, F.lds}; pg8::gemm_phase(F.lds, g, S, E); }
     PH_END if (DUP(7)) { GRID_BAR(); PH_BEGIN
        { pg8::Gemm g{(const bf16*)(F.ws + WS_YA), (const bf16*)(F.ws + WS_WBA), RW, RW, RW, nullptr}; pg8::StaticOrder S; S.init(T, D, F.G, (int)blockIdx.x);
          pg8::EpiGate<false> E{(bf16*)(F.ws + WS_MRG), P, args.in[I_BM], C_GATE, F.lds}; pg8::gemm_phase(F.lds, g, S, E); }
        { pg8::Gemm g{(const bf16*)(F.ws + WS_YB), (const bf16*)(F.ws + WS_WBB), GVW, GVW, GVW, nullptr}; pg8::StaticOrder S; S.init(T, D, F.G, (int)blockIdx.x);
          pg8::EpiGate<true> E{(bf16*)(F.ws + WS_MRG), P, args.in[I_BM] + D, C_GATE + D, F.lds}; pg8::gemm_phase(F.lds, g, S, E); }
     PH_END } } SEAM(7);
    if (IN(8)) { PH_BEGIN
        pg8::Gemm g{(const bf16*)(F.ws + WS_MRG), (const bf16*)(F.ws + WS_WOUT), D, D, D, nullptr}; pg8::StaticOrder S; S.init(T, D, F.G, (int)blockIdx.x);
        pg8::EpiResF32 E{(float*)(F.ws + WS_X1), args.in[I_X], F.lds}; pg8::gemm_phase(F.lds, g, S, E);
     PH_END if (DUP(8)) { GRID_BAR(); PH_BEGIN
        pg8::Gemm g{(const bf16*)(F.ws + WS_MRG), (const bf16*)(F.ws + WS_WOUT), D, D, D, nullptr}; pg8::StaticOrder S; S.init(T, D, F.G, (int)blockIdx.x);
        pg8::EpiResF32 E{(float*)(F.ws + WS_X1), args.in[I_X], F.lds}; pg8::gemm_phase(F.lds, g, S, E);
     PH_END } } SEAM(8);
    if (IN(9)) { PH_BEGIN  p11_router(F, args);  PH_END if (DUP(9)) { GRID_BAR(); PH_BEGIN  p11_router(F, args);  PH_END } } SEAM(9);
    if (IN(10)) { PH_BEGIN
        moe_tables(F, 16);
        pg8::Gemm g{(const bf16*)(F.ws + WS_H2), (const bf16*)(F.ws + WS_WGU), D, D, D, (const int*)(F.ws + WS_ROUTE + 1024 * 1024)};
        pg8::MoeOrder S{(const volatile LAS int*)(F.lds + MOE_OFF), 16, 4096, F.G, F.vcu, false};
        pg8::EpiGluQ E{(unsigned char*)(F.ws + WS_HH), args.in[I_BGATE], args.in[I_BUP], F.lds}; pg8::gemm_phase<pg8::EpiGluQ, pg8::MoeOrder, 1, true>(F.lds, g, S, E);
     PH_END if (DUP(10)) { GRID_BAR(); PH_BEGIN
        moe_tables(F, 16);
        pg8::Gemm g{(const bf16*)(F.ws + WS_H2), (const bf16*)(F.ws + WS_WGU), D, D, D, (const int*)(F.ws + WS_ROUTE + 1024 * 1024)};
        pg8::MoeOrder S{(const volatile LAS int*)(F.lds + MOE_OFF), 16, 4096, F.G, F.vcu, false};
        pg8::EpiGluQ E{(unsigned char*)(F.ws + WS_HH), args.in[I_BGATE], args.in[I_BUP], F.lds}; pg8::gemm_phase<pg8::EpiGluQ, pg8::MoeOrder, 1, true>(F.lds, g, S, E);
     PH_END } } SEAM(10);
    if (IN(11)) { PH_BEGIN
        moe_tables(F, 8);
        pg8::Gemm g{(const bf16*)(F.ws + WS_HH), (const bf16*)(F.ws + WS_WD), FF, FF, FF, nullptr};
        pg8::MoeOrder S{(const volatile LAS int*)(F.lds + MOE_OFF), 8, 2048, F.G, F.vcu, true};
        pg8::EpiBf16H E{(bf16*)(F.ws + WS_Y), D, args.in[I_BDOWN], D, WQ_INV, F.lds}; pg8::gemm_phase<pg8::EpiBf16H, pg8::MoeOrder, 1, false, true, true>(F.lds, g, S, E);
     PH_END if (DUP(11)) { GRID_BAR(); PH_BEGIN
        moe_tables(F, 8);
        pg8::Gemm g{(const bf16*)(F.ws + WS_HH), (const bf16*)(F.ws + WS_WD), FF, FF, FF, nullptr};
        pg8::MoeOrder S{(const volatile LAS int*)(F.lds + MOE_OFF), 8, 2048, F.G, F.vcu, true};
        pg8::EpiBf16H E{(bf16*)(F.ws + WS_Y), D, args.in[I_BDOWN], D, WQ_INV, F.lds}; pg8::gemm_phase<pg8::EpiBf16H, pg8::MoeOrder, 1, false, true, true>(F.lds, g, S, E);
     PH_END } } SEAM(11);
    if (IN(12)) { PH_BEGIN  p15_combine(F, args);  PH_END if (DUP(12)) { GRID_BAR(); PH_BEGIN  p15_combine(F, args);  PH_END } }
#undef IN
#undef SEAM
}
constexpr int N_PHASES = 13;

extern "C" void kernel_launch(void* const* d_in, const int* in_sizes, int n_in, void* d_out, int out_size, void* d_ws, size_t ws_size, hipStream_t stream) {
    static int grid = 0;
    if (grid == 0) {
        if (n_in != 31 || in_sizes[0] != T * D || out_size != T * D || ws_size < WS_END) { fprintf(stderr, "kernel_launch: unexpected shapes (n_in %d, ws %zu)\n", n_in, ws_size); grid = -1; return; }
        int dev = 0, cus = 0, per_cu = 0;
        if (hipGetDevice(&dev) != hipSuccess || hipDeviceGetAttribute(&cus, hipDeviceAttributeMultiprocessorCount, dev) != hipSuccess) { grid = -1; return; }
        if (hipFuncSetAttribute((const void*)fwd, hipFuncAttributeMaxDynamicSharedMemorySize, LDS_BYTES) != hipSuccess) { fprintf(stderr, "kernel_launch: hipFuncSetAttribute failed\n"); grid = -1; return; }
        if (hipOccupancyMaxActiveBlocksPerMultiprocessor(&per_cu, (const void*)fwd, 512, LDS_BYTES) != hipSuccess || per_cu < 1) { fprintf(stderr, "kernel_launch: occupancy query says %d\n", per_cu); }
        (void)hipGetLastError();
        grid = cus;
    }
    if (grid < 0) return;
    (void)hipMemsetAsync((char*)d_ws + WS_CTL, 0, CTL_ZERO_BYTES, stream);
    Args a{};
    for (int i = 0; i < 31; ++i) a.in[i] = (const float*)d_in[i];
    a.out = (float*)d_out; a.ws = (unsigned char*)d_ws;
#if MK_PER_PHASE
    for (int p = 0; p < N_PHASES; ++p) { a.ph_lo = p; a.ph_hi = p + 1; hipLaunchKernelGGL(fwd, dim3(grid), dim3(512), LDS_BYTES, stream, a); }
#else
    a.ph_lo = 0; a.ph_hi = N_PHASES;
    hipLaunchKernelGGL(fwd, dim3(grid), dim3(512), LDS_BYTES, stream, a);
#endif
}
```

```cpp
#include <hip/hip_runtime.h>
#include <cstdio>
#include <cstdint>

#ifndef MK_PER_PHASE
#define MK_PER_PHASE 0
#endif

#ifndef PROBE_GEMM
#define PROBE_GEMM -1
#endif
#ifndef PROBE_DUP
#define PROBE_DUP 0
#endif
#define GAS __attribute__((address_space(1)))
#define LAS __attribute__((address_space(3)))
typedef unsigned short bf16;
typedef unsigned v4u __attribute__((ext_vector_type(4)));
typedef unsigned v2u __attribute__((ext_vector_type(2)));
typedef float f32x4 __attribute__((ext_vector_type(4)));
typedef float f32x2 __attribute__((ext_vector_type(2)));
typedef short bf16x8 __attribute__((ext_vector_type(8)));
typedef long i64x2 __attribute__((ext_vector_type(2)));
typedef int v4i __attribute__((ext_vector_type(4)));
typedef int v8i __attribute__((ext_vector_type(8)));
#define RLX_AGENT __ATOMIC_RELAXED, __HIP_MEMORY_SCOPE_AGENT
#define LDS_WAIT() asm volatile("s_waitcnt lgkmcnt(0)" ::: "memory")
#define VM_WAIT() asm volatile("s_waitcnt vmcnt(0)" ::: "memory")

constexpr int D = 2048, BATCH = 4, SEQ = 2048, T = BATCH * SEQ;
constexpr int RW = 1024, RH = 16, RN = 64;
constexpr int DLORA = 96, GLORA = 256;
constexpr int RWKV_COLS = 3 * RW + 2 * DLORA + GLORA;
constexpr int GH = 4, GDK = 128, GDV = 256, GKW = GH * GDK, GVW = GH * GDV, GAL = 16;
constexpr int GLA_COLS = 2 * GKW + 2 * GVW + GAL;
constexpr int IN_COLS = RWKV_COLS + GLA_COLS + 2 * D;
constexpr int PLD = 10752;
constexpr int DP = D + 64;
constexpr int C_R = 0, C_K = 1024, C_V = 2048, C_WL = 3072, C_AL = 3168, C_GL = 3264;
constexpr int C_GQ = 3520, C_GK = 4032, C_GV = 4544, C_OG = 5568, C_GAL = 6592, C_GATE = 6608;
constexpr int NE = 32, TOPK = 4, FF = 2048;
constexpr int XS_ROWS = T * TOPK + NE * 256;
constexpr int CHUNK = 64, NCH = SEQ / CHUNK;
constexpr float NORM_EPS = 1e-5f, GN_EPS = 64e-5f;
constexpr float WQ_SCALE = 64.f, WQ_INV = 1.f / 64.f;

constexpr size_t MiB = 1u << 20;
constexpr size_t WS_CTL = 0, CTL_ZERO_BYTES = 1 * MiB;
constexpr size_t WS_WR = 1 * MiB;
constexpr size_t WS_WLWA = 2 * MiB;
constexpr size_t WS_WLG = 3 * MiB;
constexpr size_t WS_WBA = 4 * MiB, WS_WBB = 8 * MiB;
constexpr size_t WS_WOUT = 12 * MiB;
constexpr size_t WS_WIN = 64 * MiB;
constexpr size_t WS_WGU = 192 * MiB;
constexpr size_t WS_WD = 448 * MiB;
constexpr size_t WS_H = 128 * MiB;
constexpr size_t WS_P = 864 * MiB;
constexpr size_t WS_Y = WS_P;
constexpr size_t WS_A2 = 1032 * MiB;
constexpr size_t WS_WAO = 1040 * MiB;
constexpr size_t WS_GO = 1072 * MiB;
constexpr size_t WS_SCAN = 1088 * MiB;
constexpr size_t WS_BON = 1200 * MiB;
constexpr size_t WS_YRAW = 1280 * MiB;
constexpr size_t WS_GHT = 1312 * MiB;
constexpr size_t WS_GST = 1376 * MiB;
constexpr size_t WS_GDEC = 1408 * MiB;
constexpr size_t WS_GBC = 576 * MiB;
constexpr size_t WS_YA = 1410 * MiB, WS_YB = 1426 * MiB;
constexpr size_t WS_MRG = 1442 * MiB;
constexpr size_t WS_X1 = 1474 * MiB;
constexpr size_t WS_H2 = 832 * MiB;
constexpr size_t WS_ROUTE = 1570 * MiB;
constexpr size_t WS_XS = 1572 * MiB;
constexpr size_t WS_HH = 1732 * MiB;
constexpr size_t WS_END = 1892 * MiB;
constexpr int CW_BAR = 4096;
constexpr int CW_CNT = 16384;
constexpr int CW_CVQ = 20480, CW_CVSTOP = 20544;

constexpr int RING_BYTES = 131072;
constexpr int LDSCTL_OFF = 159744, MISC_OFF = LDSCTL_OFF + 320;
constexpr int MOE_OFF = LDSCTL_OFF + 1024;
constexpr int LDS_BYTES = 163840;

__device__ __forceinline__ unsigned f2bf(float f) { unsigned u = __builtin_bit_cast(unsigned, f); return (u + 0x7fffu + ((u >> 16) & 1u)) >> 16; }
__device__ __forceinline__ unsigned pk2(float lo, float hi) { return f2bf(lo) | (f2bf(hi) << 16); }
__device__ __forceinline__ unsigned pk4_fp8(float a, float b, float c, float d) { int w = 0; w = __builtin_amdgcn_cvt_pk_fp8_f32(a, b, w, false); w = __builtin_amdgcn_cvt_pk_fp8_f32(c, d, w, true); return (unsigned)w; }
__device__ __forceinline__ float bflo(unsigned u) { return __builtin_bit_cast(float, u << 16); }
__device__ __forceinline__ float bfhi(unsigned u) { return __builtin_bit_cast(float, u & 0xffff0000u); }
__device__ __forceinline__ float bf2f(bf16 b) { return __builtin_bit_cast(float, ((unsigned)b) << 16); }
__device__ __forceinline__ float wave_sum(float v) {
#pragma unroll
    for (int o = 1; o < 64; o <<= 1) v += __shfl_xor(v, o);
    return v;
}
__device__ __forceinline__ float sigmoidf_(float x) { return 1.f / (1.f + __expf(-x)); }
__device__ __forceinline__ float softplusf_(float x) { return fmaxf(x, 0.f) + log1pf(__expf(-fabsf(x))); }

namespace pg8 {
constexpr int RING_BYTES_ = 131072;
constexpr int BM = 256, BK = 64, HALF = 128, HTB = HALF * BK * 2, STAGE_BYTES = 8 * HTB, NXCD = 8, WGM = 8;
__host__ __device__ __forceinline__ int lds_byte(int r, int c) { return r * 128 + (((c >> 3) ^ ((r >> 1) & 7)) << 4) + (c & 7) * 2; }
__host__ __device__ __forceinline__ void stage_rc(int b, int& R, int& C) { R = b >> 7; C = ((((b & 127) >> 4) ^ ((R >> 1) & 7)) << 3); }
__host__ __device__ __forceinline__ int perm32(int rho) { const int n = rho >> 4, i = rho & 15; return 8 * (i >> 2) + 4 * n + (i & 3); }

struct Unit { int rowA, rowB, pn, e, rk0, cnt, hn; };
struct Gemm { const bf16* A; const bf16* Bt; int lda, ldb, K; const int* list; };

struct StaticOrder {
    int nM, nN, nwg, G, c;
    __device__ void init(int M, int N, int G_, int c_) { nM = M / BM; nN = N / BM; nwg = nM * nN; G = G_; c = c_; }
    __device__ bool next(int i, Unit& u) const {
        const long L = (long)i * G + c; if (L >= nwg) return false;
        int wgid = (int)L; { const int q = nwg / NXCD, r = nwg % NXCD, xcd = wgid % NXCD, off = wgid / NXCD; wgid = (xcd < r ? xcd * (q + 1) : r * (q + 1) + (xcd - r) * q) + off; }
        const int nig = WGM * nN, gid = wgid / nig, fm = gid * WGM, gsz = (nM - fm) < WGM ? (nM - fm) : WGM;
        const int pm = fm + ((wgid % nig) % gsz); u.pn = (wgid % nig) / gsz; u.rowA = pm * BM; u.rowB = u.pn * BM; u.e = 0; u.rk0 = 0; u.cnt = 0; u.hn = 0; return true;
    }
};
struct ProbeOrder {
    StaticOrder so; int mode;
    __device__ bool next(int i, Unit& u) const { if (!so.next(i, u)) return false; u.e = (u.rowA >> 8) * 64 + u.pn; if (mode & 1) u.rowA = 0; if (mode & 2) u.rowB = 0; return true; }
};
struct MoeOrder {
    const volatile LAS int* tab; int nct, rowsB, G, c;
    bool nsplit;
    __device__ bool next(int i, Unit& u) const {
        int L = i * G + c; const int total = __builtin_amdgcn_readfirstlane(tab[32]); int hn = 0;
        if (nsplit) { const int rf = (total / G) * G, r = total - rf;
            if (r > 0 && 2 * r <= G && L >= rf) { const int j = L - rf; if (j >= 2 * r) return false; L = rf + (j >> 1); hn = 1 + (j & 1); } }
        if (L >= total) return false;
        u.hn = hn;
        const int ln = (int)(threadIdx.x & 63);
        const int cumv = tab[1 + (ln < 31 ? ln : 31)];
        const int e = __popcll(__ballot(ln < 31 && L >= cumv));
        const int local = L - __builtin_amdgcn_readfirstlane(tab[e]); const int nt = __builtin_amdgcn_readfirstlane(tab[72 + e]);
        const int ct = local / nt, rt = local - ct * nt;
        u.rowA = __builtin_amdgcn_readfirstlane(tab[36 + e]) + rt * BM; u.rowB = e * rowsB + ct * BM + (hn == 2 ? HALF : 0); u.pn = ct; u.e = e; u.rk0 = rt * BM; u.cnt = __builtin_amdgcn_readfirstlane(tab[108 + e]); return true;
    }
};

__device__ __forceinline__ unsigned cvt_pk_bf16(float lo, float hi) { unsigned r; asm volatile("v_cvt_pk_bf16_f32 %0, %1, %2" : "=v"(r) : "v"(lo), "v"(hi)); return r; }

__device__ __forceinline__ void epi_stage(LAS unsigned char* lds, int wave, int fr, int fq, const f32x4& a0, const f32x4& a1, f32x4& v0, f32x4& v1) {
    LAS float* t = (LAS float*)(lds + RING_BYTES_ + wave * (16 * 36 * 4));
    const int lane = fr + 16 * fq;
    *(LAS f32x4*)(t + fr * 36 + 8 * fq) = a0; *(LAS f32x4*)(t + fr * 36 + 8 * fq + 4) = a1;
    v0 = *(const LAS f32x4*)(t + (lane >> 2) * 36 + 8 * (lane & 3)); v1 = *(const LAS f32x4*)(t + (lane >> 2) * 36 + 8 * (lane & 3) + 4);
}
struct EpiBf16 {
    static constexpr bool PERM = true;
    bf16* O; int ldc; const float* bias; int bias_estride; float scale; LAS unsigned char* lds;
    __device__ __forceinline__ void operator()(const f32x4 (&acc)[2][2][4][2], const Unit& u, int wr, int wc, int fr, int fq) const {
        const int lane = fr + 16 * fq, wave = wr * 4 + wc;
        const int row0 = u.rowA + wr * 64 + (lane >> 2), col0 = u.pn * BM + wc * 32 + 8 * (lane & 3);
        f32x4 bv[2][2];
#pragma unroll
        for (int bj = 0; bj < 2; ++bj)
#pragma unroll
            for (int n = 0; n < 2; ++n) bv[bj][n] = bias ? *(const f32x4*)(bias + (size_t)u.e * bias_estride + col0 + bj * HALF + 4 * n) : (f32x4){0.f, 0.f, 0.f, 0.f};
#pragma unroll
        for (int ai = 0; ai < 2; ++ai)
#pragma unroll
            for (int m = 0; m < 4; ++m) { bf16* rowp = O + (size_t)(row0 + ai * HALF + m * 16) * ldc + col0;
#pragma unroll
                for (int bj = 0; bj < 2; ++bj) { f32x4 v0, v1; epi_stage(lds, wave, fr, fq, acc[ai][bj][m][0], acc[ai][bj][m][1], v0, v1);
                    v0 = v0 * scale + bv[bj][0]; v1 = v1 * scale + bv[bj][1];
                    v4u w; w.x = cvt_pk_bf16(v0[0], v0[1]); w.y = cvt_pk_bf16(v0[2], v0[3]); w.z = cvt_pk_bf16(v1[0], v1[1]); w.w = cvt_pk_bf16(v1[2], v1[3]);
                    *(v4u*)(rowp + bj * HALF) = w; } }
    }
};
struct EpiBf16H {
    static constexpr bool PERM = true;
    bf16* O; int ldc; const float* bias; int bias_estride; float scale; LAS unsigned char* lds;
    __device__ __forceinline__ void operator()(const f32x4 (&acc)[2][2][4][2], const Unit& u, int wr, int wc, int fr, int fq) const {
        const int lane = fr + 16 * fq, wave = wr * 4 + wc;
        const int row0 = u.rowA + wr * 64 + (lane >> 2), col0 = u.pn * BM + wc * 32 + 8 * (lane & 3) + (u.hn == 2 ? HALF : 0);
#pragma unroll
        for (int bj = 0; bj < 2; ++bj) { if (bj == 1 && u.hn != 0) break;
            f32x4 bv[2];
#pragma unroll
            for (int n = 0; n < 2; ++n) bv[n] = *(const f32x4*)(bias + (size_t)u.e * bias_estride + col0 + bj * HALF + 4 * n);
#pragma unroll
            for (int ai = 0; ai < 2; ++ai)
#pragma unroll
                for (int m = 0; m < 4; ++m) { bf16* rowp = O + (size_t)(row0 + ai * HALF + m * 16) * ldc + col0;
                    f32x4 v0, v1; epi_stage(lds, wave, fr, fq, acc[ai][bj][m][0], acc[ai][bj][m][1], v0, v1);
                    v0 = v0 * scale + bv[0]; v1 = v1 * scale + bv[1];
                    v4u w; w.x = cvt_pk_bf16(v0[0], v0[1]); w.y = cvt_pk_bf16(v0[2], v0[3]); w.z = cvt_pk_bf16(v1[0], v1[1]); w.w = cvt_pk_bf16(v1[2], v1[3]);
                    *(v4u*)(rowp + bj * HALF) = w; } }
    }
};
struct EpiProbe {
    static constexpr bool PERM = true;
    bf16* O;
    __device__ __forceinline__ void operator()(const f32x4 (&acc)[2][2][4][2], const Unit& u, int wr, int wc, int fr, int fq) const {
        const int pm = u.e >> 6, pn = u.e & 63; const int row0 = pm * BM + wr * 64 + fr, col0 = pn * BM + wc * 32 + 8 * fq;
#pragma unroll
        for (int ai = 0; ai < 2; ++ai)
#pragma unroll
            for (int m = 0; m < 4; ++m) { bf16* rowp = O + (size_t)(row0 + ai * HALF + m * 16) * PLD + col0;
#pragma unroll
                for (int bj = 0; bj < 2; ++bj) { const f32x4 v0 = acc[ai][bj][m][0], v1 = acc[ai][bj][m][1];
                    v4u w; w.x = cvt_pk_bf16(v0[0], v0[1]); w.y = cvt_pk_bf16(v0[2], v0[3]); w.z = cvt_pk_bf16(v1[0], v1[1]); w.w = cvt_pk_bf16(v1[2], v1[3]);
                    *(v4u*)(rowp + bj * HALF) = w; } }
    }
};
template <bool ADD> struct EpiGate {
    static constexpr bool PERM = true;
    bf16* O; const bf16* P; const float* bm; int gcol; LAS unsigned char* lds;
    __device__ __forceinline__ void operator()(const f32x4 (&acc)[2][2][4][2], const Unit& u, int wr, int wc, int fr, int fq) const {
        const int lane = fr + 16 * fq, wave = wr * 4 + wc;
        const int row0 = u.rowA + wr * 64 + (lane >> 2), col0 = u.pn * BM + wc * 32 + 8 * (lane & 3);
        f32x4 bv[2][2];
#pragma unroll
        for (int bj = 0; bj < 2; ++bj)
#pragma unroll
            for (int n = 0; n < 2; ++n) bv[bj][n] = *(const f32x4*)(bm + col0 + bj * HALF + 4 * n);
#pragma unroll
        for (int ai = 0; ai < 2; ++ai)
#pragma unroll
            for (int m = 0; m < 4; ++m) { const size_t row = (size_t)(row0 + ai * HALF + m * 16);
#pragma unroll
                for (int bj = 0; bj < 2; ++bj) {
                    const v4u pg = *(const v4u*)(P + row * PLD + gcol + col0 + bj * HALF);
                    bf16* op = O + row * D + col0 + bj * HALF;
                    v4u pv = {0u, 0u, 0u, 0u}; if (ADD) pv = *(const v4u*)op;
                    f32x4 v0, v1; epi_stage(lds, wave, fr, fq, acc[ai][bj][m][0], acc[ai][bj][m][1], v0, v1);
                    float g[8] = {bflo(pg.x), bfhi(pg.x), bflo(pg.y), bfhi(pg.y), bflo(pg.z), bfhi(pg.z), bflo(pg.w), bfhi(pg.w)};
                    float r[8];
#pragma unroll
                    for (int j = 0; j < 4; ++j) { r[j] = sigmoidf_(g[j] + bv[bj][0][j]) * v0[j]; r[4 + j] = sigmoidf_(g[4 + j] + bv[bj][1][j]) * v1[j]; }
                    if (ADD) { r[0] += bflo(pv.x); r[1] += bfhi(pv.x); r[2] += bflo(pv.y); r[3] += bfhi(pv.y); r[4] += bflo(pv.z); r[5] += bfhi(pv.z); r[6] += bflo(pv.w); r[7] += bfhi(pv.w); }
                    v4u w; w.x = cvt_pk_bf16(r[0], r[1]); w.y = cvt_pk_bf16(r[2], r[3]); w.z = cvt_pk_bf16(r[4], r[5]); w.w = cvt_pk_bf16(r[6], r[7]);
                    *(v4u*)op = w; } }
    }
};
struct EpiResF32 {
    static constexpr bool PERM = false;
    float* O; const float* X; LAS unsigned char* lds;
    __device__ __forceinline__ void operator()(const f32x4 (&acc)[2][2][4][2], const Unit& u, int wr, int wc, int fr, int fq) const {
        constexpr int RP = 36;
        LAS float* t = (LAS float*)(lds + RING_BYTES_ + (wr * 4 + wc) * (16 * RP * 4));
        const int lane = fr + 16 * fq, row8 = lane >> 3, seg = lane & 7;
        const int row0 = u.rowA + wr * 64, col0 = u.pn * BM + wc * 32;
#pragma unroll
        for (int ai = 0; ai < 2; ++ai)
#pragma unroll
            for (int m = 0; m < 4; ++m)
#pragma unroll
                for (int bj = 0; bj < 2; ++bj) {
                    const size_t go = (size_t)(row0 + ai * HALF + m * 16 + row8) * D + col0 + bj * HALF + 4 * seg;
                    const f32x4 x0 = __builtin_nontemporal_load((const f32x4*)(X + go)), x1 = __builtin_nontemporal_load((const f32x4*)(X + go + (size_t)8 * D));
                    *(LAS f32x4*)(t + fr * RP + 4 * fq) = acc[ai][bj][m][0]; *(LAS f32x4*)(t + fr * RP + 16 + 4 * fq) = acc[ai][bj][m][1];
                    const f32x4 v0 = *(const LAS f32x4*)(t + row8 * RP + 4 * seg), v1 = *(const LAS f32x4*)(t + (8 + row8) * RP + 4 * seg);
                    *(f32x4*)(O + go) = v0 + x0; *(f32x4*)(O + go + (size_t)8 * D) = v1 + x1;
                }
    }
};
struct EpiGlu {
    static constexpr bool PERM = true;
    bf16* O; const float* bg; const float* bu;
    __device__ __forceinline__ void operator()(const f32x4 (&acc)[2][2][4][2], const Unit& u, int wr, int wc, int fr, int fq) const {
        const int row0 = u.rowA + wr * 64 + fr, col0 = u.pn * HALF + wc * 32 + 8 * fq;
        f32x4 gb[2], ub[2];
#pragma unroll
        for (int n = 0; n < 2; ++n) { gb[n] = *(const f32x4*)(bg + (size_t)u.e * FF + col0 + 4 * n); ub[n] = *(const f32x4*)(bu + (size_t)u.e * FF + col0 + 4 * n); }
#pragma unroll
        for (int ai = 0; ai < 2; ++ai)
#pragma unroll
            for (int m = 0; m < 4; ++m) { bf16* op = O + (size_t)(row0 + ai * HALF + m * 16) * FF + col0;
                float r[8];
#pragma unroll
                for (int n = 0; n < 2; ++n)
#pragma unroll
                    for (int j = 0; j < 4; ++j) { float g = fminf(acc[ai][0][m][n][j] + gb[n][j], 7.f); float up = fminf(fmaxf(acc[ai][1][m][n][j] + ub[n][j], -7.f), 7.f);
                        r[4 * n + j] = (up + 1.f) * g * sigmoidf_(1.702f * g); }
                v4u w; w.x = cvt_pk_bf16(r[0], r[1]); w.y = cvt_pk_bf16(r[2], r[3]); w.z = cvt_pk_bf16(r[4], r[5]); w.w = cvt_pk_bf16(r[6], r[7]);
                *(v4u*)op = w; }
    }
};

struct EpiGluQ {
    static constexpr bool PERM = true;
    unsigned char* O; const float* bg; const float* bu; LAS unsigned char* lds;
    __device__ __forceinline__ void operator()(const f32x4 (&acc)[2][2][4][2], const Unit& u, int wr, int wc, int fr, int fq) const {
        const int lane = fr + 16 * fq, wave = wr * 4 + wc;
        const int row0 = u.rowA + wr * 64 + (lane >> 2), col0 = u.pn * HALF + wc * 32 + 8 * (lane & 3);
        f32x4 gb[2], ub[2];
#pragma unroll
        for (int n = 0; n < 2; ++n) { gb[n] = *(const f32x4*)(bg + (size_t)u.e * FF + col0 + 4 * n); ub[n] = *(const f32x4*)(bu + (size_t)u.e * FF + col0 + 4 * n); }
#pragma unroll
        for (int ai = 0; ai < 2; ++ai)
#pragma unroll
            for (int m = 0; m < 4; ++m) { unsigned char* op = O + (size_t)(row0 + ai * HALF + m * 16) * FF + col0;
                f32x4 gv[2], uv[2]; epi_stage(lds, wave, fr, fq, acc[ai][0][m][0], acc[ai][0][m][1], gv[0], gv[1]); epi_stage(lds, wave, fr, fq, acc[ai][1][m][0], acc[ai][1][m][1], uv[0], uv[1]);
                float r[8];
#pragma unroll
                for (int n = 0; n < 2; ++n)
#pragma unroll
                    for (int j = 0; j < 4; ++j) { float g = fminf(gv[n][j] * WQ_INV + gb[n][j], 7.f); float up = fminf(fmaxf(uv[n][j] * WQ_INV + ub[n][j], -7.f), 7.f);
                        r[4 * n + j] = (up + 1.f) * g * sigmoidf_(1.702f * g); }
                v2u w; w.x = pk4_fp8(r[0], r[1], r[2], r[3]); w.y = pk4_fp8(r[4], r[5], r[6], r[7]);
                *(v2u*)op = w; }
    }
};

template <class Epi, class Sched, int ESZ = 2, bool GATHER = false, bool ALIGN_EPI = true, bool NSPLIT = false>
__device__ __forceinline__ void gemm_phase(LAS unsigned char* lds, const Gemm g, const Sched& S, const Epi& E) {
    const int tid = threadIdx.x, wid = __builtin_amdgcn_readfirstlane(tid >> 6), lane = tid & 63, wr = wid >> 2, wc = wid & 3, fr = lane & 15, fq = lane >> 4;
    const int K = g.K, nt = K * ESZ / (BK * 2);
    unsigned voffA[2], voffB[2]; int Rst[2], Cst[2];
#pragma unroll
    for (int i = 0; i < 2; ++i) { int R, C; stage_rc(tid * 16 + i * 8192, R, C); const int Rb = Epi::PERM ? ((R & ~31) + perm32(R & 31)) : R; Rst[i] = R; Cst[i] = C * 2;
        voffA[i] = (unsigned)(R * g.lda * ESZ + C * 2); voffB[i] = (unsigned)(Rb * g.ldb * ESZ + C * 2); }
    const size_t kstep = (size_t)(BK * 2);
    const size_t hstepA = (size_t)HALF * g.lda * ESZ, hstepB = (size_t)HALF * g.ldb * ESZ;
    const unsigned ldsw = (unsigned)wid * 1024u;
    const int aoff = lds_byte(wr * 64 + fr, fq * 8), boff = lds_byte(wc * 32 + fr, fq * 8);
#define PG8_SA(b, h) (((b) * 2 + (h)) * HTB)
#define PG8_SB(b, h) ((4 + (b) * 2 + (h)) * HTB)
#define PG8_STAGE(bufoff, gbase, voff) do { _Pragma("unroll") for (int _i = 0; _i < 2; ++_i) \
        __builtin_amdgcn_global_load_lds((const unsigned*)((const char*)(gbase) + (voff)[_i]), (LAS unsigned*)(lds + (bufoff) + ldsw + _i * 8192), 16, 0, 0); } while (0)
#define PG8_GOFF(u_, v_) do { int tk_[2][2];        \
        _Pragma("unroll") for (int h_ = 0; h_ < 2; ++h_) _Pragma("unroll") for (int i_ = 0; i_ < 2; ++i_) { const int rk_ = (u_).rk0 + 128 * h_ + Rst[i_]; tk_[h_][i_] = g.list[(u_).e * 8192 + (rk_ < (u_).cnt ? rk_ : 0)]; } \
        _Pragma("unroll") for (int h_ = 0; h_ < 2; ++h_) _Pragma("unroll") for (int i_ = 0; i_ < 2; ++i_) { const int rk_ = (u_).rk0 + 128 * h_ + Rst[i_]; \
        const int tok_ = rk_ < (u_).cnt ? tk_[h_][i_] : 0; (v_)[h_][i_] = (unsigned)tok_ * (unsigned)(g.lda * ESZ) + (unsigned)Cst[i_]; } } while (0)
#define PG8_STAGE_A(bufoff, isnext, tt, h) do { if constexpr (GATHER) { unsigned vo_[2] = {(isnext) ? vN[h][0] : vA[h][0], (isnext) ? vN[h][1] : vA[h][1]}; PG8_STAGE(bufoff, (const char*)g.A + (size_t)(tt) * kstep, vo_); } \
        else PG8_STAGE(bufoff, ((isnext) ? nA : cA) + (size_t)(tt) * kstep + (size_t)(h) * hstepA, voffA); } while (0)
#define PG8_LD16(off_) (*(const LAS v4i*)(lds + (off_)))
#define PG8_LDA(dst, b, h) do { if constexpr (ESZ == 2) { _Pragma("unroll") for (int m = 0; m < 4; ++m) _Pragma("unroll") for (int k = 0; k < 2; ++k) dst[m][k] = *(const LAS bf16x8*)(lds + PG8_SA(b, h) + (k ? (aoff ^ 64) : aoff) + m * 2048); } \
        else { _Pragma("unroll") for (int m = 0; m < 4; ++m) dst##8[m] = __builtin_shufflevector(PG8_LD16(PG8_SA(b, h) + aoff + m * 2048), PG8_LD16(PG8_SA(b, h) + (aoff ^ 64) + m * 2048), 0, 1, 2, 3, 4, 5, 6, 7); } } while (0)
#define PG8_LDB(dst, b, h) do { if constexpr (ESZ == 2) { _Pragma("unroll") for (int n = 0; n < 2; ++n) _Pragma("unroll") for (int k = 0; k < 2; ++k) dst[n][k] = *(const LAS bf16x8*)(lds + PG8_SB(b, h) + (k ? (boff ^ 64) : boff) + n * 2048); } \
        else { _Pragma("unroll") for (int n = 0; n < 2; ++n) dst##8[n] = __builtin_shufflevector(PG8_LD16(PG8_SB(b, h) + boff + n * 2048), PG8_LD16(PG8_SB(b, h) + (boff ^ 64) + n * 2048), 0, 1, 2, 3, 4, 5, 6, 7); } } while (0)
#define PG8_MMA(ai, bj, At, Bt) do { __builtin_amdgcn_s_setprio(1); _Pragma("unroll") for (int m = 0; m < 4; ++m) _Pragma("unroll") for (int n = 0; n < 2; ++n) { \
        if constexpr (ESZ == 2) { _Pragma("unroll") for (int k = 0; k < 2; ++k) acc[ai][bj][m][n] = __builtin_amdgcn_mfma_f32_16x16x32_bf16(Bt[n][k], At[m][k], acc[ai][bj][m][n], 0, 0, 0); } \
        else asm volatile("s_nop 1\n\tv_mfma_scale_f32_16x16x128_f8f6f4 %0, %1, %2, %0, %3, %3 op_sel_hi:[0,0,0]" : "+v"(acc[ai][bj][m][n]) : "v"(Bt##8[n]), "v"(At##8[m]), "v"(one_scale)); } \
        __builtin_amdgcn_s_setprio(0); } while (0)
#define PG8_WAIT_V(n) asm volatile("s_waitcnt vmcnt(" #n ")" ::: "memory")
#define PG8_WAIT_L(n) asm volatile("s_waitcnt lgkmcnt(" #n ")" ::: "memory")
#define PG8_BAR __builtin_amdgcn_s_barrier()
#define PG8_SCHED __builtin_amdgcn_sched_barrier(0)
    Unit cur, nxt; int ui = 0;
    if (!S.next(0, cur)) return;
    f32x4 acc[2][2][4][2];
#pragma unroll
    for (int a = 0; a < 2; ++a)
#pragma unroll
        for (int b = 0; b < 2; ++b)
#pragma unroll
            for (int m = 0; m < 4; ++m)
#pragma unroll
                for (int n = 0; n < 2; ++n) acc[a][b][m][n] = (f32x4){0.f, 0.f, 0.f, 0.f};
    const int one_scale = 0x7F7F7F7F;
    bf16x8 At[4][2], B0[2][2], B1[2][2]; v8i At8[4], B08[2], B18[2];
    const char* cA = (const char*)g.A + (size_t)cur.rowA * g.lda * ESZ; const char* cB = (const char*)g.Bt + (size_t)cur.rowB * g.ldb * ESZ;
    unsigned vA[2][2] = {{0u, 0u}, {0u, 0u}}, vN[2][2] = {{0u, 0u}, {0u, 0u}}; const char* nA = cA;
    if constexpr (GATHER) PG8_GOFF(cur, vA);
    PG8_STAGE(PG8_SB(0, 0), cB, voffB); PG8_STAGE(PG8_SB(0, 1), cB + hstepB, voffB); PG8_STAGE_A(PG8_SA(0, 0), false, 0, 0); PG8_STAGE_A(PG8_SA(0, 1), false, 0, 1);
    if (wr == 1) PG8_BAR;
    PG8_WAIT_V(2); PG8_BAR;
    PG8_STAGE(PG8_SB(1, 0), cB + kstep, voffB); PG8_STAGE_A(PG8_SA(1, 0), false, 1, 0); PG8_STAGE(PG8_SB(1, 1), cB + hstepB + kstep, voffB);
    PG8_WAIT_V(6); PG8_BAR;
    for (;;) {
        const bool has_next = S.next(ui + 1, nxt);
        nA = has_next ? (const char*)g.A + (size_t)nxt.rowA * g.lda * ESZ : cA; const char* nB = has_next ? (const char*)g.Bt + (size_t)nxt.rowB * g.ldb * ESZ : cB;
        if constexpr (GATHER) { if (has_next) PG8_GOFF(nxt, vN); else { vN[0][0] = vA[0][0]; vN[0][1] = vA[0][1]; vN[1][0] = vA[1][0]; vN[1][1] = vA[1][1]; } }
        const bool hnz = NSPLIT && cur.hn != 0;
        for (int t = 0; t < nt; t += 2) {
            const bool last = (t == nt - 2);
            const char* b2 = last ? nB : cB + (size_t)(t + 2) * kstep; const char* b3 = b2 + kstep;
            const int t2 = last ? 0 : t + 2, t3 = last ? 1 : t + 3;
            PG8_LDB(B0, 0, 0); if (NSPLIT ? !hnz : true) PG8_LDB(B1, 0, 1); PG8_SCHED; PG8_LDA(At, 0, 0); PG8_STAGE_A(PG8_SA(1, 1), false, t + 1, 1);
            PG8_WAIT_V(8); PG8_WAIT_L(0); PG8_BAR; PG8_MMA(0, 0, At, B0); if (NSPLIT ? !hnz : true) PG8_MMA(0, 1, At, B1); PG8_BAR; PG8_SCHED;
            PG8_LDA(At, 0, 1); PG8_STAGE(PG8_SB(0, 0), b2, voffB); PG8_STAGE(PG8_SB(0, 1), b2 + hstepB, voffB); PG8_STAGE_A(PG8_SA(0, 0), last, t2, 0);
            PG8_WAIT_V(8); PG8_WAIT_L(0); PG8_BAR; PG8_MMA(1, 0, At, B0); if (NSPLIT ? !hnz : true) PG8_MMA(1, 1, At, B1); PG8_BAR; PG8_SCHED;
            PG8_LDB(B0, 1, 0); if (NSPLIT ? !hnz : true) PG8_LDB(B1, 1, 1); PG8_SCHED; PG8_LDA(At, 1, 0); PG8_STAGE_A(PG8_SA(0, 1), last, t2, 1);
            PG8_WAIT_V(8); PG8_WAIT_L(0); PG8_BAR; PG8_MMA(0, 0, At, B0); if (NSPLIT ? !hnz : true) PG8_MMA(0, 1, At, B1); PG8_BAR; PG8_SCHED;
            PG8_LDA(At, 1, 1); PG8_STAGE(PG8_SB(1, 0), b3, voffB); PG8_STAGE(PG8_SB(1, 1), b3 + hstepB, voffB); PG8_STAGE_A(PG8_SA(1, 0), last, t3, 0);
            PG8_WAIT_V(8); PG8_WAIT_L(0); PG8_BAR; PG8_MMA(1, 0, At, B0); if (NSPLIT ? !hnz : true) PG8_MMA(1, 1, At, B1); PG8_BAR; PG8_SCHED;
        }
        if constexpr (ESZ == 1) asm volatile("s_nop 15\n\ts_nop 15" ::: "memory");
        if constexpr (ALIGN_EPI) { if (wr == 0) PG8_BAR; }
        E(acc, cur, wr, wc, fr, fq);
        if (!has_next) break;
#pragma unroll
        for (int a = 0; a < 2; ++a)
#pragma unroll
            for (int b = 0; b < 2; ++b)
#pragma unroll
                for (int m = 0; m < 4; ++m)
#pragma unroll
                    for (int n = 0; n < 2; ++n) acc[a][b][m][n] = (f32x4){0.f, 0.f, 0.f, 0.f};
        cur = nxt; cA = nA; cB = nB; ++ui;
        if constexpr (GATHER) { vA[0][0] = vN[0][0]; vA[0][1] = vN[0][1]; vA[1][0] = vN[1][0]; vA[1][1] = vN[1][1]; }
        if constexpr (ALIGN_EPI) { if (wr == 1) PG8_BAR; }
    }
    PG8_WAIT_V(0);
    if constexpr (!ALIGN_EPI) { if (wr == 0) PG8_BAR; }
    PG8_BAR;
#undef PG8_SA
#undef PG8_SB
#undef PG8_STAGE
#undef PG8_LDA
#undef PG8_LD16
#undef PG8_GOFF
#undef PG8_STAGE_A
#undef PG8_LDB
#undef PG8_MMA
#undef PG8_WAIT_V
#undef PG8_WAIT_L
#undef PG8_BAR
#undef PG8_SCHED
}

typedef short s16x4 __attribute__((ext_vector_type(4)));
struct UnitF { int rowA, pn, e; const float* b0; const float* b1; };
struct GemmF { const bf16* A; int lda, K, ldbn; };
struct MoeOrderF {
    const volatile LAS int* tab; int nct, G, c; const float* w0; const float* w1; size_t estride; int cstep;
    __device__ bool next(int i, UnitF& u) const {
        const int L = i * G + c; const int total = __builtin_amdgcn_readfirstlane(tab[32]); if (L >= total) return false;
        int e = 0;
        for (; e < 31; ++e) { if (L < __builtin_amdgcn_readfirstlane(tab[e + 1])) break; }
        const int local = L - __builtin_amdgcn_readfirstlane(tab[e]); const int nt = __builtin_amdgcn_readfirstlane(tab[72 + e]);
        const int ct = local / nt, rt = local - ct * nt;
        u.rowA = __builtin_amdgcn_readfirstlane(tab[36 + e]) + rt * BM; u.pn = ct; u.e = e;
        u.b0 = w0 + (size_t)e * estride + (size_t)ct * cstep; u.b1 = w1 + (size_t)e * estride + (size_t)ct * cstep; return true;
    }
};
struct EpiGluNP {
    bf16* O; const float* bg; const float* bu;
    __device__ __forceinline__ void operator()(const f32x4 (&acc)[2][2][4][2], const UnitF& u, int wr, int wc, int fr, int fq) const {
        const int row0 = u.rowA + wr * 64 + fr, col0 = u.pn * HALF + wc * 32 + 4 * fq;
        f32x4 gb[2], ub[2];
#pragma unroll
        for (int n = 0; n < 2; ++n) { gb[n] = *(const f32x4*)(bg + (size_t)u.e * FF + col0 + 16 * n); ub[n] = *(const f32x4*)(bu + (size_t)u.e * FF + col0 + 16 * n); }
#pragma unroll
        for (int ai = 0; ai < 2; ++ai)
#pragma unroll
            for (int m = 0; m < 4; ++m) { bf16* op = O + (size_t)(row0 + ai * HALF + m * 16) * FF + col0;
#pragma unroll
                for (int n = 0; n < 2; ++n) { float r[4];
#pragma unroll
                    for (int j = 0; j < 4; ++j) { const float gg = fminf(acc[ai][0][m][n][j] + gb[n][j], 7.f); const float up = fminf(fmaxf(acc[ai][1][m][n][j] + ub[n][j], -7.f), 7.f);
                        r[j] = (up + 1.f) * gg * sigmoidf_(1.702f * gg); }
                    v2u w; w.x = cvt_pk_bf16(r[0], r[1]); w.y = cvt_pk_bf16(r[2], r[3]); *(v2u*)(op + 16 * n) = w; } }
    }
};
struct EpiBf16NP {
    bf16* O; int ldc; const float* bias; int bias_estride;
    __device__ __forceinline__ void operator()(const f32x4 (&acc)[2][2][4][2], const UnitF& u, int wr, int wc, int fr, int fq) const {
        const int row0 = u.rowA + wr * 64 + fr, col0 = u.pn * BM + wc * 32 + 4 * fq;
        f32x4 bv[2][2];
#pragma unroll
        for (int bj = 0; bj < 2; ++bj)
#pragma unroll
            for (int n = 0; n < 2; ++n) bv[bj][n] = *(const f32x4*)(bias + (size_t)u.e * bias_estride + col0 + bj * HALF + 16 * n);
#pragma unroll
        for (int ai = 0; ai < 2; ++ai)
#pragma unroll
            for (int m = 0; m < 4; ++m) { bf16* rowp = O + (size_t)(row0 + ai * HALF + m * 16) * ldc + col0;
#pragma unroll
                for (int bj = 0; bj < 2; ++bj)
#pragma unroll
                    for (int n = 0; n < 2; ++n) { const f32x4 v = acc[ai][bj][m][n] + bv[bj][n]; v2u w; w.x = cvt_pk_bf16(v[0], v[1]); w.y = cvt_pk_bf16(v[2], v[3]); *(v2u*)(rowp + bj * HALF + 16 * n) = w; } }
    }
};
template <class Epi, class Sched>
__device__ __forceinline__ void gemm_phase_f32b(LAS unsigned char* lds, const GemmF g, const Sched& S, const Epi& E) {
    const int tid = threadIdx.x, wid = __builtin_amdgcn_readfirstlane(tid >> 6), lane = tid & 63, wr = wid >> 2, wc = wid & 3, fr = lane & 15, fq = lane >> 4;
    const int K = g.K, nt = K / BK;
    unsigned voffA[2];
#pragma unroll
    for (int i = 0; i < 2; ++i) { int R, C; stage_rc(tid * 16 + i * 8192, R, C); voffA[i] = (unsigned)(R * g.lda + C) * 2u; }
    const size_t kstep = (size_t)(BK * 2);
    const size_t hstepA = (size_t)HALF * g.lda * 2;
    const unsigned ldsw = (unsigned)wid * 1024u;
    const int aoff = lds_byte(wr * 64 + fr, fq * 8);
    const int ldsb = (int)(uintptr_t)lds;
    const int q4 = (lane & 15) >> 2, p4 = lane & 3;
    const int fsw = q4 | ((fq & 1) << 2);
    int rbase[2];
#pragma unroll
    for (int n = 0; n < 2; ++n) rbase[n] = (8 * fq + q4) * 256 + ((((wc * 2) ^ fsw) ^ n) * 32) + 8 * p4;
    const int hB = wid >> 2, r0 = 2 * (wid & 3) + (lane >> 5), l31 = lane & 31;
    const int wslot = (l31 >> 2) ^ (r0 & 3);
    const int wb0 = hB * HTB + r0 * 256 + wslot * 32 + (lane & 3) * 8, wb1 = hB * HTB + r0 * 256 + (wslot ^ 4) * 32 + (lane & 3) * 8;
    const unsigned laneoffB = (unsigned)(r0 * g.ldbn + 4 * l31) * 4u;
    const size_t rstep8 = (size_t)8 * g.ldbn * 4, tstepB = (size_t)64 * g.ldbn * 4;
#define PG8_SA(b, h) (((b) * 2 + (h)) * HTB)
#define PG8_SB(b, h) ((4 + (b) * 2 + (h)) * HTB)
#define PG8_STAGE(bufoff, gbase, voff) do { _Pragma("unroll") for (int _i = 0; _i < 2; ++_i) { unsigned keep_; \
        asm volatile("s_mov_b32 %0, m0\n\ts_mov_b32 m0, %2\n\ts_nop 0\n\tglobal_load_lds_dwordx4 %1, off\n\ts_mov_b32 m0, %0" : "=&s"(keep_) \
            : "v"((const char*)(gbase) + (voff)[_i]), "s"(__builtin_amdgcn_readfirstlane(ldsb + (bufoff) + (int)ldsw + _i * 8192)) : "memory"); } } while (0)
#define PG8_LDA(dst, b, h) do { _Pragma("unroll") for (int m = 0; m < 4; ++m) _Pragma("unroll") for (int k = 0; k < 2; ++k) dst[m][k] = *(const LAS bf16x8*)(lds + PG8_SA(b, h) + (k ? (aoff ^ 64) : aoff) + m * 2048); } while (0)
#define PG8_LDBT(dst, b, h) do { _Pragma("unroll") for (int n = 0; n < 2; ++n) _Pragma("unroll") for (int k = 0; k < 2; ++k) { \
        const s16x4 lo_ = __builtin_amdgcn_ds_read_tr16_b64_v4i16((LAS s16x4*)(lds + PG8_SB(b, h) + rbase[n] + k * 8192)); \
        const s16x4 hi_ = __builtin_amdgcn_ds_read_tr16_b64_v4i16((LAS s16x4*)(lds + PG8_SB(b, h) + rbase[n] + k * 8192 + 1024)); \
        dst[n][k] = __builtin_shufflevector(lo_, hi_, 0, 1, 2, 3, 4, 5, 6, 7); } } while (0)
#define PG8_BPTR(p0, p1, tt) ((const char*)(hB ? (p1) : (p0)) + (size_t)(tt) * tstepB)
#define PG8_LOADB1(pb, i) dreg[i] = *(const f32x4*)((pb) + (size_t)(i) * rstep8 + laneoffB)
#define PG8_LOADB(p0, p1, tt) do { const char* pb_ = PG8_BPTR(p0, p1, tt); _Pragma("unroll") for (int _i = 0; _i < 8; ++_i) PG8_LOADB1(pb_, _i); } while (0)
#define PG8_WRITEB1(b, i) do { v2u pk_; pk_.x = cvt_pk_bf16(dreg[i].x, dreg[i].y); pk_.y = cvt_pk_bf16(dreg[i].z, dreg[i].w); \
        *(LAS v2u*)(lds + PG8_SB(b, 0) + (((i) & 1) ? wb1 : wb0) + (i) * 2048) = pk_; } while (0)
#define PG8_WRITEB(b) do { _Pragma("unroll") for (int _i = 0; _i < 8; ++_i) PG8_WRITEB1(b, _i); } while (0)
#define PG8_MF(ai, bj, m, At, Bt) do { _Pragma("unroll") for (int n = 0; n < 2; ++n) _Pragma("unroll") for (int k = 0; k < 2; ++k) \
        acc[ai][bj][m][n] = __builtin_amdgcn_mfma_f32_16x16x32_bf16(Bt[n][k], At[m][k], acc[ai][bj][m][n], 0, 0, 0); } while (0)
#define PG8_MMA(ai, bj, At, Bt) do { __builtin_amdgcn_s_setprio(1); _Pragma("unroll") for (int m = 0; m < 4; ++m) PG8_MF(ai, bj, m, At, Bt); __builtin_amdgcn_s_setprio(0); } while (0)
#define PG8_MMA_CVT(ai, bj, At, Bt, b) do { __builtin_amdgcn_s_setprio(1); _Pragma("unroll") for (int m = 0; m < 4; ++m) { PG8_MF(ai, bj, m, At, Bt); PG8_WRITEB1(b, 2 * m); PG8_WRITEB1(b, 2 * m + 1); PG8_SCHED; } __builtin_amdgcn_s_setprio(0); } while (0)
#define PG8_MMA_LD(ai, bj, At, Bt, pb) do { __builtin_amdgcn_s_setprio(1); _Pragma("unroll") for (int m = 0; m < 4; ++m) { PG8_MF(ai, bj, m, At, Bt); PG8_LOADB1(pb, 2 * m); PG8_LOADB1(pb, 2 * m + 1); PG8_SCHED; } __builtin_amdgcn_s_setprio(0); } while (0)
#define PG8_WAIT_V(n) asm volatile("s_waitcnt vmcnt(" #n ")" ::: "memory")
#define PG8_WAIT_L(n) asm volatile("s_waitcnt lgkmcnt(" #n ")" ::: "memory")
#define PG8_BAR __builtin_amdgcn_s_barrier()
#define PG8_SCHED __builtin_amdgcn_sched_barrier(0)
#define PG8_BS0(T) ((T) >= nt ? nb0 : cur.b0)
#define PG8_BS1(T) ((T) >= nt ? nb1 : cur.b1)
#define PG8_BT(T) ((T) >= nt ? (T) - nt : (T))
    UnitF cur, nxt; int ui = 0;
    if (!S.next(0, cur)) return;
    f32x4 acc[2][2][4][2];
#pragma unroll
    for (int a = 0; a < 2; ++a)
#pragma unroll
        for (int b = 0; b < 2; ++b)
#pragma unroll
            for (int m = 0; m < 4; ++m)
#pragma unroll
                for (int n = 0; n < 2; ++n) acc[a][b][m][n] = (f32x4){0.f, 0.f, 0.f, 0.f};
    bf16x8 At[4][2], B0[2][2], B1[2][2];
    f32x4 dreg[8];
    const char* cA = (const char*)g.A + (size_t)cur.rowA * g.lda * 2;
    PG8_STAGE(PG8_SA(0, 0), cA, voffA); PG8_STAGE(PG8_SA(0, 1), cA + hstepA, voffA); PG8_STAGE(PG8_SA(1, 0), cA + kstep, voffA);
    PG8_LOADB(cur.b0, cur.b1, 0); PG8_WRITEB(0); PG8_LOADB(cur.b0, cur.b1, 1); PG8_WRITEB(1); PG8_LOADB(cur.b0, cur.b1, 2);
    PG8_WAIT_V(8); PG8_WAIT_L(0);
    if (wr == 1) PG8_BAR;
    PG8_BAR;
    for (;;) {
        const bool has_next = S.next(ui + 1, nxt);
        const char* nA = has_next ? (const char*)g.A + (size_t)nxt.rowA * g.lda * 2 : cA;
        const float* nb0 = has_next ? nxt.b0 : cur.b0; const float* nb1 = has_next ? nxt.b1 : cur.b1;
        for (int t = 0; t < nt; t += 2) {
            const bool last = (t == nt - 2);
            const char* a1 = cA + (size_t)(t + 1) * kstep;
            const char* a2 = last ? nA : cA + (size_t)(t + 2) * kstep;
            const char* a3 = a2 + kstep;
            const char* pb3 = PG8_BPTR(PG8_BS0(t + 3), PG8_BS1(t + 3), PG8_BT(t + 3));
            const char* pb4 = PG8_BPTR(PG8_BS0(t + 4), PG8_BS1(t + 4), PG8_BT(t + 4));
            PG8_LDBT(B0, 0, 0); PG8_LDBT(B1, 0, 1); PG8_SCHED; PG8_LDA(At, 0, 0); PG8_STAGE(PG8_SA(1, 1), a1 + hstepA, voffA);
            PG8_WAIT_V(12); PG8_WAIT_L(0); PG8_SCHED; PG8_BAR; PG8_MMA(0, 0, At, B0); PG8_MMA(0, 1, At, B1); PG8_BAR; PG8_SCHED;
            PG8_LDA(At, 0, 1);
            PG8_WAIT_V(10); PG8_WAIT_L(0); PG8_SCHED; PG8_BAR; PG8_MMA_CVT(1, 0, At, B0, 0); PG8_STAGE(PG8_SA(0, 0), a2, voffA); PG8_MMA_LD(1, 1, At, B1, pb3); PG8_BAR; PG8_SCHED;
            PG8_LDBT(B0, 1, 0); PG8_LDBT(B1, 1, 1); PG8_SCHED; PG8_LDA(At, 1, 0); PG8_STAGE(PG8_SA(0, 1), a2 + hstepA, voffA);
            PG8_WAIT_V(12); PG8_WAIT_L(0); PG8_SCHED; PG8_BAR; PG8_MMA(0, 0, At, B0); PG8_MMA(0, 1, At, B1); PG8_BAR; PG8_SCHED;
            PG8_LDA(At, 1, 1);
            PG8_WAIT_V(10); PG8_WAIT_L(0); PG8_SCHED; PG8_BAR; PG8_MMA_CVT(1, 0, At, B0, 1); PG8_STAGE(PG8_SA(1, 0), a3, voffA); PG8_MMA_LD(1, 1, At, B1, pb4); PG8_BAR; PG8_SCHED;
        }
        if (wr == 0) PG8_BAR;
        E(acc, cur, wr, wc, fr, fq);
        if (!has_next) break;
#pragma unroll
        for (int a = 0; a < 2; ++a)
#pragma unroll
            for (int b = 0; b < 2; ++b)
#pragma unroll
                for (int m = 0; m < 4; ++m)
#pragma unroll
                    for (int n = 0; n < 2; ++n) acc[a][b][m][n] = (f32x4){0.f, 0.f, 0.f, 0.f};
        cur = nxt; cA = nA; ++ui;
        if (wr == 1) PG8_BAR;
    }
    PG8_WAIT_V(0);
    asm volatile("" :: "v"(dreg[0]), "v"(dreg[7]));
    PG8_BAR;
#undef PG8_SA
#undef PG8_SB
#undef PG8_STAGE
#undef PG8_LDA
#undef PG8_LDBT
#undef PG8_BPTR
#undef PG8_LOADB1
#undef PG8_LOADB
#undef PG8_WRITEB1
#undef PG8_WRITEB
#undef PG8_MF
#undef PG8_MMA
#undef PG8_MMA_CVT
#undef PG8_MMA_LD
#undef PG8_WAIT_V
#undef PG8_WAIT_L
#undef PG8_BAR
#undef PG8_SCHED
#undef PG8_BS0
#undef PG8_BS1
#undef PG8_BT
}
}

#define XB_TMO      128
#define XB_XCNT(j)  (256  + 64 * (j))
#define XB_XSUB(j)  (1280 + 64 * (j))
#define XB_XGEN(j)  (2304 + 64 * (j))
#define XB_TOP      3328
#define XB_TOPGEN   3392
#define XCD_BAR_WORDS 3456
#define XB_SPIN_CAP (1u << 18)
__device__ __forceinline__ unsigned xb_ld(unsigned* p)              { return __hip_atomic_load(p, __ATOMIC_RELAXED, __HIP_MEMORY_SCOPE_AGENT); }
__device__ __forceinline__ unsigned xb_add(unsigned* p, unsigned v) { return __hip_atomic_fetch_add(p, v, __ATOMIC_RELAXED, __HIP_MEMORY_SCOPE_AGENT); }
__device__ __forceinline__ unsigned xb_xcc_id() { return (unsigned)__builtin_amdgcn_s_getreg((3 << 11) | 20) & 0xFu; }
#define XB_SPIN(cond, bar) do { unsigned _sp = 0; while (cond) { __builtin_amdgcn_s_sleep(1); \
    if ((++_sp & 255u) == 0u) { if (xb_ld(&(bar)[XB_TMO])) break; if (_sp > XB_SPIN_CAP) { atomicAdd(&(bar)[XB_TMO], 1u); break; } } } } while (0)
struct XcdBarrier { unsigned* bar; unsigned x; volatile LAS unsigned* st; };
__device__ __forceinline__ XcdBarrier xcd_barrier_post(unsigned* bar, volatile LAS unsigned* st) {
    XcdBarrier b; b.bar = bar; b.x = xb_xcc_id(); b.st = st;
    if (threadIdx.x == 0) (void)xb_add(&bar[XB_XCNT(b.x)], 1u);
    return b;
}
__device__ __forceinline__ void xcd_barrier_complete(unsigned* bar, unsigned x, unsigned& nloc, unsigned& nx) {
    const unsigned G = gridDim.x * gridDim.y * gridDim.z;
    unsigned sum, cnt, mine, sp = 0u;
    for (;;) {
        sum = 0u; cnt = 0u; mine = 0u;
#pragma unroll
        for (unsigned j = 0; j < 16; ++j) { const unsigned c = xb_ld(&bar[XB_XCNT(j)]); sum += c; cnt += (c > 0u) ? 1u : 0u; mine = (j == x) ? c : mine; }
        if (sum == G) break;
        __builtin_amdgcn_s_sleep(1);
        if ((++sp & 255u) == 0u) { if (xb_ld(&bar[XB_TMO])) break; if (sp > XB_SPIN_CAP) { atomicAdd(&bar[XB_TMO], 1u); break; } }
    }
    nloc = mine > 0u ? mine : 1u; nx = cnt > 0u ? cnt : 1u;
}
__device__ __forceinline__ void xcd_barrier(const XcdBarrier& b) {
    asm volatile("s_waitcnt vmcnt(0)" ::: "memory");
    __syncthreads();
    if (threadIdx.x == 0) {
        unsigned* bar = b.bar;
        __builtin_amdgcn_s_waitcnt(0);
        unsigned nloc = b.st[0], nx = b.st[1];
        if (nloc == 0u) { xcd_barrier_complete(bar, b.x, nloc, nx); b.st[0] = nloc; b.st[1] = nx; }
        const unsigned old = xb_add(&bar[XB_XSUB(b.x)], 1u);
        const unsigned gen = old / nloc;
        if (old + 1u == (gen + 1u) * nloc) {
            __builtin_amdgcn_fence(__ATOMIC_RELEASE, "agent");
            asm volatile("s_waitcnt vmcnt(0)" ::: "memory");
            const unsigned og = xb_add(&bar[XB_TOP], 1u);
            const unsigned tg = og / nx;
            if (og + 1u == (tg + 1u) * nx) xb_add(&bar[XB_TOPGEN], 1u);
            else XB_SPIN(xb_ld(&bar[XB_TOPGEN]) == tg, bar);
            __builtin_amdgcn_fence(__ATOMIC_ACQUIRE, "agent");
            xb_add(&bar[XB_XGEN(b.x)], 1u);
            asm volatile("s_waitcnt vmcnt(0)" ::: "memory");
        } else {
            XB_SPIN(xb_ld(&bar[XB_XGEN(b.x)]) == gen, bar);
            __builtin_amdgcn_fence(__ATOMIC_ACQUIRE, "agent");
            asm volatile("s_waitcnt vmcnt(0)" ::: "memory");
        }
    }
    __syncthreads();
}

struct Args { const float* in[31]; float* out; unsigned char* ws; int ph_lo, ph_hi; };
enum { I_X = 0, I_NMG, I_WIN, I_MU, I_W0, I_W2, I_A0, I_A2, I_G2, I_KK, I_KA, I_RK, I_LNG, I_LNB, I_GWA2, I_GBA, I_GNG, I_BM, I_WBR, I_WBG, I_WOUT, I_NFG,
       I_WROUTER, I_BROUTER, I_WGATE, I_BGATE, I_WUP, I_BUP, I_WDOWN, I_BDOWN, I_NFINAL };
struct Frame {
    LAS unsigned char* lds; unsigned char* ws; unsigned* ctl;
    int tid, lane, wave, vcu, G;
};

__device__ __forceinline__ void tr_item(const float* W, int ldw, int nvalid, int k0, int n0, bf16* dst, int ldk, LAS float* scr, int lane) {
    const int c = lane & 31;
    const bool ok = (n0 + c) < nvalid;
    const int cc = ok ? n0 + c : nvalid - 1;
#pragma unroll 8
    for (int i = 0; i < 32; ++i) { const int kk = 2 * i + (lane >> 5); const float wv_ = W[(size_t)(k0 + kk) * ldw + cc]; scr[kk * 33 + c] = ok ? wv_ : 0.f; }
    LDS_WAIT(); asm volatile("" ::: "memory");
    const int c8 = lane & 7;
#pragma unroll
    for (int j = 0; j < 4; ++j) { const int n = (lane >> 3) + 8 * j; const LAS float* s = scr + (8 * c8) * 33 + n;
        v4u o; o.x = pk2(s[0 * 33], s[1 * 33]); o.y = pk2(s[2 * 33], s[3 * 33]); o.z = pk2(s[4 * 33], s[5 * 33]); o.w = pk2(s[6 * 33], s[7 * 33]);
        *(v4u*)(dst + (size_t)n * ldk + k0 + 8 * c8) = o; }
    LDS_WAIT(); asm volatile("" ::: "memory");
}
__device__ __forceinline__ void cv_load(const float* W, int ldw, int k0, int n0, int lane, f32x4 (&cr)[16]) {
    const unsigned laneoff = (unsigned)((lane >> 3) * ldw + n0 + 4 * (lane & 7)) * 4u;
#pragma unroll
    for (int i = 0; i < 16; ++i) { const char* rowp = (const char*)W + (size_t)(k0 + 8 * i) * ldw * 4; cr[i] = *(const f32x4*)(rowp + laneoff); }
}
__device__ __forceinline__ void cv_finish(const f32x4 (&cr)[16], int k0, unsigned char* dst, int ldk, LAS float* scr, int lane, float scale) {
    const int rr = lane >> 3, ch = lane & 7;
#pragma unroll
    for (int i = 0; i < 16; ++i) { LAS float* d = scr + (8 * i + rr) * 33 + 4 * ch; d[0] = cr[i].x * scale; d[1] = cr[i].y * scale; d[2] = cr[i].z * scale; d[3] = cr[i].w * scale; }
    LDS_WAIT(); asm volatile("" ::: "memory");
#pragma unroll
    for (int j = 0; j < 4; ++j) { const int n = rr + 8 * j; const LAS float* sp = scr + (16 * ch) * 33 + n;
        v4u o; o.x = pk4_fp8(sp[0 * 33], sp[1 * 33], sp[2 * 33], sp[3 * 33]); o.y = pk4_fp8(sp[4 * 33], sp[5 * 33], sp[6 * 33], sp[7 * 33]);
        o.z = pk4_fp8(sp[8 * 33], sp[9 * 33], sp[10 * 33], sp[11 * 33]); o.w = pk4_fp8(sp[12 * 33], sp[13 * 33], sp[14 * 33], sp[15 * 33]);
        *(v4u*)(dst + (size_t)n * ldk + k0 + 16 * ch) = o; }
    LDS_WAIT(); asm volatile("" ::: "memory");
}
__device__ __forceinline__ void cv_issue_dma(const float* W, int ldw, int k0, int n0, int lane, LAS float* scr) {
#pragma unroll
    for (int i = 0; i < 16; ++i) { const char* rowp = (const char*)W + (size_t)(k0 + 8 * i) * ldw * 4;
        const unsigned off = (unsigned)((lane >> 3) * ldw + n0 + 4 * ((lane & 7) ^ (i >> 1))) * 4u;
        __builtin_amdgcn_global_load_lds((const unsigned*)(rowp + off), (LAS unsigned*)(scr + i * 256), 16, 0, 2); }
}
__device__ __forceinline__ void cv_finish_dma(int k0, unsigned char* dst, int ldk, const LAS float* scr, int lane, float scale) {
    const int rr = lane >> 3, ch = lane & 7;
#pragma unroll
    for (int j = 0; j < 4; ++j) { const int n = rr + 8 * j; const LAS float* sp = scr + (16 * ch) * 32 + ((((n >> 2) ^ ch) << 2) | (n & 3));
        float f[16];
#pragma unroll
        for (int i = 0; i < 16; ++i) f[i] = sp[i * 32] * scale;
        v4u o; o.x = pk4_fp8(f[0], f[1], f[2], f[3]); o.y = pk4_fp8(f[4], f[5], f[6], f[7]); o.z = pk4_fp8(f[8], f[9], f[10], f[11]); o.w = pk4_fp8(f[12], f[13], f[14], f[15]);
        *(v4u*)(dst + (size_t)n * ldk + k0 + 16 * ch) = o; }
}
__device__ __forceinline__ void cvb_finish_dma(int k0, bf16* dst, int ldk, const LAS float* scr, int lane) {
    const int rr = lane >> 3, ch = lane & 7;
#pragma unroll
    for (int j = 0; j < 4; ++j) { const int n = rr + 8 * j; const LAS float* sp = scr + (16 * ch) * 32 + ((((n >> 2) ^ ch) << 2) | (n & 3));
        float f[16];
#pragma unroll
        for (int i = 0; i < 16; ++i) f[i] = sp[i * 32];
        v4u o0, o1; o0.x = pk2(f[0], f[1]); o0.y = pk2(f[2], f[3]); o0.z = pk2(f[4], f[5]); o0.w = pk2(f[6], f[7]); o1.x = pk2(f[8], f[9]); o1.y = pk2(f[10], f[11]); o1.z = pk2(f[12], f[13]); o1.w = pk2(f[14], f[15]);
        bf16* d = dst + (size_t)n * ldk + k0 + 16 * ch; *(v4u*)d = o0; *(v4u*)(d + 8) = o1; }
}
__device__ __forceinline__ void cvr_load(const float* W, int ldw, int k0, int n0, int lane, f32x4 (&cr)[16]) {
    const unsigned laneoff = (unsigned)((16 * (lane >> 3)) * ldw + n0 + 4 * (lane & 7)) * 4u;
#pragma unroll
    for (int i = 0; i < 16; ++i) { const char* rowp = (const char*)W + (size_t)(k0 + i) * ldw * 4; cr[i] = __builtin_nontemporal_load((const f32x4*)(rowp + laneoff)); }
}
__device__ __forceinline__ void cvr_store(const f32x4 (&cr)[16], int k0, unsigned char* dst, int ldk, int lane, float scale) {
    unsigned char* d = dst + (size_t)(4 * (lane & 7)) * ldk + k0 + 16 * (lane >> 3);
#pragma unroll
    for (int j = 0; j < 4; ++j) { v4u o;
        o.x = pk4_fp8(cr[0][j] * scale, cr[1][j] * scale, cr[2][j] * scale, cr[3][j] * scale); o.y = pk4_fp8(cr[4][j] * scale, cr[5][j] * scale, cr[6][j] * scale, cr[7][j] * scale);
        o.z = pk4_fp8(cr[8][j] * scale, cr[9][j] * scale, cr[10][j] * scale, cr[11][j] * scale); o.w = pk4_fp8(cr[12][j] * scale, cr[13][j] * scale, cr[14][j] * scale, cr[15][j] * scale);
        __builtin_nontemporal_store(o, (v4u*)(d + (size_t)j * ldk)); }
}
struct CvItem { const float* W; unsigned char* dst; int ldw, ldk, k0, n0; };
__device__ __forceinline__ CvItem cv_item(const Args& a, unsigned char* ws, int idx) {
    constexpr int I_EXP = (D / 128) * (FF / 32);
    int r = idx; const int mat = r / (NE * I_EXP); r -= mat * (NE * I_EXP); const int e = r / I_EXP; r -= e * I_EXP;
    const int kb = r / (FF / 32), nb = r % (FF / 32), n0 = 32 * nb;
    CvItem it; it.k0 = 128 * kb; it.n0 = n0;
    if (mat == 0) { it.W = a.in[I_WGATE] + (size_t)e * D * FF; it.ldw = FF; it.dst = ws + WS_WGU + ((size_t)e * 4096 + (n0 >> 7) * 256 + (n0 & 127)) * D; it.ldk = D; }
    else if (mat == 1) { it.W = a.in[I_WUP] + (size_t)e * D * FF; it.ldw = FF; it.dst = ws + WS_WGU + ((size_t)e * 4096 + (n0 >> 7) * 256 + 128 + (n0 & 127)) * D; it.ldk = D; }
    else { it.W = a.in[I_WDOWN] + (size_t)e * FF * D; it.ldw = D; it.dst = ws + WS_WD + ((size_t)e * 2048 + n0) * FF; it.ldk = FF; }
    return it;
}
constexpr int CV_ITEMS = 3 * NE * (D / 128) * (FF / 32);
constexpr int CVQ_CH = 4, CVQ_NCH = CV_ITEMS / CVQ_CH;
__device__ __forceinline__ unsigned cvq_issue(unsigned* q, int lane) { unsigned c = 0; if (lane == 0) c = __hip_atomic_fetch_add(q, 1u, RLX_AGENT); return c; }
__device__ __forceinline__ void rms_row_to_bf16(const float* xrow, const f32x4 (&gv)[8], bf16* orow, int lane) {
    const f32x4* xr = (const f32x4*)xrow + lane;
    f32x4 v[8]; float s = 0.f;
#pragma unroll
    for (int j = 0; j < 8; ++j) { v[j] = __builtin_nontemporal_load(xr + 64 * j); s += (v[j].x * v[j].x + v[j].y * v[j].y) + (v[j].z * v[j].z + v[j].w * v[j].w); }
    const float rstd = rsqrtf(wave_sum(s) * (1.f / D) + NORM_EPS);
    v2u* o8 = (v2u*)orow + lane;
#pragma unroll
    for (int j = 0; j < 8; ++j) { const f32x4 gg = gv[j]; v2u o; o.x = pk2(v[j].x * rstd * gg.x, v[j].y * rstd * gg.y); o.y = pk2(v[j].z * rstd * gg.z, v[j].w * rstd * gg.w); o8[64 * j] = o; }
}
constexpr int DT_NBF = IN_COLS / 32;
constexpr int DT_IN = (D / 128) * DT_NBF, DT_BA = (RW / 128) * (D / 32), DT_BB = DT_BA, DT_OUT = (D / 128) * (D / 32), DT_ALL = DT_IN + DT_BA + DT_BB + DT_OUT;
__device__ __forceinline__ void dense_tile(const Frame& F, const Args& a, int it, LAS float* t2) {
    bf16* Wt_in = (bf16*)(F.ws + WS_WIN); bf16* Wt_ba = (bf16*)(F.ws + WS_WBA); bf16* Wt_bb = (bf16*)(F.ws + WS_WBB); bf16* Wt_out = (bf16*)(F.ws + WS_WOUT);
    const float* W = nullptr; int ldw = 0, k0 = 0, n0 = 0, ldk = 0; bf16* dst = nullptr; int r = it;
    if (r < DT_IN) { const int kb = r / DT_NBF, nb = r % DT_NBF; W = a.in[I_WIN]; ldw = IN_COLS; k0 = 128 * kb; n0 = 32 * nb; dst = Wt_in + (size_t)n0 * DP; ldk = DP; }
    else if ((r -= DT_IN) < DT_BA) { const int kb = r / (D / 32), nb = r % (D / 32); W = a.in[I_WBR]; ldw = D; k0 = 128 * kb; n0 = 32 * nb; dst = Wt_ba + (size_t)n0 * RW; ldk = RW; }
    else if ((r -= DT_BA) < DT_BB) { const int kb = r / (D / 32), nb = r % (D / 32); W = a.in[I_WBG]; ldw = D; k0 = 128 * kb; n0 = 32 * nb; dst = Wt_bb + (size_t)n0 * GVW; ldk = GVW; }
    else { r -= DT_BB; const int kb = r / (D / 32), nb = r % (D / 32); W = a.in[I_WOUT]; ldw = D; k0 = 128 * kb; n0 = 32 * nb; dst = Wt_out + (size_t)n0 * D; ldk = D; }
    cv_issue_dma(W, ldw, k0, n0, F.lane, t2);
    asm volatile("s_waitcnt vmcnt(0)" ::: "memory");
    cvb_finish_dma(k0, dst, ldk, t2, F.lane); asm volatile("s_waitcnt lgkmcnt(0)" ::: "memory");
}
__device__ __forceinline__ void p0_prologue(const Frame& F, const Args& a) {
    LAS float* scr = (LAS float*)(F.lds + F.wave * 16896);
    const int gw = F.vcu * 8 + F.wave, NGW = F.G * 8;
    bf16* Wt_in = (bf16*)(F.ws + WS_WIN); bf16* Wt_ba = (bf16*)(F.ws + WS_WBA); bf16* Wt_bb = (bf16*)(F.ws + WS_WBB); bf16* Wt_out = (bf16*)(F.ws + WS_WOUT);
    constexpr int NB_IN = PLD / 32;
    constexpr int I_IN = (D / 64) * NB_IN, I_BA = (RW / 64) * (D / 32), I_BB = I_BA, I_OUT = (D / 64) * (D / 32);
    constexpr int NITEMS = I_IN + I_BA + I_BB + I_OUT;
    {
        constexpr int NBF = DT_NBF;
        LAS float* t2 = (LAS float*)(F.lds + F.wave * 16384);
        const int ntile = (F.G == 256) ? DT_IN : DT_ALL;
        for (int it = gw; it < ntile; it += NGW) dense_tile(F, a, it, t2);
        __syncthreads();
        for (int it = F.wave * F.G + F.vcu; it < (D / 64) * 2; it += NGW) { const int kb = it >> 1,
 nb = NBF + (it & 1); tr_item(a.in[I_WIN], IN_COLS, IN_COLS, 64 * kb, 32 * nb, Wt_in + (size_t)(32 * nb) * DP, DP, scr, F.lane); }
    }
    bf16* Hh = (bf16*)(F.ws + WS_H);
    f32x4 nmg[8];
#pragma unroll
    for (int j = 0; j < 8; ++j) nmg[j] = ((const f32x4*)a.in[I_NMG])[64 * j + F.lane];
    {
        f32x4 xn[8];
        if (gw < T) {
#pragma unroll
            for (int j = 0; j < 8; ++j) xn[j] = __builtin_nontemporal_load((const f32x4*)(a.in[I_X] + (size_t)gw * D) + F.lane + 64 * j); }
        for (int m = gw; m < T; m += NGW) {
            f32x4 v[8]; float ssum = 0.f;
#pragma unroll
            for (int j = 0; j < 8; ++j) { v[j] = xn[j]; ssum += (v[j].x * v[j].x + v[j].y * v[j].y) + (v[j].z * v[j].z + v[j].w * v[j].w); }
            if (m + NGW < T) {
#pragma unroll
                for (int j = 0; j < 8; ++j) xn[j] = __builtin_nontemporal_load((const f32x4*)(a.in[I_X] + (size_t)(m + NGW) * D) + F.lane + 64 * j); }
            const float rstd = rsqrtf(wave_sum(ssum) * (1.f / D) + NORM_EPS);
            v2u* o8 = (v2u*)(Hh + (size_t)m * DP) + F.lane;
#pragma unroll
            for (int j = 0; j < 8; ++j) { const f32x4 gg = nmg[j]; v2u o; o.x = pk2(v[j].x * rstd * gg.x, v[j].y * rstd * gg.y); o.y = pk2(v[j].z * rstd * gg.z, v[j].w * rstd * gg.w); o8[64 * j] = o; } } }
    const int gt = F.vcu * 512 + F.tid, NGT = F.G * 512;
    bf16* Wl_wa = (bf16*)(F.ws + WS_WLWA); bf16* Wl_g = (bf16*)(F.ws + WS_WLG);
    for (int i = gt; i < 2048 * 256; i += NGT) { const int n = i >> 8, k = i & 255; float v = 0.f;
        if (n < 1024) { if (k < DLORA) v = a.in[I_W2][(size_t)k * RW + n]; } else { if (k >= DLORA && k < 2 * DLORA) v = a.in[I_A2][(size_t)(k - DLORA) * RW + (n - 1024)]; }
        Wl_wa[i] = (bf16)f2bf(v); }
    for (int i = gt; i < 1024 * 256; i += NGT) { const int n = i >> 8, k = i & 255; Wl_g[i] = (bf16)f2bf(a.in[I_G2][(size_t)k * RW + n]); }
    float* Wr = (float*)(F.ws + WS_WR);
    for (int i = gt; i < 8 * 32 * 64 * 4; i += NGT) { const int ii = i & 3, l = (i >> 2) & 63, e = (i >> 8) & 31, j = i >> 13; const int k = 256 * j + 4 * l + ii;
        Wr[i] = a.in[I_NFG][k] * a.in[I_WROUTER][(size_t)k * NE + e]; }
}

__device__ __forceinline__ void cv_queue_run(const Frame& F, const Args& a, unsigned* stop) {
    unsigned* q = F.ctl + CW_CVQ; const int lane = F.lane;
    f32x4 ca[16], cb[16];
    int cur = __builtin_amdgcn_readfirstlane((int)cvq_issue(q, lane)); unsigned nraw = cvq_issue(q, lane); int pos = 0; bool stopped = false;
#define CVQ_NEXT(idx) do { if (pos == CVQ_CH) { cur = __builtin_amdgcn_readfirstlane((int)nraw); pos = 0; \
        if (stop && !stopped && __hip_atomic_load(stop, RLX_AGENT) != 0u) stopped = true; \
        nraw = stopped ? 0x7fffffffu : cvq_issue(q, lane); } \
        idx = cur < CVQ_NCH ? cur * CVQ_CH + pos++ : -1; } while (0)
    int xa, xb; CvItem ia, ib;
    CVQ_NEXT(xa); if (xa < 0) return;
    ia = cv_item(a, F.ws, xa); cvr_load(ia.W, ia.ldw, ia.k0, ia.n0, lane, ca);
    CVQ_NEXT(xb); ib = ia; if (xb >= 0) { ib = cv_item(a, F.ws, xb); cvr_load(ib.W, ib.ldw, ib.k0, ib.n0, lane, cb); }
    while (xa >= 0) {
        cvr_store(ca, ia.k0, ia.dst, ia.ldk, lane, WQ_SCALE);
        xa = -1; if (xb >= 0) { CVQ_NEXT(xa); if (xa >= 0) { ia = cv_item(a, F.ws, xa); cvr_load(ia.W, ia.ldw, ia.k0, ia.n0, lane, ca); } }
        if (xb >= 0) { cvr_store(cb, ib.k0, ib.dst, ib.ldk, lane, WQ_SCALE);
            xb = -1; if (xa >= 0) { CVQ_NEXT(xb); if (xb >= 0) { ib = cv_item(a, F.ws, xb); cvr_load(ib.W, ib.ldw, ib.k0, ib.n0, lane, cb); } } }
    }
#undef CVQ_NEXT
}
constexpr int CVW_SH = 3;
__device__ __forceinline__ void p1_gemm_in(const Frame& F, const Args& a) {
    const bool split = (F.G == 256);
    const int bx = (int)blockIdx.x, grp = bx >> 3;
    if (split && (grp & ((1 << CVW_SH) - 1)) == (1 << CVW_SH) - 1) {
        constexpr int NCW = (256 >> CVW_SH) * 8;
        const int cw = ((grp >> CVW_SH) * 8 + (bx & 7)) * 8 + F.wave; LAS float* t2 = (LAS float*)(F.lds + F.wave * 16384);
        for (int it = DT_IN + cw; it < DT_ALL; it += NCW) dense_tile(F, a, it, t2);
        cv_queue_run(F, a, F.ctl + CW_CVSTOP); return; }
    pg8::Gemm g{(const bf16*)(F.ws + WS_H), (const bf16*)(F.ws + WS_WIN), DP, DP, D, nullptr}; pg8::StaticOrder S;
    if (split) S.init(T, PLD, 256 - (256 >> CVW_SH), (grp - (grp >> CVW_SH)) * 8 + (bx & 7)); else S.init(T, PLD, F.G, bx);
    pg8::EpiBf16 E{(bf16*)(F.ws + WS_P), PLD, nullptr, 0, 1.f, F.lds};
    pg8::gemm_phase(F.lds, g, S, E);
    if (F.tid == 0) __hip_atomic_fetch_add(F.ctl + CW_CVSTOP, 1u, RLX_AGENT);
}
__device__ __forceinline__ void p2_lora_in(const Frame& F, const Args& a) {
    const int gw = F.vcu * 8 + F.wave, NGW = F.G * 8, lane = F.lane;
    const bf16* P = (const bf16*)(F.ws + WS_P); bf16* A2 = (bf16*)(F.ws + WS_A2);
    const int kind = lane < 12 ? 0 : (lane < 24 ? 1 : (lane < 32 ? 2 : 3));
    const int src = lane < 24 ? (C_WL + 8 * lane) : (C_GL + 8 * (lane - 32));
    float mu[8];
    if (kind != 2) {
#pragma unroll
        for (int j = 0; j < 8; ++j) mu[j] = a.in[I_MU][src + j];
    }
    for (int t = gw; t < T; t += NGW) {
        v4u o = {0u, 0u, 0u, 0u};
        if (kind != 2) {
            const v4u c = *(const v4u*)(P + (size_t)t * PLD + src);
            v4u pv = {0u, 0u, 0u, 0u};
            if ((t & (SEQ - 1)) != 0) pv = *(const v4u*)(P + (size_t)(t - 1) * PLD + src);
            float x[8] = {bflo(c.x), bfhi(c.x), bflo(c.y), bfhi(c.y), bflo(c.z), bfhi(c.z), bflo(c.w), bfhi(c.w)};
            float q[8] = {bflo(pv.x), bfhi(pv.x), bflo(pv.y), bfhi(pv.y), bflo(pv.z), bfhi(pv.z), bflo(pv.w), bfhi(pv.w)};
#pragma unroll
            for (int j = 0; j < 8; ++j) { float m = x[j] + (q[j] - x[j]) * mu[j]; x[j] = kind == 0 ? tanhf(m) : (kind == 1 ? m : sigmoidf_(m)); }
            o.x = pk2(x[0], x[1]); o.y = pk2(x[2], x[3]); o.z = pk2(x[4], x[5]); o.w = pk2(x[6], x[7]);
        }
        *(v4u*)(A2 + (size_t)t * 512 + 8 * lane) = o;
    }
}

#define DPPF(x, ctrl) __builtin_bit_cast(float, __builtin_amdgcn_update_dpp(0, __builtin_bit_cast(int, (x)), (ctrl), 0xF, 0xF, false))
__device__ __forceinline__ float dpp_sum16(float x) { x += DPPF(x, 0xB1); x += DPPF(x, 0x4E); x += DPPF(x, 0x141); x += DPPF(x, 0x140); return x; }
__device__ __forceinline__ float wave_sum_dpp(float x) {
    x = dpp_sum16(x); const int xi = __builtin_bit_cast(int, x);
    return (__builtin_bit_cast(float, __builtin_amdgcn_readlane(xi, 0)) + __builtin_bit_cast(float, __builtin_amdgcn_readlane(xi, 16))) +
           (__builtin_bit_cast(float, __builtin_amdgcn_readlane(xi, 32)) + __builtin_bit_cast(float, __builtin_amdgcn_readlane(xi, 48)));
}
__device__ __forceinline__ float quad_sum(float x) { x += DPPF(x, 0xB1); x += DPPF(x, 0x4E); return x; }
__device__ __forceinline__ void unpack8(const v4u u, float (&f)[8]) { f[0] = bflo(u.x); f[1] = bfhi(u.x); f[2] = bflo(u.y); f[3] = bfhi(u.y); f[4] = bflo(u.z); f[5] = bfhi(u.z); f[6] = bflo(u.w); f[7] = bfhi(u.w); }
__device__ __forceinline__ v4u pack8(const float (&f)[8]) { v4u u; u.x = pk2(f[0], f[1]); u.y = pk2(f[2], f[3]); u.z = pk2(f[4], f[5]); u.w = pk2(f[6], f[7]); return u; }
__device__ __forceinline__ void p4_rwkv_prep(const Frame& F, const Args& a) {
    const int gw = F.vcu * 8 + F.wave, NGW = F.G * 8, lane = F.lane;
    const bf16* P = (const bf16*)(F.ws + WS_P); const bf16* WA = (const bf16*)(F.ws + WS_WAO); bf16* SC = (bf16*)(F.ws + WS_SCAN); float* BON = (float*)(F.ws + WS_BON);
    const int h = lane >> 2, q = lane & 3, c0 = h * RN + 16 * q;
    v4u ur[2], uk[2], uv[2], ur1[2], uk1[2], uv1[2], uw[2], ua[2];
#define PREP_LOAD(tt) do { const bf16* pr_ = P + (size_t)(tt) * PLD + c0; const bf16* pp_ = (((tt) & (SEQ - 1)) == 0) ? pr_ : pr_ - PLD; \
        _Pragma("unroll") for (int j = 0; j < 2; ++j) { ur[j] = *(const v4u*)(pr_ + C_R + 8 * j); uk[j] = *(const v4u*)(pr_ + C_K + 8 * j); uv[j] = *(const v4u*)(pr_ + C_V + 8 * j); \
            ur1[j] = *(const v4u*)(pp_ + C_R + 8 * j); uk1[j] = *(const v4u*)(pp_ + C_K + 8 * j); uv1[j] = *(const v4u*)(pp_ + C_V + 8 * j); \
            uw[j] = __builtin_nontemporal_load((const v4u*)(WA + (size_t)(tt) * 2048 + c0 + 8 * j)); ua[j] = __builtin_nontemporal_load((const v4u*)(WA + (size_t)(tt) * 2048 + 1024 + c0 + 8 * j)); } } while (0)
    if (gw < T) PREP_LOAD(gw);
    for (int t = gw; t < T; t += NGW) {
        const bool first = (t & (SEQ - 1)) == 0;
        float r[2][8], k[2][8], v[2][8], kk[2][8], dec[2][8], aa[2][8], wv2[2][8], av2[2][8];
        float n2 = 0.f;
#pragma unroll
        for (int j = 0; j < 2; ++j) { float x[8], x1[8];
            unpack8(ur[j], x); unpack8(ur1[j], x1);
#pragma unroll
            for (int i = 0; i < 8; ++i) { const float m = a.in[I_MU][C_R + c0 + 8 * j + i]; r[j][i] = x[i] + ((first ? 0.f : x1[i]) - x[i]) * m; }
            unpack8(uk[j], x); unpack8(uk1[j], x1);
#pragma unroll
            for (int i = 0; i < 8; ++i) { const float m = a.in[I_MU][C_K + c0 + 8 * j + i]; k[j][i] = x[i] + ((first ? 0.f : x1[i]) - x[i]) * m; }
            unpack8(uv[j], x); unpack8(uv1[j], x1);
#pragma unroll
            for (int i = 0; i < 8; ++i) { const float m = a.in[I_MU][C_V + c0 + 8 * j + i]; v[j][i] = x[i] + ((first ? 0.f : x1[i]) - x[i]) * m; }
            unpack8(uw[j], wv2[j]); unpack8(ua[j], av2[j]); }
        if (t + NGW < T) PREP_LOAD(t + NGW);
#pragma unroll
        for (int j = 0; j < 2; ++j) {
#pragma unroll
            for (int i = 0; i < 8; ++i) { const int c = c0 + 8 * j + i;
                dec[j][i] = __expf(-0.60653066f * sigmoidf_(a.in[I_W0][c] + wv2[j][i]));
                aa[j][i] = sigmoidf_(a.in[I_A0][c] + av2[j][i]);
                const float kq = k[j][i] * a.in[I_KK][c]; kk[j][i] = kq; n2 += kq * kq; } }
        n2 = quad_sum(n2);
        const float inv = rsqrtf(fmaxf(n2, 1e-24f));
        float bon = 0.f; float o0[2][8], o2[2][8], o3[2][8];
#pragma unroll
        for (int j = 0; j < 2; ++j)
#pragma unroll
            for (int i = 0; i < 8; ++i) { const int c = c0 + 8 * j + i; const float kn = kk[j][i] * inv; const float kf = k[j][i] * (1.f + (aa[j][i] - 1.f) * a.in[I_KA][c]);
                o0[j][i] = -kn; o2[j][i] = kn * aa[j][i]; o3[j][i] = kf; bon += r[j][i] * kf * a.in[I_RK][c]; }
        bon = quad_sum(bon);
        const int bh = (t >> 11) * RH + h, ts = t & (SEQ - 1);
        bf16* o = SC + ((size_t)(bh * SEQ + ts) * 6) * 64 + 16 * q;
#pragma unroll
        for (int j = 0; j < 2; ++j) { *(v4u*)(o + 8 * j) = pack8(o0[j]); *(v4u*)(o + 64 + 8 * j) = pack8(dec[j]); *(v4u*)(o + 128 + 8 * j) = pack8(o2[j]);
            *(v4u*)(o + 192 + 8 * j) = pack8(o3[j]); *(v4u*)(o + 256 + 8 * j) = pack8(r[j]); *(v4u*)(o + 320 + 8 * j) = pack8(v[j]); }
        if (q == 0) BON[(size_t)t * RH + h] = bon;
    }
}
#undef PREP_LOAD
__device__ __forceinline__ void p5_rwkv_scan(const Frame& F, const Args& a) {
    constexpr int TB = 16, NBLK = SEQ / TB, STF = 384, BLKF = TB * STF;
    const bf16* SC = (const bf16*)(F.ws + WS_SCAN); float* YR = (float*)(F.ws + WS_YRAW);
    LAS float* buf = (LAS float*)F.lds;
    volatile LAS int* hs = (volatile LAS int*)(F.lds + MOE_OFF + 2048);
    const int lane = F.lane;
    for (int u = F.vcu; u < 256; u += F.G) {
        const int bh = u >> 2, vg = u & 3, b = bh >> 4, h = bh & 15;
        const int role = F.wave < 4 ? 0 : (F.wave == 4 ? 1 : 2);
        const int cw = F.wave - 5;
        const bf16* src = SC + (size_t)bh * SEQ * STF;
        const int rl = lane >> 4, kq = lane & 15, row = 16 * vg + 4 * F.wave + rl;
        __syncthreads();
        if (F.tid < 8) hs[F.tid] = 0;
        __syncthreads();
#define HS_WAIT(cond) do { unsigned sp_ = 0; while (!(cond)) { __builtin_amdgcn_s_sleep(1); if (++sp_ > (1u << 24)) break; } asm volatile("" ::: "memory"); } while (0)
        if (role == 1) {
            v4u xb[12];
            { const v4u* s4 = (const v4u*)src;
#pragma unroll
              for (int i = 0; i < 12; ++i) xb[i] = s4[lane + 64 * i]; }
            for (int m = 0; m < NBLK; ++m) {
                if (m >= 4) HS_WAIT(hs[1] >= m - 3 && hs[2] >= m - 3 && hs[3] >= m - 3 && hs[4] >= m - 3);
                LAS f32x4* d4 = (LAS f32x4*)(buf + (m & 3) * BLKF);
#pragma unroll
                for (int i = 0; i < 12; ++i) { const int c = lane + 64 * i;
                    d4[2 * c] = (f32x4){bflo(xb[i].x), bfhi(xb[i].x), bflo(xb[i].y), bfhi(xb[i].y)}; d4[2 * c + 1] = (f32x4){bflo(xb[i].z), bfhi(xb[i].z), bflo(xb[i].w), bfhi(xb[i].w)}; }
                asm volatile("s_waitcnt lgkmcnt(0)" ::: "memory");
                if (lane == 0) hs[0] = m + 1;
                if (m + 1 < NBLK) { const v4u* s4 = (const v4u*)(src + (size_t)(m + 1) * BLKF);
#pragma unroll
                    for (int i = 0; i < 12; ++i) xb[i] = s4[lane + 64 * i]; }
            }
        } else if (role == 2) {
            cv_queue_run(F, a, nullptr);
        } else {
            float S0 = 0.f, S1 = 0.f, S2 = 0.f, S3 = 0.f;
            for (int n = 0; n < NBLK; ++n) {
                HS_WAIT(hs[0] >= n + 1);
                const LAS float* bb = buf + (n & 3) * BLKF;
                float* yo = YR + ((size_t)(b * SEQ + n * TB)) * RW + h * RN + row;
                f32x4 al = *(const LAS f32x4*)(bb + 4 * kq), w = *(const LAS f32x4*)(bb + 64 + 4 * kq), be = *(const LAS f32x4*)(bb + 128 + 4 * kq);
                f32x4 kf = *(const LAS f32x4*)(bb + 192 + 4 * kq), r = *(const LAS f32x4*)(bb + 256 + 4 * kq); float vv = bb[320 + row];
                float ykeep = 0.f, yp = 0.f;
#pragma unroll
                for (int j = 0; j < TB; ++j) {
                    f32x4 al_n = al, w_n = w, be_n = be, kf_n = kf, r_n = r; float vv_n = vv;
                    if (j + 1 < TB) { const LAS float* st = bb + (j + 1) * STF;
                        al_n = *(const LAS f32x4*)(st + 4 * kq); w_n = *(const LAS f32x4*)(st + 64 + 4 * kq); be_n = *(const LAS f32x4*)(st + 128 + 4 * kq);
                        kf_n = *(const LAS f32x4*)(st + 192 + 4 * kq); r_n = *(const LAS f32x4*)(st + 256 + 4 * kq); vv_n = st[320 + row]; }
                    float sa = (S0 * al.x + S1 * al.y) + (S2 * al.z + S3 * al.w);
                    float yq = yp;
                    sa += DPPF(sa, 0xB1); if (j > 0) yq += DPPF(yq, 0xB1);
                    sa += DPPF(sa, 0x4E); if (j > 0) yq += DPPF(yq, 0x4E);
                    sa += DPPF(sa, 0x141); if (j > 0) yq += DPPF(yq, 0x141);
                    sa += DPPF(sa, 0x140); if (j > 0) yq += DPPF(yq, 0x140);
                    if (j > 0) ykeep = __builtin_bit_cast(float, __builtin_amdgcn_update_dpp(__builtin_bit_cast(int, yq), __builtin_bit_cast(int, ykeep), 0x111, 0xF, 0xF, false));
                    S0 = S0 * w.x + (sa * be.x + vv * kf.x); S1 = S1 * w.y + (sa * be.y + vv * kf.y);
                    S2 = S2 * w.z + (sa * be.z + vv * kf.z); S3 = S3 * w.w + (sa * be.w + vv * kf.w);
                    yp = (S0 * r.x + S1 * r.y) + (S2 * r.z + S3 * r.w);
                    al = al_n; w = w_n; be = be_n; kf = kf_n; r = r_n; vv = vv_n;
                }
                const float yl = dpp_sum16(yp);
                ykeep = __builtin_bit_cast(float, __builtin_amdgcn_update_dpp(__builtin_bit_cast(int, yl), __builtin_bit_cast(int, ykeep), 0x111, 0xF, 0xF, false));
                yo[(size_t)(TB - 1 - kq) * RW] = ykeep;
                asm volatile("s_waitcnt lgkmcnt(0)" ::: "memory");
                if (lane == 0) hs[1 + F.wave] = n + 1;
            }
            __builtin_amdgcn_s_setprio(0);
        }
#undef HS_WAIT
        __syncthreads();
    }
    if (F.G != 256) { LAS float* scr = (LAS float*)(F.lds + F.wave * 16896); __syncthreads();
        for (int it = F.vcu * 8 + F.wave; it < CV_ITEMS; it += F.G * 8) { const CvItem c2 = cv_item(a, F.ws, it); f32x4 c3[16]; cv_load(c2.W, c2.ldw, c2.k0, c2.n0, lane, c3); cv_finish(c3, c2.k0, c2.dst, c2.ldk, scr, lane, WQ_SCALE); } }
}

__device__ __forceinline__ void p6_rwkv_post(const Frame& F, const Args& a) {
    const int gw = F.vcu * 8 + F.wave, NGW = F.G * 8, lane = F.lane;
    const bf16* SC = (const bf16*)(F.ws + WS_SCAN); const float* YR = (const float*)(F.ws + WS_YRAW); const float* BON = (const float*)(F.ws + WS_BON);
    const bf16* GO = (const bf16*)(F.ws + WS_GO); bf16* YA = (bf16*)(F.ws + WS_YA);
    const int h = lane >> 2, q = lane & 3, c0 = h * RN + 16 * q;
    f32x4 lg[4], lb[4];
#pragma unroll
    for (int j = 0; j < 4; ++j) { lg[j] = *(const f32x4*)(a.in[I_LNG] + c0 + 4 * j); lb[j] = *(const f32x4*)(a.in[I_LNB] + c0 + 4 * j); }
    f32x4 yn[4]; v4u uvn[2], ugn[2]; float bon_ = 0.f;
#define POST_LOAD(tt) do { const int bh_ = ((tt) >> 11) * RH + h, ts_ = (tt) & (SEQ - 1); \
        _Pragma("unroll") for (int j = 0; j < 4; ++j) yn[j] = __builtin_nontemporal_load((const f32x4*)(YR + (size_t)(tt) * RW + c0 + 4 * j)); \
        _Pragma("unroll") for (int j = 0; j < 2; ++j) { uvn[j] = *(const v4u*)(SC + ((size_t)(bh_ * SEQ + ts_) * 6 + 5) * 64 + 16 * q + 8 * j); ugn[j] = *(const v4u*)(GO + (size_t)(tt) * RW + c0 + 8 * j); } \
        bon_ = BON[(size_t)(tt) * RH + h]; } while (0)
    if (gw < T) POST_LOAD(gw);
    for (int t = gw; t < T; t += NGW) {
        f32x4 y[4]; v4u uv[2], ug[2];
#pragma unroll
        for (int j = 0; j < 4; ++j) y[j] = yn[j];
#pragma unroll
        for (int j = 0; j < 2; ++j) { uv[j] = uvn[j]; ug[j] = ugn[j]; }
        const float bo = bon_;
        if (t + NGW < T) POST_LOAD(t + NGW);
        float s = 0.f;
#pragma unroll
        for (int j = 0; j < 4; ++j) s += (y[j].x + y[j].y) + (y[j].z + y[j].w);
        const float mean = quad_sum(s) * (1.f / RN);
        float s2 = 0.f;
#pragma unroll
        for (int j = 0; j < 4; ++j) { y[j] = y[j] - mean; s2 += (y[j].x * y[j].x + y[j].y * y[j].y) + (y[j].z * y[j].z + y[j].w * y[j].w); }
        const float rstd = rsqrtf(quad_sum(s2) * (1.f / RN) + GN_EPS);
        float vv[2][8], gg[2][8], o[2][8];
        unpack8(uv[0], vv[0]); unpack8(uv[1], vv[1]); unpack8(ug[0], gg[0]); unpack8(ug[1], gg[1]);
#pragma unroll
        for (int j = 0; j < 4; ++j)
#pragma unroll
            for (int i = 0; i < 4; ++i) o[j >> 1][4 * (j & 1) + i] = (y[j][i] * rstd * lg[j][i] + lb[j][i] + bo * vv[j >> 1][4 * (j & 1) + i]) * gg[j >> 1][4 * (j & 1) + i];
        *(v4u*)(YA + (size_t)t * RW + c0) = pack8(o[0]); *(v4u*)(YA + (size_t)t * RW + c0 + 8) = pack8(o[1]);
    }
}
#undef POST_LOAD

constexpr int G_BC = 0;
constexpr int G_ALF = 32768;
constexpr int G_RED = 36864;
constexpr int G_TOT = 38912;
constexpr int G_QT = 40960;
constexpr int G_KT = 58368;
constexpr int G_VT = 76800;
constexpr int G_AT = 113664;
__device__ __forceinline__ void gla_bcum(const Frame& F, const Args& a, const bf16* P, int t0, int h) {
    LAS float* bc = (LAS float*)(F.lds + G_BC); LAS float* alf = (LAS float*)(F.lds + G_ALF); LAS float* tot = (LAS float*)(F.lds + G_TOT);
    const int tid = F.tid;
    __syncthreads();
    { const int j = tid >> 3, i2 = (tid & 7) * 2; const unsigned u = *(const unsigned*)(P + (size_t)(t0 + j) * PLD + C_GAL + i2); alf[j * 16 + i2] = bflo(u); alf[j * 16 + i2 + 1] = bfhi(u); }
    const int d = tid & 127, jq = tid >> 7, hd = h * GDK + d;
    float wv[16];
#pragma unroll
    for (int i = 0; i < 16; ++i) wv[i] = a.in[I_GWA2][(size_t)i * GKW + hd];
    const float bb = a.in[I_GBA][hd];
    __syncthreads();
    float run = 0.f;
    for (int jj = 0; jj < 16; ++jj) { const int j = jq * 16 + jj; float x = bb;
#pragma unroll
        for (int i = 0; i < 16; ++i) x += alf[j * 16 + i] * wv[i];
        run += -softplusf_(-x) * (1.f / 16.f); bc[j * 128 + d] = run; }
    tot[jq * 128 + d] = run;
    __syncthreads();
    float pre = 0.f;
    for (int q = 0; q < jq; ++q) pre += tot[q * 128 + d];
    if (jq > 0) { for (int jj = 0; jj < 16; ++jj) bc[(jq * 16 + jj) * 128 + d] += pre; }
    __syncthreads();
}
constexpr int G_VP = 264, G_KP = 136;
__device__ __forceinline__ void gla_stage_v(const Frame& F, const bf16* P, int t0, int h) {
    LAS bf16* VR = (LAS bf16*)(F.lds + G_VT);
    const int j = F.tid >> 3, e0 = (F.tid & 7) * 8;
    const bf16* src = P + (size_t)(t0 + j) * PLD + C_GV + h * GDV + e0;
#pragma unroll
    for (int q = 0; q < 4; ++q) *(LAS v4u*)(VR + j * G_VP + e0 + 64 * q) = *(const v4u*)(src + 64 * q);
}
typedef short s16x4g __attribute__((ext_vector_type(4)));
__device__ __forceinline__ bf16x8 tr_frag(const LAS bf16* img, int pitch, int row0, int col0, int lane) {
    const LAS bf16* p = img + (row0 + 8 * (lane >> 4) + ((lane & 15) >> 2)) * pitch + col0 + 4 * (lane & 3);
    const s16x4g lo = __builtin_amdgcn_ds_read_tr16_b64_v4i16((LAS s16x4g*)p);
    const s16x4g hi = __builtin_amdgcn_ds_read_tr16_b64_v4i16((LAS s16x4g*)(p + 4 * pitch));
    return __builtin_shufflevector(lo, hi, 0, 1, 2, 3, 4, 5, 6, 7);
}
#define MMA16(a_, b_, c_) __builtin_amdgcn_mfma_f32_16x16x32_bf16(a_, b_, c_, 0, 0, 0)
__device__ __forceinline__ void gla_stage(const Frame& F, const f32x4& a0, const f32x4& a1, f32x4& v0, f32x4& v1) {
    LAS float* t = (LAS float*)(F.lds + 131072 + F.wave * (16 * 36 * 4));
    const int fr = F.lane & 15, fq = F.lane >> 4;
    *(LAS f32x4*)(t + fr * 36 + 4 * fq) = a0; *(LAS f32x4*)(t + fr * 36 + 16 + 4 * fq) = a1;
    v0 = *(const LAS f32x4*)(t + (F.lane >> 2) * 36 + 8 * (F.lane & 3)); v1 = *(const LAS f32x4*)(t + (F.lane >> 2) * 36 + 8 * (F.lane & 3) + 4);
}
__device__ __forceinline__ void gla_pass_a(const Frame& F, const Args& a) {
    const bf16* P = (const bf16*)(F.ws + WS_P); bf16* HT = (bf16*)(F.ws + WS_GHT); float* DEC = (float*)(F.ws + WS_GDEC);
    LAS float* bc = (LAS float*)(F.lds + G_BC); LAS bf16* KH = (LAS bf16*)(F.lds + G_KT); LAS bf16* VR = (LAS bf16*)(F.lds + G_VT);
    const int fr = F.lane & 15, fq = F.lane >> 4;
    const int j = F.tid >> 3, d0 = (F.tid & 7) * 8;
    v4u uk2[2], uv4[4];
#define GLA_ISSUE(it_) do { const int c_ = (it_) & 31, h_ = ((it_) >> 5) & 3, b_ = (it_) >> 7, t0_ = b_ * SEQ + c_ * CHUNK; \
        const bf16* sk = P + (size_t)(t0_ + j) * PLD + C_GK + h_ * GDK + d0; const bf16* sv = P + (size_t)(t0_ + j) * PLD + C_GV + h_ * GDV + d0; \
        _Pragma("unroll") for (int q = 0; q < 2; ++q) uk2[q] = *(const v4u*)(sk + 64 * q); \
        _Pragma("unroll") for (int q = 0; q < 4; ++q) uv4[q] = *(const v4u*)(sv + 64 * q); } while (0)
    if (F.vcu < BATCH * GH * NCH) GLA_ISSUE(F.vcu);
    for (int it = F.vcu; it < BATCH * GH * NCH; it += F.G) {
        const int c = it & 31, h = (it >> 5) & 3, b = it >> 7, t0 = b * SEQ + c * CHUNK;
        gla_bcum(F, a, P, t0, h);
        if (F.tid < 128) DEC[(size_t)it * 128 + F.tid] = __expf(bc[63 * 128 + F.tid]);
        { f32x4* gbc = (f32x4*)(F.ws + WS_GBC) + (size_t)it * 2048;
#pragma unroll
          for (int i = 0; i < 4; ++i) gbc[F.tid + 512 * i] = ((const LAS f32x4*)bc)[F.tid + 512 * i]; }
        {
#pragma unroll
          for (int q = 0; q < 2; ++q) { const v4u u = uk2[q]; float kv[8]; unpack8(u, kv);
#pragma unroll
            for (int i = 0; i < 8; ++i) { const int d = d0 + 64 * q + i; kv[i] *= __expf(bc[63 * 128 + d] - bc[j * 128 + d]); }
            *(LAS v4u*)(KH + j * G_KP + d0 + 64 * q) = pack8(kv); } }
#pragma unroll
        for (int q = 0; q < 4; ++q) *(LAS v4u*)(VR + j * G_VP + d0 + 64 * q) = uv4[q];
        if (it + F.G < BATCH * GH * NCH) GLA_ISSUE(it + F.G);
        __syncthreads();
        f32x4 acc[8][2];
#pragma unroll
        for (int m = 0; m < 8; ++m)
#pragma unroll
            for (int n = 0; n < 2; ++n) acc[m][n] = (f32x4){0.f, 0.f, 0.f, 0.f};
#pragma unroll
        for (int ks = 0; ks < 2; ++ks) {
            bf16x8 vf[2];
#pragma unroll
            for (int n = 0; n < 2; ++n) vf[n] = tr_frag(VR, G_VP, ks * 32, F.wave * 32 + n * 16, F.lane);
#pragma unroll
            for (int m = 0; m < 8; ++m) { const bf16x8 kf = tr_frag(KH, G_KP, ks * 32, m * 16, F.lane);
#pragma unroll
                for (int n = 0; n < 2; ++n) acc[m][n] = MMA16(kf, vf[n], acc[m][n]); }
        }
        bf16* o = HT + (size_t)it * (GDV * GDK);
#pragma unroll
        for (int n = 0; n < 2; ++n)
#pragma unroll
            for (int mp = 0; mp < 4; ++mp) { f32x4 v0, v1; gla_stage(F, acc[2 * mp][n], acc[2 * mp + 1][n], v0, v1);
                v4u pk; pk.x = pk2(v0[0], v0[1]); pk.y = pk2(v0[2], v0[3]); pk.z = pk2(v1[0], v1[1]); pk.w = pk2(v1[2], v1[3]);
                *(v4u*)(o + (size_t)(F.wave * 32 + n * 16 + (F.lane >> 2)) * GDK + mp * 32 + 8 * (F.lane & 3)) = pk; }
    }
}
#undef GLA_ISSUE
__device__ __forceinline__ void gla_pass_b(const Frame& F, int lo, int hi, int wg, int nwg) {
    const bf16* HT = (const bf16*)(F.ws + WS_GHT); const float* DEC = (const float*)(F.ws + WS_GDEC); bf16* ST = (bf16*)(F.ws + WS_GST);
    const int gt = wg * 512 + F.tid, NGT = nwg * 512;
    for (int i = (lo >> 1) + gt; i < (hi >> 1); i += NGT) {
        const int bh = i >> 14, ed = (i & 16383) * 2, d = ed & 127;
        float s0 = 0.f, s1 = 0.f;
#pragma unroll 8
        for (int c = 0; c < NCH; ++c) { const size_t it = (size_t)bh * NCH + c;
            const unsigned hv = __builtin_nontemporal_load((const unsigned*)(HT + it * (GDV * GDK) + ed)); const float d0 = DEC[it * 128 + d], d1 = DEC[it * 128 + d + 1];
            *(unsigned*)(ST + it * (GDV * GDK) + ed) = pk2(s0, s1);
            s0 = s0 * d0 + bflo(hv); s1 = s1 * d1 + bfhi(hv); }
    }
}
__device__ __forceinline__ void gla_pass_c(const Frame& F, const Args& a) {
    const bf16* P = (const bf16*)(F.ws + WS_P); const bf16* ST = (const bf16*)(F.ws + WS_GST); bf16* YB = (bf16*)(F.ws + WS_YB);
    LAS float* bc = (LAS float*)(F.lds + G_BC); LAS float* red = (LAS float*)(F.lds + G_RED);
    LAS bf16* QT = (LAS bf16*)(F.lds + G_QT); LAS bf16* KT = (LAS bf16*)(F.lds + G_KT); LAS bf16* VR = (LAS bf16*)(F.lds + G_VT); LAS bf16* AT = (LAS bf16*)(F.lds + G_AT);
    const int fr = F.lane & 15, fq = F.lane >> 4, w = F.wave;
    const float scale = 0.08838834764831845f;
    const int j = F.tid >> 3, d0 = (F.tid & 7) * 8;
    f32x4 gb4[4]; v4u uq2[2], uk2[2], uv4[4];
#define GLC_ISSUE(it_) do { const int c_ = (it_) & 31, h_ = ((it_) >> 5) & 3, b_ = (it_) >> 7, t0_ = b_ * SEQ + c_ * CHUNK; \
        const f32x4* gbc = (const f32x4*)(F.ws + WS_GBC) + (size_t)(it_) * 2048; \
        _Pragma("unroll") for (int i = 0; i < 4; ++i) gb4[i] = gbc[F.tid + 512 * i]; \
        const bf16* sq = P + (size_t)(t0_ + j) * PLD + C_GQ + h_ * GDK + d0; const bf16* sk = P + (size_t)(t0_ + j) * PLD + C_GK + h_ * GDK + d0; const bf16* sv = P + (size_t)(t0_ + j) * PLD + C_GV + h_ * GDV + d0; \
        _Pragma("unroll") for (int q = 0; q < 2; ++q) { uq2[q] = *(const v4u*)(sq + 64 * q); uk2[q] = *(const v4u*)(sk + 64 * q); } \
        _Pragma("unroll") for (int q = 0; q < 4; ++q) uv4[q] = *(const v4u*)(sv + 64 * q); } while (0)
    if (F.vcu < BATCH * GH * NCH) GLC_ISSUE(F.vcu);
    for (int it = F.vcu; it < BATCH * GH * NCH; it += F.G) {
        const int c = it & 31, h = (it >> 5) & 3, b = it >> 7, t0 = b * SEQ + c * CHUNK;
        __syncthreads();
#pragma unroll
        for (int i = 0; i < 4; ++i) ((LAS f32x4*)bc)[F.tid + 512 * i] = gb4[i];
        __syncthreads();
        {
#pragma unroll
          for (int q = 0; q < 2; ++q) { const v4u uq = uq2[q], uk = uk2[q]; float fq8[8], fk8[8]; unpack8(uq, fq8); unpack8(uk, fk8);
#pragma unroll
            for (int i = 0; i < 8; ++i) { const float bv = bc[j * 128 + d0 + 64 * q + i]; fq8[i] *= scale * __expf(bv); fk8[i] *= __expf(-bv); }
            *(LAS v4u*)(QT + j * 136 + d0 + 64 * q) = pack8(fq8); *(LAS v4u*)(KT + j * 136 + d0 + 64 * q) = pack8(fk8); } }
#pragma unroll
        for (int q = 0; q < 4; ++q) *(LAS v4u*)(VR + j * G_VP + d0 + 64 * q) = uv4[q];
        const bf16* Sg = ST + (size_t)it * (GDV * GDK);
        bf16x8 sfr[4][2];
#pragma unroll
        for (int ks = 0; ks < 4; ++ks)
#pragma unroll
            for (int n = 0; n < 2; ++n) sfr[ks][n] = *(const bf16x8*)(Sg + (size_t)(w * 32 + n * 16 + fr) * GDK + ks * 32 + fq * 8);
        f32x4 gng[2];
#pragma unroll
        for (int n = 0; n < 2; ++n) gng[n] = *(const f32x4*)(a.in[I_GNG] + w * 32 + n * 16 + 4 * fq);
        v4u ogu[4];
#pragma unroll
        for (int m = 0; m < 4; ++m) ogu[m] = __builtin_nontemporal_load((const v4u*)(P + (size_t)(t0 + m * 16 + (F.lane >> 2)) * PLD + C_OG + h * GDV + w * 32 + 8 * (F.lane & 3)));
        if (it + F.G < BATCH * GH * NCH) GLC_ISSUE(it + F.G);
        __syncthreads();
        { const int mt = w >> 1;
#pragma unroll
          for (int q = 0; q < 2; ++q) { const int nt = (w & 1) * 2 + q; f32x4 sacc = {0.f, 0.f, 0.f, 0.f};
            if (nt <= mt) {
#pragma unroll
                for (int ks = 0; ks < 4; ++ks) { const bf16x8 kfr = *(const LAS bf16x8*)(KT + (nt * 16 + fr) * 136 + ks * 32 + fq * 8); const bf16x8 qfr = *(const LAS bf16x8*)(QT + (mt * 16 + fr) * 136 + ks * 32 + fq * 8);
                    sacc = MMA16(kfr, qfr, sacc); } }
            const int i = mt * 16 + fr, j0 = nt * 16 + 4 * fq; float v4[4];
#pragma unroll
            for (int jj = 0; jj < 4; ++jj) v4[jj] = (j0 + jj <= i) ? sacc[jj] : 0.f;
            v2u pk; pk.x = pk2(v4[0], v4[1]); pk.y = pk2(v4[2], v4[3]); *(LAS v2u*)(AT + i * 72 + j0) = pk; } }
        __syncthreads();
        f32x4 acc[2][4];
#pragma unroll
        for (int n = 0; n < 2; ++n)
#pragma unroll
            for (int m = 0; m < 4; ++m) acc[n][m] = (f32x4){0.f, 0.f, 0.f, 0.f};
#pragma unroll
        for (int ks = 0; ks < 2; ++ks) {
            bf16x8 vf[2];
#pragma unroll
            for (int n = 0; n < 2; ++n) vf[n] = tr_frag(VR, G_VP, ks * 32, w * 32 + n * 16, F.lane);
#pragma unroll
            for (int m = 0; m < 4; ++m) { const bf16x8 af = *(const LAS bf16x8*)(AT + (m * 16 + fr) * 72 + ks * 32 + fq * 8);
#pragma unroll
                for (int n = 0; n < 2; ++n) acc[n][m] = MMA16(vf[n], af, acc[n][m]); }
        }
#pragma unroll
        for (int ks = 0; ks < 4; ++ks) {
#pragma unroll
            for (int m = 0; m < 4; ++m) { const bf16x8 qf = *(const LAS bf16x8*)(QT + (m * 16 + fr) * 136 + ks * 32 + fq * 8);
#pragma unroll
                for (int n = 0; n < 2; ++n) acc[n][m] = MMA16(sfr[ks][n], qf, acc[n][m]); }
        }
        float ssq[4];
#pragma unroll
        for (int m = 0; m < 4; ++m) { float ss = 0.f;
#pragma unroll
            for (int n = 0; n < 2; ++n) ss += (acc[n][m][0] * acc[n][m][0] + acc[n][m][1] * acc[n][m][1]) + (acc[n][m][2] * acc[n][m][2] + acc[n][m][3] * acc[n][m][3]);
            ss += __shfl_xor(ss, 16); ss += __shfl_xor(ss, 32); ssq[m] = ss;
            if (fq == 0) red[(m * 16 + fr) * 8 + w] = ss; }
        __syncthreads();
#pragma unroll
        for (int m = 0; m < 4; ++m) { const int i = m * 16 + fr; float tot = 0.f;
#pragma unroll
            for (int q = 0; q < 8; ++q) tot += red[i * 8 + q];
            const float rstd = rsqrtf(tot * (1.f / GDV) + NORM_EPS);
            f32x4 rr[2];
#pragma unroll
            for (int n = 0; n < 2; ++n)
#pragma unroll
                for (int jj = 0; jj < 4; ++jj) rr[n][jj] = acc[n][m][jj] * rstd * gng[n][jj];
            f32x4 v0, v1; gla_stage(F, rr[0], rr[1], v0, v1);
            float og[8]; unpack8(ogu[m], og); float r8[8];
#pragma unroll
            for (int jj = 0; jj < 4; ++jj) { r8[jj] = v0[jj] * (og[jj] * sigmoidf_(og[jj])); r8[4 + jj] = v1[jj] * (og[4 + jj] * sigmoidf_(og[4 + jj])); }
            *(v4u*)(YB + (size_t)(t0 + m * 16 + (F.lane >> 2)) * GVW + h * GDV + w * 32 + 8 * (F.lane & 3)) = pack8(r8); }
    }
}
#undef GLC_ISSUE

__device__ __forceinline__ void p11_router(const Frame& F, const Args& a) {
    const int lane = F.lane, w = F.wave;
    const float* X1 = (const float*)(F.ws + WS_X1); unsigned char* H2 = (unsigned char*)(F.ws + WS_H2); const float* Wr = (const float*)(F.ws + WS_WR);
    int* SEL_E = (int*)(F.ws + WS_ROUTE); float* SEL_W = (float*)(F.ws + WS_ROUTE + 256 * 1024); int* SEL_R = (int*)(F.ws + WS_ROUTE + 512 * 1024);
    volatile LAS int* hist = (volatile LAS int*)(F.lds + MOE_OFF + 1024); volatile LAS int* base = (volatile LAS int*)(F.lds + MOE_OFF + 1280);
    int* LIST = (int*)(F.ws + WS_ROUTE + 1024 * 1024);
    constexpr int RP = 36;
    LAS float* XL = (LAS float*)(F.lds + w * (2 * 32 * RP * 4)); LAS float* TL = XL + 32 * RP;
    LAS float* part = (LAS float*)(F.lds + 8 * (2 * 32 * RP * 4));
    LAS float* ssq = part + 8 * 1024;
    __syncthreads();
    if (F.tid < 32) hist[F.tid] = 0;
    __syncthreads();
    const int r = lane & 15, kq = lane >> 4, row8 = lane >> 3, seg = lane & 7;
    const int grp = lane >> 4, el = lane & 15;
    const float br0 = a.in[I_BROUTER][el], br1 = a.in[I_BROUTER][16 + el];
    f32x4 nfg[8];
#pragma unroll
    for (int j = 0; j < 8; ++j) nfg[j] = ((const f32x4*)a.in[I_NFG])[64 * j + lane];
    for (int tile = F.vcu; tile < T / 32; tile += F.G) {
        const int tb = tile * 32;
        {
            const float* xg = X1 + (size_t)(tb + row8) * D + 256 * w + 4 * seg;
            const float* tg = Wr + (size_t)w * 8192 + row8 * 256 + 4 * seg;
            f32x4 acc[2][2]; float ssl[4] = {0.f, 0.f, 0.f, 0.f};
#pragma unroll
            for (int m = 0; m < 2; ++m)
#pragma unroll
                for (int n = 0; n < 2; ++n) acc[m][n] = (f32x4){0.f, 0.f, 0.f, 0.f};
            f32x4 gx[4], gt[4];
#pragma unroll
            for (int q = 0; q < 4; ++q) { gx[q] = *(const f32x4*)(xg + (size_t)(8 * q) * D); gt[q] = *(const f32x4*)(tg + (8 * q) * 256); }
#pragma unroll 1
            for (int c = 0; c < 8; ++c) {
#pragma unroll
                for (int q = 0; q < 4; ++q) { *(LAS f32x4*)(XL + (8 * q + row8) * RP + 4 * seg) = gx[q]; *(LAS f32x4*)(TL + (8 * q + row8) * RP + 4 * seg) = gt[q];
                    ssl[q] += (gx[q].x * gx[q].x + gx[q].y * gx[q].y) + (gx[q].z * gx[q].z + gx[q].w * gx[q].w); }
                if (c < 7) {
#pragma unroll
                    for (int q = 0; q < 4; ++q) { gx[q] = *(const f32x4*)(xg + (size_t)(8 * q) * D + 32 * (c + 1)); gt[q] = *(const f32x4*)(tg + (8 * q) * 256 + 32 * (c + 1)); } }
                f32x4 xa[2], xb[2], ba[2], bb[2];
#pragma unroll
                for (int m = 0; m < 2; ++m) { xa[m] = *(const LAS f32x4*)(XL + (16 * m + r) * RP + 8 * kq); xb[m] = *(const LAS f32x4*)(XL + (16 * m + r) * RP + 8 * kq + 4);
                    ba[m] = *(const LAS f32x4*)(TL + (16 * m + r) * RP + 8 * kq); bb[m] = *(const LAS f32x4*)(TL + (16 * m + r) * RP + 8 * kq + 4); }
#pragma unroll
                for (int i = 0; i < 4; ++i)
#pragma unroll
                    for (int m = 0; m < 2; ++m)
#pragma unroll
                        for (int n = 0; n < 2; ++n) acc[m][n] = __builtin_amdgcn_mfma_f32_16x16x4f32(xa[m][i], ba[n][i], acc[m][n], 0, 0, 0);
#pragma unroll
                for (int i = 0; i < 4; ++i)
#pragma unroll
                    for (int m = 0; m < 2; ++m)
#pragma unroll
                        for (int n = 0; n < 2; ++n) acc[m][n] = __builtin_amdgcn_mfma_f32_16x16x4f32(xb[m][i], bb[n][i], acc[m][n], 0, 0, 0);
            }
#pragma unroll
            for (int m = 0; m < 2; ++m)
#pragma unroll
                for (int j = 0; j < 4; ++j) { LAS float* pr = part + ((w * 32 + 16 * m + 4 * kq + j) * 32); pr[r] = acc[m][0][j]; pr[16 + r] = acc[m][1][j]; }
#pragma unroll
            for (int q = 0; q < 4; ++q) { float v = ssl[q]; v += __shfl_xor(v, 1); v += __shfl_xor(v, 2); v += __shfl_xor(v, 4); if (seg == 0) ssq[w * 32 + 8 * q + row8] = v; }
        }
        __syncthreads();
        f32x4 xh[4][8];
#pragma unroll
        for (int rr = 0; rr < 4; ++rr)
#pragma unroll
            for (int j = 0; j < 8; ++j) xh[rr][j] = __builtin_nontemporal_load((const f32x4*)(X1 + (size_t)(tb + 4 * w + rr) * D) + lane + 64 * j);
        {
            const int tk = 4 * w + grp;
            float sq = 0.f, p0 = 0.f, p1 = 0.f; const LAS float* pr = part + tk * 32;
#pragma unroll
            for (int k8 = 0; k8 < 8; ++k8) { sq += ssq[32 * k8 + tk]; p0 += pr[1024 * k8 + el]; p1 += pr[1024 * k8 + 16 + el]; }
            const float rstd = rsqrtf(sq * (1.f / D) + NORM_EPS);
            float c0 = p0 * rstd + br0, c1 = p1 * rstd + br1;
            float tv[4]; int ti[4];
#pragma unroll
            for (int k = 0; k < 4; ++k) { float bv = c0; int bi = el; if (c1 > c0) { bv = c1; bi = 16 + el; }
#pragma unroll
                for (int o = 1; o < 16; o <<= 1) { const float ov = __shfl_xor(bv, o); const int oi = __shfl_xor(bi, o); if (ov > bv || (ov == bv && oi < bi)) { bv = ov; bi = oi; } }
                tv[k] = bv; ti[k] = bi; if (bi == el) c0 = -3.0e38f; if (bi == 16 + el) c1 = -3.0e38f; }
            const float e1 = __expf(tv[1] - tv[0]), e2 = __expf(tv[2] - tv[0]), e3 = __expf(tv[3] - tv[0]); const float inv = 1.f / (1.f + e1 + e2 + e3);
            if (el < 4) { const int k = el; const float wk = (k == 0 ? 1.f : (k == 1 ? e1 : (k == 2 ? e2 : e3))) * inv; const int ek = (k == 0 ? ti[0] : (k == 1 ? ti[1] : (k == 2 ? ti[2] : ti[3])));
                const int lr = __hip_atomic_fetch_add((LAS int*)&hist[ek], 1, __ATOMIC_RELAXED, __HIP_MEMORY_SCOPE_WORKGROUP);
                SEL_E[(tb + tk) * 4 + k] = ek; SEL_W[(tb + tk) * 4 + k] = wk; SEL_R[(tb + tk) * 4 + k] = lr; }
        }
#pragma unroll
        for (int rr = 0; rr < 4; ++rr) { const int tk = 4 * w + rr;
            float sq = 0.f;
#pragma unroll
            for (int k8 = 0; k8 < 8; ++k8) sq += ssq[32 * k8 + tk];
            const float rstd = rsqrtf(sq * (1.f / D) + NORM_EPS);
            unsigned* hr = (unsigned*)(H2 + (size_t)(tb + tk) * D) + lane;
#pragma unroll
            for (int j = 0; j < 8; ++j) { const f32x4 xv = xh[rr][j]; const f32x4 gg = nfg[j];
                hr[64 * j] = pk4_fp8(xv.x * rstd * gg.x, xv.y * rstd * gg.y, xv.z * rstd * gg.z, xv.w * rstd * gg.w); } }
        __syncthreads();
    }
    if (F.tid < 32) base[F.tid] = (int)__hip_atomic_fetch_add(F.ctl + CW_CNT + F.tid, (unsigned)hist[F.tid], RLX_AGENT);
    __syncthreads();
    for (int tile = F.vcu; tile < T / 32; tile += F.G) {
        if (F.tid < 128) { const int tk = tile * 32 + (F.tid >> 2); const int idx = tk * 4 + (F.tid & 3);
            const int e_ = __hip_atomic_load(SEL_E + idx, RLX_AGENT); const int rk_ = __hip_atomic_load(SEL_R + idx, RLX_AGENT) + base[e_]; SEL_R[idx] = rk_; LIST[e_ * 8192 + rk_] = tk; }
    }
}
__device__ __forceinline__ void moe_tables(const Frame& F, int nct) {
    volatile LAS int* tab = (volatile LAS int*)(F.lds + MOE_OFF);
    __syncthreads();
    if (F.wave == 0) {
        const int e = F.lane; int cnt = 0, nt = 0;
        if (e < NE) { cnt = (int)__hip_atomic_load(F.ctl + CW_CNT + e, RLX_AGENT); nt = (cnt + 255) >> 8; }
        int inc = nt;
#pragma unroll
        for (int o = 1; o < 32; o <<= 1) { const int v = __shfl_up(inc, o); if (F.lane >= o) inc += v; }
        const int ex = inc - nt;
        if (e < NE) { tab[e] = ex * nct; tab[36 + e] = ex * 256; tab[72 + e] = nt > 0 ? nt : 1; tab[108 + e] = cnt; }
        if (e == NE - 1) tab[32] = inc * nct; }
    __syncthreads();
}
__device__ __forceinline__ void p12_scatter(const Frame& F) {
    const int gw = F.vcu * 8 + F.wave, NGW = F.G * 8, lane = F.lane;
    const unsigned char* H2 = (const unsigned char*)(F.ws + WS_H2); unsigned char* XS = (unsigned char*)(F.ws + WS_XS);
    const int* SEL_E = (const int*)(F.ws + WS_ROUTE); const int* SEL_R = (const int*)(F.ws + WS_ROUTE + 512 * 1024); int* DEST = (int*)(F.ws + WS_ROUTE + 768 * 1024);
    moe_tables(F, 1);
    volatile LAS int* tab = (volatile LAS int*)(F.lds + MOE_OFF);
    for (int it = gw; it < T * TOPK; it += NGW) {
        const int t = it >> 2; const int e = SEL_E[it], dest = tab[36 + e] + SEL_R[it];
        const v4u* s = (const v4u*)(H2 + (size_t)t * D) + lane; v4u* d = (v4u*)(XS + (size_t)dest * D) + lane;
        d[0] = s[0]; d[64] = s[64];
        if (lane == 0) DEST[it] = dest;
    }
}
__device__ __forceinline__ void p15_combine(const Frame& F, const Args& a) {
    const int gw = F.vcu * 8 + F.wave, NGW = F.G * 8, lane = F.lane;
    const float* X1 = (const float*)(F.ws + WS_X1); const bf16* Y = (const bf16*)(F.ws + WS_Y);
    const float* SEL_W = (const float*)(F.ws + WS_ROUTE + 256 * 1024); const int* SEL_E = (const int*)(F.ws + WS_ROUTE); const int* SEL_R = (const int*)(F.ws + WS_ROUTE + 512 * 1024);
    moe_tables(F, 1);
    volatile LAS int* tab = (volatile LAS int*)(F.lds + MOE_OFF);
    f32x4 nfin[8];
#pragma unroll
    for (int j = 0; j < 8; ++j) nfin[j] = ((const f32x4*)a.in[I_NFINAL])[64 * j + lane];
    float wkn[4]; int rown[4]; f32x4 xn[8];
#define CMB_LOAD(tt) do { _Pragma("unroll") for (int k = 0; k < 4; ++k) { wkn[k] = SEL_W[(tt) * 4 + k]; rown[k] = tab[36 + SEL_E[(tt) * 4 + k]] + SEL_R[(tt) * 4 + k]; } \
        _Pragma("unroll") for (int j = 0; j < 8; ++j) xn[j] = __builtin_nontemporal_load((const f32x4*)(X1 + (size_t)(tt) * D) + lane + 64 * j); } while (0)
    if (gw < T) CMB_LOAD(gw);
    for (int t = gw; t < T; t += NGW) {
        f32x4 v[8]; float wks[4]; int rows[4];
#pragma unroll
        for (int j = 0; j < 8; ++j) v[j] = xn[j];
#pragma unroll
        for (int k = 0; k < 4; ++k) { wks[k] = wkn[k]; rows[k] = rown[k]; }
        if (t + NGW < T) CMB_LOAD(t + NGW);
#pragma unroll
        for (int k = 0; k < 4; ++k) { const float wk = wks[k]; const v2u* yr = (const v2u*)(Y + (size_t)rows[k] * D) + lane;
#pragma unroll
            for (int j = 0; j < 8; ++j) { const v2u u = __builtin_nontemporal_load(yr + 64 * j); v[j].x += wk * bflo(u.x); v[j].y += wk * bfhi(u.x); v[j].z += wk * bflo(u.y); v[j].w += wk * bfhi(u.y); } }
        float s = 0.f;
#pragma unroll
        for (int j = 0; j < 8; ++j) s += (v[j].x * v[j].x + v[j].y * v[j].y) + (v[j].z * v[j].z + v[j].w * v[j].w);
        const float rstd = rsqrtf(wave_sum(s) * (1.f / D) + NORM_EPS);
        f32x4* o = (f32x4*)(a.out + (size_t)t * D) + lane;
#pragma unroll
        for (int j = 0; j < 8; ++j) __builtin_nontemporal_store(v[j] * rstd * nfin[j], o + 64 * j);
    }
}
#undef CMB_LOAD

__global__ void __launch_bounds__(512, 2) __attribute__((amdgpu_num_sgpr(96))) fwd(Args args) {
    extern __shared__ __attribute__((aligned(16))) unsigned char lds[];
    Frame F;
    F.lds = (LAS unsigned char*)lds; F.ws = args.ws; F.ctl = (unsigned*)(args.ws + WS_CTL);
    F.tid = threadIdx.x; F.lane = F.tid & 63; F.wave = __builtin_amdgcn_readfirstlane(F.tid >> 6);
    F.G = gridDim.x; { const int bx = blockIdx.x; F.vcu = (F.G % 8 == 0) ? (bx % 8) * (F.G / 8) + bx / 8 : bx; }
    for (int u = F.tid; u < (LDS_BYTES - LDSCTL_OFF) / 4; u += 512) ((LAS unsigned*)(F.lds + LDSCTL_OFF))[u] = 0u;
    __syncthreads();
    volatile LAS unsigned* MISC = (volatile LAS unsigned*)(F.lds + MISC_OFF);
#if MK_PER_PHASE
#define GRID_BAR() do { } while (0)
#else
    XcdBarrier bar = xcd_barrier_post(F.ctl + CW_BAR, MISC + 8);
#define GRID_BAR() xcd_barrier(bar)
#endif
    const int lo = args.ph_lo, hi = args.ph_hi;
#define IN(k) (lo <= (k) && (k) < hi)
#define SEAM(k) do { if (IN(k) && IN((k) + 1)) GRID_BAR(); } while (0)
#define DUP(k) (((PROBE_DUP) >> (k)) & 1)
#define PH_BEGIN {
#define PH_END }
    const bf16* P = (const bf16*)(F.ws + WS_P);

    if (IN(0)) { PH_BEGIN  p0_prologue(F, args);  PH_END if (DUP(0)) { GRID_BAR(); PH_BEGIN  p0_prologue(F, args);  PH_END } } SEAM(0);
    if (IN(1)) { PH_BEGIN  p1_gemm_in(F, args);  PH_END if (DUP(1)) { GRID_BAR(); PH_BEGIN  p1_gemm_in(F, args);  PH_END } } SEAM(1);
    if (PROBE_GEMM >= 0 && IN(1)) {
        pg8::Gemm g{(const bf16*)(F.ws + WS_H), (const bf16*)(F.ws + WS_WIN), DP, DP, D, nullptr}; pg8::ProbeOrder S; S.so.init(T, PLD, F.G, (int)blockIdx.x); S.mode = PROBE_GEMM;
        pg8::EpiProbe E{(bf16*)(F.ws + WS_XS)}; pg8::gemm_phase(F.lds, g, S, E); GRID_BAR();
    }
    if (IN(2)) { PH_BEGIN  p2_lora_in(F, args); gla_pass_a(F, args);  PH_END if (DUP(2)) { GRID_BAR(); PH_BEGIN  p2_lora_in(F, args); gla_pass_a(F, args);  PH_END } } SEAM(2);
    if (IN(3)) { PH_BEGIN
        { pg8::Gemm g{(const bf16*)(F.ws + WS_A2), (const bf16*)(F.ws + WS_WLWA), 512, 256, 256, nullptr}; pg8::StaticOrder S; S.init(T, 2048, F.G, (int)blockIdx.x);
          pg8::EpiBf16 E{(bf16*)(F.ws + WS_WAO), 2048, nullptr, 0, 1.f, F.lds}; pg8::gemm_phase(F.lds, g, S, E); }
        { pg8::Gemm g{(const bf16*)(F.ws + WS_A2) + 256, (const bf16*)(F.ws + WS_WLG), 512, 256, 256, nullptr}; pg8::StaticOrder S; S.init(T, 1024, F.G, (int)blockIdx.x);
          pg8::EpiBf16 E{(bf16*)(F.ws + WS_GO), 1024, nullptr, 0, 1.f, F.lds}; pg8::gemm_phase(F.lds, g, S, E); }
        {
            constexpr int NEL = BATCH * GH * GDV * GDK, HEAD = (NEL / 4 / 65536) * 65536; const int bx = (int)blockIdx.x;
            if (F.G == 256) { if (bx >= 128) gla_pass_b(F, 0, HEAD, bx - 128, 128); gla_pass_b(F, HEAD, NEL, F.vcu, F.G); } else gla_pass_b(F, 0, NEL, F.vcu, F.G); }
     PH_END if (DUP(3)) { GRID_BAR(); PH_BEGIN
        { pg8::Gemm g{(const bf16*)(F.ws + WS_A2), (const bf16*)(F.ws + WS_WLWA), 512, 256, 256, nullptr}; pg8::StaticOrder S; S.init(T, 2048, F.G, (int)blockIdx.x);
          pg8::EpiBf16 E{(bf16*)(F.ws + WS_WAO), 2048, nullptr, 0, 1.f, F.lds}; pg8::gemm_phase(F.lds, g, S, E); }
        { pg8::Gemm g{(const bf16*)(F.ws + WS_A2) + 256, (const bf16*)(F.ws + WS_WLG), 512, 256, 256, nullptr}; pg8::StaticOrder S; S.init(T, 1024, F.G, (int)blockIdx.x);
          pg8::EpiBf16 E{(bf16*)(F.ws + WS_GO), 1024, nullptr, 0, 1.f, F.lds}; pg8::gemm_phase(F.lds, g, S, E); }
        {
            constexpr int NEL = BATCH * GH * GDV * GDK, HEAD = (NEL / 4 / 65536) * 65536; const int bx = (int)blockIdx.x;
            if (F.G == 256) { if (bx >= 128) gla_pass_b(F, 0, HEAD, bx - 128, 128); gla_pass_b(F, HEAD, NEL, F.vcu, F.G); } else gla_pass_b(F, 0, NEL, F.vcu, F.G); }
     PH_END } } SEAM(3);
    if (IN(4)) { PH_BEGIN  p4_rwkv_prep(F, args); gla_pass_c(F, args);  PH_END if (DUP(4)) { GRID_BAR(); PH_BEGIN  p4_rwkv_prep(F, args); gla_pass_c(F, args);  PH_END } } SEAM(4);
    if (IN(5)) { PH_BEGIN  p5_rwkv_scan(F, args);  PH_END if (DUP(5)) { GRID_BAR(); PH_BEGIN  p5_rwkv_scan(F, args);  PH_END } } SEAM(5);
    if (IN(6)) { PH_BEGIN  p6_rwkv_post(F, args);  PH_END if (DUP(6)) { GRID_BAR(); PH_BEGIN  p6_rwkv_post(F, args);  PH_END } } SEAM(6);
    if (IN(7)) { PH_BEGIN
        { pg8::Gemm g{(const bf16*)(F.ws + WS_YA), (const bf16*)(F.ws + WS_WBA), RW, RW, RW, nullptr}; pg8::StaticOrder S; S.init(T, D, F.G, (int)blockIdx.x);
          pg8::EpiGate<false> E{(bf16*)(F.ws + WS_MRG), P, args.in[I_BM], C_GATE, F.lds}; pg8::gemm_phase(F.lds, g, S, E); }
        { pg8::Gemm g{(const bf16*)(F.ws + WS_YB), (const bf16*)(F.ws + WS_WBB), GVW, GVW, GVW, nullptr}; pg8::StaticOrder S; S.init(T, D, F.G, (int)blockIdx.x);
          pg8::EpiGate<true> E{(bf16*)(F.ws + WS_MRG), P, args.in[I_BM] + D, C_GATE + D, F.lds}; pg8::gemm_phase(F.lds, g, S, E); }
     PH_END if (DUP(7)) { GRID_BAR(); PH_BEGIN
        { pg8::Gemm g{(const bf16*)(F.ws + WS_YA), (const bf16*)(F.ws + WS_WBA), RW, RW, RW, nullptr}; pg8::StaticOrder S; S.init(T, D, F.G, (int)blockIdx.x);
          pg8::EpiGate<false> E{(bf16*)(F.ws + WS_MRG), P, args.in[I_BM], C_GATE, F.lds}; pg8::gemm_phase(F.lds, g, S, E); }
        { pg8::Gemm g{(const bf16*)(F.ws + WS_YB), (const bf16*)(F.ws + WS_WBB), GVW, GVW, GVW, nullptr}; pg8::StaticOrder S; S.init(T, D, F.G, (int)blockIdx.x);
          pg8::EpiGate<true> E{(bf16*)(F.ws + WS_MRG), P, args.in[I_BM] + D, C_GATE + D, F.lds}; pg8::gemm_phase(F.lds, g, S, E); }
     PH_END } } SEAM(7);
    if (IN(8)) { PH_BEGIN
        pg8::Gemm g{(const bf16*)(F.ws + WS_MRG), (const bf16*)(F.ws + WS_WOUT), D, D, D, nullptr}; pg8::StaticOrder S; S.init(T, D, F.G, (int)blockIdx.x);
        pg8::EpiResF32 E{(float*)(F.ws + WS_X1), args.in[I_X], F.lds}; pg8::gemm_phase(F.lds, g, S, E);
     PH_END if (DUP(8)) { GRID_BAR(); PH_BEGIN
        pg8::Gemm g{(const bf16*)(F.ws + WS_MRG), (const bf16*)(F.ws + WS_WOUT), D, D, D, nullptr}; pg8::StaticOrder S; S.init(T, D, F.G, (int)blockIdx.x);
        pg8::EpiResF32 E{(float*)(F.ws + WS_X1), args.in[I_X], F.lds}; pg8::gemm_phase(F.lds, g, S, E);
     PH_END } } SEAM(8);
    if (IN(9)) { PH_BEGIN  p11_router(F, args);  PH_END if (DUP(9)) { GRID_BAR(); PH_BEGIN  p11_router(F, args);  PH_END } } SEAM(9);
    if (IN(10)) { PH_BEGIN
        moe_tables(F, 16);
        pg8::Gemm g{(const bf16*)(F.ws + WS_H2), (const bf16*)(F.ws + WS_WGU), D, D, D, (const int*)(F.ws + WS_ROUTE + 1024 * 1024)};
        pg8::MoeOrder S{(const volatile LAS int*)(F.lds + MOE_OFF), 16, 4096, F.G, F.vcu, false};
        pg8::EpiGluQ E{(unsigned char*)(F.ws + WS_HH), args.in[I_BGATE], args.in[I_BUP], F.lds}; pg8::gemm_phase<pg8::EpiGluQ, pg8::MoeOrder, 1, true>(F.lds, g, S, E);
     PH_END if (DUP(10)) { GRID_BAR(); PH_BEGIN
        moe_tables(F, 16);
        pg8::Gemm g{(const bf16*)(F.ws + WS_H2), (const bf16*)(F.ws + WS_WGU), D, D, D, (const int*)(F.ws + WS_ROUTE + 1024 * 1024)};
        pg8::MoeOrder S{(const volatile LAS int*)(F.lds + MOE_OFF), 16, 4096, F.G, F.vcu, false};
        pg8::EpiGluQ E{(unsigned char*)(F.ws + WS_HH), args.in[I_BGATE], args.in[I_BUP], F.lds}; pg8::gemm_phase<pg8::EpiGluQ, pg8::MoeOrder, 1, true>(F.lds, g, S, E);
     PH_END } } SEAM(10);
    if (IN(11)) { PH_BEGIN
        moe_tables(F, 8);
        pg8::Gemm g{(const bf16*)(F.ws + WS_HH), (const bf16*)(F.ws + WS_WD), FF, FF, FF, nullptr};
        pg8::MoeOrder S{(const volatile LAS int*)(F.lds + MOE_OFF), 8, 2048, F.G, F.vcu, true};
        pg8::EpiBf16H E{(bf16*)(F.ws + WS_Y), D, args.in[I_BDOWN], D, WQ_INV, F.lds}; pg8::gemm_phase<pg8::EpiBf16H, pg8::MoeOrder, 1, false, true, true>(F.lds, g, S, E);
     PH_END if (DUP(11)) { GRID_BAR(); PH_BEGIN
        moe_tables(F, 8);
        pg8::Gemm g{(const bf16*)(F.ws + WS_HH), (const bf16*)(F.ws + WS_WD), FF, FF, FF, nullptr};
        pg8::MoeOrder S{(const volatile LAS int*)(F.lds + MOE_OFF), 8, 2048, F.G, F.vcu, true};
        pg8::EpiBf16H E{(bf16*)(F.ws + WS_Y), D, args.in[I_BDOWN], D, WQ_INV, F.lds}; pg8::gemm_phase<pg8::EpiBf16H, pg8::MoeOrder, 1, false, true, true>(F.lds, g, S, E);
     PH_END } } SEAM(11);
    if (IN(12)) { PH_BEGIN  p15_combine(F, args);  PH_END if (DUP(12)) { GRID_BAR(); PH_BEGIN  p15_combine(F, args);  PH_END } }
#undef IN
#undef SEAM
}
constexpr int N_PHASES = 13;

extern "C" void kernel_launch(void* const* d_in, const int* in_sizes, int n_in, void* d_out, int out_size, void* d_ws, size_t ws_size, hipStream_t stream) {
    static int grid = 0;
    if (grid == 0) {
        if (n_in != 31 || in_sizes[0] != T * D || out_size != T * D || ws_size < WS_END) { fprintf(stderr, "kernel_launch: unexpected shapes (n_in %d, ws %zu)\n", n_in, ws_size); grid = -1; return; }
        int dev = 0, cus = 0, per_cu = 0;
        if (hipGetDevice(&dev) != hipSuccess || hipDeviceGetAttribute(&cus, hipDeviceAttributeMultiprocessorCount, dev) != hipSuccess) { grid = -1; return; }
        if (hipFuncSetAttribute((const void*)fwd, hipFuncAttributeMaxDynamicSharedMemorySize, LDS_BYTES) != hipSuccess) { fprintf(stderr, "kernel_launch: hipFuncSetAttribute failed\n"); grid = -1; return; }
        if (hipOccupancyMaxActiveBlocksPerMultiprocessor(&per_cu, (const void*)fwd, 512, LDS_BYTES) != hipSuccess || per_cu < 1) { fprintf(stderr, "kernel_launch: occupancy query says %d\n", per_cu); }
        (void)hipGetLastError();
        grid = cus;
    }
    if (grid < 0) return;
    (void)hipMemsetAsync((char*)d_ws + WS_CTL, 0, CTL_ZERO_BYTES, stream);
    Args a{};
    for (int i = 0; i < 31; ++i) a.in[i] = (const float*)d_in[i];
    a.out = (float*)d_out; a.ws = (unsigned char*)d_ws;
#if MK_PER_PHASE
    for (int p = 0; p < N_PHASES; ++p) { a.ph_lo = p; a.ph_hi = p + 1; hipLaunchKernelGGL(fwd, dim3(grid), dim3(512), LDS_BYTES, stream, a); }
#else
    a.ph_lo = 0; a.ph_hi = N_PHASES;
    hipLaunchKernelGGL(fwd, dim3(grid), dim3(512), LDS_BYTES, stream, a);
#endif
}
```
